# Optimizing an MI355X kernel written in HIP

```python
import math
import jax, jax.numpy as jnp
from jax import lax
import numpy as np

D_MODEL = 1024
BATCH = 4
SEQ = 4096
DEPTH = 2

BRANCH_WIDTH = D_MODEL // 2
N_BRANCH = 3
HG_HEADS = 4
HG_HEAD_DIM = BRANCH_WIDTH // HG_HEADS
HG_CHUNK = 16
S5_GROUP_CH = 16
S5_GROUPS = BRANCH_WIDTH // S5_GROUP_CH
S5_STATE = 64
RG_BLOCKS = 4
RG_BLOCK_W = BRANCH_WIDTH // RG_BLOCKS
RG_CONV = 4
RG_C = 8.0
IN_COLS = 4 * BRANCH_WIDTH + BRANCH_WIDTH + 2 * BRANCH_WIDTH + N_BRANCH * D_MODEL
N_EXPERTS = 64
N_EXPERT_GROUPS = 8
TOPK_GROUPS = 4
TOP_K = 8
EXPERT_HIDDEN = D_MODEL // 4
ROUTED_SCALE = 2.5
MOE_BLOCK = 128
DN_ALPHA = (2 * DEPTH) ** 0.25
DN_BETA = (8 * DEPTH) ** -0.25
LN_EPS = 1e-5
RMS_EPS = 1e-6

kernel_name = 'hybrid_hgrn2_s5_rglru_moe_deepnorm'


def _layernorm(x, g, b):
    xf = x.astype(jnp.float32)
    mu = jnp.mean(xf, axis=-1, keepdims=True)
    var = jnp.mean(jnp.square(xf - mu), axis=-1, keepdims=True)
    y = (xf - mu) * lax.rsqrt(var + LN_EPS) * g.astype(jnp.float32) + b.astype(jnp.float32)
    return y.astype(x.dtype)


def _lin_combine(left, right):
    a_l, b_l = left
    a_r, b_r = right
    return a_l * a_r, a_r * b_l + b_r


def _hgrn2(q, f_pre, v, g, lb, norm_w):
    Bn, S, _ = q.shape
    nc = S // HG_CHUNK
    f32 = jnp.float32

    def heads(t):
        return t.reshape(Bn, nc, HG_CHUNK, HG_HEADS, HG_HEAD_DIM).transpose(0, 3, 1, 2, 4)

    lbf = lb.astype(f32)
    f = lbf + (1.0 - lbf) * jax.nn.sigmoid(f_pre.astype(f32))
    qh = heads(jax.nn.silu(q.astype(f32)))
    kh = heads(1.0 - f)
    vh = heads(v.astype(f32))
    bcum = jnp.cumsum(heads(jnp.log(f)), axis=3)
    causal = jnp.tril(jnp.ones((HG_CHUNK, HG_CHUNK), dtype=bool))
    diff = bcum[:, :, :, :, None, :] - bcum[:, :, :, None, :, :]
    decay = jnp.exp(jnp.where(causal[:, :, None], diff, -jnp.inf))
    scores = jnp.sum(qh[:, :, :, :, None, :] * kh[:, :, :, None, :, :] * decay, axis=-1)
    o_intra = jnp.einsum('bhnts,bhnsv->bhntv', scores, vh)
    b_last = bcum[:, :, :, -1, :]
    kv = jnp.einsum('bhnsd,bhnsv->bhndv', kh * jnp.exp(b_last[:, :, :, None, :] - bcum), vh)

    def step(state, inp):
        dec, upd = inp
        return dec[..., None] * state + upd, state

    init = jnp.zeros((Bn, HG_HEADS, HG_HEAD_DIM, HG_HEAD_DIM), f32)
    _, s_prev = lax.scan(step, init, (jnp.moveaxis(jnp.exp(b_last), 2, 0), jnp.moveaxis(kv, 2, 0)))
    s_prev = jnp.moveaxis(s_prev, 0, 2)
    o = o_intra + jnp.einsum('bhntd,bhndv->bhntv', qh * jnp.exp(bcum), s_prev)
    o = o.transpose(0, 2, 3, 1, 4).reshape(Bn, S, HG_HEADS, HG_HEAD_DIM)
    o = o * lax.rsqrt(jnp.mean(jnp.square(o), axis=-1, keepdims=True) + RMS_EPS)
    o = o.reshape(Bn, S, BRANCH_WIDTH) * norm_w.astype(f32) * jax.nn.silu(g.astype(f32))
    return o.astype(q.dtype)


def _s5(u, a_re, a_im, b_re, b_im, c_re, c_im, d, log_dt, glu_w, glu_b):
    Bn, S, _ = u.shape
    f32 = jnp.float32
    uf = u.astype(f32).reshape(Bn, S, S5_GROUPS, S5_GROUP_CH)
    A = lax.complex(a_re.astype(f32), a_im.astype(f32))
    dt = jnp.exp(log_dt.astype(f32))[:, None]
    A_bar = jnp.exp(A * dt)
    B_bar = ((A_bar - 1.0) / A)[..., None] * lax.complex(b_re.astype(f32), b_im.astype(f32))
    Cm = lax.complex(c_re.astype(f32), c_im.astype(f32))
    bu = jnp.einsum('bsgc,gpc->bsgp', uf.astype(jnp.complex64), B_bar)
    a = jnp.broadcast_to(A_bar[None, None], (1, S, S5_GROUPS, S5_STATE))
    _, h = lax.associative_scan(_lin_combine, (a, bu), axis=1)
    y = jnp.einsum('bsgp,gcp->bsgc', h, Cm).real + d.astype(f32).reshape(S5_GROUPS, S5_GROUP_CH) * uf
    y = jax.nn.gelu(y.reshape(Bn, S, BRANCH_WIDTH))
    y = y * jax.nn.sigmoid(jnp.einsum('bsc,ce->bse', y, glu_w.astype(f32)) + glu_b.astype(f32))
    return y.astype(u.dtype)


def _rglru(xg, xr, conv_w, conv_b, wa, ba, wx, bx, lam):
    Bn, S, _ = xr.shape
    f32 = jnp.float32
    xc = lax.conv_general_dilated(
        xr.astype(f32), conv_w.astype(f32)[:, None, :], window_strides=(1,),
        padding=[(RG_CONV - 1, 0)], dimension_numbers=('NWC', 'WIO', 'NWC'),
        feature_group_count=BRANCH_WIDTH) + conv_b.astype(f32)
    xb = xc.reshape(Bn, S, RG_BLOCKS, RG_BLOCK_W)
    r = jax.nn.sigmoid(jnp.einsum('bshi,hij->bshj', xb, wa.astype(f32)).reshape(Bn, S, BRANCH_WIDTH) + ba.astype(f32))
    i = jax.nn.sigmoid(jnp.einsum('bshi,hij->bshj', xb, wx.astype(f32)).reshape(Bn, S, BRANCH_WIDTH) + bx.astype(f32))
    log_a = -RG_C * r * jax.nn.softplus(-lam.astype(f32))
    a = jnp.exp(log_a)
    b = jnp.sqrt(-jnp.expm1(2.0 * log_a)) * (i * xc)
    _, h = lax.associative_scan(_lin_combine, (a, b), axis=1)
    return (h * jax.nn.gelu(xg.astype(f32))).astype(xr.dtype)


def _swiglu(x, w1, w3, w2):
    return (jax.nn.silu(x @ w1) * (x @ w3)) @ w2


def _moe(x2d, router_w, router_bias, w1, w3, w2, sw1, sw3, sw2):
    N, D = x2d.shape
    f32 = jnp.float32
    scores = jax.nn.sigmoid(x2d.astype(f32) @ router_w.astype(f32))
    biased = scores + router_bias.astype(f32)
    per_group = N_EXPERTS // N_EXPERT_GROUPS
    grp_score = jnp.sum(lax.top_k(biased.reshape(N, N_EXPERT_GROUPS, per_group), 2)[0], axis=-1)
    _, grp_idx = lax.top_k(grp_score, TOPK_GROUPS)
    grp_mask = jnp.any(grp_idx[:, :, None] == jnp.arange(N_EXPERT_GROUPS)[None, None, :], axis=1)
    masked = jnp.where(jnp.repeat(grp_mask, per_group, axis=1), biased, -jnp.inf)
    _, top_idx = lax.top_k(masked, TOP_K)
    w = jnp.take_along_axis(scores, top_idx, axis=1)
    w = w / jnp.sum(w, axis=-1, keepdims=True) * ROUTED_SCALE

    nk = N * TOP_K
    e_flat = top_idx.reshape(-1)
    tok_flat = jnp.arange(nk, dtype=jnp.int32) // TOP_K
    w_flat = w.reshape(-1)
    order = jnp.argsort(e_flat)
    e_sorted = e_flat[order]
    counts = jnp.zeros((N_EXPERTS,), jnp.int32).at[e_flat].add(1)
    start = jnp.cumsum(counts) - counts
    padded = (counts + MOE_BLOCK - 1) // MOE_BLOCK * MOE_BLOCK
    pad_end = jnp.cumsum(padded)
    pad_start = pad_end - padded
    dest = pad_start[e_sorted] + (jnp.arange(nk, dtype=jnp.int32) - start[e_sorted])
    n_blocks = (nk + N_EXPERTS * (MOE_BLOCK - 1) + MOE_BLOCK - 1) // MOE_BLOCK
    n_rows = n_blocks * MOE_BLOCK
    row_tok = jnp.full((n_rows,), N, jnp.int32).at[dest].set(tok_flat[order])
    row_w = jnp.zeros((n_rows,), f32).at[dest].set(w_flat[order])
    block_start = jnp.arange(n_blocks, dtype=jnp.int32) * MOE_BLOCK
    block_exp = jnp.minimum(jnp.searchsorted(pad_end, block_start, side='right'), N_EXPERTS - 1)
    x_pad = jnp.concatenate([x2d, jnp.zeros((1, D), x2d.dtype)], axis=0)

    def block_fn(acc, inp):
        rows, wts, e = inp
        xb = x_pad[rows]
        yb = _swiglu(xb, w1[e], w3[e], w2[e]) * wts[:, None].astype(x2d.dtype)
        return acc.at[rows].add(yb), None

    acc0 = jnp.zeros((N + 1, D), x2d.dtype)
    routed, _ = lax.scan(block_fn, acc0, (row_tok.reshape(n_blocks, MOE_BLOCK),
                                          row_w.reshape(n_blocks, MOE_BLOCK), block_exp))
    return routed[:N] + _swiglu(x2d, sw1, sw3, sw2)


def setup_inputs(seed: int = 0) -> dict:
    key = jax.random.key(seed)
    ks = jax.random.split(key, 36)
    L, D, W = DEPTH, D_MODEL, BRANCH_WIDTH
    G, P, CH = S5_GROUPS, S5_STATE, S5_GROUP_CH
    E, H = N_EXPERTS, EXPERT_HIDDEN

    def nrm(i, shape, s):
        return s * jax.random.normal(ks[i], shape, jnp.float32)

    def uni(i, shape, lo, hi):
        return jax.random.uniform(ks[i], shape, jnp.float32, lo, hi)

    a0 = uni(21, (L, W), 0.9, 0.999)
    s = a0 ** (1.0 / RG_C)
    return {
        'x': nrm(0, (BATCH, SEQ, D), 1.0),
        'w_in': nrm(1, (L, D, IN_COLS), D ** -0.5),
        'b_gate': nrm(2, (L, N_BRANCH * D), 0.02),
        'hgrn_lb_logits': nrm(3, (L, W), 0.5),
        'hgrn_norm_w': 1.0 + nrm(4, (L, W), 0.02),
        's5_a_re': -0.5 + nrm(5, (L, G, P), 0.01),
        's5_a_im': math.pi * jnp.arange(P, dtype=jnp.float32) + nrm(6, (L, G, P), 0.01),
        's5_b_re': nrm(7, (L, G, P, CH), (2 * CH) ** -0.5),
        's5_b_im': nrm(8, (L, G, P, CH), (2 * CH) ** -0.5),
        's5_c_re': nrm(9, (L, G, CH, P), (2 * P) ** -0.5),
        's5_c_im': nrm(10, (L, G, CH, P), (2 * P) ** -0.5),
        's5_d': nrm(11, (L, W), 0.5),
        's5_log_dt': uni(12, (L, G), math.log(1e-3), math.log(1e-1)),
        's5_glu_w': nrm(13, (L, W, W), W ** -0.5),
        's5_glu_b': nrm(14, (L, W), 0.02),
        'rg_conv_w': nrm(15, (L, RG_CONV, W), RG_CONV ** -0.5),
        'rg_conv_b': nrm(16, (L, W), 0.02),
        'rg_wa': nrm(17, (L, RG_BLOCKS, RG_BLOCK_W, RG_BLOCK_W), RG_BLOCK_W ** -0.5),
        'rg_ba': nrm(18, (L, W), 0.02),
        'rg_wx': nrm(19, (L, RG_BLOCKS, RG_BLOCK_W, RG_BLOCK_W), RG_BLOCK_W ** -0.5),
        'rg_bx': nrm(20, (L, W), 0.02),
        'rg_lambda': jnp.log(s) - jnp.log1p(-s),
        'w_branch': nrm(22, (L, N_BRANCH, W, D), DN_BETA * W ** -0.5),
        'w_out': nrm(23, (L, D, D), DN_BETA * D ** -0.5),
        'ln1_g': 1.0 + nrm(24, (L, D), 0.02),
        'ln1_b': nrm(25, (L, D), 0.02),
        'router_w': nrm(26, (L, D, E), D ** -0.5),
        'router_bias': nrm(27, (L, E), 0.01),
        'exp_w1': nrm(28, (L, E, D, H), D ** -0.5),
        'exp_w3': nrm(29, (L, E, D, H), D ** -0.5),
        'exp_w2': nrm(30, (L, E, H, D), DN_BETA * H ** -0.5),
        'sh_w1': nrm(31, (L, D, H), D ** -0.5),
        'sh_w3': nrm(32, (L, D, H), D ** -0.5),
        'sh_w2': nrm(33, (L, H, D), DN_BETA * H ** -0.5),
        'ln2_g': 1.0 + nrm(34, (L, D), 0.02),
        'ln2_b': nrm(35, (L, D), 0.02),
    }


def reference(x, w_in, b_gate, hgrn_lb_logits, hgrn_norm_w, s5_a_re, s5_a_im, s5_b_re, s5_b_im,
              s5_c_re, s5_c_im, s5_d, s5_log_dt, s5_glu_w, s5_glu_b, rg_conv_w, rg_conv_b,
              rg_wa, rg_ba, rg_wx, rg_bx, rg_lambda, w_branch, w_out, ln1_g, ln1_b,
              router_w, router_bias, exp_w1, exp_w3, exp_w2, sh_w1, sh_w3, sh_w2, ln2_g, ln2_b):
    Bn, S, D = x.shape
    sm = jax.nn.softmax(hgrn_lb_logits.astype(jnp.float32), axis=0)
    lower_bounds = jnp.cumsum(sm, axis=0) - sm[0:1]
    splits = np.cumsum([BRANCH_WIDTH] * 7).tolist()
    for l in range(DEPTH):
        proj = jnp.einsum('bsd,dc->bsc', x, w_in[l])
        hq, hf, hi, hg, su, rg_g, rg_x, gate_pre = jnp.split(proj, splits, axis=-1)
        y_a = _hgrn2(hq, hf, hi, hg, lower_bounds[l], hgrn_norm_w[l])
        y_b = _s5(su, s5_a_re[l], s5_a_im[l], s5_b_re[l], s5_b_im[l], s5_c_re[l], s5_c_im[l],
                  s5_d[l], s5_log_dt[l], s5_glu_w[l], s5_glu_b[l])
        y_c = _rglru(rg_g, rg_x, rg_conv_w[l], rg_conv_b[l], rg_wa[l], rg_ba[l], rg_wx[l], rg_bx[l],
                     rg_lambda[l])
        ys = jnp.stack([y_a, y_b, y_c], axis=2)
        branch = jnp.einsum('bskc,kcd->bskd', ys, w_branch[l])
        gates = jax.nn.sigmoid(gate_pre.reshape(Bn, S, N_BRANCH, D) + b_gate[l].reshape(N_BRANCH, D))
        mix = jnp.einsum('bsd,de->bse', jnp.sum(gates * branch, axis=2), w_out[l])
        x = _layernorm(DN_ALPHA * x + mix, ln1_g[l], ln1_b[l])
        ffn = _moe(x.reshape(Bn * S, D), router_w[l], router_bias[l], exp_w1[l], exp_w3[l], exp_w2[l],
                   sh_w1[l], sh_w3[l], sh_w2[l]).reshape(Bn, S, D)
        x = _layernorm(DN_ALPHA * x + ffn, ln2_g[l], ln2_b[l])
    return x
```

```cpp
#include <hip/hip_runtime.h>
#include <hip/hip_cooperative_groups.h>
#include <cstdio>
#include <cstdint>
namespace cg = cooperative_groups;

typedef unsigned short u16;
typedef __attribute__((ext_vector_type(8))) short bf16x8;
typedef __attribute__((ext_vector_type(4))) float f32x4;

constexpr int NTOK = 16384, DM = 1024, SEQ = 4096, BW = 512, INC = 6656;
constexpr int NE = 64, EH = 256;
constexpr int NPH = 12;
constexpr float DN_ALPHA = 1.4142135623730951f;
constexpr size_t SLOT = 16777216ull;

constexpr size_t OFF_WINT  = 0;
constexpr size_t OFF_WBRT  = 13631488;
constexpr size_t OFF_WOUTT = 16777216;
constexpr size_t OFF_GLUT  = 18874368;
constexpr size_t OFF_RGT   = 19398656;
constexpr size_t OFF_SH13T = 19660800;
constexpr size_t OFF_SH2T  = 20709376;
constexpr size_t OFF_BTA   = 21233664;
constexpr size_t OFF_BTC   = 23330816;
constexpr size_t OFF_ROUTT = 29622272;
constexpr size_t OFF_MISC  = 29753344;
constexpr size_t OFF_LB    = OFF_MISC;
constexpr size_t OFF_CUR   = OFF_MISC + 2048;
constexpr size_t OFF_DEC   = OFF_MISC + 4096;
constexpr size_t OFF_TKW   = OFF_DEC + 524288;
constexpr size_t OFF_XB    = 2 * SLOT;
constexpr size_t OFF_VC    = 2 * SLOT;
constexpr size_t OFF_XC    = 3 * SLOT;
constexpr size_t OFF_MIXP  = 2 * SLOT;
constexpr size_t OFF_LIST  = 2 * SLOT;
constexpr size_t OFF_HSH   = 2 * SLOT + 4194304;
constexpr size_t OFF_PQ    = 4 * SLOT;
constexpr size_t OFF_PLF   = 5 * SLOT;
constexpr size_t OFF_PK    = 7 * SLOT;
constexpr size_t OFF_PV    = 8 * SLOT;
constexpr size_t OFF_YC    = 8 * SLOT;
constexpr size_t OFF_PG    = 9 * SLOT;
constexpr size_t OFF_PU    = 10 * SLOT;
constexpr size_t OFF_PXG   = 11 * SLOT;
constexpr size_t OFF_PXR   = 12 * SLOT;
constexpr size_t OFF_YB    = 12 * SLOT;
constexpr size_t OFF_PGATE = 13 * SLOT;
constexpr size_t OFF_KTT   = 19 * SLOT;
constexpr size_t OFF_YA    = 19 * SLOT;
constexpr size_t OFF_VT    = 20 * SLOT;
constexpr size_t OFF_ST    = 21 * SLOT;
constexpr size_t OFF_LA    = 23 * SLOT;
constexpr size_t OFF_BB    = 24 * SLOT;
constexpr size_t OFF_YG    = 25 * SLOT;
constexpr size_t OFF_HC    = 26 * SLOT;
constexpr size_t OFF_PRELN = 4 * SLOT;
constexpr size_t OFF_XM    = 8 * SLOT;
constexpr size_t OFF_EW13  = 10 * SLOT;
constexpr size_t OFF_EW2   = 14 * SLOT;
constexpr size_t OFF_HBUF  = 4 * SLOT;
constexpr size_t OFF_YBUF  = 16 * SLOT;
constexpr size_t WS_NEED   = 32 * SLOT;

struct Params {
    const float* in[36];
    float* out;
    unsigned char* ws;
    int ph_lo, ph_hi;
    int coop, pad;
};
typedef const __attribute__((address_space(4))) Params CParams;

__device__ __forceinline__ u16 f2bf(float f) {
    unsigned u = __builtin_bit_cast(unsigned, f);
    return (u16)((u + 0x7fffu + ((u >> 16) & 1u)) >> 16);
}
__device__ __forceinline__ float bf2f(u16 h) { return __builtin_bit_cast(float, (unsigned)h << 16); }
__device__ __forceinline__ float sigm(float x) { return 1.f / (1.f + __expf(-x)); }
__device__ __forceinline__ float silu_f(float x) { return x * sigm(x); }
__device__ __forceinline__ float gelu_f(float x) {
    float u = 0.7978845608028654f * (x + 0.044715f * x * x * x);
    float t = 1.f - 2.f / (1.f + __expf(2.f * u));
    return 0.5f * x * (1.f + t);
}
__device__ __forceinline__ float wave_sum(float v) {
#pragma unroll
    for (int o = 32; o >= 1; o >>= 1) v += __shfl_xor(v, o);
    return v;
}
__device__ __forceinline__ int swz(int row, int ch) { return row * 128 + ((ch ^ ((row >> 1) & 7)) << 4); }


template <class T> __device__ __forceinline__ T ldg(const void* base, unsigned off) { return *(const T*)((const char*)base + off); }
template <class T> __device__ __forceinline__ void stg(void* base, unsigned off, T v) { *(T*)((char*)base + off) = v; }

template <int TM, int TN, int RW, int CW, class F>
__device__ __forceinline__ void epi(f32x4 (&acc)[TM][TN], int wr, int wc, int fq, int fr, F f) {
#pragma unroll
    for (int m = 0; m < TM; ++m) {
#pragma unroll
        for (int j = 0; j < 4; ++j) {
#pragma unroll
            for (int n = 0; n < TN; ++n) f(wr * RW + m * 16 + fq * 4 + j, wc * CW + n * 16 + fr, acc[m][n][j]);
        }
        __builtin_amdgcn_sched_barrier(0);
    }
}

__device__ __forceinline__ int otid() { int t = threadIdx.x; asm volatile("" : "+v"(t)); return t; }

struct NoHook { __device__ __forceinline__ void operator()(int) const {} };

template <int BM, int BN, int WM, int WN, class AL, class BL, class HK>
__device__ __forceinline__ void mma_loop(f32x4 (&acc)[BM / WM / 16][BN / WN / 16], int nk, AL aload, BL bload, HK hook, char* lds) {
    constexpr int TM = BM / WM / 16, TN = BN / WN / 16;
    constexpr int ACH = BM / 32, BCH = BN / 32;
    const int tid = otid(), lane = tid & 63, wid = tid >> 6;
    const int wr = wid / WN, wc = wid % WN, fr = lane & 15, fq = lane >> 4;
    const int srow = tid >> 3, sk = (tid & 7) * 8;
    const int swr = srow * 128 + (((tid & 7) ^ ((tid >> 4) & 7)) << 4);
    const int xr = (fr >> 1) & 7;
    const int a_rd = (wr * (BM / WM) + fr) * 128;
    const int b_rd = BM * 128 + (wc * (BN / WN) + fr) * 128;
    bf16x8 ra[ACH], rb[BCH];
#pragma unroll
    for (int i = 0; i < ACH; ++i) ra[i] = aload(srow + i * 32, sk);
#pragma unroll
    for (int i = 0; i < BCH; ++i) rb[i] = bload(srow + i * 32, sk);
#pragma unroll 1
    for (int t = 0; t < nk; ++t) {
        __syncthreads();
#pragma unroll
        for (int i = 0; i < ACH; ++i) *(bf16x8*)(lds + swr + i * 4096) = ra[i];
#pragma unroll
        for (int i = 0; i < BCH; ++i) *(bf16x8*)(lds + BM * 128 + swr + i * 4096) = rb[i];
        __syncthreads();
        if (t + 1 < nk) {
#pragma unroll
            for (int i = 0; i < ACH; ++i) ra[i] = aload(srow + i * 32, (t + 1) * 64 + sk);
#pragma unroll
            for (int i = 0; i < BCH; ++i) rb[i] = bload(srow + i * 32, (t + 1) * 64 + sk);
        }
        hook(t);
#pragma unroll
        for (int ks = 0; ks < 2; ++ks) {
            const int co = ((ks * 4 + fq) ^ xr) << 4;
            bf16x8 af[TM], bfr[TN];
#pragma unroll
            for (int m = 0; m < TM; ++m) af[m] = *(const bf16x8*)(lds + a_rd + m * 2048 + co);
#pragma unroll
            for (int n = 0; n < TN; ++n) bfr[n] = *(const bf16x8*)(lds + b_rd + n * 2048 + co);
#pragma unroll
            for (int m = 0; m < TM; ++m)
#pragma unroll
                for (int n = 0; n < TN; ++n) acc[m][n] = __builtin_amdgcn_mfma_f32_16x16x32_bf16(af[m], bfr[n], acc[m][n], 0, 0, 0);
        }
    }
}

#define ZERO_ACC(acc, TM, TN) _Pragma("unroll") for (int m_ = 0; m_ < TM; ++m_) _Pragma("unroll") for (int n_ = 0; n_ < TN; ++n_) acc[m_][n_] = f32x4{0.f, 0.f, 0.f, 0.f}

#define LANE_IDS const int tid = otid(), lane = tid & 63, wid = tid >> 6, fr = lane & 15, fq = lane >> 4; (void)tid; (void)lane; (void)wid; (void)fr; (void)fq

__device__ void conv_tile(const float* s1, const float* s2, int ldsrc, int K, int perm, u16* dst, int tile, float* lds) {
    const int tid = otid();
    const int ktiles = K >> 6;
    const int kt = tile % ktiles, nt = tile / ktiles;
    __syncthreads();
#pragma unroll 4
    for (int i = 0; i < 16; ++i) {
        int idx = tid + i * 256, kr = idx >> 6, nc = idx & 63;
        const float* s; int col;
        if (perm) { s = (nc < 32) ? s1 : s2; col = nt * 32 + (nc & 31); } else { s = s1; col = nt * 64 + nc; }
        lds[kr * 65 + nc] = s[(size_t)(kt * 64 + kr) * ldsrc + col];
    }
    __syncthreads();
#pragma unroll 4
    for (int i = 0; i < 16; ++i) {
        int idx = tid + i * 256, nr = idx >> 6, kc = idx & 63;
        dst[(size_t)(nt * 64 + nr) * K + kt * 64 + kc] = f2bf(lds[kc * 65 + nr]);
    }
}

__device__ void s5_precompute(CParams& p, int l, int g, float* lds) {
    const int tid = otid();
    float* Er = lds;
    float* Ei = Er + 64 * 17;
    float* Br = Ei + 64 * 17;
    float* Bi = Br + 1024;
    float* Cr = Bi + 1024;
    float* Ci = Cr + 1024;
    float* Kt = Ci + 1024;
    __syncthreads();
    const int lg = l * 32 + g;
    const float dt = expf(p.in[12][lg]);
    {
        const int pp = tid & 63, part = tid >> 6;
        const float ar = p.in[5][lg * 64 + pp], ai = p.in[6][lg * 64 + pp];
        for (int tau = part; tau <= 16; tau += 4) {
            float mag = expf((float)tau * ar * dt);
            float ang = (float)tau * ai * dt;
            Er[pp * 17 + tau] = mag * cosf(ang);
            Ei[pp * 17 + tau] = mag * sinf(ang);
        }
        float mag = expf(ar * dt), ang = ai * dt;
        float e1r = mag * cosf(ang) - 1.f, e1i = mag * sinf(ang);
        float den = ar * ar + ai * ai;
        float qr = (e1r * ar + e1i * ai) / den, qi = (e1i * ar - e1r * ai) / den;
        for (int c = part * 4; c < part * 4 + 4; ++c) {
            float br = p.in[7][((size_t)lg * 64 + pp) * 16 + c], bi = p.in[8][((size_t)lg * 64 + pp) * 16 + c];
            Br[pp * 16 + c] = qr * br - qi * bi;
            Bi[pp * 16 + c] = qr * bi + qi * br;
            Cr[c * 64 + pp] = p.in[9][((size_t)lg * 16 + c) * 64 + pp];
            Ci[c * 64 + pp] = p.in[10][((size_t)lg * 16 + c) * 64 + pp];
        }
    }
    __syncthreads();
    for (int i = 0; i < 16; ++i) {
        int idx = tid + i * 256, tau = idx >> 8, ch = (idx >> 4) & 15, c2 = idx & 15;
        float s = 0.f;
        for (int pp = 0; pp < 64; ++pp) {
            float cr = Cr[ch * 64 + pp], ci = Ci[ch * 64 + pp], er = Er[pp * 17 + tau], ei = Ei[pp * 17 + tau];
            float gr = cr * er - ci * ei, gi = cr * ei + ci * er;
            s += gr * Br[pp * 16 + c2] - gi * Bi[pp * 16 + c2];
        }
        Kt[idx] = s;
    }
    __syncthreads();
    u16* bta = (u16*)(p.ws + OFF_BTA) + (size_t)g * 128 * 256;
    for (int i = 0; i < 128; ++i) {
        int idx = tid + i * 256, pr = idx >> 8, k = idx & 255, s = k >> 4, ch = k & 15, pp = pr & 63;
        float er = Er[pp * 17 + 15 - s], ei = Ei[pp * 17 + 15 - s], br = Br[pp * 16 + ch], bi = Bi[pp * 16 + ch];
        float v = (pr < 64) ? (er * br - ei * bi) : (er * bi + ei * br);
        bta[idx] = f2bf(v);
    }
    u16* btc = (u16*)(p.ws + OFF_BTC) + (size_t)g * 256 * 384;
    for (int i = 0; i < 384; ++i) {
        int idx = tid + i * 256, n = idx / 384, k = idx - n * 384, j = n >> 4, ch = n & 15;
        float v;
        if (k < 256) {
            int s = k >> 4, c2 = k & 15;
            v = (s <= j) ? Kt[((j - s) * 16 + ch) * 16 + c2] : 0.f;
        } else {
            int pr = k - 256, pp = pr & 63;
            float cr = Cr[ch * 64 + pp], ci = Ci[ch * 64 + pp], er = Er[pp * 17 + j + 1], ei = Ei[pp * 17 + j + 1];
            float gr = cr * er - ci * ei, gi = cr * ei + ci * er;
            v = (pr < 64) ? gr : -gi;
        }
        btc[idx] = f2bf(v);
    }
}

constexpr int W_CONV_TILES = 2608;
__device__ void phase_w(CParams& p, int l, char* lds) {
    const int tid = otid();
    const int nunits = W_CONV_TILES + 32 + 1 + (l == 0 ? 1024 : 0);
    for (int u = blockIdx.x; u < nunits; u += gridDim.x) {
        if (u < W_CONV_TILES) {
            int t = u;
            const float *s1, *s2 = nullptr; int ld, K, perm = 0; u16* dst;
            if (t < 1664) { s1 = p.in[1] + (size_t)l * DM * INC; ld = INC; K = 1024; dst = (u16*)(p.ws + OFF_WINT); }
            else if ((t -= 1664) < 384) { int k = t >> 7; t &= 127; s1 = p.in[22] + (size_t)(l * 3 + k) * 512 * 1024; ld = 1024; K = 512; dst = (u16*)(p.ws + OFF_WBRT) + (size_t)k * 1024 * 512; }
            else if ((t -= 384) < 256) { s1 = p.in[23] + (size_t)l * 1024 * 1024; ld = 1024; K = 1024; dst = (u16*)(p.ws + OFF_WOUTT); }
            else if ((t -= 256) < 64) { s1 = p.in[13] + (size_t)l * 512 * 512; ld = 512; K = 512; dst = (u16*)(p.ws + OFF_GLUT); }
            else if ((t -= 64) < 32) { int h = t >> 3; t &= 7; s1 = p.in[17] + (size_t)(l * 4 + h) * 128 * 128; s2 = p.in[19] + (size_t)(l * 4 + h) * 128 * 128; ld = 128; K = 128; perm = 1; dst = (u16*)(p.ws + OFF_RGT) + (size_t)h * 256 * 128; }
            else if ((t -= 32) < 128) { s1 = p.in[31] + (size_t)l * 1024 * 256; s2 = p.in[32] + (size_t)l * 1024 * 256; ld = 256; K = 1024; perm = 1; dst = (u16*)(p.ws + OFF_SH13T); }
            else if ((t -= 128) < 64) { s1 = p.in[33] + (size_t)l * 256 * 1024; ld = 1024; K = 256; dst = (u16*)(p.ws + OFF_SH2T); }
            else { t -= 64; s1 = p.in[26] + (size_t)l * 1024 * 64; ld = 64; K = 1024; dst = (u16*)(p.ws + OFF_ROUTT); }
            conv_tile(s1, s2, ld, K, perm, dst, t, (float*)lds);
        } else if (u < W_CONV_TILES + 32) {
            s5_precompute(p, l, u - W_CONV_TILES, (float*)lds);
        } else if (u == W_CONV_TILES + 32) {
            float* LB = (float*)(p.ws + OFF_LB);
            for (int c = tid; c < 512; c += 256) {
                float x0 = p.in[3][c], x1 = p.in[3][512 + c];
                LB[c] = (l == 0) ? 0.f : 1.f / (1.f + expf(x0 - x1));
            }
            if (tid < 64) ((int*)(p.ws + OFF_CUR))[tid] = 0;
        } else {
            int r0 = (u - (W_CONV_TILES + 33)) * 16;
            const float4* src = (const float4*)(p.in[0] + (size_t)r0 * DM);
            uint2* dst = (uint2*)((u16*)(p.ws + OFF_XB) + (size_t)r0 * DM);
            for (int i = tid; i < 16 * 256; i += 256) {
                float4 v = src[i];
                uint2 o; o.x = f2bf(v.x) | ((unsigned)f2bf(v.y) << 16); o.y = f2bf(v.z) | ((unsigned)f2bf(v.w) << 16);
                dst[i] = o;
            }
        }
    }
}

__device__ void phase_proj(CParams& p, int l, char* lds) {
    LANE_IDS;
    const int wr = wid >> 1, wc = wid & 1;
    unsigned char* ws = p.ws;
    const float* bg = p.in[2] + (size_t)l * 3072;
    const int ntn = INC / 128;
    for (int u = blockIdx.x; u < 128 * ntn; u += gridDim.x) {
        const int tm = u / ntn, tn = u % ntn, row0 = tm * 128, col0 = tn * 128;
        f32x4 acc[4][4]; ZERO_ACC(acc, 4, 4);
        mma_loop<128, 128, 2, 2>(acc, 16,
            [&](int r, int k) { return ldg<bf16x8>(ws, (unsigned)(OFF_XB + ((row0 + r) * DM + k) * 2)); },
            [&](int c, int k) { return ldg<bf16x8>(ws, (unsigned)(OFF_WINT + ((col0 + c) * DM + k) * 2)); }, NoHook(), lds);
        const int seg = col0 >> 9;
        if (seg == 0) epi<4, 4, 64, 64>(acc, wr, wc, fq, fr, [&](int r, int cc, float v) {
            stg<u16>(ws, (unsigned)(OFF_PQ + ((row0 + r) * 512 + ((col0 + cc) & 511)) * 2), f2bf(silu_f(v))); });
        else if (seg == 1) epi<4, 4, 64, 64>(acc, wr, wc, fq, fr, [&](int r, int cc, float v) {
            const int c = (col0 + cc) & 511;
            const float lb = ldg<float>(ws, (unsigned)(OFF_LB + c * 4)), sg = sigm(v);
            const float f = lb + (1.f - lb) * sg;
            stg<float>(ws, (unsigned)(OFF_PLF + ((row0 + r) * 512 + c) * 4), logf(f));
            stg<u16>(ws, (unsigned)(OFF_PK + ((row0 + r) * 512 + c) * 2), f2bf((1.f - lb) * (1.f - sg))); });
        else if (seg == 2) epi<4, 4, 64, 64>(acc, wr, wc, fq, fr, [&](int r, int cc, float v) {
            stg<u16>(ws, (unsigned)(OFF_PV + ((row0 + r) * 512 + ((col0 + cc) & 511)) * 2), f2bf(v)); });
        else if (seg == 3) epi<4, 4, 64, 64>(acc, wr, wc, fq, fr, [&](int r, int cc, float v) {
            stg<u16>(ws, (unsigned)(OFF_PG + ((row0 + r) * 512 + ((col0 + cc) & 511)) * 2), f2bf(silu_f(v))); });
        else if (seg == 4) epi<4, 4, 64, 64>(acc, wr, wc, fq, fr, [&](int r, int cc, float v) {
            const int c = (col0 + cc) & 511;
            stg<u16>(ws, (unsigned)(OFF_PU + (((c >> 4) * NTOK + row0 + r) * 16 + (c & 15)) * 2), f2bf(v)); });
        else if (seg == 5) epi<4, 4, 64, 64>(acc, wr, wc, fq, fr, [&](int r, int cc, float v) {
            stg<u16>(ws, (unsigned)(OFF_PXG + ((row0 + r) * 512 + ((col0 + cc) & 511)) * 2), f2bf(gelu_f(v))); });
        else if (seg == 6) epi<4, 4, 64, 64>(acc, wr, wc, fq, fr, [&](int r, int cc, float v) {
            stg<u16>(ws, (unsigned)(OFF_PXR + ((row0 + r) * 512 + ((col0 + cc) & 511)) * 2), f2bf(v)); });
        else epi<4, 4, 64, 64>(acc, wr, wc, fq, fr, [&](int r, int cc, float v) {
            const int gc = col0 + cc - 3584;
            stg<u16>(ws, (unsigned)(OFF_PGATE + ((row0 + r) * 3072 + gc) * 2), f2bf(sigm(v + bg[gc]))); });
    }
}

__device__ void hgrn_prep(CParams& p, int u) {
    const int tid = otid();
    const int h = u & 3, c = (u >> 2) & 63, b = u >> 8;
    const int r0 = b * SEQ + c * 64;
    const size_t cu = (size_t)((b * 4 + h) * 64 + c);
    if (tid < 128) {
        const int d = tid;
        float* lf = (float*)(p.ws + OFF_PLF) + (size_t)r0 * 512 + h * 128 + d;
        const u16* kk = (const u16*)(p.ws + OFF_PK) + (size_t)r0 * 512 + h * 128 + d;
        float bs[64];
#pragma unroll
        for (int s = 0; s < 64; ++s) bs[s] = lf[(size_t)s * 512];
        float run = 0.f;
#pragma unroll
        for (int s = 0; s < 64; ++s) { run += bs[s]; bs[s] = run; lf[(size_t)s * 512] = run; }
        const float btot = run;
        ((float*)(p.ws + OFF_DEC))[(size_t)(b * 64 + c) * 512 + h * 128 + d] = __expf(btot);
        u16* dst = (u16*)(p.ws + OFF_KTT) + (cu * 128 + d) * 64;
#pragma unroll
        for (int s8 = 0; s8 < 8; ++s8) {
            bf16x8 o;
#pragma unroll
            for (int e = 0; e < 8; ++e) {
                int s = s8 * 8 + e;
                o[e] = (short)f2bf(bf2f(kk[(size_t)s * 512]) * __expf(btot - bs[s]));
            }
            *(bf16x8*)(dst + s8 * 8) = o;
        }
    } else {
        const int v = tid - 128;
        const u16* vv = (const u16*)(p.ws + OFF_PV) + (size_t)r0 * 512 + h * 128 + v;
        u16* dst = (u16*)(p.ws + OFF_VT) + (cu * 128 + v) * 64;
#pragma unroll
        for (int s8 = 0; s8 < 8; ++s8) {
            bf16x8 o;
#pragma unroll
            for (int e = 0; e < 8; ++e) o[e] = (short)vv[(size_t)(s8 * 8 + e) * 512];
            *(bf16x8*)(dst + s8 * 8) = o;
        }
    }
}

__device__ void s5_gemm_a(CParams& p, int u, char* lds) {
    LANE_IDS;
    const int wr = wid >> 1, wc = wid & 1;
    const int g = u >> 3, tm = u & 7, row0 = tm * 128;
    unsigned char* ws = p.ws;
    const unsigned aoff = (unsigned)(OFF_PU + (size_t)g * NTOK * 16 * 2), boff = (unsigned)(OFF_BTA + (size_t)g * 128 * 256 * 2);
    f32x4 acc[4][4]; ZERO_ACC(acc, 4, 4);
    mma_loop<128, 128, 2, 2>(acc, 4,
        [&](int r, int k) { return ldg<bf16x8>(ws, aoff + ((row0 + r) * 256 + k) * 2); },
        [&](int c, int k) { return ldg<bf16x8>(ws, boff + (c * 256 + k) * 2); }, NoHook(), lds);
    epi<4, 4, 64, 64>(acc, wr, wc, fq, fr, [&](int r, int cc, float v) {
        stg<float>(ws, (unsigned)(OFF_VC + (((row0 + r) * 32 + g) * 128 + cc) * 4), v); });
}

__device__ void rg_conv(CParams& p, int l, int u) {
    const int tid = otid();
    const u16* xr = (const u16*)(p.ws + OFF_PXR);
    u16* xc = (u16*)(p.ws + OFF_XC);
    const float* cw = p.in[15] + (size_t)l * 4 * 512;
    const float* cb = p.in[16] + (size_t)l * 512;
    for (int i = tid; i < 64 * 64; i += 256) {
        const int row = u * 64 + (i >> 6), c8 = (i & 63) * 8;
        const int t = row & (SEQ - 1);
        float a[8];
#pragma unroll
        for (int e = 0; e < 8; ++e) a[e] = cb[c8 + e];
#pragma unroll
        for (int j = 0; j < 4; ++j) {
            if (t - 3 + j >= 0) {
                bf16x8 x = *(const bf16x8*)(xr + (size_t)(row - 3 + j) * 512 + c8);
#pragma unroll
                for (int e = 0; e < 8; ++e) a[e] += cw[j * 512 + c8 + e] * bf2f((u16)x[e]);
            }
        }
        bf16x8 o;
#pragma unroll
        for (int e = 0; e < 8; ++e) o[e] = (short)f2bf(a[e]);
        *(bf16x8*)(xc + (size_t)row * 512 + c8) = o;
    }
}

__device__ void phase2(CParams& p, int l, char* lds) {
    for (int u = blockIdx.x; u < 1536; u += gridDim.x) {
        if (u < 1024) hgrn_prep(p, u);
        else if (u < 1280) s5_gemm_a(p, u - 1024, lds);
        else rg_conv(p, l, u - 1280);
    }
}

__device__ void hgrn_state(CParams& p, int u, char* lds) {
    LANE_IDS;
    const int wr = wid >> 1, wc = wid & 1;
    const int vh = u & 1, bh = u >> 1, b = bh >> 2, h = bh & 3;
    const u16* A = (const u16*)(p.ws + OFF_KTT) + (size_t)bh * 64 * 128 * 64;
    const u16* Bv = (const u16*)(p.ws + OFF_VT) + (size_t)bh * 64 * 128 * 64 + (size_t)vh * 64 * 64;
    u16* ST = (u16*)(p.ws + OFF_ST) + (size_t)bh * 64 * 128 * 128;
    const float* Dec = (const float*)(p.ws + OFF_DEC) + (size_t)b * 64 * 512 + h * 128;
    f32x4 acc[4][2]; ZERO_ACC(acc, 4, 2);
    auto hook = [&](int t) {
        const float* dc = Dec + (size_t)t * 512;
#pragma unroll
        for (int m = 0; m < 4; ++m) {
            const int d0 = wr * 64 + m * 16 + fq * 4;
            const float4 dv = *(const float4*)(dc + d0);
#pragma unroll
            for (int n = 0; n < 2; ++n) {
                const int v = vh * 64 + wc * 32 + n * 16 + fr;
                uint2 o;
                o.x = f2bf(acc[m][n][0]) | ((unsigned)f2bf(acc[m][n][1]) << 16);
                o.y = f2bf(acc[m][n][2]) | ((unsigned)f2bf(acc[m][n][3]) << 16);
                *(uint2*)(ST + ((size_t)t * 128 + v) * 128 + d0) = o;
                acc[m][n][0] *= dv.x; acc[m][n][1] *= dv.y; acc[m][n][2] *= dv.z; acc[m][n][3] *= dv.w;
            }
        }
    };
    mma_loop<128, 64, 2, 2>(acc, 64,
        [&](int r, int k) { return *(const bf16x8*)(A + ((size_t)(k >> 6) * 128 + r) * 64 + (k & 63)); },
        [&](int c, int k) { return *(const bf16x8*)(Bv + ((size_t)(k >> 6) * 128 + c) * 64 + (k & 63)); }, hook, lds);
}

__device__ void s5_scan(CParams& p, int l, int u) {
    const int tid = otid();
    const int b = u >> 3, g = (u & 7) * 4 + (tid >> 6), pp = tid & 63;
    const int lg = l * 32 + g;
    const float dt = expf(p.in[12][lg]);
    const float ar = p.in[5][lg * 64 + pp], ai = p.in[6][lg * 64 + pp];
    const float mag = expf(16.f * ar * dt), ang = 16.f * ai * dt;
    const float er = mag * cosf(ang), ei = mag * sinf(ang);
    const float* Vc = (const float*)(p.ws + OFF_VC) + ((size_t)(b * 256) * 32 + g) * 128 + pp;
    u16* Hc = (u16*)(p.ws + OFF_HC) + ((size_t)(b * 256) * 32 + g) * 128 + pp;
    float hr = 0.f, hi = 0.f;
    for (int c0 = 0; c0 < 256; c0 += 16) {
        float vr[16], vi[16];
#pragma unroll
        for (int i = 0; i < 16; ++i) { vr[i] = Vc[(size_t)(c0 + i) * 4096]; vi[i] = Vc[(size_t)(c0 + i) * 4096 + 64]; }
#pragma unroll
        for (int i = 0; i < 16; ++i) {
            Hc[(size_t)(c0 + i) * 4096] = f2bf(hr);
            Hc[(size_t)(c0 + i) * 4096 + 64] = f2bf(hi);
            float nr = er * hr - ei * hi + vr[i];
            float ni = er * hi + ei * hr + vi[i];
            hr = nr; hi = ni;
        }
    }
}

__device__ void rg_gemm(CParams& p, int l, int u, char* lds) {
    LANE_IDS;
    const int wr = wid >> 1, wc = wid & 1;
    const int tm = u >> 3, h = (u >> 1) & 3, nt = u & 1, row0 = tm * 128;
    unsigned char* ws = p.ws;
    const unsigned aoff = (unsigned)(OFF_XC + h * 128 * 2), boff = (unsigned)(OFF_RGT + ((size_t)h * 256 * 128 + (size_t)nt * 128 * 128) * 2);
    f32x4 acc[4][4]; ZERO_ACC(acc, 4, 4);
    mma_loop<128, 128, 2, 2>(acc, 2,
        [&](int r, int k) { return ldg<bf16x8>(ws, aoff + ((row0 + r) * 512 + k) * 2); },
        [&](int c, int k) { return ldg<bf16x8>(ws, boff + (c * 128 + k) * 2); }, NoHook(), lds);
    const float* ba = p.in[18] + (size_t)l * 512;
    const float* bx = p.in[20] + (size_t)l * 512;
    const float* lam = p.in[21] + (size_t)l * 512;
#pragma unroll
    for (int n = 0; n < 2; ++n) {
        const int ch = h * 128 + (nt * 2 + wc) * 32 + n * 16 + fr;
        const float c1 = -8.f * log1pf(expf(-lam[ch]));
        const float bav = ba[ch], bxv = bx[ch];
#pragma unroll
        for (int m = 0; m < 4; ++m) {
#pragma unroll
            for (int j = 0; j < 4; ++j) {
                const int row = row0 + wr * 64 + m * 16 + fq * 4 + j;
                const float r = sigm(acc[m][n][j] + bav), ig = sigm(acc[m][n + 2][j] + bxv);
                const float la = c1 * r;
                const float x = bf2f(ldg<u16>(ws, (unsigned)(OFF_XC + (row * 512 + ch) * 2)));
                const float bb = sqrtf(fmaxf(1.f - __expf(2.f * la), 0.f)) * ig * x;
                stg<u16>(ws, (unsigned)(OFF_LA + (row * 512 + ch) * 2), f2bf(la));
                stg<u16>(ws, (unsigned)(OFF_BB + (row * 512 + ch) * 2), f2bf(bb));
            }
            __builtin_amdgcn_sched_barrier(0);
        }
    }
}

__device__ void phase3(CParams& p, int l, char* lds) {
    for (int u = blockIdx.x; u < 64 + 1024; u += gridDim.x) {
        if (u < 32) hgrn_state(p, u, lds);
        else if (u < 64) s5_scan(p, l, u - 32);
        else rg_gemm(p, l, u - 64, lds);
    }
}

__device__ void hgrn_out(CParams& p, int l, int u, char* lds) {
    LANE_IDS;
    const int h = u & 3, c = (u >> 2) & 63, b = u >> 8;
    const int r0 = b * SEQ + c * 64;
    const size_t cu = (size_t)((b * 4 + h) * 64 + c);
    const u16* Pq = (const u16*)(p.ws + OFF_PQ) + (size_t)r0 * 512 + h * 128;
    const u16* Pk = (const u16*)(p.ws + OFF_PK) + (size_t)r0 * 512 + h * 128;
    const float* Bc = (const float*)(p.ws + OFF_PLF) + (size_t)r0 * 512 + h * 128;
    char* Ss = lds + (64 + 128) * 128;
    __syncthreads();
    {
        const int i = wid;
        const int t = 16 * i + fr;
        bf16x8 aq[4];
        float refv[4][8];
#pragma unroll
        for (int kk = 0; kk < 4; ++kk) {
            const int d0 = kk * 32 + fq * 8;
            bf16x8 q8 = *(const bf16x8*)(Pq + (size_t)t * 512 + d0);
#pragma unroll
            for (int e = 0; e < 8; ++e) {
                float rf = (i == 0) ? 0.f : Bc[(size_t)(16 * i - 1) * 512 + d0 + e];
                refv[kk][e] = rf;
                float bt = Bc[(size_t)t * 512 + d0 + e];
                aq[kk][e] = (short)f2bf(bf2f((u16)q8[e]) * __expf(bt - rf));
            }
        }
#pragma unroll
        for (int j = 0; j < 4; ++j) {
            f32x4 sc = {0.f, 0.f, 0.f, 0.f};
            if (j <= i) {
                const int s = 16 * j + fr;
#pragma unroll
                for (int kk = 0; kk < 4; ++kk) {
                    const int d0 = kk * 32 + fq * 8;
                    bf16x8 k8 = *(const bf16x8*)(Pk + (size_t)s * 512 + d0);
                    bf16x8 bk;
#pragma unroll
                    for (int e = 0; e < 8; ++e) {
                        float bsv = Bc[(size_t)s * 512 + d0 + e];
                        bk[e] = (short)f2bf(bf2f((u16)k8[e]) * __expf(fminf(refv[kk][e] - bsv, 60.f)));
                    }
                    sc = __builtin_amdgcn_mfma_f32_16x16x32_bf16(aq[kk], bk, sc, 0, 0, 0);
                }
            }
#pragma unroll
            for (int r = 0; r < 4; ++r) {
                const int tl = fq * 4 + r, sl = fr;
                float v = sc[r];
                if (j > i || (j == i && sl > tl)) v = 0.f;
                const int row = 16 * i + tl, col = 16 * j + sl;
                *(u16*)(Ss + swz(row, col >> 3) + (col & 7) * 2) = f2bf(v);
            }
        }
    }
    __syncthreads();
    const u16* STc = (const u16*)(p.ws + OFF_ST) + cu * 128 * 128;
    const u16* VTc = (const u16*)(p.ws + OFF_VT) + cu * 128 * 64;
    f32x4 acc[1][8]; ZERO_ACC(acc, 1, 8);
    mma_loop<64, 128, 4, 1>(acc, 3,
        [&](int r, int k) {
            bf16x8 o;
            if (k < 128) {
                bf16x8 q8 = *(const bf16x8*)(Pq + (size_t)r * 512 + k);
                const float4 b0 = *(const float4*)(Bc + (size_t)r * 512 + k), b1 = *(const float4*)(Bc + (size_t)r * 512 + k + 4);
                o[0] = (short)f2bf(bf2f((u16)q8[0]) * __expf(b0.x)); o[1] = (short)f2bf(bf2f((u16)q8[1]) * __expf(b0.y));
                o[2] = (short)f2bf(bf2f((u16)q8[2]) * __expf(b0.z)); o[3] = (short)f2bf(bf2f((u16)q8[3]) * __expf(b0.w));
                o[4] = (short)f2bf(bf2f((u16)q8[4]) * __expf(b1.x)); o[5] = (short)f2bf(bf2f((u16)q8[5]) * __expf(b1.y));
                o[6] = (short)f2bf(bf2f((u16)q8[6]) * __expf(b1.z)); o[7] = (short)f2bf(bf2f((u16)q8[7]) * __expf(b1.w));
            } else {
                o = *(const bf16x8*)(Ss + swz(r, (k - 128) >> 3));
            }
            return o;
        },
        [&](int cc, int k) {
            return (k < 128) ? *(const bf16x8*)(STc + (size_t)cc * 128 + k) : *(const bf16x8*)(VTc + (size_t)cc * 64 + (k - 128));
        }, NoHook(), lds);
    const float* nw = p.in[4] + (size_t)l * 512 + h * 128;
    const u16* Pg = (const u16*)(p.ws + OFF_PG) + (size_t)r0 * 512 + h * 128;
    u16* Ya = (u16*)(p.ws + OFF_YA) + (size_t)r0 * 512 + h * 128;
#pragma unroll
    for (int j = 0; j < 4; ++j) {
        float ss = 0.f;
#pragma unroll
        for (int n = 0; n < 8; ++n) ss += acc[0][n][j] * acc[0][n][j];
        ss += __shfl_xor(ss, 1); ss += __shfl_xor(ss, 2); ss += __shfl_xor(ss, 4); ss += __shfl_xor(ss, 8);
        const float rs = rsqrtf(ss * (1.f / 128.f) + 1e-6f);
        const int row = wid * 16 + fq * 4 + j;
#pragma unroll
        for (int n = 0; n < 8; ++n) {
            const int v = n * 16 + fr;
            Ya[(size_t)row * 512 + v] = f2bf(acc[0][n][j] * rs * nw[v] * bf2f(Pg[(size_t)row * 512 + v]));
        }
    }
}

__device__ void s5_gemm_c(CParams& p, int l, int u, char* lds) {
    LANE_IDS;
    const int wr = wid >> 1, wc = wid & 1;
    const int g = u >> 4, tm = (u >> 1) & 7, tn = u & 1, row0 = tm * 128, col0 = tn * 128;
    unsigned char* ws = p.ws;
    const unsigned aoff = (unsigned)(OFF_PU + (size_t)g * NTOK * 16 * 2), boff = (unsigned)(OFF_BTC + (size_t)g * 256 * 384 * 2);
    f32x4 acc[4][4]; ZERO_ACC(acc, 4, 4);
    mma_loop<128, 128, 2, 2>(acc, 6,
        [&](int r, int k) {
            const unsigned o = (k < 256) ? aoff + ((row0 + r) * 256 + k) * 2 : (unsigned)(OFF_HC + (((row0 + r) * 32 + g) * 128 + (k - 256)) * 2);
            return ldg<bf16x8>(ws, o);
        },
        [&](int c, int k) { return ldg<bf16x8>(ws, boff + ((col0 + c) * 384 + k) * 2); }, NoHook(), lds);
    const float dch = p.in[11][(size_t)l * 512 + g * 16 + fr];
    epi<4, 4, 64, 64>(acc, wr, wc, fq, fr, [&](int r, int cc, float v) {
        const int row = row0 + r, col = col0 + cc;
        const int jj = col >> 4, ch = col & 15;
        const int tok = (row >> 8) * SEQ + (row & 255) * 16 + jj;
        const float uu = bf2f(ldg<u16>(ws, aoff + (tok * 16 + ch) * 2));
        const float y = v + dch * uu;
        stg<u16>(ws, (unsigned)(OFF_YG + (tok * 512 + g * 16 + ch) * 2), f2bf(gelu_f(y))); });
}

__device__ void rg_scan(CParams& p, int u, char* lds) {
    const int tid = otid();
    const int b = u >> 5, c0 = (u & 31) * 16, seg = tid >> 4, ch = c0 + (tid & 15);
    const size_t base = (size_t)(b * SEQ + seg * 256) * 512 + ch;
    const u16* La = (const u16*)(p.ws + OFF_LA) + base;
    const u16* Bb = (const u16*)(p.ws + OFF_BB) + base;
    const u16* Xg = (const u16*)(p.ws + OFF_PXG) + base;
    u16* Yc = (u16*)(p.ws + OFF_YC) + base;
    float* sA = (float*)lds;
    float* sH = sA + 256;
    __syncthreads();
    float hh = 0.f, ap = 1.f;
    for (int s0 = 0; s0 < 256; s0 += 16) {
        float a[16], bb[16];
#pragma unroll
        for (int i = 0; i < 16; ++i) { a[i] = bf2f(La[(size_t)(s0 + i) * 512]); bb[i] = bf2f(Bb[(size_t)(s0 + i) * 512]); }
#pragma unroll
        for (int i = 0; i < 16; ++i) { float av = __expf(a[i]); hh = av * hh + bb[i]; ap *= av; }
    }
    sA[tid] = ap; sH[tid] = hh;
    __syncthreads();
    float cin = 0.f;
    for (int sg = 0; sg < seg; ++sg) cin = sA[sg * 16 + (tid & 15)] * cin + sH[sg * 16 + (tid & 15)];
    hh = cin;
    for (int s0 = 0; s0 < 256; s0 += 16) {
        float a[16], bb[16], xg[16];
#pragma unroll
        for (int i = 0; i < 16; ++i) { a[i] = bf2f(La[(size_t)(s0 + i) * 512]); bb[i] = bf2f(Bb[(size_t)(s0 + i) * 512]); xg[i] = bf2f(Xg[(size_t)(s0 + i) * 512]); }
#pragma unroll
        for (int i = 0; i < 16; ++i) { hh = __expf(a[i]) * hh + bb[i]; Yc[(size_t)(s0 + i) * 512] = f2bf(hh * xg[i]); }
    }
}

__device__ void phase4(CParams& p, int l, char* lds) {
    for (int u = blockIdx.x; u < 1664; u += gridDim.x) {
        if (u < 128) rg_scan(p, u, lds);
        else if (u < 1152) hgrn_out(p, l, u - 128, lds);
        else s5_gemm_c(p, l, u - 1152, lds);
    }
}

__device__ void phase_glu(CParams& p, int l, char* lds) {
    LANE_IDS;
    const int wr = wid >> 1, wc = wid & 1;
    unsigned char* ws = p.ws;
    const float* gb = p.in[14] + (size_t)l * 512;
    for (int u = blockIdx.x; u < 512; u += gridDim.x) {
        const int row0 = (u >> 2) * 128, col0 = (u & 3) * 128;
        f32x4 acc[4][4]; ZERO_ACC(acc, 4, 4);
        mma_loop<128, 128, 2, 2>(acc, 8,
            [&](int r, int k) { return ldg<bf16x8>(ws, (unsigned)(OFF_YG + ((row0 + r) * 512 + k) * 2)); },
            [&](int c, int k) { return ldg<bf16x8>(ws, (unsigned)(OFF_GLUT + ((col0 + c) * 512 + k) * 2)); }, NoHook(), lds);
        epi<4, 4, 64, 64>(acc, wr, wc, fq, fr, [&](int r, int cc, float v) {
            const int row = row0 + r, col = col0 + cc;
            const float y = bf2f(ldg<u16>(ws, (unsigned)(OFF_YG + (row * 512 + col) * 2)));
            stg<u16>(ws, (unsigned)(OFF_YB + (row * 512 + col) * 2), f2bf(y * sigm(v + gb[col]))); });
    }
}

__device__ void phase_branch(CParams& p, int l, char* lds) {
    LANE_IDS;
    const int wr = wid >> 1, wc = wid & 1;
    unsigned char* ws = p.ws;
    for (int u = blockIdx.x; u < 2048; u += gridDim.x) {
        const int row0 = (u >> 4) * 128, col0 = (u & 15) * 64;
        f32x4 tot[4][2]; ZERO_ACC(tot, 4, 2);
#pragma unroll 1
        for (int kb = 0; kb < 3; ++kb) {
            const unsigned yoff = (unsigned)(kb == 0 ? OFF_YA : (kb == 1 ? OFF_YB : OFF_YC));
            const unsigned boff = (unsigned)(OFF_WBRT + (size_t)kb * 1024 * 512 * 2);
            f32x4 acc[4][2]; ZERO_ACC(acc, 4, 2);
            mma_loop<128, 64, 2, 2>(acc, 8,
                [&](int r, int k) { return ldg<bf16x8>(ws, yoff + ((row0 + r) * 512 + k) * 2); },
                [&](int c, int k) { return ldg<bf16x8>(ws, boff + ((col0 + c) * 512 + k) * 2); }, NoHook(), lds);
#pragma unroll
            for (int m = 0; m < 4; ++m) {
#pragma unroll
                for (int j = 0; j < 4; ++j)
#pragma unroll
                    for (int n = 0; n < 2; ++n) {
                        const int row = row0 + wr * 64 + m * 16 + fq * 4 + j, col = col0 + wc * 32 + n * 16 + fr;
                        tot[m][n][j] += bf2f(ldg<u16>(ws, (unsigned)(OFF_PGATE + (row * 3072 + kb * 1024 + col) * 2))) * acc[m][n][j];
                    }
                __builtin_amdgcn_sched_barrier(0);
            }
        }
        epi<4, 2, 64, 32>(tot, wr, wc, fq, fr, [&](int r, int cc, float v) {
            stg<u16>(ws, (unsigned)(OFF_MIXP + ((row0 + r) * 1024 + col0 + cc) * 2), f2bf(v)); });
    }
}

__device__ void phase_out(CParams& p, int l, char* lds) {
    LANE_IDS;
    const int wr = wid >> 1, wc = wid & 1;
    unsigned char* ws = p.ws;
    const float* xres = (l == 0) ? p.in[0] : p.out;
    for (int u = blockIdx.x; u < 1024 + 12288; u += gridDim.x) {
        if (u < 1024) {
            const int row0 = (u >> 3) * 128, col0 = (u & 7) * 128;
            f32x4 acc[4][4]; ZERO_ACC(acc, 4, 4);
            mma_loop<128, 128, 2, 2>(acc, 16,
                [&](int r, int k) { return ldg<bf16x8>(ws, (unsigned)(OFF_MIXP + ((row0 + r) * 1024 + k) * 2)); },
                [&](int c, int k) { return ldg<bf16x8>(ws, (unsigned)(OFF_WOUTT + ((col0 + c) * 1024 + k) * 2)); }, NoHook(), lds);
            epi<4, 4, 64, 64>(acc, wr, wc, fq, fr, [&](int r, int cc, float v) {
                const unsigned o = (unsigned)(((row0 + r) * 1024 + col0 + cc) * 4);
                stg<float>(ws, (unsigned)OFF_PRELN + o, DN_ALPHA * ldg<float>(xres, o) + v); });
        } else {
            const int t = u - 1024, e = t / 192, r = t % 192;
            if (r < 128)
                conv_tile(p.in[28] + (size_t)(l * 64 + e) * 1024 * 256, p.in[29] + (size_t)(l * 64 + e) * 1024 * 256, 256, 1024, 1,
                          (u16*)(p.ws + OFF_EW13) + (size_t)e * 512 * 1024, r, (float*)lds);
            else
                conv_tile(p.in[30] + (size_t)(l * 64 + e) * 256 * 1024, nullptr, 1024, 256, 0,
                          (u16*)(p.ws + OFF_EW2) + (size_t)e * 1024 * 256, r - 128, (float*)lds);
        }
    }
}

__device__ __forceinline__ void ln_row(float (&v)[16], const float* g, const float* bta, int lane) {
    float s = 0.f;
#pragma unroll
    for (int i = 0; i < 16; ++i) s += v[i];
    const float mu = wave_sum(s) * (1.f / 1024.f);
    float q = 0.f;
#pragma unroll
    for (int i = 0; i < 16; ++i) { float d = v[i] - mu; q += d * d; }
    const float rs = rsqrtf(wave_sum(q) * (1.f / 1024.f) + 1e-5f);
#pragma unroll
    for (int i = 0; i < 4; ++i) {
        const float4 gg = *(const float4*)(g + i * 256 + lane * 4), bb = *(const float4*)(bta + i * 256 + lane * 4);
        v[i * 4 + 0] = (v[i * 4 + 0] - mu) * rs * gg.x + bb.x;
        v[i * 4 + 1] = (v[i * 4 + 1] - mu) * rs * gg.y + bb.y;
        v[i * 4 + 2] = (v[i * 4 + 2] - mu) * rs * gg.z + bb.z;
        v[i * 4 + 3] = (v[i * 4 + 3] - mu) * rs * gg.w + bb.w;
    }
}

__device__ void phase_route(CParams& p, int l, char* lds) {
    LANE_IDS;
    const float* Pre = (const float*)(p.ws + OFF_PRELN);
    u16* Xm = (u16*)(p.ws + OFF_XM);
    const u16* Rt = (const u16*)(p.ws + OFF_ROUTT);
    const float* g1 = p.in[24] + (size_t)l * 1024;
    const float* b1 = p.in[25] + (size_t)l * 1024;
    const float* rbias = p.in[27] + (size_t)l * 64;
    int* cursor = (int*)(p.ws + OFF_CUR);
    int* list = (int*)(p.ws + OFF_LIST);
    float* tkw = (float*)(p.ws + OFF_TKW);
    float* Ls = (float*)(lds + 16384);
    int* hist = (int*)(lds + 16384 + 64 * 65 * 4);
    int* basep = hist + 64;
    for (int u = blockIdx.x; u < 256; u += gridDim.x) {
        const int row0 = u * 64;
        for (int rr = 0; rr < 16; ++rr) {
            const int row = row0 + wid * 16 + rr;
            float v[16];
#pragma unroll
            for (int i = 0; i < 4; ++i) {
                const float4 x = *(const float4*)(Pre + (size_t)row * 1024 + i * 256 + lane * 4);
                v[i * 4] = x.x; v[i * 4 + 1] = x.y; v[i * 4 + 2] = x.z; v[i * 4 + 3] = x.w;
            }
            ln_row(v, g1, b1, lane);
#pragma unroll
            for (int i = 0; i < 4; ++i) {
                uint2 o; o.x = f2bf(v[i * 4]) | ((unsigned)f2bf(v[i * 4 + 1]) << 16); o.y = f2bf(v[i * 4 + 2]) | ((unsigned)f2bf(v[i * 4 + 3]) << 16);
                *(uint2*)(Xm + (size_t)row * 1024 + i * 256 + lane * 4) = o;
            }
        }
        if (tid < 64) hist[tid] = 0;
        __syncthreads();
        f32x4 acc[1][4]; ZERO_ACC(acc, 1, 4);
        mma_loop<64, 64, 4, 1>(acc, 16,
            [&](int r, int k) { return *(const bf16x8*)(Xm + (size_t)(row0 + r) * 1024 + k); },
            [&](int c, int k) { return *(const bf16x8*)(Rt + (size_t)c * 1024 + k); }, NoHook(), lds);
#pragma unroll
        for (int n = 0; n < 4; ++n)
#pragma unroll
            for (int j = 0; j < 4; ++j) {
                const int r = wid * 16 + fq * 4 + j, e = n * 16 + fr;
                Ls[r * 65 + e] = sigm(acc[0][n][j]) + rbias[e];
            }
        __syncthreads();
        int myrank[8]; int myexp[8];
        if (tid < 64) {
            float* sc = Ls + tid * 65;
            float gs[8];
#pragma unroll
            for (int g = 0; g < 8; ++g) {
                float m1 = -1e30f, m2 = -1e30f;
#pragma unroll
                for (int i = 0; i < 8; ++i) { float x = sc[g * 8 + i]; if (x > m1) { m2 = m1; m1 = x; } else if (x > m2) m2 = x; }
                gs[g] = m1 + m2;
            }
            unsigned gmask = 0;
#pragma unroll
            for (int it = 0; it < 4; ++it) {
                float best = -1e30f; int bi = 0;
#pragma unroll
                for (int g = 0; g < 8; ++g) { bool ok = !((gmask >> g) & 1u) && gs[g] > best; if (ok) { best = gs[g]; bi = g; } }
                gmask |= 1u << bi;
            }
            unsigned long long chosen = 0ull;
            float wsum = 0.f; float wv[8];
#pragma unroll
            for (int k = 0; k < 8; ++k) {
                float best = -1e30f; int bi = 0;
                for (int e = 0; e < 64; ++e) {
                    float x = sc[e];
                    bool ok = ((gmask >> (e >> 3)) & 1u) && !((chosen >> e) & 1ull) && x > best;
                    if (ok) { best = x; bi = e; }
                }
                chosen |= 1ull << bi;
                myexp[k] = bi;
                wv[k] = best - rbias[bi];
                wsum += wv[k];
            }
            const float sc_ = 2.5f / wsum;
#pragma unroll
            for (int k = 0; k < 8; ++k) {
                tkw[(size_t)(row0 + tid) * 8 + k] = wv[k] * sc_;
                myrank[k] = atomicAdd(&hist[myexp[k]], 1);
            }
        }
        __syncthreads();
        if (tid < 64) basep[tid] = atomicAdd(&cursor[tid], hist[tid]);
        __syncthreads();
        if (tid < 64) {
#pragma unroll
            for (int k = 0; k < 8; ++k) list[(size_t)myexp[k] * NTOK + basep[myexp[k]] + myrank[k]] = (row0 + tid) * 8 + k;
        }
        __syncthreads();
    }
}

struct MoeMap { int e, lb, cnt, off; };
__device__ __forceinline__ void moe_setup(CParams& p, int* sm) {
    if (otid() == 0) {
        const int* cursor = (const int*)(p.ws + OFF_CUR);
        int nb = 0, nr = 0;
        for (int e = 0; e < 64; ++e) { sm[e] = nb; sm[65 + e] = nr; int c = cursor[e]; nb += (c + 127) >> 7; nr += c; }
        sm[64] = nb; sm[129] = nr;
    }
    __syncthreads();
}
__device__ __forceinline__ MoeMap moe_map(CParams& p, const int* sm, int blk) {
    MoeMap m;
    const int nbr = sm[64];
    if (blk >= nbr) { m.e = 64; m.lb = blk - nbr; m.cnt = NTOK; m.off = 0; return m; }
    int e = 0;
    for (int i = 0; i < 64; ++i) if (sm[i] <= blk && sm[i + 1] > blk) e = i;
    m.e = e; m.lb = blk - sm[e]; m.cnt = ((const int*)(p.ws + OFF_CUR))[e]; m.off = sm[65 + e];
    return m;
}

__device__ void phase_moe1(CParams& p, int l, char* lds) {
    LANE_IDS;
    const int wr = wid >> 1, wc = wid & 1;
    int* sm = (int*)(lds + 40960);
    __syncthreads();
    moe_setup(p, sm);
    const int nblk = sm[64] + 128;
    unsigned char* ws = p.ws;
    const int* list = (const int*)(p.ws + OFF_LIST);
    int* rowtok = (int*)(lds + 32768);
    for (int u = blockIdx.x; u < nblk * 4; u += gridDim.x) {
        const int blk = u >> 2, nt = u & 3;
        const MoeMap mm = moe_map(p, sm, blk);
        const int valid = min(128, mm.cnt - mm.lb * 128);
        __syncthreads();
        if (tid < 128) {
            int tok;
            if (mm.e == 64) tok = mm.lb * 128 + tid;
            else tok = (tid < valid) ? (list[(size_t)mm.e * NTOK + mm.lb * 128 + tid] >> 3) : 0;
            rowtok[tid] = tok;
        }
        __syncthreads();
        const unsigned boff = (unsigned)(((mm.e == 64) ? OFF_SH13T : OFF_EW13 + (size_t)mm.e * 512 * 1024 * 2) + (size_t)nt * 128 * 1024 * 2);
        f32x4 acc[4][4]; ZERO_ACC(acc, 4, 4);
        mma_loop<128, 128, 2, 2>(acc, 16,
            [&](int r, int k) { return ldg<bf16x8>(ws, (unsigned)(OFF_XM + (rowtok[r] * 1024 + k) * 2)); },
            [&](int c, int k) { return ldg<bf16x8>(ws, boff + (c * 1024 + k) * 2); }, NoHook(), lds);
        const unsigned hoff = (unsigned)((mm.e == 64) ? OFF_HSH + (size_t)mm.lb * 128 * 256 * 2 : OFF_HBUF + (size_t)(mm.off + mm.lb * 128) * 256 * 2);
#pragma unroll
        for (int m = 0; m < 4; ++m) {
#pragma unroll
            for (int n = 0; n < 2; ++n)
#pragma unroll
                for (int j = 0; j < 4; ++j) {
                    const int r = wr * 64 + m * 16 + fq * 4 + j;
                    const int hid = (nt * 2 + wc) * 32 + n * 16 + fr;
                    if (r < valid) stg<u16>(ws, hoff + (r * 256 + hid) * 2, f2bf(silu_f(acc[m][n][j]) * acc[m][n + 2][j]));
                }
            __builtin_amdgcn_sched_barrier(0);
        }
    }
}

__device__ void phase_moe2(CParams& p, int l, char* lds) {
    LANE_IDS;
    const int wr = wid >> 1, wc = wid & 1;
    int* sm = (int*)(lds + 40960);
    __syncthreads();
    moe_setup(p, sm);
    const int nblk = sm[64] + 128;
    const int* list = (const int*)(p.ws + OFF_LIST);
    const float* tkw = (const float*)(p.ws + OFF_TKW);
    int* rowent = (int*)(lds + 32768);
    float* roww = (float*)(lds + 32768 + 512);
    for (int u = blockIdx.x; u < nblk * 8; u += gridDim.x) {
        const int blk = u >> 3, nt = u & 7;
        const MoeMap mm = moe_map(p, sm, blk);
        const int valid = min(128, mm.cnt - mm.lb * 128);
        __syncthreads();
        if (tid < 128 && mm.e < 64) {
            int ent = (tid < valid) ? list[(size_t)mm.e * NTOK + mm.lb * 128 + tid] : 0;
            rowent[tid] = ent; roww[tid] = tkw[ent];
        }
        __syncthreads();
        unsigned char* ws = p.ws;
        const unsigned aoff = (unsigned)((mm.e == 64) ? OFF_HSH + (size_t)mm.lb * 128 * 256 * 2 : OFF_HBUF + (size_t)(mm.off + mm.lb * 128) * 256 * 2);
        const unsigned boff = (unsigned)(((mm.e == 64) ? OFF_SH2T : OFF_EW2 + (size_t)mm.e * 1024 * 256 * 2) + (size_t)nt * 128 * 256 * 2);
        f32x4 acc[4][4]; ZERO_ACC(acc, 4, 4);
        mma_loop<128, 128, 2, 2>(acc, 4,
            [&](int r, int k) { return (r < valid) ? ldg<bf16x8>(ws, aoff + (r * 256 + k) * 2) : bf16x8{0, 0, 0, 0, 0, 0, 0, 0}; },
            [&](int c, int k) { return ldg<bf16x8>(ws, boff + (c * 256 + k) * 2); }, NoHook(), lds);
        if (mm.e == 64) {
            float* Ysh = p.out;
            epi<4, 4, 64, 64>(acc, wr, wc, fq, fr, [&](int r, int cc, float v) {
                stg<float>(Ysh, (unsigned)(((mm.lb * 128 + r) * 1024 + nt * 128 + cc) * 4), v); });
        } else {
            epi<4, 4, 64, 64>(acc, wr, wc, fq, fr, [&](int r, int cc, float v) {
                if (r < valid) stg<u16>(ws, (unsigned)OFF_YBUF + (unsigned)(rowent[r] * 1024 + nt * 128 + cc) * 2u, f2bf(v * roww[r])); });
        }
    }
}

__device__ void phase_combine(CParams& p, int l) {
    LANE_IDS;
    const u16* Xm = (const u16*)(p.ws + OFF_XM);
    const u16* Yb = (const u16*)(p.ws + OFF_YBUF);
    const float* g2 = p.in[34] + (size_t)l * 1024;
    const float* b2 = p.in[35] + (size_t)l * 1024;
    u16* Xb = (u16*)(p.ws + OFF_XB);
    for (int row = blockIdx.x * 4 + wid; row < NTOK; row += gridDim.x * 4) {
        float v[16];
#pragma unroll
        for (int i = 0; i < 4; ++i) {
            const float4 y = *(const float4*)(p.out + (size_t)row * 1024 + i * 256 + lane * 4);
            const uint2 x = *(const uint2*)(Xm + (size_t)row * 1024 + i * 256 + lane * 4);
            v[i * 4 + 0] = y.x + DN_ALPHA * bf2f((u16)(x.x & 0xffff));
            v[i * 4 + 1] = y.y + DN_ALPHA * bf2f((u16)(x.x >> 16));
            v[i * 4 + 2] = y.z + DN_ALPHA * bf2f((u16)(x.y & 0xffff));
            v[i * 4 + 3] = y.w + DN_ALPHA * bf2f((u16)(x.y >> 16));
        }
#pragma unroll
        for (int k = 0; k < 8; ++k)
#pragma unroll
            for (int i = 0; i < 4; ++i) {
                const uint2 x = *(const uint2*)(Yb + ((size_t)row * 8 + k) * 1024 + i * 256 + lane * 4);
                v[i * 4 + 0] += bf2f((u16)(x.x & 0xffff));
                v[i * 4 + 1] += bf2f((u16)(x.x >> 16));
                v[i * 4 + 2] += bf2f((u16)(x.y & 0xffff));
                v[i * 4 + 3] += bf2f((u16)(x.y >> 16));
            }
        ln_row(v, g2, b2, lane);
#pragma unroll
        for (int i = 0; i < 4; ++i) {
            *(float4*)(p.out + (size_t)row * 1024 + i * 256 + lane * 4) = float4{v[i * 4], v[i * 4 + 1], v[i * 4 + 2], v[i * 4 + 3]};
            uint2 o; o.x = f2bf(v[i * 4]) | ((unsigned)f2bf(v[i * 4 + 1]) << 16); o.y = f2bf(v[i * 4 + 2]) | ((unsigned)f2bf(v[i * 4 + 3]) << 16);
            *(uint2*)(Xb + (size_t)row * 1024 + i * 256 + lane * 4) = o;
        }
    }
}

__global__ void __launch_bounds__(256, 2) fwd_kernel(Params p_unused) {
    __shared__ __attribute__((aligned(16))) char lds[49152];
    cg::grid_group grid = cg::this_grid();
    CParams* pp = (CParams*)__builtin_amdgcn_kernarg_segment_ptr();
    const int ph_lo = pp->ph_lo, ph_hi = pp->ph_hi;
#pragma unroll 1
    for (int ph = ph_lo; ph < ph_hi; ++ph) {
        asm volatile("" : "+s"(pp));
        CParams& p = *pp;
        const int l = ph / NPH, q = ph % NPH;
        switch (q) {
            case 0: phase_w(p, l, lds); break;
            case 1: phase_proj(p, l, lds); break;
            case 2: phase2(p, l, lds); break;
            case 3: phase3(p, l, lds); break;
            case 4: phase4(p, l, lds); break;
            case 5: phase_glu(p, l, lds); break;
            case 6: phase_branch(p, l, lds); break;
            case 7: phase_out(p, l, lds); break;
            case 8: phase_route(p, l, lds); break;
            case 9: phase_moe1(p, l, lds); break;
            case 10: phase_moe2(p, l, lds); break;
            default: phase_combine(p, l); break;
        }
        if (ph + 1 < ph_hi) {
            if (p.coop) grid.sync();
        }
    }
}

extern "C" void kernel_launch(void* const* d_in, const int* in_sizes, int n_in, void* d_out, int out_size, void* d_ws, size_t ws_size,
                              hipStream_t stream) {
    static int grid_blocks = 0;
    if (!grid_blocks) {
        int dev = 0, cus = 0, per_cu = 0;
        hipGetDevice(&dev);
        hipDeviceGetAttribute(&cus, hipDeviceAttributeMultiprocessorCount, dev);
        hipOccupancyMaxActiveBlocksPerMultiprocessor(&per_cu, fwd_kernel, 256, 0);
        if (per_cu < 1) per_cu = 1;
        if (per_cu > 2) per_cu = 2;
        grid_blocks = cus * per_cu;
        if (ws_size < WS_NEED) fprintf(stderr, "kernel_launch: workspace too small: %zu < %zu\n", ws_size, (size_t)WS_NEED);
    }
    Params p{};
    for (int i = 0; i < 36; ++i) p.in[i] = (const float*)d_in[i];
    p.out = (float*)d_out;
    p.ws = (unsigned char*)d_ws;
    p.ph_lo = 0; p.ph_hi = 2 * NPH; p.coop = 1; p.pad = 0;
    void* args[] = {&p};
    hipError_t e = hipLaunchCooperativeKernel((void*)fwd_kernel, dim3(grid_blocks), dim3(256), args, 0, stream);
    if (e != hipSuccess) fprintf(stderr, "cooperative launch failed: %s (grid %d)\n", hipGetErrorString(e), grid_blocks);
}
```

```cpp
#include <hip/hip_runtime.h>
#include <hip/hip_cooperative_groups.h>
#include <cstdio>
#include <cstdint>
namespace cg = cooperative_groups;

typedef unsigned short u16;
typedef __attribute__((ext_vector_type(8))) short bf16x8;
typedef __attribute__((ext_vector_type(4))) float f32x4;

constexpr int NTOK = 16384, DM = 1024, SEQ = 4096, BW = 512, INC = 6656;
constexpr int NE = 64, EH = 256;
constexpr int NPH = 12;
constexpr float DN_ALPHA = 1.4142135623730951f;
constexpr size_t SLOT = 16777216ull;

constexpr size_t OFF_WINT  = 0;
constexpr size_t OFF_WBRT  = 13631488;
constexpr size_t OFF_WOUTT = 16777216;
constexpr size_t OFF_GLUT  = 18874368;
constexpr size_t OFF_RGT   = 19398656;
constexpr size_t OFF_SH13T = 19660800;
constexpr size_t OFF_SH2T  = 20709376;
constexpr size_t OFF_BTA   = 21233664;
constexpr size_t OFF_BTC   = 23330816;
constexpr size_t OFF_ROUTT = 29622272;
constexpr size_t OFF_MISC  = 29753344;
constexpr size_t OFF_LB    = OFF_MISC;
constexpr size_t OFF_CUR   = OFF_MISC + 2048;
constexpr size_t OFF_DEC   = OFF_MISC + 4096;
constexpr size_t OFF_TKW   = OFF_DEC + 524288;
constexpr size_t OFF_XB    = 2 * SLOT;
constexpr size_t OFF_VC    = 2 * SLOT;
constexpr size_t OFF_XC    = 3 * SLOT;
constexpr size_t OFF_MIXP  = 2 * SLOT;
constexpr size_t OFF_LIST  = 2 * SLOT;
constexpr size_t OFF_HSH   = 2 * SLOT + 4194304;
constexpr size_t OFF_PQ    = 4 * SLOT;
constexpr size_t OFF_PLF   = 5 * SLOT;
constexpr size_t OFF_PK    = 7 * SLOT;
constexpr size_t OFF_PV    = 8 * SLOT;
constexpr size_t OFF_YC    = 8 * SLOT;
constexpr size_t OFF_PG    = 9 * SLOT;
constexpr size_t OFF_PU    = 10 * SLOT;
constexpr size_t OFF_PXG   = 11 * SLOT;
constexpr size_t OFF_PXR   = 12 * SLOT;
constexpr size_t OFF_YB    = 12 * SLOT;
constexpr size_t OFF_PGATE = 13 * SLOT;
constexpr size_t OFF_KTT   = 19 * SLOT;
constexpr size_t OFF_YA    = 19 * SLOT;
constexpr size_t OFF_VT    = 20 * SLOT;
constexpr size_t OFF_ST    = 21 * SLOT;
constexpr size_t OFF_LA    = 23 * SLOT;
constexpr size_t OFF_BB    = 24 * SLOT;
constexpr size_t OFF_YG    = 25 * SLOT;
constexpr size_t OFF_HC    = 26 * SLOT;
constexpr size_t OFF_PRELN = 4 * SLOT;
constexpr size_t OFF_XM    = 8 * SLOT;
constexpr size_t OFF_EW13  = 10 * SLOT;
constexpr size_t OFF_EW2   = 14 * SLOT;
constexpr size_t OFF_HBUF  = 4 * SLOT;
constexpr size_t OFF_YBUF  = 16 * SLOT;
constexpr size_t OFF_BAR   = 32 * SLOT;
constexpr size_t WS_NEED   = 32 * SLOT + 16384;

struct Params {
    const float* in[36];
    float* out;
    unsigned char* ws;
    int ph_lo, ph_hi;
    int coop, pad;
};
typedef const __attribute__((address_space(4))) Params CParams;

__device__ __forceinline__ u16 f2bf(float f) {
    unsigned u = __builtin_bit_cast(unsigned, f);
    return (u16)((u + 0x7fffu + ((u >> 16) & 1u)) >> 16);
}
__device__ __forceinline__ float bf2f(u16 h) { return __builtin_bit_cast(float, (unsigned)h << 16); }
__device__ __forceinline__ float sigm(float x) { return 1.f / (1.f + __expf(-x)); }
__device__ __forceinline__ float silu_f(float x) { return x * sigm(x); }
__device__ __forceinline__ float gelu_f(float x) {
    float u = 0.7978845608028654f * (x + 0.044715f * x * x * x);
    float t = 1.f - 2.f / (1.f + __expf(2.f * u));
    return 0.5f * x * (1.f + t);
}
__device__ __forceinline__ float wave_sum(float v) {
#pragma unroll
    for (int o = 32; o >= 1; o >>= 1) v += __shfl_xor(v, o);
    return v;
}
__device__ __forceinline__ int swz(int row, int ch) { return row * 128 + ((ch ^ ((row >> 1) & 7)) << 4); }


template <class T> __device__ __forceinline__ T ldg(const void* base, unsigned off) { return *(const T*)((const char*)base + off); }
template <class T> __device__ __forceinline__ void stg(void* base, unsigned off, T v) { *(T*)((char*)base + off) = v; }

template <int TM, int TN, int RW, int CW, class F>
__device__ __forceinline__ void epi(f32x4 (&acc)[TM][TN], int wr, int wc, int fq, int fr, F f) {
#pragma unroll
    for (int m = 0; m < TM; ++m) {
#pragma unroll
        for (int j = 0; j < 4; ++j) {
#pragma unroll
            for (int n = 0; n < TN; ++n) f(wr * RW + m * 16 + fq * 4 + j, wc * CW + n * 16 + fr, acc[m][n][j]);
        }
        __builtin_amdgcn_sched_barrier(0);
    }
}

__device__ __forceinline__ int otid() { int t = threadIdx.x; asm volatile("" : "+v"(t)); return t; }

struct NoHook { __device__ __forceinline__ void operator()(int) const {} };

template <int BM, int BN, int WM, int WN, class AL, class BL, class HK>
__device__ __forceinline__ void mma_loop(f32x4 (&acc)[BM / WM / 16][BN / WN / 16], int nk, AL aload, BL bload, HK hook, char* lds) {
    constexpr int TM = BM / WM / 16, TN = BN / WN / 16;
    constexpr int ACH = BM / 32, BCH = BN / 32;
    const int tid = otid(), lane = tid & 63, wid = tid >> 6;
    const int wr = wid / WN, wc = wid % WN, fr = lane & 15, fq = lane >> 4;
    const int srow = tid >> 3, sk = (tid & 7) * 8;
    const int swr = srow * 128 + (((tid & 7) ^ ((tid >> 4) & 7)) << 4);
    const int xr = (fr >> 1) & 7;
    const int a_rd = (wr * (BM / WM) + fr) * 128;
    const int b_rd = BM * 128 + (wc * (BN / WN) + fr) * 128;
    bf16x8 ra[ACH], rb[BCH];
#pragma unroll
    for (int i = 0; i < ACH; ++i) ra[i] = aload(srow + i * 32, sk);
#pragma unroll
    for (int i = 0; i < BCH; ++i) rb[i] = bload(srow + i * 32, sk);
#pragma unroll 1
    for (int t = 0; t < nk; ++t) {
        __syncthreads();
#pragma unroll
        for (int i = 0; i < ACH; ++i) *(bf16x8*)(lds + swr + i * 4096) = ra[i];
#pragma unroll
        for (int i = 0; i < BCH; ++i) *(bf16x8*)(lds + BM * 128 + swr + i * 4096) = rb[i];
        __syncthreads();
        if (t + 1 < nk) {
#pragma unroll
            for (int i = 0; i < ACH; ++i) ra[i] = aload(srow + i * 32, (t + 1) * 64 + sk);
#pragma unroll
            for (int i = 0; i < BCH; ++i) rb[i] = bload(srow + i * 32, (t + 1) * 64 + sk);
        }
        hook(t);
#pragma unroll
        for (int ks = 0; ks < 2; ++ks) {
            const int co = ((ks * 4 + fq) ^ xr) << 4;
            bf16x8 af[TM], bfr[TN];
#pragma unroll
            for (int m = 0; m < TM; ++m) af[m] = *(const bf16x8*)(lds + a_rd + m * 2048 + co);
#pragma unroll
            for (int n = 0; n < TN; ++n) bfr[n] = *(const bf16x8*)(lds + b_rd + n * 2048 + co);
#pragma unroll
            for (int m = 0; m < TM; ++m)
#pragma unroll
                for (int n = 0; n < TN; ++n) acc[m][n] = __builtin_amdgcn_mfma_f32_16x16x32_bf16(af[m], bfr[n], acc[m][n], 0, 0, 0);
        }
    }
}

#define ZERO_ACC(acc, TM, TN) _Pragma("unroll") for (int m_ = 0; m_ < TM; ++m_) _Pragma("unroll") for (int n_ = 0; n_ < TN; ++n_) acc[m_][n_] = f32x4{0.f, 0.f, 0.f, 0.f}

#define LANE_IDS const int tid = otid(), lane = tid & 63, wid = tid >> 6, fr = lane & 15, fq = lane >> 4; (void)tid; (void)lane; (void)wid; (void)fr; (void)fq

__device__ void conv_tile(const float* s1, const float* s2, int ldsrc, int K, int perm, u16* dst, int tile, float* lds) {
    const int tid = otid();
    const int ktiles = K >> 6;
    const int kt = tile % ktiles, nt = tile / ktiles;
    __syncthreads();
#pragma unroll 4
    for (int i = 0; i < 16; ++i) {
        int idx = tid + i * 256, kr = idx >> 6, nc = idx & 63;
        const float* s; int col;
        if (perm) { s = (nc < 32) ? s1 : s2; col = nt * 32 + (nc & 31); } else { s = s1; col = nt * 64 + nc; }
        lds[kr * 65 + nc] = s[(size_t)(kt * 64 + kr) * ldsrc + col];
    }
    __syncthreads();
#pragma unroll 4
    for (int i = 0; i < 16; ++i) {
        int idx = tid + i * 256, nr = idx >> 6, kc = idx & 63;
        dst[(size_t)(nt * 64 + nr) * K + kt * 64 + kc] = f2bf(lds[kc * 65 + nr]);
    }
}

__device__ void s5_precompute(CParams& p, int l, int g, float* lds) {
    const int tid = otid();
    float* Er = lds;
    float* Ei = Er + 64 * 17;
    float* Br = Ei + 64 * 17;
    float* Bi = Br + 1024;
    float* Cr = Bi + 1024;
    float* Ci = Cr + 1024;
    float* Kt = Ci + 1024;
    __syncthreads();
    const int lg = l * 32 + g;
    const float dt = expf(p.in[12][lg]);
    {
        const int pp = tid & 63, part = tid >> 6;
        const float ar = p.in[5][lg * 64 + pp], ai = p.in[6][lg * 64 + pp];
        for (int tau = part; tau <= 16; tau += 4) {
            float mag = expf((float)tau * ar * dt);
            float ang = (float)tau * ai * dt;
            Er[pp * 17 + tau] = mag * cosf(ang);
            Ei[pp * 17 + tau] = mag * sinf(ang);
        }
        float mag = expf(ar * dt), ang = ai * dt;
        float e1r = mag * cosf(ang) - 1.f, e1i = mag * sinf(ang);
        float den = ar * ar + ai * ai;
        float qr = (e1r * ar + e1i * ai) / den, qi = (e1i * ar - e1r * ai) / den;
        for (int c = part * 4; c < part * 4 + 4; ++c) {
            float br = p.in[7][((size_t)lg * 64 + pp) * 16 + c], bi = p.in[8][((size_t)lg * 64 + pp) * 16 + c];
            Br[pp * 16 + c] = qr * br - qi * bi;
            Bi[pp * 16 + c] = qr * bi + qi * br;
            Cr[c * 64 + pp] = p.in[9][((size_t)lg * 16 + c) * 64 + pp];
            Ci[c * 64 + pp] = p.in[10][((size_t)lg * 16 + c) * 64 + pp];
        }
    }
    __syncthreads();
    for (int i = 0; i < 16; ++i) {
        int idx = tid + i * 256, tau = idx >> 8, ch = (idx >> 4) & 15, c2 = idx & 15;
        float s = 0.f;
        for (int pp = 0; pp < 64; ++pp) {
            float cr = Cr[ch * 64 + pp], ci = Ci[ch * 64 + pp], er = Er[pp * 17 + tau], ei = Ei[pp * 17 + tau];
            float gr = cr * er - ci * ei, gi = cr * ei + ci * er;
            s += gr * Br[pp * 16 + c2] - gi * Bi[pp * 16 + c2];
        }
        Kt[idx] = s;
    }
    __syncthreads();
    u16* bta = (u16*)(p.ws + OFF_BTA) + (size_t)g * 128 * 256;
    for (int i = 0; i < 128; ++i) {
        int idx = tid + i * 256, pr = idx >> 8, k = idx & 255, s = k >> 4, ch = k & 15, pp = pr & 63;
        float er = Er[pp * 17 + 15 - s], ei = Ei[pp * 17 + 15 - s], br = Br[pp * 16 + ch], bi = Bi[pp * 16 + ch];
        float v = (pr < 64) ? (er * br - ei * bi) : (er * bi + ei * br);
        bta[idx] = f2bf(v);
    }
    u16* btc = (u16*)(p.ws + OFF_BTC) + (size_t)g * 256 * 384;
    for (int i = 0; i < 384; ++i) {
        int idx = tid + i * 256, n = idx / 384, k = idx - n * 384, j = n >> 4, ch = n & 15;
        float v;
        if (k < 256) {
            int s = k >> 4, c2 = k & 15;
            v = (s <= j) ? Kt[((j - s) * 16 + ch) * 16 + c2] : 0.f;
        } else {
            int pr = k - 256, pp = pr & 63;
            float cr = Cr[ch * 64 + pp], ci = Ci[ch * 64 + pp], er = Er[pp * 17 + j + 1], ei = Ei[pp * 17 + j + 1];
            float gr = cr * er - ci * ei, gi = cr * ei + ci * er;
            v = (pr < 64) ? gr : -gi;
        }
        btc[idx] = f2bf(v);
    }
}

constexpr int W_CONV_TILES = 2608;
__device__ void phase_w(CParams& p, int l, char* lds) {
    const int tid = otid();
    const int nunits = W_CONV_TILES + 32 + 1 + (l == 0 ? 1024 : 0);
    for (int u = blockIdx.x; u < nunits; u += gridDim.x) {
        if (u < W_CONV_TILES) {
            int t = u;
            const float *s1, *s2 = nullptr; int ld, K, perm = 0; u16* dst;
            if (t < 1664) { s1 = p.in[1] + (size_t)l * DM * INC; ld = INC; K = 1024; dst = (u16*)(p.ws + OFF_WINT); }
            else if ((t -= 1664) < 384) { int k = t >> 7; t &= 127; s1 = p.in[22] + (size_t)(l * 3 + k) * 512 * 1024; ld = 1024; K = 512; dst = (u16*)(p.ws + OFF_WBRT) + (size_t)k * 1024 * 512; }
            else if ((t -= 384) < 256) { s1 = p.in[23] + (size_t)l * 1024 * 1024; ld = 1024; K = 1024; dst = (u16*)(p.ws + OFF_WOUTT); }
            else if ((t -= 256) < 64) { s1 = p.in[13] + (size_t)l * 512 * 512; ld = 512; K = 512; dst = (u16*)(p.ws + OFF_GLUT); }
            else if ((t -= 64) < 32) { int h = t >> 3; t &= 7; s1 = p.in[17] + (size_t)(l * 4 + h) * 128 * 128; s2 = p.in[19] + (size_t)(l * 4 + h) * 128 * 128; ld = 128; K = 128; perm = 1; dst = (u16*)(p.ws + OFF_RGT) + (size_t)h * 256 * 128; }
            else if ((t -= 32) < 128) { s1 = p.in[31] + (size_t)l * 1024 * 256; s2 = p.in[32] + (size_t)l * 1024 * 256; ld = 256; K = 1024; perm = 1; dst = (u16*)(p.ws + OFF_SH13T); }
            else if ((t -= 128) < 64) { s1 = p.in[33] + (size_t)l * 256 * 1024; ld = 1024; K = 256; dst = (u16*)(p.ws + OFF_SH2T); }
            else { t -= 64; s1 = p.in[26] + (size_t)l * 1024 * 64; ld = 64; K = 1024; dst = (u16*)(p.ws + OFF_ROUTT); }
            conv_tile(s1, s2, ld, K, perm, dst, t, (float*)lds);
        } else if (u < W_CONV_TILES + 32) {
            s5_precompute(p, l, u - W_CONV_TILES, (float*)lds);
        } else if (u == W_CONV_TILES + 32) {
            float* LB = (float*)(p.ws + OFF_LB);
            for (int c = tid; c < 512; c += 256) {
                float x0 = p.in[3][c], x1 = p.in[3][512 + c];
                LB[c] = (l == 0) ? 0.f : 1.f / (1.f + expf(x0 - x1));
            }
            if (tid < 64) ((int*)(p.ws + OFF_CUR))[tid] = 0;
        } else {
            int r0 = (u - (W_CONV_TILES + 33)) * 16;
            const float4* src = (const float4*)(p.in[0] + (size_t)r0 * DM);
            uint2* dst = (uint2*)((u16*)(p.ws + OFF_XB) + (size_t)r0 * DM);
            for (int i = tid; i < 16 * 256; i += 256) {
                float4 v = src[i];
                uint2 o; o.x = f2bf(v.x) | ((unsigned)f2bf(v.y) << 16); o.y = f2bf(v.z) | ((unsigned)f2bf(v.w) << 16);
                dst[i] = o;
            }
        }
    }
}

__device__ void phase_proj(CParams& p, int l, char* lds) {
    LANE_IDS;
    const int wr = wid >> 1, wc = wid & 1;
    unsigned char* ws = p.ws;
    const float* bg = p.in[2] + (size_t)l * 3072;
    const int ntn = INC / 128;
    for (int u = blockIdx.x; u < 128 * ntn; u += gridDim.x) {
        const int tm = u / ntn, tn = u % ntn, row0 = tm * 128, col0 = tn * 128;
        f32x4 acc[4][4]; ZERO_ACC(acc, 4, 4);
        mma_loop<128, 128, 2, 2>(acc, 16,
            [&](int r, int k) { return ldg<bf16x8>(ws, (unsigned)(OFF_XB + ((row0 + r) * DM + k) * 2)); },
            [&](int c, int k) { return ldg<bf16x8>(ws, (unsigned)(OFF_WINT + ((col0 + c) * DM + k) * 2)); }, NoHook(), lds);
        const int seg = col0 >> 9;
        if (seg == 0) epi<4, 4, 64, 64>(acc, wr, wc, fq, fr, [&](int r, int cc, float v) {
            stg<u16>(ws, (unsigned)(OFF_PQ + ((row0 + r) * 512 + ((col0 + cc) & 511)) * 2), f2bf(silu_f(v))); });
        else if (seg == 1) epi<4, 4, 64, 64>(acc, wr, wc, fq, fr, [&](int r, int cc, float v) {
            const int c = (col0 + cc) & 511;
            const float lb = ldg<float>(ws, (unsigned)(OFF_LB + c * 4)), sg = sigm(v);
            const float f = lb + (1.f - lb) * sg;
            stg<float>(ws, (unsigned)(OFF_PLF + ((row0 + r) * 512 + c) * 4), logf(f));
            stg<u16>(ws, (unsigned)(OFF_PK + ((row0 + r) * 512 + c) * 2), f2bf((1.f - lb) * (1.f - sg))); });
        else if (seg == 2) epi<4, 4, 64, 64>(acc, wr, wc, fq, fr, [&](int r, int cc, float v) {
            stg<u16>(ws, (unsigned)(OFF_PV + ((row0 + r) * 512 + ((col0 + cc) & 511)) * 2), f2bf(v)); });
        else if (seg == 3) epi<4, 4, 64, 64>(acc, wr, wc, fq, fr, [&](int r, int cc, float v) {
            stg<u16>(ws, (unsigned)(OFF_PG + ((row0 + r) * 512 + ((col0 + cc) & 511)) * 2), f2bf(silu_f(v))); });
        else if (seg == 4) epi<4, 4, 64, 64>(acc, wr, wc, fq, fr, [&](int r, int cc, float v) {
            const int c = (col0 + cc) & 511;
            stg<u16>(ws, (unsigned)(OFF_PU + (((c >> 4) * NTOK + row0 + r) * 16 + (c & 15)) * 2), f2bf(v)); });
        else if (seg == 5) epi<4, 4, 64, 64>(acc, wr, wc, fq, fr, [&](int r, int cc, float v) {
            stg<u16>(ws, (unsigned)(OFF_PXG + ((row0 + r) * 512 + ((col0 + cc) & 511)) * 2), f2bf(gelu_f(v))); });
        else if (seg == 6) epi<4, 4, 64, 64>(acc, wr, wc, fq, fr, [&](int r, int cc, float v) {
            stg<u16>(ws, (unsigned)(OFF_PXR + ((row0 + r) * 512 + ((col0 + cc) & 511)) * 2), f2bf(v)); });
        else epi<4, 4, 64, 64>(acc, wr, wc, fq, fr, [&](int r, int cc, float v) {
            const int gc = col0 + cc - 3584;
            stg<u16>(ws, (unsigned)(OFF_PGATE + ((row0 + r) * 3072 + gc) * 2), f2bf(sigm(v + bg[gc]))); });
    }
}

__device__ void hgrn_prep(CParams& p, int u) {
    const int tid = otid();
    const int h = u & 3, c = (u >> 2) & 63, b = u >> 8;
    const int r0 = b * SEQ + c * 64;
    const size_t cu = (size_t)((b * 4 + h) * 64 + c);
    if (tid < 128) {
        const int d = tid;
        float* lf = (float*)(p.ws + OFF_PLF) + (size_t)r0 * 512 + h * 128 + d;
        const u16* kk = (const u16*)(p.ws + OFF_PK) + (size_t)r0 * 512 + h * 128 + d;
        float bs[64];
#pragma unroll
        for (int s = 0; s < 64; ++s) bs[s] = lf[(size_t)s * 512];
        float run = 0.f;
#pragma unroll
        for (int s = 0; s < 64; ++s) { run += bs[s]; bs[s] = run; lf[(size_t)s * 512] = run; }
        const float btot = run;
        ((float*)(p.ws + OFF_DEC))[(size_t)(b * 64 + c) * 512 + h * 128 + d] = __expf(btot);
        u16* dst = (u16*)(p.ws + OFF_KTT) + (cu * 128 + d) * 64;
#pragma unroll
        for (int s8 = 0; s8 < 8; ++s8) {
            bf16x8 o;
#pragma unroll
            for (int e = 0; e < 8; ++e) {
                int s = s8 * 8 + e;
                o[e] = (short)f2bf(bf2f(kk[(size_t)s * 512]) * __expf(btot - bs[s]));
            }
            *(bf16x8*)(dst + s8 * 8) = o;
        }
    } else {
        const int v = tid - 128;
        const u16* vv = (const u16*)(p.ws + OFF_PV) + (size_t)r0 * 512 + h * 128 + v;
        u16* dst = (u16*)(p.ws + OFF_VT) + (cu * 128 + v) * 64;
#pragma unroll
        for (int s8 = 0; s8 < 8; ++s8) {
            bf16x8 o;
#pragma unroll
            for (int e = 0; e < 8; ++e) o[e] = (short)vv[(size_t)(s8 * 8 + e) * 512];
            *(bf16x8*)(dst + s8 * 8) = o;
        }
    }
}

__device__ void s5_gemm_a(CParams& p, int u, char* lds) {
    LANE_IDS;
    const int wr = wid >> 1, wc = wid & 1;
    const int g = u >> 3, tm = u & 7, row0 = tm * 128;
    unsigned char* ws = p.ws;
    const unsigned aoff = (unsigned)(OFF_PU + (size_t)g * NTOK * 16 * 2), boff = (unsigned)(OFF_BTA + (size_t)g * 128 * 256 * 2);
    f32x4 acc[4][4]; ZERO_ACC(acc, 4, 4);
    mma_loop<128, 128, 2, 2>(acc, 4,
        [&](int r, int k) { return ldg<bf16x8>(ws, aoff + ((row0 + r) * 256 + k) * 2); },
        [&](int c, int k) { return ldg<bf16x8>(ws, boff + (c * 256 + k) * 2); }, NoHook(), lds);
    epi<4, 4, 64, 64>(acc, wr, wc, fq, fr, [&](int r, int cc, float v) {
        stg<float>(ws, (unsigned)(OFF_VC + (((row0 + r) * 32 + g) * 128 + cc) * 4), v); });
}

__device__ void rg_conv(CParams& p, int l, int u) {
    const int tid = otid();
    const u16* xr = (const u16*)(p.ws + OFF_PXR);
    u16* xc = (u16*)(p.ws + OFF_XC);
    const float* cw = p.in[15] + (size_t)l * 4 * 512;
    const float* cb = p.in[16] + (size_t)l * 512;
    for (int i = tid; i < 64 * 64; i += 256) {
        const int row = u * 64 + (i >> 6), c8 = (i & 63) * 8;
        const int t = row & (SEQ - 1);
        float a[8];
#pragma unroll
        for (int e = 0; e < 8; ++e) a[e] = cb[c8 + e];
#pragma unroll
        for (int j = 0; j < 4; ++j) {
            if (t - 3 + j >= 0) {
                bf16x8 x = *(const bf16x8*)(xr + (size_t)(row - 3 + j) * 512 + c8);
#pragma unroll
                for (int e = 0; e < 8; ++e) a[e] += cw[j * 512 + c8 + e] * bf2f((u16)x[e]);
            }
        }
        bf16x8 o;
#pragma unroll
        for (int e = 0; e < 8; ++e) o[e] = (short)f2bf(a[e]);
        *(bf16x8*)(xc + (size_t)row * 512 + c8) = o;
    }
}

__device__ void phase2(CParams& p, int l, char* lds) {
    for (int u = blockIdx.x; u < 1536; u += gridDim.x) {
        if (u < 1024) hgrn_prep(p, u);
        else if (u < 1280) s5_gemm_a(p, u - 1024, lds);
        else rg_conv(p, l, u - 1280);
    }
}

__device__ void hgrn_state(CParams& p, int u, char* lds) {
    LANE_IDS;
    const int wr = wid >> 1, wc = wid & 1;
    const int vh = u & 1, bh = u >> 1, b = bh >> 2, h = bh & 3;
    const u16* A = (const u16*)(p.ws + OFF_KTT) + (size_t)bh * 64 * 128 * 64;
    const u16* Bv = (const u16*)(p.ws + OFF_VT) + (size_t)bh * 64 * 128 * 64 + (size_t)vh * 64 * 64;
    u16* ST = (u16*)(p.ws + OFF_ST) + (size_t)bh * 64 * 128 * 128;
    const float* Dec = (const float*)(p.ws + OFF_DEC) + (size_t)b * 64 * 512 + h * 128;
    f32x4 acc[4][2]; ZERO_ACC(acc, 4, 2);
    auto hook = [&](int t) {
        const float* dc = Dec + (size_t)t * 512;
#pragma unroll
        for (int m = 0; m < 4; ++m) {
            const int d0 = wr * 64 + m * 16 + fq * 4;
            const float4 dv = *(const float4*)(dc + d0);
#pragma unroll
            for (int n = 0; n < 2; ++n) {
                const int v = vh * 64 + wc * 32 + n * 16 + fr;
                uint2 o;
                o.x = f2bf(acc[m][n][0]) | ((unsigned)f2bf(acc[m][n][1]) << 16);
                o.y = f2bf(acc[m][n][2]) | ((unsigned)f2bf(acc[m][n][3]) << 16);
                *(uint2*)(ST + ((size_t)t * 128 + v) * 128 + d0) = o;
                acc[m][n][0] *= dv.x; acc[m][n][1] *= dv.y; acc[m][n][2] *= dv.z; acc[m][n][3] *= dv.w;
            }
        }
    };
    mma_loop<128, 64, 2, 2>(acc, 64,
        [&](int r, int k) { return *(const bf16x8*)(A + ((size_t)(k >> 6) * 128 + r) * 64 + (k & 63)); },
        [&](int c, int k) { return *(const bf16x8*)(Bv + ((size_t)(k >> 6) * 128 + c) * 64 + (k & 63)); }, hook, lds);
}

__device__ void s5_scan(CParams& p, int l, int u) {
    const int tid = otid();
    const int b = u >> 3, g = (u & 7) * 4 + (tid >> 6), pp = tid & 63;
    const int lg = l * 32 + g;
    const float dt = expf(p.in[12][lg]);
    const float ar = p.in[5][lg * 64 + pp], ai = p.in[6][lg * 64 + pp];
    const float mag = expf(16.f * ar * dt), ang = 16.f * ai * dt;
    const float er = mag * cosf(ang), ei = mag * sinf(ang);
    const float* Vc = (const float*)(p.ws + OFF_VC) + ((size_t)(b * 256) * 32 + g) * 128 + pp;
    u16* Hc = (u16*)(p.ws + OFF_HC) + ((size_t)(b * 256) * 32 + g) * 128 + pp;
    float hr = 0.f, hi = 0.f;
    for (int c0 = 0; c0 < 256; c0 += 16) {
        float vr[16], vi[16];
#pragma unroll
        for (int i = 0; i < 16; ++i) { vr[i] = Vc[(size_t)(c0 + i) * 4096]; vi[i] = Vc[(size_t)(c0 + i) * 4096 + 64]; }
#pragma unroll
        for (int i = 0; i < 16; ++i) {
            Hc[(size_t)(c0 + i) * 4096] = f2bf(hr);
            Hc[(size_t)(c0 + i) * 4096 + 64] = f2bf(hi);
            float nr = er * hr - ei * hi + vr[i];
            float ni = er * hi + ei * hr + vi[i];
            hr = nr; hi = ni;
        }
    }
}

__device__ void rg_gemm(CParams& p, int l, int u, char* lds) {
    LANE_IDS;
    const int wr = wid >> 1, wc = wid & 1;
    const int tm = u >> 3, h = (u >> 1) & 3, nt = u & 1, row0 = tm * 128;
    unsigned char* ws = p.ws;
    const unsigned aoff = (unsigned)(OFF_XC + h * 128 * 2), boff = (unsigned)(OFF_RGT + ((size_t)h * 256 * 128 + (size_t)nt * 128 * 128) * 2);
    f32x4 acc[4][4]; ZERO_ACC(acc, 4, 4);
    mma_loop<128, 128, 2, 2>(acc, 2,
        [&](int r, int k) { return ldg<bf16x8>(ws, aoff + ((row0 + r) * 512 + k) * 2); },
        [&](int c, int k) { return ldg<bf16x8>(ws, boff + (c * 128 + k) * 2); }, NoHook(), lds);
    const float* ba = p.in[18] + (size_t)l * 512;
    const float* bx = p.in[20] + (size_t)l * 512;
    const float* lam = p.in[21] + (size_t)l * 512;
#pragma unroll
    for (int n = 0; n < 2; ++n) {
        const int ch = h * 128 + (nt * 2 + wc) * 32 + n * 16 + fr;
        const float c1 = -8.f * log1pf(expf(-lam[ch]));
        const float bav = ba[ch], bxv = bx[ch];
#pragma unroll
        for (int m = 0; m < 4; ++m) {
#pragma unroll
            for (int j = 0; j < 4; ++j) {
                const int row = row0 + wr * 64 + m * 16 + fq * 4 + j;
                const float r = sigm(acc[m][n][j] + bav), ig = sigm(acc[m][n + 2][j] + bxv);
                const float la = c1 * r;
                const float x = bf2f(ldg<u16>(ws, (unsigned)(OFF_XC + (row * 512 + ch) * 2)));
                const float bb = sqrtf(fmaxf(1.f - __expf(2.f * la), 0.f)) * ig * x;
                stg<u16>(ws, (unsigned)(OFF_LA + (row * 512 + ch) * 2), f2bf(la));
                stg<u16>(ws, (unsigned)(OFF_BB + (row * 512 + ch) * 2), f2bf(bb));
            }
            __builtin_amdgcn_sched_barrier(0);
        }
    }
}

__device__ void phase3(CParams& p, int l, char* lds) {
    for (int u = blockIdx.x; u < 64 + 1024; u += gridDim.x) {
        if (u < 32) hgrn_state(p, u, lds);
        else if (u < 64) s5_scan(p, l, u - 32);
        else rg_gemm(p, l, u - 64, lds);
    }
}

__device__ void hgrn_out(CParams& p, int l, int u, char* lds) {
    LANE_IDS;
    const int h = u & 3, c = (u >> 2) & 63, b = u >> 8;
    const int r0 = b * SEQ + c * 64;
    const size_t cu = (size_t)((b * 4 + h) * 64 + c);
    const u16* Pq = (const u16*)(p.ws + OFF_PQ) + (size_t)r0 * 512 + h * 128;
    const u16* Pk = (const u16*)(p.ws + OFF_PK) + (size_t)r0 * 512 + h * 128;
    const float* Bc = (const float*)(p.ws + OFF_PLF) + (size_t)r0 * 512 + h * 128;
    char* Ss = lds + (64 + 128) * 128;
    __syncthreads();
    {
        const int i = wid;
        const int t = 16 * i + fr;
        bf16x8 aq[4];
        float refv[4][8];
#pragma unroll
        for (int kk = 0; kk < 4; ++kk) {
            const int d0 = kk * 32 + fq * 8;
            bf16x8 q8 = *(const bf16x8*)(Pq + (size_t)t * 512 + d0);
#pragma unroll
            for (int e = 0; e < 8; ++e) {
                float rf = (i == 0) ? 0.f : Bc[(size_t)(16 * i - 1) * 512 + d0 + e];
                refv[kk][e] = rf;
                float bt = Bc[(size_t)t * 512 + d0 + e];
                aq[kk][e] = (short)f2bf(bf2f((u16)q8[e]) * __expf(bt - rf));
            }
        }
#pragma unroll
        for (int j = 0; j < 4; ++j) {
            f32x4 sc = {0.f, 0.f, 0.f, 0.f};
            if (j <= i) {
                const int s = 16 * j + fr;
#pragma unroll
                for (int kk = 0; kk < 4; ++kk) {
                    const int d0 = kk * 32 + fq * 8;
                    bf16x8 k8 = *(const bf16x8*)(Pk + (size_t)s * 512 + d0);
                    bf16x8 bk;
#pragma unroll
                    for (int e = 0; e < 8; ++e) {
                        float bsv = Bc[(size_t)s * 512 + d0 + e];
                        bk[e] = (short)f2bf(bf2f((u16)k8[e]) * __expf(fminf(refv[kk][e] - bsv, 60.f)));
                    }
                    sc = __builtin_amdgcn_mfma_f32_16x16x32_bf16(aq[kk], bk, sc, 0, 0, 0);
                }
            }
#pragma unroll
            for (int r = 0; r < 4; ++r) {
                const int tl = fq * 4 + r, sl = fr;
                float v = sc[r];
                if (j > i || (j == i && sl > tl)) v = 0.f;
                const int row = 16 * i + tl, col = 16 * j + sl;
                *(u16*)(Ss + swz(row, col >> 3) + (col & 7) * 2) = f2bf(v);
            }
        }
    }
    __syncthreads();
    const u16* STc = (const u16*)(p.ws + OFF_ST) + cu * 128 * 128;
    const u16* VTc = (const u16*)(p.ws + OFF_VT) + cu * 128 * 64;
    f32x4 acc[1][8]; ZERO_ACC(acc, 1, 8);
    mma_loop<64, 128, 4, 1>(acc, 3,
        [&](int r, int k) {
            bf16x8 o;
            if (k < 128) {
                bf16x8 q8 = *(const bf16x8*)(Pq + (size_t)r * 512 + k);
                const float4 b0 = *(const float4*)(Bc + (size_t)r * 512 + k), b1 = *(const float4*)(Bc + (size_t)r * 512 + k + 4);
                o[0] = (short)f2bf(bf2f((u16)q8[0]) * __expf(b0.x)); o[1] = (short)f2bf(bf2f((u16)q8[1]) * __expf(b0.y));
                o[2] = (short)f2bf(bf2f((u16)q8[2]) * __expf(b0.z)); o[3] = (short)f2bf(bf2f((u16)q8[3]) * __expf(b0.w));
                o[4] = (short)f2bf(bf2f((u16)q8[4]) * __expf(b1.x)); o[5] = (short)f2bf(bf2f((u16)q8[5]) * __expf(b1.y));
                o[6] = (short)f2bf(bf2f((u16)q8[6]) * __expf(b1.z)); o[7] = (short)f2bf(bf2f((u16)q8[7]) * __expf(b1.w));
            } else {
                o = *(const bf16x8*)(Ss + swz(r, (k - 128) >> 3));
            }
            return o;
        },
        [&](int cc, int k) {
            return (k < 128) ? *(const bf16x8*)(STc + (size_t)cc * 128 + k) : *(const bf16x8*)(VTc + (size_t)cc * 64 + (k - 128));
        }, NoHook(), lds);
    const float* nw = p.in[4] + (size_t)l * 512 + h * 128;
    const u16* Pg = (const u16*)(p.ws + OFF_PG) + (size_t)r0 * 512 + h * 128;
    u16* Ya = (u16*)(p.ws + OFF_YA) + (size_t)r0 * 512 + h * 128;
#pragma unroll
    for (int j = 0; j < 4; ++j) {
        float ss = 0.f;
#pragma unroll
        for (int n = 0; n < 8; ++n) ss += acc[0][n][j] * acc[0][n][j];
        ss += __shfl_xor(ss, 1); ss += __shfl_xor(ss, 2); ss += __shfl_xor(ss, 4); ss += __shfl_xor(ss, 8);
        const float rs = rsqrtf(ss * (1.f / 128.f) + 1e-6f);
        const int row = wid * 16 + fq * 4 + j;
#pragma unroll
        for (int n = 0; n < 8; ++n) {
            const int v = n * 16 + fr;
            Ya[(size_t)row * 512 + v] = f2bf(acc[0][n][j] * rs * nw[v] * bf2f(Pg[(size_t)row * 512 + v]));
        }
    }
}

__device__ void s5_gemm_c(CParams& p, int l, int u, char* lds) {
    LANE_IDS;
    const int wr = wid >> 1, wc = wid & 1;
    const int g = u >> 4, tm = (u >> 1) & 7, tn = u & 1, row0 = tm * 128, col0 = tn * 128;
    unsigned char* ws = p.ws;
    const unsigned aoff = (unsigned)(OFF_PU + (size_t)g * NTOK * 16 * 2), boff = (unsigned)(OFF_BTC + (size_t)g * 256 * 384 * 2);
    f32x4 acc[4][4]; ZERO_ACC(acc, 4, 4);
    mma_loop<128, 128, 2, 2>(acc, 6,
        [&](int r, int k) {
            const unsigned o = (k < 256) ? aoff + ((row0 + r) * 256 + k) * 2 : (unsigned)(OFF_HC + (((row0 + r) * 32 + g) * 128 + (k - 256)) * 2);
            return ldg<bf16x8>(ws, o);
        },
        [&](int c, int k) { return ldg<bf16x8>(ws, boff + ((col0 + c) * 384 + k) * 2); }, NoHook(), lds);
    const float dch = p.in[11][(size_t)l * 512 + g * 16 + fr];
    epi<4, 4, 64, 64>(acc, wr, wc, fq, fr, [&](int r, int cc, float v) {
        const int row = row0 + r, col = col0 + cc;
        const int jj = col >> 4, ch = col & 15;
        const int tok = (row >> 8) * SEQ + (row & 255) * 16 + jj;
        const float uu = bf2f(ldg<u16>(ws, aoff + (tok * 16 + ch) * 2));
        const float y = v + dch * uu;
        stg<u16>(ws, (unsigned)(OFF_YG + (tok * 512 + g * 16 + ch) * 2), f2bf(gelu_f(y))); });
}

__device__ void rg_scan(CParams& p, int u, char* lds) {
    const int tid = otid();
    const int b = u >> 5, c0 = (u & 31) * 16, seg = tid >> 4, ch = c0 + (tid & 15);
    const size_t base = (size_t)(b * SEQ + seg * 256) * 512 + ch;
    const u16* La = (const u16*)(p.ws + OFF_LA) + base;
    const u16* Bb = (const u16*)(p.ws + OFF_BB) + base;
    const u16* Xg = (const u16*)(p.ws + OFF_PXG) + base;
    u16* Yc = (u16*)(p.ws + OFF_YC) + base;
    float* sA = (float*)lds;
    float* sH = sA + 256;
    __syncthreads();
    float hh = 0.f, ap = 1.f;
    for (int s0 = 0; s0 < 256; s0 += 16) {
        float a[16], bb[16];
#pragma unroll
        for (int i = 0; i < 16; ++i) { a[i] = bf2f(La[(size_t)(s0 + i) * 512]); bb[i] = bf2f(Bb[(size_t)(s0 + i) * 512]); }
#pragma unroll
        for (int i = 0; i < 16; ++i) { float av = __expf(a[i]); hh = av * hh + bb[i]; ap *= av; }
    }
    sA[tid] = ap; sH[tid] = hh;
    __syncthreads();
    float cin = 0.f;
    for (int sg = 0; sg < seg; ++sg) cin = sA[sg * 16 + (tid & 15)] * cin + sH[sg * 16 + (tid & 15)];
    hh = cin;
    for (int s0 = 0; s0 < 256; s0 += 16) {
        float a[16], bb[16], xg[16];
#pragma unroll
        for (int i = 0; i < 16; ++i) { a[i] = bf2f(La[(size_t)(s0 + i) * 512]); bb[i] = bf2f(Bb[(size_t)(s0 + i) * 512]); xg[i] = bf2f(Xg[(size_t)(s0 + i) * 512]); }
#pragma unroll
        for (int i = 0; i < 16; ++i) { hh = __expf(a[i]) * hh + bb[i]; Yc[(size_t)(s0 + i) * 512] = f2bf(hh * xg[i]); }
    }
}

__device__ void phase4(CParams& p, int l, char* lds) {
    for (int u = blockIdx.x; u < 1664; u += gridDim.x) {
        if (u < 128) rg_scan(p, u, lds);
        else if (u < 1152) hgrn_out(p, l, u - 128, lds);
        else s5_gemm_c(p, l, u - 1152, lds);
    }
}

__device__ void phase_glu(CParams& p, int l, char* lds) {
    LANE_IDS;
    const int wr = wid >> 1, wc = wid & 1;
    unsigned char* ws = p.ws;
    const float* gb = p.in[14] + (size_t)l * 512;
    for (int u = blockIdx.x; u < 512; u += gridDim.x) {
        const int row0 = (u >> 2) * 128, col0 = (u & 3) * 128;
        f32x4 acc[4][4]; ZERO_ACC(acc, 4, 4);
        mma_loop<128, 128, 2, 2>(acc, 8,
            [&](int r, int k) { return ldg<bf16x8>(ws, (unsigned)(OFF_YG + ((row0 + r) * 512 + k) * 2)); },
            [&](int c, int k) { return ldg<bf16x8>(ws, (unsigned)(OFF_GLUT + ((col0 + c) * 512 + k) * 2)); }, NoHook(), lds);
        epi<4, 4, 64, 64>(acc, wr, wc, fq, fr, [&](int r, int cc, float v) {
            const int row = row0 + r, col = col0 + cc;
            const float y = bf2f(ldg<u16>(ws, (unsigned)(OFF_YG + (row * 512 + col) * 2)));
            stg<u16>(ws, (unsigned)(OFF_YB + (row * 512 + col) * 2), f2bf(y * sigm(v + gb[col]))); });
    }
}

__device__ void phase_branch(CParams& p, int l, char* lds) {
    LANE_IDS;
    const int wr = wid >> 1, wc = wid & 1;
    unsigned char* ws = p.ws;
    for (int u = blockIdx.x; u < 2048; u += gridDim.x) {
        const int row0 = (u >> 4) * 128, col0 = (u & 15) * 64;
        f32x4 tot[4][2]; ZERO_ACC(tot, 4, 2);
#pragma unroll 1
        for (int kb = 0; kb < 3; ++kb) {
            const unsigned yoff = (unsigned)(kb == 0 ? OFF_YA : (kb == 1 ? OFF_YB : OFF_YC));
            const unsigned boff = (unsigned)(OFF_WBRT + (size_t)kb * 1024 * 512 * 2);
            f32x4 acc[4][2]; ZERO_ACC(acc, 4, 2);
            mma_loop<128, 64, 2, 2>(acc, 8,
                [&](int r, int k) { return ldg<bf16x8>(ws, yoff + ((row0 + r) * 512 + k) * 2); },
                [&](int c, int k) { return ldg<bf16x8>(ws, boff + ((col0 + c) * 512 + k) * 2); }, NoHook(), lds);
#pragma unroll
            for (int m = 0; m < 4; ++m) {
#pragma unroll
                for (int j = 0; j < 4; ++j)
#pragma unroll
                    for (int n = 0; n < 2; ++n) {
                        const int row = row0 + wr * 64 + m * 16 + fq * 4 + j, col = col0 + wc * 32 + n * 16 + fr;
                        tot[m][n][j] += bf2f(ldg<u16>(ws, (unsigned)(OFF_PGATE + (row * 3072 + kb * 1024 + col) * 2))) * acc[m][n][j];
                    }
                __builtin_amdgcn_sched_barrier(0);
            }
        }
        epi<4, 2, 64, 32>(tot, wr, wc, fq, fr, [&](int r, int cc, float v) {
            stg<u16>(ws, (unsigned)(OFF_MIXP + ((row0 + r) * 1024 + col0 + cc) * 2), f2bf(v)); });
    }
}

__device__ void phase_out(CParams& p, int l, char* lds) {
    LANE_IDS;
    const int wr = wid >> 1, wc = wid & 1;
    unsigned char* ws = p.ws;
    const float* xres = (l == 0) ? p.in[0] : p.out;
    for (int u = blockIdx.x; u < 1024 + 12288; u += gridDim.x) {
        if (u < 1024) {
            const int row0 = (u >> 3) * 128, col0 = (u & 7) * 128;
            f32x4 acc[4][4]; ZERO_ACC(acc, 4, 4);
            mma_loop<128, 128, 2, 2>(acc, 16,
                [&](int r, int k) { return ldg<bf16x8>(ws, (unsigned)(OFF_MIXP + ((row0 + r) * 1024 + k) * 2)); },
                [&](int c, int k) { return ldg<bf16x8>(ws, (unsigned)(OFF_WOUTT + ((col0 + c) * 1024 + k) * 2)); }, NoHook(), lds);
            epi<4, 4, 64, 64>(acc, wr, wc, fq, fr, [&](int r, int cc, float v) {
                const unsigned o = (unsigned)(((row0 + r) * 1024 + col0 + cc) * 4);
                stg<float>(ws, (unsigned)OFF_PRELN + o, DN_ALPHA * ldg<float>(xres, o) + v); });
        } else {
            const int t = u - 1024, e = t / 192, r = t % 192;
            if (r < 128)
                conv_tile(p.in[28] + (size_t)(l * 64 + e) * 1024 * 256, p.in[29] + (size_t)(l * 64 + e) * 1024 * 256, 256, 1024, 1,
                          (u16*)(p.ws + OFF_EW13) + (size_t)e * 512 * 1024, r, (float*)lds);
            else
                conv_tile(p.in[30] + (size_t)(l * 64 + e) * 256 * 1024, nullptr, 1024, 256, 0,
                          (u16*)(p.ws + OFF_EW2) + (size_t)e * 1024 * 256, r - 128, (float*)lds);
        }
    }
}

__device__ __forceinline__ void ln_row(float (&v)[16], const float* g, const float* bta, int lane) {
    float s = 0.f;
#pragma unroll
    for (int i = 0; i < 16; ++i) s += v[i];
    const float mu = wave_sum(s) * (1.f / 1024.f);
    float q = 0.f;
#pragma unroll
    for (int i = 0; i < 16; ++i) { float d = v[i] - mu; q += d * d; }
    const float rs = rsqrtf(wave_sum(q) * (1.f / 1024.f) + 1e-5f);
#pragma unroll
    for (int i = 0; i < 4; ++i) {
        const float4 gg = *(const float4*)(g + i * 256 + lane * 4), bb = *(const float4*)(bta + i * 256 + lane * 4);
        v[i * 4 + 0] = (v[i * 4 + 0] - mu) * rs * gg.x + bb.x;
        v[i * 4 + 1] = (v[i * 4 + 1] - mu) * rs * gg.y + bb.y;
        v[i * 4 + 2] = (v[i * 4 + 2] - mu) * rs * gg.z + bb.z;
        v[i * 4 + 3] = (v[i * 4 + 3] - mu) * rs * gg.w + bb.w;
    }
}

__device__ void phase_route(CParams& p, int l, char* lds) {
    LANE_IDS;
    const float* Pre = (const float*)(p.ws + OFF_PRELN);
    u16* Xm = (u16*)(p.ws + OFF_XM);
    const u16* Rt = (const u16*)(p.ws + OFF_ROUTT);
    const float* g1 = p.in[24] + (size_t)l * 1024;
    const float* b1 = p.in[25] + (size_t)l * 1024;
    const float* rbias = p.in[27] + (size_t)l * 64;
    int* cursor = (int*)(p.ws + OFF_CUR);
    int* list = (int*)(p.ws + OFF_LIST);
    float* tkw = (float*)(p.ws + OFF_TKW);
    float* Ls = (float*)(lds + 16384);
    int* hist = (int*)(lds + 16384 + 64 * 65 * 4);
    int* basep = hist + 64;
    for (int u = blockIdx.x; u < 256; u += gridDim.x) {
        const int row0 = u * 64;
        for (int rr = 0; rr < 16; ++rr) {
            const int row = row0 + wid * 16 + rr;
            float v[16];
#pragma unroll
            for (int i = 0; i < 4; ++i) {
                const float4 x = *(const float4*)(Pre + (size_t)row * 1024 + i * 256 + lane * 4);
                v[i * 4] = x.x; v[i * 4 + 1] = x.y; v[i * 4 + 2] = x.z; v[i * 4 + 3] = x.w;
            }
            ln_row(v, g1, b1, lane);
#pragma unroll
            for (int i = 0; i < 4; ++i) {
                uint2 o; o.x = f2bf(v[i * 4]) | ((unsigned)f2bf(v[i * 4 + 1]) << 16); o.y = f2bf(v[i * 4 + 2]) | ((unsigned)f2bf(v[i * 4 + 3]) << 16);
                *(uint2*)(Xm + (size_t)row * 1024 + i * 256 + lane * 4) = o;
            }
        }
        if (tid < 64) hist[tid] = 0;
        __syncthreads();
        f32x4 acc[1][4]; ZERO_ACC(acc, 1, 4);
        mma_loop<64, 64, 4, 1>(acc, 16,
            [&](int r, int k) { return *(const bf16x8*)(Xm + (size_t)(row0 + r) * 1024 + k); },
            [&](int c, int k) { return *(const bf16x8*)(Rt + (size_t)c * 1024 + k); }, NoHook(), lds);
#pragma unroll
        for (int n = 0; n < 4; ++n)
#pragma unroll
            for (int j = 0; j < 4; ++j) {
                const int r = wid * 16 + fq * 4 + j, e = n * 16 + fr;
                Ls[r * 65 + e] = sigm(acc[0][n][j]) + rbias[e];
            }
        __syncthreads();
        int myrank[8]; int myexp[8];
        if (tid < 64) {
            float* sc = Ls + tid * 65;
            float gs[8];
#pragma unroll
            for (int g = 0; g < 8; ++g) {
                float m1 = -1e30f, m2 = -1e30f;
#pragma unroll
                for (int i = 0; i < 8; ++i) { float x = sc[g * 8 + i]; if (x > m1) { m2 = m1; m1 = x; } else if (x > m2) m2 = x; }
                gs[g] = m1 + m2;
            }
            unsigned gmask = 0;
#pragma unroll
            for (int it = 0; it < 4; ++it) {
                float best = -1e30f; int bi = 0;
#pragma unroll
                for (int g = 0; g < 8; ++g) { bool ok = !((gmask >> g) & 1u) && gs[g] > best; if (ok) { best = gs[g]; bi = g; } }
                gmask |= 1u << bi;
            }
            unsigned long long chosen = 0ull;
            float wsum = 0.f; float wv[8];
#pragma unroll
            for (int k = 0; k < 8; ++k) {
                float best = -1e30f; int bi = 0;
                for (int e = 0; e < 64; ++e) {
                    float x = sc[e];
                    bool ok = ((gmask >> (e >> 3)) & 1u) && !((chosen >> e) & 1ull) && x > best;
                    if (ok) { best = x; bi = e; }
                }
                chosen |= 1ull << bi;
                myexp[k] = bi;
                wv[k] = best - rbias[bi];
                wsum += wv[k];
            }
            const float sc_ = 2.5f / wsum;
#pragma unroll
            for (int k = 0; k < 8; ++k) {
                tkw[(size_t)(row0 + tid) * 8 + k] = wv[k] * sc_;
                myrank[k] = atomicAdd(&hist[myexp[k]], 1);
            }
        }
        __syncthreads();
        if (tid < 64) basep[tid] = atomicAdd(&cursor[tid], hist[tid]);
        __syncthreads();
        if (tid < 64) {
#pragma unroll
            for (int k = 0; k < 8; ++k) list[(size_t)myexp[k] * NTOK + basep[myexp[k]] + myrank[k]] = (row0 + tid) * 8 + k;
        }
        __syncthreads();
    }
}

struct MoeMap { int e, lb, cnt, off; };
__device__ __forceinline__ void moe_setup(CParams& p, int* sm) {
    if (otid() == 0) {
        const int* cursor = (const int*)(p.ws + OFF_CUR);
        int nb = 0, nr = 0;
        for (int e = 0; e < 64; ++e) { sm[e] = nb; sm[65 + e] = nr; int c = cursor[e]; nb += (c + 127) >> 7; nr += c; }
        sm[64] = nb; sm[129] = nr;
    }
    __syncthreads();
}
__device__ __forceinline__ MoeMap moe_map(CParams& p, const int* sm, int blk) {
    MoeMap m;
    const int nbr = sm[64];
    if (blk >= nbr) { m.e = 64; m.lb = blk - nbr; m.cnt = NTOK; m.off = 0; return m; }
    int e = 0;
    for (int i = 0; i < 64; ++i) if (sm[i] <= blk && sm[i + 1] > blk) e = i;
    m.e = e; m.lb = blk - sm[e]; m.cnt = ((const int*)(p.ws + OFF_CUR))[e]; m.off = sm[65 + e];
    return m;
}

__device__ void phase_moe1(CParams& p, int l, char* lds) {
    LANE_IDS;
    const int wr = wid >> 1, wc = wid & 1;
    int* sm = (int*)(lds + 40960);
    __syncthreads();
    moe_setup(p, sm);
    const int nblk = sm[64] + 128;
    unsigned char* ws = p.ws;
    const int* list = (const int*)(p.ws + OFF_LIST);
    int* rowtok = (int*)(lds + 32768);
    for (int u = blockIdx.x; u < nblk * 4; u += gridDim.x) {
        const int blk = u >> 2, nt = u & 3;
        const MoeMap mm = moe_map(p, sm, blk);
        const int valid = min(128, mm.cnt - mm.lb * 128);
        __syncthreads();
        if (tid < 128) {
            int tok;
            if (mm.e == 64) tok = mm.lb * 128 + tid;
            else tok = (tid < valid) ? (list[(size_t)mm.e * NTOK + mm.lb * 128 + tid] >> 3) : 0;
            rowtok[tid] = tok;
        }
        __syncthreads();
        const unsigned boff = (unsigned)(((mm.e == 64) ? OFF_SH13T : OFF_EW13 + (size_t)mm.e * 512 * 1024 * 2) + (size_t)nt * 128 * 1024 * 2);
        f32x4 acc[4][4]; ZERO_ACC(acc, 4, 4);
        mma_loop<128, 128, 2, 2>(acc, 16,
            [&](int r, int k) { return ldg<bf16x8>(ws, (unsigned)(OFF_XM + (rowtok[r] * 1024 + k) * 2)); },
            [&](int c, int k) { return ldg<bf16x8>(ws, boff + (c * 1024 + k) * 2); }, NoHook(), lds);
        const unsigned hoff = (unsigned)((mm.e == 64) ? OFF_HSH + (size_t)mm.lb * 128 * 256 * 2 : OFF_HBUF + (size_t)(mm.off + mm.lb * 128) * 256 * 2);
#pragma unroll
        for (int m = 0; m < 4; ++m) {
#pragma unroll
            for (int n = 0; n < 2; ++n)
#pragma unroll
                for (int j = 0; j < 4; ++j) {
                    const int r = wr * 64 + m * 16 + fq * 4 + j;
                    const int hid = (nt * 2 + wc) * 32 + n * 16 + fr;
                    if (r < valid) stg<u16>(ws, hoff + (r * 256 + hid) * 2, f2bf(silu_f(acc[m][n][j]) * acc[m][n + 2][j]));
                }
            __builtin_amdgcn_sched_barrier(0);
        }
    }
}

__device__ void phase_moe2(CParams& p, int l, char* lds) {
    LANE_IDS;
    const int wr = wid >> 1, wc = wid & 1;
    int* sm = (int*)(lds + 40960);
    __syncthreads();
    moe_setup(p, sm);
    const int nblk = sm[64] + 128;
    const int* list = (const int*)(p.ws + OFF_LIST);
    const float* tkw = (const float*)(p.ws + OFF_TKW);
    int* rowent = (int*)(lds + 32768);
    float* roww = (float*)(lds + 32768 + 512);
    for (int u = blockIdx.x; u < nblk * 8; u += gridDim.x) {
        const int blk = u >> 3, nt = u & 7;
        const MoeMap mm = moe_map(p, sm, blk);
        const int valid = min(128, mm.cnt - mm.lb * 128);
        __syncthreads();
        if (tid < 128 && mm.e < 64) {
            int ent = (tid < valid) ? list[(size_t)mm.e * NTOK + mm.lb * 128 + tid] : 0;
            rowent[tid] = ent; roww[tid] = tkw[ent];
        }
        __syncthreads();
        unsigned char* ws = p.ws;
        const unsigned aoff = (unsigned)((mm.e == 64) ? OFF_HSH + (size_t)mm.lb * 128 * 256 * 2 : OFF_HBUF + (size_t)(mm.off + mm.lb * 128) * 256 * 2);
        const unsigned boff = (unsigned)(((mm.e == 64) ? OFF_SH2T : OFF_EW2 + (size_t)mm.e * 1024 * 256 * 2) + (size_t)nt * 128 * 256 * 2);
        f32x4 acc[4][4]; ZERO_ACC(acc, 4, 4);
        mma_loop<128, 128, 2, 2>(acc, 4,
            [&](int r, int k) { return (r < valid) ? ldg<bf16x8>(ws, aoff + (r * 256 + k) * 2) : bf16x8{0, 0, 0, 0, 0, 0, 0, 0}; },
            [&](int c, int k) { return ldg<bf16x8>(ws, boff + (c * 256 + k) * 2); }, NoHook(), lds);
        if (mm.e == 64) {
            float* Ysh = p.out;
            epi<4, 4, 64, 64>(acc, wr, wc, fq, fr, [&](int r, int cc, float v) {
                stg<float>(Ysh, (unsigned)(((mm.lb * 128 + r) * 1024 + nt * 128 + cc) * 4), v); });
        } else {
            epi<4, 4, 64, 64>(acc, wr, wc, fq, fr, [&](int r, int cc, float v) {
                if (r < valid) stg<u16>(ws, (unsigned)OFF_YBUF + (unsigned)(rowent[r] * 1024 + nt * 128 + cc) * 2u, f2bf(v * roww[r])); });
        }
    }
}

__device__ void phase_combine(CParams& p, int l) {
    LANE_IDS;
    const u16* Xm = (const u16*)(p.ws + OFF_XM);
    const u16* Yb = (const u16*)(p.ws + OFF_YBUF);
    const float* g2 = p.in[34] + (size_t)l * 1024;
    const float* b2 = p.in[35] + (size_t)l * 1024;
    u16* Xb = (u16*)(p.ws + OFF_XB);
    for (int row = blockIdx.x * 4 + wid; row < NTOK; row += gridDim.x * 4) {
        float v[16];
#pragma unroll
        for (int i = 0; i < 4; ++i) {
            const float4 y = *(const float4*)(p.out + (size_t)row * 1024 + i * 256 + lane * 4);
            const uint2 x = *(const uint2*)(Xm + (size_t)row * 1024 + i * 256 + lane * 4);
            v[i * 4 + 0] = y.x + DN_ALPHA * bf2f((u16)(x.x & 0xffff));
            v[i * 4 + 1] = y.y + DN_ALPHA * bf2f((u16)(x.x >> 16));
            v[i * 4 + 2] = y.z + DN_ALPHA * bf2f((u16)(x.y & 0xffff));
            v[i * 4 + 3] = y.w + DN_ALPHA * bf2f((u16)(x.y >> 16));
        }
#pragma unroll
        for (int k = 0; k < 8; ++k)
#pragma unroll
            for (int i = 0; i < 4; ++i) {
                const uint2 x = *(const uint2*)(Yb + ((size_t)row * 8 + k) * 1024 + i * 256 + lane * 4);
                v[i * 4 + 0] += bf2f((u16)(x.x & 0xffff));
                v[i * 4 + 1] += bf2f((u16)(x.x >> 16));
                v[i * 4 + 2] += bf2f((u16)(x.y & 0xffff));
                v[i * 4 + 3] += bf2f((u16)(x.y >> 16));
            }
        ln_row(v, g2, b2, lane);
#pragma unroll
        for (int i = 0; i < 4; ++i) {
            *(float4*)(p.out + (size_t)row * 1024 + i * 256 + lane * 4) = float4{v[i * 4], v[i * 4 + 1], v[i * 4 + 2], v[i * 4 + 3]};
            uint2 o; o.x = f2bf(v[i * 4]) | ((unsigned)f2bf(v[i * 4 + 1]) << 16); o.y = f2bf(v[i * 4 + 2]) | ((unsigned)f2bf(v[i * 4 + 3]) << 16);
            *(uint2*)(Xb + (size_t)row * 1024 + i * 256 + lane * 4) = o;
        }
    }
}


#define XB_TMO      128
#define XB_XCNT(j)  (256  + 64 * (j))
#define XB_XSUB(j)  (1280 + 64 * (j))
#define XB_XGEN(j)  (2304 + 64 * (j))
#define XB_TOP      3328
#define XB_TOPGEN   3392
#define XCD_BAR_WORDS 3456
#define XB_SPIN_CAP (1u << 22)
#define LAS __attribute__((address_space(3)))
__device__ __forceinline__ unsigned xb_ld(unsigned* p)              { return __hip_atomic_load(p, __ATOMIC_RELAXED, __HIP_MEMORY_SCOPE_AGENT); }
__device__ __forceinline__ unsigned xb_add(unsigned* p, unsigned v) { return __hip_atomic_fetch_add(p, v, __ATOMIC_RELAXED, __HIP_MEMORY_SCOPE_AGENT); }
__device__ __forceinline__ unsigned xb_xcc_id() { return (unsigned)__builtin_amdgcn_s_getreg((3 << 11) | 20) & 0xFu; }
#define XB_SPIN(cond, bar) do { unsigned _sp = 0; while (cond) { __builtin_amdgcn_s_sleep(1); \
    if ((++_sp & 255u) == 0u) { if (xb_ld(&(bar)[XB_TMO])) break; if (_sp > XB_SPIN_CAP) { atomicAdd(&(bar)[XB_TMO], 1u); break; } } } } while (0)
struct XcdBarrier { unsigned* bar; unsigned x; volatile LAS unsigned* st; };
__device__ __forceinline__ XcdBarrier xcd_barrier_post(unsigned* bar, volatile LAS unsigned* st) {
    XcdBarrier b; b.bar = bar; b.x = xb_xcc_id(); b.st = st;
    if (threadIdx.x == 0) (void)xb_add(&bar[XB_XCNT(b.x)], 1u);
    return b;
}
__device__ __forceinline__ void xcd_barrier_complete(unsigned* bar, unsigned x, unsigned& nloc, unsigned& nx) {
    const unsigned G = gridDim.x * gridDim.y * gridDim.z;
    unsigned sum, cnt, mine, sp = 0u;
    for (;;) {
        sum = 0u; cnt = 0u; mine = 0u;
#pragma unroll
        for (unsigned j = 0; j < 16; ++j) { const unsigned c = xb_ld(&bar[XB_XCNT(j)]); sum += c; cnt += (c > 0u) ? 1u : 0u; mine = (j == x) ? c : mine; }
        if (sum == G) break;
        __builtin_amdgcn_s_sleep(1);
        if ((++sp & 255u) == 0u) { if (xb_ld(&bar[XB_TMO])) break; if (sp > XB_SPIN_CAP) { atomicAdd(&bar[XB_TMO], 1u); break; } }
    }
    nloc = mine > 0u ? mine : 1u; nx = cnt > 0u ? cnt : 1u;
}
__device__ __forceinline__ void xcd_barrier(const XcdBarrier& b) {
    asm volatile("s_waitcnt vmcnt(0)" ::: "memory");
    __syncthreads();
    if (threadIdx.x == 0) {
        unsigned* bar = b.bar;
        __builtin_amdgcn_s_waitcnt(0);
        unsigned nloc = b.st[0], nx = b.st[1];
        if (nloc == 0u) { xcd_barrier_complete(bar, b.x, nloc, nx); b.st[0] = nloc; b.st[1] = nx; }
        const unsigned old = xb_add(&bar[XB_XSUB(b.x)], 1u);
        const unsigned gen = old / nloc;
        if (old + 1u == (gen + 1u) * nloc) {
            __builtin_amdgcn_fence(__ATOMIC_RELEASE, "agent");
            asm volatile("s_waitcnt vmcnt(0)" ::: "memory");
            const unsigned og = xb_add(&bar[XB_TOP], 1u);
            const unsigned tg = og / nx;
            if (og + 1u == (tg + 1u) * nx) xb_add(&bar[XB_TOPGEN], 1u);
            else XB_SPIN(xb_ld(&bar[XB_TOPGEN]) == tg, bar);
            __builtin_amdgcn_fence(__ATOMIC_ACQUIRE, "agent");
            xb_add(&bar[XB_XGEN(b.x)], 1u);
            asm volatile("s_waitcnt vmcnt(0)" ::: "memory");
        } else {
            XB_SPIN(xb_ld(&bar[XB_XGEN(b.x)]) == gen, bar);
            __builtin_amdgcn_fence(__ATOMIC_ACQUIRE, "agent");
            asm volatile("s_waitcnt vmcnt(0)" ::: "memory");
        }
    }
    __syncthreads();
}

__global__ void __launch_bounds__(256, 2) fwd_kernel(Params p_unused) {
    __shared__ __attribute__((aligned(16))) char lds[49152];
    cg::grid_group grid = cg::this_grid();
    CParams* pp = (CParams*)__builtin_amdgcn_kernarg_segment_ptr();
    const int ph_lo = pp->ph_lo, ph_hi = pp->ph_hi;
    volatile LAS unsigned* xst = (volatile LAS unsigned*)(lds + 49136);
    if (threadIdx.x == 0) { xst[0] = 0u; xst[1] = 0u; }
    __syncthreads();
    const XcdBarrier xb = xcd_barrier_post((unsigned*)(pp->ws + OFF_BAR), xst);
#pragma unroll 1
    for (int ph = ph_lo; ph < ph_hi; ++ph) {
        asm volatile("" : "+s"(pp));
        CParams& p = *pp;
        const int l = ph / NPH, q = ph % NPH;
        switch (q) {
            case 0: phase_w(p, l, lds); break;
            case 1: phase_proj(p, l, lds); break;
            case 2: phase2(p, l, lds); break;
            case 3: phase3(p, l, lds); break;
            case 4: phase4(p, l, lds); break;
            case 5: phase_glu(p, l, lds); break;
            case 6: phase_branch(p, l, lds); break;
            case 7: phase_out(p, l, lds); break;
            case 8: phase_route(p, l, lds); break;
            case 9: phase_moe1(p, l, lds); break;
            case 10: phase_moe2(p, l, lds); break;
            default: phase_combine(p, l); break;
        }
        if (ph + 1 < ph_hi) {
            if (p.coop == 1) xcd_barrier(xb);
            else if (p.coop == 2) grid.sync();
        }
    }
}

extern "C" void kernel_launch(void* const* d_in, const int* in_sizes, int n_in, void* d_out, int out_size, void* d_ws, size_t ws_size,
                              hipStream_t stream) {
    static int grid_blocks = 0;
    if (!grid_blocks) {
        int dev = 0, cus = 0, per_cu = 0;
        hipGetDevice(&dev);
        hipDeviceGetAttribute(&cus, hipDeviceAttributeMultiprocessorCount, dev);
        hipOccupancyMaxActiveBlocksPerMultiprocessor(&per_cu, fwd_kernel, 256, 0);
        if (per_cu < 1) per_cu = 1;
        if (per_cu > 2) per_cu = 2;
        grid_blocks = cus * per_cu;
        if (ws_size < WS_NEED) fprintf(stderr, "kernel_launch: workspace too small: %zu < %zu\n", ws_size, (size_t)WS_NEED);
    }
    Params p{};
    for (int i = 0; i < 36; ++i) p.in[i] = (const float*)d_in[i];
    p.out = (float*)d_out;
    p.ws = (unsigned char*)d_ws;
    p.ph_lo = 0; p.ph_hi = 2 * NPH; p.coop = 1; p.pad = 0;
    (void)hipMemsetAsync((char*)d_ws + OFF_BAR, 0, XCD_BAR_WORDS * 4, stream);
    void* args[] = {&p};
    hipError_t e = hipLaunchCooperativeKernel((void*)fwd_kernel, dim3(grid_blocks), dim3(256), args, 0, stream);
    if (e != hipSuccess) fprintf(stderr, "cooperative launch failed: %s (grid %d)\n", hipGetErrorString(e), grid_blocks);
}
```

```cpp
#include <hip/hip_runtime.h>
#include <hip/hip_cooperative_groups.h>
#include <cstdio>
#include <cstdint>
namespace cg = cooperative_groups;

typedef unsigned short u16;
typedef __attribute__((ext_vector_type(8))) short bf16x8;
typedef __attribute__((ext_vector_type(4))) float f32x4;

constexpr int NTOK = 16384, DM = 1024, SEQ = 4096, BW = 512, INC = 6656;
constexpr int NE = 64, EH = 256;
constexpr int NPH = 12;
constexpr float DN_ALPHA = 1.4142135623730951f;
constexpr size_t SLOT = 16777216ull;

constexpr size_t OFF_WINT  = 0;
constexpr size_t OFF_WBRT  = 13631488;
constexpr size_t OFF_WOUTT = 16777216;
constexpr size_t OFF_GLUT  = 18874368;
constexpr size_t OFF_RGT   = 19398656;
constexpr size_t OFF_SH13T = 19660800;
constexpr size_t OFF_SH2T  = 20709376;
constexpr size_t OFF_BTA   = 21233664;
constexpr size_t OFF_BTC   = 23330816;
constexpr size_t OFF_ROUTT = 29622272;
constexpr size_t OFF_MISC  = 29753344;
constexpr size_t OFF_LB    = OFF_MISC;
constexpr size_t OFF_CUR   = OFF_MISC + 2048;
constexpr size_t OFF_DEC   = OFF_MISC + 4096;
constexpr size_t OFF_TKW   = OFF_DEC + 524288;
constexpr size_t OFF_XB    = 2 * SLOT;
constexpr size_t OFF_VC    = 2 * SLOT;
constexpr size_t OFF_XC    = 3 * SLOT;
constexpr size_t OFF_MIXP  = 2 * SLOT;
constexpr size_t OFF_LIST  = 2 * SLOT;
constexpr size_t OFF_HSH   = 2 * SLOT + 4194304;
constexpr size_t OFF_PQ    = 4 * SLOT;
constexpr size_t OFF_PLF   = 5 * SLOT;
constexpr size_t OFF_PK    = 7 * SLOT;
constexpr size_t OFF_PV    = 8 * SLOT;
constexpr size_t OFF_YC    = 8 * SLOT;
constexpr size_t OFF_PG    = 9 * SLOT;
constexpr size_t OFF_PU    = 10 * SLOT;
constexpr size_t OFF_PXG   = 11 * SLOT;
constexpr size_t OFF_PXR   = 12 * SLOT;
constexpr size_t OFF_YB    = 12 * SLOT;
constexpr size_t OFF_PGATE = 13 * SLOT;
constexpr size_t OFF_KTT   = 19 * SLOT;
constexpr size_t OFF_YA    = 19 * SLOT;
constexpr size_t OFF_VT    = 20 * SLOT;
constexpr size_t OFF_ST    = 21 * SLOT;
constexpr size_t OFF_LA    = 23 * SLOT;
constexpr size_t OFF_BB    = 24 * SLOT;
constexpr size_t OFF_YG    = 25 * SLOT;
constexpr size_t OFF_HC    = 26 * SLOT;
constexpr size_t OFF_PRELN = 4 * SLOT;
constexpr size_t OFF_XM    = 8 * SLOT;
constexpr size_t OFF_EW13  = 10 * SLOT;
constexpr size_t OFF_EW2   = 14 * SLOT;
constexpr size_t OFF_HBUF  = 4 * SLOT;
constexpr size_t OFF_YBUF  = 16 * SLOT;
constexpr size_t OFF_BAR   = 32 * SLOT;
constexpr int LDS_BYTES = 73728;
constexpr int L_ROW = 65536, L_ROWW = 66048, L_SM = 66560, L_XST = 73712;
constexpr size_t WS_NEED   = 32 * SLOT + 16384;

struct Params {
    const float* in[36];
    float* out;
    unsigned char* ws;
    int ph_lo, ph_hi;
    int coop, pad;
};
typedef const __attribute__((address_space(4))) Params CParams;

__device__ __forceinline__ u16 f2bf(float f) {
    unsigned u = __builtin_bit_cast(unsigned, f);
    return (u16)((u + 0x7fffu + ((u >> 16) & 1u)) >> 16);
}
__device__ __forceinline__ float bf2f(u16 h) { return __builtin_bit_cast(float, (unsigned)h << 16); }
__device__ __forceinline__ float sigm(float x) { return 1.f / (1.f + __expf(-x)); }
__device__ __forceinline__ float silu_f(float x) { return x * sigm(x); }
__device__ __forceinline__ float gelu_f(float x) {
    float u = 0.7978845608028654f * (x + 0.044715f * x * x * x);
    float t = 1.f - 2.f / (1.f + __expf(2.f * u));
    return 0.5f * x * (1.f + t);
}
__device__ __forceinline__ float wave_sum(float v) {
#pragma unroll
    for (int o = 32; o >= 1; o >>= 1) v += __shfl_xor(v, o);
    return v;
}
__device__ __forceinline__ int swz(int row, int ch) { return row * 128 + ((ch ^ ((row >> 1) & 7)) << 4); }


template <class T> __device__ __forceinline__ T ldg(const void* base, unsigned off) { return *(const T*)((const char*)base + off); }
template <class T> __device__ __forceinline__ void stg(void* base, unsigned off, T v) { *(T*)((char*)base + off) = v; }

template <int TM, int TN, int RW, int CW, class F>
__device__ __forceinline__ void epi(f32x4 (&acc)[TM][TN], int wr, int wc, int fq, int fr, F f) {
#pragma unroll
    for (int m = 0; m < TM; ++m) {
#pragma unroll
        for (int j = 0; j < 4; ++j) {
#pragma unroll
            for (int n = 0; n < TN; ++n) f(wr * RW + m * 16 + fq * 4 + j, wc * CW + n * 16 + fr, acc[m][n][j]);
        }
        __builtin_amdgcn_sched_barrier(0);
    }
}

__device__ __forceinline__ int otid() { int t = threadIdx.x; asm volatile("" : "+v"(t)); return t; }

struct NoHook { __device__ __forceinline__ void operator()(int) const {} };

template <int BM, int BN, int WM, int WN, class AL, class BL, class HK>
__device__ __forceinline__ void mma_loop(f32x4 (&acc)[BM / WM / 16][BN / WN / 16], int nk, AL aload, BL bload, HK hook, char* lds) {
    constexpr int TM = BM / WM / 16, TN = BN / WN / 16;
    constexpr int ACH = BM / 32, BCH = BN / 32;
    const int tid = otid(), lane = tid & 63, wid = tid >> 6;
    const int wr = wid / WN, wc = wid % WN, fr = lane & 15, fq = lane >> 4;
    const int srow = tid >> 3, sk = (tid & 7) * 8;
    const int swr = srow * 128 + (((tid & 7) ^ ((tid >> 4) & 7)) << 4);
    const int xr = (fr >> 1) & 7;
    const int a_rd = (wr * (BM / WM) + fr) * 128;
    const int b_rd = BM * 128 + (wc * (BN / WN) + fr) * 128;
    bf16x8 ra[ACH], rb[BCH];
#pragma unroll
    for (int i = 0; i < ACH; ++i) ra[i] = aload(srow + i * 32, sk);
#pragma unroll
    for (int i = 0; i < BCH; ++i) rb[i] = bload(srow + i * 32, sk);
#pragma unroll 1
    for (int t = 0; t < nk; ++t) {
        __syncthreads();
#pragma unroll
        for (int i = 0; i < ACH; ++i) *(bf16x8*)(lds + swr + i * 4096) = ra[i];
#pragma unroll
        for (int i = 0; i < BCH; ++i) *(bf16x8*)(lds + BM * 128 + swr + i * 4096) = rb[i];
        __syncthreads();
        if (t + 1 < nk) {
#pragma unroll
            for (int i = 0; i < ACH; ++i) ra[i] = aload(srow + i * 32, (t + 1) * 64 + sk);
#pragma unroll
            for (int i = 0; i < BCH; ++i) rb[i] = bload(srow + i * 32, (t + 1) * 64 + sk);
        }
        hook(t);
#pragma unroll
        for (int ks = 0; ks < 2; ++ks) {
            const int co = ((ks * 4 + fq) ^ xr) << 4;
            bf16x8 af[TM], bfr[TN];
#pragma unroll
            for (int m = 0; m < TM; ++m) af[m] = *(const bf16x8*)(lds + a_rd + m * 2048 + co);
#pragma unroll
            for (int n = 0; n < TN; ++n) bfr[n] = *(const bf16x8*)(lds + b_rd + n * 2048 + co);
#pragma unroll
            for (int m = 0; m < TM; ++m)
#pragma unroll
                for (int n = 0; n < TN; ++n) acc[m][n] = __builtin_amdgcn_mfma_f32_16x16x32_bf16(af[m], bfr[n], acc[m][n], 0, 0, 0);
        }
    }
}

template <int BM, int BN, int WM, int WN, class AO, class BO, class HK>
__device__ __forceinline__ void mma_glds(f32x4 (&acc)[BM / WM / 16][BN / WN / 16], int nk, const unsigned char* ws, AO aoff, BO boff, HK hook, char* lds) {
    constexpr int TM = BM / WM / 16, TN = BN / WN / 16;
    constexpr int ACH = BM / 32, BCH = BN / 32, BUF = (BM + BN) * 128;
    const int tid = otid(), lane = tid & 63, wid = tid >> 6;
    const int wr = wid / WN, wc = wid % WN, fr = lane & 15, fq = lane >> 4;
    const int srow = tid >> 3;
    const unsigned csrc = (unsigned)(((tid & 7) ^ ((tid >> 4) & 7)) << 4);
    const int xr = (fr >> 1) & 7;
    const int a_rd = (wr * (BM / WM) + fr) * 128;
    const int b_rd = BM * 128 + (wc * (BN / WN) + fr) * 128;
    auto stage = [&](int buf, int t) {
        char* d = lds + buf * BUF + tid * 16;
#pragma unroll
        for (int i = 0; i < ACH; ++i)
            __builtin_amdgcn_global_load_lds((const unsigned*)(ws + (aoff(srow + i * 32, t) + csrc)), (unsigned*)(d + i * 4096), 16, 0, 0);
#pragma unroll
        for (int i = 0; i < BCH; ++i)
            __builtin_amdgcn_global_load_lds((const unsigned*)(ws + (boff(srow + i * 32, t) + csrc)), (unsigned*)(d + BM * 128 + i * 4096), 16, 0, 0);
    };
    __syncthreads();
    stage(0, 0);
#pragma unroll 1
    for (int t = 0; t < nk; ++t) {
        asm volatile("s_waitcnt vmcnt(0)" ::: "memory");
        __syncthreads();
        if (t + 1 < nk) stage((t + 1) & 1, t + 1);
        hook(t);
        const char* bb = lds + (t & 1) * BUF;
#pragma unroll
        for (int ks = 0; ks < 2; ++ks) {
            const int co = ((ks * 4 + fq) ^ xr) << 4;
            bf16x8 af[TM], bfr[TN];
#pragma unroll
            for (int m = 0; m < TM; ++m) af[m] = *(const bf16x8*)(bb + a_rd + m * 2048 + co);
#pragma unroll
            for (int n = 0; n < TN; ++n) bfr[n] = *(const bf16x8*)(bb + b_rd + n * 2048 + co);
#pragma unroll
            for (int m = 0; m < TM; ++m)
#pragma unroll
                for (int n = 0; n < TN; ++n) acc[m][n] = __builtin_amdgcn_mfma_f32_16x16x32_bf16(af[m], bfr[n], acc[m][n], 0, 0, 0);
        }
    }
}

#define ZERO_ACC(acc, TM, TN) _Pragma("unroll") for (int m_ = 0; m_ < TM; ++m_) _Pragma("unroll") for (int n_ = 0; n_ < TN; ++n_) acc[m_][n_] = f32x4{0.f, 0.f, 0.f, 0.f}

#define LANE_IDS const int tid = otid(), lane = tid & 63, wid = tid >> 6, fr = lane & 15, fq = lane >> 4; (void)tid; (void)lane; (void)wid; (void)fr; (void)fq

__device__ void conv_tile(const float* s1, const float* s2, int ldsrc, int K, int perm, u16* dst, int tile, float* lds) {
    const int tid = otid();
    const int ktiles = K >> 6;
    const int kt = tile % ktiles, nt = tile / ktiles;
    __syncthreads();
#pragma unroll 4
    for (int i = 0; i < 16; ++i) {
        int idx = tid + i * 256, kr = idx >> 6, nc = idx & 63;
        const float* s; int col;
        if (perm) { s = (nc < 32) ? s1 : s2; col = nt * 32 + (nc & 31); } else { s = s1; col = nt * 64 + nc; }
        lds[kr * 65 + nc] = s[(size_t)(kt * 64 + kr) * ldsrc + col];
    }
    __syncthreads();
#pragma unroll 4
    for (int i = 0; i < 16; ++i) {
        int idx = tid + i * 256, nr = idx >> 6, kc = idx & 63;
        dst[(size_t)(nt * 64 + nr) * K + kt * 64 + kc] = f2bf(lds[kc * 65 + nr]);
    }
}

__device__ void s5_precompute(CParams& p, int l, int g, float* lds) {
    const int tid = otid();
    float* Er = lds;
    float* Ei = Er + 64 * 17;
    float* Br = Ei + 64 * 17;
    float* Bi = Br + 1024;
    float* Cr = Bi + 1024;
    float* Ci = Cr + 1024;
    float* Kt = Ci + 1024;
    __syncthreads();
    const int lg = l * 32 + g;
    const float dt = expf(p.in[12][lg]);
    {
        const int pp = tid & 63, part = tid >> 6;
        const float ar = p.in[5][lg * 64 + pp], ai = p.in[6][lg * 64 + pp];
        for (int tau = part; tau <= 16; tau += 4) {
            float mag = expf((float)tau * ar * dt);
            float ang = (float)tau * ai * dt;
            Er[pp * 17 + tau] = mag * cosf(ang);
            Ei[pp * 17 + tau] = mag * sinf(ang);
        }
        float mag = expf(ar * dt), ang = ai * dt;
        float e1r = mag * cosf(ang) - 1.f, e1i = mag * sinf(ang);
        float den = ar * ar + ai * ai;
        float qr = (e1r * ar + e1i * ai) / den, qi = (e1i * ar - e1r * ai) / den;
        for (int c = part * 4; c < part * 4 + 4; ++c) {
            float br = p.in[7][((size_t)lg * 64 + pp) * 16 + c], bi = p.in[8][((size_t)lg * 64 + pp) * 16 + c];
            Br[pp * 16 + c] = qr * br - qi * bi;
            Bi[pp * 16 + c] = qr * bi + qi * br;
            Cr[c * 64 + pp] = p.in[9][((size_t)lg * 16 + c) * 64 + pp];
            Ci[c * 64 + pp] = p.in[10][((size_t)lg * 16 + c) * 64 + pp];
        }
    }
    __syncthreads();
    for (int i = 0; i < 16; ++i) {
        int idx = tid + i * 256, tau = idx >> 8, ch = (idx >> 4) & 15, c2 = idx & 15;
        float s = 0.f;
        for (int pp = 0; pp < 64; ++pp) {
            float cr = Cr[ch * 64 + pp], ci = Ci[ch * 64 + pp], er = Er[pp * 17 + tau], ei = Ei[pp * 17 + tau];
            float gr = cr * er - ci * ei, gi = cr * ei + ci * er;
            s += gr * Br[pp * 16 + c2] - gi * Bi[pp * 16 + c2];
        }
        Kt[idx] = s;
    }
    __syncthreads();
    u16* bta = (u16*)(p.ws + OFF_BTA) + (size_t)g * 128 * 256;
    for (int i = 0; i < 128; ++i) {
        int idx = tid + i * 256, pr = idx >> 8, k = idx & 255, s = k >> 4, ch = k & 15, pp = pr & 63;
        float er = Er[pp * 17 + 15 - s], ei = Ei[pp * 17 + 15 - s], br = Br[pp * 16 + ch], bi = Bi[pp * 16 + ch];
        float v = (pr < 64) ? (er * br - ei * bi) : (er * bi + ei * br);
        bta[idx] = f2bf(v);
    }
    u16* btc = (u16*)(p.ws + OFF_BTC) + (size_t)g * 256 * 384;
    for (int i = 0; i < 384; ++i) {
        int idx = tid + i * 256, n = idx / 384, k = idx - n * 384, j = n >> 4, ch = n & 15;
        float v;
        if (k < 256) {
            int s = k >> 4, c2 = k & 15;
            v = (s <= j) ? Kt[((j - s) * 16 + ch) * 16 + c2] : 0.f;
        } else {
            int pr = k - 256, pp = pr & 63;
            float cr = Cr[ch * 64 + pp], ci = Ci[ch * 64 + pp], er = Er[pp * 17 + j + 1], ei = Ei[pp * 17 + j + 1];
            float gr = cr * er - ci * ei, gi = cr * ei + ci * er;
            v = (pr < 64) ? gr : -gi;
        }
        btc[idx] = f2bf(v);
    }
}

constexpr int W_CONV_TILES = 2608;
__device__ void phase_w(CParams& p, int l, char* lds) {
    const int tid = otid();
    const int nunits = W_CONV_TILES + 32 + 1 + (l == 0 ? 1024 : 0);
    for (int u = blockIdx.x; u < nunits; u += gridDim.x) {
        if (u < W_CONV_TILES) {
            int t = u;
            const float *s1, *s2 = nullptr; int ld, K, perm = 0; u16* dst;
            if (t < 1664) { s1 = p.in[1] + (size_t)l * DM * INC; ld = INC; K = 1024; dst = (u16*)(p.ws + OFF_WINT); }
            else if ((t -= 1664) < 384) { int k = t >> 7; t &= 127; s1 = p.in[22] + (size_t)(l * 3 + k) * 512 * 1024; ld = 1024; K = 512; dst = (u16*)(p.ws + OFF_WBRT) + (size_t)k * 1024 * 512; }
            else if ((t -= 384) < 256) { s1 = p.in[23] + (size_t)l * 1024 * 1024; ld = 1024; K = 1024; dst = (u16*)(p.ws + OFF_WOUTT); }
            else if ((t -= 256) < 64) { s1 = p.in[13] + (size_t)l * 512 * 512; ld = 512; K = 512; dst = (u16*)(p.ws + OFF_GLUT); }
            else if ((t -= 64) < 32) { int h = t >> 3; t &= 7; s1 = p.in[17] + (size_t)(l * 4 + h) * 128 * 128; s2 = p.in[19] + (size_t)(l * 4 + h) * 128 * 128; ld = 128; K = 128; perm = 1; dst = (u16*)(p.ws + OFF_RGT) + (size_t)h * 256 * 128; }
            else if ((t -= 32) < 128) { s1 = p.in[31] + (size_t)l * 1024 * 256; s2 = p.in[32] + (size_t)l * 1024 * 256; ld = 256; K = 1024; perm = 1; dst = (u16*)(p.ws + OFF_SH13T); }
            else if ((t -= 128) < 64) { s1 = p.in[33] + (size_t)l * 256 * 1024; ld = 1024; K = 256; dst = (u16*)(p.ws + OFF_SH2T); }
            else { t -= 64; s1 = p.in[26] + (size_t)l * 1024 * 64; ld = 64; K = 1024; dst = (u16*)(p.ws + OFF_ROUTT); }
            conv_tile(s1, s2, ld, K, perm, dst, t, (float*)lds);
        } else if (u < W_CONV_TILES + 32) {
            s5_precompute(p, l, u - W_CONV_TILES, (float*)lds);
        } else if (u == W_CONV_TILES + 32) {
            float* LB = (float*)(p.ws + OFF_LB);
            for (int c = tid; c < 512; c += 256) {
                float x0 = p.in[3][c], x1 = p.in[3][512 + c];
                LB[c] = (l == 0) ? 0.f : 1.f / (1.f + expf(x0 - x1));
            }
            if (tid < 64) ((int*)(p.ws + OFF_CUR))[tid] = 0;
        } else {
            int r0 = (u - (W_CONV_TILES + 33)) * 16;
            const float4* src = (const float4*)(p.in[0] + (size_t)r0 * DM);
            uint2* dst = (uint2*)((u16*)(p.ws + OFF_XB) + (size_t)r0 * DM);
            for (int i = tid; i < 16 * 256; i += 256) {
                float4 v = src[i];
                uint2 o; o.x = f2bf(v.x) | ((unsigned)f2bf(v.y) << 16); o.y = f2bf(v.z) | ((unsigned)f2bf(v.w) << 16);
                dst[i] = o;
            }
        }
    }
}

__device__ void phase_proj(CParams& p, int l, char* lds) {
    LANE_IDS;
    const int wr = wid >> 1, wc = wid & 1;
    unsigned char* ws = p.ws;
    const float* bg = p.in[2] + (size_t)l * 3072;
    const int ntn = INC / 128;
    for (int u = blockIdx.x; u < 128 * ntn; u += gridDim.x) {
        const int xcd = u & 7, jx = u >> 3, sup = xcd * 2 + jx / (8 * ntn), jj = jx % (8 * ntn);
        const int tm = sup * 8 + (jj & 7), tn = jj >> 3, row0 = tm * 128, col0 = tn * 128;
        f32x4 acc[4][4]; ZERO_ACC(acc, 4, 4);
        mma_glds<128, 128, 2, 2>(acc, 16, ws,
            [&](int r, int t) { return (unsigned)(OFF_XB + ((row0 + r) * DM + t * 64) * 2); },
            [&](int c, int t) { return (unsigned)(OFF_WINT + ((col0 + c) * DM + t * 64) * 2); }, NoHook(), lds);
        const int seg = col0 >> 9;
        if (seg == 0) epi<4, 4, 64, 64>(acc, wr, wc, fq, fr, [&](int r, int cc, float v) {
            stg<u16>(ws, (unsigned)(OFF_PQ + ((row0 + r) * 512 + ((col0 + cc) & 511)) * 2), f2bf(silu_f(v))); });
        else if (seg == 1) epi<4, 4, 64, 64>(acc, wr, wc, fq, fr, [&](int r, int cc, float v) {
            const int c = (col0 + cc) & 511;
            const float lb = ldg<float>(ws, (unsigned)(OFF_LB + c * 4)), sg = sigm(v);
            const float f = lb + (1.f - lb) * sg;
            stg<float>(ws, (unsigned)(OFF_PLF + ((row0 + r) * 512 + c) * 4), logf(f));
            stg<u16>(ws, (unsigned)(OFF_PK + ((row0 + r) * 512 + c) * 2), f2bf((1.f - lb) * (1.f - sg))); });
        else if (seg == 2) epi<4, 4, 64, 64>(acc, wr, wc, fq, fr, [&](int r, int cc, float v) {
            stg<u16>(ws, (unsigned)(OFF_PV + ((row0 + r) * 512 + ((col0 + cc) & 511)) * 2), f2bf(v)); });
        else if (seg == 3) epi<4, 4, 64, 64>(acc, wr, wc, fq, fr, [&](int r, int cc, float v) {
            stg<u16>(ws, (unsigned)(OFF_PG + ((row0 + r) * 512 + ((col0 + cc) & 511)) * 2), f2bf(silu_f(v))); });
        else if (seg == 4) epi<4, 4, 64, 64>(acc, wr, wc, fq, fr, [&](int r, int cc, float v) {
            const int c = (col0 + cc) & 511;
            stg<u16>(ws, (unsigned)(OFF_PU + (((c >> 4) * NTOK + row0 + r) * 16 + (c & 15)) * 2), f2bf(v)); });
        else if (seg == 5) epi<4, 4, 64, 64>(acc, wr, wc, fq, fr, [&](int r, int cc, float v) {
            stg<u16>(ws, (unsigned)(OFF_PXG + ((row0 + r) * 512 + ((col0 + cc) & 511)) * 2), f2bf(gelu_f(v))); });
        else if (seg == 6) epi<4, 4, 64, 64>(acc, wr, wc, fq, fr, [&](int r, int cc, float v) {
            stg<u16>(ws, (unsigned)(OFF_PXR + ((row0 + r) * 512 + ((col0 + cc) & 511)) * 2), f2bf(v)); });
        else epi<4, 4, 64, 64>(acc, wr, wc, fq, fr, [&](int r, int cc, float v) {
            const int gc = col0 + cc - 3584;
            stg<u16>(ws, (unsigned)(OFF_PGATE + ((row0 + r) * 3072 + gc) * 2), f2bf(sigm(v + bg[gc]))); });
    }
}

__device__ void hgrn_prep(CParams& p, int u) {
    const int tid = otid();
    const int h = u & 3, c = (u >> 2) & 63, b = u >> 8;
    const int r0 = b * SEQ + c * 64;
    const size_t cu = (size_t)((b * 4 + h) * 64 + c);
    if (tid < 128) {
        const int d = tid;
        float* lf = (float*)(p.ws + OFF_PLF) + (size_t)r0 * 512 + h * 128 + d;
        const u16* kk = (const u16*)(p.ws + OFF_PK) + (size_t)r0 * 512 + h * 128 + d;
        float bs[64];
#pragma unroll
        for (int s = 0; s < 64; ++s) bs[s] = lf[(size_t)s * 512];
        float run = 0.f;
#pragma unroll
        for (int s = 0; s < 64; ++s) { run += bs[s]; bs[s] = run; lf[(size_t)s * 512] = run; }
        const float btot = run;
        ((float*)(p.ws + OFF_DEC))[(size_t)(b * 64 + c) * 512 + h * 128 + d] = __expf(btot);
        u16* dst = (u16*)(p.ws + OFF_KTT) + (cu * 128 + d) * 64;
#pragma unroll
        for (int s8 = 0; s8 < 8; ++s8) {
            bf16x8 o;
#pragma unroll
            for (int e = 0; e < 8; ++e) {
                int s = s8 * 8 + e;
                o[e] = (short)f2bf(bf2f(kk[(size_t)s * 512]) * __expf(btot - bs[s]));
            }
            *(bf16x8*)(dst + s8 * 8) = o;
        }
    } else {
        const int v = tid - 128;
        const u16* vv = (const u16*)(p.ws + OFF_PV) + (size_t)r0 * 512 + h * 128 + v;
        u16* dst = (u16*)(p.ws + OFF_VT) + (cu * 128 + v) * 64;
#pragma unroll
        for (int s8 = 0; s8 < 8; ++s8) {
            bf16x8 o;
#pragma unroll
            for (int e = 0; e < 8; ++e) o[e] = (short)vv[(size_t)(s8 * 8 + e) * 512];
            *(bf16x8*)(dst + s8 * 8) = o;
        }
    }
}

__device__ void s5_gemm_a(CParams& p, int u, char* lds) {
    LANE_IDS;
    const int wr = wid >> 1, wc = wid & 1;
    const int g = u >> 3, tm = u & 7, row0 = tm * 128;
    unsigned char* ws = p.ws;
    const unsigned aoff = (unsigned)(OFF_PU + (size_t)g * NTOK * 16 * 2), boff = (unsigned)(OFF_BTA + (size_t)g * 128 * 256 * 2);
    f32x4 acc[4][4]; ZERO_ACC(acc, 4, 4);
    mma_glds<128, 128, 2, 2>(acc, 4, ws,
        [&](int r, int t) { return aoff + ((row0 + r) * 256 + t * 64) * 2; },
        [&](int c, int t) { return boff + (c * 256 + t * 64) * 2; }, NoHook(), lds);
    epi<4, 4, 64, 64>(acc, wr, wc, fq, fr, [&](int r, int cc, float v) {
        stg<float>(ws, (unsigned)(OFF_VC + (((row0 + r) * 32 + g) * 128 + cc) * 4), v); });
}

__device__ void rg_conv(CParams& p, int l, int u) {
    const int tid = otid();
    const u16* xr = (const u16*)(p.ws + OFF_PXR);
    u16* xc = (u16*)(p.ws + OFF_XC);
    const float* cw = p.in[15] + (size_t)l * 4 * 512;
    const float* cb = p.in[16] + (size_t)l * 512;
    for (int i = tid; i < 64 * 64; i += 256) {
        const int row = u * 64 + (i >> 6), c8 = (i & 63) * 8;
        const int t = row & (SEQ - 1);
        float a[8];
#pragma unroll
        for (int e = 0; e < 8; ++e) a[e] = cb[c8 + e];
#pragma unroll
        for (int j = 0; j < 4; ++j) {
            if (t - 3 + j >= 0) {
                bf16x8 x = *(const bf16x8*)(xr + (size_t)(row - 3 + j) * 512 + c8);
#pragma unroll
                for (int e = 0; e < 8; ++e) a[e] += cw[j * 512 + c8 + e] * bf2f((u16)x[e]);
            }
        }
        bf16x8 o;
#pragma unroll
        for (int e = 0; e < 8; ++e) o[e] = (short)f2bf(a[e]);
        *(bf16x8*)(xc + (size_t)row * 512 + c8) = o;
    }
}

__device__ void phase2(CParams& p, int l, char* lds) {
    for (int u = blockIdx.x; u < 1536; u += gridDim.x) {
        if (u < 1024) hgrn_prep(p, u);
        else if (u < 1280) s5_gemm_a(p, u - 1024, lds);
        else rg_conv(p, l, u - 1280);
    }
}

__device__ void hgrn_state(CParams& p, int u, char* lds) {
    LANE_IDS;
    const int wr = wid >> 1, wc = wid & 1;
    const int vh = u & 1, bh = u >> 1, b = bh >> 2, h = bh & 3;
    u16* ST = (u16*)(p.ws + OFF_ST) + (size_t)bh * 64 * 128 * 128;
    const float* Dec = (const float*)(p.ws + OFF_DEC) + (size_t)b * 64 * 512 + h * 128;
    f32x4 acc[4][2]; ZERO_ACC(acc, 4, 2);
    auto hook = [&](int t) {
        const float* dc = Dec + (size_t)t * 512;
#pragma unroll
        for (int m = 0; m < 4; ++m) {
            const int d0 = wr * 64 + m * 16 + fq * 4;
            const float4 dv = *(const float4*)(dc + d0);
#pragma unroll
            for (int n = 0; n < 2; ++n) {
                const int v = vh * 64 + wc * 32 + n * 16 + fr;
                uint2 o;
                o.x = f2bf(acc[m][n][0]) | ((unsigned)f2bf(acc[m][n][1]) << 16);
                o.y = f2bf(acc[m][n][2]) | ((unsigned)f2bf(acc[m][n][3]) << 16);
                *(uint2*)(ST + ((size_t)t * 128 + v) * 128 + d0) = o;
                acc[m][n][0] *= dv.x; acc[m][n][1] *= dv.y; acc[m][n][2] *= dv.z; acc[m][n][3] *= dv.w;
            }
        }
    };
    mma_glds<128, 64, 2, 2>(acc, 64, p.ws,
        [&](int r, int t) { return (unsigned)(OFF_KTT + (((bh * 64 + t) * 128 + r) * 64) * 2); },
        [&](int c, int t) { return (unsigned)(OFF_VT + (((bh * 64 + t) * 128 + vh * 64 + c) * 64) * 2); }, hook, lds);
}

__device__ void s5_scan(CParams& p, int l, int u) {
    const int tid = otid();
    const int b = u >> 3, g = (u & 7) * 4 + (tid >> 6), pp = tid & 63;
    const int lg = l * 32 + g;
    const float dt = expf(p.in[12][lg]);
    const float ar = p.in[5][lg * 64 + pp], ai = p.in[6][lg * 64 + pp];
    const float mag = expf(16.f * ar * dt), ang = 16.f * ai * dt;
    const float er = mag * cosf(ang), ei = mag * sinf(ang);
    const float* Vc = (const float*)(p.ws + OFF_VC) + ((size_t)(b * 256) * 32 + g) * 128 + pp;
    u16* Hc = (u16*)(p.ws + OFF_HC) + ((size_t)(b * 256) * 32 + g) * 128 + pp;
    float hr = 0.f, hi = 0.f;
    for (int c0 = 0; c0 < 256; c0 += 16) {
        float vr[16], vi[16];
#pragma unroll
        for (int i = 0; i < 16; ++i) { vr[i] = Vc[(size_t)(c0 + i) * 4096]; vi[i] = Vc[(size_t)(c0 + i) * 4096 + 64]; }
#pragma unroll
        for (int i = 0; i < 16; ++i) {
            Hc[(size_t)(c0 + i) * 4096] = f2bf(hr);
            Hc[(size_t)(c0 + i) * 4096 + 64] = f2bf(hi);
            float nr = er * hr - ei * hi + vr[i];
            float ni = er * hi + ei * hr + vi[i];
            hr = nr; hi = ni;
        }
    }
}

__device__ void rg_gemm(CParams& p, int l, int u, char* lds) {
    LANE_IDS;
    const int wr = wid >> 1, wc = wid & 1;
    const int tm = u >> 3, h = (u >> 1) & 3, nt = u & 1, row0 = tm * 128;
    unsigned char* ws = p.ws;
    const unsigned aoff = (unsigned)(OFF_XC + h * 128 * 2), boff = (unsigned)(OFF_RGT + ((size_t)h * 256 * 128 + (size_t)nt * 128 * 128) * 2);
    f32x4 acc[4][4]; ZERO_ACC(acc, 4, 4);
    mma_glds<128, 128, 2, 2>(acc, 2, ws,
        [&](int r, int t) { return aoff + ((row0 + r) * 512 + t * 64) * 2; },
        [&](int c, int t) { return boff + (c * 128 + t * 64) * 2; }, NoHook(), lds);
    const float* ba = p.in[18] + (size_t)l * 512;
    const float* bx = p.in[20] + (size_t)l * 512;
    const float* lam = p.in[21] + (size_t)l * 512;
#pragma unroll
    for (int n = 0; n < 2; ++n) {
        const int ch = h * 128 + (nt * 2 + wc) * 32 + n * 16 + fr;
        const float c1 = -8.f * log1pf(expf(-lam[ch]));
        const float bav = ba[ch], bxv = bx[ch];
#pragma unroll
        for (int m = 0; m < 4; ++m) {
#pragma unroll
            for (int j = 0; j < 4; ++j) {
                const int row = row0 + wr * 64 + m * 16 + fq * 4 + j;
                const float r = sigm(acc[m][n][j] + bav), ig = sigm(acc[m][n + 2][j] + bxv);
                const float la = c1 * r;
                const float x = bf2f(ldg<u16>(ws, (unsigned)(OFF_XC + (row * 512 + ch) * 2)));
                const float bb = sqrtf(fmaxf(1.f - __expf(2.f * la), 0.f)) * ig * x;
                stg<u16>(ws, (unsigned)(OFF_LA + (row * 512 + ch) * 2), f2bf(la));
                stg<u16>(ws, (unsigned)(OFF_BB + (row * 512 + ch) * 2), f2bf(bb));
            }
            __builtin_amdgcn_sched_barrier(0);
        }
    }
}

__device__ void phase3(CParams& p, int l, char* lds) {
    for (int u = blockIdx.x; u < 64 + 1024; u += gridDim.x) {
        if (u < 32) hgrn_state(p, u, lds);
        else if (u < 64) s5_scan(p, l, u - 32);
        else rg_gemm(p, l, u - 64, lds);
    }
}

__device__ void hgrn_out(CParams& p, int l, int u, char* lds) {
    LANE_IDS;
    const int h = u & 3, c = (u >> 2) & 63, b = u >> 8;
    const int r0 = b * SEQ + c * 64;
    const size_t cu = (size_t)((b * 4 + h) * 64 + c);
    const u16* Pq = (const u16*)(p.ws + OFF_PQ) + (size_t)r0 * 512 + h * 128;
    const u16* Pk = (const u16*)(p.ws + OFF_PK) + (size_t)r0 * 512 + h * 128;
    const float* Bc = (const float*)(p.ws + OFF_PLF) + (size_t)r0 * 512 + h * 128;
    char* Ss = lds + (64 + 128) * 128;
    __syncthreads();
    {
        const int i = wid;
        const int t = 16 * i + fr;
        bf16x8 aq[4];
        float refv[4][8];
#pragma unroll
        for (int kk = 0; kk < 4; ++kk) {
            const int d0 = kk * 32 + fq * 8;
            bf16x8 q8 = *(const bf16x8*)(Pq + (size_t)t * 512 + d0);
#pragma unroll
            for (int e = 0; e < 8; ++e) {
                float rf = (i == 0) ? 0.f : Bc[(size_t)(16 * i - 1) * 512 + d0 + e];
                refv[kk][e] = rf;
                float bt = Bc[(size_t)t * 512 + d0 + e];
                aq[kk][e] = (short)f2bf(bf2f((u16)q8[e]) * __expf(bt - rf));
            }
        }
#pragma unroll
        for (int j = 0; j < 4; ++j) {
            f32x4 sc = {0.f, 0.f, 0.f, 0.f};
            if (j <= i) {
                const int s = 16 * j + fr;
#pragma unroll
                for (int kk = 0; kk < 4; ++kk) {
                    const int d0 = kk * 32 + fq * 8;
                    bf16x8 k8 = *(const bf16x8*)(Pk + (size_t)s * 512 + d0);
                    bf16x8 bk;
#pragma unroll
                    for (int e = 0; e < 8; ++e) {
                        float bsv = Bc[(size_t)s * 512 + d0 + e];
                        bk[e] = (short)f2bf(bf2f((u16)k8[e]) * __expf(fminf(refv[kk][e] - bsv, 60.f)));
                    }
                    sc = __builtin_amdgcn_mfma_f32_16x16x32_bf16(aq[kk], bk, sc, 0, 0, 0);
                }
            }
#pragma unroll
            for (int r = 0; r < 4; ++r) {
                const int tl = fq * 4 + r, sl = fr;
                float v = sc[r];
                if (j > i || (j == i && sl > tl)) v = 0.f;
                const int row = 16 * i + tl, col = 16 * j + sl;
                *(u16*)(Ss + swz(row, col >> 3) + (col & 7) * 2) = f2bf(v);
            }
        }
    }
    __syncthreads();
    const u16* STc = (const u16*)(p.ws + OFF_ST) + cu * 128 * 128;
    const u16* VTc = (const u16*)(p.ws + OFF_VT) + cu * 128 * 64;
    f32x4 acc[1][8]; ZERO_ACC(acc, 1, 8);
    mma_loop<64, 128, 4, 1>(acc, 3,
        [&](int r, int k) {
            bf16x8 o;
            if (k < 128) {
                bf16x8 q8 = *(const bf16x8*)(Pq + (size_t)r * 512 + k);
                const float4 b0 = *(const float4*)(Bc + (size_t)r * 512 + k), b1 = *(const float4*)(Bc + (size_t)r * 512 + k + 4);
                o[0] = (short)f2bf(bf2f((u16)q8[0]) * __expf(b0.x)); o[1] = (short)f2bf(bf2f((u16)q8[1]) * __expf(b0.y));
                o[2] = (short)f2bf(bf2f((u16)q8[2]) * __expf(b0.z)); o[3] = (short)f2bf(bf2f((u16)q8[3]) * __expf(b0.w));
                o[4] = (short)f2bf(bf2f((u16)q8[4]) * __expf(b1.x)); o[5] = (short)f2bf(bf2f((u16)q8[5]) * __expf(b1.y));
                o[6] = (short)f2bf(bf2f((u16)q8[6]) * __expf(b1.z)); o[7] = (short)f2bf(bf2f((u16)q8[7]) * __expf(b1.w));
            } else {
                o = *(const bf16x8*)(Ss + swz(r, (k - 128) >> 3));
            }
            return o;
        },
        [&](int cc, int k) {
            return (k < 128) ? *(const bf16x8*)(STc + (size_t)cc * 128 + k) : *(const bf16x8*)(VTc + (size_t)cc * 64 + (k - 128));
        }, NoHook(), lds);
    const float* nw = p.in[4] + (size_t)l * 512 + h * 128;
    const u16* Pg = (const u16*)(p.ws + OFF_PG) + (size_t)r0 * 512 + h * 128;
    u16* Ya = (u16*)(p.ws + OFF_YA) + (size_t)r0 * 512 + h * 128;
#pragma unroll
    for (int j = 0; j < 4; ++j) {
        float ss = 0.f;
#pragma unroll
        for (int n = 0; n < 8; ++n) ss += acc[0][n][j] * acc[0][n][j];
        ss += __shfl_xor(ss, 1); ss += __shfl_xor(ss, 2); ss += __shfl_xor(ss, 4); ss += __shfl_xor(ss, 8);
        const float rs = rsqrtf(ss * (1.f / 128.f) + 1e-6f);
        const int row = wid * 16 + fq * 4 + j;
#pragma unroll
        for (int n = 0; n < 8; ++n) {
            const int v = n * 16 + fr;
            Ya[(size_t)row * 512 + v] = f2bf(acc[0][n][j] * rs * nw[v] * bf2f(Pg[(size_t)row * 512 + v]));
        }
    }
}

__device__ void s5_gemm_c(CParams& p, int l, int u, char* lds) {
    LANE_IDS;
    const int wr = wid >> 1, wc = wid & 1;
    const int g = u >> 4, tm = (u >> 1) & 7, tn = u & 1, row0 = tm * 128, col0 = tn * 128;
    unsigned char* ws = p.ws;
    const unsigned aoff = (unsigned)(OFF_PU + (size_t)g * NTOK * 16 * 2), boff = (unsigned)(OFF_BTC + (size_t)g * 256 * 384 * 2);
    f32x4 acc[4][4]; ZERO_ACC(acc, 4, 4);
    mma_glds<128, 128, 2, 2>(acc, 6, ws,
        [&](int r, int t) {
            return (t < 4) ? aoff + ((row0 + r) * 256 + t * 64) * 2 : (unsigned)(OFF_HC + (((row0 + r) * 32 + g) * 128 + (t - 4) * 64) * 2);
        },
        [&](int c, int t) { return boff + ((col0 + c) * 384 + t * 64) * 2; }, NoHook(), lds);
    const float dch = p.in[11][(size_t)l * 512 + g * 16 + fr];
    epi<4, 4, 64, 64>(acc, wr, wc, fq, fr, [&](int r, int cc, float v) {
        const int row = row0 + r, col = col0 + cc;
        const int jj = col >> 4, ch = col & 15;
        const int tok = (row >> 8) * SEQ + (row & 255) * 16 + jj;
        const float uu = bf2f(ldg<u16>(ws, aoff + (tok * 16 + ch) * 2));
        const float y = v + dch * uu;
        stg<u16>(ws, (unsigned)(OFF_YG + (tok * 512 + g * 16 + ch) * 2), f2bf(gelu_f(y))); });
}

__device__ void rg_scan(CParams& p, int u, char* lds) {
    const int tid = otid();
    const int b = u >> 5, c0 = (u & 31) * 16, seg = tid >> 4, ch = c0 + (tid & 15);
    const size_t base = (size_t)(b * SEQ + seg * 256) * 512 + ch;
    const u16* La = (const u16*)(p.ws + OFF_LA) + base;
    const u16* Bb = (const u16*)(p.ws + OFF_BB) + base;
    const u16* Xg = (const u16*)(p.ws + OFF_PXG) + base;
    u16* Yc = (u16*)(p.ws + OFF_YC) + base;
    float* sA = (float*)lds;
    float* sH = sA + 256;
    __syncthreads();
    float hh = 0.f, ap = 1.f;
    for (int s0 = 0; s0 < 256; s0 += 16) {
        float a[16], bb[16];
#pragma unroll
        for (int i = 0; i < 16; ++i) { a[i] = bf2f(La[(size_t)(s0 + i) * 512]); bb[i] = bf2f(Bb[(size_t)(s0 + i) * 512]); }
#pragma unroll
        for (int i = 0; i < 16; ++i) { float av = __expf(a[i]); hh = av * hh + bb[i]; ap *= av; }
    }
    sA[tid] = ap; sH[tid] = hh;
    __syncthreads();
    float cin = 0.f;
    for (int sg = 0; sg < seg; ++sg) cin = sA[sg * 16 + (tid & 15)] * cin + sH[sg * 16 + (tid & 15)];
    hh = cin;
    for (int s0 = 0; s0 < 256; s0 += 16) {
        float a[16], bb[16], xg[16];
#pragma unroll
        for (int i = 0; i < 16; ++i) { a[i] = bf2f(La[(size_t)(s0 + i) * 512]); bb[i] = bf2f(Bb[(size_t)(s0 + i) * 512]); xg[i] = bf2f(Xg[(size_t)(s0 + i) * 512]); }
#pragma unroll
        for (int i = 0; i < 16; ++i) { hh = __expf(a[i]) * hh + bb[i]; Yc[(size_t)(s0 + i) * 512] = f2bf(hh * xg[i]); }
    }
}

__device__ void phase4(CParams& p, int l, char* lds) {
    for (int u = blockIdx.x; u < 1664; u += gridDim.x) {
        if (u < 128) rg_scan(p, u, lds);
        else if (u < 1152) hgrn_out(p, l, u - 128, lds);
        else s5_gemm_c(p, l, u - 1152, lds);
    }
}

__device__ void phase_glu(CParams& p, int l, char* lds) {
    LANE_IDS;
    const int wr = wid >> 1, wc = wid & 1;
    unsigned char* ws = p.ws;
    const float* gb = p.in[14] + (size_t)l * 512;
    for (int u = blockIdx.x; u < 512; u += gridDim.x) {
        const int row0 = (u >> 2) * 128, col0 = (u & 3) * 128;
        f32x4 acc[4][4]; ZERO_ACC(acc, 4, 4);
        mma_glds<128, 128, 2, 2>(acc, 8, ws,
            [&](int r, int t) { return (unsigned)(OFF_YG + ((row0 + r) * 512 + t * 64) * 2); },
            [&](int c, int t) { return (unsigned)(OFF_GLUT + ((col0 + c) * 512 + t * 64) * 2); }, NoHook(), lds);
        epi<4, 4, 64, 64>(acc, wr, wc, fq, fr, [&](int r, int cc, float v) {
            const int row = row0 + r, col = col0 + cc;
            const float y = bf2f(ldg<u16>(ws, (unsigned)(OFF_YG + (row * 512 + col) * 2)));
            stg<u16>(ws, (unsigned)(OFF_YB + (row * 512 + col) * 2), f2bf(y * sigm(v + gb[col]))); });
    }
}

__device__ void phase_branch(CParams& p, int l, char* lds) {
    LANE_IDS;
    const int wr = wid >> 1, wc = wid & 1;
    unsigned char* ws = p.ws;
    for (int u = blockIdx.x; u < 2048; u += gridDim.x) {
        const int row0 = (u >> 4) * 128, col0 = (u & 15) * 64;
        f32x4 tot[4][2]; ZERO_ACC(tot, 4, 2);
#pragma unroll 1
        for (int kb = 0; kb < 3; ++kb) {
            const unsigned yoff = (unsigned)(kb == 0 ? OFF_YA : (kb == 1 ? OFF_YB : OFF_YC));
            const unsigned boff = (unsigned)(OFF_WBRT + (size_t)kb * 1024 * 512 * 2);
            f32x4 acc[4][2]; ZERO_ACC(acc, 4, 2);
            mma_glds<128, 64, 2, 2>(acc, 8, ws,
                [&](int r, int t) { return yoff + ((row0 + r) * 512 + t * 64) * 2; },
                [&](int c, int t) { return boff + ((col0 + c) * 512 + t * 64) * 2; }, NoHook(), lds);
#pragma unroll
            for (int m = 0; m < 4; ++m) {
#pragma unroll
                for (int j = 0; j < 4; ++j)
#pragma unroll
                    for (int n = 0; n < 2; ++n) {
                        const int row = row0 + wr * 64 + m * 16 + fq * 4 + j, col = col0 + wc * 32 + n * 16 + fr;
                        tot[m][n][j] += bf2f(ldg<u16>(ws, (unsigned)(OFF_PGATE + (row * 3072 + kb * 1024 + col) * 2))) * acc[m][n][j];
                    }
                __builtin_amdgcn_sched_barrier(0);
            }
        }
        epi<4, 2, 64, 32>(tot, wr, wc, fq, fr, [&](int r, int cc, float v) {
            stg<u16>(ws, (unsigned)(OFF_MIXP + ((row0 + r) * 1024 + col0 + cc) * 2), f2bf(v)); });
    }
}

__device__ void phase_out(CParams& p, int l, char* lds) {
    LANE_IDS;
    const int wr = wid >> 1, wc = wid & 1;
    unsigned char* ws = p.ws;
    const float* xres = (l == 0) ? p.in[0] : p.out;
    for (int u = blockIdx.x; u < 1024 + 12288; u += gridDim.x) {
        if (u < 1024) {
            const int row0 = (u >> 3) * 128, col0 = (u & 7) * 128;
            f32x4 acc[4][4]; ZERO_ACC(acc, 4, 4);
            mma_glds<128, 128, 2, 2>(acc, 16, ws,
                [&](int r, int t) { return (unsigned)(OFF_MIXP + ((row0 + r) * 1024 + t * 64) * 2); },
                [&](int c, int t) { return (unsigned)(OFF_WOUTT + ((col0 + c) * 1024 + t * 64) * 2); }, NoHook(), lds);
            epi<4, 4, 64, 64>(acc, wr, wc, fq, fr, [&](int r, int cc, float v) {
                const unsigned o = (unsigned)(((row0 + r) * 1024 + col0 + cc) * 4);
                stg<float>(ws, (unsigned)OFF_PRELN + o, DN_ALPHA * ldg<float>(xres, o) + v); });
        } else {
            const int t = u - 1024, e = t / 192, r = t % 192;
            if (r < 128)
                conv_tile(p.in[28] + (size_t)(l * 64 + e) * 1024 * 256, p.in[29] + (size_t)(l * 64 + e) * 1024 * 256, 256, 1024, 1,
                          (u16*)(p.ws + OFF_EW13) + (size_t)e * 512 * 1024, r, (float*)lds);
            else
                conv_tile(p.in[30] + (size_t)(l * 64 + e) * 256 * 1024, nullptr, 1024, 256, 0,
                          (u16*)(p.ws + OFF_EW2) + (size_t)e * 1024 * 256, r - 128, (float*)lds);
        }
    }
}

__device__ __forceinline__ void ln_row(float (&v)[16], const float* g, const float* bta, int lane) {
    float s = 0.f;
#pragma unroll
    for (int i = 0; i < 16; ++i) s += v[i];
    const float mu = wave_sum(s) * (1.f / 1024.f);
    float q = 0.f;
#pragma unroll
    for (int i = 0; i < 16; ++i) { float d = v[i] - mu; q += d * d; }
    const float rs = rsqrtf(wave_sum(q) * (1.f / 1024.f) + 1e-5f);
#pragma unroll
    for (int i = 0; i < 4; ++i) {
        const float4 gg = *(const float4*)(g + i * 256 + lane * 4), bb = *(const float4*)(bta + i * 256 + lane * 4);
        v[i * 4 + 0] = (v[i * 4 + 0] - mu) * rs * gg.x + bb.x;
        v[i * 4 + 1] = (v[i * 4 + 1] - mu) * rs * gg.y + bb.y;
        v[i * 4 + 2] = (v[i * 4 + 2] - mu) * rs * gg.z + bb.z;
        v[i * 4 + 3] = (v[i * 4 + 3] - mu) * rs * gg.w + bb.w;
    }
}

__device__ void phase_route(CParams& p, int l, char* lds) {
    LANE_IDS;
    const float* Pre = (const float*)(p.ws + OFF_PRELN);
    u16* Xm = (u16*)(p.ws + OFF_XM);
    const float* g1 = p.in[24] + (size_t)l * 1024;
    const float* b1 = p.in[25] + (size_t)l * 1024;
    const float* rbias = p.in[27] + (size_t)l * 64;
    int* cursor = (int*)(p.ws + OFF_CUR);
    int* list = (int*)(p.ws + OFF_LIST);
    float* tkw = (float*)(p.ws + OFF_TKW);
    float* Ls = (float*)(lds + 32768);
    int* hist = (int*)(lds + 32768 + 64 * 65 * 4);
    int* basep = hist + 64;
    for (int u = blockIdx.x; u < 256; u += gridDim.x) {
        const int row0 = u * 64;
        for (int rr = 0; rr < 16; ++rr) {
            const int row = row0 + wid * 16 + rr;
            float v[16];
#pragma unroll
            for (int i = 0; i < 4; ++i) {
                const float4 x = *(const float4*)(Pre + (size_t)row * 1024 + i * 256 + lane * 4);
                v[i * 4] = x.x; v[i * 4 + 1] = x.y; v[i * 4 + 2] = x.z; v[i * 4 + 3] = x.w;
            }
            ln_row(v, g1, b1, lane);
#pragma unroll
            for (int i = 0; i < 4; ++i) {
                uint2 o; o.x = f2bf(v[i * 4]) | ((unsigned)f2bf(v[i * 4 + 1]) << 16); o.y = f2bf(v[i * 4 + 2]) | ((unsigned)f2bf(v[i * 4 + 3]) << 16);
                *(uint2*)(Xm + (size_t)row * 1024 + i * 256 + lane * 4) = o;
            }
        }
        if (tid < 64) hist[tid] = 0;
        __syncthreads();
        f32x4 acc[1][4]; ZERO_ACC(acc, 1, 4);
        mma_glds<64, 64, 4, 1>(acc, 16, p.ws,
            [&](int r, int t) { return (unsigned)(OFF_XM + ((row0 + r) * 1024 + t * 64) * 2); },
            [&](int c, int t) { return (unsigned)(OFF_ROUTT + (c * 1024 + t * 64) * 2); }, NoHook(), lds);
#pragma unroll
        for (int n = 0; n < 4; ++n)
#pragma unroll
            for (int j = 0; j < 4; ++j) {
                const int r = wid * 16 + fq * 4 + j, e = n * 16 + fr;
                Ls[r * 65 + e] = sigm(acc[0][n][j]) + rbias[e];
            }
        __syncthreads();
        int myrank[8]; int myexp[8];
        if (tid < 64) {
            float* sc = Ls + tid * 65;
            float gs[8];
#pragma unroll
            for (int g = 0; g < 8; ++g) {
                float m1 = -1e30f, m2 = -1e30f;
#pragma unroll
                for (int i = 0; i < 8; ++i) { float x = sc[g * 8 + i]; if (x > m1) { m2 = m1; m1 = x; } else if (x > m2) m2 = x; }
                gs[g] = m1 + m2;
            }
            unsigned gmask = 0;
#pragma unroll
            for (int it = 0; it < 4; ++it) {
                float best = -1e30f; int bi = 0;
#pragma unroll
                for (int g = 0; g < 8; ++g) { bool ok = !((gmask >> g) & 1u) && gs[g] > best; if (ok) { best = gs[g]; bi = g; } }
                gmask |= 1u << bi;
            }
            unsigned long long chosen = 0ull;
            float wsum = 0.f; float wv[8];
#pragma unroll
            for (int k = 0; k < 8; ++k) {
                float best = -1e30f; int bi = 0;
                for (int e = 0; e < 64; ++e) {
                    float x = sc[e];
                    bool ok = ((gmask >> (e >> 3)) & 1u) && !((chosen >> e) & 1ull) && x > best;
                    if (ok) { best = x; bi = e; }
                }
                chosen |= 1ull << bi;
                myexp[k] = bi;
                wv[k] = best - rbias[bi];
                wsum += wv[k];
            }
            const float sc_ = 2.5f / wsum;
#pragma unroll
            for (int k = 0; k < 8; ++k) {
                tkw[(size_t)(row0 + tid) * 8 + k] = wv[k] * sc_;
                myrank[k] = atomicAdd(&hist[myexp[k]], 1);
            }
        }
        __syncthreads();
        if (tid < 64) basep[tid] = atomicAdd(&cursor[tid], hist[tid]);
        __syncthreads();
        if (tid < 64) {
#pragma unroll
            for (int k = 0; k < 8; ++k) list[(size_t)myexp[k] * NTOK + basep[myexp[k]] + myrank[k]] = (row0 + tid) * 8 + k;
        }
        __syncthreads();
    }
}

struct MoeMap { int e, lb, cnt, off; };
__device__ __forceinline__ void moe_setup(CParams& p, int* sm) {
    if (otid() == 0) {
        const int* cursor = (const int*)(p.ws + OFF_CUR);
        int nb = 0, nr = 0;
        for (int e = 0; e < 64; ++e) { sm[e] = nb; sm[65 + e] = nr; int c = cursor[e]; nb += (c + 127) >> 7; nr += c; }
        sm[64] = nb; sm[129] = nr;
    }
    __syncthreads();
}
__device__ __forceinline__ MoeMap moe_map(CParams& p, const int* sm, int blk) {
    MoeMap m;
    const int nbr = sm[64];
    if (blk >= nbr) { m.e = 64; m.lb = blk - nbr; m.cnt = NTOK; m.off = 0; return m; }
    int e = 0;
    for (int i = 0; i < 64; ++i) if (sm[i] <= blk && sm[i + 1] > blk) e = i;
    m.e = e; m.lb = blk - sm[e]; m.cnt = ((const int*)(p.ws + OFF_CUR))[e]; m.off = sm[65 + e];
    return m;
}

__device__ void phase_moe1(CParams& p, int l, char* lds) {
    LANE_IDS;
    const int wr = wid >> 1, wc = wid & 1;
    int* sm = (int*)(lds + L_SM);
    __syncthreads();
    moe_setup(p, sm);
    const int nblk = sm[64] + 128;
    unsigned char* ws = p.ws;
    const int* list = (const int*)(p.ws + OFF_LIST);
    int* rowtok = (int*)(lds + L_ROW);
    for (int u = blockIdx.x; u < nblk * 4; u += gridDim.x) {
        const int blk = u >> 2, nt = u & 3;
        const MoeMap mm = moe_map(p, sm, blk);
        const int valid = min(128, mm.cnt - mm.lb * 128);
        __syncthreads();
        if (tid < 128) {
            int tok;
            if (mm.e == 64) tok = mm.lb * 128 + tid;
            else tok = (tid < valid) ? (list[(size_t)mm.e * NTOK + mm.lb * 128 + tid] >> 3) : 0;
            rowtok[tid] = tok;
        }
        __syncthreads();
        const unsigned boff = (unsigned)(((mm.e == 64) ? OFF_SH13T : OFF_EW13 + (size_t)mm.e * 512 * 1024 * 2) + (size_t)nt * 128 * 1024 * 2);
        f32x4 acc[4][4]; ZERO_ACC(acc, 4, 4);
        mma_glds<128, 128, 2, 2>(acc, 16, ws,
            [&](int r, int t) { return (unsigned)(OFF_XM + (rowtok[r] * 1024 + t * 64) * 2); },
            [&](int c, int t) { return boff + (c * 1024 + t * 64) * 2; }, NoHook(), lds);
        const unsigned hoff = (unsigned)((mm.e == 64) ? OFF_HSH + (size_t)mm.lb * 128 * 256 * 2 : OFF_HBUF + (size_t)(mm.off + mm.lb * 128) * 256 * 2);
#pragma unroll
        for (int m = 0; m < 4; ++m) {
#pragma unroll
            for (int n = 0; n < 2; ++n)
#pragma unroll
                for (int j = 0; j < 4; ++j) {
                    const int r = wr * 64 + m * 16 + fq * 4 + j;
                    const int hid = (nt * 2 + wc) * 32 + n * 16 + fr;
                    if (r < valid) stg<u16>(ws, hoff + (r * 256 + hid) * 2, f2bf(silu_f(acc[m][n][j]) * acc[m][n + 2][j]));
                }
            __builtin_amdgcn_sched_barrier(0);
        }
    }
}

__device__ void phase_moe2(CParams& p, int l, char* lds) {
    LANE_IDS;
    const int wr = wid >> 1, wc = wid & 1;
    int* sm = (int*)(lds + L_SM);
    __syncthreads();
    moe_setup(p, sm);
    const int nblk = sm[64] + 128;
    const int* list = (const int*)(p.ws + OFF_LIST);
    const float* tkw = (const float*)(p.ws + OFF_TKW);
    int* rowent = (int*)(lds + L_ROW);
    float* roww = (float*)(lds + L_ROWW);
    for (int u = blockIdx.x; u < nblk * 8; u += gridDim.x) {
        const int blk = u >> 3, nt = u & 7;
        const MoeMap mm = moe_map(p, sm, blk);
        const int valid = min(128, mm.cnt - mm.lb * 128);
        __syncthreads();
        if (tid < 128 && mm.e < 64) {
            int ent = (tid < valid) ? list[(size_t)mm.e * NTOK + mm.lb * 128 + tid] : 0;
            rowent[tid] = ent; roww[tid] = tkw[ent];
        }
        __syncthreads();
        unsigned char* ws = p.ws;
        const unsigned aoff = (unsigned)((mm.e == 64) ? OFF_HSH + (size_t)mm.lb * 128 * 256 * 2 : OFF_HBUF + (size_t)(mm.off + mm.lb * 128) * 256 * 2);
        const unsigned boff = (unsigned)(((mm.e == 64) ? OFF_SH2T : OFF_EW2 + (size_t)mm.e * 1024 * 256 * 2) + (size_t)nt * 128 * 256 * 2);
        f32x4 acc[4][4]; ZERO_ACC(acc, 4, 4);
        mma_glds<128, 128, 2, 2>(acc, 4, ws,
            [&](int r, int t) { return aoff + (r * 256 + t * 64) * 2; },
            [&](int c, int t) { return boff + (c * 256 + t * 64) * 2; }, NoHook(), lds);
        if (mm.e == 64) {
            float* Ysh = p.out;
            epi<4, 4, 64, 64>(acc, wr, wc, fq, fr, [&](int r, int cc, float v) {
                stg<float>(Ysh, (unsigned)(((mm.lb * 128 + r) * 1024 + nt * 128 + cc) * 4), v); });
        } else {
            epi<4, 4, 64, 64>(acc, wr, wc, fq, fr, [&](int r, int cc, float v) {
                if (r < valid) stg<u16>(ws, (unsigned)OFF_YBUF + (unsigned)(rowent[r] * 1024 + nt * 128 + cc) * 2u, f2bf(v * roww[r])); });
        }
    }
}

__device__ void phase_combine(CParams& p, int l) {
    LANE_IDS;
    const u16* Xm = (const u16*)(p.ws + OFF_XM);
    const u16* Yb = (const u16*)(p.ws + OFF_YBUF);
    const float* g2 = p.in[34] + (size_t)l * 1024;
    const float* b2 = p.in[35] + (size_t)l * 1024;
    u16* Xb = (u16*)(p.ws + OFF_XB);
    for (int row = blockIdx.x * 4 + wid; row < NTOK; row += gridDim.x * 4) {
        float v[16];
#pragma unroll
        for (int i = 0; i < 4; ++i) {
            const float4 y = *(const float4*)(p.out + (size_t)row * 1024 + i * 256 + lane * 4);
            const uint2 x = *(const uint2*)(Xm + (size_t)row * 1024 + i * 256 + lane * 4);
            v[i * 4 + 0] = y.x + DN_ALPHA * bf2f((u16)(x.x & 0xffff));
            v[i * 4 + 1] = y.y + DN_ALPHA * bf2f((u16)(x.x >> 16));
            v[i * 4 + 2] = y.z + DN_ALPHA * bf2f((u16)(x.y & 0xffff));
            v[i * 4 + 3] = y.w + DN_ALPHA * bf2f((u16)(x.y >> 16));
        }
#pragma unroll
        for (int k = 0; k < 8; ++k)
#pragma unroll
            for (int i = 0; i < 4; ++i) {
                const uint2 x = *(const uint2*)(Yb + ((size_t)row * 8 + k) * 1024 + i * 256 + lane * 4);
                v[i * 4 + 0] += bf2f((u16)(x.x & 0xffff));
                v[i * 4 + 1] += bf2f((u16)(x.x >> 16));
                v[i * 4 + 2] += bf2f((u16)(x.y & 0xffff));
                v[i * 4 + 3] += bf2f((u16)(x.y >> 16));
            }
        ln_row(v, g2, b2, lane);
#pragma unroll
        for (int i = 0; i < 4; ++i) {
            *(float4*)(p.out + (size_t)row * 1024 + i * 256 + lane * 4) = float4{v[i * 4], v[i * 4 + 1], v[i * 4 + 2], v[i * 4 + 3]};
            uint2 o; o.x = f2bf(v[i * 4]) | ((unsigned)f2bf(v[i * 4 + 1]) << 16); o.y = f2bf(v[i * 4 + 2]) | ((unsigned)f2bf(v[i * 4 + 3]) << 16);
            *(uint2*)(Xb + (size_t)row * 1024 + i * 256 + lane * 4) = o;
        }
    }
}


#define XB_TMO      128
#define XB_XCNT(j)  (256  + 64 * (j))
#define XB_XSUB(j)  (1280 + 64 * (j))
#define XB_XGEN(j)  (2304 + 64 * (j))
#define XB_TOP      3328
#define XB_TOPGEN   3392
#define XCD_BAR_WORDS 3456
#define XB_SPIN_CAP (1u << 22)
#define LAS __attribute__((address_space(3)))
__device__ __forceinline__ unsigned xb_ld(unsigned* p)              { return __hip_atomic_load(p, __ATOMIC_RELAXED, __HIP_MEMORY_SCOPE_AGENT); }
__device__ __forceinline__ unsigned xb_add(unsigned* p, unsigned v) { return __hip_atomic_fetch_add(p, v, __ATOMIC_RELAXED, __HIP_MEMORY_SCOPE_AGENT); }
__device__ __forceinline__ unsigned xb_xcc_id() { return (unsigned)__builtin_amdgcn_s_getreg((3 << 11) | 20) & 0xFu; }
#define XB_SPIN(cond, bar) do { unsigned _sp = 0; while (cond) { __builtin_amdgcn_s_sleep(1); \
    if ((++_sp & 255u) == 0u) { if (xb_ld(&(bar)[XB_TMO])) break; if (_sp > XB_SPIN_CAP) { atomicAdd(&(bar)[XB_TMO], 1u); break; } } } } while (0)
struct XcdBarrier { unsigned* bar; unsigned x; volatile LAS unsigned* st; };
__device__ __forceinline__ XcdBarrier xcd_barrier_post(unsigned* bar, volatile LAS unsigned* st) {
    XcdBarrier b; b.bar = bar; b.x = xb_xcc_id(); b.st = st;
    if (threadIdx.x == 0) (void)xb_add(&bar[XB_XCNT(b.x)], 1u);
    return b;
}
__device__ __forceinline__ void xcd_barrier_complete(unsigned* bar, unsigned x, unsigned& nloc, unsigned& nx) {
    const unsigned G = gridDim.x * gridDim.y * gridDim.z;
    unsigned sum, cnt, mine, sp = 0u;
    for (;;) {
        sum = 0u; cnt = 0u; mine = 0u;
#pragma unroll
        for (unsigned j = 0; j < 16; ++j) { const unsigned c = xb_ld(&bar[XB_XCNT(j)]); sum += c; cnt += (c > 0u) ? 1u : 0u; mine = (j == x) ? c : mine; }
        if (sum == G) break;
        __builtin_amdgcn_s_sleep(1);
        if ((++sp & 255u) == 0u) { if (xb_ld(&bar[XB_TMO])) break; if (sp > XB_SPIN_CAP) { atomicAdd(&bar[XB_TMO], 1u); break; } }
    }
    nloc = mine > 0u ? mine : 1u; nx = cnt > 0u ? cnt : 1u;
}
__device__ __forceinline__ void xcd_barrier(const XcdBarrier& b) {
    asm volatile("s_waitcnt vmcnt(0)" ::: "memory");
    __syncthreads();
    if (threadIdx.x == 0) {
        unsigned* bar = b.bar;
        __builtin_amdgcn_s_waitcnt(0);
        unsigned nloc = b.st[0], nx = b.st[1];
        if (nloc == 0u) { xcd_barrier_complete(bar, b.x, nloc, nx); b.st[0] = nloc; b.st[1] = nx; }
        const unsigned old = xb_add(&bar[XB_XSUB(b.x)], 1u);
        const unsigned gen = old / nloc;
        if (old + 1u == (gen + 1u) * nloc) {
            __builtin_amdgcn_fence(__ATOMIC_RELEASE, "agent");
            asm volatile("s_waitcnt vmcnt(0)" ::: "memory");
            const unsigned og = xb_add(&bar[XB_TOP], 1u);
            const unsigned tg = og / nx;
            if (og + 1u == (tg + 1u) * nx) xb_add(&bar[XB_TOPGEN], 1u);
            else XB_SPIN(xb_ld(&bar[XB_TOPGEN]) == tg, bar);
            __builtin_amdgcn_fence(__ATOMIC_ACQUIRE, "agent");
            xb_add(&bar[XB_XGEN(b.x)], 1u);
            asm volatile("s_waitcnt vmcnt(0)" ::: "memory");
        } else {
            XB_SPIN(xb_ld(&bar[XB_XGEN(b.x)]) == gen, bar);
            __builtin_amdgcn_fence(__ATOMIC_ACQUIRE, "agent");
            asm volatile("s_waitcnt vmcnt(0)" ::: "memory");
        }
    }
    __syncthreads();
}

__global__ void __launch_bounds__(256, 2) fwd_kernel(Params p_unused) {
    extern __shared__ __attribute__((aligned(16))) char lds[];
    cg::grid_group grid = cg::this_grid();
    CParams* pp = (CParams*)__builtin_amdgcn_kernarg_segment_ptr();
    const int ph_lo = pp->ph_lo, ph_hi = pp->ph_hi;
    volatile LAS unsigned* xst = (volatile LAS unsigned*)(lds + L_XST);
    if (threadIdx.x == 0) { xst[0] = 0u; xst[1] = 0u; }
    __syncthreads();
    const XcdBarrier xb = xcd_barrier_post((unsigned*)(pp->ws + OFF_BAR), xst);
#pragma unroll 1
    for (int ph = ph_lo; ph < ph_hi; ++ph) {
        asm volatile("" : "+s"(pp));
        CParams& p = *pp;
        const int l = ph / NPH, q = ph % NPH;
        switch (q) {
            case 0: phase_w(p, l, lds); break;
            case 1: phase_proj(p, l, lds); break;
            case 2: phase2(p, l, lds); break;
            case 3: phase3(p, l, lds); break;
            case 4: phase4(p, l, lds); break;
            case 5: phase_glu(p, l, lds); break;
            case 6: phase_branch(p, l, lds); break;
            case 7: phase_out(p, l, lds); break;
            case 8: phase_route(p, l, lds); break;
            case 9: phase_moe1(p, l, lds); break;
            case 10: phase_moe2(p, l, lds); break;
            default: phase_combine(p, l); break;
        }
        if (ph + 1 < ph_hi) {
            if (p.coop == 1) xcd_barrier(xb);
            else if (p.coop == 2) grid.sync();
        }
    }
}

extern "C" void kernel_launch(void* const* d_in, const int* in_sizes, int n_in, void* d_out, int out_size, void* d_ws, size_t ws_size,
                              hipStream_t stream) {
    static int grid_blocks = 0;
    if (!grid_blocks) {
        int dev = 0, cus = 0, per_cu = 0;
        (void)hipGetDevice(&dev);
        (void)hipDeviceGetAttribute(&cus, hipDeviceAttributeMultiprocessorCount, dev);
        (void)hipFuncSetAttribute((const void*)fwd_kernel, hipFuncAttributeMaxDynamicSharedMemorySize, LDS_BYTES);
        (void)hipOccupancyMaxActiveBlocksPerMultiprocessor(&per_cu, fwd_kernel, 256, LDS_BYTES);
        if (per_cu < 1) per_cu = 1;
        if (per_cu > 2) per_cu = 2;
        grid_blocks = cus * per_cu;
        if (ws_size < WS_NEED) fprintf(stderr, "kernel_launch: workspace too small: %zu < %zu\n", ws_size, (size_t)WS_NEED);
    }
    Params p{};
    for (int i = 0; i < 36; ++i) p.in[i] = (const float*)d_in[i];
    p.out = (float*)d_out;
    p.ws = (unsigned char*)d_ws;
    p.ph_lo = 0; p.ph_hi = 2 * NPH; p.coop = 1; p.pad = 0;
    (void)hipMemsetAsync((char*)d_ws + OFF_BAR, 0, XCD_BAR_WORDS * 4, stream);
    void* args[] = {&p};
    hipError_t e = hipLaunchCooperativeKernel((void*)fwd_kernel, dim3(grid_blocks), dim3(256), args, LDS_BYTES, stream);
    if (e != hipSuccess) fprintf(stderr, "cooperative launch failed: %s (grid %d)\n", hipGetErrorString(e), grid_blocks);
}
```

```cpp
#include <hip/hip_runtime.h>
#include <hip/hip_cooperative_groups.h>
#include <cstdio>
#include <cstdint>
namespace cg = cooperative_groups;

typedef unsigned short u16;
typedef __attribute__((ext_vector_type(8))) short bf16x8;
typedef __attribute__((ext_vector_type(4))) float f32x4;
typedef __attribute__((ext_vector_type(4))) unsigned u32x4;
#define LAS __attribute__((address_space(3)))

constexpr int NTOK = 16384, DM = 1024, SEQ = 4096, BW = 512, INC = 6656;
constexpr int NE = 64, EH = 256;
#ifndef PROBE_MASK
#define PROBE_MASK 0u
#endif
constexpr int NPH = 12;
constexpr float DN_ALPHA = 1.4142135623730951f;
constexpr size_t SLOT = 16777216ull;

constexpr size_t OFF_WINT  = 0;
constexpr size_t OFF_WBRT  = 13631488;
constexpr size_t OFF_WOUTT = 16777216;
constexpr size_t OFF_GLUT  = 18874368;
constexpr size_t OFF_RGT   = 19398656;
constexpr size_t OFF_SH13T = 19660800;
constexpr size_t OFF_SH2T  = 20709376;
constexpr size_t OFF_BTA   = 21233664;
constexpr size_t OFF_BTC   = 23330816;
constexpr size_t OFF_ROUTT = 29622272;
constexpr size_t OFF_MISC  = 29753344;
constexpr size_t OFF_LB    = OFF_MISC;
constexpr size_t OFF_CUR   = OFF_MISC + 2048;
constexpr size_t OFF_DEC   = OFF_MISC + 4096;
constexpr size_t OFF_SEGA  = OFF_DEC + 524288;
constexpr size_t OFF_SEGH  = OFF_SEGA + 524288;
constexpr size_t OFF_XB    = 2 * SLOT;
constexpr size_t OFF_VC    = 2 * SLOT;
constexpr size_t OFF_XC    = 3 * SLOT;
constexpr size_t OFF_MIXP  = 2 * SLOT;
constexpr size_t OFF_LIST  = 2 * SLOT;
constexpr size_t OFF_HSH   = 2 * SLOT + 4194304;
constexpr size_t OFF_WLIST = 2 * SLOT + 4194304 + 8388608;
constexpr size_t OFF_PQ    = 4 * SLOT;
constexpr size_t OFF_PLF   = 5 * SLOT;
constexpr size_t OFF_PK    = 7 * SLOT;
constexpr size_t OFF_PV    = 8 * SLOT;
constexpr size_t OFF_YC    = 8 * SLOT;
constexpr size_t OFF_PG    = 9 * SLOT;
constexpr size_t OFF_PU    = 10 * SLOT;
constexpr size_t OFF_PXG   = 11 * SLOT;
constexpr size_t OFF_PXR   = 12 * SLOT;
constexpr size_t OFF_YB    = 12 * SLOT;
constexpr size_t OFF_PGATE = 13 * SLOT;
constexpr size_t OFF_KTT   = 19 * SLOT;
constexpr size_t OFF_YA    = 19 * SLOT;
constexpr size_t OFF_VT    = 20 * SLOT;
constexpr size_t OFF_ST    = 21 * SLOT;
constexpr size_t OFF_LA    = 23 * SLOT;
constexpr size_t OFF_BB    = 24 * SLOT;
constexpr size_t OFF_YG    = 25 * SLOT;
constexpr size_t OFF_HC    = 26 * SLOT;
constexpr size_t OFF_UT    = 27 * SLOT;
constexpr size_t OFF_PRELN = 4 * SLOT;
constexpr size_t OFF_XM    = 8 * SLOT;
constexpr size_t OFF_EW13  = 10 * SLOT;
constexpr size_t OFF_EW2   = 14 * SLOT;
constexpr size_t OFF_HBUF  = 4 * SLOT;
constexpr size_t OFF_YBUF  = 16 * SLOT;
constexpr size_t OFF_BAR   = 32 * SLOT;
constexpr int HLDS = 73728;
constexpr int LDS_BYTES = 2 * HLDS + 64;
constexpr int L_XST = 2 * HLDS;
constexpr size_t WS_NEED   = 32 * SLOT + 16384;

struct Params {
    const float* in[36];
    float* out;
    unsigned char* ws;
    int ph_lo, ph_hi;
    int coop, pad;
};
typedef const __attribute__((address_space(4))) Params CParams;

__device__ __forceinline__ u16 f2bf(float f) {
    unsigned u = __builtin_bit_cast(unsigned, f);
    return (u16)((u + 0x7fffu + ((u >> 16) & 1u)) >> 16);
}
__device__ __forceinline__ float bf2f(u16 h) { return __builtin_bit_cast(float, (unsigned)h << 16); }
__device__ __forceinline__ float sigm(float x) { return 1.f / (1.f + __expf(-x)); }
__device__ __forceinline__ float silu_f(float x) { return x * sigm(x); }
__device__ __forceinline__ float gelu_f(float x) {
    float u = 0.7978845608028654f * (x + 0.044715f * x * x * x);
    float t = 1.f - 2.f / (1.f + __expf(2.f * u));
    return 0.5f * x * (1.f + t);
}
__device__ __forceinline__ float shfl_xor_l(float v, int o, int lane) {
    return __builtin_bit_cast(float, __builtin_amdgcn_ds_bpermute((lane ^ o) << 2, __builtin_bit_cast(int, v)));
}
__device__ __forceinline__ float wave_sum(float v, int lane) {
#pragma unroll
    for (int o = 32; o >= 1; o >>= 1) v += shfl_xor_l(v, o, lane);
    return v;
}
__device__ __forceinline__ int swz(int row, int ch) { return row * 128 + ((ch ^ ((row >> 1) & 7)) << 4); }


template <class T> __device__ __forceinline__ T ldg(const void* base, unsigned off) { return *(const T*)((const char*)base + off); }
template <class T> __device__ __forceinline__ void stg(void* base, unsigned off, T v) { *(T*)((char*)base + off) = v; }

template <int TM, int TN, int RW, int CW, class F>
__device__ __forceinline__ void epi(f32x4 (&acc)[TM][TN], int wr, int wc, int fq, int fr, F f) {
#pragma unroll
    for (int m = 0; m < TM; ++m) {
#pragma unroll
        for (int j = 0; j < 4; ++j) {
#pragma unroll
            for (int n = 0; n < TN; ++n) f(wr * RW + m * 16 + fq * 4 + j, wc * CW + n * 16 + fr, acc[m][n][j]);
        }
        __builtin_amdgcn_sched_barrier(0);
    }
}

__device__ __forceinline__ int otid() { int t = threadIdx.x & 255; asm volatile("" : "+v"(t)); return t; }
#define VB ((int)blockIdx.x * 2 + __builtin_amdgcn_readfirstlane((int)(threadIdx.x >> 8)))
#define VG ((int)gridDim.x * 2)

struct NoHook { __device__ __forceinline__ void operator()(int) const {} };

template <int BM, int BN, int WM, int WN, class AL, class BL, class HK>
__device__ __forceinline__ void mma_loop(f32x4 (&acc)[BM / WM / 16][BN / WN / 16], int nk, AL aload, BL bload, HK hook, char* lds) {
    constexpr int TM = BM / WM / 16, TN = BN / WN / 16;
    constexpr int ACH = BM / 32, BCH = BN / 32;
    const int tid = otid(), lane = tid & 63, wid = tid >> 6;
    const int wr = wid / WN, wc = wid % WN, fr = lane & 15, fq = lane >> 4;
    const int srow = tid >> 3, sk = (tid & 7) * 8;
    const int swr = srow * 128 + (((tid & 7) ^ ((tid >> 4) & 7)) << 4);
    const int xr = (fr >> 1) & 7;
    const int a_rd = (wr * (BM / WM) + fr) * 128;
    const int b_rd = BM * 128 + (wc * (BN / WN) + fr) * 128;
    bf16x8 ra[ACH], rb[BCH];
#pragma unroll
    for (int i = 0; i < ACH; ++i) ra[i] = aload(srow + i * 32, sk);
#pragma unroll
    for (int i = 0; i < BCH; ++i) rb[i] = bload(srow + i * 32, sk);
#pragma unroll 1
    for (int t = 0; t < nk; ++t) {
        __syncthreads();
#pragma unroll
        for (int i = 0; i < ACH; ++i) *(bf16x8*)(lds + swr + i * 4096) = ra[i];
#pragma unroll
        for (int i = 0; i < BCH; ++i) *(bf16x8*)(lds + BM * 128 + swr + i * 4096) = rb[i];
        __syncthreads();
        if (t + 1 < nk) {
#pragma unroll
            for (int i = 0; i < ACH; ++i) ra[i] = aload(srow + i * 32, (t + 1) * 64 + sk);
#pragma unroll
            for (int i = 0; i < BCH; ++i) rb[i] = bload(srow + i * 32, (t + 1) * 64 + sk);
        }
        hook(t);
#pragma unroll
        for (int ks = 0; ks < 2; ++ks) {
            const int co = ((ks * 4 + fq) ^ xr) << 4;
            bf16x8 af[TM], bfr[TN];
#pragma unroll
            for (int m = 0; m < TM; ++m) af[m] = *(const bf16x8*)(lds + a_rd + m * 2048 + co);
#pragma unroll
            for (int n = 0; n < TN; ++n) bfr[n] = *(const bf16x8*)(lds + b_rd + n * 2048 + co);
#pragma unroll
            for (int m = 0; m < TM; ++m)
#pragma unroll
                for (int n = 0; n < TN; ++n) acc[m][n] = __builtin_amdgcn_mfma_f32_16x16x32_bf16(af[m], bfr[n], acc[m][n], 0, 0, 0);
        }
    }
}

template <int BM, int BN, int WM, int WN, class AO, class BO, class HK>
__device__ __forceinline__ void mma_glds(f32x4 (&acc)[BM / WM / 16][BN / WN / 16], int nk, const unsigned char* ws, AO aoff, BO boff, HK hook, char* lds) {
    constexpr int TM = BM / WM / 16, TN = BN / WN / 16;
    constexpr int ACH = BM / 32, BCH = BN / 32, BUF = (BM + BN) * 128;
    const int tid = otid(), lane = tid & 63, wid = tid >> 6;
    const int wr = wid / WN, wc = wid % WN, fr = lane & 15, fq = lane >> 4;
    const int srow = tid >> 3;
    const unsigned csrc = (unsigned)(((tid & 7) ^ ((tid >> 4) & 7)) << 4);
    const int xr = (fr >> 1) & 7;
    const int a_rd = (wr * (BM / WM) + fr) * 128;
    const int b_rd = BM * 128 + (wc * (BN / WN) + fr) * 128;
    auto stage = [&](int buf, int t) {
        char* d = lds + buf * BUF + tid * 16;
#pragma unroll
        for (int i = 0; i < ACH; ++i)
            __builtin_amdgcn_global_load_lds((const unsigned*)(ws + (aoff(srow + i * 32, t) + csrc)), (unsigned*)(d + i * 4096), 16, 0, 0);
#pragma unroll
        for (int i = 0; i < BCH; ++i)
            __builtin_amdgcn_global_load_lds((const unsigned*)(ws + (boff(srow + i * 32, t) + csrc)), (unsigned*)(d + BM * 128 + i * 4096), 16, 0, 0);
    };
    __syncthreads();
    stage(0, 0);
#pragma unroll 1
    for (int t = 0; t < nk; ++t) {
        asm volatile("s_waitcnt vmcnt(0)" ::: "memory");
        __syncthreads();
        if (t + 1 < nk) stage((t + 1) & 1, t + 1);
        hook(t);
        const char* bb = lds + (t & 1) * BUF;
#pragma unroll
        for (int ks = 0; ks < 2; ++ks) {
            const int co = ((ks * 4 + fq) ^ xr) << 4;
            bf16x8 af[TM], bfr[TN];
#pragma unroll
            for (int m = 0; m < TM; ++m) af[m] = *(const bf16x8*)(bb + a_rd + m * 2048 + co);
#pragma unroll
            for (int n = 0; n < TN; ++n) bfr[n] = *(const bf16x8*)(bb + b_rd + n * 2048 + co);
#pragma unroll
            for (int m = 0; m < TM; ++m)
#pragma unroll
                for (int n = 0; n < TN; ++n) acc[m][n] = __builtin_amdgcn_mfma_f32_16x16x32_bf16(af[m], bfr[n], acc[m][n], 0, 0, 0);
        }
    }
}

#define ZERO_ACC(acc, TM, TN) _Pragma("unroll") for (int m_ = 0; m_ < TM; ++m_) _Pragma("unroll") for (int n_ = 0; n_ < TN; ++n_) acc[m_][n_] = f32x4{0.f, 0.f, 0.f, 0.f}

#define LANE_IDS const int tid = otid(), lane = tid & 63, wid = tid >> 6, fr = lane & 15, fq = lane >> 4; (void)tid; (void)lane; (void)wid; (void)fr; (void)fq

namespace g8 {
constexpr int BM = 256, BK = 64, HALF = 128, HTB = HALF * BK * 2, STAGE_BYTES = 8 * HTB;
__device__ __forceinline__ int lds_byte(int r, int c) { const int st = (r >> 4) * 2 + (c >> 5), rr = r & 15, cc = c & 31, ob = rr * 64 + cc * 2; return st * 1024 + (ob ^ (((ob >> 9) & 1) << 5)); }
__device__ __forceinline__ void stage_rc(int b, int& R, int& C) { const int st = b / 1024, sb = b % 1024, swz = sb ^ (((sb >> 9) & 1) << 5); R = (st >> 1) * 16 + swz / 64; C = (st & 1) * 32 + (swz % 64) / 2; }
__device__ __forceinline__ int perm32(int rho) { const int n = rho >> 4, i = rho & 15; return 8 * (i >> 2) + 4 * n + (i & 3); }
struct Unit { unsigned A, B; int pm, pn, x0, x1; };
__device__ __forceinline__ unsigned cvt_pk_bf16(float lo, float hi) { unsigned r; asm volatile("v_cvt_pk_bf16_f32 %0, %1, %2" : "=v"(r) : "v"(lo), "v"(hi)); return r; }

template <class Epi, class Sched, bool GATHER>
__device__ __forceinline__ void gemm_phase(LAS unsigned char* lds, const unsigned char* wsb, const int K, const Sched& S, const Epi& E) {
    int tid_ = threadIdx.x; asm volatile("" : "+v"(tid_));
    const int tid = tid_, wid = __builtin_amdgcn_readfirstlane(tid >> 6), lane = tid & 63, wr = wid >> 2, wc = wid & 3, fr = lane & 15, fq = lane >> 4;
    const int nt = K / BK;
    unsigned voffA[2], voffB[2];
#pragma unroll
    for (int i = 0; i < 2; ++i) { int R, C; stage_rc(tid * 16 + i * 8192, R, C); const int Rb = Epi::PERM ? ((R & ~31) + perm32(R & 31)) : R;
        voffA[i] = (unsigned)(R * K + C) * 2u; voffB[i] = (unsigned)(Rb * K + C) * 2u; }
    const unsigned kstep = (unsigned)(BK * 2);
    const unsigned hstep = (unsigned)(HALF * K * 2);
    const unsigned ldsw = (unsigned)wid * 1024u;
    const int aoff = lds_byte(wr * 64 + fr, fq * 8), boff = lds_byte(wc * 32 + fr, fq * 8);
#define G8_SA(b, h) (((b) * 2 + (h)) * HTB)
#define G8_SB(b, h) ((4 + (b) * 2 + (h)) * HTB)
#define G8_STAGE(bufoff, gbase, voff) do { _Pragma("unroll") for (int _i = 0; _i < 2; ++_i) \
        __builtin_amdgcn_global_load_lds((const unsigned*)(wsb + (unsigned)((gbase) + (voff)[_i])), (LAS unsigned*)(lds + (bufoff) + ldsw + _i * 8192), 16, 0, 0); } while (0)
#define G8_STAGE_A(bufoff, kp, h, vg) do { if (GATHER) G8_STAGE(bufoff, kp, vg[h]); else G8_STAGE(bufoff, (kp) + (h) * hstep, voffA); } while (0)
#define G8_LDA(dst, b, h) do { _Pragma("unroll") for (int m = 0; m < 4; ++m) _Pragma("unroll") for (int k = 0; k < 2; ++k) dst[m][k] = *(const LAS bf16x8*)(lds + G8_SA(b, h) + aoff + m * 2048 + k * 1024); } while (0)
#define G8_LDB(dst, b, h) do { _Pragma("unroll") for (int n = 0; n < 2; ++n) _Pragma("unroll") for (int k = 0; k < 2; ++k) dst[n][k] = *(const LAS bf16x8*)(lds + G8_SB(b, h) + boff + n * 2048 + k * 1024); } while (0)
#define G8_MMA(ai, bj, At, Bt) do { __builtin_amdgcn_s_setprio(1); _Pragma("unroll") for (int m = 0; m < 4; ++m) _Pragma("unroll") for (int n = 0; n < 2; ++n) _Pragma("unroll") for (int k = 0; k < 2; ++k) \
        acc[ai][bj][m][n] = __builtin_amdgcn_mfma_f32_16x16x32_bf16(Bt[n][k], At[m][k], acc[ai][bj][m][n], 0, 0, 0); __builtin_amdgcn_s_setprio(0); } while (0)
#define G8_WAIT_V(n) asm volatile("s_waitcnt vmcnt(" #n ")" ::: "memory")
#define G8_WAIT_L(n) asm volatile("s_waitcnt lgkmcnt(" #n ")" ::: "memory")
#define G8_BAR __builtin_amdgcn_s_barrier()
#define G8_SCHED __builtin_amdgcn_sched_barrier(0)
#define G8_GOFF(dst, u) do { _Pragma("unroll") for (int _i = 0; _i < 2; ++_i) { int _R, _C; stage_rc(tid * 16 + _i * 8192, _R, _C); \
        _Pragma("unroll") for (int _h = 0; _h < 2; ++_h) dst[_h][_i] = (unsigned)(S.row(u, _h * HALF + _R) * K + _C) * 2u; } \
        asm volatile("" : "+v"(dst[0][0]), "+v"(dst[0][1]), "+v"(dst[1][0]), "+v"(dst[1][1])); } while (0)
    Unit cur, nxt; int ui = 0;
    if (!S.next(0, cur)) return;
    f32x4 acc[2][2][4][2];
#pragma unroll
    for (int a = 0; a < 2; ++a)
#pragma unroll
        for (int b = 0; b < 2; ++b)
#pragma unroll
            for (int m = 0; m < 4; ++m)
#pragma unroll
                for (int n = 0; n < 2; ++n) acc[a][b][m][n] = (f32x4){0.f, 0.f, 0.f, 0.f};
    bf16x8 At[4][2], B0[2][2], B1[2][2];
    unsigned vgc[2][2] = {{0u, 0u}, {0u, 0u}};
    LAS u32x4* gslot = (LAS u32x4*)(lds + STAGE_BYTES + 4096) + tid;
    unsigned cA = cur.A, cB = cur.B;
    if (GATHER) { G8_GOFF(vgc, cur); }
    G8_STAGE(G8_SB(0, 0), cB, voffB); G8_STAGE_A(G8_SA(0, 0), cA, 0, vgc); G8_STAGE(G8_SB(0, 1), cB + hstep, voffB); G8_STAGE_A(G8_SA(0, 1), cA, 1, vgc);
    if (wr == 1) G8_BAR;
    G8_WAIT_V(4); G8_BAR;
    G8_STAGE(G8_SB(1, 0), cB + kstep, voffB); G8_STAGE_A(G8_SA(1, 0), cA + kstep, 0, vgc); G8_STAGE(G8_SB(1, 1), cB + hstep + kstep, voffB);
    G8_WAIT_V(6); G8_BAR;
    for (;;) {
        const bool has_next = S.next(ui + 1, nxt);
        const unsigned nA = has_next ? nxt.A : cA, nB = has_next ? nxt.B : cB;
        if (GATHER && has_next) {
            unsigned vt[2][2]; G8_GOFF(vt, nxt);
            *gslot = u32x4{vt[0][0], vt[0][1], vt[1][0], vt[1][1]};
        }
#pragma unroll 1
        for (int t = 0; t < nt; t += 2) {
            const bool last = (t == nt - 2);
            const unsigned a1 = cA + (unsigned)(t + 1) * kstep;
            const unsigned a2 = last ? nA : cA + (unsigned)(t + 2) * kstep, b2 = last ? nB : cB + (unsigned)(t + 2) * kstep;
            const unsigned a3 = a2 + kstep, b3 = b2 + kstep;
            G8_LDB(B0, 0, 0); G8_SCHED; G8_LDA(At, 0, 0); G8_STAGE_A(G8_SA(1, 1), a1, 1, vgc);
            G8_WAIT_L(8); G8_BAR; G8_WAIT_L(0); G8_MMA(0, 0, At, B0); G8_BAR; G8_SCHED;
            G8_LDB(B1, 0, 1);
            if (GATHER && last && has_next) { const u32x4 x = *gslot; vgc[0][0] = x[0]; vgc[0][1] = x[1]; vgc[1][0] = x[2]; vgc[1][1] = x[3]; }
            G8_STAGE(G8_SB(0, 0), b2, voffB);
            G8_BAR; G8_WAIT_L(0); G8_MMA(0, 1, At, B1); G8_BAR;
            G8_LDA(At, 0, 1); G8_STAGE_A(G8_SA(0, 0), a2, 0, vgc);
            G8_BAR; G8_WAIT_L(0); G8_MMA(1, 0, At, B0); G8_BAR; G8_SCHED;
            G8_STAGE(G8_SB(0, 1), b2 + hstep, voffB);
            G8_WAIT_V(6); G8_BAR; G8_MMA(1, 1, At, B1); G8_BAR;
            G8_LDB(B0, 1, 0); G8_SCHED; G8_LDA(At, 1, 0); G8_STAGE_A(G8_SA(0, 1), a2, 1, vgc);
            G8_WAIT_L(8); G8_BAR; G8_WAIT_L(0); G8_MMA(0, 0, At, B0); G8_BAR; G8_SCHED;
            G8_LDB(B1, 1, 1); G8_STAGE(G8_SB(1, 0), b3, voffB);
            G8_BAR; G8_WAIT_L(0); G8_MMA(0, 1, At, B1); G8_BAR;
            G8_LDA(At, 1, 1); G8_STAGE_A(G8_SA(1, 0), a3, 0, vgc);
            G8_BAR; G8_WAIT_L(0); G8_MMA(1, 0, At, B0); G8_BAR; G8_SCHED;
            G8_STAGE(G8_SB(1, 1), b3 + hstep, voffB);
            G8_WAIT_V(6); G8_BAR; G8_MMA(1, 1, At, B1); G8_BAR;
        }
        E(acc, cur, wr, wc, fr, fq);
        if (!has_next) break;
#pragma unroll
        for (int a = 0; a < 2; ++a)
#pragma unroll
            for (int b = 0; b < 2; ++b)
#pragma unroll
                for (int m = 0; m < 4; ++m)
#pragma unroll
                    for (int n = 0; n < 2; ++n) acc[a][b][m][n] = (f32x4){0.f, 0.f, 0.f, 0.f};
        cur = nxt; cA = nA; cB = nB; ++ui;
    }
    G8_WAIT_V(0);
    if (wr == 0) G8_BAR;
    G8_BAR;
#undef G8_SA
#undef G8_SB
#undef G8_STAGE
#undef G8_STAGE_A
#undef G8_LDA
#undef G8_LDB
#undef G8_MMA
#undef G8_WAIT_V
#undef G8_WAIT_L
#undef G8_BAR
#undef G8_SCHED
#undef G8_GOFF
}
}

__device__ __forceinline__ uint4 pack8(const f32x4& a, const f32x4& b) {
    uint4 w; w.x = g8::cvt_pk_bf16(a[0], a[1]); w.y = g8::cvt_pk_bf16(a[2], a[3]); w.z = g8::cvt_pk_bf16(b[0], b[1]); w.w = g8::cvt_pk_bf16(b[2], b[3]); return w;
}

struct ProjSched {
    unsigned A, B; int c, G;
    __device__ __forceinline__ bool next(int i, g8::Unit& u) const {
        const int L = i * G + c; if (L >= 64 * 26) return false;
        const int xcd = L & 7, jx = L >> 3;
        u.pm = xcd * 8 + (jx & 7); u.pn = jx >> 3;
        u.A = A + (unsigned)u.pm * 256 * DM * 2; u.B = B + (unsigned)u.pn * 256 * DM * 2; u.x0 = 0; u.x1 = 0; return true;
    }
    __device__ __forceinline__ int row(const g8::Unit&, int) const { return 0; }
};
struct ProjEpi {
    static constexpr bool PERM = true;
    unsigned char* ws; const float* bg;
    __device__ __forceinline__ void operator()(const f32x4 (&acc)[2][2][4][2], const g8::Unit& u, int wr, int wc, int fr, int fq) const {
        const int seg = (u.pn * 256) >> 9;
#pragma unroll
        for (int ai = 0; ai < 2; ++ai)
#pragma unroll
            for (int m = 0; m < 4; ++m) {
                const int row = u.pm * 256 + ai * 128 + wr * 64 + m * 16 + fr;
#pragma unroll
                for (int bj = 0; bj < 2; ++bj) {
                    const int col = u.pn * 256 + bj * 128 + wc * 32 + fq * 8;
                    const int c = col & 511;
                    f32x4 v0 = acc[ai][bj][m][0], v1 = acc[ai][bj][m][1];
                    if (seg == 0 || seg == 3) {
#pragma unroll
                        for (int i = 0; i < 4; ++i) { v0[i] = silu_f(v0[i]); v1[i] = silu_f(v1[i]); }
                        stg<uint4>(ws, (unsigned)((seg == 0 ? OFF_PQ : OFF_PG) + (row * 512 + c) * 2), pack8(v0, v1));
                    } else if (seg == 1) {
                        const f32x4 l0 = ldg<f32x4>(ws, (unsigned)(OFF_LB + c * 4)), l1 = ldg<f32x4>(ws, (unsigned)(OFF_LB + c * 4 + 16));
                        f32x4 g0, g1, k0, k1;
#pragma unroll
                        for (int i = 0; i < 4; ++i) {
                            const float s0 = sigm(v0[i]), s1 = sigm(v1[i]);
                            g0[i] = logf(l0[i] + (1.f - l0[i]) * s0); g1[i] = logf(l1[i] + (1.f - l1[i]) * s1);
                            k0[i] = (1.f - l0[i]) * (1.f - s0); k1[i] = (1.f - l1[i]) * (1.f - s1);
                        }
                        stg<f32x4>(ws, (unsigned)(OFF_PLF + (row * 512 + c) * 4), g0);
                        stg<f32x4>(ws, (unsigned)(OFF_PLF + (row * 512 + c) * 4 + 16), g1);
                        stg<uint4>(ws, (unsigned)(OFF_PK + (row * 512 + c) * 2), pack8(k0, k1));
                    } else if (seg == 2 || seg == 6) {
                        stg<uint4>(ws, (unsigned)((seg == 2 ? OFF_PV : OFF_PXR) + (row * 512 + c) * 2), pack8(v0, v1));
                    } else if (seg == 4) {
                        stg<uint4>(ws, (unsigned)(OFF_PU + (((c >> 4) * NTOK + row) * 16 + (c & 15)) * 2), pack8(v0, v1));
                    } else if (seg == 5) {
#pragma unroll
                        for (int i = 0; i < 4; ++i) { v0[i] = gelu_f(v0[i]); v1[i] = gelu_f(v1[i]); }
                        stg<uint4>(ws, (unsigned)(OFF_PXG + (row * 512 + c) * 2), pack8(v0, v1));
                    } else {
                        const int gc = col - 3584;
                        const f32x4 b0 = *(const f32x4*)(bg + gc), b1 = *(const f32x4*)(bg + gc + 4);
#pragma unroll
                        for (int i = 0; i < 4; ++i) { v0[i] = sigm(v0[i] + b0[i]); v1[i] = sigm(v1[i] + b1[i]); }
                        stg<uint4>(ws, (unsigned)(OFF_PGATE + (row * 3072 + gc) * 2), pack8(v0, v1));
                    }
                }
                __builtin_amdgcn_sched_barrier(0);
            }
    }
};
__device__ void phase_proj(CParams& p, int l, char* lds) {
    ProjSched S; S.A = (unsigned)OFF_XB; S.B = (unsigned)OFF_WINT; S.c = blockIdx.x; S.G = gridDim.x;
    ProjEpi E; E.ws = p.ws; E.bg = p.in[2] + (size_t)l * 3072;
    g8::gemm_phase<ProjEpi, ProjSched, false>((LAS unsigned char*)lds, p.ws, 1024, S, E);
}

struct OutSched {
    unsigned A, B; int c, G;
    __device__ __forceinline__ bool next(int i, g8::Unit& u) const {
        const int L = i * G + c; if (L >= 64 * 4) return false;
        const int xcd = L & 7, jx = L >> 3;
        u.pm = xcd * 8 + (jx & 7); u.pn = jx >> 3;
        u.A = A + (unsigned)u.pm * 256 * 1024 * 2; u.B = B + (unsigned)u.pn * 256 * 1024 * 2; u.x0 = 0; u.x1 = 0; return true;
    }
    __device__ __forceinline__ int row(const g8::Unit&, int) const { return 0; }
};
struct OutEpi {
    static constexpr bool PERM = false;
    unsigned char* ws; const float* xres;
    __device__ __forceinline__ void operator()(const f32x4 (&acc)[2][2][4][2], const g8::Unit& u, int wr, int wc, int fr, int fq) const {
#pragma unroll
        for (int ai = 0; ai < 2; ++ai)
#pragma unroll
            for (int m = 0; m < 4; ++m) {
                const int row = u.pm * 256 + ai * 128 + wr * 64 + m * 16 + fr;
#pragma unroll
                for (int bj = 0; bj < 2; ++bj)
#pragma unroll
                    for (int n = 0; n < 2; ++n) {
                        const int col = u.pn * 256 + bj * 128 + wc * 32 + n * 16 + fq * 4;
                        const unsigned o = (unsigned)((row * 1024 + col) * 4);
                        const f32x4 x = ldg<f32x4>(xres, o);
                        stg<f32x4>(ws, (unsigned)OFF_PRELN + o, x * DN_ALPHA + acc[ai][bj][m][n]);
                    }
                __builtin_amdgcn_sched_barrier(0);
            }
    }
};

struct MoeSched {
    const int* sm; const unsigned char* ws; unsigned A, Bexp, Bsh, Ash;
    int c, G, npn, K, bstride_e, gather, nsh;
    __device__ __forceinline__ bool next(int i, g8::Unit& u) const {
        int nbr = __builtin_amdgcn_readfirstlane(sm[64]); asm volatile("" : "+s"(nbr));
        const int L = i * G + c; if (L >= (nbr + nsh) * npn) return false;
        const int blk = L / npn; u.pn = L - blk * npn;
        if (blk >= nbr) {
            u.x0 = 64; u.pm = blk - nbr; u.x1 = NTOK;
            u.A = gather ? A : Ash + (unsigned)u.pm * 256 * K * 2;
            u.B = Bsh + (unsigned)u.pn * 256 * K * 2;
        } else {
            int e = __builtin_amdgcn_readfirstlane(sm[256 + blk]);
            int be = __builtin_amdgcn_readfirstlane(sm[e]), re = __builtin_amdgcn_readfirstlane(sm[65 + e]), ce = __builtin_amdgcn_readfirstlane(sm[130 + e]);
            asm volatile("" : "+s"(e), "+s"(be), "+s"(re), "+s"(ce));
            u.x0 = e; u.pm = blk - be; u.x1 = ce;
            u.A = gather ? A : A + (unsigned)(re + u.pm * 256) * K * 2;
            u.B = Bexp + (unsigned)e * bstride_e + (unsigned)u.pn * 256 * K * 2;
        }
        return true;
    }
    __device__ __forceinline__ int row(const g8::Unit& u, int r) const {
        const int rr = u.pm * 256 + r;
        if (u.x0 == 64) return rr;
        return (rr < u.x1) ? (ldg<int>(ws, (unsigned)(OFF_LIST + (u.x0 * NTOK + rr) * 4)) >> 3) : 0;
    }
};
__device__ __forceinline__ void moe_setup(CParams& p, int* sm) {
    __syncthreads();
    if (threadIdx.x == 0) {
        const int* cursor = (const int*)(p.ws + OFF_CUR);
        int nb = 0, nr = 0;
        for (int e = 0; e < 64; ++e) { sm[e] = nb; sm[65 + e] = nr; int c = cursor[e]; sm[130 + e] = c; nb += (c + 255) >> 8; nr += c; }
        sm[64] = nb; sm[129] = nr;
    }
    __syncthreads();
    if (threadIdx.x < 64) { const int e = threadIdx.x; for (int k = sm[e]; k < sm[e + 1]; ++k) sm[256 + k] = e; }
    __syncthreads();
}
struct Moe1Epi {
    static constexpr bool PERM = false;
    unsigned char* ws; const int* sm;
    __device__ __forceinline__ void operator()(const f32x4 (&acc)[2][2][4][2], const g8::Unit& u, int wr, int wc, int fr, int fq) const {
        const int rbase = (u.x0 == 64) ? 0 : __builtin_amdgcn_readfirstlane(sm[65 + (u.x0 & 63)]);
        const unsigned hoff = (unsigned)((u.x0 == 64) ? OFF_HSH + (size_t)u.pm * 256 * 256 * 2 : OFF_HBUF + (size_t)(rbase + u.pm * 256) * 256 * 2);
        const int valid = u.x1 - u.pm * 256;
        float rw[2][4];
        const unsigned wb = (unsigned)(OFF_WLIST + ((u.x0 & 63) * NTOK + u.pm * 256 + wr * 64 + fr) * 4);
#pragma unroll
        for (int ai = 0; ai < 2; ++ai)
#pragma unroll
            for (int m = 0; m < 4; ++m) {
                const int r = ai * 128 + wr * 64 + m * 16 + fr;
                rw[ai][m] = (u.x0 != 64 && r < valid) ? ldg<float>(ws, wb + (unsigned)((ai * 128 + m * 16) * 4)) : 1.f;
            }
#pragma unroll
        for (int ai = 0; ai < 2; ++ai)
#pragma unroll
            for (int m = 0; m < 4; ++m) {
                const int r = ai * 128 + wr * 64 + m * 16 + fr;
                const float w = rw[ai][m];
#pragma unroll
                for (int bj = 0; bj < 2; ++bj) {
                    const int hid = ((u.pn * 256 + bj * 128 + wc * 32) >> 1) + fq * 4;
                    const f32x4 a = acc[ai][bj][m][0], b = acc[ai][bj][m][1] * w;
                    uint2 pk;
                    pk.x = g8::cvt_pk_bf16(silu_f(a[0]) * b[0], silu_f(a[1]) * b[1]);
                    pk.y = g8::cvt_pk_bf16(silu_f(a[2]) * b[2], silu_f(a[3]) * b[3]);
                    if (r < valid) stg<uint2>(ws, hoff + (unsigned)(r * 256 + hid) * 2u, pk);
                }
                __builtin_amdgcn_sched_barrier(0);
            }
    }
};
__device__ void phase_moe1(CParams& p, int l, char* lds) {
    int* sm = (int*)(lds + g8::STAGE_BYTES);
    moe_setup(p, sm);
    MoeSched S; S.sm = sm; S.ws = p.ws;
    S.A = (unsigned)OFF_XM; S.Ash = S.A; S.Bexp = (unsigned)OFF_EW13; S.Bsh = (unsigned)OFF_SH13T;
    S.c = blockIdx.x; S.G = gridDim.x; S.npn = 2; S.K = 1024; S.bstride_e = 512 * 1024 * 2; S.gather = 1; S.nsh = 64;
    Moe1Epi E; E.ws = p.ws; E.sm = sm;
    g8::gemm_phase<Moe1Epi, MoeSched, true>((LAS unsigned char*)lds, p.ws, 1024, S, E);
}
struct Moe2Epi {
    static constexpr bool PERM = true;
    unsigned char* ws;
    __device__ __forceinline__ void operator()(const f32x4 (&acc)[2][2][4][2], const g8::Unit& u, int wr, int wc, int fr, int fq) const {
        const int valid = u.x1 - u.pm * 256;
        const int colb = u.pn * 256 + wc * 32 + fq * 8;
        const unsigned lbase = (unsigned)(OFF_LIST + (u.x0 * NTOK + u.pm * 256 + wr * 64 + fr) * 4);
        int ent[2][4];
#pragma unroll
        for (int ai = 0; ai < 2; ++ai)
#pragma unroll
            for (int m = 0; m < 4; ++m) {
                const int r = ai * 128 + wr * 64 + m * 16 + fr;
                ent[ai][m] = (r < valid) ? ldg<int>(ws, lbase + (unsigned)((ai * 128 + m * 16) * 4)) : 0;
            }
#pragma unroll
        for (int ai = 0; ai < 2; ++ai)
#pragma unroll
            for (int m = 0; m < 4; ++m) {
                const int r = ai * 128 + wr * 64 + m * 16 + fr;
                if (r < valid) {
                    const unsigned o = (unsigned)OFF_YBUF + (unsigned)(ent[ai][m] * 1024 + colb) * 2u;
#pragma unroll
                    for (int bj = 0; bj < 2; ++bj) stg<uint4>(ws, o + bj * 256, pack8(acc[ai][bj][m][0], acc[ai][bj][m][1]));
                }
                __builtin_amdgcn_sched_barrier(0);
            }
    }
};
struct ShSched {
    int c, G;
    __device__ __forceinline__ bool next(int i, g8::Unit& u) const {
        const int L = i * G + c; if (L >= 64 * 4) return false;
        u.pm = L >> 2; u.pn = L & 3; u.A = (unsigned)OFF_HSH + (unsigned)u.pm * 256 * 256 * 2; u.B = (unsigned)OFF_SH2T + (unsigned)u.pn * 256 * 256 * 2; u.x0 = 64; u.x1 = NTOK; return true;
    }
    __device__ __forceinline__ int row(const g8::Unit&, int) const { return 0; }
};
struct ShEpi {
    static constexpr bool PERM = false;
    float* ysh;
    __device__ __forceinline__ void operator()(const f32x4 (&acc)[2][2][4][2], const g8::Unit& u, int wr, int wc, int fr, int fq) const {
#pragma unroll
        for (int ai = 0; ai < 2; ++ai)
#pragma unroll
            for (int m = 0; m < 4; ++m) {
                const int row = u.pm * 256 + ai * 128 + wr * 64 + m * 16 + fr;
#pragma unroll
                for (int bj = 0; bj < 2; ++bj)
#pragma unroll
                    for (int n = 0; n < 2; ++n)
                        stg<f32x4>(ysh, (unsigned)((row * 1024 + u.pn * 256 + bj * 128 + wc * 32 + n * 16 + fq * 4) * 4), acc[ai][bj][m][n]);
                __builtin_amdgcn_sched_barrier(0);
            }
    }
};
__device__ void phase_moe2(CParams& p, int l, char* lds) {
    int* sm = (int*)(lds + g8::STAGE_BYTES);
    moe_setup(p, sm);
    MoeSched S; S.sm = sm; S.ws = p.ws;
    S.A = (unsigned)OFF_HBUF; S.Ash = (unsigned)OFF_HSH; S.Bexp = (unsigned)OFF_EW2; S.Bsh = (unsigned)OFF_SH2T;
    S.c = blockIdx.x; S.G = gridDim.x; S.npn = 4; S.K = 256; S.bstride_e = 1024 * 256 * 2; S.gather = 0; S.nsh = 0;
    Moe2Epi E; E.ws = p.ws;
    g8::gemm_phase<Moe2Epi, MoeSched, false>((LAS unsigned char*)lds, p.ws, 256, S, E);
    ShSched S2; S2.c = (blockIdx.x + 128) & 255; S2.G = gridDim.x;
    ShEpi E2; E2.ysh = p.out;
    g8::gemm_phase<ShEpi, ShSched, false>((LAS unsigned char*)lds, p.ws, 256, S2, E2);
}

__device__ void conv_tile(const float* s1, const float* s2, int ldsrc, int K, int perm, u16* dst, int tile, float* lds) {
    const int tid = otid();
    const int ktiles = K >> 6;
    const int kt = tile % ktiles, nt = tile / ktiles;
    __syncthreads();
#pragma unroll 4
    for (int i = 0; i < 16; ++i) {
        int idx = tid + i * 256, kr = idx >> 6, nc = idx & 63;
        const float* s; int col;
        if (perm == 32) { s = (nc < 32) ? s1 : s2; col = nt * 32 + (nc & 31); }
        else if (perm == 16) { s = ((nc & 31) < 16) ? s1 : s2; col = (nt * 2 + (nc >> 5)) * 16 + (nc & 15); }
        else { s = s1; col = nt * 64 + nc; }
        lds[kr * 65 + nc] = s[(size_t)(kt * 64 + kr) * ldsrc + col];
    }
    __syncthreads();
#pragma unroll 4
    for (int i = 0; i < 16; ++i) {
        int idx = tid + i * 256, nr = idx >> 6, kc = idx & 63;
        dst[(size_t)(nt * 64 + nr) * K + kt * 64 + kc] = f2bf(lds[kc * 65 + nr]);
    }
}

__device__ void s5_precompute(CParams& p, int l, int g, float* lds) {
    const int tid = otid();
    float* Er = lds;
    float* Ei = Er + 64 * 17;
    float* Br = Ei + 64 * 17;
    float* Bi = Br + 1024;
    float* Cr = Bi + 1024;
    float* Ci = Cr + 1024;
    float* Kt = Ci + 1024;
    __syncthreads();
    const int lg = l * 32 + g;
    const float dt = expf(p.in[12][lg]);
    {
        const int pp = tid & 63, part = tid >> 6;
        const float ar = p.in[5][lg * 64 + pp], ai = p.in[6][lg * 64 + pp];
        for (int tau = part; tau <= 16; tau += 4) {
            float mag = expf((float)tau * ar * dt);
            float ang = (float)tau * ai * dt;
            Er[pp * 17 + tau] = mag * cosf(ang);
            Ei[pp * 17 + tau] = mag * sinf(ang);
        }
        float mag = expf(ar * dt), ang = ai * dt;
        float e1r = mag * cosf(ang) - 1.f, e1i = mag * sinf(ang);
        float den = ar * ar + ai * ai;
        float qr = (e1r * ar + e1i * ai) / den, qi = (e1i * ar - e1r * ai) / den;
        for (int c = part * 4; c < part * 4 + 4; ++c) {
            float br = p.in[7][((size_t)lg * 64 + pp) * 16 + c], bi = p.in[8][((size_t)lg * 64 + pp) * 16 + c];
            Br[pp * 16 + c] = qr * br - qi * bi;
            Bi[pp * 16 + c] = qr * bi + qi * br;
            Cr[c * 64 + pp] = p.in[9][((size_t)lg * 16 + c) * 64 + pp];
            Ci[c * 64 + pp] = p.in[10][((size_t)lg * 16 + c) * 64 + pp];
        }
    }
    __syncthreads();
    for (int i = 0; i < 16; ++i) {
        int idx = tid + i * 256, tau = idx >> 8, ch = (idx >> 4) & 15, c2 = idx & 15;
        float s = 0.f;
        for (int pp = 0; pp < 64; ++pp) {
            float cr = Cr[ch * 64 + pp], ci = Ci[ch * 64 + pp], er = Er[pp * 17 + tau], ei = Ei[pp * 17 + tau];
            float gr = cr * er - ci * ei, gi = cr * ei + ci * er;
            s += gr * Br[pp * 16 + c2] - gi * Bi[pp * 16 + c2];
        }
        Kt[idx] = s;
    }
    __syncthreads();
    u16* bta = (u16*)(p.ws + OFF_BTA) + (size_t)g * 128 * 256;
    for (int i = 0; i < 128; ++i) {
        int idx = tid + i * 256, pr = idx >> 8, k = idx & 255, s = k >> 4, ch = k & 15, pp = pr & 63;
        float er = Er[pp * 17 + 15 - s], ei = Ei[pp * 17 + 15 - s], br = Br[pp * 16 + ch], bi = Bi[pp * 16 + ch];
        float v = (pr < 64) ? (er * br - ei * bi) : (er * bi + ei * br);
        bta[idx] = f2bf(v);
    }
    u16* btc = (u16*)(p.ws + OFF_BTC) + (size_t)g * 256 * 384;
    for (int i = 0; i < 384; ++i) {
        int idx = tid + i * 256, n = idx / 384, k = idx - n * 384, j = n >> 4, ch = n & 15;
        float v;
        if (k < 256) {
            int s = k >> 4, c2 = k & 15;
            v = (s <= j) ? Kt[((j - s) * 16 + ch) * 16 + c2] : 0.f;
        } else {
            int pr = k - 256, pp = pr & 63;
            float cr = Cr[ch * 64 + pp], ci = Ci[ch * 64 + pp], er = Er[pp * 17 + j + 1], ei = Ei[pp * 17 + j + 1];
            float gr = cr * er - ci * ei, gi = cr * ei + ci * er;
            v = (pr < 64) ? gr : -gi;
        }
        btc[idx] = f2bf(v);
    }
}

constexpr int W_CONV_TILES = 2608;
__device__ void phase_w(CParams& p, int l, char* lds) {
    const int tid = otid();
    const int nunits = W_CONV_TILES + 32 + 1 + (l == 0 ? 1024 : 0);
    for (int u = VB; u < nunits; u += VG) {
        if (u < W_CONV_TILES) {
            int t = u;
            const float *s1, *s2 = nullptr; int ld, K, perm = 0; u16* dst;
            if (t < 1664) { s1 = p.in[1] + (size_t)l * DM * INC; ld = INC; K = 1024; dst = (u16*)(p.ws + OFF_WINT); }
            else if ((t -= 1664) < 384) { int k = t >> 7; t &= 127; s1 = p.in[22] + (size_t)(l * 3 + k) * 512 * 1024; ld = 1024; K = 512; dst = (u16*)(p.ws + OFF_WBRT) + (size_t)k * 1024 * 512; }
            else if ((t -= 384) < 256) { s1 = p.in[23] + (size_t)l * 1024 * 1024; ld = 1024; K = 1024; dst = (u16*)(p.ws + OFF_WOUTT); }
            else if ((t -= 256) < 64) { s1 = p.in[13] + (size_t)l * 512 * 512; ld = 512; K = 512; dst = (u16*)(p.ws + OFF_GLUT); }
            else if ((t -= 64) < 32) { int h = t >> 3; t &= 7; s1 = p.in[17] + (size_t)(l * 4 + h) * 128 * 128; s2 = p.in[19] + (size_t)(l * 4 + h) * 128 * 128; ld = 128; K = 128; perm = 32; dst = (u16*)(p.ws + OFF_RGT) + (size_t)h * 256 * 128; }
            else if ((t -= 32) < 128) { s1 = p.in[31] + (size_t)l * 1024 * 256; s2 = p.in[32] + (size_t)l * 1024 * 256; ld = 256; K = 1024; perm = 16; dst = (u16*)(p.ws + OFF_SH13T); }
            else if ((t -= 128) < 64) { s1 = p.in[33] + (size_t)l * 256 * 1024; ld = 1024; K = 256; dst = (u16*)(p.ws + OFF_SH2T); }
            else { t -= 64; s1 = p.in[26] + (size_t)l * 1024 * 64; ld = 64; K = 1024; dst = (u16*)(p.ws + OFF_ROUTT); }
            conv_tile(s1, s2, ld, K, perm, dst, t, (float*)lds);
        } else if (u < W_CONV_TILES + 32) {
            s5_precompute(p, l, u - W_CONV_TILES, (float*)lds);
        } else if (u == W_CONV_TILES + 32) {
            float* LB = (float*)(p.ws + OFF_LB);
            for (int c = tid; c < 512; c += 256) {
                float x0 = p.in[3][c], x1 = p.in[3][512 + c];
                LB[c] = (l == 0) ? 0.f : 1.f / (1.f + expf(x0 - x1));
            }
            if (tid < 64) ((int*)(p.ws + OFF_CUR))[tid] = 0;
        } else {
            int r0 = (u - (W_CONV_TILES + 33)) * 16;
            const float4* src = (const float4*)(p.in[0] + (size_t)r0 * DM);
            uint2* dst = (uint2*)((u16*)(p.ws + OFF_XB) + (size_t)r0 * DM);
            for (int i = tid; i < 16 * 256; i += 256) {
                float4 v = src[i];
                uint2 o; o.x = f2bf(v.x) | ((unsigned)f2bf(v.y) << 16); o.y = f2bf(v.z) | ((unsigned)f2bf(v.w) << 16);
                dst[i] = o;
            }
        }
    }
}

__device__ void hgrn_prep(CParams& p, int u) {
    const int tid = otid();
    const int h = u & 3, c = (u >> 2) & 63, b = u >> 8;
    const int r0 = b * SEQ + c * 64;
    const size_t cu = (size_t)((b * 4 + h) * 64 + c);
    if (tid < 128) {
        const int d = tid;
        float* lf = (float*)(p.ws + OFF_PLF) + (size_t)r0 * 512 + h * 128 + d;
        const u16* kk = (const u16*)(p.ws + OFF_PK) + (size_t)r0 * 512 + h * 128 + d;
        float bs[64];
#pragma unroll
        for (int s = 0; s < 64; ++s) bs[s] = lf[(size_t)s * 512];
        float run = 0.f;
#pragma unroll
        for (int s = 0; s < 64; ++s) { run += bs[s]; bs[s] = run; lf[(size_t)s * 512] = run; }
        const float btot = run;
        ((float*)(p.ws + OFF_DEC))[(size_t)(b * 64 + c) * 512 + h * 128 + d] = __expf(btot);
        u16* dst = (u16*)(p.ws + OFF_KTT) + (cu * 128 + d) * 64;
#pragma unroll
        for (int s8 = 0; s8 < 8; ++s8) {
            bf16x8 o;
#pragma unroll
            for (int e = 0; e < 8; ++e) {
                int s = s8 * 8 + e;
                o[e] = (short)f2bf(bf2f(kk[(size_t)s * 512]) * __expf(btot - bs[s]));
            }
            *(bf16x8*)(dst + s8 * 8) = o;
        }
    } else {
        const int v = tid - 128;
        const u16* vv = (const u16*)(p.ws + OFF_PV) + (size_t)r0 * 512 + h * 128 + v;
        u16* dst = (u16*)(p.ws + OFF_VT) + (cu * 128 + v) * 64;
#pragma unroll
        for (int s8 = 0; s8 < 8; ++s8) {
            bf16x8 o;
#pragma unroll
            for (int e = 0; e < 8; ++e) o[e] = (short)vv[(size_t)(s8 * 8 + e) * 512];
            *(bf16x8*)(dst + s8 * 8) = o;
        }
    }
}

__device__ void s5_gemm_a(CParams& p, int u, char* lds) {
    LANE_IDS;
    const int wr = wid >> 1, wc = wid & 1;
    const int g = u >> 3, tm = u & 7, row0 = tm * 128;
    unsigned char* ws = p.ws;
    const unsigned aoff = (unsigned)(OFF_PU + (size_t)g * NTOK * 16 * 2), boff = (unsigned)(OFF_BTA + (size_t)g * 128 * 256 * 2);
    f32x4 acc[4][4]; ZERO_ACC(acc, 4, 4);
    mma_glds<128, 128, 2, 2>(acc, 4, ws,
        [&](int r, int t) { return aoff + ((row0 + r) * 256 + t * 64) * 2; },
        [&](int c, int t) { return boff + (c * 256 + t * 64) * 2; }, NoHook(), lds);
    epi<4, 4, 64, 64>(acc, wr, wc, fq, fr, [&](int r, int cc, float v) {
        stg<float>(ws, (unsigned)(OFF_VC + (((row0 + r) * 32 + g) * 128 + cc) * 4), v); });
}

__device__ void rg_conv(CParams& p, int l, int u) {
    const int tid = otid();
    const u16* xr = (const u16*)(p.ws + OFF_PXR);
    u16* xc = (u16*)(p.ws + OFF_XC);
    const float* cw = p.in[15] + (size_t)l * 4 * 512;
    const float* cb = p.in[16] + (size_t)l * 512;
    for (int i = tid; i < 64 * 64; i += 256) {
        const int row = u * 64 + (i >> 6), c8 = (i & 63) * 8;
        const int t = row & (SEQ - 1);
        float a[8];
#pragma unroll
        for (int e = 0; e < 8; ++e) a[e] = cb[c8 + e];
#pragma unroll
        for (int j = 0; j < 4; ++j) {
            if (t - 3 + j >= 0) {
                bf16x8 x = *(const bf16x8*)(xr + (size_t)(row - 3 + j) * 512 + c8);
#pragma unroll
                for (int e = 0; e < 8; ++e) a[e] += cw[j * 512 + c8 + e] * bf2f((u16)x[e]);
            }
        }
        bf16x8 o;
#pragma unroll
        for (int e = 0; e < 8; ++e) o[e] = (short)f2bf(a[e]);
        *(bf16x8*)(xc + (size_t)row * 512 + c8) = o;
    }
}

__device__ void phase2(CParams& p, int l, char* lds) {
    for (int u = VB; u < 1536; u += VG) {
        if (u < 1024) hgrn_prep(p, u);
        else if (u < 1280) s5_gemm_a(p, u - 1024, lds);
        else rg_conv(p, l, u - 1280);
    }
}

__device__ void hgrn_u(CParams& p, int u, char* lds) {
    LANE_IDS;
    const int wr = wid >> 1, wc = wid & 1;
    unsigned char* ws = p.ws;
    f32x4 acc[4][4]; ZERO_ACC(acc, 4, 4);
    mma_glds<128, 128, 2, 2>(acc, 1, ws,
        [&](int r, int t) { return (unsigned)(OFF_KTT + ((u * 128 + r) * 64) * 2); },
        [&](int c, int t) { return (unsigned)(OFF_VT + ((u * 128 + c) * 64) * 2); }, NoHook(), lds);
#pragma unroll
    for (int m = 0; m < 4; ++m) {
#pragma unroll
        for (int n = 0; n < 4; ++n) {
            const int d0 = wr * 64 + m * 16 + fq * 4, v = wc * 64 + n * 16 + fr;
            uint2 o;
            o.x = f2bf(acc[m][n][0]) | ((unsigned)f2bf(acc[m][n][1]) << 16);
            o.y = f2bf(acc[m][n][2]) | ((unsigned)f2bf(acc[m][n][3]) << 16);
            stg<uint2>(ws, (unsigned)(OFF_UT + ((u * 128 + v) * 128 + d0) * 2), o);
        }
        __builtin_amdgcn_sched_barrier(0);
    }
}

__device__ void hgrn_sscan(CParams& p, int u) {
    const int tid = otid();
    const int bh = u >> 4, ec = (u & 15) * 256 + tid, v = ec >> 5, d4 = (ec & 31) * 4;
    const int b = bh >> 2, h = bh & 3;
    unsigned char* ws = p.ws;
    const unsigned ub = (unsigned)(OFF_UT + ((bh * 64 * 128 + v) * 128 + d4) * 2);
    const unsigned sb = (unsigned)(OFF_ST + ((bh * 64 * 128 + v) * 128 + d4) * 2);
    const unsigned db = (unsigned)(OFF_DEC + ((b * 64) * 512 + h * 128 + d4) * 4);
    f32x4 S = {0.f, 0.f, 0.f, 0.f};
    for (int c0 = 0; c0 < 64; c0 += 8) {
        uint2 uu[8]; f32x4 dd[8];
#pragma unroll
        for (int i = 0; i < 8; ++i) { uu[i] = ldg<uint2>(ws, ub + (unsigned)((c0 + i) * 128 * 128 * 2)); dd[i] = ldg<f32x4>(ws, db + (unsigned)((c0 + i) * 512 * 4)); }
#pragma unroll
        for (int i = 0; i < 8; ++i) {
            uint2 o;
            o.x = f2bf(S[0]) | ((unsigned)f2bf(S[1]) << 16); o.y = f2bf(S[2]) | ((unsigned)f2bf(S[3]) << 16);
            stg<uint2>(ws, sb + (unsigned)((c0 + i) * 128 * 128 * 2), o);
            S[0] = dd[i][0] * S[0] + bf2f((u16)(uu[i].x & 0xffff)); S[1] = dd[i][1] * S[1] + bf2f((u16)(uu[i].x >> 16));
            S[2] = dd[i][2] * S[2] + bf2f((u16)(uu[i].y & 0xffff)); S[3] = dd[i][3] * S[3] + bf2f((u16)(uu[i].y >> 16));
        }
    }
}

__device__ void s5_scan(CParams& p, int l, int u, char* lds) {
    const int tid = otid();
    const int b = u >> 5, g = u & 31, seg = tid >> 6, pp = tid & 63;
    const int lg = l * 32 + g;
    const float dt = expf(p.in[12][lg]);
    const float ar = p.in[5][lg * 64 + pp], ai = p.in[6][lg * 64 + pp];
    const float mag = expf(16.f * ar * dt), ang = 16.f * ai * dt;
    const float er = mag * cosf(ang), ei = mag * sinf(ang);
    const float mg2 = expf(1024.f * ar * dt), an2 = 1024.f * ai * dt;
    const float sr = mg2 * cosf(an2), si = mg2 * sinf(an2);
    unsigned char* ws = p.ws;
    const unsigned vb = (unsigned)(OFF_VC + (((b * 256 + seg * 64) * 32 + g) * 128 + pp) * 4);
    const unsigned hb = (unsigned)(OFF_HC + (((b * 256 + seg * 64) * 32 + g) * 128 + pp) * 2);
    float* ex = (float*)lds;
    __syncthreads();
    float hr = 0.f, hi = 0.f;
    for (int c0 = 0; c0 < 64; c0 += 16) {
        float vr[16], vi[16];
#pragma unroll
        for (int i = 0; i < 16; ++i) { vr[i] = ldg<float>(ws, vb + (unsigned)((c0 + i) * 4096 * 4)); vi[i] = ldg<float>(ws, vb + (unsigned)((c0 + i) * 4096 * 4 + 256)); }
#pragma unroll
        for (int i = 0; i < 16; ++i) { const float nr = er * hr - ei * hi + vr[i], ni = er * hi + ei * hr + vi[i]; hr = nr; hi = ni; }
    }
    ex[(seg * 64 + pp) * 2] = hr; ex[(seg * 64 + pp) * 2 + 1] = hi;
    __syncthreads();
    hr = 0.f; hi = 0.f;
    for (int sg = 0; sg < seg; ++sg) {
        const float lr = ex[(sg * 64 + pp) * 2], li = ex[(sg * 64 + pp) * 2 + 1];
        const float nr = sr * hr - si * hi + lr, ni = sr * hi + si * hr + li; hr = nr; hi = ni;
    }
    for (int c0 = 0; c0 < 64; c0 += 16) {
        float vr[16], vi[16];
#pragma unroll
        for (int i = 0; i < 16; ++i) { vr[i] = ldg<float>(ws, vb + (unsigned)((c0 + i) * 4096 * 4)); vi[i] = ldg<float>(ws, vb + (unsigned)((c0 + i) * 4096 * 4 + 256)); }
#pragma unroll
        for (int i = 0; i < 16; ++i) {
            stg<u16>(ws, hb + (unsigned)((c0 + i) * 4096 * 2), f2bf(hr));
            stg<u16>(ws, hb + (unsigned)((c0 + i) * 4096 * 2 + 128), f2bf(hi));
            const float nr = er * hr - ei * hi + vr[i], ni = er * hi + ei * hr + vi[i]; hr = nr; hi = ni;
        }
    }
}

__device__ void rg_gemm(CParams& p, int l, int u, char* lds) {
    LANE_IDS;
    const int wr = wid >> 1, wc = wid & 1;
    const int tm = u >> 3, h = (u >> 1) & 3, nt = u & 1, row0 = tm * 128;
    unsigned char* ws = p.ws;
    const unsigned aoff = (unsigned)(OFF_XC + h * 128 * 2), boff = (unsigned)(OFF_RGT + ((size_t)h * 256 * 128 + (size_t)nt * 128 * 128) * 2);
    f32x4 acc[4][4]; ZERO_ACC(acc, 4, 4);
    mma_glds<128, 128, 2, 2>(acc, 2, ws,
        [&](int r, int t) { return aoff + ((row0 + r) * 512 + t * 64) * 2; },
        [&](int c, int t) { return boff + (c * 128 + t * 64) * 2; }, NoHook(), lds);
    const float* ba = p.in[18] + (size_t)l * 512;
    const float* bx = p.in[20] + (size_t)l * 512;
    const float* lam = p.in[21] + (size_t)l * 512;
#pragma unroll
    for (int n = 0; n < 2; ++n) {
        const int ch = h * 128 + (nt * 2 + wc) * 32 + n * 16 + fr;
        const float c1 = -8.f * log1pf(expf(-lam[ch]));
        const float bav = ba[ch], bxv = bx[ch];
#pragma unroll
        for (int m = 0; m < 4; ++m) {
#pragma unroll
            for (int j = 0; j < 4; ++j) {
                const int row = row0 + wr * 64 + m * 16 + fq * 4 + j;
                const float r = sigm(acc[m][n][j] + bav), ig = sigm(acc[m][n + 2][j] + bxv);
                const float la = c1 * r;
                const float x = bf2f(ldg<u16>(ws, (unsigned)(OFF_XC + (row * 512 + ch) * 2)));
                const float bb = sqrtf(fmaxf(1.f - __expf(2.f * la), 0.f)) * ig * x;
                stg<u16>(ws, (unsigned)(OFF_LA + (row * 512 + ch) * 2), f2bf(la));
                stg<u16>(ws, (unsigned)(OFF_BB + (row * 512 + ch) * 2), f2bf(bb));
            }
            __builtin_amdgcn_sched_barrier(0);
        }
    }
}

__device__ void phase3(CParams& p, int l, char* lds) {
    for (int u = VB; u < 2176; u += VG) {
        if (u < 128) s5_scan(p, l, u, lds);
        else if (u < 1152) hgrn_u(p, u - 128, lds);
        else rg_gemm(p, l, u - 1152, lds);
    }
}

__device__ void hgrn_out(CParams& p, int l, int u, char* lds) {
    LANE_IDS;
    const int h = u & 3, c = (u >> 2) & 63, b = u >> 8;
    const int r0 = b * SEQ + c * 64;
    const size_t cu = (size_t)((b * 4 + h) * 64 + c);
    const u16* Pq = (const u16*)(p.ws + OFF_PQ) + (size_t)r0 * 512 + h * 128;
    const u16* Pk = (const u16*)(p.ws + OFF_PK) + (size_t)r0 * 512 + h * 128;
    const float* Bc = (const float*)(p.ws + OFF_PLF) + (size_t)r0 * 512 + h * 128;
    char* Ss = lds + (64 + 128) * 128;
    __syncthreads();
    {
        const int i = wid;
        const int t = 16 * i + fr;
        bf16x8 aq[4];
        float refv[4][8];
#pragma unroll
        for (int kk = 0; kk < 4; ++kk) {
            const int d0 = kk * 32 + fq * 8;
            bf16x8 q8 = *(const bf16x8*)(Pq + (size_t)t * 512 + d0);
#pragma unroll
            for (int e = 0; e < 8; ++e) {
                float rf = (i == 0) ? 0.f : Bc[(size_t)(16 * i - 1) * 512 + d0 + e];
                refv[kk][e] = rf;
                float bt = Bc[(size_t)t * 512 + d0 + e];
                aq[kk][e] = (short)f2bf(bf2f((u16)q8[e]) * __expf(bt - rf));
            }
        }
#pragma unroll
        for (int j = 0; j < 4; ++j) {
            f32x4 sc = {0.f, 0.f, 0.f, 0.f};
            if (j <= i) {
                const int s = 16 * j + fr;
#pragma unroll
                for (int kk = 0; kk < 4; ++kk) {
                    const int d0 = kk * 32 + fq * 8;
                    bf16x8 k8 = *(const bf16x8*)(Pk + (size_t)s * 512 + d0);
                    bf16x8 bk;
#pragma unroll
                    for (int e = 0; e < 8; ++e) {
                        float bsv = Bc[(size_t)s * 512 + d0 + e];
                        bk[e] = (short)f2bf(bf2f((u16)k8[e]) * __expf(fminf(refv[kk][e] - bsv, 60.f)));
                    }
                    sc = __builtin_amdgcn_mfma_f32_16x16x32_bf16(aq[kk], bk, sc, 0, 0, 0);
                }
            }
#pragma unroll
            for (int r = 0; r < 4; ++r) {
                const int tl = fq * 4 + r, sl = fr;
                float v = sc[r];
                if (j > i || (j == i && sl > tl)) v = 0.f;
                const int row = 16 * i + tl, col = 16 * j + sl;
                *(u16*)(Ss + swz(row, col >> 3) + (col & 7) * 2) = f2bf(v);
            }
        }
    }
    __syncthreads();
    const u16* STc = (const u16*)(p.ws + OFF_ST) + cu * 128 * 128;
    const u16* VTc = (const u16*)(p.ws + OFF_VT) + cu * 128 * 64;
    f32x4 acc[1][8]; ZERO_ACC(acc, 1, 8);
    mma_loop<64, 128, 4, 1>(acc, 3,
        [&](int r, int k) {
            bf16x8 o;
            if (k < 128) {
                bf16x8 q8 = *(const bf16x8*)(Pq + (size_t)r * 512 + k);
                const float4 b0 = *(const float4*)(Bc + (size_t)r * 512 + k), b1 = *(const float4*)(Bc + (size_t)r * 512 + k + 4);
                o[0] = (short)f2bf(bf2f((u16)q8[0]) * __expf(b0.x)); o[1] = (short)f2bf(bf2f((u16)q8[1]) * __expf(b0.y));
                o[2] = (short)f2bf(bf2f((u16)q8[2]) * __expf(b0.z)); o[3] = (short)f2bf(bf2f((u16)q8[3]) * __expf(b0.w));
                o[4] = (short)f2bf(bf2f((u16)q8[4]) * __expf(b1.x)); o[5] = (short)f2bf(bf2f((u16)q8[5]) * __expf(b1.y));
                o[6] = (short)f2bf(bf2f((u16)q8[6]) * __expf(b1.z)); o[7] = (short)f2bf(bf2f((u16)q8[7]) * __expf(b1.w));
            } else {
                o = *(const bf16x8*)(Ss + swz(r, (k - 128) >> 3));
            }
            return o;
        },
        [&](int cc, int k) {
            return (k < 128) ? *(const bf16x8*)(STc + (size_t)cc * 128 + k) : *(const bf16x8*)(VTc + (size_t)cc * 64 + (k - 128));
        }, NoHook(), lds);
    const float* nw = p.in[4] + (size_t)l * 512 + h * 128;
    const u16* Pg = (const u16*)(p.ws + OFF_PG) + (size_t)r0 * 512 + h * 128;
    u16* Ya = (u16*)(p.ws + OFF_YA) + (size_t)r0 * 512 + h * 128;
#pragma unroll
    for (int j = 0; j < 4; ++j) {
        float ss = 0.f;
#pragma unroll
        for (int n = 0; n < 8; ++n) ss += acc[0][n][j] * acc[0][n][j];
        ss += shfl_xor_l(ss, 1, lane); ss += shfl_xor_l(ss, 2, lane); ss += shfl_xor_l(ss, 4, lane); ss += shfl_xor_l(ss, 8, lane);
        const float rs = rsqrtf(ss * (1.f / 128.f) + 1e-6f);
        const int row = wid * 16 + fq * 4 + j;
#pragma unroll
        for (int n = 0; n < 8; ++n) {
            const int v = n * 16 + fr;
            Ya[(size_t)row * 512 + v] = f2bf(acc[0][n][j] * rs * nw[v] * bf2f(Pg[(size_t)row * 512 + v]));
        }
    }
}

__device__ void s5_gemm_c(CParams& p, int l, int u, char* lds) {
    LANE_IDS;
    const int wr = wid >> 1, wc = wid & 1;
    const int g = u >> 4, tm = (u >> 1) & 7, tn = u & 1, row0 = tm * 128, col0 = tn * 128;
    unsigned char* ws = p.ws;
    const unsigned aoff = (unsigned)(OFF_PU + (size_t)g * NTOK * 16 * 2), boff = (unsigned)(OFF_BTC + (size_t)g * 256 * 384 * 2);
    f32x4 acc[4][4]; ZERO_ACC(acc, 4, 4);
    mma_glds<128, 128, 2, 2>(acc, 6, ws,
        [&](int r, int t) {
            return (t < 4) ? aoff + ((row0 + r) * 256 + t * 64) * 2 : (unsigned)(OFF_HC + (((row0 + r) * 32 + g) * 128 + (t - 4) * 64) * 2);
        },
        [&](int c, int t) { return boff + ((col0 + c) * 384 + t * 64) * 2; }, NoHook(), lds);
    const float dch = p.in[11][(size_t)l * 512 + g * 16 + fr];
    epi<4, 4, 64, 64>(acc, wr, wc, fq, fr, [&](int r, int cc, float v) {
        const int row = row0 + r, col = col0 + cc;
        const int jj = col >> 4, ch = col & 15;
        const int tok = (row >> 8) * SEQ + (row & 255) * 16 + jj;
        const float uu = bf2f(ldg<u16>(ws, aoff + (tok * 16 + ch) * 2));
        const float y = v + dch * uu;
        stg<u16>(ws, (unsigned)(OFF_YG + (tok * 512 + g * 16 + ch) * 2), f2bf(gelu_f(y))); });
}

__device__ void rg_local(CParams& p, int u) {
    const int tid = otid();
    const int b = u >> 7, seg = (u >> 1) & 63, ch = (u & 1) * 256 + tid;
    unsigned char* ws = p.ws;
    const unsigned base = (unsigned)(((b * SEQ + seg * 64) * 512 + ch) * 2);
    float hh = 0.f, ap = 1.f;
    for (int s0 = 0; s0 < 64; s0 += 16) {
        float a[16], bb[16];
#pragma unroll
        for (int i = 0; i < 16; ++i) { a[i] = bf2f(ldg<u16>(ws, (unsigned)OFF_LA + base + (unsigned)((s0 + i) * 1024))); bb[i] = bf2f(ldg<u16>(ws, (unsigned)OFF_BB + base + (unsigned)((s0 + i) * 1024))); }
#pragma unroll
        for (int i = 0; i < 16; ++i) { const float av = __expf(a[i]); hh = av * hh + bb[i]; ap *= av; }
    }
    stg<float>(ws, (unsigned)(OFF_SEGA + ((b * 64 + seg) * 512 + ch) * 4), ap);
    stg<float>(ws, (unsigned)(OFF_SEGH + ((b * 64 + seg) * 512 + ch) * 4), hh);
}

__device__ void rg_final(CParams& p, int u) {
    const int tid = otid();
    const int b = u >> 7, seg = (u >> 1) & 63, ch = (u & 1) * 256 + tid;
    unsigned char* ws = p.ws;
    const unsigned base = (unsigned)(((b * SEQ + seg * 64) * 512 + ch) * 2);
    float hh = 0.f;
    for (int sg = 0; sg < seg; ++sg) {
        const float sa = ldg<float>(ws, (unsigned)(OFF_SEGA + ((b * 64 + sg) * 512 + ch) * 4));
        const float sh = ldg<float>(ws, (unsigned)(OFF_SEGH + ((b * 64 + sg) * 512 + ch) * 4));
        hh = sa * hh + sh;
    }
    for (int s0 = 0; s0 < 64; s0 += 16) {
        float a[16], bb[16], xg[16];
#pragma unroll
        for (int i = 0; i < 16; ++i) {
            a[i] = bf2f(ldg<u16>(ws, (unsigned)OFF_LA + base + (unsigned)((s0 + i) * 1024)));
            bb[i] = bf2f(ldg<u16>(ws, (unsigned)OFF_BB + base + (unsigned)((s0 + i) * 1024)));
            xg[i] = bf2f(ldg<u16>(ws, (unsigned)OFF_PXG + base + (unsigned)((s0 + i) * 1024)));
        }
#pragma unroll
        for (int i = 0; i < 16; ++i) { hh = __expf(a[i]) * hh + bb[i]; stg<u16>(ws, (unsigned)OFF_YC + base + (unsigned)((s0 + i) * 1024), f2bf(hh * xg[i])); }
    }
}

__device__ void phase4(CParams& p, int l, char* lds) {
    for (int u = VB; u < 1280; u += VG) {
        if (u < 256) hgrn_sscan(p, u);
        else if (u < 768) rg_local(p, u - 256);
        else s5_gemm_c(p, l, u - 768, lds);
    }
}

__device__ void phase_glu(CParams& p, int l, char* lds) {
    LANE_IDS;
    const int wr = wid >> 1, wc = wid & 1;
    unsigned char* ws = p.ws;
    const float* gb = p.in[14] + (size_t)l * 512;
    for (int uu = VB; uu < 2048; uu += VG) {
        if (uu < 1024) { hgrn_out(p, l, uu, lds); continue; }
        if (uu < 1536) { rg_final(p, uu - 1024); continue; }
        const int u = uu - 1536;
        const int row0 = (u >> 2) * 128, col0 = (u & 3) * 128;
        f32x4 acc[4][4]; ZERO_ACC(acc, 4, 4);
        mma_glds<128, 128, 2, 2>(acc, 8, ws,
            [&](int r, int t) { return (unsigned)(OFF_YG + ((row0 + r) * 512 + t * 64) * 2); },
            [&](int c, int t) { return (unsigned)(OFF_GLUT + ((col0 + c) * 512 + t * 64) * 2); }, NoHook(), lds);
        epi<4, 4, 64, 64>(acc, wr, wc, fq, fr, [&](int r, int cc, float v) {
            const int row = row0 + r, col = col0 + cc;
            const float y = bf2f(ldg<u16>(ws, (unsigned)(OFF_YG + (row * 512 + col) * 2)));
            stg<u16>(ws, (unsigned)(OFF_YB + (row * 512 + col) * 2), f2bf(y * sigm(v + gb[col]))); });
    }
}

__device__ void phase_branch(CParams& p, int l, char* lds) {
    LANE_IDS;
    const int wr = wid >> 1, wc = wid & 1;
    unsigned char* ws = p.ws;
    for (int u = VB; u < 2048; u += VG) {
        const int row0 = (u >> 4) * 128, col0 = (u & 15) * 64;
        f32x4 tot[4][2]; ZERO_ACC(tot, 4, 2);
#pragma unroll 1
        for (int kb = 0; kb < 3; ++kb) {
            const unsigned yoff = (unsigned)(kb == 0 ? OFF_YA : (kb == 1 ? OFF_YB : OFF_YC));
            const unsigned boff = (unsigned)(OFF_WBRT + (size_t)kb * 1024 * 512 * 2);
            f32x4 acc[4][2]; ZERO_ACC(acc, 4, 2);
            mma_glds<128, 64, 2, 2>(acc, 8, ws,
                [&](int r, int t) { return yoff + ((row0 + r) * 512 + t * 64) * 2; },
                [&](int c, int t) { return boff + ((col0 + c) * 512 + t * 64) * 2; }, NoHook(), lds);
#pragma unroll
            for (int m = 0; m < 4; ++m) {
#pragma unroll
                for (int j = 0; j < 4; ++j)
#pragma unroll
                    for (int n = 0; n < 2; ++n) {
                        const int row = row0 + wr * 64 + m * 16 + fq * 4 + j, col = col0 + wc * 32 + n * 16 + fr;
                        tot[m][n][j] += bf2f(ldg<u16>(ws, (unsigned)(OFF_PGATE + (row * 3072 + kb * 1024 + col) * 2))) * acc[m][n][j];
                    }
                __builtin_amdgcn_sched_barrier(0);
            }
        }
        epi<4, 2, 64, 32>(tot, wr, wc, fq, fr, [&](int r, int cc, float v) {
            stg<u16>(ws, (unsigned)(OFF_MIXP + ((row0 + r) * 1024 + col0 + cc) * 2), f2bf(v)); });
    }
}

__device__ void phase_out(CParams& p, int l, char* lds, char* hlds) {
    {
        OutSched S; S.A = (unsigned)OFF_MIXP; S.B = (unsigned)OFF_WOUTT; S.c = blockIdx.x; S.G = gridDim.x;
        OutEpi E; E.ws = p.ws; E.xres = (l == 0) ? p.in[0] : p.out;
        g8::gemm_phase<OutEpi, OutSched, false>((LAS unsigned char*)lds, p.ws, 1024, S, E);
    }
    for (int u = VB; u < 12288; u += VG) {
        const int e = u / 192, r = u % 192;
        if (r < 128)
            conv_tile(p.in[28] + (size_t)(l * 64 + e) * 1024 * 256, p.in[29] + (size_t)(l * 64 + e) * 1024 * 256, 256, 1024, 16,
                      (u16*)(p.ws + OFF_EW13) + (size_t)e * 512 * 1024, r, (float*)hlds);
        else
            conv_tile(p.in[30] + (size_t)(l * 64 + e) * 256 * 1024, nullptr, 1024, 256, 0,
                      (u16*)(p.ws + OFF_EW2) + (size_t)e * 1024 * 256, r - 128, (float*)hlds);
    }
}

__device__ __forceinline__ void ln_row(float (&v)[16], const float* g, const float* bta, int lane) {
    float s = 0.f;
#pragma unroll
    for (int i = 0; i < 16; ++i) s += v[i];
    const float mu = wave_sum(s, lane) * (1.f / 1024.f);
    float q = 0.f;
#pragma unroll
    for (int i = 0; i < 16; ++i) { float d = v[i] - mu; q += d * d; }
    const float rs = rsqrtf(wave_sum(q, lane) * (1.f / 1024.f) + 1e-5f);
#pragma unroll
    for (int i = 0; i < 4; ++i) {
        const float4 gg = *(const float4*)(g + i * 256 + lane * 4), bb = *(const float4*)(bta + i * 256 + lane * 4);
        v[i * 4 + 0] = (v[i * 4 + 0] - mu) * rs * gg.x + bb.x;
        v[i * 4 + 1] = (v[i * 4 + 1] - mu) * rs * gg.y + bb.y;
        v[i * 4 + 2] = (v[i * 4 + 2] - mu) * rs * gg.z + bb.z;
        v[i * 4 + 3] = (v[i * 4 + 3] - mu) * rs * gg.w + bb.w;
    }
}

__device__ void phase_route(CParams& p, int l, char* lds) {
    LANE_IDS;
    const float* Pre = (const float*)(p.ws + OFF_PRELN);
    u16* Xm = (u16*)(p.ws + OFF_XM);
    const float* g1 = p.in[24] + (size_t)l * 1024;
    const float* b1 = p.in[25] + (size_t)l * 1024;
    const float* rbias = p.in[27] + (size_t)l * 64;
    int* cursor = (int*)(p.ws + OFF_CUR);
    int* list = (int*)(p.ws + OFF_LIST);
    float* wlist = (float*)(p.ws + OFF_WLIST);
    float* Ls = (float*)(lds + 32768);
    int* hist = (int*)(lds + 32768 + 64 * 65 * 4);
    int* basep = hist + 64;
    for (int u = VB; u < 256; u += VG) {
        const int row0 = u * 64;
        for (int rr = 0; rr < 16; ++rr) {
            const int row = row0 + wid * 16 + rr;
            float v[16];
#pragma unroll
            for (int i = 0; i < 4; ++i) {
                const float4 x = *(const float4*)(Pre + (size_t)row * 1024 + i * 256 + lane * 4);
                v[i * 4] = x.x; v[i * 4 + 1] = x.y; v[i * 4 + 2] = x.z; v[i * 4 + 3] = x.w;
            }
            ln_row(v, g1, b1, lane);
#pragma unroll
            for (int i = 0; i < 4; ++i) {
                uint2 o; o.x = f2bf(v[i * 4]) | ((unsigned)f2bf(v[i * 4 + 1]) << 16); o.y = f2bf(v[i * 4 + 2]) | ((unsigned)f2bf(v[i * 4 + 3]) << 16);
                *(uint2*)(Xm + (size_t)row * 1024 + i * 256 + lane * 4) = o;
            }
        }
        if (tid < 64) hist[tid] = 0;
        __syncthreads();
        f32x4 acc[1][4]; ZERO_ACC(acc, 1, 4);
        mma_glds<64, 64, 4, 1>(acc, 16, p.ws,
            [&](int r, int t) { return (unsigned)(OFF_XM + ((row0 + r) * 1024 + t * 64) * 2); },
            [&](int c, int t) { return (unsigned)(OFF_ROUTT + (c * 1024 + t * 64) * 2); }, NoHook(), lds);
#pragma unroll
        for (int n = 0; n < 4; ++n)
#pragma unroll
            for (int j = 0; j < 4; ++j) {
                const int r = wid * 16 + fq * 4 + j, e = n * 16 + fr;
                Ls[r * 65 + e] = sigm(acc[0][n][j]) + rbias[e];
            }
        __syncthreads();
        int myrank[8]; int myexp[8]; float wv[8];
        if (tid < 64) {
            float* sc = Ls + tid * 65;
            float gs[8];
#pragma unroll
            for (int g = 0; g < 8; ++g) {
                float m1 = -1e30f, m2 = -1e30f;
#pragma unroll
                for (int i = 0; i < 8; ++i) { float x = sc[g * 8 + i]; if (x > m1) { m2 = m1; m1 = x; } else if (x > m2) m2 = x; }
                gs[g] = m1 + m2;
            }
            unsigned gmask = 0;
#pragma unroll
            for (int it = 0; it < 4; ++it) {
                float best = -1e30f; int bi = 0;
#pragma unroll
                for (int g = 0; g < 8; ++g) { bool ok = !((gmask >> g) & 1u) && gs[g] > best; if (ok) { best = gs[g]; bi = g; } }
                gmask |= 1u << bi;
            }
            unsigned long long chosen = 0ull;
            float wsum = 0.f;
#pragma unroll
            for (int k = 0; k < 8; ++k) {
                float best = -1e30f; int bi = 0;
                for (int e = 0; e < 64; ++e) {
                    float x = sc[e];
                    bool ok = ((gmask >> (e >> 3)) & 1u) && !((chosen >> e) & 1ull) && x > best;
                    if (ok) { best = x; bi = e; }
                }
                chosen |= 1ull << bi;
                myexp[k] = bi;
                wv[k] = best - rbias[bi];
                wsum += wv[k];
            }
            const float sc_ = 2.5f / wsum;
#pragma unroll
            for (int k = 0; k < 8; ++k) {
                wv[k] *= sc_;
                myrank[k] = atomicAdd(&hist[myexp[k]], 1);
            }
        }
        __syncthreads();
        if (tid < 64) basep[tid] = atomicAdd(&cursor[tid], hist[tid]);
        __syncthreads();
        if (tid < 64) {
#pragma unroll
            for (int k = 0; k < 8; ++k) {
                const size_t pos = (size_t)myexp[k] * NTOK + basep[myexp[k]] + myrank[k];
                list[pos] = (row0 + tid) * 8 + k;
                wlist[pos] = wv[k];
            }
        }
        __syncthreads();
    }
}

__device__ void phase_combine(CParams& p, int l) {
    LANE_IDS;
    const u16* Xm = (const u16*)(p.ws + OFF_XM);
    const u16* Yb = (const u16*)(p.ws + OFF_YBUF);
    const float* g2 = p.in[34] + (size_t)l * 1024;
    const float* b2 = p.in[35] + (size_t)l * 1024;
    u16* Xb = (u16*)(p.ws + OFF_XB);
    for (int row = VB * 4 + wid; row < NTOK; row += VG * 4) {
        float v[16];
#pragma unroll
        for (int i = 0; i < 4; ++i) {
            const float4 y = *(const float4*)(p.out + (size_t)row * 1024 + i * 256 + lane * 4);
            const uint2 x = *(const uint2*)(Xm + (size_t)row * 1024 + i * 256 + lane * 4);
            v[i * 4 + 0] = y.x + DN_ALPHA * bf2f((u16)(x.x & 0xffff));
            v[i * 4 + 1] = y.y + DN_ALPHA * bf2f((u16)(x.x >> 16));
            v[i * 4 + 2] = y.z + DN_ALPHA * bf2f((u16)(x.y & 0xffff));
            v[i * 4 + 3] = y.w + DN_ALPHA * bf2f((u16)(x.y >> 16));
        }
#pragma unroll
        for (int k = 0; k < 8; ++k)
#pragma unroll
            for (int i = 0; i < 4; ++i) {
                const uint2 x = *(const uint2*)(Yb + ((size_t)row * 8 + k) * 1024 + i * 256 + lane * 4);
                v[i * 4 + 0] += bf2f((u16)(x.x & 0xffff));
                v[i * 4 + 1] += bf2f((u16)(x.x >> 16));
                v[i * 4 + 2] += bf2f((u16)(x.y & 0xffff));
                v[i * 4 + 3] += bf2f((u16)(x.y >> 16));
            }
        ln_row(v, g2, b2, lane);
#pragma unroll
        for (int i = 0; i < 4; ++i) {
            *(float4*)(p.out + (size_t)row * 1024 + i * 256 + lane * 4) = float4{v[i * 4], v[i * 4 + 1], v[i * 4 + 2], v[i * 4 + 3]};
            uint2 o; o.x = f2bf(v[i * 4]) | ((unsigned)f2bf(v[i * 4 + 1]) << 16); o.y = f2bf(v[i * 4 + 2]) | ((unsigned)f2bf(v[i * 4 + 3]) << 16);
            *(uint2*)(Xb + (size_t)row * 1024 + i * 256 + lane * 4) = o;
        }
    }
}


#define XB_TMO      128
#define XB_XCNT(j)  (256  + 64 * (j))
#define XB_XSUB(j)  (1280 + 64 * (j))
#define XB_XGEN(j)  (2304 + 64 * (j))
#define XB_TOP      3328
#define XB_TOPGEN   3392
#define XCD_BAR_WORDS 3456
#define XB_SPIN_CAP (1u << 22)
__device__ __forceinline__ unsigned xb_ld(unsigned* p)              { return __hip_atomic_load(p, __ATOMIC_RELAXED, __HIP_MEMORY_SCOPE_AGENT); }
__device__ __forceinline__ unsigned xb_add(unsigned* p, unsigned v) { return __hip_atomic_fetch_add(p, v, __ATOMIC_RELAXED, __HIP_MEMORY_SCOPE_AGENT); }
__device__ __forceinline__ unsigned xb_xcc_id() { return (unsigned)__builtin_amdgcn_s_getreg((3 << 11) | 20) & 0xFu; }
#define XB_SPIN(cond, bar) do { unsigned _sp = 0; while (cond) { __builtin_amdgcn_s_sleep(1); \
    if ((++_sp & 255u) == 0u) { if (xb_ld(&(bar)[XB_TMO])) break; if (_sp > XB_SPIN_CAP) { atomicAdd(&(bar)[XB_TMO], 1u); break; } } } } while (0)
struct XcdBarrier { unsigned* bar; unsigned x; volatile LAS unsigned* st; };
__device__ __forceinline__ XcdBarrier xcd_barrier_post(unsigned* bar, volatile LAS unsigned* st) {
    XcdBarrier b; b.bar = bar; b.x = xb_xcc_id(); b.st = st;
    if (threadIdx.x == 0) (void)xb_add(&bar[XB_XCNT(b.x)], 1u);
    return b;
}
__device__ __forceinline__ void xcd_barrier_complete(unsigned* bar, unsigned x, unsigned& nloc, unsigned& nx) {
    const unsigned G = gridDim.x * gridDim.y * gridDim.z;
    unsigned sum, cnt, mine, sp = 0u;
    for (;;) {
        sum = 0u; cnt = 0u; mine = 0u;
#pragma unroll
        for (unsigned j = 0; j < 16; ++j) { const unsigned c = xb_ld(&bar[XB_XCNT(j)]); sum += c; cnt += (c > 0u) ? 1u : 0u; mine = (j == x) ? c : mine; }
        if (sum == G) break;
        __builtin_amdgcn_s_sleep(1);
        if ((++sp & 255u) == 0u) { if (xb_ld(&bar[XB_TMO])) break; if (sp > XB_SPIN_CAP) { atomicAdd(&bar[XB_TMO], 1u); break; } }
    }
    nloc = mine > 0u ? mine : 1u; nx = cnt > 0u ? cnt : 1u;
}
__device__ __forceinline__ void xcd_barrier(const XcdBarrier& b) {
    asm volatile("s_waitcnt vmcnt(0)" ::: "memory");
    __syncthreads();
    if (threadIdx.x == 0) {
        unsigned* bar = b.bar;
        __builtin_amdgcn_s_waitcnt(0);
        unsigned nloc = b.st[0], nx = b.st[1];
        if (nloc == 0u) { xcd_barrier_complete(bar, b.x, nloc, nx); b.st[0] = nloc; b.st[1] = nx; }
        const unsigned old = xb_add(&bar[XB_XSUB(b.x)], 1u);
        const unsigned gen = old / nloc;
        if (old + 1u == (gen + 1u) * nloc) {
            __builtin_amdgcn_fence(__ATOMIC_RELEASE, "agent");
            asm volatile("s_waitcnt vmcnt(0)" ::: "memory");
            const unsigned og = xb_add(&bar[XB_TOP], 1u);
            const unsigned tg = og / nx;
            if (og + 1u == (tg + 1u) * nx) xb_add(&bar[XB_TOPGEN], 1u);
            else XB_SPIN(xb_ld(&bar[XB_TOPGEN]) == tg, bar);
            __builtin_amdgcn_fence(__ATOMIC_ACQUIRE, "agent");
            xb_add(&bar[XB_XGEN(b.x)], 1u);
            asm volatile("s_waitcnt vmcnt(0)" ::: "memory");
        } else {
            XB_SPIN(xb_ld(&bar[XB_XGEN(b.x)]) == gen, bar);
            __builtin_amdgcn_fence(__ATOMIC_ACQUIRE, "agent");
            asm volatile("s_waitcnt vmcnt(0)" ::: "memory");
        }
    }
    __syncthreads();
}

__global__ void __launch_bounds__(512, 2) fwd_kernel(Params p_unused) {
    extern __shared__ __attribute__((aligned(16))) char lds[];
    cg::grid_group grid = cg::this_grid();
    CParams* pp = (CParams*)__builtin_amdgcn_kernarg_segment_ptr();
    const int ph_lo = pp->ph_lo;
    volatile LAS unsigned* xst = (volatile LAS unsigned*)(lds + L_XST);
    if (threadIdx.x == 0) { xst[0] = 0u; xst[1] = 0u; }
    __syncthreads();
    const XcdBarrier xb = xcd_barrier_post((unsigned*)(pp->ws + OFF_BAR), xst);
    char* hlds = lds + __builtin_amdgcn_readfirstlane((int)(threadIdx.x >> 8)) * HLDS;
    (void)ph_lo;
#pragma unroll
    for (int ph = 0; ph < 2 * NPH; ++ph) {
        asm volatile("" : "+s"(pp));
        CParams& p = *pp;
        const int l = ph / NPH, q = ph % NPH;
#pragma unroll 1
        for (int rep = 0; rep < 1 + (int)((PROBE_MASK >> q) & 1u); ++rep) {
            if (rep) xcd_barrier(xb);
            switch (q) {
                case 0: phase_w(p, l, hlds); break;
                case 1: phase_proj(p, l, lds); break;
                case 2: phase2(p, l, hlds); break;
                case 3: phase3(p, l, hlds); break;
                case 4: phase4(p, l, hlds); break;
                case 5: phase_glu(p, l, hlds); break;
                case 6: phase_branch(p, l, hlds); break;
                case 7: phase_out(p, l, lds, hlds); break;
                case 8: phase_route(p, l, hlds); break;
                case 9: phase_moe1(p, l, lds); break;
                case 10: phase_moe2(p, l, lds); break;
                default: phase_combine(p, l); break;
            }
        }
        if (ph + 1 < 2 * NPH) {
            if (p.coop == 1) xcd_barrier(xb);
            else if (p.coop == 2) grid.sync();
        }
    }
}

extern "C" void kernel_launch(void* const* d_in, const int* in_sizes, int n_in, void* d_out, int out_size, void* d_ws, size_t ws_size,
                              hipStream_t stream) {
    static int grid_blocks = 0;
    if (!grid_blocks) {
        int dev = 0, cus = 0, per_cu = 0;
        (void)hipGetDevice(&dev);
        (void)hipDeviceGetAttribute(&cus, hipDeviceAttributeMultiprocessorCount, dev);
        (void)hipFuncSetAttribute((const void*)fwd_kernel, hipFuncAttributeMaxDynamicSharedMemorySize, LDS_BYTES);
        (void)hipOccupancyMaxActiveBlocksPerMultiprocessor(&per_cu, fwd_kernel, 512, LDS_BYTES);
        if (per_cu < 1) per_cu = 1;
        per_cu = 1;
        grid_blocks = cus * per_cu;
        if (ws_size < WS_NEED) fprintf(stderr, "kernel_launch: workspace too small: %zu < %zu\n", ws_size, (size_t)WS_NEED);
    }
    Params p{};
    for (int i = 0; i < 36; ++i) p.in[i] = (const float*)d_in[i];
    p.out = (float*)d_out;
    p.ws = (unsigned char*)d_ws;
    p.ph_lo = 0; p.ph_hi = 2 * NPH; p.coop = 1; p.pad = 0;
    (void)hipMemsetAsync((char*)d_ws + OFF_BAR, 0, XCD_BAR_WORDS * 4, stream);
    void* args[] = {&p};
    hipError_t e = hipLaunchCooperativeKernel((void*)fwd_kernel, dim3(grid_blocks), dim3(512), args, LDS_BYTES, stream);
    if (e != hipSuccess) fprintf(stderr, "cooperative launch failed: %s (grid %d)\n", hipGetErrorString(e), grid_blocks);
}
```

```cpp
#include <hip/hip_runtime.h>
#include <hip/hip_cooperative_groups.h>
#include <cstdio>
#include <cstdint>
namespace cg = cooperative_groups;

typedef unsigned short u16;
typedef __attribute__((ext_vector_type(8))) short bf16x8;
typedef __attribute__((ext_vector_type(4))) float f32x4;
typedef __attribute__((ext_vector_type(4))) unsigned u32x4;
#define LAS __attribute__((address_space(3)))

constexpr int NTOK = 16384, DM = 1024, SEQ = 4096, BW = 512, INC = 6656;
constexpr int NE = 64, EH = 256;
#ifndef PROBE_MASK
#define PROBE_MASK 0u
#endif
constexpr int NPH = 12;
constexpr float DN_ALPHA = 1.4142135623730951f;
constexpr size_t SLOT = 16777216ull;

constexpr size_t OFF_WINT  = 0;
constexpr size_t OFF_WBRT  = 13631488;
constexpr size_t OFF_WOUTT = 16777216;
constexpr size_t OFF_GLUT  = 18874368;
constexpr size_t OFF_RGT   = 19398656;
constexpr size_t OFF_SH13T = 19660800;
constexpr size_t OFF_SH2T  = 20709376;
constexpr size_t OFF_BTA   = 21233664;
constexpr size_t OFF_BTC   = 23330816;
constexpr size_t OFF_ROUTT = 29622272;
constexpr size_t OFF_MISC  = 29753344;
constexpr size_t OFF_LB    = OFF_MISC;
constexpr size_t OFF_CUR   = OFF_MISC + 2048;
constexpr size_t OFF_DEC   = OFF_MISC + 4096;
constexpr size_t OFF_SEGA  = OFF_DEC + 524288;
constexpr size_t OFF_SEGH  = OFF_SEGA + 524288;
constexpr size_t OFF_XB    = 2 * SLOT;
constexpr size_t OFF_VC    = 2 * SLOT;
constexpr size_t OFF_XC    = 3 * SLOT;
constexpr size_t OFF_MIXP  = 2 * SLOT;
constexpr size_t OFF_LIST  = 2 * SLOT;
constexpr size_t OFF_HSH   = 2 * SLOT + 4194304;
constexpr size_t OFF_WLIST = 2 * SLOT + 4194304 + 8388608;
constexpr size_t OFF_PQ    = 4 * SLOT;
constexpr size_t OFF_PLF   = 5 * SLOT;
constexpr size_t OFF_PK    = 7 * SLOT;
constexpr size_t OFF_PV    = 8 * SLOT;
constexpr size_t OFF_YC    = 8 * SLOT;
constexpr size_t OFF_PG    = 9 * SLOT;
constexpr size_t OFF_PU    = 10 * SLOT;
constexpr size_t OFF_PXG   = 11 * SLOT;
constexpr size_t OFF_PXR   = 12 * SLOT;
constexpr size_t OFF_YB    = 12 * SLOT;
constexpr size_t OFF_PGATE = 13 * SLOT;
constexpr size_t OFF_KTT   = 19 * SLOT;
constexpr size_t OFF_YA    = 19 * SLOT;
constexpr size_t OFF_VT    = 20 * SLOT;
constexpr size_t OFF_ST    = 21 * SLOT;
constexpr size_t OFF_LA    = 23 * SLOT;
constexpr size_t OFF_BB    = 24 * SLOT;
constexpr size_t OFF_YG    = 25 * SLOT;
constexpr size_t OFF_HC    = 26 * SLOT;
constexpr size_t OFF_UT    = 27 * SLOT;
constexpr size_t OFF_PRELN = 4 * SLOT;
constexpr size_t OFF_XM    = 8 * SLOT;
constexpr size_t OFF_EW13  = 10 * SLOT;
constexpr size_t OFF_EW2   = 14 * SLOT;
constexpr size_t OFF_HBUF  = 4 * SLOT;
constexpr size_t OFF_YBUF  = 16 * SLOT;
constexpr size_t OFF_BAR   = 32 * SLOT;
constexpr int HLDS = 73728;
constexpr int LDS_BYTES = 2 * HLDS + 64;
constexpr int L_XST = 2 * HLDS;
constexpr size_t WS_NEED   = 32 * SLOT + 16384;

struct Params {
    const float* in[36];
    float* out;
    unsigned char* ws;
    int ph_lo, ph_hi;
    int coop, pad;
};
typedef const __attribute__((address_space(4))) Params CParams;

__device__ __forceinline__ u16 f2bf(float f) {
    unsigned u = __builtin_bit_cast(unsigned, f);
    return (u16)((u + 0x7fffu + ((u >> 16) & 1u)) >> 16);
}
__device__ __forceinline__ float bf2f(u16 h) { return __builtin_bit_cast(float, (unsigned)h << 16); }
__device__ __forceinline__ float sigm(float x) { return __builtin_amdgcn_rcpf(1.f + __expf(-x)); }
__device__ __forceinline__ float silu_f(float x) { return x * sigm(x); }
__device__ __forceinline__ float gelu_f(float x) {
    float u = 0.7978845608028654f * (x + 0.044715f * x * x * x);
    float t = 1.f - 2.f * __builtin_amdgcn_rcpf(1.f + __expf(2.f * u));
    return 0.5f * x * (1.f + t);
}
__device__ __forceinline__ float shfl_xor_l(float v, int o, int lane) {
    return __builtin_bit_cast(float, __builtin_amdgcn_ds_bpermute((lane ^ o) << 2, __builtin_bit_cast(int, v)));
}
__device__ __forceinline__ float wave_sum(float v, int lane) {
#pragma unroll
    for (int o = 32; o >= 1; o >>= 1) v += shfl_xor_l(v, o, lane);
    return v;
}
__device__ __forceinline__ int swz(int row, int ch) { return row * 128 + ((ch ^ ((row >> 1) & 7)) << 4); }


template <class T> __device__ __forceinline__ T ldg(const void* base, unsigned off) { return *(const T*)((const char*)base + off); }
template <class T> __device__ __forceinline__ void stg(void* base, unsigned off, T v) { *(T*)((char*)base + off) = v; }

template <int TM, int TN, int RW, int CW, class F>
__device__ __forceinline__ void epi(f32x4 (&acc)[TM][TN], int wr, int wc, int fq, int fr, F f) {
#pragma unroll
    for (int m = 0; m < TM; ++m) {
#pragma unroll
        for (int j = 0; j < 4; ++j) {
#pragma unroll
            for (int n = 0; n < TN; ++n) f(wr * RW + m * 16 + fq * 4 + j, wc * CW + n * 16 + fr, acc[m][n][j]);
        }
        __builtin_amdgcn_sched_barrier(0);
    }
}

__device__ __forceinline__ int otid() { int t = threadIdx.x & 255; asm volatile("" : "+v"(t)); return t; }
#define VB ((int)blockIdx.x * 2 + __builtin_amdgcn_readfirstlane((int)(threadIdx.x >> 8)))
#define VG ((int)gridDim.x * 2)

struct NoHook { __device__ __forceinline__ void operator()(int) const {} };

template <int BM, int BN, int WM, int WN, class AL, class BL, class HK>
__device__ __forceinline__ void mma_loop(f32x4 (&acc)[BM / WM / 16][BN / WN / 16], int nk, AL aload, BL bload, HK hook, char* lds) {
    constexpr int TM = BM / WM / 16, TN = BN / WN / 16;
    constexpr int ACH = BM / 32, BCH = BN / 32;
    const int tid = otid(), lane = tid & 63, wid = tid >> 6;
    const int wr = wid / WN, wc = wid % WN, fr = lane & 15, fq = lane >> 4;
    const int srow = tid >> 3, sk = (tid & 7) * 8;
    const int swr = srow * 128 + (((tid & 7) ^ ((tid >> 4) & 7)) << 4);
    const int xr = (fr >> 1) & 7;
    const int a_rd = (wr * (BM / WM) + fr) * 128;
    const int b_rd = BM * 128 + (wc * (BN / WN) + fr) * 128;
    bf16x8 ra[ACH], rb[BCH];
#pragma unroll
    for (int i = 0; i < ACH; ++i) ra[i] = aload(srow + i * 32, sk);
#pragma unroll
    for (int i = 0; i < BCH; ++i) rb[i] = bload(srow + i * 32, sk);
#pragma unroll 1
    for (int t = 0; t < nk; ++t) {
        __syncthreads();
#pragma unroll
        for (int i = 0; i < ACH; ++i) *(bf16x8*)(lds + swr + i * 4096) = ra[i];
#pragma unroll
        for (int i = 0; i < BCH; ++i) *(bf16x8*)(lds + BM * 128 + swr + i * 4096) = rb[i];
        __syncthreads();
        if (t + 1 < nk) {
#pragma unroll
            for (int i = 0; i < ACH; ++i) ra[i] = aload(srow + i * 32, (t + 1) * 64 + sk);
#pragma unroll
            for (int i = 0; i < BCH; ++i) rb[i] = bload(srow + i * 32, (t + 1) * 64 + sk);
        }
        hook(t);
#pragma unroll
        for (int ks = 0; ks < 2; ++ks) {
            const int co = ((ks * 4 + fq) ^ xr) << 4;
            bf16x8 af[TM], bfr[TN];
#pragma unroll
            for (int m = 0; m < TM; ++m) af[m] = *(const bf16x8*)(lds + a_rd + m * 2048 + co);
#pragma unroll
            for (int n = 0; n < TN; ++n) bfr[n] = *(const bf16x8*)(lds + b_rd + n * 2048 + co);
#pragma unroll
            for (int m = 0; m < TM; ++m)
#pragma unroll
                for (int n = 0; n < TN; ++n) acc[m][n] = __builtin_amdgcn_mfma_f32_16x16x32_bf16(af[m], bfr[n], acc[m][n], 0, 0, 0);
        }
    }
}

template <int BM, int BN, int WM, int WN, class AO, class BO, class HK>
__device__ __forceinline__ void mma_glds(f32x4 (&acc)[BM / WM / 16][BN / WN / 16], int nk, const unsigned char* ws, AO aoff, BO boff, HK hook, char* lds) {
    constexpr int TM = BM / WM / 16, TN = BN / WN / 16;
    constexpr int ACH = BM / 32, BCH = BN / 32, BUF = (BM + BN) * 128;
    const int tid = otid(), lane = tid & 63, wid = tid >> 6;
    const int wr = wid / WN, wc = wid % WN, fr = lane & 15, fq = lane >> 4;
    const int srow = tid >> 3;
    const unsigned csrc = (unsigned)(((tid & 7) ^ ((tid >> 4) & 7)) << 4);
    const int xr = (fr >> 1) & 7;
    const int a_rd = (wr * (BM / WM) + fr) * 128;
    const int b_rd = BM * 128 + (wc * (BN / WN) + fr) * 128;
    auto stage = [&](int buf, int t) {
        char* d = lds + buf * BUF + tid * 16;
#pragma unroll
        for (int i = 0; i < ACH; ++i)
            __builtin_amdgcn_global_load_lds((const unsigned*)(ws + (aoff(srow + i * 32, t) + csrc)), (unsigned*)(d + i * 4096), 16, 0, 0);
#pragma unroll
        for (int i = 0; i < BCH; ++i)
            __builtin_amdgcn_global_load_lds((const unsigned*)(ws + (boff(srow + i * 32, t) + csrc)), (unsigned*)(d + BM * 128 + i * 4096), 16, 0, 0);
    };
    __syncthreads();
    stage(0, 0);
#pragma unroll 1
    for (int t = 0; t < nk; ++t) {
        asm volatile("s_waitcnt vmcnt(0)" ::: "memory");
        __syncthreads();
        if (t + 1 < nk) stage((t + 1) & 1, t + 1);
        hook(t);
        const char* bb = lds + (t & 1) * BUF;
#pragma unroll
        for (int ks = 0; ks < 2; ++ks) {
            const int co = ((ks * 4 + fq) ^ xr) << 4;
            bf16x8 af[TM], bfr[TN];
#pragma unroll
            for (int m = 0; m < TM; ++m) af[m] = *(const bf16x8*)(bb + a_rd + m * 2048 + co);
#pragma unroll
            for (int n = 0; n < TN; ++n) bfr[n] = *(const bf16x8*)(bb + b_rd + n * 2048 + co);
#pragma unroll
            for (int m = 0; m < TM; ++m)
#pragma unroll
                for (int n = 0; n < TN; ++n) acc[m][n] = __builtin_amdgcn_mfma_f32_16x16x32_bf16(af[m], bfr[n], acc[m][n], 0, 0, 0);
        }
    }
}

#define ZERO_ACC(acc, TM, TN) _Pragma("unroll") for (int m_ = 0; m_ < TM; ++m_) _Pragma("unroll") for (int n_ = 0; n_ < TN; ++n_) acc[m_][n_] = f32x4{0.f, 0.f, 0.f, 0.f}

#define LANE_IDS const int tid = otid(), lane = tid & 63, wid = tid >> 6, fr = lane & 15, fq = lane >> 4; (void)tid; (void)lane; (void)wid; (void)fr; (void)fq

namespace g8 {
constexpr int BM = 256, BK = 64, HALF = 128, HTB = HALF * BK * 2, STAGE_BYTES = 8 * HTB;
__device__ __forceinline__ int lds_byte(int r, int c) { const int st = (r >> 4) * 2 + (c >> 5), rr = r & 15, cc = c & 31, ob = rr * 64 + cc * 2; return st * 1024 + (ob ^ (((ob >> 9) & 1) << 5)); }
__device__ __forceinline__ void stage_rc(int b, int& R, int& C) { const int st = b / 1024, sb = b % 1024, swz = sb ^ (((sb >> 9) & 1) << 5); R = (st >> 1) * 16 + swz / 64; C = (st & 1) * 32 + (swz % 64) / 2; }
__device__ __forceinline__ int perm32(int rho) { const int n = rho >> 4, i = rho & 15; return 8 * (i >> 2) + 4 * n + (i & 3); }
struct Unit { unsigned A, B; int pm, pn, x0, x1; };
__device__ __forceinline__ unsigned cvt_pk_bf16(float lo, float hi) { unsigned r; asm volatile("v_cvt_pk_bf16_f32 %0, %1, %2" : "=v"(r) : "v"(lo), "v"(hi)); return r; }

template <class Epi, class Sched, bool GATHER>
__device__ __forceinline__ void gemm_phase(LAS unsigned char* lds, const unsigned char* wsb, const int K, const Sched& S, const Epi& E) {
    int tid_ = threadIdx.x; asm volatile("" : "+v"(tid_));
    const int tid = tid_, wid = __builtin_amdgcn_readfirstlane(tid >> 6), lane = tid & 63, wr = wid >> 2, wc = wid & 3, fr = lane & 15, fq = lane >> 4;
    const int nt = K / BK;
    unsigned voffA[2], voffB[2];
#pragma unroll
    for (int i = 0; i < 2; ++i) { int R, C; stage_rc(tid * 16 + i * 8192, R, C); const int Rb = Epi::PERM ? ((R & ~31) + perm32(R & 31)) : R;
        voffA[i] = (unsigned)(R * K + C) * 2u; voffB[i] = (unsigned)(Rb * K + C) * 2u; }
    const unsigned kstep = (unsigned)(BK * 2);
    const unsigned hstep = (unsigned)(HALF * K * 2);
    const unsigned ldsw = (unsigned)wid * 1024u;
    const int aoff = lds_byte(wr * 64 + fr, fq * 8), boff = lds_byte(wc * 32 + fr, fq * 8);
#define G8_SA(b, h) (((b) * 2 + (h)) * HTB)
#define G8_SB(b, h) ((4 + (b) * 2 + (h)) * HTB)
#define G8_STAGE(bufoff, gbase, voff) do { _Pragma("unroll") for (int _i = 0; _i < 2; ++_i) \
        __builtin_amdgcn_global_load_lds((const unsigned*)(wsb + (unsigned)((gbase) + (voff)[_i])), (LAS unsigned*)(lds + (bufoff) + ldsw + _i * 8192), 16, 0, 0); } while (0)
#define G8_STAGE_A(bufoff, kp, h, vg) do { if (GATHER) G8_STAGE(bufoff, kp, vg[h]); else G8_STAGE(bufoff, (kp) + (h) * hstep, voffA); } while (0)
#define G8_LDA(dst, b, h) do { _Pragma("unroll") for (int m = 0; m < 4; ++m) _Pragma("unroll") for (int k = 0; k < 2; ++k) dst[m][k] = *(const LAS bf16x8*)(lds + G8_SA(b, h) + aoff + m * 2048 + k * 1024); } while (0)
#define G8_LDB(dst, b, h) do { _Pragma("unroll") for (int n = 0; n < 2; ++n) _Pragma("unroll") for (int k = 0; k < 2; ++k) dst[n][k] = *(const LAS bf16x8*)(lds + G8_SB(b, h) + boff + n * 2048 + k * 1024); } while (0)
#define G8_MMA(ai, bj, At, Bt) do { __builtin_amdgcn_s_setprio(1); _Pragma("unroll") for (int m = 0; m < 4; ++m) _Pragma("unroll") for (int n = 0; n < 2; ++n) _Pragma("unroll") for (int k = 0; k < 2; ++k) \
        acc[ai][bj][m][n] = __builtin_amdgcn_mfma_f32_16x16x32_bf16(Bt[n][k], At[m][k], acc[ai][bj][m][n], 0, 0, 0); __builtin_amdgcn_s_setprio(0); } while (0)
#define G8_WAIT_V(n) asm volatile("s_waitcnt vmcnt(" #n ")" ::: "memory")
#define G8_WAIT_L(n) asm volatile("s_waitcnt lgkmcnt(" #n ")" ::: "memory")
#define G8_BAR __builtin_amdgcn_s_barrier()
#define G8_SCHED __builtin_amdgcn_sched_barrier(0)
#define G8_GOFF(dst, u) do { _Pragma("unroll") for (int _i = 0; _i < 2; ++_i) { int _R, _C; stage_rc(tid * 16 + _i * 8192, _R, _C); \
        _Pragma("unroll") for (int _h = 0; _h < 2; ++_h) dst[_h][_i] = (unsigned)(S.row(u, _h * HALF + _R) * K + _C) * 2u; } \
        asm volatile("" : "+v"(dst[0][0]), "+v"(dst[0][1]), "+v"(dst[1][0]), "+v"(dst[1][1])); } while (0)
    Unit cur, nxt; int ui = 0;
    if (!S.next(0, cur)) return;
    f32x4 acc[2][2][4][2];
#pragma unroll
    for (int a = 0; a < 2; ++a)
#pragma unroll
        for (int b = 0; b < 2; ++b)
#pragma unroll
            for (int m = 0; m < 4; ++m)
#pragma unroll
                for (int n = 0; n < 2; ++n) acc[a][b][m][n] = (f32x4){0.f, 0.f, 0.f, 0.f};
    bf16x8 At[4][2], B0[2][2], B1[2][2];
    unsigned vgc[2][2] = {{0u, 0u}, {0u, 0u}};
    LAS u32x4* gslot = (LAS u32x4*)(lds + STAGE_BYTES + 4096) + tid;
    unsigned cA = cur.A, cB = cur.B;
    if (GATHER) { G8_GOFF(vgc, cur); }
    G8_STAGE(G8_SB(0, 0), cB, voffB); G8_STAGE_A(G8_SA(0, 0), cA, 0, vgc); G8_STAGE(G8_SB(0, 1), cB + hstep, voffB); G8_STAGE_A(G8_SA(0, 1), cA, 1, vgc);
    if (wr == 1) G8_BAR;
    G8_WAIT_V(4); G8_BAR;
    G8_STAGE(G8_SB(1, 0), cB + kstep, voffB); G8_STAGE_A(G8_SA(1, 0), cA + kstep, 0, vgc); G8_STAGE(G8_SB(1, 1), cB + hstep + kstep, voffB);
    G8_WAIT_V(6); G8_BAR;
    for (;;) {
        const bool has_next = S.next(ui + 1, nxt);
        const unsigned nA = has_next ? nxt.A : cA, nB = has_next ? nxt.B : cB;
        if (GATHER && has_next) {
            unsigned vt[2][2]; G8_GOFF(vt, nxt);
            *gslot = u32x4{vt[0][0], vt[0][1], vt[1][0], vt[1][1]};
        }
#pragma unroll 1
        for (int t = 0; t < nt; t += 2) {
            const bool last = (t == nt - 2);
            const unsigned a1 = cA + (unsigned)(t + 1) * kstep;
            const unsigned a2 = last ? nA : cA + (unsigned)(t + 2) * kstep, b2 = last ? nB : cB + (unsigned)(t + 2) * kstep;
            const unsigned a3 = a2 + kstep, b3 = b2 + kstep;
            G8_LDB(B0, 0, 0); G8_SCHED; G8_LDA(At, 0, 0); G8_STAGE_A(G8_SA(1, 1), a1, 1, vgc);
            G8_WAIT_L(8); G8_BAR; G8_WAIT_L(0); G8_MMA(0, 0, At, B0); G8_BAR; G8_SCHED;
            G8_LDB(B1, 0, 1);
            if (GATHER && last && has_next) { const u32x4 x = *gslot; vgc[0][0] = x[0]; vgc[0][1] = x[1]; vgc[1][0] = x[2]; vgc[1][1] = x[3]; }
            G8_STAGE(G8_SB(0, 0), b2, voffB);
            G8_BAR; G8_WAIT_L(0); G8_MMA(0, 1, At, B1); G8_BAR;
            G8_LDA(At, 0, 1); G8_STAGE_A(G8_SA(0, 0), a2, 0, vgc);
            G8_BAR; G8_WAIT_L(0); G8_MMA(1, 0, At, B0); G8_BAR; G8_SCHED;
            G8_STAGE(G8_SB(0, 1), b2 + hstep, voffB);
            G8_WAIT_V(6); G8_BAR; G8_MMA(1, 1, At, B1); G8_BAR;
            G8_LDB(B0, 1, 0); G8_SCHED; G8_LDA(At, 1, 0); G8_STAGE_A(G8_SA(0, 1), a2, 1, vgc);
            G8_WAIT_L(8); G8_BAR; G8_WAIT_L(0); G8_MMA(0, 0, At, B0); G8_BAR; G8_SCHED;
            G8_LDB(B1, 1, 1); G8_STAGE(G8_SB(1, 0), b3, voffB);
            G8_BAR; G8_WAIT_L(0); G8_MMA(0, 1, At, B1); G8_BAR;
            G8_LDA(At, 1, 1); G8_STAGE_A(G8_SA(1, 0), a3, 0, vgc);
            G8_BAR; G8_WAIT_L(0); G8_MMA(1, 0, At, B0); G8_BAR; G8_SCHED;
            G8_STAGE(G8_SB(1, 1), b3 + hstep, voffB);
            G8_WAIT_V(6); G8_BAR; G8_MMA(1, 1, At, B1); G8_BAR;
        }
        const bool keep = E(acc, cur, wr, wc, fr, fq);
        if (!has_next) break;
        if (!keep) {
#pragma unroll
        for (int a = 0; a < 2; ++a)
#pragma unroll
            for (int b = 0; b < 2; ++b)
#pragma unroll
                for (int m = 0; m < 4; ++m)
#pragma unroll
                    for (int n = 0; n < 2; ++n) acc[a][b][m][n] = (f32x4){0.f, 0.f, 0.f, 0.f};
        }
        cur = nxt; cA = nA; cB = nB; ++ui;
    }
    G8_WAIT_V(0);
    if (wr == 0) G8_BAR;
    G8_BAR;
#undef G8_SA
#undef G8_SB
#undef G8_STAGE
#undef G8_STAGE_A
#undef G8_LDA
#undef G8_LDB
#undef G8_MMA
#undef G8_WAIT_V
#undef G8_WAIT_L
#undef G8_BAR
#undef G8_SCHED
#undef G8_GOFF
}
}

__device__ __forceinline__ uint4 pack8(const f32x4& a, const f32x4& b) {
    uint4 w; w.x = g8::cvt_pk_bf16(a[0], a[1]); w.y = g8::cvt_pk_bf16(a[2], a[3]); w.z = g8::cvt_pk_bf16(b[0], b[1]); w.w = g8::cvt_pk_bf16(b[2], b[3]); return w;
}

struct ProjSched {
    unsigned A, B; int c, G;
    __device__ __forceinline__ bool next(int i, g8::Unit& u) const {
        const int L = i * G + c; if (L >= 64 * 26) return false;
        const int xcd = L & 7, jx = L >> 3;
        u.pm = xcd * 8 + (jx & 7); u.pn = jx >> 3;
        u.A = A + (unsigned)u.pm * 256 * DM * 2; u.B = B + (unsigned)u.pn * 256 * DM * 2; u.x0 = 0; u.x1 = 0; return true;
    }
    __device__ __forceinline__ int row(const g8::Unit&, int) const { return 0; }
};
struct ProjEpi {
    static constexpr bool PERM = true;
    unsigned char* ws; const float* bg;
    __device__ __forceinline__ bool operator()(f32x4 (&acc)[2][2][4][2], const g8::Unit& u, int wr, int wc, int fr, int fq) const {
        const int seg = (u.pn * 256) >> 9;
#pragma unroll
        for (int ai = 0; ai < 2; ++ai)
#pragma unroll
            for (int m = 0; m < 4; ++m) {
                const int row = u.pm * 256 + ai * 128 + wr * 64 + m * 16 + fr;
#pragma unroll
                for (int bj = 0; bj < 2; ++bj) {
                    const int col = u.pn * 256 + bj * 128 + wc * 32 + fq * 8;
                    const int c = col & 511;
                    f32x4 v0 = acc[ai][bj][m][0], v1 = acc[ai][bj][m][1];
                    if (seg == 0 || seg == 3) {
#pragma unroll
                        for (int i = 0; i < 4; ++i) { v0[i] = silu_f(v0[i]); v1[i] = silu_f(v1[i]); }
                        stg<uint4>(ws, (unsigned)((seg == 0 ? OFF_PQ : OFF_PG) + (row * 512 + c) * 2), pack8(v0, v1));
                    } else if (seg == 1) {
                        const f32x4 l0 = ldg<f32x4>(ws, (unsigned)(OFF_LB + c * 4)), l1 = ldg<f32x4>(ws, (unsigned)(OFF_LB + c * 4 + 16));
                        f32x4 g0, g1, k0, k1;
#pragma unroll
                        for (int i = 0; i < 4; ++i) {
                            const float s0 = sigm(v0[i]), s1 = sigm(v1[i]);
                            g0[i] = __logf(l0[i] + (1.f - l0[i]) * s0); g1[i] = __logf(l1[i] + (1.f - l1[i]) * s1);
                            k0[i] = (1.f - l0[i]) * (1.f - s0); k1[i] = (1.f - l1[i]) * (1.f - s1);
                        }
                        stg<f32x4>(ws, (unsigned)(OFF_PLF + (row * 512 + c) * 4), g0);
                        stg<f32x4>(ws, (unsigned)(OFF_PLF + (row * 512 + c) * 4 + 16), g1);
                        stg<uint4>(ws, (unsigned)(OFF_PK + (row * 512 + c) * 2), pack8(k0, k1));
                    } else if (seg == 2 || seg == 6) {
                        stg<uint4>(ws, (unsigned)((seg == 2 ? OFF_PV : OFF_PXR) + (row * 512 + c) * 2), pack8(v0, v1));
                    } else if (seg == 4) {
                        stg<uint4>(ws, (unsigned)(OFF_PU + (((c >> 4) * NTOK + row) * 16 + (c & 15)) * 2), pack8(v0, v1));
                    } else if (seg == 5) {
#pragma unroll
                        for (int i = 0; i < 4; ++i) { v0[i] = gelu_f(v0[i]); v1[i] = gelu_f(v1[i]); }
                        stg<uint4>(ws, (unsigned)(OFF_PXG + (row * 512 + c) * 2), pack8(v0, v1));
                    } else {
                        const int gc = col - 3584;
                        const f32x4 b0 = *(const f32x4*)(bg + gc), b1 = *(const f32x4*)(bg + gc + 4);
#pragma unroll
                        for (int i = 0; i < 4; ++i) { v0[i] = sigm(v0[i] + b0[i]); v1[i] = sigm(v1[i] + b1[i]); }
                        stg<uint4>(ws, (unsigned)(OFF_PGATE + (row * 3072 + gc) * 2), pack8(v0, v1));
                    }
                }
                __builtin_amdgcn_sched_barrier(0);
            }
        return false;
    }
};
__device__ void phase_proj(CParams& p, int l, char* lds) {
    ProjSched S; S.A = (unsigned)OFF_XB; S.B = (unsigned)OFF_WINT; S.c = blockIdx.x; S.G = gridDim.x;
    ProjEpi E; E.ws = p.ws; E.bg = p.in[2] + (size_t)l * 3072;
    g8::gemm_phase<ProjEpi, ProjSched, false>((LAS unsigned char*)lds, p.ws, 1024, S, E);
}

struct OutSched {
    unsigned A, B; int c, G;
    __device__ __forceinline__ bool next(int i, g8::Unit& u) const {
        const int L = i * G + c; if (L >= 64 * 4) return false;
        const int xcd = L & 7, jx = L >> 3;
        u.pm = xcd * 8 + (jx & 7); u.pn = jx >> 3;
        u.A = A + (unsigned)u.pm * 256 * 1024 * 2; u.B = B + (unsigned)u.pn * 256 * 1024 * 2; u.x0 = 0; u.x1 = 0; return true;
    }
    __device__ __forceinline__ int row(const g8::Unit&, int) const { return 0; }
};
struct OutEpi {
    static constexpr bool PERM = false;
    unsigned char* ws; const float* xres;
    __device__ __forceinline__ bool operator()(f32x4 (&acc)[2][2][4][2], const g8::Unit& u, int wr, int wc, int fr, int fq) const {
#pragma unroll
        for (int ai = 0; ai < 2; ++ai)
#pragma unroll
            for (int m = 0; m < 4; ++m) {
                const int row = u.pm * 256 + ai * 128 + wr * 64 + m * 16 + fr;
#pragma unroll
                for (int bj = 0; bj < 2; ++bj)
#pragma unroll
                    for (int n = 0; n < 2; ++n) {
                        const int col = u.pn * 256 + bj * 128 + wc * 32 + n * 16 + fq * 4;
                        const unsigned o = (unsigned)((row * 1024 + col) * 4);
                        const f32x4 x = ldg<f32x4>(xres, o);
                        stg<f32x4>(ws, (unsigned)OFF_PRELN + o, x * DN_ALPHA + acc[ai][bj][m][n]);
                    }
                __builtin_amdgcn_sched_barrier(0);
            }
        return false;
    }
};

struct BrSched {
    int c;
    __device__ __forceinline__ bool next(int i, g8::Unit& u) const {
        if (i >= 3) return false;
        const int xcd = c & 7, jx = c >> 3;
        u.pm = xcd * 8 + (jx & 7); u.pn = jx >> 3; u.x0 = i; u.x1 = 0;
        u.A = (unsigned)(i == 0 ? OFF_YA : (i == 1 ? OFF_YB : OFF_YC)) + (unsigned)u.pm * 256 * 512 * 2;
        u.B = (unsigned)OFF_WBRT + (unsigned)i * 1024 * 512 * 2 + (unsigned)u.pn * 256 * 512 * 2;
        return true;
    }
    __device__ __forceinline__ int row(const g8::Unit&, int) const { return 0; }
};
struct BrEpi {
    static constexpr bool PERM = true;
    unsigned char* ws;
    __device__ __forceinline__ bool operator()(f32x4 (&acc)[2][2][4][2], const g8::Unit& u, int wr, int wc, int fr, int fq) const {
        const int k = u.x0;
#pragma unroll
        for (int ai = 0; ai < 2; ++ai)
#pragma unroll
            for (int m = 0; m < 4; ++m) {
                const int row = u.pm * 256 + ai * 128 + wr * 64 + m * 16 + fr;
#pragma unroll
                for (int bj = 0; bj < 2; ++bj) {
                    const int col = u.pn * 256 + bj * 128 + wc * 32 + fq * 8;
                    const unsigned go = (unsigned)(OFF_PGATE + (row * 3072 + k * 1024 + col) * 2);
                    const uint4 gq = ldg<uint4>(ws, go);
                    float s[8] = {bf2f((u16)(gq.x & 0xffff)), bf2f((u16)(gq.x >> 16)), bf2f((u16)(gq.y & 0xffff)), bf2f((u16)(gq.y >> 16)),
                                  bf2f((u16)(gq.z & 0xffff)), bf2f((u16)(gq.z >> 16)), bf2f((u16)(gq.w & 0xffff)), bf2f((u16)(gq.w >> 16))};
                    if (k < 2) {
                        const uint4 gn = ldg<uint4>(ws, go + 2048);
                        s[0] *= __builtin_amdgcn_rcpf(bf2f((u16)(gn.x & 0xffff))); s[1] *= __builtin_amdgcn_rcpf(bf2f((u16)(gn.x >> 16)));
                        s[2] *= __builtin_amdgcn_rcpf(bf2f((u16)(gn.y & 0xffff))); s[3] *= __builtin_amdgcn_rcpf(bf2f((u16)(gn.y >> 16)));
                        s[4] *= __builtin_amdgcn_rcpf(bf2f((u16)(gn.z & 0xffff))); s[5] *= __builtin_amdgcn_rcpf(bf2f((u16)(gn.z >> 16)));
                        s[6] *= __builtin_amdgcn_rcpf(bf2f((u16)(gn.w & 0xffff))); s[7] *= __builtin_amdgcn_rcpf(bf2f((u16)(gn.w >> 16)));
                    }
#pragma unroll
                    for (int i = 0; i < 4; ++i) { acc[ai][bj][m][0][i] *= s[i]; acc[ai][bj][m][1][i] *= s[4 + i]; }
                    if (k == 2) stg<uint4>(ws, (unsigned)(OFF_MIXP + (row * 1024 + col) * 2), pack8(acc[ai][bj][m][0], acc[ai][bj][m][1]));
                }
                __builtin_amdgcn_sched_barrier(0);
            }
        return k < 2;
    }
};

struct MoeSched {
    const int* sm; const unsigned char* ws; unsigned A, Bexp, Bsh, Ash;
    int c, G, npn, K, bstride_e, gather, nsh;
    __device__ __forceinline__ bool next(int i, g8::Unit& u) const {
        int nbr = __builtin_amdgcn_readfirstlane(sm[64]); asm volatile("" : "+s"(nbr));
        const int L = i * G + c; if (L >= (nbr + nsh) * npn) return false;
        const int blk = L / npn; u.pn = L - blk * npn;
        if (blk >= nbr) {
            u.x0 = 64; u.pm = blk - nbr; u.x1 = NTOK;
            u.A = gather ? A : Ash + (unsigned)u.pm * 256 * K * 2;
            u.B = Bsh + (unsigned)u.pn * 256 * K * 2;
        } else {
            int e = __builtin_amdgcn_readfirstlane(sm[256 + blk]);
            int be = __builtin_amdgcn_readfirstlane(sm[e]), re = __builtin_amdgcn_readfirstlane(sm[65 + e]), ce = __builtin_amdgcn_readfirstlane(sm[130 + e]);
            asm volatile("" : "+s"(e), "+s"(be), "+s"(re), "+s"(ce));
            u.x0 = e; u.pm = blk - be; u.x1 = ce;
            u.A = gather ? A : A + (unsigned)(re + u.pm * 256) * K * 2;
            u.B = Bexp + (unsigned)e * bstride_e + (unsigned)u.pn * 256 * K * 2;
        }
        return true;
    }
    __device__ __forceinline__ int row(const g8::Unit& u, int r) const {
        const int rr = u.pm * 256 + r;
        if (u.x0 == 64) return rr;
        return (rr < u.x1) ? (ldg<int>(ws, (unsigned)(OFF_LIST + (u.x0 * NTOK + rr) * 4)) >> 3) : 0;
    }
};
__device__ __forceinline__ void moe_setup(CParams& p, int* sm) {
    __syncthreads();
    if (threadIdx.x == 0) {
        const int* cursor = (const int*)(p.ws + OFF_CUR);
        int nb = 0, nr = 0;
        for (int e = 0; e < 64; ++e) { sm[e] = nb; sm[65 + e] = nr; int c = cursor[e]; sm[130 + e] = c; nb += (c + 255) >> 8; nr += c; }
        sm[64] = nb; sm[129] = nr;
    }
    __syncthreads();
    if (threadIdx.x < 64) { const int e = threadIdx.x; for (int k = sm[e]; k < sm[e + 1]; ++k) sm[256 + k] = e; }
    __syncthreads();
}
struct Moe1Epi {
    static constexpr bool PERM = false;
    unsigned char* ws; const int* sm;
    __device__ __forceinline__ bool operator()(f32x4 (&acc)[2][2][4][2], const g8::Unit& u, int wr, int wc, int fr, int fq) const {
        const int rbase = (u.x0 == 64) ? 0 : __builtin_amdgcn_readfirstlane(sm[65 + (u.x0 & 63)]);
        const unsigned hoff = (unsigned)((u.x0 == 64) ? OFF_HSH + (size_t)u.pm * 256 * 256 * 2 : OFF_HBUF + (size_t)(rbase + u.pm * 256) * 256 * 2);
        const int valid = u.x1 - u.pm * 256;
        float rw[2][4];
        const unsigned wb = (unsigned)(OFF_WLIST + ((u.x0 & 63) * NTOK + u.pm * 256 + wr * 64 + fr) * 4);
#pragma unroll
        for (int ai = 0; ai < 2; ++ai)
#pragma unroll
            for (int m = 0; m < 4; ++m) {
                const int r = ai * 128 + wr * 64 + m * 16 + fr;
                rw[ai][m] = (u.x0 != 64 && r < valid) ? ldg<float>(ws, wb + (unsigned)((ai * 128 + m * 16) * 4)) : 1.f;
            }
#pragma unroll
        for (int ai = 0; ai < 2; ++ai)
#pragma unroll
            for (int m = 0; m < 4; ++m) {
                const int r = ai * 128 + wr * 64 + m * 16 + fr;
                const float w = rw[ai][m];
#pragma unroll
                for (int bj = 0; bj < 2; ++bj) {
                    const int hid = ((u.pn * 256 + bj * 128 + wc * 32) >> 1) + fq * 4;
                    const f32x4 a = acc[ai][bj][m][0], b = acc[ai][bj][m][1] * w;
                    uint2 pk;
                    pk.x = g8::cvt_pk_bf16(silu_f(a[0]) * b[0], silu_f(a[1]) * b[1]);
                    pk.y = g8::cvt_pk_bf16(silu_f(a[2]) * b[2], silu_f(a[3]) * b[3]);
                    if (r < valid) stg<uint2>(ws, hoff + (unsigned)(r * 256 + hid) * 2u, pk);
                }
                __builtin_amdgcn_sched_barrier(0);
            }
        return false;
    }
};
__device__ void phase_moe1(CParams& p, int l, char* lds) {
    int* sm = (int*)(lds + g8::STAGE_BYTES);
    moe_setup(p, sm);
    MoeSched S; S.sm = sm; S.ws = p.ws;
    S.A = (unsigned)OFF_XM; S.Ash = S.A; S.Bexp = (unsigned)OFF_EW13; S.Bsh = (unsigned)OFF_SH13T;
    S.c = (blockIdx.x & 7) * 32 + (blockIdx.x >> 3); S.G = gridDim.x; S.npn = 2; S.K = 1024; S.bstride_e = 512 * 1024 * 2; S.gather = 1; S.nsh = 64;
    Moe1Epi E; E.ws = p.ws; E.sm = sm;
    g8::gemm_phase<Moe1Epi, MoeSched, true>((LAS unsigned char*)lds, p.ws, 1024, S, E);
}
struct Moe2Epi {
    static constexpr bool PERM = true;
    unsigned char* ws;
    __device__ __forceinline__ bool operator()(f32x4 (&acc)[2][2][4][2], const g8::Unit& u, int wr, int wc, int fr, int fq) const {
        const int valid = u.x1 - u.pm * 256;
        const int colb = u.pn * 256 + wc * 32 + fq * 8;
        const unsigned lbase = (unsigned)(OFF_LIST + (u.x0 * NTOK + u.pm * 256 + wr * 64 + fr) * 4);
        int ent[2][4];
#pragma unroll
        for (int ai = 0; ai < 2; ++ai)
#pragma unroll
            for (int m = 0; m < 4; ++m) {
                const int r = ai * 128 + wr * 64 + m * 16 + fr;
                ent[ai][m] = (r < valid) ? ldg<int>(ws, lbase + (unsigned)((ai * 128 + m * 16) * 4)) : 0;
            }
#pragma unroll
        for (int ai = 0; ai < 2; ++ai)
#pragma unroll
            for (int m = 0; m < 4; ++m) {
                const int r = ai * 128 + wr * 64 + m * 16 + fr;
                if (r < valid) {
                    const unsigned o = (unsigned)OFF_YBUF + (unsigned)(ent[ai][m] * 1024 + colb) * 2u;
#pragma unroll
                    for (int bj = 0; bj < 2; ++bj) stg<uint4>(ws, o + bj * 256, pack8(acc[ai][bj][m][0], acc[ai][bj][m][1]));
                }
                __builtin_amdgcn_sched_barrier(0);
            }
        return false;
    }
};
struct ShSched {
    int c, G;
    __device__ __forceinline__ bool next(int i, g8::Unit& u) const {
        const int L = i * G + c; if (L >= 64 * 4) return false;
        u.pm = L >> 2; u.pn = L & 3; u.A = (unsigned)OFF_HSH + (unsigned)u.pm * 256 * 256 * 2; u.B = (unsigned)OFF_SH2T + (unsigned)u.pn * 256 * 256 * 2; u.x0 = 64; u.x1 = NTOK; return true;
    }
    __device__ __forceinline__ int row(const g8::Unit&, int) const { return 0; }
};
struct ShEpi {
    static constexpr bool PERM = false;
    float* ysh;
    __device__ __forceinline__ bool operator()(f32x4 (&acc)[2][2][4][2], const g8::Unit& u, int wr, int wc, int fr, int fq) const {
#pragma unroll
        for (int ai = 0; ai < 2; ++ai)
#pragma unroll
            for (int m = 0; m < 4; ++m) {
                const int row = u.pm * 256 + ai * 128 + wr * 64 + m * 16 + fr;
#pragma unroll
                for (int bj = 0; bj < 2; ++bj)
#pragma unroll
                    for (int n = 0; n < 2; ++n)
                        stg<f32x4>(ysh, (unsigned)((row * 1024 + u.pn * 256 + bj * 128 + wc * 32 + n * 16 + fq * 4) * 4), acc[ai][bj][m][n]);
                __builtin_amdgcn_sched_barrier(0);
            }
        return false;
    }
};
__device__ void phase_moe2(CParams& p, int l, char* lds) {
    int* sm = (int*)(lds + g8::STAGE_BYTES);
    moe_setup(p, sm);
    MoeSched S; S.sm = sm; S.ws = p.ws;
    S.A = (unsigned)OFF_HBUF; S.Ash = (unsigned)OFF_HSH; S.Bexp = (unsigned)OFF_EW2; S.Bsh = (unsigned)OFF_SH2T;
    S.c = (blockIdx.x & 7) * 32 + (blockIdx.x >> 3); S.G = gridDim.x; S.npn = 4; S.K = 256; S.bstride_e = 1024 * 256 * 2; S.gather = 0; S.nsh = 0;
    Moe2Epi E; E.ws = p.ws;
    g8::gemm_phase<Moe2Epi, MoeSched, false>((LAS unsigned char*)lds, p.ws, 256, S, E);
    ShSched S2; S2.c = (blockIdx.x & 7) * 32 + (blockIdx.x >> 3); S2.G = gridDim.x;
    ShEpi E2; E2.ysh = p.out;
    g8::gemm_phase<ShEpi, ShSched, false>((LAS unsigned char*)lds, p.ws, 256, S2, E2);
}

__device__ void conv_tile(const float* s1, const float* s2, int ldsrc, int K, int perm, u16* dst, int tile, float* lds) {
    const int tid = otid();
    const int ktiles = K >> 6;
    const int kt = tile % ktiles, nt = tile / ktiles;
    __syncthreads();
#pragma unroll 4
    for (int i = 0; i < 16; ++i) {
        int idx = tid + i * 256, kr = idx >> 6, nc = idx & 63;
        const float* s; int col;
        if (perm == 32) { s = (nc < 32) ? s1 : s2; col = nt * 32 + (nc & 31); }
        else if (perm == 16) { s = ((nc & 31) < 16) ? s1 : s2; col = (nt * 2 + (nc >> 5)) * 16 + (nc & 15); }
        else { s = s1; col = nt * 64 + nc; }
        lds[kr * 65 + nc] = s[(size_t)(kt * 64 + kr) * ldsrc + col];
    }
    __syncthreads();
#pragma unroll 4
    for (int i = 0; i < 16; ++i) {
        int idx = tid + i * 256, nr = idx >> 6, kc = idx & 63;
        dst[(size_t)(nt * 64 + nr) * K + kt * 64 + kc] = f2bf(lds[kc * 65 + nr]);
    }
}

__device__ void s5_precompute(CParams& p, int l, int g, int part, float* lds) {
    const int tid = otid();
    float* Er = lds;
    float* Ei = Er + 64 * 17;
    float* Br = Ei + 64 * 17;
    float* Bi = Br + 1024;
    float* Cr = Bi + 1024;
    float* Ci = Cr + 1024;
    float* Kt = Ci + 1024;
    __syncthreads();
    const int lg = l * 32 + g;
    const float dt = expf(p.in[12][lg]);
    {
        const int pp = tid & 63, part = tid >> 6;
        const float ar = p.in[5][lg * 64 + pp], ai = p.in[6][lg * 64 + pp];
        for (int tau = part; tau <= 16; tau += 4) {
            float mag = expf((float)tau * ar * dt);
            float ang = (float)tau * ai * dt;
            Er[pp * 17 + tau] = mag * cosf(ang);
            Ei[pp * 17 + tau] = mag * sinf(ang);
        }
        float mag = expf(ar * dt), ang = ai * dt;
        float e1r = mag * cosf(ang) - 1.f, e1i = mag * sinf(ang);
        float den = ar * ar + ai * ai;
        float qr = (e1r * ar + e1i * ai) / den, qi = (e1i * ar - e1r * ai) / den;
        for (int c = part * 4; c < part * 4 + 4; ++c) {
            float br = p.in[7][((size_t)lg * 64 + pp) * 16 + c], bi = p.in[8][((size_t)lg * 64 + pp) * 16 + c];
            Br[pp * 16 + c] = qr * br - qi * bi;
            Bi[pp * 16 + c] = qr * bi + qi * br;
            Cr[c * 64 + pp] = p.in[9][((size_t)lg * 16 + c) * 64 + pp];
            Ci[c * 64 + pp] = p.in[10][((size_t)lg * 16 + c) * 64 + pp];
        }
    }
    __syncthreads();
    for (int i = 0; i < 16; ++i) {
        int idx = tid + i * 256, tau = idx >> 8, ch = (idx >> 4) & 15, c2 = idx & 15;
        float s = 0.f;
        for (int pp = 0; pp < 64; ++pp) {
            float cr = Cr[ch * 64 + pp], ci = Ci[ch * 64 + pp], er = Er[pp * 17 + tau], ei = Ei[pp * 17 + tau];
            float gr = cr * er - ci * ei, gi = cr * ei + ci * er;
            s += gr * Br[pp * 16 + c2] - gi * Bi[pp * 16 + c2];
        }
        Kt[idx] = s;
    }
    __syncthreads();
    u16* bta = (u16*)(p.ws + OFF_BTA) + (size_t)g * 128 * 256;
    for (int i = part * 16; i < part * 16 + 16; ++i) {
        int idx = tid + i * 256, pr = idx >> 8, k = idx & 255, s = k >> 4, ch = k & 15, pp = pr & 63;
        float er = Er[pp * 17 + 15 - s], ei = Ei[pp * 17 + 15 - s], br = Br[pp * 16 + ch], bi = Bi[pp * 16 + ch];
        float v = (pr < 64) ? (er * br - ei * bi) : (er * bi + ei * br);
        bta[idx] = f2bf(v);
    }
    u16* btc = (u16*)(p.ws + OFF_BTC) + (size_t)g * 256 * 384;
    for (int i = part * 48; i < part * 48 + 48; ++i) {
        int idx = tid + i * 256, n = idx / 384, k = idx - n * 384, j = n >> 4, ch = n & 15;
        float v;
        if (k < 256) {
            int s = k >> 4, c2 = k & 15;
            v = (s <= j) ? Kt[((j - s) * 16 + ch) * 16 + c2] : 0.f;
        } else {
            int pr = k - 256, pp = pr & 63;
            float cr = Cr[ch * 64 + pp], ci = Ci[ch * 64 + pp], er = Er[pp * 17 + j + 1], ei = Ei[pp * 17 + j + 1];
            float gr = cr * er - ci * ei, gi = cr * ei + ci * er;
            v = (pr < 64) ? gr : -gi;
        }
        btc[idx] = f2bf(v);
    }
}

constexpr int W_CONV_TILES = 2608;
__device__ void phase_w(CParams& p, int l, char* lds) {
    const int tid = otid();
    const int nunits = W_CONV_TILES + 256 + 2 + (l == 0 ? 1024 : 0);
    for (int u = VB; u < nunits; u += VG) {
        if (u < W_CONV_TILES) {
            int t = u;
            const float *s1, *s2 = nullptr; int ld, K, perm = 0; u16* dst;
            if (t < 1664) { s1 = p.in[1] + (size_t)l * DM * INC; ld = INC; K = 1024; dst = (u16*)(p.ws + OFF_WINT); }
            else if ((t -= 1664) < 384) { int k = t >> 7; t &= 127; s1 = p.in[22] + (size_t)(l * 3 + k) * 512 * 1024; ld = 1024; K = 512; dst = (u16*)(p.ws + OFF_WBRT) + (size_t)k * 1024 * 512; }
            else if ((t -= 384) < 256) { s1 = p.in[23] + (size_t)l * 1024 * 1024; ld = 1024; K = 1024; dst = (u16*)(p.ws + OFF_WOUTT); }
            else if ((t -= 256) < 64) { s1 = p.in[13] + (size_t)l * 512 * 512; ld = 512; K = 512; dst = (u16*)(p.ws + OFF_GLUT); }
            else if ((t -= 64) < 32) { int h = t >> 3; t &= 7; s1 = p.in[17] + (size_t)(l * 4 + h) * 128 * 128; s2 = p.in[19] + (size_t)(l * 4 + h) * 128 * 128; ld = 128; K = 128; perm = 32; dst = (u16*)(p.ws + OFF_RGT) + (size_t)h * 256 * 128; }
            else if ((t -= 32) < 128) { s1 = p.in[31] + (size_t)l * 1024 * 256; s2 = p.in[32] + (size_t)l * 1024 * 256; ld = 256; K = 1024; perm = 16; dst = (u16*)(p.ws + OFF_SH13T); }
            else if ((t -= 128) < 64) { s1 = p.in[33] + (size_t)l * 256 * 1024; ld = 1024; K = 256; dst = (u16*)(p.ws + OFF_SH2T); }
            else { t -= 64; s1 = p.in[26] + (size_t)l * 1024 * 64; ld = 64; K = 1024; dst = (u16*)(p.ws + OFF_ROUTT); }
            conv_tile(s1, s2, ld, K, perm, dst, t, (float*)lds);
        } else if (u < W_CONV_TILES + 256) {
            s5_precompute(p, l, (u - W_CONV_TILES) >> 3, (u - W_CONV_TILES) & 7, (float*)lds);
        } else if (u == W_CONV_TILES + 256) {
            float* LB = (float*)(p.ws + OFF_LB);
            for (int c = tid; c < 512; c += 256) {
                float x0 = p.in[3][c], x1 = p.in[3][512 + c];
                LB[c] = (l == 0) ? 0.f : 1.f / (1.f + expf(x0 - x1));
            }
            if (tid < 64) ((int*)(p.ws + OFF_CUR))[tid] = 0;
        } else if (u == W_CONV_TILES + 257) {
        } else {
            int r0 = (u - (W_CONV_TILES + 258)) * 16;
            const float4* src = (const float4*)(p.in[0] + (size_t)r0 * DM);
            uint2* dst = (uint2*)((u16*)(p.ws + OFF_XB) + (size_t)r0 * DM);
            for (int i = tid; i < 16 * 256; i += 256) {
                float4 v = src[i];
                uint2 o; o.x = f2bf(v.x) | ((unsigned)f2bf(v.y) << 16); o.y = f2bf(v.z) | ((unsigned)f2bf(v.w) << 16);
                dst[i] = o;
            }
        }
    }
}

__device__ void hgrn_prep(CParams& p, int u) {
    const int tid = otid();
    const int h = u & 3, c = (u >> 2) & 63, b = u >> 8;
    const int r0 = b * SEQ + c * 64;
    const size_t cu = (size_t)((b * 4 + h) * 64 + c);
    if (tid < 128) {
        const int d = tid;
        float* lf = (float*)(p.ws + OFF_PLF) + (size_t)r0 * 512 + h * 128 + d;
        const u16* kk = (const u16*)(p.ws + OFF_PK) + (size_t)r0 * 512 + h * 128 + d;
        float bs[64];
#pragma unroll
        for (int s = 0; s < 64; ++s) bs[s] = lf[(size_t)s * 512];
        float run = 0.f;
#pragma unroll
        for (int s = 0; s < 64; ++s) { run += bs[s]; bs[s] = run; lf[(size_t)s * 512] = run; }
        const float btot = run;
        ((float*)(p.ws + OFF_DEC))[(size_t)(b * 64 + c) * 512 + h * 128 + d] = __expf(btot);
        u16* dst = (u16*)(p.ws + OFF_KTT) + (cu * 128 + d) * 64;
#pragma unroll
        for (int s8 = 0; s8 < 8; ++s8) {
            bf16x8 o;
#pragma unroll
            for (int e = 0; e < 8; ++e) {
                int s = s8 * 8 + e;
                o[e] = (short)f2bf(bf2f(kk[(size_t)s * 512]) * __expf(btot - bs[s]));
            }
            *(bf16x8*)(dst + s8 * 8) = o;
        }
    } else {
        const int v = tid - 128;
        const u16* vv = (const u16*)(p.ws + OFF_PV) + (size_t)r0 * 512 + h * 128 + v;
        u16* dst = (u16*)(p.ws + OFF_VT) + (cu * 128 + v) * 64;
#pragma unroll
        for (int s8 = 0; s8 < 8; ++s8) {
            bf16x8 o;
#pragma unroll
            for (int e = 0; e < 8; ++e) o[e] = (short)vv[(size_t)(s8 * 8 + e) * 512];
            *(bf16x8*)(dst + s8 * 8) = o;
        }
    }
}

__device__ void s5_gemm_a(CParams& p, int u, char* lds) {
    LANE_IDS;
    const int wr = wid >> 1, wc = wid & 1;
    const int g = u >> 3, tm = u & 7, row0 = tm * 128;
    unsigned char* ws = p.ws;
    const unsigned aoff = (unsigned)(OFF_PU + (size_t)g * NTOK * 16 * 2), boff = (unsigned)(OFF_BTA + (size_t)g * 128 * 256 * 2);
    f32x4 acc[4][4]; ZERO_ACC(acc, 4, 4);
    mma_glds<128, 128, 2, 2>(acc, 4, ws,
        [&](int r, int t) { return aoff + ((row0 + r) * 256 + t * 64) * 2; },
        [&](int c, int t) { return boff + (c * 256 + t * 64) * 2; }, NoHook(), lds);
    epi<4, 4, 64, 64>(acc, wr, wc, fq, fr, [&](int r, int cc, float v) {
        stg<float>(ws, (unsigned)(OFF_VC + (((row0 + r) * 32 + g) * 128 + cc) * 4), v); });
}

__device__ void rg_conv(CParams& p, int l, int u) {
    const int tid = otid();
    const u16* xr = (const u16*)(p.ws + OFF_PXR);
    u16* xc = (u16*)(p.ws + OFF_XC);
    const float* cw = p.in[15] + (size_t)l * 4 * 512;
    const float* cb = p.in[16] + (size_t)l * 512;
    for (int i = tid; i < 64 * 64; i += 256) {
        const int row = u * 64 + (i >> 6), c8 = (i & 63) * 8;
        const int t = row & (SEQ - 1);
        float a[8];
#pragma unroll
        for (int e = 0; e < 8; ++e) a[e] = cb[c8 + e];
#pragma unroll
        for (int j = 0; j < 4; ++j) {
            if (t - 3 + j >= 0) {
                bf16x8 x = *(const bf16x8*)(xr + (size_t)(row - 3 + j) * 512 + c8);
#pragma unroll
                for (int e = 0; e < 8; ++e) a[e] += cw[j * 512 + c8 + e] * bf2f((u16)x[e]);
            }
        }
        bf16x8 o;
#pragma unroll
        for (int e = 0; e < 8; ++e) o[e] = (short)f2bf(a[e]);
        *(bf16x8*)(xc + (size_t)row * 512 + c8) = o;
    }
}

__device__ void phase2(CParams& p, int l, char* lds) {
    for (int u = VB; u < 1536; u += VG) {
        if (u < 1024) hgrn_prep(p, u);
        else if (u < 1280) s5_gemm_a(p, u - 1024, lds);
        else rg_conv(p, l, u - 1280);
    }
}

__device__ void hgrn_u(CParams& p, int u, char* lds) {
    LANE_IDS;
    const int wr = wid >> 1, wc = wid & 1;
    unsigned char* ws = p.ws;
    f32x4 acc[4][4]; ZERO_ACC(acc, 4, 4);
    mma_glds<128, 128, 2, 2>(acc, 1, ws,
        [&](int r, int t) { return (unsigned)(OFF_KTT + ((u * 128 + r) * 64) * 2); },
        [&](int c, int t) { return (unsigned)(OFF_VT + ((u * 128 + c) * 64) * 2); }, NoHook(), lds);
#pragma unroll
    for (int m = 0; m < 4; ++m) {
#pragma unroll
        for (int n = 0; n < 4; ++n) {
            const int d0 = wr * 64 + m * 16 + fq * 4, v = wc * 64 + n * 16 + fr;
            uint2 o;
            o.x = f2bf(acc[m][n][0]) | ((unsigned)f2bf(acc[m][n][1]) << 16);
            o.y = f2bf(acc[m][n][2]) | ((unsigned)f2bf(acc[m][n][3]) << 16);
            stg<uint2>(ws, (unsigned)(OFF_UT + ((u * 128 + v) * 128 + d0) * 2), o);
        }
        __builtin_amdgcn_sched_barrier(0);
    }
}

__device__ void hgrn_sscan(CParams& p, int u) {
    const int tid = otid();
    const int bh = u >> 4, ec = (u & 15) * 256 + tid, v = ec >> 5, d4 = (ec & 31) * 4;
    const int b = bh >> 2, h = bh & 3;
    unsigned char* ws = p.ws;
    const unsigned ub = (unsigned)(OFF_UT + ((bh * 64 * 128 + v) * 128 + d4) * 2);
    const unsigned sb = (unsigned)(OFF_ST + ((bh * 64 * 128 + v) * 128 + d4) * 2);
    const unsigned db = (unsigned)(OFF_DEC + ((b * 64) * 512 + h * 128 + d4) * 4);
    f32x4 S = {0.f, 0.f, 0.f, 0.f};
    for (int c0 = 0; c0 < 64; c0 += 8) {
        uint2 uu[8]; f32x4 dd[8];
#pragma unroll
        for (int i = 0; i < 8; ++i) { uu[i] = ldg<uint2>(ws, ub + (unsigned)((c0 + i) * 128 * 128 * 2)); dd[i] = ldg<f32x4>(ws, db + (unsigned)((c0 + i) * 512 * 4)); }
#pragma unroll
        for (int i = 0; i < 8; ++i) {
            uint2 o;
            o.x = f2bf(S[0]) | ((unsigned)f2bf(S[1]) << 16); o.y = f2bf(S[2]) | ((unsigned)f2bf(S[3]) << 16);
            stg<uint2>(ws, sb + (unsigned)((c0 + i) * 128 * 128 * 2), o);
            S[0] = dd[i][0] * S[0] + bf2f((u16)(uu[i].x & 0xffff)); S[1] = dd[i][1] * S[1] + bf2f((u16)(uu[i].x >> 16));
            S[2] = dd[i][2] * S[2] + bf2f((u16)(uu[i].y & 0xffff)); S[3] = dd[i][3] * S[3] + bf2f((u16)(uu[i].y >> 16));
        }
    }
}

__device__ void s5_scan(CParams& p, int l, int u, char* lds) {
    const int tid = otid();
    const int b = u >> 5, g = u & 31, seg = tid >> 6, pp = tid & 63;
    const int lg = l * 32 + g;
    const float dt = expf(p.in[12][lg]);
    const float ar = p.in[5][lg * 64 + pp], ai = p.in[6][lg * 64 + pp];
    const float mag = expf(16.f * ar * dt), ang = 16.f * ai * dt;
    const float er = mag * cosf(ang), ei = mag * sinf(ang);
    const float mg2 = expf(1024.f * ar * dt), an2 = 1024.f * ai * dt;
    const float sr = mg2 * cosf(an2), si = mg2 * sinf(an2);
    unsigned char* ws = p.ws;
    const unsigned vb = (unsigned)(OFF_VC + (((b * 256 + seg * 64) * 32 + g) * 128 + pp) * 4);
    const unsigned hb = (unsigned)(OFF_HC + (((b * 256 + seg * 64) * 32 + g) * 128 + pp) * 2);
    float* ex = (float*)lds;
    __syncthreads();
    float hr = 0.f, hi = 0.f;
    for (int c0 = 0; c0 < 64; c0 += 16) {
        float vr[16], vi[16];
#pragma unroll
        for (int i = 0; i < 16; ++i) { vr[i] = ldg<float>(ws, vb + (unsigned)((c0 + i) * 4096 * 4)); vi[i] = ldg<float>(ws, vb + (unsigned)((c0 + i) * 4096 * 4 + 256)); }
#pragma unroll
        for (int i = 0; i < 16; ++i) { const float nr = er * hr - ei * hi + vr[i], ni = er * hi + ei * hr + vi[i]; hr = nr; hi = ni; }
    }
    ex[(seg * 64 + pp) * 2] = hr; ex[(seg * 64 + pp) * 2 + 1] = hi;
    __syncthreads();
    hr = 0.f; hi = 0.f;
    for (int sg = 0; sg < seg; ++sg) {
        const float lr = ex[(sg * 64 + pp) * 2], li = ex[(sg * 64 + pp) * 2 + 1];
        const float nr = sr * hr - si * hi + lr, ni = sr * hi + si * hr + li; hr = nr; hi = ni;
    }
    for (int c0 = 0; c0 < 64; c0 += 16) {
        float vr[16], vi[16];
#pragma unroll
        for (int i = 0; i < 16; ++i) { vr[i] = ldg<float>(ws, vb + (unsigned)((c0 + i) * 4096 * 4)); vi[i] = ldg<float>(ws, vb + (unsigned)((c0 + i) * 4096 * 4 + 256)); }
#pragma unroll
        for (int i = 0; i < 16; ++i) {
            stg<u16>(ws, hb + (unsigned)((c0 + i) * 4096 * 2), f2bf(hr));
            stg<u16>(ws, hb + (unsigned)((c0 + i) * 4096 * 2 + 128), f2bf(hi));
            const float nr = er * hr - ei * hi + vr[i], ni = er * hi + ei * hr + vi[i]; hr = nr; hi = ni;
        }
    }
}

__device__ void rg_gemm(CParams& p, int l, int u, char* lds) {
    LANE_IDS;
    const int wr = wid >> 1, wc = wid & 1;
    const int tm = u >> 3, h = (u >> 1) & 3, nt = u & 1, row0 = tm * 128;
    unsigned char* ws = p.ws;
    const unsigned aoff = (unsigned)(OFF_XC + h * 128 * 2), boff = (unsigned)(OFF_RGT + ((size_t)h * 256 * 128 + (size_t)nt * 128 * 128) * 2);
    f32x4 acc[4][4]; ZERO_ACC(acc, 4, 4);
    mma_glds<128, 128, 2, 2>(acc, 2, ws,
        [&](int r, int t) { return aoff + ((row0 + r) * 512 + t * 64) * 2; },
        [&](int c, int t) { return boff + (c * 128 + t * 64) * 2; }, NoHook(), lds);
    const float* ba = p.in[18] + (size_t)l * 512;
    const float* bx = p.in[20] + (size_t)l * 512;
    const float* lam = p.in[21] + (size_t)l * 512;
#pragma unroll
    for (int n = 0; n < 2; ++n) {
        const int ch = h * 128 + (nt * 2 + wc) * 32 + n * 16 + fr;
        const float c1 = -8.f * log1pf(expf(-lam[ch]));
        const float bav = ba[ch], bxv = bx[ch];
#pragma unroll
        for (int m = 0; m < 4; ++m) {
#pragma unroll
            for (int j = 0; j < 4; ++j) {
                const int row = row0 + wr * 64 + m * 16 + fq * 4 + j;
                const float r = sigm(acc[m][n][j] + bav), ig = sigm(acc[m][n + 2][j] + bxv);
                const float la = c1 * r;
                const float x = bf2f(ldg<u16>(ws, (unsigned)(OFF_XC + (row * 512 + ch) * 2)));
                const float bb = sqrtf(fmaxf(1.f - __expf(2.f * la), 0.f)) * ig * x;
                stg<u16>(ws, (unsigned)(OFF_LA + (row * 512 + ch) * 2), f2bf(la));
                stg<u16>(ws, (unsigned)(OFF_BB + (row * 512 + ch) * 2), f2bf(bb));
            }
            __builtin_amdgcn_sched_barrier(0);
        }
    }
}

__device__ void phase3(CParams& p, int l, char* lds) {
    for (int u = VB; u < 2176; u += VG) {
        if (u < 128) s5_scan(p, l, u, lds);
        else if (u < 1152) hgrn_u(p, u - 128, lds);
        else rg_gemm(p, l, u - 1152, lds);
    }
}

__device__ void hgrn_out(CParams& p, int l, int u, char* lds) {
    LANE_IDS;
    const int h = u & 3, c = (u >> 2) & 63, b = u >> 8;
    const int r0 = b * SEQ + c * 64;
    const size_t cu = (size_t)((b * 4 + h) * 64 + c);
    const u16* Pq = (const u16*)(p.ws + OFF_PQ) + (size_t)r0 * 512 + h * 128;
    const u16* Pk = (const u16*)(p.ws + OFF_PK) + (size_t)r0 * 512 + h * 128;
    const float* Bc = (const float*)(p.ws + OFF_PLF) + (size_t)r0 * 512 + h * 128;
    char* Ss = lds + (64 + 128) * 128;
    __syncthreads();
    {
        const int i = wid;
        const int t = 16 * i + fr;
        bf16x8 aq[4];
        float refv[4][8];
#pragma unroll
        for (int kk = 0; kk < 4; ++kk) {
            const int d0 = kk * 32 + fq * 8;
            bf16x8 q8 = *(const bf16x8*)(Pq + (size_t)t * 512 + d0);
#pragma unroll
            for (int e = 0; e < 8; ++e) {
                float rf = (i == 0) ? 0.f : Bc[(size_t)(16 * i - 1) * 512 + d0 + e];
                refv[kk][e] = rf;
                float bt = Bc[(size_t)t * 512 + d0 + e];
                aq[kk][e] = (short)f2bf(bf2f((u16)q8[e]) * __expf(bt - rf));
            }
        }
#pragma unroll
        for (int j = 0; j < 4; ++j) {
            f32x4 sc = {0.f, 0.f, 0.f, 0.f};
            if (j <= i) {
                const int s = 16 * j + fr;
#pragma unroll
                for (int kk = 0; kk < 4; ++kk) {
                    const int d0 = kk * 32 + fq * 8;
                    bf16x8 k8 = *(const bf16x8*)(Pk + (size_t)s * 512 + d0);
                    bf16x8 bk;
#pragma unroll
                    for (int e = 0; e < 8; ++e) {
                        float bsv = Bc[(size_t)s * 512 + d0 + e];
                        bk[e] = (short)f2bf(bf2f((u16)k8[e]) * __expf(fminf(refv[kk][e] - bsv, 60.f)));
                    }
                    sc = __builtin_amdgcn_mfma_f32_16x16x32_bf16(aq[kk], bk, sc, 0, 0, 0);
                }
            }
#pragma unroll
            for (int r = 0; r < 4; ++r) {
                const int tl = fq * 4 + r, sl = fr;
                float v = sc[r];
                if (j > i || (j == i && sl > tl)) v = 0.f;
                const int row = 16 * i + tl, col = 16 * j + sl;
                *(u16*)(Ss + swz(row, col >> 3) + (col & 7) * 2) = f2bf(v);
            }
        }
    }
    __syncthreads();
    const u16* STc = (const u16*)(p.ws + OFF_ST) + cu * 128 * 128;
    const u16* VTc = (const u16*)(p.ws + OFF_VT) + cu * 128 * 64;
    f32x4 acc[1][8]; ZERO_ACC(acc, 1, 8);
    mma_loop<64, 128, 4, 1>(acc, 3,
        [&](int r, int k) {
            bf16x8 o;
            if (k < 128) {
                bf16x8 q8 = *(const bf16x8*)(Pq + (size_t)r * 512 + k);
                const float4 b0 = *(const float4*)(Bc + (size_t)r * 512 + k), b1 = *(const float4*)(Bc + (size_t)r * 512 + k + 4);
                o[0] = (short)f2bf(bf2f((u16)q8[0]) * __expf(b0.x)); o[1] = (short)f2bf(bf2f((u16)q8[1]) * __expf(b0.y));
                o[2] = (short)f2bf(bf2f((u16)q8[2]) * __expf(b0.z)); o[3] = (short)f2bf(bf2f((u16)q8[3]) * __expf(b0.w));
                o[4] = (short)f2bf(bf2f((u16)q8[4]) * __expf(b1.x)); o[5] = (short)f2bf(bf2f((u16)q8[5]) * __expf(b1.y));
                o[6] = (short)f2bf(bf2f((u16)q8[6]) * __expf(b1.z)); o[7] = (short)f2bf(bf2f((u16)q8[7]) * __expf(b1.w));
            } else {
                o = *(const bf16x8*)(Ss + swz(r, (k - 128) >> 3));
            }
            return o;
        },
        [&](int cc, int k) {
            return (k < 128) ? *(const bf16x8*)(STc + (size_t)cc * 128 + k) : *(const bf16x8*)(VTc + (size_t)cc * 64 + (k - 128));
        }, NoHook(), lds);
    const float* nw = p.in[4] + (size_t)l * 512 + h * 128;
    const u16* Pg = (const u16*)(p.ws + OFF_PG) + (size_t)r0 * 512 + h * 128;
    u16* Ya = (u16*)(p.ws + OFF_YA) + (size_t)r0 * 512 + h * 128;
#pragma unroll
    for (int j = 0; j < 4; ++j) {
        float ss = 0.f;
#pragma unroll
        for (int n = 0; n < 8; ++n) ss += acc[0][n][j] * acc[0][n][j];
        ss += shfl_xor_l(ss, 1, lane); ss += shfl_xor_l(ss, 2, lane); ss += shfl_xor_l(ss, 4, lane); ss += shfl_xor_l(ss, 8, lane);
        const float rs = rsqrtf(ss * (1.f / 128.f) + 1e-6f);
        const int row = wid * 16 + fq * 4 + j;
#pragma unroll
        for (int n = 0; n < 8; ++n) {
            const int v = n * 16 + fr;
            Ya[(size_t)row * 512 + v] = f2bf(acc[0][n][j] * rs * nw[v] * bf2f(Pg[(size_t)row * 512 + v]));
        }
    }
}

__device__ void s5_gemm_c(CParams& p, int l, int u, char* lds) {
    LANE_IDS;
    const int wr = wid >> 1, wc = wid & 1;
    const int g = u >> 4, tm = (u >> 1) & 7, tn = u & 1, row0 = tm * 128, col0 = tn * 128;
    unsigned char* ws = p.ws;
    const unsigned aoff = (unsigned)(OFF_PU + (size_t)g * NTOK * 16 * 2), boff = (unsigned)(OFF_BTC + (size_t)g * 256 * 384 * 2);
    f32x4 acc[4][4]; ZERO_ACC(acc, 4, 4);
    mma_glds<128, 128, 2, 2>(acc, 6, ws,
        [&](int r, int t) {
            return (t < 4) ? aoff + ((row0 + r) * 256 + t * 64) * 2 : (unsigned)(OFF_HC + (((row0 + r) * 32 + g) * 128 + (t - 4) * 64) * 2);
        },
        [&](int c, int t) { return boff + ((col0 + c) * 384 + t * 64) * 2; }, NoHook(), lds);
    const float dch = p.in[11][(size_t)l * 512 + g * 16 + fr];
    epi<4, 4, 64, 64>(acc, wr, wc, fq, fr, [&](int r, int cc, float v) {
        const int row = row0 + r, col = col0 + cc;
        const int jj = col >> 4, ch = col & 15;
        const int tok = (row >> 8) * SEQ + (row & 255) * 16 + jj;
        const float uu = bf2f(ldg<u16>(ws, aoff + (tok * 16 + ch) * 2));
        const float y = v + dch * uu;
        stg<u16>(ws, (unsigned)(OFF_YG + (tok * 512 + g * 16 + ch) * 2), f2bf(gelu_f(y))); });
}

__device__ void rg_local(CParams& p, int u) {
    const int tid = otid();
    const int b = u >> 7, seg = (u >> 1) & 63, ch = (u & 1) * 256 + tid;
    unsigned char* ws = p.ws;
    const unsigned base = (unsigned)(((b * SEQ + seg * 64) * 512 + ch) * 2);
    float hh = 0.f, ap = 1.f;
    for (int s0 = 0; s0 < 64; s0 += 16) {
        float a[16], bb[16];
#pragma unroll
        for (int i = 0; i < 16; ++i) { a[i] = bf2f(ldg<u16>(ws, (unsigned)OFF_LA + base + (unsigned)((s0 + i) * 1024))); bb[i] = bf2f(ldg<u16>(ws, (unsigned)OFF_BB + base + (unsigned)((s0 + i) * 1024))); }
#pragma unroll
        for (int i = 0; i < 16; ++i) { const float av = __expf(a[i]); hh = av * hh + bb[i]; ap *= av; }
    }
    stg<float>(ws, (unsigned)(OFF_SEGA + ((b * 64 + seg) * 512 + ch) * 4), ap);
    stg<float>(ws, (unsigned)(OFF_SEGH + ((b * 64 + seg) * 512 + ch) * 4), hh);
}

__device__ void rg_final(CParams& p, int u) {
    const int tid = otid();
    const int b = u >> 7, seg = (u >> 1) & 63, ch = (u & 1) * 256 + tid;
    unsigned char* ws = p.ws;
    const unsigned base = (unsigned)(((b * SEQ + seg * 64) * 512 + ch) * 2);
    float hh = 0.f;
    for (int sg = 0; sg < seg; ++sg) {
        const float sa = ldg<float>(ws, (unsigned)(OFF_SEGA + ((b * 64 + sg) * 512 + ch) * 4));
        const float sh = ldg<float>(ws, (unsigned)(OFF_SEGH + ((b * 64 + sg) * 512 + ch) * 4));
        hh = sa * hh + sh;
    }
    for (int s0 = 0; s0 < 64; s0 += 16) {
        float a[16], bb[16], xg[16];
#pragma unroll
        for (int i = 0; i < 16; ++i) {
            a[i] = bf2f(ldg<u16>(ws, (unsigned)OFF_LA + base + (unsigned)((s0 + i) * 1024)));
            bb[i] = bf2f(ldg<u16>(ws, (unsigned)OFF_BB + base + (unsigned)((s0 + i) * 1024)));
            xg[i] = bf2f(ldg<u16>(ws, (unsigned)OFF_PXG + base + (unsigned)((s0 + i) * 1024)));
        }
#pragma unroll
        for (int i = 0; i < 16; ++i) { hh = __expf(a[i]) * hh + bb[i]; stg<u16>(ws, (unsigned)OFF_YC + base + (unsigned)((s0 + i) * 1024), f2bf(hh * xg[i])); }
    }
}

__device__ void phase4(CParams& p, int l, char* lds) {
    for (int u = VB; u < 1280; u += VG) {
        if (u < 256) hgrn_sscan(p, u);
        else if (u < 768) rg_local(p, u - 256);
        else s5_gemm_c(p, l, u - 768, lds);
    }
}

__device__ void phase_glu(CParams& p, int l, char* lds) {
    LANE_IDS;
    const int wr = wid >> 1, wc = wid & 1;
    unsigned char* ws = p.ws;
    const float* gb = p.in[14] + (size_t)l * 512;
    for (int uu = VB; uu < 2048; uu += VG) {
        if (uu < 1024) { hgrn_out(p, l, uu, lds); continue; }
        if (uu < 1536) { rg_final(p, uu - 1024); continue; }
        const int u = uu - 1536;
        const int row0 = (u >> 2) * 128, col0 = (u & 3) * 128;
        f32x4 acc[4][4]; ZERO_ACC(acc, 4, 4);
        mma_glds<128, 128, 2, 2>(acc, 8, ws,
            [&](int r, int t) { return (unsigned)(OFF_YG + ((row0 + r) * 512 + t * 64) * 2); },
            [&](int c, int t) { return (unsigned)(OFF_GLUT + ((col0 + c) * 512 + t * 64) * 2); }, NoHook(), lds);
        epi<4, 4, 64, 64>(acc, wr, wc, fq, fr, [&](int r, int cc, float v) {
            const int row = row0 + r, col = col0 + cc;
            const float y = bf2f(ldg<u16>(ws, (unsigned)(OFF_YG + (row * 512 + col) * 2)));
            stg<u16>(ws, (unsigned)(OFF_YB + (row * 512 + col) * 2), f2bf(y * sigm(v + gb[col]))); });
    }
}

__device__ void phase_branch(CParams& p, int l, char* lds) {
    BrSched S; S.c = blockIdx.x;
    BrEpi E; E.ws = p.ws;
    g8::gemm_phase<BrEpi, BrSched, false>((LAS unsigned char*)lds, p.ws, 512, S, E);
}

__device__ void phase_out(CParams& p, int l, char* lds, char* hlds) {
    {
        OutSched S; S.A = (unsigned)OFF_MIXP; S.B = (unsigned)OFF_WOUTT; S.c = blockIdx.x; S.G = gridDim.x;
        OutEpi E; E.ws = p.ws; E.xres = (l == 0) ? p.in[0] : p.out;
        g8::gemm_phase<OutEpi, OutSched, false>((LAS unsigned char*)lds, p.ws, 1024, S, E);
    }
    for (int u = VB; u < 12288; u += VG) {
        const int e = u / 192, r = u % 192;
        if (r < 128)
            conv_tile(p.in[28] + (size_t)(l * 64 + e) * 1024 * 256, p.in[29] + (size_t)(l * 64 + e) * 1024 * 256, 256, 1024, 16,
                      (u16*)(p.ws + OFF_EW13) + (size_t)e * 512 * 1024, r, (float*)hlds);
        else
            conv_tile(p.in[30] + (size_t)(l * 64 + e) * 256 * 1024, nullptr, 1024, 256, 0,
                      (u16*)(p.ws + OFF_EW2) + (size_t)e * 1024 * 256, r - 128, (float*)hlds);
    }
}

__device__ __forceinline__ void ln_row(float (&v)[16], const float* g, const float* bta, int lane) {
    float s = 0.f;
#pragma unroll
    for (int i = 0; i < 16; ++i) s += v[i];
    const float mu = wave_sum(s, lane) * (1.f / 1024.f);
    float q = 0.f;
#pragma unroll
    for (int i = 0; i < 16; ++i) { float d = v[i] - mu; q += d * d; }
    const float rs = rsqrtf(wave_sum(q, lane) * (1.f / 1024.f) + 1e-5f);
#pragma unroll
    for (int i = 0; i < 4; ++i) {
        const float4 gg = *(const float4*)(g + i * 256 + lane * 4), bb = *(const float4*)(bta + i * 256 + lane * 4);
        v[i * 4 + 0] = (v[i * 4 + 0] - mu) * rs * gg.x + bb.x;
        v[i * 4 + 1] = (v[i * 4 + 1] - mu) * rs * gg.y + bb.y;
        v[i * 4 + 2] = (v[i * 4 + 2] - mu) * rs * gg.z + bb.z;
        v[i * 4 + 3] = (v[i * 4 + 3] - mu) * rs * gg.w + bb.w;
    }
}

__device__ void phase_route(CParams& p, int l, char* lds) {
    LANE_IDS;
    const float* Pre = (const float*)(p.ws + OFF_PRELN);
    u16* Xm = (u16*)(p.ws + OFF_XM);
    const float* g1 = p.in[24] + (size_t)l * 1024;
    const float* b1 = p.in[25] + (size_t)l * 1024;
    const float* rbias = p.in[27] + (size_t)l * 64;
    int* cursor = (int*)(p.ws + OFF_CUR);
    int* list = (int*)(p.ws + OFF_LIST);
    float* wlist = (float*)(p.ws + OFF_WLIST);
    float* Ls = (float*)(lds + 32768);
    int* hist = (int*)(lds + 32768 + 64 * 65 * 4);
    int* basep = hist + 64;
    for (int u = VB; u < 256; u += VG) {
        const int row0 = u * 64;
        for (int rr = 0; rr < 16; ++rr) {
            const int row = row0 + wid * 16 + rr;
            float v[16];
#pragma unroll
            for (int i = 0; i < 4; ++i) {
                const float4 x = *(const float4*)(Pre + (size_t)row * 1024 + i * 256 + lane * 4);
                v[i * 4] = x.x; v[i * 4 + 1] = x.y; v[i * 4 + 2] = x.z; v[i * 4 + 3] = x.w;
            }
            ln_row(v, g1, b1, lane);
#pragma unroll
            for (int i = 0; i < 4; ++i) {
                uint2 o; o.x = f2bf(v[i * 4]) | ((unsigned)f2bf(v[i * 4 + 1]) << 16); o.y = f2bf(v[i * 4 + 2]) | ((unsigned)f2bf(v[i * 4 + 3]) << 16);
                *(uint2*)(Xm + (size_t)row * 1024 + i * 256 + lane * 4) = o;
            }
        }
        if (tid < 64) hist[tid] = 0;
        __syncthreads();
        f32x4 acc[1][4]; ZERO_ACC(acc, 1, 4);
        mma_glds<64, 64, 4, 1>(acc, 16, p.ws,
            [&](int r, int t) { return (unsigned)(OFF_XM + ((row0 + r) * 1024 + t * 64) * 2); },
            [&](int c, int t) { return (unsigned)(OFF_ROUTT + (c * 1024 + t * 64) * 2); }, NoHook(), lds);
#pragma unroll
        for (int n = 0; n < 4; ++n)
#pragma unroll
            for (int j = 0; j < 4; ++j) {
                const int r = wid * 16 + fq * 4 + j, e = n * 16 + fr;
                Ls[r * 65 + e] = sigm(acc[0][n][j]) + rbias[e];
            }
        __syncthreads();
        int myrank[8]; int myexp[8]; float wv[8];
        if (tid < 64) {
            float* sc = Ls + tid * 65;
            float gs[8];
#pragma unroll
            for (int g = 0; g < 8; ++g) {
                float m1 = -1e30f, m2 = -1e30f;
#pragma unroll
                for (int i = 0; i < 8; ++i) { float x = sc[g * 8 + i]; if (x > m1) { m2 = m1; m1 = x; } else if (x > m2) m2 = x; }
                gs[g] = m1 + m2;
            }
            unsigned gmask = 0;
#pragma unroll
            for (int it = 0; it < 4; ++it) {
                float best = -1e30f; int bi = 0;
#pragma unroll
                for (int g = 0; g < 8; ++g) { bool ok = !((gmask >> g) & 1u) && gs[g] > best; if (ok) { best = gs[g]; bi = g; } }
                gmask |= 1u << bi;
            }
            unsigned long long chosen = 0ull;
            float wsum = 0.f;
#pragma unroll
            for (int k = 0; k < 8; ++k) {
                float best = -1e30f; int bi = 0;
                for (int e = 0; e < 64; ++e) {
                    float x = sc[e];
                    bool ok = ((gmask >> (e >> 3)) & 1u) && !((chosen >> e) & 1ull) && x > best;
                    if (ok) { best = x; bi = e; }
                }
                chosen |= 1ull << bi;
                myexp[k] = bi;
                wv[k] = best - rbias[bi];
                wsum += wv[k];
            }
            const float sc_ = 2.5f / wsum;
#pragma unroll
            for (int k = 0; k < 8; ++k) {
                wv[k] *= sc_;
                myrank[k] = atomicAdd(&hist[myexp[k]], 1);
            }
        }
        __syncthreads();
        if (tid < 64) basep[tid] = atomicAdd(&cursor[tid], hist[tid]);
        __syncthreads();
        if (tid < 64) {
#pragma unroll
            for (int k = 0; k < 8; ++k) {
                const size_t pos = (size_t)myexp[k] * NTOK + basep[myexp[k]] + myrank[k];
                list[pos] = (row0 + tid) * 8 + k;
                wlist[pos] = wv[k];
            }
        }
        __syncthreads();
    }
}

__device__ void phase_combine(CParams& p, int l) {
    LANE_IDS;
    const u16* Xm = (const u16*)(p.ws + OFF_XM);
    const u16* Yb = (const u16*)(p.ws + OFF_YBUF);
    const float* g2 = p.in[34] + (size_t)l * 1024;
    const float* b2 = p.in[35] + (size_t)l * 1024;
    u16* Xb = (u16*)(p.ws + OFF_XB);
    for (int row = VB * 4 + wid; row < NTOK; row += VG * 4) {
        float v[16];
#pragma unroll
        for (int i = 0; i < 4; ++i) {
            const float4 y = *(const float4*)(p.out + (size_t)row * 1024 + i * 256 + lane * 4);
            const uint2 x = *(const uint2*)(Xm + (size_t)row * 1024 + i * 256 + lane * 4);
            v[i * 4 + 0] = y.x + DN_ALPHA * bf2f((u16)(x.x & 0xffff));
            v[i * 4 + 1] = y.y + DN_ALPHA * bf2f((u16)(x.x >> 16));
            v[i * 4 + 2] = y.z + DN_ALPHA * bf2f((u16)(x.y & 0xffff));
            v[i * 4 + 3] = y.w + DN_ALPHA * bf2f((u16)(x.y >> 16));
        }
#pragma unroll
        for (int k = 0; k < 8; ++k)
#pragma unroll
            for (int i = 0; i < 4; ++i) {
                const uint2 x = *(const uint2*)(Yb + ((size_t)row * 8 + k) * 1024 + i * 256 + lane * 4);
                v[i * 4 + 0] += bf2f((u16)(x.x & 0xffff));
                v[i * 4 + 1] += bf2f((u16)(x.x >> 16));
                v[i * 4 + 2] += bf2f((u16)(x.y & 0xffff));
                v[i * 4 + 3] += bf2f((u16)(x.y >> 16));
            }
        ln_row(v, g2, b2, lane);
#pragma unroll
        for (int i = 0; i < 4; ++i) {
            *(float4*)(p.out + (size_t)row * 1024 + i * 256 + lane * 4) = float4{v[i * 4], v[i * 4 + 1], v[i * 4 + 2], v[i * 4 + 3]};
            uint2 o; o.x = f2bf(v[i * 4]) | ((unsigned)f2bf(v[i * 4 + 1]) << 16); o.y = f2bf(v[i * 4 + 2]) | ((unsigned)f2bf(v[i * 4 + 3]) << 16);
            *(uint2*)(Xb + (size_t)row * 1024 + i * 256 + lane * 4) = o;
        }
    }
}


#define XB_TMO      128
#define XB_XCNT(j)  (256  + 64 * (j))
#define XB_XSUB(j)  (1280 + 64 * (j))
#define XB_XGEN(j)  (2304 + 64 * (j))
#define XB_TOP      3328
#define XB_TOPGEN   3392
#define XCD_BAR_WORDS 3456
#define XB_SPIN_CAP (1u << 22)
__device__ __forceinline__ unsigned xb_ld(unsigned* p)              { return __hip_atomic_load(p, __ATOMIC_RELAXED, __HIP_MEMORY_SCOPE_AGENT); }
__device__ __forceinline__ unsigned xb_add(unsigned* p, unsigned v) { return __hip_atomic_fetch_add(p, v, __ATOMIC_RELAXED, __HIP_MEMORY_SCOPE_AGENT); }
__device__ __forceinline__ unsigned xb_xcc_id() { return (unsigned)__builtin_amdgcn_s_getreg((3 << 11) | 20) & 0xFu; }
#define XB_SPIN(cond, bar) do { unsigned _sp = 0; while (cond) { __builtin_amdgcn_s_sleep(1); \
    if ((++_sp & 255u) == 0u) { if (xb_ld(&(bar)[XB_TMO])) break; if (_sp > XB_SPIN_CAP) { atomicAdd(&(bar)[XB_TMO], 1u); break; } } } } while (0)
struct XcdBarrier { unsigned* bar; unsigned x; volatile LAS unsigned* st; };
__device__ __forceinline__ XcdBarrier xcd_barrier_post(unsigned* bar, volatile LAS unsigned* st) {
    XcdBarrier b; b.bar = bar; b.x = xb_xcc_id(); b.st = st;
    if (threadIdx.x == 0) (void)xb_add(&bar[XB_XCNT(b.x)], 1u);
    return b;
}
__device__ __forceinline__ void xcd_barrier_complete(unsigned* bar, unsigned x, unsigned& nloc, unsigned& nx) {
    const unsigned G = gridDim.x * gridDim.y * gridDim.z;
    unsigned sum, cnt, mine, sp = 0u;
    for (;;) {
        sum = 0u; cnt = 0u; mine = 0u;
#pragma unroll
        for (unsigned j = 0; j < 16; ++j) { const unsigned c = xb_ld(&bar[XB_XCNT(j)]); sum += c; cnt += (c > 0u) ? 1u : 0u; mine = (j == x) ? c : mine; }
        if (sum == G) break;
        __builtin_amdgcn_s_sleep(1);
        if ((++sp & 255u) == 0u) { if (xb_ld(&bar[XB_TMO])) break; if (sp > XB_SPIN_CAP) { atomicAdd(&bar[XB_TMO], 1u); break; } }
    }
    nloc = mine > 0u ? mine : 1u; nx = cnt > 0u ? cnt : 1u;
}
__device__ __forceinline__ void xcd_barrier(const XcdBarrier& b) {
    asm volatile("s_waitcnt vmcnt(0)" ::: "memory");
    __syncthreads();
    if (threadIdx.x == 0) {
        unsigned* bar = b.bar;
        __builtin_amdgcn_s_waitcnt(0);
        unsigned nloc = b.st[0], nx = b.st[1];
        if (nloc == 0u) { xcd_barrier_complete(bar, b.x, nloc, nx); b.st[0] = nloc; b.st[1] = nx; }
        const unsigned old = xb_add(&bar[XB_XSUB(b.x)], 1u);
        const unsigned gen = old / nloc;
        if (old + 1u == (gen + 1u) * nloc) {
            __builtin_amdgcn_fence(__ATOMIC_RELEASE, "agent");
            asm volatile("s_waitcnt vmcnt(0)" ::: "memory");
            const unsigned og = xb_add(&bar[XB_TOP], 1u);
            const unsigned tg = og / nx;
            if (og + 1u == (tg + 1u) * nx) xb_add(&bar[XB_TOPGEN], 1u);
            else XB_SPIN(xb_ld(&bar[XB_TOPGEN]) == tg, bar);
            __builtin_amdgcn_fence(__ATOMIC_ACQUIRE, "agent");
            xb_add(&bar[XB_XGEN(b.x)], 1u);
            asm volatile("s_waitcnt vmcnt(0)" ::: "memory");
        } else {
            XB_SPIN(xb_ld(&bar[XB_XGEN(b.x)]) == gen, bar);
            __builtin_amdgcn_fence(__ATOMIC_ACQUIRE, "agent");
            asm volatile("s_waitcnt vmcnt(0)" ::: "memory");
        }
    }
    __syncthreads();
}

__global__ void __launch_bounds__(512, 2) fwd_kernel(Params p_unused) {
    extern __shared__ __attribute__((aligned(16))) char lds[];
    cg::grid_group grid = cg::this_grid();
    CParams* pp = (CParams*)__builtin_amdgcn_kernarg_segment_ptr();
    const int ph_lo = pp->ph_lo;
    volatile LAS unsigned* xst = (volatile LAS unsigned*)(lds + L_XST);
    if (threadIdx.x == 0) { xst[0] = 0u; xst[1] = 0u; }
    __syncthreads();
    const XcdBarrier xb = xcd_barrier_post((unsigned*)(pp->ws + OFF_BAR), xst);
    char* hlds = lds + __builtin_amdgcn_readfirstlane((int)(threadIdx.x >> 8)) * HLDS;
    (void)ph_lo;
#pragma unroll
    for (int ph = 0; ph < 2 * NPH; ++ph) {
        asm volatile("" : "+s"(pp));
        CParams& p = *pp;
        const int l = ph / NPH, q = ph % NPH;
#pragma unroll 1
        for (int rep = 0; rep < 1 + (int)((PROBE_MASK >> q) & 1u); ++rep) {
            if (rep) xcd_barrier(xb);
            switch (q) {
                case 0: phase_w(p, l, hlds); break;
                case 1: phase_proj(p, l, lds); break;
                case 2: phase2(p, l, hlds); break;
                case 3: phase3(p, l, hlds); break;
                case 4: phase4(p, l, hlds); break;
                case 5: phase_glu(p, l, hlds); break;
                case 6: phase_branch(p, l, lds); break;
                case 7: phase_out(p, l, lds, hlds); break;
                case 8: phase_route(p, l, hlds); break;
                case 9: phase_moe1(p, l, lds); break;
                case 10: phase_moe2(p, l, lds); break;
                default: phase_combine(p, l); break;
            }
        }
        if (ph + 1 < 2 * NPH) {
            if (p.coop == 1) xcd_barrier(xb);
            else if (p.coop == 2) grid.sync();
        }
    }
}

extern "C" void kernel_launch(void* const* d_in, const int* in_sizes, int n_in, void* d_out, int out_size, void* d_ws, size_t ws_size,
                              hipStream_t stream) {
    static int grid_blocks = 0;
    if (!grid_blocks) {
        int dev = 0, cus = 0, per_cu = 0;
        (void)hipGetDevice(&dev);
        (void)hipDeviceGetAttribute(&cus, hipDeviceAttributeMultiprocessorCount, dev);
        (void)hipFuncSetAttribute((const void*)fwd_kernel, hipFuncAttributeMaxDynamicSharedMemorySize, LDS_BYTES);
        (void)hipOccupancyMaxActiveBlocksPerMultiprocessor(&per_cu, fwd_kernel, 512, LDS_BYTES);
        if (per_cu < 1) per_cu = 1;
        per_cu = 1;
        grid_blocks = cus * per_cu;
        if (ws_size < WS_NEED) fprintf(stderr, "kernel_launch: workspace too small: %zu < %zu\n", ws_size, (size_t)WS_NEED);
    }
    Params p{};
    for (int i = 0; i < 36; ++i) p.in[i] = (const float*)d_in[i];
    p.out = (float*)d_out;
    p.ws = (unsigned char*)d_ws;
    p.ph_lo = 0; p.ph_hi = 2 * NPH; p.coop = 1; p.pad = 0;
    (void)hipMemsetAsync((char*)d_ws + OFF_BAR, 0, XCD_BAR_WORDS * 4, stream);
    void* args[] = {&p};
    hipError_t e = hipLaunchCooperativeKernel((void*)fwd_kernel, dim3(grid_blocks), dim3(512), args, LDS_BYTES, stream);
    if (e != hipSuccess) fprintf(stderr, "cooperative launch failed: %s (grid %d)\n", hipGetErrorString(e), grid_blocks);
}
```

```cpp
#include <hip/hip_runtime.h>
#include <hip/hip_cooperative_groups.h>
#include <cstdio>
#include <cstdint>
namespace cg = cooperative_groups;

typedef unsigned short u16;
typedef __attribute__((ext_vector_type(8))) short bf16x8;
typedef __attribute__((ext_vector_type(4))) float f32x4;
typedef __attribute__((ext_vector_type(4))) unsigned u32x4;
#define LAS __attribute__((address_space(3)))

constexpr int NTOK = 16384, DM = 1024, SEQ = 4096, BW = 512, INC = 6656;
constexpr int NE = 64, EH = 256;
#ifndef PROBE_MASK
#define PROBE_MASK 0u
#endif
#define PROBE_TIMEK_ProjEpi false
#define PROBE_TIMEK_OutEpi false
#define PROBE_TIMEK_BrEpi false
#define PROBE_TIMEK_Moe1Epi false
#define PROBE_TIMEK_Moe2Epi false
#define PROBE_TIMEK_ShEpi false
#define PROBE_TQ -1
constexpr int NPH = 12;
constexpr float DN_ALPHA = 1.4142135623730951f;
constexpr size_t SLOT = 16777216ull;

constexpr size_t OFF_WINT  = 0;
constexpr size_t OFF_WBRT  = 13631488;
constexpr size_t OFF_WOUTT = 16777216;
constexpr size_t OFF_GLUT  = 18874368;
constexpr size_t OFF_RGT   = 19398656;
constexpr size_t OFF_SH13T = 19660800;
constexpr size_t OFF_SH2T  = 20709376;
constexpr size_t OFF_BTA   = 21233664;
constexpr size_t OFF_BTC   = 23330816;
constexpr size_t OFF_ROUTT = 29622272;
constexpr size_t OFF_MISC  = 29753344;
constexpr size_t OFF_LB    = OFF_MISC;
constexpr size_t OFF_CUR   = OFF_MISC + 2048;
constexpr size_t OFF_DEC   = OFF_MISC + 4096;
constexpr size_t OFF_SEGA  = OFF_DEC + 524288;
constexpr size_t OFF_SEGH  = OFF_SEGA + 524288;
constexpr size_t OFF_XB    = 2 * SLOT;
constexpr size_t OFF_VC    = 2 * SLOT;
constexpr size_t OFF_XC    = 3 * SLOT;
constexpr size_t OFF_MIXP  = 2 * SLOT;
constexpr size_t OFF_LIST  = 2 * SLOT;
constexpr size_t OFF_HSH   = 2 * SLOT + 4194304;
constexpr size_t OFF_WLIST = 2 * SLOT + 4194304 + 8388608;
constexpr size_t OFF_PQ    = 4 * SLOT;
constexpr size_t OFF_PLF   = 5 * SLOT;
constexpr size_t OFF_PK    = 7 * SLOT;
constexpr size_t OFF_PV    = 8 * SLOT;
constexpr size_t OFF_YC    = 8 * SLOT;
constexpr size_t OFF_PG    = 9 * SLOT;
constexpr size_t OFF_PU    = 10 * SLOT;
constexpr size_t OFF_PXG   = 11 * SLOT;
constexpr size_t OFF_PXR   = 12 * SLOT;
constexpr size_t OFF_YB    = 12 * SLOT;
constexpr size_t OFF_PGATE = 13 * SLOT;
constexpr size_t OFF_KTT   = 19 * SLOT;
constexpr size_t OFF_YA    = 19 * SLOT;
constexpr size_t OFF_VT    = 20 * SLOT;
constexpr size_t OFF_ST    = 21 * SLOT;
constexpr size_t OFF_LA    = 23 * SLOT;
constexpr size_t OFF_BB    = 24 * SLOT;
constexpr size_t OFF_YG    = 25 * SLOT;
constexpr size_t OFF_HC    = 26 * SLOT;
constexpr size_t OFF_UT    = 27 * SLOT;
constexpr size_t OFF_PRELN = 4 * SLOT;
constexpr size_t OFF_XM    = 8 * SLOT;
constexpr size_t OFF_EW13  = 10 * SLOT;
constexpr size_t OFF_EW2   = 14 * SLOT;
constexpr size_t OFF_HBUF  = 4 * SLOT;
constexpr size_t OFF_YBUF  = 16 * SLOT;
constexpr size_t OFF_BAR   = 32 * SLOT;
constexpr int HLDS = 73728;
constexpr int LDS_BYTES = 2 * HLDS + 64;
constexpr int L_XST = 2 * HLDS;
constexpr size_t WS_NEED   = 32 * SLOT + 16384;

struct Params {
    const float* in[36];
    float* out;
    unsigned char* ws;
    int ph_lo, ph_hi;
    int coop, pad;
};
typedef const __attribute__((address_space(4))) Params CParams;

__device__ __forceinline__ u16 f2bf(float f) {
    unsigned u = __builtin_bit_cast(unsigned, f);
    return (u16)((u + 0x7fffu + ((u >> 16) & 1u)) >> 16);
}
__device__ __forceinline__ float bf2f(u16 h) { return __builtin_bit_cast(float, (unsigned)h << 16); }
__device__ __forceinline__ float sigm(float x) { return __builtin_amdgcn_rcpf(1.f + __expf(-x)); }
__device__ __forceinline__ float silu_f(float x) { return x * sigm(x); }
__device__ __forceinline__ float gelu_f(float x) {
    float u = 0.7978845608028654f * (x + 0.044715f * x * x * x);
    float t = 1.f - 2.f * __builtin_amdgcn_rcpf(1.f + __expf(2.f * u));
    return 0.5f * x * (1.f + t);
}
__device__ __forceinline__ float shfl_xor_l(float v, int o, int lane) {
    return __builtin_bit_cast(float, __builtin_amdgcn_ds_bpermute((lane ^ o) << 2, __builtin_bit_cast(int, v)));
}
__device__ __forceinline__ float wave_sum(float v, int lane) {
#pragma unroll
    for (int o = 32; o >= 1; o >>= 1) v += shfl_xor_l(v, o, lane);
    return v;
}
__device__ __forceinline__ int swz(int row, int ch) { return row * 128 + ((ch ^ ((row >> 1) & 7)) << 4); }


template <class T> __device__ __forceinline__ T ldg(const void* base, unsigned off) { return *(const T*)((const char*)base + off); }
template <class T> __device__ __forceinline__ void stg(void* base, unsigned off, T v) { *(T*)((char*)base + off) = v; }
template <class T> __device__ __forceinline__ void stg_nt(void* base, unsigned off, T v) { __builtin_nontemporal_store(v, (T*)((char*)base + off)); }

template <int TM, int TN, int RW, int CW, class F>
__device__ __forceinline__ void epi(f32x4 (&acc)[TM][TN], int wr, int wc, int fq, int fr, F f) {
#pragma unroll
    for (int m = 0; m < TM; ++m) {
#pragma unroll
        for (int j = 0; j < 4; ++j) {
#pragma unroll
            for (int n = 0; n < TN; ++n) f(wr * RW + m * 16 + fq * 4 + j, wc * CW + n * 16 + fr, acc[m][n][j]);
        }
        __builtin_amdgcn_sched_barrier(0);
    }
}

__device__ __forceinline__ int otid() { int t = threadIdx.x & 255; asm volatile("" : "+v"(t)); return t; }
#define VB ((int)blockIdx.x * 2 + __builtin_amdgcn_readfirstlane((int)(threadIdx.x >> 8)))
#define VG ((int)gridDim.x * 2)

struct NoHook { __device__ __forceinline__ void operator()(int) const {} };

template <int BM, int BN, int WM, int WN, class AL, class BL, class HK>
__device__ __forceinline__ void mma_loop(f32x4 (&acc)[BM / WM / 16][BN / WN / 16], int nk, AL aload, BL bload, HK hook, char* lds) {
    constexpr int TM = BM / WM / 16, TN = BN / WN / 16;
    constexpr int ACH = BM / 32, BCH = BN / 32;
    const int tid = otid(), lane = tid & 63, wid = tid >> 6;
    const int wr = wid / WN, wc = wid % WN, fr = lane & 15, fq = lane >> 4;
    const int srow = tid >> 3, sk = (tid & 7) * 8;
    const int swr = srow * 128 + (((tid & 7) ^ ((tid >> 4) & 7)) << 4);
    const int xr = (fr >> 1) & 7;
    const int a_rd = (wr * (BM / WM) + fr) * 128;
    const int b_rd = BM * 128 + (wc * (BN / WN) + fr) * 128;
    bf16x8 ra[ACH], rb[BCH];
#pragma unroll
    for (int i = 0; i < ACH; ++i) ra[i] = aload(srow + i * 32, sk);
#pragma unroll
    for (int i = 0; i < BCH; ++i) rb[i] = bload(srow + i * 32, sk);
#pragma unroll 1
    for (int t = 0; t < nk; ++t) {
        __syncthreads();
#pragma unroll
        for (int i = 0; i < ACH; ++i) *(bf16x8*)(lds + swr + i * 4096) = ra[i];
#pragma unroll
        for (int i = 0; i < BCH; ++i) *(bf16x8*)(lds + BM * 128 + swr + i * 4096) = rb[i];
        __syncthreads();
        if (t + 1 < nk) {
#pragma unroll
            for (int i = 0; i < ACH; ++i) ra[i] = aload(srow + i * 32, (t + 1) * 64 + sk);
#pragma unroll
            for (int i = 0; i < BCH; ++i) rb[i] = bload(srow + i * 32, (t + 1) * 64 + sk);
        }
        hook(t);
#pragma unroll
        for (int ks = 0; ks < 2; ++ks) {
            const int co = ((ks * 4 + fq) ^ xr) << 4;
            bf16x8 af[TM], bfr[TN];
#pragma unroll
            for (int m = 0; m < TM; ++m) af[m] = *(const bf16x8*)(lds + a_rd + m * 2048 + co);
#pragma unroll
            for (int n = 0; n < TN; ++n) bfr[n] = *(const bf16x8*)(lds + b_rd + n * 2048 + co);
#pragma unroll
            for (int m = 0; m < TM; ++m)
#pragma unroll
                for (int n = 0; n < TN; ++n) acc[m][n] = __builtin_amdgcn_mfma_f32_16x16x32_bf16(af[m], bfr[n], acc[m][n], 0, 0, 0);
        }
    }
}

template <int BM, int BN, int WM, int WN, class AO, class BO, class HK>
__device__ __forceinline__ void mma_glds(f32x4 (&acc)[BM / WM / 16][BN / WN / 16], int nk, const unsigned char* ws, AO aoff, BO boff, HK hook, char* lds) {
    constexpr int TM = BM / WM / 16, TN = BN / WN / 16;
    constexpr int ACH = BM / 32, BCH = BN / 32, BUF = (BM + BN) * 128;
    const int tid = otid(), lane = tid & 63, wid = tid >> 6;
    const int wr = wid / WN, wc = wid % WN, fr = lane & 15, fq = lane >> 4;
    const int srow = tid >> 3;
    const unsigned csrc = (unsigned)(((tid & 7) ^ ((tid >> 4) & 7)) << 4);
    const int xr = (fr >> 1) & 7;
    const int a_rd = (wr * (BM / WM) + fr) * 128;
    const int b_rd = BM * 128 + (wc * (BN / WN) + fr) * 128;
    auto stage = [&](int buf, int t) {
        char* d = lds + buf * BUF + tid * 16;
#pragma unroll
        for (int i = 0; i < ACH; ++i)
            __builtin_amdgcn_global_load_lds((const unsigned*)(ws + (aoff(srow + i * 32, t) + csrc)), (unsigned*)(d + i * 4096), 16, 0, 0);
#pragma unroll
        for (int i = 0; i < BCH; ++i)
            __builtin_amdgcn_global_load_lds((const unsigned*)(ws + (boff(srow + i * 32, t) + csrc)), (unsigned*)(d + BM * 128 + i * 4096), 16, 0, 0);
    };
    __syncthreads();
    stage(0, 0);
#pragma unroll 1
    for (int t = 0; t < nk; ++t) {
        asm volatile("s_waitcnt vmcnt(0)" ::: "memory");
        __syncthreads();
        if (t + 1 < nk) stage((t + 1) & 1, t + 1);
        hook(t);
        const char* bb = lds + (t & 1) * BUF;
#pragma unroll
        for (int ks = 0; ks < 2; ++ks) {
            const int co = ((ks * 4 + fq) ^ xr) << 4;
            bf16x8 af[TM], bfr[TN];
#pragma unroll
            for (int m = 0; m < TM; ++m) af[m] = *(const bf16x8*)(bb + a_rd + m * 2048 + co);
#pragma unroll
            for (int n = 0; n < TN; ++n) bfr[n] = *(const bf16x8*)(bb + b_rd + n * 2048 + co);
#pragma unroll
            for (int m = 0; m < TM; ++m)
#pragma unroll
                for (int n = 0; n < TN; ++n) acc[m][n] = __builtin_amdgcn_mfma_f32_16x16x32_bf16(af[m], bfr[n], acc[m][n], 0, 0, 0);
        }
    }
}

#define ZERO_ACC(acc, TM, TN) _Pragma("unroll") for (int m_ = 0; m_ < TM; ++m_) _Pragma("unroll") for (int n_ = 0; n_ < TN; ++n_) acc[m_][n_] = f32x4{0.f, 0.f, 0.f, 0.f}

#define LANE_IDS const int tid = otid(), lane = tid & 63, wid = tid >> 6, fr = lane & 15, fq = lane >> 4; (void)tid; (void)lane; (void)wid; (void)fr; (void)fq

namespace g8 {
constexpr int BM = 256, BK = 64, HALF = 128, HTB = HALF * BK * 2, STAGE_BYTES = 8 * HTB;
__device__ __forceinline__ int lds_byte(int r, int c) { const int st = (r >> 4) * 2 + (c >> 5), rr = r & 15, cc = c & 31, ob = rr * 64 + cc * 2; return st * 1024 + (ob ^ (((ob >> 9) & 1) << 5)); }
__device__ __forceinline__ void stage_rc(int b, int& R, int& C) { const int st = b / 1024, sb = b % 1024, swz = sb ^ (((sb >> 9) & 1) << 5); R = (st >> 1) * 16 + swz / 64; C = (st & 1) * 32 + (swz % 64) / 2; }
__device__ __forceinline__ int perm32(int rho) { const int n = rho >> 4, i = rho & 15; return 8 * (i >> 2) + 4 * n + (i & 3); }
struct Unit { unsigned A, B; int pm, pn, x0, x1; };
__device__ __forceinline__ unsigned cvt_pk_bf16(float lo, float hi) { unsigned r; asm volatile("v_cvt_pk_bf16_f32 %0, %1, %2" : "=v"(r) : "v"(lo), "v"(hi)); return r; }

template <class Epi, class Sched, bool GATHER>
__device__ __forceinline__ void gemm_phase(LAS unsigned char* lds, const unsigned char* wsb, const int K, const Sched& S, const Epi& E) {
    int tid_ = threadIdx.x; asm volatile("" : "+v"(tid_));
    const int tid = tid_, wid = __builtin_amdgcn_readfirstlane(tid >> 6), lane = tid & 63, wr = wid >> 2, wc = wid & 3, fr = lane & 15, fq = lane >> 4;
    const int nt = K / BK;
    unsigned voffA[2], voffB[2];
#pragma unroll
    for (int i = 0; i < 2; ++i) { int R, C; stage_rc(tid * 16 + i * 8192, R, C); const int Rb = Epi::PERM ? ((R & ~31) + perm32(R & 31)) : R;
        voffA[i] = (unsigned)(R * K + C) * 2u; voffB[i] = (unsigned)(Rb * K + C) * 2u; }
    const unsigned kstep = (unsigned)(BK * 2);
    const unsigned hstep = (unsigned)(HALF * K * 2);
    const unsigned ldsw = (unsigned)wid * 1024u;
    const int aoff = lds_byte(wr * 64 + fr, fq * 8), boff = lds_byte(wc * 32 + fr, fq * 8);
#define G8_SA(b, h) (((b) * 2 + (h)) * HTB)
#define G8_SB(b, h) ((4 + (b) * 2 + (h)) * HTB)
#define G8_STAGE(bufoff, gbase, voff) do { _Pragma("unroll") for (int _i = 0; _i < 2; ++_i) \
        __builtin_amdgcn_global_load_lds((const unsigned*)(wsb + (unsigned)((gbase) + (voff)[_i])), (LAS unsigned*)(lds + (bufoff) + ldsw + _i * 8192), 16, 0, 0); } while (0)
#define G8_STAGE_A(bufoff, kp, h, vg) do { if (GATHER) G8_STAGE(bufoff, kp, vg[h]); else G8_STAGE(bufoff, (kp) + (h) * hstep, voffA); } while (0)
#define G8_LDA(dst, b, h) do { _Pragma("unroll") for (int m = 0; m < 4; ++m) _Pragma("unroll") for (int k = 0; k < 2; ++k) dst[m][k] = *(const LAS bf16x8*)(lds + G8_SA(b, h) + aoff + m * 2048 + k * 1024); } while (0)
#define G8_LDB(dst, b, h) do { _Pragma("unroll") for (int n = 0; n < 2; ++n) _Pragma("unroll") for (int k = 0; k < 2; ++k) dst[n][k] = *(const LAS bf16x8*)(lds + G8_SB(b, h) + boff + n * 2048 + k * 1024); } while (0)
#define G8_MMA(ai, bj, At, Bt) do { __builtin_amdgcn_s_setprio(1); _Pragma("unroll") for (int m = 0; m < 4; ++m) _Pragma("unroll") for (int n = 0; n < 2; ++n) _Pragma("unroll") for (int k = 0; k < 2; ++k) \
        acc[ai][bj][m][n] = __builtin_amdgcn_mfma_f32_16x16x32_bf16(Bt[n][k], At[m][k], acc[ai][bj][m][n], 0, 0, 0); __builtin_amdgcn_s_setprio(0); } while (0)
#define G8_WAIT_V(n) asm volatile("s_waitcnt vmcnt(" #n ")" ::: "memory")
#define G8_WAIT_L(n) asm volatile("s_waitcnt lgkmcnt(" #n ")" ::: "memory")
#define G8_BAR __builtin_amdgcn_s_barrier()
#define G8_SCHED __builtin_amdgcn_sched_barrier(0)
#define G8_GOFF(dst, u) do { _Pragma("unroll") for (int _i = 0; _i < 2; ++_i) { int _R, _C; stage_rc(tid * 16 + _i * 8192, _R, _C); \
        _Pragma("unroll") for (int _h = 0; _h < 2; ++_h) dst[_h][_i] = (unsigned)(S.row(u, _h * HALF + _R) * K + _C) * 2u; } \
        asm volatile("" : "+v"(dst[0][0]), "+v"(dst[0][1]), "+v"(dst[1][0]), "+v"(dst[1][1])); } while (0)
    Unit cur, nxt; int ui = 0;
    if (!S.next(0, cur)) return;
    f32x4 acc[2][2][4][2];
#pragma unroll
    for (int a = 0; a < 2; ++a)
#pragma unroll
        for (int b = 0; b < 2; ++b)
#pragma unroll
            for (int m = 0; m < 4; ++m)
#pragma unroll
                for (int n = 0; n < 2; ++n) acc[a][b][m][n] = (f32x4){0.f, 0.f, 0.f, 0.f};
    bf16x8 At[4][2], B0[2][2], B1[2][2];
    unsigned vgc[2][2] = {{0u, 0u}, {0u, 0u}};
    LAS u32x4* gslot = (LAS u32x4*)(lds + STAGE_BYTES + 4096) + tid;
    unsigned cA = cur.A, cB = cur.B;
    if (GATHER) { G8_GOFF(vgc, cur); }
    G8_STAGE(G8_SB(0, 0), cB, voffB); G8_STAGE_A(G8_SA(0, 0), cA, 0, vgc); G8_STAGE(G8_SB(0, 1), cB + hstep, voffB); G8_STAGE_A(G8_SA(0, 1), cA, 1, vgc);
    if (wr == 1) G8_BAR;
    G8_WAIT_V(4); G8_BAR;
    G8_STAGE(G8_SB(1, 0), cB + kstep, voffB); G8_STAGE_A(G8_SA(1, 0), cA + kstep, 0, vgc); G8_STAGE(G8_SB(1, 1), cB + hstep + kstep, voffB);
    G8_WAIT_V(6); G8_BAR;
    for (;;) {
        const bool has_next = S.next(ui + 1, nxt);
        const unsigned nA = has_next ? nxt.A : cA, nB = has_next ? nxt.B : cB;
        if (GATHER && has_next) {
            unsigned vt[2][2]; G8_GOFF(vt, nxt);
            *gslot = u32x4{vt[0][0], vt[0][1], vt[1][0], vt[1][1]};
        }
        unsigned long long tk0 = 0;
        if (Epi::TIMEK) tk0 = __builtin_amdgcn_s_memrealtime();
#pragma unroll 1
        for (int t = 0; t < nt; t += 2) {
            const bool last = (t == nt - 2);
            const unsigned a1 = cA + (unsigned)(t + 1) * kstep;
            const unsigned a2 = last ? nA : cA + (unsigned)(t + 2) * kstep, b2 = last ? nB : cB + (unsigned)(t + 2) * kstep;
            const unsigned a3 = a2 + kstep, b3 = b2 + kstep;
            G8_LDB(B0, 0, 0); G8_SCHED; G8_LDA(At, 0, 0); G8_STAGE_A(G8_SA(1, 1), a1, 1, vgc);
            G8_WAIT_L(8); G8_BAR; G8_WAIT_L(0); G8_MMA(0, 0, At, B0); G8_BAR; G8_SCHED;
            G8_LDB(B1, 0, 1);
            if (GATHER && last && has_next) { const u32x4 x = *gslot; vgc[0][0] = x[0]; vgc[0][1] = x[1]; vgc[1][0] = x[2]; vgc[1][1] = x[3]; }
            G8_STAGE(G8_SB(0, 0), b2, voffB);
            G8_BAR; G8_WAIT_L(0); G8_MMA(0, 1, At, B1); G8_BAR;
            G8_LDA(At, 0, 1); G8_STAGE_A(G8_SA(0, 0), a2, 0, vgc);
            G8_BAR; G8_WAIT_L(0); G8_MMA(1, 0, At, B0); G8_BAR; G8_SCHED;
            G8_STAGE(G8_SB(0, 1), b2 + hstep, voffB);
            G8_WAIT_V(6); G8_BAR; G8_MMA(1, 1, At, B1); G8_BAR;
            G8_LDB(B0, 1, 0); G8_SCHED; G8_LDA(At, 1, 0); G8_STAGE_A(G8_SA(0, 1), a2, 1, vgc);
            G8_WAIT_L(8); G8_BAR; G8_WAIT_L(0); G8_MMA(0, 0, At, B0); G8_BAR; G8_SCHED;
            G8_LDB(B1, 1, 1); G8_STAGE(G8_SB(1, 0), b3, voffB);
            G8_BAR; G8_WAIT_L(0); G8_MMA(0, 1, At, B1); G8_BAR;
            G8_LDA(At, 1, 1); G8_STAGE_A(G8_SA(1, 0), a3, 0, vgc);
            G8_BAR; G8_WAIT_L(0); G8_MMA(1, 0, At, B0); G8_BAR; G8_SCHED;
            G8_STAGE(G8_SB(1, 1), b3 + hstep, voffB);
            G8_WAIT_V(6); G8_BAR; G8_MMA(1, 1, At, B1); G8_BAR;
        }
        if (Epi::TIMEK && tid == 0) { const unsigned dt = (unsigned)(__builtin_amdgcn_s_memrealtime() - tk0); *(LAS unsigned*)(lds + 147456 + 32) += dt; }
        const bool keep = E(acc, cur, wr, wc, fr, fq);
        if (!has_next) break;
        if (!keep) {
#pragma unroll
        for (int a = 0; a < 2; ++a)
#pragma unroll
            for (int b = 0; b < 2; ++b)
#pragma unroll
                for (int m = 0; m < 4; ++m)
#pragma unroll
                    for (int n = 0; n < 2; ++n) acc[a][b][m][n] = (f32x4){0.f, 0.f, 0.f, 0.f};
        }
        cur = nxt; cA = nA; cB = nB; ++ui;
    }
    G8_WAIT_V(0);
    if (wr == 0) G8_BAR;
    G8_BAR;
#undef G8_SA
#undef G8_SB
#undef G8_STAGE
#undef G8_STAGE_A
#undef G8_LDA
#undef G8_LDB
#undef G8_MMA
#undef G8_WAIT_V
#undef G8_WAIT_L
#undef G8_BAR
#undef G8_SCHED
#undef G8_GOFF
}
}

__device__ __forceinline__ u32x4 pack8v(const f32x4& a, const f32x4& b) {
    u32x4 w; w[0] = g8::cvt_pk_bf16(a[0], a[1]); w[1] = g8::cvt_pk_bf16(a[2], a[3]); w[2] = g8::cvt_pk_bf16(b[0], b[1]); w[3] = g8::cvt_pk_bf16(b[2], b[3]); return w;
}
__device__ __forceinline__ uint4 pack8(const f32x4& a, const f32x4& b) {
    uint4 w; w.x = g8::cvt_pk_bf16(a[0], a[1]); w.y = g8::cvt_pk_bf16(a[2], a[3]); w.z = g8::cvt_pk_bf16(b[0], b[1]); w.w = g8::cvt_pk_bf16(b[2], b[3]); return w;
}

struct ProjSched {
    unsigned A, B; int c, G;
    __device__ __forceinline__ bool next(int i, g8::Unit& u) const {
        const int L = i * G + c; if (L >= 64 * 26) return false;
        const int xcd = L & 7, jx = L >> 3;
        u.pm = xcd * 8 + (jx & 7); u.pn = jx >> 3;
        u.A = A + (unsigned)u.pm * 256 * DM * 2; u.B = B + (unsigned)u.pn * 256 * DM * 2; u.x0 = 0; u.x1 = 0; return true;
    }
    __device__ __forceinline__ int row(const g8::Unit&, int) const { return 0; }
};
struct ProjEpi {
    static constexpr bool TIMEK = PROBE_TIMEK_ProjEpi;
    static constexpr bool PERM = true;
    unsigned char* ws; const float* bg;
    __device__ __forceinline__ bool operator()(f32x4 (&acc)[2][2][4][2], const g8::Unit& u, int wr, int wc, int fr, int fq) const {
        const int seg = (u.pn * 256) >> 9;
        f32x4 cc[2][2];
#pragma unroll
        for (int bj = 0; bj < 2; ++bj) {
            const int col = u.pn * 256 + bj * 128 + wc * 32 + fq * 8;
            if (seg == 1) { cc[bj][0] = ldg<f32x4>(ws, (unsigned)(OFF_LB + (col & 511) * 4)); cc[bj][1] = ldg<f32x4>(ws, (unsigned)(OFF_LB + (col & 511) * 4 + 16)); }
            else if (seg >= 7) { cc[bj][0] = *(const f32x4*)(bg + col - 3584); cc[bj][1] = *(const f32x4*)(bg + col - 3584 + 4); }
            else { cc[bj][0] = f32x4{0.f, 0.f, 0.f, 0.f}; cc[bj][1] = cc[bj][0]; }
        }
#pragma unroll
        for (int ai = 0; ai < 2; ++ai)
#pragma unroll
            for (int m = 0; m < 4; ++m) {
                const int row = u.pm * 256 + ai * 128 + wr * 64 + m * 16 + fr;
#pragma unroll
                for (int bj = 0; bj < 2; ++bj) {
                    const int col = u.pn * 256 + bj * 128 + wc * 32 + fq * 8;
                    const int c = col & 511;
                    f32x4 v0 = acc[ai][bj][m][0], v1 = acc[ai][bj][m][1];
                    if (seg == 0 || seg == 3) {
#pragma unroll
                        for (int i = 0; i < 4; ++i) { v0[i] = silu_f(v0[i]); v1[i] = silu_f(v1[i]); }
                        stg<uint4>(ws, (unsigned)((seg == 0 ? OFF_PQ : OFF_PG) + (row * 512 + c) * 2), pack8(v0, v1));
                    } else if (seg == 1) {
                        const f32x4 l0 = cc[bj][0], l1 = cc[bj][1];
                        f32x4 g0, g1, k0, k1;
#pragma unroll
                        for (int i = 0; i < 4; ++i) {
                            const float s0 = sigm(v0[i]), s1 = sigm(v1[i]);
                            g0[i] = __logf(l0[i] + (1.f - l0[i]) * s0); g1[i] = __logf(l1[i] + (1.f - l1[i]) * s1);
                            k0[i] = (1.f - l0[i]) * (1.f - s0); k1[i] = (1.f - l1[i]) * (1.f - s1);
                        }
                        stg<f32x4>(ws, (unsigned)(OFF_PLF + (row * 512 + c) * 4), g0);
                        stg<f32x4>(ws, (unsigned)(OFF_PLF + (row * 512 + c) * 4 + 16), g1);
                        stg<uint4>(ws, (unsigned)(OFF_PK + (row * 512 + c) * 2), pack8(k0, k1));
                    } else if (seg == 2 || seg == 6) {
                        stg<uint4>(ws, (unsigned)((seg == 2 ? OFF_PV : OFF_PXR) + (row * 512 + c) * 2), pack8(v0, v1));
                    } else if (seg == 4) {
                        stg<uint4>(ws, (unsigned)(OFF_PU + (((c >> 4) * NTOK + row) * 16 + (c & 15)) * 2), pack8(v0, v1));
                    } else if (seg == 5) {
#pragma unroll
                        for (int i = 0; i < 4; ++i) { v0[i] = gelu_f(v0[i]); v1[i] = gelu_f(v1[i]); }
                        stg<uint4>(ws, (unsigned)(OFF_PXG + (row * 512 + c) * 2), pack8(v0, v1));
                    } else {
                        const int gc = col - 3584;
#pragma unroll
                        for (int i = 0; i < 4; ++i) { v0[i] = sigm(v0[i] + cc[bj][0][i]); v1[i] = sigm(v1[i] + cc[bj][1][i]); }
                        stg<uint4>(ws, (unsigned)(OFF_PGATE + (row * 3072 + gc) * 2), pack8(v0, v1));
                    }
                }
            }
        return false;
    }
};
__device__ void phase_proj(CParams& p, int l, char* lds) {
    ProjSched S; S.A = (unsigned)OFF_XB; S.B = (unsigned)OFF_WINT; S.c = blockIdx.x; S.G = gridDim.x;
    ProjEpi E; E.ws = p.ws; E.bg = p.in[2] + (size_t)l * 3072;
    g8::gemm_phase<ProjEpi, ProjSched, false>((LAS unsigned char*)lds, p.ws, 1024, S, E);
}

struct OutSched {
    unsigned A, B; int c, G;
    __device__ __forceinline__ bool next(int i, g8::Unit& u) const {
        const int L = i * G + c; if (L >= 64 * 4) return false;
        const int xcd = L & 7, jx = L >> 3;
        u.pm = xcd * 8 + (jx & 7); u.pn = jx >> 3;
        u.A = A + (unsigned)u.pm * 256 * 1024 * 2; u.B = B + (unsigned)u.pn * 256 * 1024 * 2; u.x0 = 0; u.x1 = 0; return true;
    }
    __device__ __forceinline__ int row(const g8::Unit&, int) const { return 0; }
};
struct OutEpi {
    static constexpr bool TIMEK = PROBE_TIMEK_OutEpi;
    static constexpr bool PERM = false;
    unsigned char* ws; const float* xres;
    __device__ __forceinline__ bool operator()(f32x4 (&acc)[2][2][4][2], const g8::Unit& u, int wr, int wc, int fr, int fq) const {
#pragma unroll
        for (int ai = 0; ai < 2; ++ai) {
            f32x4 x[4][2][2];
#pragma unroll
            for (int m = 0; m < 4; ++m)
#pragma unroll
                for (int bj = 0; bj < 2; ++bj)
#pragma unroll
                    for (int n = 0; n < 2; ++n) {
                        const int row = u.pm * 256 + ai * 128 + wr * 64 + m * 16 + fr, col = u.pn * 256 + bj * 128 + wc * 32 + n * 16 + fq * 4;
                        x[m][bj][n] = ldg<f32x4>(xres, (unsigned)((row * 1024 + col) * 4));
                    }
#pragma unroll
            for (int m = 0; m < 4; ++m)
#pragma unroll
                for (int bj = 0; bj < 2; ++bj)
#pragma unroll
                    for (int n = 0; n < 2; ++n) {
                        const int row = u.pm * 256 + ai * 128 + wr * 64 + m * 16 + fr, col = u.pn * 256 + bj * 128 + wc * 32 + n * 16 + fq * 4;
                        stg<f32x4>(ws, (unsigned)OFF_PRELN + (unsigned)((row * 1024 + col) * 4), x[m][bj][n] * DN_ALPHA + acc[ai][bj][m][n]);
                    }
        }
        return false;
    }
};

struct BrSched {
    int c;
    __device__ __forceinline__ bool next(int i, g8::Unit& u) const {
        if (i >= 3) return false;
        const int xcd = c & 7, jx = c >> 3;
        u.pm = xcd * 8 + (jx & 7); u.pn = jx >> 3; u.x0 = i; u.x1 = 0;
        u.A = (unsigned)(i == 0 ? OFF_YA : (i == 1 ? OFF_YB : OFF_YC)) + (unsigned)u.pm * 256 * 512 * 2;
        u.B = (unsigned)OFF_WBRT + (unsigned)i * 1024 * 512 * 2 + (unsigned)u.pn * 256 * 512 * 2;
        return true;
    }
    __device__ __forceinline__ int row(const g8::Unit&, int) const { return 0; }
};
struct BrEpi {
    static constexpr bool TIMEK = PROBE_TIMEK_BrEpi;
    static constexpr bool PERM = true;
    unsigned char* ws;
    __device__ __forceinline__ bool operator()(f32x4 (&acc)[2][2][4][2], const g8::Unit& u, int wr, int wc, int fr, int fq) const {
        const int k = u.x0;
#pragma unroll
        for (int ai = 0; ai < 2; ++ai) {
            uint4 gq[4][2], gn[4][2];
#pragma unroll
            for (int m = 0; m < 4; ++m)
#pragma unroll
                for (int bj = 0; bj < 2; ++bj) {
                    const int row = u.pm * 256 + ai * 128 + wr * 64 + m * 16 + fr, col = u.pn * 256 + bj * 128 + wc * 32 + fq * 8;
                    const unsigned go = (unsigned)(OFF_PGATE + (row * 3072 + k * 1024 + col) * 2);
                    gq[m][bj] = ldg<uint4>(ws, go);
                    gn[m][bj] = (k < 2) ? ldg<uint4>(ws, go + 2048) : uint4{0x3f803f80u, 0x3f803f80u, 0x3f803f80u, 0x3f803f80u};
                }
#pragma unroll
            for (int m = 0; m < 4; ++m)
#pragma unroll
                for (int bj = 0; bj < 2; ++bj) {
                    const int row = u.pm * 256 + ai * 128 + wr * 64 + m * 16 + fr, col = u.pn * 256 + bj * 128 + wc * 32 + fq * 8;
                    const uint4 q = gq[m][bj], nx = gn[m][bj];
                    float s[8] = {bf2f((u16)(q.x & 0xffff)), bf2f((u16)(q.x >> 16)), bf2f((u16)(q.y & 0xffff)), bf2f((u16)(q.y >> 16)),
                                  bf2f((u16)(q.z & 0xffff)), bf2f((u16)(q.z >> 16)), bf2f((u16)(q.w & 0xffff)), bf2f((u16)(q.w >> 16))};
                    s[0] *= __builtin_amdgcn_rcpf(bf2f((u16)(nx.x & 0xffff))); s[1] *= __builtin_amdgcn_rcpf(bf2f((u16)(nx.x >> 16)));
                    s[2] *= __builtin_amdgcn_rcpf(bf2f((u16)(nx.y & 0xffff))); s[3] *= __builtin_amdgcn_rcpf(bf2f((u16)(nx.y >> 16)));
                    s[4] *= __builtin_amdgcn_rcpf(bf2f((u16)(nx.z & 0xffff))); s[5] *= __builtin_amdgcn_rcpf(bf2f((u16)(nx.z >> 16)));
                    s[6] *= __builtin_amdgcn_rcpf(bf2f((u16)(nx.w & 0xffff))); s[7] *= __builtin_amdgcn_rcpf(bf2f((u16)(nx.w >> 16)));
#pragma unroll
                    for (int i = 0; i < 4; ++i) { acc[ai][bj][m][0][i] *= s[i]; acc[ai][bj][m][1][i] *= s[4 + i]; }
                    if (k == 2) stg<uint4>(ws, (unsigned)(OFF_MIXP + (row * 1024 + col) * 2), pack8(acc[ai][bj][m][0], acc[ai][bj][m][1]));
                }
        }
        return k < 2;
    }
};

struct MoeSched {
    const int* sm; const unsigned char* ws; unsigned A, Bexp, Bsh, Ash;
    int c, G, npn, K, bstride_e, gather, nsh;
    __device__ __forceinline__ bool next(int i, g8::Unit& u) const {
        int nbr = __builtin_amdgcn_readfirstlane(sm[64]); asm volatile("" : "+s"(nbr));
        const int L = i * G + c; if (L >= (nbr + nsh) * npn) return false;
        const int blk = L / npn; u.pn = L - blk * npn;
        if (blk >= nbr) {
            u.x0 = 64; u.pm = blk - nbr; u.x1 = NTOK;
            u.A = gather ? A : Ash + (unsigned)u.pm * 256 * K * 2;
            u.B = Bsh + (unsigned)u.pn * 256 * K * 2;
        } else {
            int e = __builtin_amdgcn_readfirstlane(sm[256 + blk]);
            int be = __builtin_amdgcn_readfirstlane(sm[e]), re = __builtin_amdgcn_readfirstlane(sm[65 + e]), ce = __builtin_amdgcn_readfirstlane(sm[130 + e]);
            asm volatile("" : "+s"(e), "+s"(be), "+s"(re), "+s"(ce));
            u.x0 = e; u.pm = blk - be; u.x1 = ce;
            u.A = gather ? A : A + (unsigned)(re + u.pm * 256) * K * 2;
            u.B = Bexp + (unsigned)e * bstride_e + (unsigned)u.pn * 256 * K * 2;
        }
        return true;
    }
    __device__ __forceinline__ int row(const g8::Unit& u, int r) const {
        const int rr = u.pm * 256 + r;
        if (u.x0 == 64) return rr;
        return (rr < u.x1) ? (ldg<int>(ws, (unsigned)(OFF_LIST + (u.x0 * NTOK + rr) * 4)) >> 3) : 0;
    }
};
__device__ __forceinline__ void moe_setup(CParams& p, int* sm) {
    __syncthreads();
    if (threadIdx.x == 0) {
        const int* cursor = (const int*)(p.ws + OFF_CUR);
        int nb = 0, nr = 0;
        for (int e = 0; e < 64; ++e) { sm[e] = nb; sm[65 + e] = nr; int c = cursor[e]; sm[130 + e] = c; nb += (c + 255) >> 8; nr += c; }
        sm[64] = nb; sm[129] = nr;
    }
    __syncthreads();
    if (threadIdx.x < 64) { const int e = threadIdx.x; for (int k = sm[e]; k < sm[e + 1]; ++k) sm[256 + k] = e; }
    __syncthreads();
}
struct Moe1Epi {
    static constexpr bool TIMEK = PROBE_TIMEK_Moe1Epi;
    static constexpr bool PERM = false;
    unsigned char* ws; const int* sm;
    __device__ __forceinline__ bool operator()(f32x4 (&acc)[2][2][4][2], const g8::Unit& u, int wr, int wc, int fr, int fq) const {
        const int rbase = (u.x0 == 64) ? 0 : __builtin_amdgcn_readfirstlane(sm[65 + (u.x0 & 63)]);
        const unsigned hoff = (unsigned)((u.x0 == 64) ? OFF_HSH + (size_t)u.pm * 256 * 256 * 2 : OFF_HBUF + (size_t)(rbase + u.pm * 256) * 256 * 2);
        const int valid = u.x1 - u.pm * 256;
        float rw[2][4];
        const unsigned wb = (unsigned)(OFF_WLIST + ((u.x0 & 63) * NTOK + u.pm * 256 + wr * 64 + fr) * 4);
#pragma unroll
        for (int ai = 0; ai < 2; ++ai)
#pragma unroll
            for (int m = 0; m < 4; ++m) {
                const int r = ai * 128 + wr * 64 + m * 16 + fr;
                rw[ai][m] = (u.x0 != 64 && r < valid) ? ldg<float>(ws, wb + (unsigned)((ai * 128 + m * 16) * 4)) : 1.f;
            }
#pragma unroll
        for (int ai = 0; ai < 2; ++ai)
#pragma unroll
            for (int m = 0; m < 4; ++m) {
                const int r = ai * 128 + wr * 64 + m * 16 + fr;
                const float w = rw[ai][m];
#pragma unroll
                for (int bj = 0; bj < 2; ++bj) {
                    const int hid = ((u.pn * 256 + bj * 128 + wc * 32) >> 1) + fq * 4;
                    const f32x4 a = acc[ai][bj][m][0], b = acc[ai][bj][m][1] * w;
                    uint2 pk;
                    pk.x = g8::cvt_pk_bf16(silu_f(a[0]) * b[0], silu_f(a[1]) * b[1]);
                    pk.y = g8::cvt_pk_bf16(silu_f(a[2]) * b[2], silu_f(a[3]) * b[3]);
                    if (r < valid) stg<uint2>(ws, hoff + (unsigned)(r * 256 + hid) * 2u, pk);
                }
                __builtin_amdgcn_sched_barrier(0);
            }
        return false;
    }
};
__device__ void phase_moe1(CParams& p, int l, char* lds) {
    int* sm = (int*)(lds + g8::STAGE_BYTES);
    moe_setup(p, sm);
    MoeSched S; S.sm = sm; S.ws = p.ws;
    S.A = (unsigned)OFF_XM; S.Ash = S.A; S.Bexp = (unsigned)OFF_EW13; S.Bsh = (unsigned)OFF_SH13T;
    S.c = (blockIdx.x & 7) * 32 + (blockIdx.x >> 3); S.G = gridDim.x; S.npn = 2; S.K = 1024; S.bstride_e = 512 * 1024 * 2; S.gather = 1; S.nsh = 64;
    Moe1Epi E; E.ws = p.ws; E.sm = sm;
    g8::gemm_phase<Moe1Epi, MoeSched, true>((LAS unsigned char*)lds, p.ws, 1024, S, E);
}
struct Moe2Epi {
    static constexpr bool TIMEK = PROBE_TIMEK_Moe2Epi;
    static constexpr bool PERM = true;
    unsigned char* ws;
    __device__ __forceinline__ bool operator()(f32x4 (&acc)[2][2][4][2], const g8::Unit& u, int wr, int wc, int fr, int fq) const {
        const int valid = u.x1 - u.pm * 256;
        const int colb = u.pn * 256 + wc * 32 + fq * 8;
        const unsigned lbase = (unsigned)(OFF_LIST + (u.x0 * NTOK + u.pm * 256 + wr * 64 + fr) * 4);
        int ent[2][4];
#pragma unroll
        for (int ai = 0; ai < 2; ++ai)
#pragma unroll
            for (int m = 0; m < 4; ++m) {
                const int r = ai * 128 + wr * 64 + m * 16 + fr;
                ent[ai][m] = (r < valid) ? ldg<int>(ws, lbase + (unsigned)((ai * 128 + m * 16) * 4)) : 0;
            }
#pragma unroll
        for (int ai = 0; ai < 2; ++ai)
#pragma unroll
            for (int m = 0; m < 4; ++m) {
                const int r = ai * 128 + wr * 64 + m * 16 + fr;
                if (r < valid) {
                    const unsigned o = (unsigned)OFF_YBUF + (unsigned)(ent[ai][m] * 1024 + colb);
#pragma unroll
                    for (int bj = 0; bj < 2; ++bj) {
                        const f32x4 a = acc[ai][bj][m][0] * 32.f, b = acc[ai][bj][m][1] * 32.f;
                        int w0 = __builtin_amdgcn_cvt_pk_fp8_f32(a[0], a[1], 0, false); w0 = __builtin_amdgcn_cvt_pk_fp8_f32(a[2], a[3], w0, true);
                        int w1 = __builtin_amdgcn_cvt_pk_fp8_f32(b[0], b[1], 0, false); w1 = __builtin_amdgcn_cvt_pk_fp8_f32(b[2], b[3], w1, true);
                        stg<uint2>(ws, o + bj * 128, uint2{(unsigned)w0, (unsigned)w1});
                    }
                }
                __builtin_amdgcn_sched_barrier(0);
            }
        return false;
    }
};
struct ShSched {
    int c, G;
    __device__ __forceinline__ bool next(int i, g8::Unit& u) const {
        const int L = i * G + c; if (L >= 64 * 4) return false;
        u.pm = L >> 2; u.pn = L & 3; u.A = (unsigned)OFF_HSH + (unsigned)u.pm * 256 * 256 * 2; u.B = (unsigned)OFF_SH2T + (unsigned)u.pn * 256 * 256 * 2; u.x0 = 64; u.x1 = NTOK; return true;
    }
    __device__ __forceinline__ int row(const g8::Unit&, int) const { return 0; }
};
struct ShEpi {
    static constexpr bool TIMEK = PROBE_TIMEK_ShEpi;
    static constexpr bool PERM = false;
    float* ysh;
    __device__ __forceinline__ bool operator()(f32x4 (&acc)[2][2][4][2], const g8::Unit& u, int wr, int wc, int fr, int fq) const {
#pragma unroll
        for (int ai = 0; ai < 2; ++ai)
#pragma unroll
            for (int m = 0; m < 4; ++m) {
                const int row = u.pm * 256 + ai * 128 + wr * 64 + m * 16 + fr;
#pragma unroll
                for (int bj = 0; bj < 2; ++bj)
#pragma unroll
                    for (int n = 0; n < 2; ++n)
                        stg<f32x4>(ysh, (unsigned)((row * 1024 + u.pn * 256 + bj * 128 + wc * 32 + n * 16 + fq * 4) * 4), acc[ai][bj][m][n]);
                __builtin_amdgcn_sched_barrier(0);
            }
        return false;
    }
};
__device__ void phase_moe2(CParams& p, int l, char* lds) {
    int* sm = (int*)(lds + g8::STAGE_BYTES);
    moe_setup(p, sm);
    MoeSched S; S.sm = sm; S.ws = p.ws;
    S.A = (unsigned)OFF_HBUF; S.Ash = (unsigned)OFF_HSH; S.Bexp = (unsigned)OFF_EW2; S.Bsh = (unsigned)OFF_SH2T;
    S.c = (blockIdx.x & 7) * 32 + (blockIdx.x >> 3); S.G = gridDim.x; S.npn = 4; S.K = 256; S.bstride_e = 1024 * 256 * 2; S.gather = 0; S.nsh = 0;
    Moe2Epi E; E.ws = p.ws;
    g8::gemm_phase<Moe2Epi, MoeSched, false>((LAS unsigned char*)lds, p.ws, 256, S, E);
    ShSched S2; S2.c = (blockIdx.x & 7) * 32 + (blockIdx.x >> 3); S2.G = gridDim.x;
    ShEpi E2; E2.ysh = p.out;
    g8::gemm_phase<ShEpi, ShSched, false>((LAS unsigned char*)lds, p.ws, 256, S2, E2);
}

__device__ void conv_tile(const float* s1, const float* s2, int ldsrc, int K, int perm, u16* dst, int tile, float* lds) {
    const int tid = otid();
    const int ktiles = K >> 6;
    const int kt = tile % ktiles, nt = tile / ktiles;
    __syncthreads();
#pragma unroll 4
    for (int i = 0; i < 16; ++i) {
        int idx = tid + i * 256, kr = idx >> 6, nc = idx & 63;
        const float* s; int col;
        if (perm == 32) { s = (nc < 32) ? s1 : s2; col = nt * 32 + (nc & 31); }
        else if (perm == 16) { s = ((nc & 31) < 16) ? s1 : s2; col = (nt * 2 + (nc >> 5)) * 16 + (nc & 15); }
        else { s = s1; col = nt * 64 + nc; }
        lds[kr * 65 + nc] = s[(size_t)(kt * 64 + kr) * ldsrc + col];
    }
    __syncthreads();
#pragma unroll 4
    for (int i = 0; i < 16; ++i) {
        int idx = tid + i * 256, nr = idx >> 6, kc = idx & 63;
        dst[(size_t)(nt * 64 + nr) * K + kt * 64 + kc] = f2bf(lds[kc * 65 + nr]);
    }
}

__device__ void s5_precompute(CParams& p, int l, int g, int part, float* lds) {
    const int tid = otid();
    float* Er = lds;
    float* Ei = Er + 64 * 17;
    float* Br = Ei + 64 * 17;
    float* Bi = Br + 1024;
    float* Cr = Bi + 1024;
    float* Ci = Cr + 1024;
    float* Kt = Ci + 1024;
    __syncthreads();
    const int lg = l * 32 + g;
    const float dt = expf(p.in[12][lg]);
    {
        const int pp = tid & 63, part = tid >> 6;
        const float ar = p.in[5][lg * 64 + pp], ai = p.in[6][lg * 64 + pp];
        for (int tau = part; tau <= 16; tau += 4) {
            float mag = expf((float)tau * ar * dt);
            float ang = (float)tau * ai * dt;
            Er[pp * 17 + tau] = mag * cosf(ang);
            Ei[pp * 17 + tau] = mag * sinf(ang);
        }
        float mag = expf(ar * dt), ang = ai * dt;
        float e1r = mag * cosf(ang) - 1.f, e1i = mag * sinf(ang);
        float den = ar * ar + ai * ai;
        float qr = (e1r * ar + e1i * ai) / den, qi = (e1i * ar - e1r * ai) / den;
        for (int c = part * 4; c < part * 4 + 4; ++c) {
            float br = p.in[7][((size_t)lg * 64 + pp) * 16 + c], bi = p.in[8][((size_t)lg * 64 + pp) * 16 + c];
            Br[pp * 16 + c] = qr * br - qi * bi;
            Bi[pp * 16 + c] = qr * bi + qi * br;
            Cr[c * 64 + pp] = p.in[9][((size_t)lg * 16 + c) * 64 + pp];
            Ci[c * 64 + pp] = p.in[10][((size_t)lg * 16 + c) * 64 + pp];
        }
    }
    __syncthreads();
    for (int i = 0; i < 16; ++i) {
        int idx = tid + i * 256, tau = idx >> 8, ch = (idx >> 4) & 15, c2 = idx & 15;
        float s = 0.f;
        for (int pp = 0; pp < 64; ++pp) {
            float cr = Cr[ch * 64 + pp], ci = Ci[ch * 64 + pp], er = Er[pp * 17 + tau], ei = Ei[pp * 17 + tau];
            float gr = cr * er - ci * ei, gi = cr * ei + ci * er;
            s += gr * Br[pp * 16 + c2] - gi * Bi[pp * 16 + c2];
        }
        Kt[idx] = s;
    }
    __syncthreads();
    u16* bta = (u16*)(p.ws + OFF_BTA) + (size_t)g * 128 * 256;
    for (int i = part * 16; i < part * 16 + 16; ++i) {
        int idx = tid + i * 256, pr = idx >> 8, k = idx & 255, s = k >> 4, ch = k & 15, pp = pr & 63;
        float er = Er[pp * 17 + 15 - s], ei = Ei[pp * 17 + 15 - s], br = Br[pp * 16 + ch], bi = Bi[pp * 16 + ch];
        float v = (pr < 64) ? (er * br - ei * bi) : (er * bi + ei * br);
        bta[idx] = f2bf(v);
    }
    u16* btc = (u16*)(p.ws + OFF_BTC) + (size_t)g * 256 * 384;
    for (int i = part * 48; i < part * 48 + 48; ++i) {
        int idx = tid + i * 256, n = idx / 384, k = idx - n * 384, j = n >> 4, ch = n & 15;
        float v;
        if (k < 256) {
            int s = k >> 4, c2 = k & 15;
            v = (s <= j) ? Kt[((j - s) * 16 + ch) * 16 + c2] : 0.f;
        } else {
            int pr = k - 256, pp = pr & 63;
            float cr = Cr[ch * 64 + pp], ci = Ci[ch * 64 + pp], er = Er[pp * 17 + j + 1], ei = Ei[pp * 17 + j + 1];
            float gr = cr * er - ci * ei, gi = cr * ei + ci * er;
            v = (pr < 64) ? gr : -gi;
        }
        btc[idx] = f2bf(v);
    }
}

constexpr int W_CONV_TILES = 2608;
__device__ void phase_w(CParams& p, int l, char* lds) {
    const int tid = otid();
    const int nunits = W_CONV_TILES + 256 + 2 + (l == 0 ? 1024 : 0);
    for (int u = VB; u < nunits; u += VG) {
        if (u < W_CONV_TILES) {
            int t = u;
            const float *s1, *s2 = nullptr; int ld, K, perm = 0; u16* dst;
            if (t < 1664) { s1 = p.in[1] + (size_t)l * DM * INC; ld = INC; K = 1024; dst = (u16*)(p.ws + OFF_WINT); }
            else if ((t -= 1664) < 384) { int k = t >> 7; t &= 127; s1 = p.in[22] + (size_t)(l * 3 + k) * 512 * 1024; ld = 1024; K = 512; dst = (u16*)(p.ws + OFF_WBRT) + (size_t)k * 1024 * 512; }
            else if ((t -= 384) < 256) { s1 = p.in[23] + (size_t)l * 1024 * 1024; ld = 1024; K = 1024; dst = (u16*)(p.ws + OFF_WOUTT); }
            else if ((t -= 256) < 64) { s1 = p.in[13] + (size_t)l * 512 * 512; ld = 512; K = 512; dst = (u16*)(p.ws + OFF_GLUT); }
            else if ((t -= 64) < 32) { int h = t >> 3; t &= 7; s1 = p.in[17] + (size_t)(l * 4 + h) * 128 * 128; s2 = p.in[19] + (size_t)(l * 4 + h) * 128 * 128; ld = 128; K = 128; perm = 32; dst = (u16*)(p.ws + OFF_RGT) + (size_t)h * 256 * 128; }
            else if ((t -= 32) < 128) { s1 = p.in[31] + (size_t)l * 1024 * 256; s2 = p.in[32] + (size_t)l * 1024 * 256; ld = 256; K = 1024; perm = 16; dst = (u16*)(p.ws + OFF_SH13T); }
            else if ((t -= 128) < 64) { s1 = p.in[33] + (size_t)l * 256 * 1024; ld = 1024; K = 256; dst = (u16*)(p.ws + OFF_SH2T); }
            else { t -= 64; s1 = p.in[26] + (size_t)l * 1024 * 64; ld = 64; K = 1024; dst = (u16*)(p.ws + OFF_ROUTT); }
            conv_tile(s1, s2, ld, K, perm, dst, t, (float*)lds);
        } else if (u < W_CONV_TILES + 256) {
            s5_precompute(p, l, (u - W_CONV_TILES) >> 3, (u - W_CONV_TILES) & 7, (float*)lds);
        } else if (u == W_CONV_TILES + 256) {
            float* LB = (float*)(p.ws + OFF_LB);
            for (int c = tid; c < 512; c += 256) {
                float x0 = p.in[3][c], x1 = p.in[3][512 + c];
                LB[c] = (l == 0) ? 0.f : 1.f / (1.f + expf(x0 - x1));
            }
            if (tid < 64) ((int*)(p.ws + OFF_CUR))[tid] = 0;
        } else if (u == W_CONV_TILES + 257) {
        } else {
            int r0 = (u - (W_CONV_TILES + 258)) * 16;
            const float4* src = (const float4*)(p.in[0] + (size_t)r0 * DM);
            uint2* dst = (uint2*)((u16*)(p.ws + OFF_XB) + (size_t)r0 * DM);
            for (int i = tid; i < 16 * 256; i += 256) {
                float4 v = src[i];
                uint2 o; o.x = f2bf(v.x) | ((unsigned)f2bf(v.y) << 16); o.y = f2bf(v.z) | ((unsigned)f2bf(v.w) << 16);
                dst[i] = o;
            }
        }
    }
}

__device__ void hgrn_prep(CParams& p, int u) {
    const int tid = otid();
    const int h = u & 3, c = (u >> 2) & 63, b = u >> 8;
    const int r0 = b * SEQ + c * 64;
    const size_t cu = (size_t)((b * 4 + h) * 64 + c);
    if (tid < 128) {
        const int d = tid;
        float* lf = (float*)(p.ws + OFF_PLF) + (size_t)r0 * 512 + h * 128 + d;
        const u16* kk = (const u16*)(p.ws + OFF_PK) + (size_t)r0 * 512 + h * 128 + d;
        float bs[64];
#pragma unroll
        for (int s = 0; s < 64; ++s) bs[s] = lf[(size_t)s * 512];
        float run = 0.f;
#pragma unroll
        for (int s = 0; s < 64; ++s) { run += bs[s]; bs[s] = run; lf[(size_t)s * 512] = run; }
        const float btot = run;
        ((float*)(p.ws + OFF_DEC))[(size_t)(b * 64 + c) * 512 + h * 128 + d] = __expf(btot);
        u16* dst = (u16*)(p.ws + OFF_KTT) + (cu * 128 + d) * 64;
#pragma unroll
        for (int s8 = 0; s8 < 8; ++s8) {
            bf16x8 o;
#pragma unroll
            for (int e = 0; e < 8; ++e) {
                int s = s8 * 8 + e;
                o[e] = (short)f2bf(bf2f(kk[(size_t)s * 512]) * __expf(btot - bs[s]));
            }
            *(bf16x8*)(dst + s8 * 8) = o;
        }
    } else {
        const int v = tid - 128;
        const u16* vv = (const u16*)(p.ws + OFF_PV) + (size_t)r0 * 512 + h * 128 + v;
        u16* dst = (u16*)(p.ws + OFF_VT) + (cu * 128 + v) * 64;
#pragma unroll
        for (int s8 = 0; s8 < 8; ++s8) {
            bf16x8 o;
#pragma unroll
            for (int e = 0; e < 8; ++e) o[e] = (short)vv[(size_t)(s8 * 8 + e) * 512];
            *(bf16x8*)(dst + s8 * 8) = o;
        }
    }
}

__device__ void s5_gemm_a(CParams& p, int u, char* lds) {
    LANE_IDS;
    const int wr = wid >> 1, wc = wid & 1;
    const int g = u >> 3, tm = u & 7, row0 = tm * 128;
    unsigned char* ws = p.ws;
    const unsigned aoff = (unsigned)(OFF_PU + (size_t)g * NTOK * 16 * 2), boff = (unsigned)(OFF_BTA + (size_t)g * 128 * 256 * 2);
    f32x4 acc[4][4]; ZERO_ACC(acc, 4, 4);
    mma_glds<128, 128, 2, 2>(acc, 4, ws,
        [&](int r, int t) { return aoff + ((row0 + r) * 256 + t * 64) * 2; },
        [&](int c, int t) { return boff + (c * 256 + t * 64) * 2; }, NoHook(), lds);
    epi<4, 4, 64, 64>(acc, wr, wc, fq, fr, [&](int r, int cc, float v) {
        stg<float>(ws, (unsigned)(OFF_VC + (((row0 + r) * 32 + g) * 128 + cc) * 4), v); });
}

__device__ void rg_conv(CParams& p, int l, int u) {
    const int tid = otid();
    const u16* xr = (const u16*)(p.ws + OFF_PXR);
    u16* xc = (u16*)(p.ws + OFF_XC);
    const float* cw = p.in[15] + (size_t)l * 4 * 512;
    const float* cb = p.in[16] + (size_t)l * 512;
    for (int i = tid; i < 64 * 64; i += 256) {
        const int row = u * 64 + (i >> 6), c8 = (i & 63) * 8;
        const int t = row & (SEQ - 1);
        float a[8];
#pragma unroll
        for (int e = 0; e < 8; ++e) a[e] = cb[c8 + e];
#pragma unroll
        for (int j = 0; j < 4; ++j) {
            if (t - 3 + j >= 0) {
                bf16x8 x = *(const bf16x8*)(xr + (size_t)(row - 3 + j) * 512 + c8);
#pragma unroll
                for (int e = 0; e < 8; ++e) a[e] += cw[j * 512 + c8 + e] * bf2f((u16)x[e]);
            }
        }
        bf16x8 o;
#pragma unroll
        for (int e = 0; e < 8; ++e) o[e] = (short)f2bf(a[e]);
        *(bf16x8*)(xc + (size_t)row * 512 + c8) = o;
    }
}

__device__ void phase2(CParams& p, int l, char* lds) {
    for (int u = VB; u < 1536; u += VG) {
        if (u < 1024) hgrn_prep(p, u);
        else if (u < 1280) s5_gemm_a(p, u - 1024, lds);
        else rg_conv(p, l, u - 1280);
    }
}

__device__ void hgrn_u(CParams& p, int u, char* lds) {
    LANE_IDS;
    const int wr = wid >> 1, wc = wid & 1;
    unsigned char* ws = p.ws;
    f32x4 acc[4][4]; ZERO_ACC(acc, 4, 4);
    mma_glds<128, 128, 2, 2>(acc, 1, ws,
        [&](int r, int t) { return (unsigned)(OFF_KTT + ((u * 128 + r) * 64) * 2); },
        [&](int c, int t) { return (unsigned)(OFF_VT + ((u * 128 + c) * 64) * 2); }, NoHook(), lds);
#pragma unroll
    for (int m = 0; m < 4; ++m) {
#pragma unroll
        for (int n = 0; n < 4; ++n) {
            const int d0 = wr * 64 + m * 16 + fq * 4, v = wc * 64 + n * 16 + fr;
            uint2 o;
            o.x = f2bf(acc[m][n][0]) | ((unsigned)f2bf(acc[m][n][1]) << 16);
            o.y = f2bf(acc[m][n][2]) | ((unsigned)f2bf(acc[m][n][3]) << 16);
            stg<uint2>(ws, (unsigned)(OFF_UT + ((u * 128 + v) * 128 + d0) * 2), o);
        }
        __builtin_amdgcn_sched_barrier(0);
    }
}

__device__ void hgrn_sscan(CParams& p, int u) {
    const int tid = otid();
    const int bh = u >> 4, ec = (u & 15) * 256 + tid, v = ec >> 5, d4 = (ec & 31) * 4;
    const int b = bh >> 2, h = bh & 3;
    unsigned char* ws = p.ws;
    const unsigned ub = (unsigned)(OFF_UT + ((bh * 64 * 128 + v) * 128 + d4) * 2);
    const unsigned sb = (unsigned)(OFF_ST + ((bh * 64 * 128 + v) * 128 + d4) * 2);
    const unsigned db = (unsigned)(OFF_DEC + ((b * 64) * 512 + h * 128 + d4) * 4);
    f32x4 S = {0.f, 0.f, 0.f, 0.f};
    for (int c0 = 0; c0 < 64; c0 += 8) {
        uint2 uu[8]; f32x4 dd[8];
#pragma unroll
        for (int i = 0; i < 8; ++i) { uu[i] = ldg<uint2>(ws, ub + (unsigned)((c0 + i) * 128 * 128 * 2)); dd[i] = ldg<f32x4>(ws, db + (unsigned)((c0 + i) * 512 * 4)); }
#pragma unroll
        for (int i = 0; i < 8; ++i) {
            uint2 o;
            o.x = f2bf(S[0]) | ((unsigned)f2bf(S[1]) << 16); o.y = f2bf(S[2]) | ((unsigned)f2bf(S[3]) << 16);
            stg<uint2>(ws, sb + (unsigned)((c0 + i) * 128 * 128 * 2), o);
            S[0] = dd[i][0] * S[0] + bf2f((u16)(uu[i].x & 0xffff)); S[1] = dd[i][1] * S[1] + bf2f((u16)(uu[i].x >> 16));
            S[2] = dd[i][2] * S[2] + bf2f((u16)(uu[i].y & 0xffff)); S[3] = dd[i][3] * S[3] + bf2f((u16)(uu[i].y >> 16));
        }
    }
}

__device__ void s5_scan(CParams& p, int l, int u, char* lds) {
    const int tid = otid();
    const int b = u >> 5, g = u & 31, seg = tid >> 6, pp = tid & 63;
    const int lg = l * 32 + g;
    const float dt = expf(p.in[12][lg]);
    const float ar = p.in[5][lg * 64 + pp], ai = p.in[6][lg * 64 + pp];
    const float mag = expf(16.f * ar * dt), ang = 16.f * ai * dt;
    const float er = mag * cosf(ang), ei = mag * sinf(ang);
    const float mg2 = expf(1024.f * ar * dt), an2 = 1024.f * ai * dt;
    const float sr = mg2 * cosf(an2), si = mg2 * sinf(an2);
    unsigned char* ws = p.ws;
    const unsigned vb = (unsigned)(OFF_VC + (((b * 256 + seg * 64) * 32 + g) * 128 + pp) * 4);
    const unsigned hb = (unsigned)(OFF_HC + (((b * 256 + seg * 64) * 32 + g) * 128 + pp) * 2);
    float* ex = (float*)lds;
    __syncthreads();
    float hr = 0.f, hi = 0.f;
    for (int c0 = 0; c0 < 64; c0 += 16) {
        float vr[16], vi[16];
#pragma unroll
        for (int i = 0; i < 16; ++i) { vr[i] = ldg<float>(ws, vb + (unsigned)((c0 + i) * 4096 * 4)); vi[i] = ldg<float>(ws, vb + (unsigned)((c0 + i) * 4096 * 4 + 256)); }
#pragma unroll
        for (int i = 0; i < 16; ++i) { const float nr = er * hr - ei * hi + vr[i], ni = er * hi + ei * hr + vi[i]; hr = nr; hi = ni; }
    }
    ex[(seg * 64 + pp) * 2] = hr; ex[(seg * 64 + pp) * 2 + 1] = hi;
    __syncthreads();
    hr = 0.f; hi = 0.f;
    for (int sg = 0; sg < seg; ++sg) {
        const float lr = ex[(sg * 64 + pp) * 2], li = ex[(sg * 64 + pp) * 2 + 1];
        const float nr = sr * hr - si * hi + lr, ni = sr * hi + si * hr + li; hr = nr; hi = ni;
    }
    for (int c0 = 0; c0 < 64; c0 += 16) {
        float vr[16], vi[16];
#pragma unroll
        for (int i = 0; i < 16; ++i) { vr[i] = ldg<float>(ws, vb + (unsigned)((c0 + i) * 4096 * 4)); vi[i] = ldg<float>(ws, vb + (unsigned)((c0 + i) * 4096 * 4 + 256)); }
#pragma unroll
        for (int i = 0; i < 16; ++i) {
            stg<u16>(ws, hb + (unsigned)((c0 + i) * 4096 * 2), f2bf(hr));
            stg<u16>(ws, hb + (unsigned)((c0 + i) * 4096 * 2 + 128), f2bf(hi));
            const float nr = er * hr - ei * hi + vr[i], ni = er * hi + ei * hr + vi[i]; hr = nr; hi = ni;
        }
    }
}

__device__ void rg_gemm(CParams& p, int l, int u, char* lds) {
    LANE_IDS;
    const int wr = wid >> 1, wc = wid & 1;
    const int tm = u >> 3, h = (u >> 1) & 3, nt = u & 1, row0 = tm * 128;
    unsigned char* ws = p.ws;
    const unsigned aoff = (unsigned)(OFF_XC + h * 128 * 2), boff = (unsigned)(OFF_RGT + ((size_t)h * 256 * 128 + (size_t)nt * 128 * 128) * 2);
    f32x4 acc[4][4]; ZERO_ACC(acc, 4, 4);
    mma_glds<128, 128, 2, 2>(acc, 2, ws,
        [&](int r, int t) { return aoff + ((row0 + r) * 512 + t * 64) * 2; },
        [&](int c, int t) { return boff + (c * 128 + t * 64) * 2; }, NoHook(), lds);
    const float* ba = p.in[18] + (size_t)l * 512;
    const float* bx = p.in[20] + (size_t)l * 512;
    const float* lam = p.in[21] + (size_t)l * 512;
#pragma unroll
    for (int n = 0; n < 2; ++n) {
        const int ch = h * 128 + (nt * 2 + wc) * 32 + n * 16 + fr;
        const float c1 = -8.f * log1pf(expf(-lam[ch]));
        const float bav = ba[ch], bxv = bx[ch];
#pragma unroll
        for (int m = 0; m < 4; ++m) {
#pragma unroll
            for (int j = 0; j < 4; ++j) {
                const int row = row0 + wr * 64 + m * 16 + fq * 4 + j;
                const float r = sigm(acc[m][n][j] + bav), ig = sigm(acc[m][n + 2][j] + bxv);
                const float la = c1 * r;
                const float x = bf2f(ldg<u16>(ws, (unsigned)(OFF_XC + (row * 512 + ch) * 2)));
                const float bb = sqrtf(fmaxf(1.f - __expf(2.f * la), 0.f)) * ig * x;
                stg<u16>(ws, (unsigned)(OFF_LA + (row * 512 + ch) * 2), f2bf(la));
                stg<u16>(ws, (unsigned)(OFF_BB + (row * 512 + ch) * 2), f2bf(bb));
            }
            __builtin_amdgcn_sched_barrier(0);
        }
    }
}

__device__ void phase3(CParams& p, int l, char* lds) {
    for (int u = VB; u < 2176; u += VG) {
        if (u < 128) s5_scan(p, l, u, lds);
        else if (u < 1152) hgrn_u(p, u - 128, lds);
        else rg_gemm(p, l, u - 1152, lds);
    }
}

__device__ void hgrn_out(CParams& p, int l, int u, char* lds) {
    LANE_IDS;
    const int h = u & 3, c = (u >> 2) & 63, b = u >> 8;
    const int r0 = b * SEQ + c * 64;
    const size_t cu = (size_t)((b * 4 + h) * 64 + c);
    const u16* Pq = (const u16*)(p.ws + OFF_PQ) + (size_t)r0 * 512 + h * 128;
    const u16* Pk = (const u16*)(p.ws + OFF_PK) + (size_t)r0 * 512 + h * 128;
    const float* Bc = (const float*)(p.ws + OFF_PLF) + (size_t)r0 * 512 + h * 128;
    char* Ss = lds + (64 + 128) * 128;
    __syncthreads();
    {
        const int i = wid;
        const int t = 16 * i + fr;
        bf16x8 aq[4];
        float refv[4][8];
#pragma unroll
        for (int kk = 0; kk < 4; ++kk) {
            const int d0 = kk * 32 + fq * 8;
            bf16x8 q8 = *(const bf16x8*)(Pq + (size_t)t * 512 + d0);
#pragma unroll
            for (int e = 0; e < 8; ++e) {
                float rf = (i == 0) ? 0.f : Bc[(size_t)(16 * i - 1) * 512 + d0 + e];
                refv[kk][e] = rf;
                float bt = Bc[(size_t)t * 512 + d0 + e];
                aq[kk][e] = (short)f2bf(bf2f((u16)q8[e]) * __expf(bt - rf));
            }
        }
#pragma unroll
        for (int j = 0; j < 4; ++j) {
            f32x4 sc = {0.f, 0.f, 0.f, 0.f};
            if (j <= i) {
                const int s = 16 * j + fr;
#pragma unroll
                for (int kk = 0; kk < 4; ++kk) {
                    const int d0 = kk * 32 + fq * 8;
                    bf16x8 k8 = *(const bf16x8*)(Pk + (size_t)s * 512 + d0);
                    bf16x8 bk;
#pragma unroll
                    for (int e = 0; e < 8; ++e) {
                        float bsv = Bc[(size_t)s * 512 + d0 + e];
                        bk[e] = (short)f2bf(bf2f((u16)k8[e]) * __expf(fminf(refv[kk][e] - bsv, 60.f)));
                    }
                    sc = __builtin_amdgcn_mfma_f32_16x16x32_bf16(aq[kk], bk, sc, 0, 0, 0);
                }
            }
#pragma unroll
            for (int r = 0; r < 4; ++r) {
                const int tl = fq * 4 + r, sl = fr;
                float v = sc[r];
                if (j > i || (j == i && sl > tl)) v = 0.f;
                const int row = 16 * i + tl, col = 16 * j + sl;
                *(u16*)(Ss + swz(row, col >> 3) + (col & 7) * 2) = f2bf(v);
            }
        }
    }
    __syncthreads();
    const u16* STc = (const u16*)(p.ws + OFF_ST) + cu * 128 * 128;
    const u16* VTc = (const u16*)(p.ws + OFF_VT) + cu * 128 * 64;
    f32x4 acc[1][8]; ZERO_ACC(acc, 1, 8);
    mma_loop<64, 128, 4, 1>(acc, 3,
        [&](int r, int k) {
            bf16x8 o;
            if (k < 128) {
                bf16x8 q8 = *(const bf16x8*)(Pq + (size_t)r * 512 + k);
                const float4 b0 = *(const float4*)(Bc + (size_t)r * 512 + k), b1 = *(const float4*)(Bc + (size_t)r * 512 + k + 4);
                o[0] = (short)f2bf(bf2f((u16)q8[0]) * __expf(b0.x)); o[1] = (short)f2bf(bf2f((u16)q8[1]) * __expf(b0.y));
                o[2] = (short)f2bf(bf2f((u16)q8[2]) * __expf(b0.z)); o[3] = (short)f2bf(bf2f((u16)q8[3]) * __expf(b0.w));
                o[4] = (short)f2bf(bf2f((u16)q8[4]) * __expf(b1.x)); o[5] = (short)f2bf(bf2f((u16)q8[5]) * __expf(b1.y));
                o[6] = (short)f2bf(bf2f((u16)q8[6]) * __expf(b1.z)); o[7] = (short)f2bf(bf2f((u16)q8[7]) * __expf(b1.w));
            } else {
                o = *(const bf16x8*)(Ss + swz(r, (k - 128) >> 3));
            }
            return o;
        },
        [&](int cc, int k) {
            return (k < 128) ? *(const bf16x8*)(STc + (size_t)cc * 128 + k) : *(const bf16x8*)(VTc + (size_t)cc * 64 + (k - 128));
        }, NoHook(), lds);
    const float* nw = p.in[4] + (size_t)l * 512 + h * 128;
    const u16* Pg = (const u16*)(p.ws + OFF_PG) + (size_t)r0 * 512 + h * 128;
    u16* Ya = (u16*)(p.ws + OFF_YA) + (size_t)r0 * 512 + h * 128;
#pragma unroll
    for (int j = 0; j < 4; ++j) {
        float ss = 0.f;
#pragma unroll
        for (int n = 0; n < 8; ++n) ss += acc[0][n][j] * acc[0][n][j];
        ss += shfl_xor_l(ss, 1, lane); ss += shfl_xor_l(ss, 2, lane); ss += shfl_xor_l(ss, 4, lane); ss += shfl_xor_l(ss, 8, lane);
        const float rs = rsqrtf(ss * (1.f / 128.f) + 1e-6f);
        const int row = wid * 16 + fq * 4 + j;
#pragma unroll
        for (int n = 0; n < 8; ++n) {
            const int v = n * 16 + fr;
            Ya[(size_t)row * 512 + v] = f2bf(acc[0][n][j] * rs * nw[v] * bf2f(Pg[(size_t)row * 512 + v]));
        }
    }
}

__device__ void s5_gemm_c(CParams& p, int l, int u, char* lds) {
    LANE_IDS;
    const int wr = wid >> 1, wc = wid & 1;
    const int g = u >> 4, tm = (u >> 1) & 7, tn = u & 1, row0 = tm * 128, col0 = tn * 128;
    unsigned char* ws = p.ws;
    const unsigned aoff = (unsigned)(OFF_PU + (size_t)g * NTOK * 16 * 2), boff = (unsigned)(OFF_BTC + (size_t)g * 256 * 384 * 2);
    f32x4 acc[4][4]; ZERO_ACC(acc, 4, 4);
    mma_glds<128, 128, 2, 2>(acc, 6, ws,
        [&](int r, int t) {
            return (t < 4) ? aoff + ((row0 + r) * 256 + t * 64) * 2 : (unsigned)(OFF_HC + (((row0 + r) * 32 + g) * 128 + (t - 4) * 64) * 2);
        },
        [&](int c, int t) { return boff + ((col0 + c) * 384 + t * 64) * 2; }, NoHook(), lds);
    const float dch = p.in[11][(size_t)l * 512 + g * 16 + fr];
    epi<4, 4, 64, 64>(acc, wr, wc, fq, fr, [&](int r, int cc, float v) {
        const int row = row0 + r, col = col0 + cc;
        const int jj = col >> 4, ch = col & 15;
        const int tok = (row >> 8) * SEQ + (row & 255) * 16 + jj;
        const float uu = bf2f(ldg<u16>(ws, aoff + (tok * 16 + ch) * 2));
        const float y = v + dch * uu;
        stg<u16>(ws, (unsigned)(OFF_YG + (tok * 512 + g * 16 + ch) * 2), f2bf(gelu_f(y))); });
}

__device__ void rg_local(CParams& p, int u) {
    const int tid = otid();
    const int b = u >> 7, seg = (u >> 1) & 63, ch = (u & 1) * 256 + tid;
    unsigned char* ws = p.ws;
    const unsigned base = (unsigned)(((b * SEQ + seg * 64) * 512 + ch) * 2);
    float hh = 0.f, ap = 1.f;
    for (int s0 = 0; s0 < 64; s0 += 16) {
        float a[16], bb[16];
#pragma unroll
        for (int i = 0; i < 16; ++i) { a[i] = bf2f(ldg<u16>(ws, (unsigned)OFF_LA + base + (unsigned)((s0 + i) * 1024))); bb[i] = bf2f(ldg<u16>(ws, (unsigned)OFF_BB + base + (unsigned)((s0 + i) * 1024))); }
#pragma unroll
        for (int i = 0; i < 16; ++i) { const float av = __expf(a[i]); hh = av * hh + bb[i]; ap *= av; }
    }
    stg<float>(ws, (unsigned)(OFF_SEGA + ((b * 64 + seg) * 512 + ch) * 4), ap);
    stg<float>(ws, (unsigned)(OFF_SEGH + ((b * 64 + seg) * 512 + ch) * 4), hh);
}

__device__ void rg_final(CParams& p, int u) {
    const int tid = otid();
    const int b = u >> 7, seg = (u >> 1) & 63, ch = (u & 1) * 256 + tid;
    unsigned char* ws = p.ws;
    const unsigned base = (unsigned)(((b * SEQ + seg * 64) * 512 + ch) * 2);
    float hh = 0.f;
    for (int sg = 0; sg < seg; ++sg) {
        const float sa = ldg<float>(ws, (unsigned)(OFF_SEGA + ((b * 64 + sg) * 512 + ch) * 4));
        const float sh = ldg<float>(ws, (unsigned)(OFF_SEGH + ((b * 64 + sg) * 512 + ch) * 4));
        hh = sa * hh + sh;
    }
    for (int s0 = 0; s0 < 64; s0 += 16) {
        float a[16], bb[16], xg[16];
#pragma unroll
        for (int i = 0; i < 16; ++i) {
            a[i] = bf2f(ldg<u16>(ws, (unsigned)OFF_LA + base + (unsigned)((s0 + i) * 1024)));
            bb[i] = bf2f(ldg<u16>(ws, (unsigned)OFF_BB + base + (unsigned)((s0 + i) * 1024)));
            xg[i] = bf2f(ldg<u16>(ws, (unsigned)OFF_PXG + base + (unsigned)((s0 + i) * 1024)));
        }
#pragma unroll
        for (int i = 0; i < 16; ++i) { hh = __expf(a[i]) * hh + bb[i]; stg<u16>(ws, (unsigned)OFF_YC + base + (unsigned)((s0 + i) * 1024), f2bf(hh * xg[i])); }
    }
}

__device__ void phase4(CParams& p, int l, char* lds) {
    for (int u = VB; u < 1280; u += VG) {
        if (u < 256) hgrn_sscan(p, u);
        else if (u < 768) rg_local(p, u - 256);
        else s5_gemm_c(p, l, u - 768, lds);
    }
}

__device__ void phase_glu(CParams& p, int l, char* lds) {
    LANE_IDS;
    const int wr = wid >> 1, wc = wid & 1;
    unsigned char* ws = p.ws;
    const float* gb = p.in[14] + (size_t)l * 512;
    for (int uu = VB; uu < 2048; uu += VG) {
        if (uu < 1024) { hgrn_out(p, l, uu, lds); continue; }
        if (uu < 1536) { rg_final(p, uu - 1024); continue; }
        const int u = uu - 1536;
        const int row0 = (u >> 2) * 128, col0 = (u & 3) * 128;
        f32x4 acc[4][4]; ZERO_ACC(acc, 4, 4);
        mma_glds<128, 128, 2, 2>(acc, 8, ws,
            [&](int r, int t) { return (unsigned)(OFF_YG + ((row0 + r) * 512 + t * 64) * 2); },
            [&](int c, int t) { return (unsigned)(OFF_GLUT + ((col0 + c) * 512 + t * 64) * 2); }, NoHook(), lds);
        epi<4, 4, 64, 64>(acc, wr, wc, fq, fr, [&](int r, int cc, float v) {
            const int row = row0 + r, col = col0 + cc;
            const float y = bf2f(ldg<u16>(ws, (unsigned)(OFF_YG + (row * 512 + col) * 2)));
            stg<u16>(ws, (unsigned)(OFF_YB + (row * 512 + col) * 2), f2bf(y * sigm(v + gb[col]))); });
    }
}

__device__ void phase_branch(CParams& p, int l, char* lds) {
    BrSched S; S.c = blockIdx.x;
    BrEpi E; E.ws = p.ws;
    g8::gemm_phase<BrEpi, BrSched, false>((LAS unsigned char*)lds, p.ws, 512, S, E);
}

__device__ void phase_out(CParams& p, int l, char* lds, char* hlds) {
    {
        OutSched S; S.A = (unsigned)OFF_MIXP; S.B = (unsigned)OFF_WOUTT; S.c = blockIdx.x; S.G = gridDim.x;
        OutEpi E; E.ws = p.ws; E.xres = (l == 0) ? p.in[0] : p.out;
        g8::gemm_phase<OutEpi, OutSched, false>((LAS unsigned char*)lds, p.ws, 1024, S, E);
    }
    for (int u = VB; u < 12288; u += VG) {
        const int e = u / 192, r = u % 192;
        if (r < 128)
            conv_tile(p.in[28] + (size_t)(l * 64 + e) * 1024 * 256, p.in[29] + (size_t)(l * 64 + e) * 1024 * 256, 256, 1024, 16,
                      (u16*)(p.ws + OFF_EW13) + (size_t)e * 512 * 1024, r, (float*)hlds);
        else
            conv_tile(p.in[30] + (size_t)(l * 64 + e) * 256 * 1024, nullptr, 1024, 256, 0,
                      (u16*)(p.ws + OFF_EW2) + (size_t)e * 1024 * 256, r - 128, (float*)hlds);
    }
}

__device__ __forceinline__ void ln_row(float (&v)[16], const float* g, const float* bta, int lane) {
    float s = 0.f;
#pragma unroll
    for (int i = 0; i < 16; ++i) s += v[i];
    const float mu = wave_sum(s, lane) * (1.f / 1024.f);
    float q = 0.f;
#pragma unroll
    for (int i = 0; i < 16; ++i) { float d = v[i] - mu; q += d * d; }
    const float rs = rsqrtf(wave_sum(q, lane) * (1.f / 1024.f) + 1e-5f);
#pragma unroll
    for (int i = 0; i < 4; ++i) {
        const float4 gg = *(const float4*)(g + i * 256 + lane * 4), bb = *(const float4*)(bta + i * 256 + lane * 4);
        v[i * 4 + 0] = (v[i * 4 + 0] - mu) * rs * gg.x + bb.x;
        v[i * 4 + 1] = (v[i * 4 + 1] - mu) * rs * gg.y + bb.y;
        v[i * 4 + 2] = (v[i * 4 + 2] - mu) * rs * gg.z + bb.z;
        v[i * 4 + 3] = (v[i * 4 + 3] - mu) * rs * gg.w + bb.w;
    }
}

__device__ void phase_route(CParams& p, int l, char* lds) {
    LANE_IDS;
    const float* Pre = (const float*)(p.ws + OFF_PRELN);
    u16* Xm = (u16*)(p.ws + OFF_XM);
    const float* g1 = p.in[24] + (size_t)l * 1024;
    const float* b1 = p.in[25] + (size_t)l * 1024;
    const float* rbias = p.in[27] + (size_t)l * 64;
    int* cursor = (int*)(p.ws + OFF_CUR);
    int* list = (int*)(p.ws + OFF_LIST);
    float* wlist = (float*)(p.ws + OFF_WLIST);
    float* Ls = (float*)(lds + 32768);
    int* hist = (int*)(lds + 32768 + 64 * 65 * 4);
    int* basep = hist + 64;
    for (int u = VB; u < 512; u += VG) {
        const int row0 = u * 32;
#pragma unroll 1
        for (int hb = 0; hb < 2; ++hb) {
            float v[4][16];
#pragma unroll
            for (int rr = 0; rr < 4; ++rr) {
                const int row = row0 + wid * 8 + hb * 4 + rr;
#pragma unroll
                for (int i = 0; i < 4; ++i) {
                    const float4 x = *(const float4*)(Pre + (size_t)row * 1024 + i * 256 + lane * 4);
                    v[rr][i * 4] = x.x; v[rr][i * 4 + 1] = x.y; v[rr][i * 4 + 2] = x.z; v[rr][i * 4 + 3] = x.w;
                }
            }
#pragma unroll
            for (int rr = 0; rr < 4; ++rr) {
                const int row = row0 + wid * 8 + hb * 4 + rr;
                ln_row(v[rr], g1, b1, lane);
#pragma unroll
                for (int i = 0; i < 4; ++i) {
                    uint2 o; o.x = f2bf(v[rr][i * 4]) | ((unsigned)f2bf(v[rr][i * 4 + 1]) << 16); o.y = f2bf(v[rr][i * 4 + 2]) | ((unsigned)f2bf(v[rr][i * 4 + 3]) << 16);
                    *(uint2*)(Xm + (size_t)row * 1024 + i * 256 + lane * 4) = o;
                }
            }
        }
        if (tid < 64) hist[tid] = 0;
        __syncthreads();
        f32x4 acc[1][2]; ZERO_ACC(acc, 1, 2);
        mma_glds<32, 64, 2, 2>(acc, 16, p.ws,
            [&](int r, int t) { return (unsigned)(OFF_XM + ((row0 + r) * 1024 + t * 64) * 2); },
            [&](int c, int t) { return (unsigned)(OFF_ROUTT + (c * 1024 + t * 64) * 2); }, NoHook(), lds);
#pragma unroll
        for (int n = 0; n < 2; ++n)
#pragma unroll
            for (int j = 0; j < 4; ++j) {
                const int r = (wid >> 1) * 16 + fq * 4 + j, e = (wid & 1) * 32 + n * 16 + fr;
                Ls[r * 65 + e] = sigm(acc[0][n][j]) + rbias[e];
            }
        __syncthreads();
        int myrank[8]; int myexp[8]; float wv[8];
        if (tid < 32) {
            float* sc = Ls + tid * 65;
            float gs[8];
#pragma unroll
            for (int g = 0; g < 8; ++g) {
                float m1 = -1e30f, m2 = -1e30f;
#pragma unroll
                for (int i = 0; i < 8; ++i) { float x = sc[g * 8 + i]; if (x > m1) { m2 = m1; m1 = x; } else if (x > m2) m2 = x; }
                gs[g] = m1 + m2;
            }
            unsigned gmask = 0;
#pragma unroll
            for (int it = 0; it < 4; ++it) {
                float best = -1e30f; int bi = 0;
#pragma unroll
                for (int g = 0; g < 8; ++g) { bool ok = !((gmask >> g) & 1u) && gs[g] > best; if (ok) { best = gs[g]; bi = g; } }
                gmask |= 1u << bi;
            }
            unsigned long long chosen = 0ull;
            float wsum = 0.f;
#pragma unroll
            for (int k = 0; k < 8; ++k) {
                float best = -1e30f; int bi = 0;
                for (int e = 0; e < 64; ++e) {
                    float x = sc[e];
                    bool ok = ((gmask >> (e >> 3)) & 1u) && !((chosen >> e) & 1ull) && x > best;
                    if (ok) { best = x; bi = e; }
                }
                chosen |= 1ull << bi;
                myexp[k] = bi;
                wv[k] = best - rbias[bi];
                wsum += wv[k];
            }
            const float sc_ = 2.5f / wsum;
#pragma unroll
            for (int k = 0; k < 8; ++k) {
                wv[k] *= sc_;
                myrank[k] = atomicAdd(&hist[myexp[k]], 1);
            }
        }
        __syncthreads();
        if (tid < 64) basep[tid] = atomicAdd(&cursor[tid], hist[tid]);
        __syncthreads();
        if (tid < 32) {
#pragma unroll
            for (int k = 0; k < 8; ++k) {
                const size_t pos = (size_t)myexp[k] * NTOK + basep[myexp[k]] + myrank[k];
                list[pos] = (row0 + tid) * 8 + k;
                wlist[pos] = wv[k];
            }
        }
        __syncthreads();
    }
}

__device__ void phase_combine(CParams& p, int l) {
    LANE_IDS;
    typedef float f32x2 __attribute__((ext_vector_type(2)));
    unsigned char* ws = p.ws;
    const float* g2 = p.in[34] + (size_t)l * 1024 + lane * 16;
    const float* b2 = p.in[35] + (size_t)l * 1024 + lane * 16;
    for (int row = VB * 4 + wid; row < NTOK; row += VG * 4) {
        f32x4 y[4]; uint4 xm[2]; u32x4 yb[8];
#pragma unroll
        for (int i = 0; i < 4; ++i) y[i] = ldg<f32x4>(p.out, (unsigned)((row * 1024 + lane * 16 + i * 4) * 4));
#pragma unroll
        for (int i = 0; i < 2; ++i) xm[i] = ldg<uint4>(ws, (unsigned)(OFF_XM + (row * 1024 + lane * 16 + i * 8) * 2));
#pragma unroll
        for (int k = 0; k < 8; ++k) yb[k] = ldg<u32x4>(ws, (unsigned)OFF_YBUF + (unsigned)((row * 8 + k) * 1024 + lane * 16));
        float v[16], s[16];
#pragma unroll
        for (int i = 0; i < 16; ++i) s[i] = 0.f;
#pragma unroll
        for (int k = 0; k < 8; ++k)
#pragma unroll
            for (int w = 0; w < 4; ++w) {
                const f32x2 lo = __builtin_amdgcn_cvt_pk_f32_fp8((int)yb[k][w], false), hi = __builtin_amdgcn_cvt_pk_f32_fp8((int)yb[k][w], true);
                s[w * 4 + 0] += lo.x; s[w * 4 + 1] += lo.y; s[w * 4 + 2] += hi.x; s[w * 4 + 3] += hi.y;
            }
#pragma unroll
        for (int i = 0; i < 2; ++i) {
            const uint4 x = xm[i];
            const float xf[8] = {bf2f((u16)(x.x & 0xffff)), bf2f((u16)(x.x >> 16)), bf2f((u16)(x.y & 0xffff)), bf2f((u16)(x.y >> 16)),
                                 bf2f((u16)(x.z & 0xffff)), bf2f((u16)(x.z >> 16)), bf2f((u16)(x.w & 0xffff)), bf2f((u16)(x.w >> 16))};
#pragma unroll
            for (int j = 0; j < 8; ++j) v[i * 8 + j] = y[i * 2 + (j >> 2)][j & 3] + DN_ALPHA * xf[j] + s[i * 8 + j] * (1.f / 32.f);
        }
        float sum = 0.f;
#pragma unroll
        for (int i = 0; i < 16; ++i) sum += v[i];
        const float mu = wave_sum(sum, lane) * (1.f / 1024.f);
        float q = 0.f;
#pragma unroll
        for (int i = 0; i < 16; ++i) { const float d = v[i] - mu; q += d * d; }
        const float rs = rsqrtf(wave_sum(q, lane) * (1.f / 1024.f) + 1e-5f);
#pragma unroll
        for (int i = 0; i < 4; ++i) {
            const f32x4 gg = *(const f32x4*)(g2 + i * 4), bb = *(const f32x4*)(b2 + i * 4);
#pragma unroll
            for (int j = 0; j < 4; ++j) v[i * 4 + j] = (v[i * 4 + j] - mu) * rs * gg[j] + bb[j];
            stg<f32x4>(p.out, (unsigned)((row * 1024 + lane * 16 + i * 4) * 4), f32x4{v[i * 4], v[i * 4 + 1], v[i * 4 + 2], v[i * 4 + 3]});
        }
#pragma unroll
        for (int i = 0; i < 2; ++i) {
            uint4 o;
            o.x = f2bf(v[i * 8 + 0]) | ((unsigned)f2bf(v[i * 8 + 1]) << 16); o.y = f2bf(v[i * 8 + 2]) | ((unsigned)f2bf(v[i * 8 + 3]) << 16);
            o.z = f2bf(v[i * 8 + 4]) | ((unsigned)f2bf(v[i * 8 + 5]) << 16); o.w = f2bf(v[i * 8 + 6]) | ((unsigned)f2bf(v[i * 8 + 7]) << 16);
            stg<uint4>(ws, (unsigned)(OFF_XB + (row * 1024 + lane * 16 + i * 8) * 2), o);
        }
    }
}


#define XB_TMO      128
#define XB_XCNT(j)  (256  + 64 * (j))
#define XB_XSUB(j)  (1280 + 64 * (j))
#define XB_XGEN(j)  (2304 + 64 * (j))
#define XB_TOP      3328
#define XB_TOPGEN   3392
#define XCD_BAR_WORDS 3456
#define XB_SPIN_CAP (1u << 22)
__device__ __forceinline__ unsigned xb_ld(unsigned* p)              { return __hip_atomic_load(p, __ATOMIC_RELAXED, __HIP_MEMORY_SCOPE_AGENT); }
__device__ __forceinline__ unsigned xb_add(unsigned* p, unsigned v) { return __hip_atomic_fetch_add(p, v, __ATOMIC_RELAXED, __HIP_MEMORY_SCOPE_AGENT); }
__device__ __forceinline__ unsigned xb_xcc_id() { return (unsigned)__builtin_amdgcn_s_getreg((3 << 11) | 20) & 0xFu; }
#define XB_SPIN(cond, bar) do { unsigned _sp = 0; while (cond) { __builtin_amdgcn_s_sleep(1); \
    if ((++_sp & 255u) == 0u) { if (xb_ld(&(bar)[XB_TMO])) break; if (_sp > XB_SPIN_CAP) { atomicAdd(&(bar)[XB_TMO], 1u); break; } } } } while (0)
struct XcdBarrier { unsigned* bar; unsigned x; volatile LAS unsigned* st; };
__device__ __forceinline__ XcdBarrier xcd_barrier_post(unsigned* bar, volatile LAS unsigned* st) {
    XcdBarrier b; b.bar = bar; b.x = xb_xcc_id(); b.st = st;
    if (threadIdx.x == 0) (void)xb_add(&bar[XB_XCNT(b.x)], 1u);
    return b;
}
__device__ __forceinline__ void xcd_barrier_complete(unsigned* bar, unsigned x, unsigned& nloc, unsigned& nx) {
    const unsigned G = gridDim.x * gridDim.y * gridDim.z;
    unsigned sum, cnt, mine, sp = 0u;
    for (;;) {
        sum = 0u; cnt = 0u; mine = 0u;
#pragma unroll
        for (unsigned j = 0; j < 16; ++j) { const unsigned c = xb_ld(&bar[XB_XCNT(j)]); sum += c; cnt += (c > 0u) ? 1u : 0u; mine = (j == x) ? c : mine; }
        if (sum == G) break;
        __builtin_amdgcn_s_sleep(1);
        if ((++sp & 255u) == 0u) { if (xb_ld(&bar[XB_TMO])) break; if (sp > XB_SPIN_CAP) { atomicAdd(&bar[XB_TMO], 1u); break; } }
    }
    nloc = mine > 0u ? mine : 1u; nx = cnt > 0u ? cnt : 1u;
}
__device__ __forceinline__ void xcd_barrier(const XcdBarrier& b) {
    asm volatile("s_waitcnt vmcnt(0)" ::: "memory");
    __syncthreads();
    if (threadIdx.x == 0) {
        unsigned* bar = b.bar;
        __builtin_amdgcn_s_waitcnt(0);
        unsigned nloc = b.st[0], nx = b.st[1];
        if (nloc == 0u) { xcd_barrier_complete(bar, b.x, nloc, nx); b.st[0] = nloc; b.st[1] = nx; }
        const unsigned old = xb_add(&bar[XB_XSUB(b.x)], 1u);
        const unsigned gen = old / nloc;
        if (old + 1u == (gen + 1u) * nloc) {
            __builtin_amdgcn_fence(__ATOMIC_RELEASE, "agent");
            asm volatile("s_waitcnt vmcnt(0)" ::: "memory");
            const unsigned og = xb_add(&bar[XB_TOP], 1u);
            const unsigned tg = og / nx;
            if (og + 1u == (tg + 1u) * nx) xb_add(&bar[XB_TOPGEN], 1u);
            else XB_SPIN(xb_ld(&bar[XB_TOPGEN]) == tg, bar);
            __builtin_amdgcn_fence(__ATOMIC_ACQUIRE, "agent");
            xb_add(&bar[XB_XGEN(b.x)], 1u);
            asm volatile("s_waitcnt vmcnt(0)" ::: "memory");
        } else {
            XB_SPIN(xb_ld(&bar[XB_XGEN(b.x)]) == gen, bar);
            __builtin_amdgcn_fence(__ATOMIC_ACQUIRE, "agent");
            asm volatile("s_waitcnt vmcnt(0)" ::: "memory");
        }
    }
    __syncthreads();
}

__global__ void __launch_bounds__(512, 2) fwd_kernel(Params p_unused) {
    extern __shared__ __attribute__((aligned(16))) char lds[];
    cg::grid_group grid = cg::this_grid();
    CParams* pp = (CParams*)__builtin_amdgcn_kernarg_segment_ptr();
    const int ph_lo = pp->ph_lo;
    volatile LAS unsigned* xst = (volatile LAS unsigned*)(lds + L_XST);
    if (threadIdx.x == 0) { xst[0] = 0u; xst[1] = 0u; *(LAS unsigned*)(lds + 147456 + 32) = 0u; }
    __syncthreads();
    const XcdBarrier xb = xcd_barrier_post((unsigned*)(pp->ws + OFF_BAR), xst);
    char* hlds = lds + __builtin_amdgcn_readfirstlane((int)(threadIdx.x >> 8)) * HLDS;
    unsigned long long tq_acc = 0;
    (void)ph_lo;
#pragma unroll
    for (int ph = 0; ph < 2 * NPH; ++ph) {
        asm volatile("" : "+s"(pp));
        CParams& p = *pp;
        const int l = ph / NPH, q = ph % NPH;
        unsigned long long tq0 = 0;
        if (PROBE_TQ >= 0 && q == PROBE_TQ) tq0 = __builtin_amdgcn_s_memrealtime();
#pragma unroll 1
        for (int rep = 0; rep < 1 + (int)((PROBE_MASK >> q) & 1u); ++rep) {
            if (rep) xcd_barrier(xb);
            switch (q) {
                case 0: phase_w(p, l, hlds); break;
                case 1: phase_proj(p, l, lds); break;
                case 2: phase2(p, l, hlds); break;
                case 3: phase3(p, l, hlds); break;
                case 4: phase4(p, l, hlds); break;
                case 5: phase_glu(p, l, hlds); break;
                case 6: phase_branch(p, l, lds); break;
                case 7: phase_out(p, l, lds, hlds); break;
                case 8: phase_route(p, l, hlds); break;
                case 9: phase_moe1(p, l, lds); break;
                case 10: phase_moe2(p, l, lds); break;
                default: phase_combine(p, l); break;
            }
        }
        if (ph + 1 < 2 * NPH) {
            if (p.coop == 1) xcd_barrier(xb);
            else if (p.coop == 2) grid.sync();
        }
        if (PROBE_TQ >= 0 && q == PROBE_TQ) tq_acc += __builtin_amdgcn_s_memrealtime() - tq0;
    }
    if (PROBE_TQ == 98) tq_acc = *(LAS unsigned*)(lds + 147456 + 32);
    if (PROBE_TQ >= 0 && blockIdx.x == 0) {
        const unsigned long long t0 = __builtin_amdgcn_s_memrealtime();
        while (__builtin_amdgcn_s_memrealtime() - t0 < 4ull * tq_acc) __builtin_amdgcn_s_sleep(8);
    }
}

extern "C" void kernel_launch(void* const* d_in, const int* in_sizes, int n_in, void* d_out, int out_size, void* d_ws, size_t ws_size,
                              hipStream_t stream) {
    static int grid_blocks = 0;
    if (!grid_blocks) {
        int dev = 0, cus = 0, per_cu = 0;
        (void)hipGetDevice(&dev);
        (void)hipDeviceGetAttribute(&cus, hipDeviceAttributeMultiprocessorCount, dev);
        (void)hipFuncSetAttribute((const void*)fwd_kernel, hipFuncAttributeMaxDynamicSharedMemorySize, LDS_BYTES);
        (void)hipOccupancyMaxActiveBlocksPerMultiprocessor(&per_cu, fwd_kernel, 512, LDS_BYTES);
        if (per_cu < 1) per_cu = 1;
        per_cu = 1;
        grid_blocks = cus * per_cu;
        if (ws_size < WS_NEED) fprintf(stderr, "kernel_launch: workspace too small: %zu < %zu\n", ws_size, (size_t)WS_NEED);
    }
    Params p{};
    for (int i = 0; i < 36; ++i) p.in[i] = (const float*)d_in[i];
    p.out = (float*)d_out;
    p.ws = (unsigned char*)d_ws;
    p.ph_lo = 0; p.ph_hi = 2 * NPH; p.coop = 1; p.pad = 0;
    (void)hipMemsetAsync((char*)d_ws + OFF_BAR, 0, XCD_BAR_WORDS * 4, stream);
    void* args[] = {&p};
    hipError_t e = hipLaunchCooperativeKernel((void*)fwd_kernel, dim3(grid_blocks), dim3(512), args, LDS_BYTES, stream);
    if (e != hipSuccess) fprintf(stderr, "cooperative launch failed: %s (grid %d)\n", hipGetErrorString(e), grid_blocks);
}
```

```cpp
#include <hip/hip_runtime.h>
#include <hip/hip_cooperative_groups.h>
#include <cstdio>
#include <cstdint>
namespace cg = cooperative_groups;

typedef unsigned short u16;
typedef __attribute__((ext_vector_type(8))) short bf16x8;
typedef __attribute__((ext_vector_type(4))) float f32x4;
typedef __attribute__((ext_vector_type(4))) unsigned u32x4;
#define LAS __attribute__((address_space(3)))

constexpr int NTOK = 16384, DM = 1024, SEQ = 4096, BW = 512, INC = 6656;
constexpr int NE = 64, EH = 256;
#ifndef PROBE_MASK
#define PROBE_MASK 0u
#endif
#define PROBE_TIMEK_ProjEpi false
#define PROBE_TIMEK_OutEpi false
#define PROBE_TIMEK_BrEpi false
#define PROBE_TIMEK_Moe1Epi false
#define PROBE_TIMEK_Moe2Epi false
#define PROBE_TIMEK_ShEpi false
#define PROBE_TQ -1
constexpr int NPH = 12;
constexpr float DN_ALPHA = 1.4142135623730951f;
constexpr size_t SLOT = 16777216ull;

constexpr size_t OFF_WINT  = 0;
constexpr size_t OFF_WBRT  = 13631488;
constexpr size_t OFF_WOUTT = 16777216;
constexpr size_t OFF_GLUT  = 18874368;
constexpr size_t OFF_RGT   = 19398656;
constexpr size_t OFF_SH13T = 19660800;
constexpr size_t OFF_SH2T  = 20709376;
constexpr size_t OFF_BTA   = 21233664;
constexpr size_t OFF_BTC   = 23330816;
constexpr size_t OFF_ROUTT = 29622272;
constexpr size_t OFF_MISC  = 29753344;
constexpr size_t OFF_LB    = OFF_MISC;
constexpr size_t OFF_CUR   = OFF_MISC + 2048;
constexpr size_t OFF_DEC   = OFF_MISC + 4096;
constexpr size_t OFF_SEGA  = OFF_DEC + 524288;
constexpr size_t OFF_SEGH  = OFF_SEGA + 524288;
constexpr size_t OFF_XB    = 2 * SLOT;
constexpr size_t OFF_VC    = 2 * SLOT;
constexpr size_t OFF_XC    = 3 * SLOT;
constexpr size_t OFF_MIXP  = 2 * SLOT;
constexpr size_t OFF_LIST  = 2 * SLOT;
constexpr size_t OFF_HSH   = 2 * SLOT + 4194304;
constexpr size_t OFF_WLIST = 2 * SLOT + 4194304 + 8388608;
constexpr size_t OFF_PQ    = 4 * SLOT;
constexpr size_t OFF_PLF   = 5 * SLOT;
constexpr size_t OFF_PK    = 7 * SLOT;
constexpr size_t OFF_PV    = 8 * SLOT;
constexpr size_t OFF_YC    = 8 * SLOT;
constexpr size_t OFF_PG    = 9 * SLOT;
constexpr size_t OFF_PU    = 10 * SLOT;
constexpr size_t OFF_PXG   = 11 * SLOT;
constexpr size_t OFF_PXR   = 12 * SLOT;
constexpr size_t OFF_YB    = 12 * SLOT;
constexpr size_t OFF_PGATE = 13 * SLOT;
constexpr size_t OFF_KTT   = 19 * SLOT;
constexpr size_t OFF_YA    = 19 * SLOT;
constexpr size_t OFF_VT    = 20 * SLOT;
constexpr size_t OFF_ST    = 21 * SLOT;
constexpr size_t OFF_LA    = 23 * SLOT;
constexpr size_t OFF_BB    = 24 * SLOT;
constexpr size_t OFF_YG    = 25 * SLOT;
constexpr size_t OFF_HC    = 26 * SLOT;
constexpr size_t OFF_UT    = 27 * SLOT;
constexpr size_t OFF_PRELN = 4 * SLOT;
constexpr size_t OFF_XM    = 8 * SLOT;
constexpr size_t OFF_EW13  = 10 * SLOT;
constexpr size_t OFF_EW2   = 14 * SLOT;
constexpr size_t OFF_HBUF  = 4 * SLOT;
constexpr size_t OFF_YBUF  = 16 * SLOT;
constexpr size_t OFF_BAR   = 32 * SLOT;
constexpr int HLDS = 73728;
constexpr int LDS_BYTES = 2 * HLDS + 64;
constexpr int L_XST = 2 * HLDS;
constexpr size_t WS_NEED   = 32 * SLOT + 16384;

struct Params {
    const float* in[36];
    float* out;
    unsigned char* ws;
    int ph_lo, ph_hi;
    int coop, pad;
};
typedef const __attribute__((address_space(4))) Params CParams;

__device__ __forceinline__ u16 f2bf(float f) {
    unsigned u = __builtin_bit_cast(unsigned, f);
    return (u16)((u + 0x7fffu + ((u >> 16) & 1u)) >> 16);
}
__device__ __forceinline__ float bf2f(u16 h) { return __builtin_bit_cast(float, (unsigned)h << 16); }
__device__ __forceinline__ float sigm(float x) { return __builtin_amdgcn_rcpf(1.f + __expf(-x)); }
__device__ __forceinline__ float silu_f(float x) { return x * sigm(x); }
__device__ __forceinline__ float gelu_f(float x) {
    float u = 0.7978845608028654f * (x + 0.044715f * x * x * x);
    float t = 1.f - 2.f * __builtin_amdgcn_rcpf(1.f + __expf(2.f * u));
    return 0.5f * x * (1.f + t);
}
__device__ __forceinline__ float shfl_xor_l(float v, int o, int lane) {
    return __builtin_bit_cast(float, __builtin_amdgcn_ds_bpermute((lane ^ o) << 2, __builtin_bit_cast(int, v)));
}
__device__ __forceinline__ float wave_sum(float v, int lane) {
#pragma unroll
    for (int o = 32; o >= 1; o >>= 1) v += shfl_xor_l(v, o, lane);
    return v;
}
__device__ __forceinline__ int swz(int row, int ch) { return row * 128 + ((ch ^ ((row >> 1) & 7)) << 4); }


template <class T> __device__ __forceinline__ T ldg(const void* base, unsigned off) { return *(const T*)((const char*)base + off); }
template <class T> __device__ __forceinline__ void stg(void* base, unsigned off, T v) { *(T*)((char*)base + off) = v; }
template <class T> __device__ __forceinline__ void stg_nt(void* base, unsigned off, T v) { __builtin_nontemporal_store(v, (T*)((char*)base + off)); }

template <int TM, int TN, int RW, int CW, class F>
__device__ __forceinline__ void epi(f32x4 (&acc)[TM][TN], int wr, int wc, int fq, int fr, F f) {
#pragma unroll
    for (int m = 0; m < TM; ++m) {
#pragma unroll
        for (int j = 0; j < 4; ++j) {
#pragma unroll
            for (int n = 0; n < TN; ++n) f(wr * RW + m * 16 + fq * 4 + j, wc * CW + n * 16 + fr, acc[m][n][j]);
        }
        __builtin_amdgcn_sched_barrier(0);
    }
}

template <int TM, int TN, int RW, int CW, class F>
__device__ __forceinline__ void epiT(f32x4 (&acc)[TM][TN], int wr, int wc, int fq, int fr, F f) {
#pragma unroll
    for (int m = 0; m < TM; ++m) {
#pragma unroll
        for (int n = 0; n < TN; ++n) f(wr * RW + m * 16 + fr, wc * CW + n * 16 + fq * 4, acc[m][n]);
    }
}
__device__ __forceinline__ uint2 pack4(const f32x4& a) {
    uint2 w; w.x = f2bf(a[0]) | ((unsigned)f2bf(a[1]) << 16); w.y = f2bf(a[2]) | ((unsigned)f2bf(a[3]) << 16); return w;
}
__device__ __forceinline__ f32x4 unpack4(const uint2 q) {
    return f32x4{bf2f((u16)(q.x & 0xffff)), bf2f((u16)(q.x >> 16)), bf2f((u16)(q.y & 0xffff)), bf2f((u16)(q.y >> 16))};
}

__device__ __forceinline__ int otid() { int t = threadIdx.x & 255; asm volatile("" : "+v"(t)); return t; }
#define VB ((int)blockIdx.x * 2 + __builtin_amdgcn_readfirstlane((int)(threadIdx.x >> 8)))
#define VG ((int)gridDim.x * 2)

struct NoHook { __device__ __forceinline__ void operator()(int) const {} };

template <int BM, int BN, int WM, int WN, bool TR = false, class AL, class BL, class HK>
__device__ __forceinline__ void mma_loop(f32x4 (&acc)[BM / WM / 16][BN / WN / 16], int nk, AL aload, BL bload, HK hook, char* lds) {
    constexpr int TM = BM / WM / 16, TN = BN / WN / 16;
    constexpr int ACH = BM / 32, BCH = BN / 32;
    const int tid = otid(), lane = tid & 63, wid = tid >> 6;
    const int wr = wid / WN, wc = wid % WN, fr = lane & 15, fq = lane >> 4;
    const int srow = tid >> 3, sk = (tid & 7) * 8;
    const int swr = srow * 128 + (((tid & 7) ^ ((tid >> 4) & 7)) << 4);
    const int xr = (fr >> 1) & 7;
    const int a_rd = (wr * (BM / WM) + fr) * 128;
    const int b_rd = BM * 128 + (wc * (BN / WN) + fr) * 128;
    bf16x8 ra[ACH], rb[BCH];
#pragma unroll
    for (int i = 0; i < ACH; ++i) ra[i] = aload(srow + i * 32, sk);
#pragma unroll
    for (int i = 0; i < BCH; ++i) rb[i] = bload(srow + i * 32, sk);
#pragma unroll 1
    for (int t = 0; t < nk; ++t) {
        __syncthreads();
#pragma unroll
        for (int i = 0; i < ACH; ++i) *(bf16x8*)(lds + swr + i * 4096) = ra[i];
#pragma unroll
        for (int i = 0; i < BCH; ++i) *(bf16x8*)(lds + BM * 128 + swr + i * 4096) = rb[i];
        __syncthreads();
        if (t + 1 < nk) {
#pragma unroll
            for (int i = 0; i < ACH; ++i) ra[i] = aload(srow + i * 32, (t + 1) * 64 + sk);
#pragma unroll
            for (int i = 0; i < BCH; ++i) rb[i] = bload(srow + i * 32, (t + 1) * 64 + sk);
        }
        hook(t);
#pragma unroll
        for (int ks = 0; ks < 2; ++ks) {
            const int co = ((ks * 4 + fq) ^ xr) << 4;
            bf16x8 af[TM], bfr[TN];
#pragma unroll
            for (int m = 0; m < TM; ++m) af[m] = *(const bf16x8*)(lds + a_rd + m * 2048 + co);
#pragma unroll
            for (int n = 0; n < TN; ++n) bfr[n] = *(const bf16x8*)(lds + b_rd + n * 2048 + co);
#pragma unroll
            for (int m = 0; m < TM; ++m)
#pragma unroll
                for (int n = 0; n < TN; ++n) acc[m][n] = TR ? __builtin_amdgcn_mfma_f32_16x16x32_bf16(bfr[n], af[m], acc[m][n], 0, 0, 0)
                                                            : __builtin_amdgcn_mfma_f32_16x16x32_bf16(af[m], bfr[n], acc[m][n], 0, 0, 0);
        }
    }
}

template <int BM, int BN, int WM, int WN, bool TR = false, class AO, class BO, class HK>
__device__ __forceinline__ void mma_glds(f32x4 (&acc)[BM / WM / 16][BN / WN / 16], int nk, const unsigned char* ws, AO aoff, BO boff, HK hook, char* lds) {
    constexpr int TM = BM / WM / 16, TN = BN / WN / 16;
    constexpr int ACH = BM / 32, BCH = BN / 32, BUF = (BM + BN) * 128;
    const int tid = otid(), lane = tid & 63, wid = tid >> 6;
    const int wr = wid / WN, wc = wid % WN, fr = lane & 15, fq = lane >> 4;
    const int srow = tid >> 3;
    const unsigned csrc = (unsigned)(((tid & 7) ^ ((tid >> 4) & 7)) << 4);
    const int xr = (fr >> 1) & 7;
    const int a_rd = (wr * (BM / WM) + fr) * 128;
    const int b_rd = BM * 128 + (wc * (BN / WN) + fr) * 128;
    auto stage = [&](int buf, int t) {
        char* d = lds + buf * BUF + tid * 16;
#pragma unroll
        for (int i = 0; i < ACH; ++i)
            __builtin_amdgcn_global_load_lds((const unsigned*)(ws + (aoff(srow + i * 32, t) + csrc)), (unsigned*)(d + i * 4096), 16, 0, 0);
#pragma unroll
        for (int i = 0; i < BCH; ++i)
            __builtin_amdgcn_global_load_lds((const unsigned*)(ws + (boff(srow + i * 32, t) + csrc)), (unsigned*)(d + BM * 128 + i * 4096), 16, 0, 0);
    };
    __syncthreads();
    stage(0, 0);
#pragma unroll 1
    for (int t = 0; t < nk; ++t) {
        asm volatile("s_waitcnt vmcnt(0)" ::: "memory");
        __syncthreads();
        if (t + 1 < nk) stage((t + 1) & 1, t + 1);
        hook(t);
        const char* bb = lds + (t & 1) * BUF;
#pragma unroll
        for (int ks = 0; ks < 2; ++ks) {
            const int co = ((ks * 4 + fq) ^ xr) << 4;
            bf16x8 af[TM], bfr[TN];
#pragma unroll
            for (int m = 0; m < TM; ++m) af[m] = *(const bf16x8*)(bb + a_rd + m * 2048 + co);
#pragma unroll
            for (int n = 0; n < TN; ++n) bfr[n] = *(const bf16x8*)(bb + b_rd + n * 2048 + co);
#pragma unroll
            for (int m = 0; m < TM; ++m)
#pragma unroll
                for (int n = 0; n < TN; ++n) acc[m][n] = TR ? __builtin_amdgcn_mfma_f32_16x16x32_bf16(bfr[n], af[m], acc[m][n], 0, 0, 0)
                                                            : __builtin_amdgcn_mfma_f32_16x16x32_bf16(af[m], bfr[n], acc[m][n], 0, 0, 0);
        }
    }
}

#define ZERO_ACC(acc, TM, TN) _Pragma("unroll") for (int m_ = 0; m_ < TM; ++m_) _Pragma("unroll") for (int n_ = 0; n_ < TN; ++n_) acc[m_][n_] = f32x4{0.f, 0.f, 0.f, 0.f}

#define LANE_IDS const int tid = otid(), lane = tid & 63, wid = tid >> 6, fr = lane & 15, fq = lane >> 4; (void)tid; (void)lane; (void)wid; (void)fr; (void)fq

namespace g8 {
constexpr int BM = 256, BK = 64, HALF = 128, HTB = HALF * BK * 2, STAGE_BYTES = 8 * HTB;
__device__ __forceinline__ int lds_byte(int r, int c) { const int st = (r >> 4) * 2 + (c >> 5), rr = r & 15, cc = c & 31, ob = rr * 64 + cc * 2; return st * 1024 + (ob ^ (((ob >> 9) & 1) << 5)); }
__device__ __forceinline__ void stage_rc(int b, int& R, int& C) { const int st = b / 1024, sb = b % 1024, swz = sb ^ (((sb >> 9) & 1) << 5); R = (st >> 1) * 16 + swz / 64; C = (st & 1) * 32 + (swz % 64) / 2; }
__device__ __forceinline__ int perm32(int rho) { const int n = rho >> 4, i = rho & 15; return 8 * (i >> 2) + 4 * n + (i & 3); }
struct Unit { unsigned A, B; int pm, pn, x0, x1; };
__device__ __forceinline__ unsigned cvt_pk_bf16(float lo, float hi) { unsigned r; asm volatile("v_cvt_pk_bf16_f32 %0, %1, %2" : "=v"(r) : "v"(lo), "v"(hi)); return r; }

template <class Epi, class Sched, bool GATHER>
__device__ __forceinline__ void gemm_phase(LAS unsigned char* lds, const unsigned char* wsb, const int K, const Sched& S, const Epi& E) {
    int tid_ = threadIdx.x; asm volatile("" : "+v"(tid_));
    const int tid = tid_, wid = __builtin_amdgcn_readfirstlane(tid >> 6), lane = tid & 63, wr = wid >> 2, wc = wid & 3, fr = lane & 15, fq = lane >> 4;
    const int nt = K / BK;
    unsigned voffA[2], voffB[2];
#pragma unroll
    for (int i = 0; i < 2; ++i) { int R, C; stage_rc(tid * 16 + i * 8192, R, C); const int Rb = Epi::PERM ? ((R & ~31) + perm32(R & 31)) : R;
        voffA[i] = (unsigned)(R * K + C) * 2u; voffB[i] = (unsigned)(Rb * K + C) * 2u; }
    const unsigned kstep = (unsigned)(BK * 2);
    const unsigned hstep = (unsigned)(HALF * K * 2);
    const unsigned ldsw = (unsigned)wid * 1024u;
    const int aoff = lds_byte(wr * 64 + fr, fq * 8), boff = lds_byte(wc * 32 + fr, fq * 8);
#define G8_SA(b, h) (((b) * 2 + (h)) * HTB)
#define G8_SB(b, h) ((4 + (b) * 2 + (h)) * HTB)
#define G8_STAGE(bufoff, gbase, voff) do { _Pragma("unroll") for (int _i = 0; _i < 2; ++_i) \
        __builtin_amdgcn_global_load_lds((const unsigned*)(wsb + (unsigned)((gbase) + (voff)[_i])), (LAS unsigned*)(lds + (bufoff) + ldsw + _i * 8192), 16, 0, 0); } while (0)
#define G8_STAGE_A(bufoff, kp, h, vg) do { if (GATHER) G8_STAGE(bufoff, kp, vg[h]); else G8_STAGE(bufoff, (kp) + (h) * hstep, voffA); } while (0)
#define G8_LDA(dst, b, h) do { _Pragma("unroll") for (int m = 0; m < 4; ++m) _Pragma("unroll") for (int k = 0; k < 2; ++k) dst[m][k] = *(const LAS bf16x8*)(lds + G8_SA(b, h) + aoff + m * 2048 + k * 1024); } while (0)
#define G8_LDB(dst, b, h) do { _Pragma("unroll") for (int n = 0; n < 2; ++n) _Pragma("unroll") for (int k = 0; k < 2; ++k) dst[n][k] = *(const LAS bf16x8*)(lds + G8_SB(b, h) + boff + n * 2048 + k * 1024); } while (0)
#define G8_MMA(ai, bj, At, Bt) do { __builtin_amdgcn_s_setprio(1); _Pragma("unroll") for (int m = 0; m < 4; ++m) _Pragma("unroll") for (int n = 0; n < 2; ++n) _Pragma("unroll") for (int k = 0; k < 2; ++k) \
        acc[ai][bj][m][n] = __builtin_amdgcn_mfma_f32_16x16x32_bf16(Bt[n][k], At[m][k], acc[ai][bj][m][n], 0, 0, 0); __builtin_amdgcn_s_setprio(0); } while (0)
#define G8_WAIT_V(n) asm volatile("s_waitcnt vmcnt(" #n ")" ::: "memory")
#define G8_WAIT_L(n) asm volatile("s_waitcnt lgkmcnt(" #n ")" ::: "memory")
#define G8_BAR __builtin_amdgcn_s_barrier()
#define G8_SCHED __builtin_amdgcn_sched_barrier(0)
#define G8_GOFF(dst, u) do { _Pragma("unroll") for (int _i = 0; _i < 2; ++_i) { int _R, _C; stage_rc(tid * 16 + _i * 8192, _R, _C); \
        _Pragma("unroll") for (int _h = 0; _h < 2; ++_h) dst[_h][_i] = (unsigned)(S.row(u, _h * HALF + _R) * K + _C) * 2u; } \
        asm volatile("" : "+v"(dst[0][0]), "+v"(dst[0][1]), "+v"(dst[1][0]), "+v"(dst[1][1])); } while (0)
    Unit cur, nxt; int ui = 0;
    if (!S.next(0, cur)) return;
    f32x4 acc[2][2][4][2];
#pragma unroll
    for (int a = 0; a < 2; ++a)
#pragma unroll
        for (int b = 0; b < 2; ++b)
#pragma unroll
            for (int m = 0; m < 4; ++m)
#pragma unroll
                for (int n = 0; n < 2; ++n) acc[a][b][m][n] = (f32x4){0.f, 0.f, 0.f, 0.f};
    bf16x8 At[4][2], B0[2][2], B1[2][2];
    unsigned vgc[2][2] = {{0u, 0u}, {0u, 0u}};
    LAS u32x4* gslot = (LAS u32x4*)(lds + STAGE_BYTES + 4096) + tid;
    unsigned cA = cur.A, cB = cur.B;
    if (GATHER) { G8_GOFF(vgc, cur); }
    G8_STAGE(G8_SB(0, 0), cB, voffB); G8_STAGE_A(G8_SA(0, 0), cA, 0, vgc); G8_STAGE(G8_SB(0, 1), cB + hstep, voffB); G8_STAGE_A(G8_SA(0, 1), cA, 1, vgc);
    if (wr == 1) G8_BAR;
    G8_WAIT_V(4); G8_BAR;
    G8_STAGE(G8_SB(1, 0), cB + kstep, voffB); G8_STAGE_A(G8_SA(1, 0), cA + kstep, 0, vgc); G8_STAGE(G8_SB(1, 1), cB + hstep + kstep, voffB);
    G8_WAIT_V(6); G8_BAR;
    for (;;) {
        const bool has_next = S.next(ui + 1, nxt);
        const unsigned nA = has_next ? nxt.A : cA, nB = has_next ? nxt.B : cB;
        if (GATHER && has_next) {
            unsigned vt[2][2]; G8_GOFF(vt, nxt);
            *gslot = u32x4{vt[0][0], vt[0][1], vt[1][0], vt[1][1]};
        }
        unsigned long long tk0 = 0;
        if (Epi::TIMEK) tk0 = __builtin_amdgcn_s_memrealtime();
#pragma unroll 1
        for (int t = 0; t < nt; t += 2) {
            const bool last = (t == nt - 2);
            const unsigned a1 = cA + (unsigned)(t + 1) * kstep;
            const unsigned a2 = last ? nA : cA + (unsigned)(t + 2) * kstep, b2 = last ? nB : cB + (unsigned)(t + 2) * kstep;
            const unsigned a3 = a2 + kstep, b3 = b2 + kstep;
            G8_LDB(B0, 0, 0); G8_SCHED; G8_LDA(At, 0, 0); G8_STAGE_A(G8_SA(1, 1), a1, 1, vgc);
            G8_WAIT_L(8); G8_BAR; G8_WAIT_L(0); G8_MMA(0, 0, At, B0); G8_BAR; G8_SCHED;
            G8_LDB(B1, 0, 1);
            if (GATHER && last && has_next) { const u32x4 x = *gslot; vgc[0][0] = x[0]; vgc[0][1] = x[1]; vgc[1][0] = x[2]; vgc[1][1] = x[3]; }
            G8_STAGE(G8_SB(0, 0), b2, voffB);
            G8_BAR; G8_WAIT_L(0); G8_MMA(0, 1, At, B1); G8_BAR;
            G8_LDA(At, 0, 1); G8_STAGE_A(G8_SA(0, 0), a2, 0, vgc);
            G8_BAR; G8_WAIT_L(0); G8_MMA(1, 0, At, B0); G8_BAR; G8_SCHED;
            G8_STAGE(G8_SB(0, 1), b2 + hstep, voffB);
            G8_WAIT_V(6); G8_BAR; G8_MMA(1, 1, At, B1); G8_BAR;
            G8_LDB(B0, 1, 0); G8_SCHED; G8_LDA(At, 1, 0); G8_STAGE_A(G8_SA(0, 1), a2, 1, vgc);
            G8_WAIT_L(8); G8_BAR; G8_WAIT_L(0); G8_MMA(0, 0, At, B0); G8_BAR; G8_SCHED;
            G8_LDB(B1, 1, 1); G8_STAGE(G8_SB(1, 0), b3, voffB);
            G8_BAR; G8_WAIT_L(0); G8_MMA(0, 1, At, B1); G8_BAR;
            G8_LDA(At, 1, 1); G8_STAGE_A(G8_SA(1, 0), a3, 0, vgc);
            G8_BAR; G8_WAIT_L(0); G8_MMA(1, 0, At, B0); G8_BAR; G8_SCHED;
            G8_STAGE(G8_SB(1, 1), b3 + hstep, voffB);
            G8_WAIT_V(6); G8_BAR; G8_MMA(1, 1, At, B1); G8_BAR;
        }
        if (Epi::TIMEK && tid == 0) { const unsigned dt = (unsigned)(__builtin_amdgcn_s_memrealtime() - tk0); *(LAS unsigned*)(lds + 147456 + 32) += dt; }
        const bool keep = E(acc, cur, wr, wc, fr, fq);
        if (!has_next) break;
        if (!keep) {
#pragma unroll
        for (int a = 0; a < 2; ++a)
#pragma unroll
            for (int b = 0; b < 2; ++b)
#pragma unroll
                for (int m = 0; m < 4; ++m)
#pragma unroll
                    for (int n = 0; n < 2; ++n) acc[a][b][m][n] = (f32x4){0.f, 0.f, 0.f, 0.f};
        }
        cur = nxt; cA = nA; cB = nB; ++ui;
    }
    G8_WAIT_V(0);
    if (wr == 0) G8_BAR;
    G8_BAR;
#undef G8_SA
#undef G8_SB
#undef G8_STAGE
#undef G8_STAGE_A
#undef G8_LDA
#undef G8_LDB
#undef G8_MMA
#undef G8_WAIT_V
#undef G8_WAIT_L
#undef G8_BAR
#undef G8_SCHED
#undef G8_GOFF
}
}

__device__ __forceinline__ u32x4 pack8v(const f32x4& a, const f32x4& b) {
    u32x4 w; w[0] = g8::cvt_pk_bf16(a[0], a[1]); w[1] = g8::cvt_pk_bf16(a[2], a[3]); w[2] = g8::cvt_pk_bf16(b[0], b[1]); w[3] = g8::cvt_pk_bf16(b[2], b[3]); return w;
}
__device__ __forceinline__ uint4 pack8(const f32x4& a, const f32x4& b) {
    uint4 w; w.x = g8::cvt_pk_bf16(a[0], a[1]); w.y = g8::cvt_pk_bf16(a[2], a[3]); w.z = g8::cvt_pk_bf16(b[0], b[1]); w.w = g8::cvt_pk_bf16(b[2], b[3]); return w;
}

struct ProjSched {
    unsigned A, B; int c, G;
    __device__ __forceinline__ bool next(int i, g8::Unit& u) const {
        const int L = i * G + c; if (L >= 64 * 26) return false;
        const int xcd = L & 7, jx = L >> 3;
        u.pm = xcd * 8 + (jx & 7); u.pn = jx >> 3;
        u.A = A + (unsigned)u.pm * 256 * DM * 2; u.B = B + (unsigned)u.pn * 256 * DM * 2; u.x0 = 0; u.x1 = 0; return true;
    }
    __device__ __forceinline__ int row(const g8::Unit&, int) const { return 0; }
};
struct ProjEpi {
    static constexpr bool TIMEK = PROBE_TIMEK_ProjEpi;
    static constexpr bool PERM = true;
    unsigned char* ws; const float* bg;
    __device__ __forceinline__ bool operator()(f32x4 (&acc)[2][2][4][2], const g8::Unit& u, int wr, int wc, int fr, int fq) const {
        const int seg = (u.pn * 256) >> 9;
        f32x4 cc[2][2];
#pragma unroll
        for (int bj = 0; bj < 2; ++bj) {
            const int col = u.pn * 256 + bj * 128 + wc * 32 + fq * 8;
            if (seg == 1) { cc[bj][0] = ldg<f32x4>(ws, (unsigned)(OFF_LB + (col & 511) * 4)); cc[bj][1] = ldg<f32x4>(ws, (unsigned)(OFF_LB + (col & 511) * 4 + 16)); }
            else if (seg >= 7) { cc[bj][0] = *(const f32x4*)(bg + col - 3584); cc[bj][1] = *(const f32x4*)(bg + col - 3584 + 4); }
            else { cc[bj][0] = f32x4{0.f, 0.f, 0.f, 0.f}; cc[bj][1] = cc[bj][0]; }
        }
#pragma unroll
        for (int ai = 0; ai < 2; ++ai)
#pragma unroll
            for (int m = 0; m < 4; ++m) {
                const int row = u.pm * 256 + ai * 128 + wr * 64 + m * 16 + fr;
#pragma unroll
                for (int bj = 0; bj < 2; ++bj) {
                    const int col = u.pn * 256 + bj * 128 + wc * 32 + fq * 8;
                    const int c = col & 511;
                    f32x4 v0 = acc[ai][bj][m][0], v1 = acc[ai][bj][m][1];
                    if (seg == 0 || seg == 3) {
#pragma unroll
                        for (int i = 0; i < 4; ++i) { v0[i] = silu_f(v0[i]); v1[i] = silu_f(v1[i]); }
                        stg<uint4>(ws, (unsigned)((seg == 0 ? OFF_PQ : OFF_PG) + (row * 512 + c) * 2), pack8(v0, v1));
                    } else if (seg == 1) {
                        const f32x4 l0 = cc[bj][0], l1 = cc[bj][1];
                        f32x4 g0, g1, k0, k1;
#pragma unroll
                        for (int i = 0; i < 4; ++i) {
                            const float s0 = sigm(v0[i]), s1 = sigm(v1[i]);
                            g0[i] = __logf(l0[i] + (1.f - l0[i]) * s0); g1[i] = __logf(l1[i] + (1.f - l1[i]) * s1);
                            k0[i] = (1.f - l0[i]) * (1.f - s0); k1[i] = (1.f - l1[i]) * (1.f - s1);
                        }
                        stg<f32x4>(ws, (unsigned)(OFF_PLF + (row * 512 + c) * 4), g0);
                        stg<f32x4>(ws, (unsigned)(OFF_PLF + (row * 512 + c) * 4 + 16), g1);
                        stg<uint4>(ws, (unsigned)(OFF_PK + (row * 512 + c) * 2), pack8(k0, k1));
                    } else if (seg == 2 || seg == 6) {
                        stg<uint4>(ws, (unsigned)((seg == 2 ? OFF_PV : OFF_PXR) + (row * 512 + c) * 2), pack8(v0, v1));
                    } else if (seg == 4) {
                        stg<uint4>(ws, (unsigned)(OFF_PU + (((c >> 4) * NTOK + row) * 16 + (c & 15)) * 2), pack8(v0, v1));
                    } else if (seg == 5) {
#pragma unroll
                        for (int i = 0; i < 4; ++i) { v0[i] = gelu_f(v0[i]); v1[i] = gelu_f(v1[i]); }
                        stg<uint4>(ws, (unsigned)(OFF_PXG + (row * 512 + c) * 2), pack8(v0, v1));
                    } else {
                        const int gc = col - 3584;
#pragma unroll
                        for (int i = 0; i < 4; ++i) { v0[i] = sigm(v0[i] + cc[bj][0][i]); v1[i] = sigm(v1[i] + cc[bj][1][i]); }
                        stg<uint4>(ws, (unsigned)(OFF_PGATE + (row * 3072 + gc) * 2), pack8(v0, v1));
                    }
                }
            }
        return false;
    }
};
__device__ void phase_proj(CParams& p, int l, char* lds) {
    ProjSched S; S.A = (unsigned)OFF_XB; S.B = (unsigned)OFF_WINT; S.c = blockIdx.x; S.G = gridDim.x;
    ProjEpi E; E.ws = p.ws; E.bg = p.in[2] + (size_t)l * 3072;
    g8::gemm_phase<ProjEpi, ProjSched, false>((LAS unsigned char*)lds, p.ws, 1024, S, E);
}

struct OutSched {
    unsigned A, B; int c, G;
    __device__ __forceinline__ bool next(int i, g8::Unit& u) const {
        const int L = i * G + c; if (L >= 64 * 4) return false;
        const int xcd = L & 7, jx = L >> 3;
        u.pm = xcd * 8 + (jx & 7); u.pn = jx >> 3;
        u.A = A + (unsigned)u.pm * 256 * 1024 * 2; u.B = B + (unsigned)u.pn * 256 * 1024 * 2; u.x0 = 0; u.x1 = 0; return true;
    }
    __device__ __forceinline__ int row(const g8::Unit&, int) const { return 0; }
};
struct OutEpi {
    static constexpr bool TIMEK = PROBE_TIMEK_OutEpi;
    static constexpr bool PERM = false;
    unsigned char* ws; const float* xres;
    __device__ __forceinline__ bool operator()(f32x4 (&acc)[2][2][4][2], const g8::Unit& u, int wr, int wc, int fr, int fq) const {
#pragma unroll
        for (int ai = 0; ai < 2; ++ai) {
            f32x4 x[4][2][2];
#pragma unroll
            for (int m = 0; m < 4; ++m)
#pragma unroll
                for (int bj = 0; bj < 2; ++bj)
#pragma unroll
                    for (int n = 0; n < 2; ++n) {
                        const int row = u.pm * 256 + ai * 128 + wr * 64 + m * 16 + fr, col = u.pn * 256 + bj * 128 + wc * 32 + n * 16 + fq * 4;
                        x[m][bj][n] = ldg<f32x4>(xres, (unsigned)((row * 1024 + col) * 4));
                    }
#pragma unroll
            for (int m = 0; m < 4; ++m)
#pragma unroll
                for (int bj = 0; bj < 2; ++bj)
#pragma unroll
                    for (int n = 0; n < 2; ++n) {
                        const int row = u.pm * 256 + ai * 128 + wr * 64 + m * 16 + fr, col = u.pn * 256 + bj * 128 + wc * 32 + n * 16 + fq * 4;
                        stg<f32x4>(ws, (unsigned)OFF_PRELN + (unsigned)((row * 1024 + col) * 4), x[m][bj][n] * DN_ALPHA + acc[ai][bj][m][n]);
                    }
        }
        return false;
    }
};

struct BrSched {
    int c;
    __device__ __forceinline__ bool next(int i, g8::Unit& u) const {
        if (i >= 3) return false;
        const int xcd = c & 7, jx = c >> 3;
        u.pm = xcd * 8 + (jx & 7); u.pn = jx >> 3; u.x0 = i; u.x1 = 0;
        u.A = (unsigned)(i == 0 ? OFF_YA : (i == 1 ? OFF_YB : OFF_YC)) + (unsigned)u.pm * 256 * 512 * 2;
        u.B = (unsigned)OFF_WBRT + (unsigned)i * 1024 * 512 * 2 + (unsigned)u.pn * 256 * 512 * 2;
        return true;
    }
    __device__ __forceinline__ int row(const g8::Unit&, int) const { return 0; }
};
struct BrEpi {
    static constexpr bool TIMEK = PROBE_TIMEK_BrEpi;
    static constexpr bool PERM = true;
    unsigned char* ws;
    __device__ __forceinline__ bool operator()(f32x4 (&acc)[2][2][4][2], const g8::Unit& u, int wr, int wc, int fr, int fq) const {
        const int k = u.x0;
#pragma unroll
        for (int ai = 0; ai < 2; ++ai) {
            uint4 gq[4][2], gn[4][2];
#pragma unroll
            for (int m = 0; m < 4; ++m)
#pragma unroll
                for (int bj = 0; bj < 2; ++bj) {
                    const int row = u.pm * 256 + ai * 128 + wr * 64 + m * 16 + fr, col = u.pn * 256 + bj * 128 + wc * 32 + fq * 8;
                    const unsigned go = (unsigned)(OFF_PGATE + (row * 3072 + k * 1024 + col) * 2);
                    gq[m][bj] = ldg<uint4>(ws, go);
                    gn[m][bj] = (k < 2) ? ldg<uint4>(ws, go + 2048) : uint4{0x3f803f80u, 0x3f803f80u, 0x3f803f80u, 0x3f803f80u};
                }
#pragma unroll
            for (int m = 0; m < 4; ++m)
#pragma unroll
                for (int bj = 0; bj < 2; ++bj) {
                    const int row = u.pm * 256 + ai * 128 + wr * 64 + m * 16 + fr, col = u.pn * 256 + bj * 128 + wc * 32 + fq * 8;
                    const uint4 q = gq[m][bj], nx = gn[m][bj];
                    float s[8] = {bf2f((u16)(q.x & 0xffff)), bf2f((u16)(q.x >> 16)), bf2f((u16)(q.y & 0xffff)), bf2f((u16)(q.y >> 16)),
                                  bf2f((u16)(q.z & 0xffff)), bf2f((u16)(q.z >> 16)), bf2f((u16)(q.w & 0xffff)), bf2f((u16)(q.w >> 16))};
                    s[0] *= __builtin_amdgcn_rcpf(bf2f((u16)(nx.x & 0xffff))); s[1] *= __builtin_amdgcn_rcpf(bf2f((u16)(nx.x >> 16)));
                    s[2] *= __builtin_amdgcn_rcpf(bf2f((u16)(nx.y & 0xffff))); s[3] *= __builtin_amdgcn_rcpf(bf2f((u16)(nx.y >> 16)));
                    s[4] *= __builtin_amdgcn_rcpf(bf2f((u16)(nx.z & 0xffff))); s[5] *= __builtin_amdgcn_rcpf(bf2f((u16)(nx.z >> 16)));
                    s[6] *= __builtin_amdgcn_rcpf(bf2f((u16)(nx.w & 0xffff))); s[7] *= __builtin_amdgcn_rcpf(bf2f((u16)(nx.w >> 16)));
#pragma unroll
                    for (int i = 0; i < 4; ++i) { acc[ai][bj][m][0][i] *= s[i]; acc[ai][bj][m][1][i] *= s[4 + i]; }
                    if (k == 2) stg<uint4>(ws, (unsigned)(OFF_MIXP + (row * 1024 + col) * 2), pack8(acc[ai][bj][m][0], acc[ai][bj][m][1]));
                }
        }
        return k < 2;
    }
};

struct MoeSched {
    const int* sm; const unsigned char* ws; unsigned A, Bexp, Bsh, Ash;
    int c, G, npn, K, bstride_e, gather, nsh;
    __device__ __forceinline__ bool next(int i, g8::Unit& u) const {
        int nbr = __builtin_amdgcn_readfirstlane(sm[64]); asm volatile("" : "+s"(nbr));
        const int L = i * G + c; if (L >= (nbr + nsh) * npn) return false;
        const int blk = L / npn; u.pn = L - blk * npn;
        if (blk >= nbr) {
            u.x0 = 64; u.pm = blk - nbr; u.x1 = NTOK;
            u.A = gather ? A : Ash + (unsigned)u.pm * 256 * K * 2;
            u.B = Bsh + (unsigned)u.pn * 256 * K * 2;
        } else {
            int e = __builtin_amdgcn_readfirstlane(sm[256 + blk]);
            int be = __builtin_amdgcn_readfirstlane(sm[e]), re = __builtin_amdgcn_readfirstlane(sm[65 + e]), ce = __builtin_amdgcn_readfirstlane(sm[130 + e]);
            asm volatile("" : "+s"(e), "+s"(be), "+s"(re), "+s"(ce));
            u.x0 = e; u.pm = blk - be; u.x1 = ce;
            u.A = gather ? A : A + (unsigned)(re + u.pm * 256) * K * 2;
            u.B = Bexp + (unsigned)e * bstride_e + (unsigned)u.pn * 256 * K * 2;
        }
        return true;
    }
    __device__ __forceinline__ int row(const g8::Unit& u, int r) const {
        const int rr = u.pm * 256 + r;
        if (u.x0 == 64) return rr;
        return (rr < u.x1) ? (ldg<int>(ws, (unsigned)(OFF_LIST + (u.x0 * NTOK + rr) * 4)) >> 3) : 0;
    }
};
__device__ __forceinline__ void moe_setup(CParams& p, int* sm) {
    __syncthreads();
    if (threadIdx.x == 0) {
        const int* cursor = (const int*)(p.ws + OFF_CUR);
        int nb = 0, nr = 0;
        for (int e = 0; e < 64; ++e) { sm[e] = nb; sm[65 + e] = nr; int c = cursor[e]; sm[130 + e] = c; nb += (c + 255) >> 8; nr += c; }
        sm[64] = nb; sm[129] = nr;
    }
    __syncthreads();
    if (threadIdx.x < 64) { const int e = threadIdx.x; for (int k = sm[e]; k < sm[e + 1]; ++k) sm[256 + k] = e; }
    __syncthreads();
}
struct Moe1Epi {
    static constexpr bool TIMEK = PROBE_TIMEK_Moe1Epi;
    static constexpr bool PERM = false;
    unsigned char* ws; const int* sm;
    __device__ __forceinline__ bool operator()(f32x4 (&acc)[2][2][4][2], const g8::Unit& u, int wr, int wc, int fr, int fq) const {
        const int rbase = (u.x0 == 64) ? 0 : __builtin_amdgcn_readfirstlane(sm[65 + (u.x0 & 63)]);
        const unsigned hoff = (unsigned)((u.x0 == 64) ? OFF_HSH + (size_t)u.pm * 256 * 256 * 2 : OFF_HBUF + (size_t)(rbase + u.pm * 256) * 256 * 2);
        const int valid = u.x1 - u.pm * 256;
        float rw[2][4];
        const unsigned wb = (unsigned)(OFF_WLIST + ((u.x0 & 63) * NTOK + u.pm * 256 + wr * 64 + fr) * 4);
#pragma unroll
        for (int ai = 0; ai < 2; ++ai)
#pragma unroll
            for (int m = 0; m < 4; ++m) {
                const int r = ai * 128 + wr * 64 + m * 16 + fr;
                rw[ai][m] = (u.x0 != 64 && r < valid) ? ldg<float>(ws, wb + (unsigned)((ai * 128 + m * 16) * 4)) : 1.f;
            }
#pragma unroll
        for (int ai = 0; ai < 2; ++ai)
#pragma unroll
            for (int m = 0; m < 4; ++m) {
                const int r = ai * 128 + wr * 64 + m * 16 + fr;
                const float w = rw[ai][m];
#pragma unroll
                for (int bj = 0; bj < 2; ++bj) {
                    const int hid = ((u.pn * 256 + bj * 128 + wc * 32) >> 1) + fq * 4;
                    const f32x4 a = acc[ai][bj][m][0], b = acc[ai][bj][m][1] * w;
                    uint2 pk;
                    pk.x = g8::cvt_pk_bf16(silu_f(a[0]) * b[0], silu_f(a[1]) * b[1]);
                    pk.y = g8::cvt_pk_bf16(silu_f(a[2]) * b[2], silu_f(a[3]) * b[3]);
                    if (r < valid) stg<uint2>(ws, hoff + (unsigned)(r * 256 + hid) * 2u, pk);
                }
                __builtin_amdgcn_sched_barrier(0);
            }
        return false;
    }
};
__device__ void phase_moe1(CParams& p, int l, char* lds) {
    int* sm = (int*)(lds + g8::STAGE_BYTES);
    moe_setup(p, sm);
    MoeSched S; S.sm = sm; S.ws = p.ws;
    S.A = (unsigned)OFF_XM; S.Ash = S.A; S.Bexp = (unsigned)OFF_EW13; S.Bsh = (unsigned)OFF_SH13T;
    S.c = (blockIdx.x & 7) * 32 + (blockIdx.x >> 3); S.G = gridDim.x; S.npn = 2; S.K = 1024; S.bstride_e = 512 * 1024 * 2; S.gather = 1; S.nsh = 64;
    Moe1Epi E; E.ws = p.ws; E.sm = sm;
    g8::gemm_phase<Moe1Epi, MoeSched, true>((LAS unsigned char*)lds, p.ws, 1024, S, E);
}
struct Moe2Epi {
    static constexpr bool TIMEK = PROBE_TIMEK_Moe2Epi;
    static constexpr bool PERM = true;
    unsigned char* ws;
    __device__ __forceinline__ bool operator()(f32x4 (&acc)[2][2][4][2], const g8::Unit& u, int wr, int wc, int fr, int fq) const {
        const int valid = u.x1 - u.pm * 256;
        const int colb = u.pn * 256 + wc * 32 + fq * 8;
        const unsigned lbase = (unsigned)(OFF_LIST + (u.x0 * NTOK + u.pm * 256 + wr * 64 + fr) * 4);
        int ent[2][4];
#pragma unroll
        for (int ai = 0; ai < 2; ++ai)
#pragma unroll
            for (int m = 0; m < 4; ++m) {
                const int r = ai * 128 + wr * 64 + m * 16 + fr;
                ent[ai][m] = (r < valid) ? ldg<int>(ws, lbase + (unsigned)((ai * 128 + m * 16) * 4)) : 0;
            }
#pragma unroll
        for (int ai = 0; ai < 2; ++ai)
#pragma unroll
            for (int m = 0; m < 4; ++m) {
                const int r = ai * 128 + wr * 64 + m * 16 + fr;
                if (r < valid) {
                    const unsigned o = (unsigned)OFF_YBUF + (unsigned)(ent[ai][m] * 1024 + colb);
#pragma unroll
                    for (int bj = 0; bj < 2; ++bj) {
                        const f32x4 a = acc[ai][bj][m][0] * 32.f, b = acc[ai][bj][m][1] * 32.f;
                        int w0 = __builtin_amdgcn_cvt_pk_fp8_f32(a[0], a[1], 0, false); w0 = __builtin_amdgcn_cvt_pk_fp8_f32(a[2], a[3], w0, true);
                        int w1 = __builtin_amdgcn_cvt_pk_fp8_f32(b[0], b[1], 0, false); w1 = __builtin_amdgcn_cvt_pk_fp8_f32(b[2], b[3], w1, true);
                        stg<uint2>(ws, o + bj * 128, uint2{(unsigned)w0, (unsigned)w1});
                    }
                }
                __builtin_amdgcn_sched_barrier(0);
            }
        return false;
    }
};
struct ShSched {
    int c, G;
    __device__ __forceinline__ bool next(int i, g8::Unit& u) const {
        const int L = i * G + c; if (L >= 64 * 4) return false;
        u.pm = L >> 2; u.pn = L & 3; u.A = (unsigned)OFF_HSH + (unsigned)u.pm * 256 * 256 * 2; u.B = (unsigned)OFF_SH2T + (unsigned)u.pn * 256 * 256 * 2; u.x0 = 64; u.x1 = NTOK; return true;
    }
    __device__ __forceinline__ int row(const g8::Unit&, int) const { return 0; }
};
struct ShEpi {
    static constexpr bool TIMEK = PROBE_TIMEK_ShEpi;
    static constexpr bool PERM = false;
    float* ysh;
    __device__ __forceinline__ bool operator()(f32x4 (&acc)[2][2][4][2], const g8::Unit& u, int wr, int wc, int fr, int fq) const {
#pragma unroll
        for (int ai = 0; ai < 2; ++ai)
#pragma unroll
            for (int m = 0; m < 4; ++m) {
                const int row = u.pm * 256 + ai * 128 + wr * 64 + m * 16 + fr;
#pragma unroll
                for (int bj = 0; bj < 2; ++bj)
#pragma unroll
                    for (int n = 0; n < 2; ++n)
                        stg<f32x4>(ysh, (unsigned)((row * 1024 + u.pn * 256 + bj * 128 + wc * 32 + n * 16 + fq * 4) * 4), acc[ai][bj][m][n]);
                __builtin_amdgcn_sched_barrier(0);
            }
        return false;
    }
};
__device__ void phase_moe2(CParams& p, int l, char* lds) {
    int* sm = (int*)(lds + g8::STAGE_BYTES);
    moe_setup(p, sm);
    MoeSched S; S.sm = sm; S.ws = p.ws;
    S.A = (unsigned)OFF_HBUF; S.Ash = (unsigned)OFF_HSH; S.Bexp = (unsigned)OFF_EW2; S.Bsh = (unsigned)OFF_SH2T;
    S.c = (blockIdx.x & 7) * 32 + (blockIdx.x >> 3); S.G = gridDim.x; S.npn = 4; S.K = 256; S.bstride_e = 1024 * 256 * 2; S.gather = 0; S.nsh = 0;
    Moe2Epi E; E.ws = p.ws;
    g8::gemm_phase<Moe2Epi, MoeSched, false>((LAS unsigned char*)lds, p.ws, 256, S, E);
    ShSched S2; S2.c = (blockIdx.x & 7) * 32 + (blockIdx.x >> 3); S2.G = gridDim.x;
    ShEpi E2; E2.ysh = p.out;
    g8::gemm_phase<ShEpi, ShSched, false>((LAS unsigned char*)lds, p.ws, 256, S2, E2);
}

__device__ void conv_tile(const float* s1, const float* s2, int ldsrc, int K, int perm, u16* dst, int tile, float* lds) {
    const int tid = otid();
    const int ktiles = K >> 6;
    const int kt = tile % ktiles, nt = tile / ktiles;
    __syncthreads();
#pragma unroll 4
    for (int i = 0; i < 16; ++i) {
        int idx = tid + i * 256, kr = idx >> 6, nc = idx & 63;
        const float* s; int col;
        if (perm == 32) { s = (nc < 32) ? s1 : s2; col = nt * 32 + (nc & 31); }
        else if (perm == 16) { s = ((nc & 31) < 16) ? s1 : s2; col = (nt * 2 + (nc >> 5)) * 16 + (nc & 15); }
        else { s = s1; col = nt * 64 + nc; }
        lds[kr * 65 + nc] = s[(size_t)(kt * 64 + kr) * ldsrc + col];
    }
    __syncthreads();
#pragma unroll 4
    for (int i = 0; i < 16; ++i) {
        int idx = tid + i * 256, nr = idx >> 6, kc = idx & 63;
        dst[(size_t)(nt * 64 + nr) * K + kt * 64 + kc] = f2bf(lds[kc * 65 + nr]);
    }
}

__device__ void s5_precompute(CParams& p, int l, int g, int part, float* lds) {
    const int tid = otid();
    float* Er = lds;
    float* Ei = Er + 64 * 17;
    float* Br = Ei + 64 * 17;
    float* Bi = Br + 1024;
    float* Cr = Bi + 1024;
    float* Ci = Cr + 1024;
    float* Kt = Ci + 1024;
    __syncthreads();
    const int lg = l * 32 + g;
    const float dt = expf(p.in[12][lg]);
    {
        const int pp = tid & 63, part = tid >> 6;
        const float ar = p.in[5][lg * 64 + pp], ai = p.in[6][lg * 64 + pp];
        for (int tau = part; tau <= 16; tau += 4) {
            float mag = expf((float)tau * ar * dt);
            float ang = (float)tau * ai * dt;
            Er[pp * 17 + tau] = mag * cosf(ang);
            Ei[pp * 17 + tau] = mag * sinf(ang);
        }
        float mag = expf(ar * dt), ang = ai * dt;
        float e1r = mag * cosf(ang) - 1.f, e1i = mag * sinf(ang);
        float den = ar * ar + ai * ai;
        float qr = (e1r * ar + e1i * ai) / den, qi = (e1i * ar - e1r * ai) / den;
        for (int c = part * 4; c < part * 4 + 4; ++c) {
            float br = p.in[7][((size_t)lg * 64 + pp) * 16 + c], bi = p.in[8][((size_t)lg * 64 + pp) * 16 + c];
            Br[pp * 16 + c] = qr * br - qi * bi;
            Bi[pp * 16 + c] = qr * bi + qi * br;
            Cr[c * 64 + pp] = p.in[9][((size_t)lg * 16 + c) * 64 + pp];
            Ci[c * 64 + pp] = p.in[10][((size_t)lg * 16 + c) * 64 + pp];
        }
    }
    __syncthreads();
    for (int i = 0; i < 16; ++i) {
        int idx = tid + i * 256, tau = idx >> 8, ch = (idx >> 4) & 15, c2 = idx & 15;
        float s = 0.f;
        for (int pp = 0; pp < 64; ++pp) {
            float cr = Cr[ch * 64 + pp], ci = Ci[ch * 64 + pp], er = Er[pp * 17 + tau], ei = Ei[pp * 17 + tau];
            float gr = cr * er - ci * ei, gi = cr * ei + ci * er;
            s += gr * Br[pp * 16 + c2] - gi * Bi[pp * 16 + c2];
        }
        Kt[idx] = s;
    }
    __syncthreads();
    u16* bta = (u16*)(p.ws + OFF_BTA) + (size_t)g * 128 * 256;
    for (int i = part * 16; i < part * 16 + 16; ++i) {
        int idx = tid + i * 256, pr = idx >> 8, k = idx & 255, s = k >> 4, ch = k & 15, pp = pr & 63;
        float er = Er[pp * 17 + 15 - s], ei = Ei[pp * 17 + 15 - s], br = Br[pp * 16 + ch], bi = Bi[pp * 16 + ch];
        float v = (pr < 64) ? (er * br - ei * bi) : (er * bi + ei * br);
        bta[idx] = f2bf(v);
    }
    u16* btc = (u16*)(p.ws + OFF_BTC) + (size_t)g * 256 * 384;
    for (int i = part * 48; i < part * 48 + 48; ++i) {
        int idx = tid + i * 256, n = idx / 384, k = idx - n * 384, j = n >> 4, ch = n & 15;
        float v;
        if (k < 256) {
            int s = k >> 4, c2 = k & 15;
            v = (s <= j) ? Kt[((j - s) * 16 + ch) * 16 + c2] : 0.f;
        } else {
            int pr = k - 256, pp = pr & 63;
            float cr = Cr[ch * 64 + pp], ci = Ci[ch * 64 + pp], er = Er[pp * 17 + j + 1], ei = Ei[pp * 17 + j + 1];
            float gr = cr * er - ci * ei, gi = cr * ei + ci * er;
            v = (pr < 64) ? gr : -gi;
        }
        btc[idx] = f2bf(v);
    }
}

constexpr int W_CONV_TILES = 2608;
__device__ void phase_w(CParams& p, int l, char* lds) {
    const int tid = otid();
    const int nunits = W_CONV_TILES + 256 + 2 + (l == 0 ? 1024 : 0);
    for (int u = VB; u < nunits; u += VG) {
        if (u < W_CONV_TILES) {
            int t = u;
            const float *s1, *s2 = nullptr; int ld, K, perm = 0; u16* dst;
            if (t < 1664) { s1 = p.in[1] + (size_t)l * DM * INC; ld = INC; K = 1024; dst = (u16*)(p.ws + OFF_WINT); }
            else if ((t -= 1664) < 384) { int k = t >> 7; t &= 127; s1 = p.in[22] + (size_t)(l * 3 + k) * 512 * 1024; ld = 1024; K = 512; dst = (u16*)(p.ws + OFF_WBRT) + (size_t)k * 1024 * 512; }
            else if ((t -= 384) < 256) { s1 = p.in[23] + (size_t)l * 1024 * 1024; ld = 1024; K = 1024; dst = (u16*)(p.ws + OFF_WOUTT); }
            else if ((t -= 256) < 64) { s1 = p.in[13] + (size_t)l * 512 * 512; ld = 512; K = 512; dst = (u16*)(p.ws + OFF_GLUT); }
            else if ((t -= 64) < 32) { int h = t >> 3; t &= 7; s1 = p.in[17] + (size_t)(l * 4 + h) * 128 * 128; s2 = p.in[19] + (size_t)(l * 4 + h) * 128 * 128; ld = 128; K = 128; perm = 32; dst = (u16*)(p.ws + OFF_RGT) + (size_t)h * 256 * 128; }
            else if ((t -= 32) < 128) { s1 = p.in[31] + (size_t)l * 1024 * 256; s2 = p.in[32] + (size_t)l * 1024 * 256; ld = 256; K = 1024; perm = 16; dst = (u16*)(p.ws + OFF_SH13T); }
            else if ((t -= 128) < 64) { s1 = p.in[33] + (size_t)l * 256 * 1024; ld = 1024; K = 256; dst = (u16*)(p.ws + OFF_SH2T); }
            else { t -= 64; s1 = p.in[26] + (size_t)l * 1024 * 64; ld = 64; K = 1024; dst = (u16*)(p.ws + OFF_ROUTT); }
            conv_tile(s1, s2, ld, K, perm, dst, t, (float*)lds);
        } else if (u < W_CONV_TILES + 256) {
            s5_precompute(p, l, (u - W_CONV_TILES) >> 3, (u - W_CONV_TILES) & 7, (float*)lds);
        } else if (u == W_CONV_TILES + 256) {
            float* LB = (float*)(p.ws + OFF_LB);
            for (int c = tid; c < 512; c += 256) {
                float x0 = p.in[3][c], x1 = p.in[3][512 + c];
                LB[c] = (l == 0) ? 0.f : 1.f / (1.f + expf(x0 - x1));
            }
            if (tid < 64) ((int*)(p.ws + OFF_CUR))[tid] = 0;
        } else if (u == W_CONV_TILES + 257) {
        } else {
            int r0 = (u - (W_CONV_TILES + 258)) * 16;
            const float4* src = (const float4*)(p.in[0] + (size_t)r0 * DM);
            uint2* dst = (uint2*)((u16*)(p.ws + OFF_XB) + (size_t)r0 * DM);
            for (int i = tid; i < 16 * 256; i += 256) {
                float4 v = src[i];
                uint2 o; o.x = f2bf(v.x) | ((unsigned)f2bf(v.y) << 16); o.y = f2bf(v.z) | ((unsigned)f2bf(v.w) << 16);
                dst[i] = o;
            }
        }
    }
}

__device__ void hgrn_prep(CParams& p, int u) {
    const int tid = otid();
    const int h = u & 3, c = (u >> 2) & 63, b = u >> 8;
    const int r0 = b * SEQ + c * 64;
    const size_t cu = (size_t)((b * 4 + h) * 64 + c);
    if (tid < 128) {
        const int d = tid;
        float* lf = (float*)(p.ws + OFF_PLF) + (size_t)r0 * 512 + h * 128 + d;
        const u16* kk = (const u16*)(p.ws + OFF_PK) + (size_t)r0 * 512 + h * 128 + d;
        float bs[64];
#pragma unroll
        for (int s = 0; s < 64; ++s) bs[s] = lf[(size_t)s * 512];
        float run = 0.f;
#pragma unroll
        for (int s = 0; s < 64; ++s) { run += bs[s]; bs[s] = run; lf[(size_t)s * 512] = run; }
        const float btot = run;
        ((float*)(p.ws + OFF_DEC))[(size_t)(b * 64 + c) * 512 + h * 128 + d] = __expf(btot);
        u16* dst = (u16*)(p.ws + OFF_KTT) + (cu * 128 + d) * 64;
#pragma unroll
        for (int s8 = 0; s8 < 8; ++s8) {
            bf16x8 o;
#pragma unroll
            for (int e = 0; e < 8; ++e) {
                int s = s8 * 8 + e;
                o[e] = (short)f2bf(bf2f(kk[(size_t)s * 512]) * __expf(btot - bs[s]));
            }
            *(bf16x8*)(dst + s8 * 8) = o;
        }
    } else {
        const int v = tid - 128;
        const u16* vv = (const u16*)(p.ws + OFF_PV) + (size_t)r0 * 512 + h * 128 + v;
        u16* dst = (u16*)(p.ws + OFF_VT) + (cu * 128 + v) * 64;
#pragma unroll
        for (int s8 = 0; s8 < 8; ++s8) {
            bf16x8 o;
#pragma unroll
            for (int e = 0; e < 8; ++e) o[e] = (short)vv[(size_t)(s8 * 8 + e) * 512];
            *(bf16x8*)(dst + s8 * 8) = o;
        }
    }
}

__device__ void s5_gemm_a(CParams& p, int u, char* lds) {
    LANE_IDS;
    const int wr = wid >> 1, wc = wid & 1;
    const int g = u >> 3, tm = u & 7, row0 = tm * 128;
    unsigned char* ws = p.ws;
    const unsigned aoff = (unsigned)(OFF_PU + (size_t)g * NTOK * 16 * 2), boff = (unsigned)(OFF_BTA + (size_t)g * 128 * 256 * 2);
    f32x4 acc[4][4]; ZERO_ACC(acc, 4, 4);
    mma_glds<128, 128, 2, 2, true>(acc, 4, ws,
        [&](int r, int t) { return aoff + ((row0 + r) * 256 + t * 64) * 2; },
        [&](int c, int t) { return boff + (c * 256 + t * 64) * 2; }, NoHook(), lds);
    epiT<4, 4, 64, 64>(acc, wr, wc, fq, fr, [&](int r, int cc, const f32x4& v) {
        stg<f32x4>(ws, (unsigned)(OFF_VC + (((row0 + r) * 32 + g) * 128 + cc) * 4), v); });
}

__device__ void rg_conv(CParams& p, int l, int u) {
    const int tid = otid();
    const u16* xr = (const u16*)(p.ws + OFF_PXR);
    u16* xc = (u16*)(p.ws + OFF_XC);
    const float* cw = p.in[15] + (size_t)l * 4 * 512;
    const float* cb = p.in[16] + (size_t)l * 512;
    for (int i = tid; i < 64 * 64; i += 256) {
        const int row = u * 64 + (i >> 6), c8 = (i & 63) * 8;
        const int t = row & (SEQ - 1);
        float a[8];
#pragma unroll
        for (int e = 0; e < 8; ++e) a[e] = cb[c8 + e];
#pragma unroll
        for (int j = 0; j < 4; ++j) {
            if (t - 3 + j >= 0) {
                bf16x8 x = *(const bf16x8*)(xr + (size_t)(row - 3 + j) * 512 + c8);
#pragma unroll
                for (int e = 0; e < 8; ++e) a[e] += cw[j * 512 + c8 + e] * bf2f((u16)x[e]);
            }
        }
        bf16x8 o;
#pragma unroll
        for (int e = 0; e < 8; ++e) o[e] = (short)f2bf(a[e]);
        *(bf16x8*)(xc + (size_t)row * 512 + c8) = o;
    }
}

__device__ void phase2(CParams& p, int l, char* lds) {
    for (int u = VB; u < 1536; u += VG) {
        if (u < 1024) hgrn_prep(p, u);
        else if (u < 1280) s5_gemm_a(p, u - 1024, lds);
        else rg_conv(p, l, u - 1280);
    }
}

__device__ void hgrn_u(CParams& p, int u, char* lds) {
    LANE_IDS;
    const int wr = wid >> 1, wc = wid & 1;
    unsigned char* ws = p.ws;
    f32x4 acc[4][4]; ZERO_ACC(acc, 4, 4);
    mma_glds<128, 128, 2, 2>(acc, 1, ws,
        [&](int r, int t) { return (unsigned)(OFF_KTT + ((u * 128 + r) * 64) * 2); },
        [&](int c, int t) { return (unsigned)(OFF_VT + ((u * 128 + c) * 64) * 2); }, NoHook(), lds);
#pragma unroll
    for (int m = 0; m < 4; ++m) {
#pragma unroll
        for (int n = 0; n < 4; ++n) {
            const int d0 = wr * 64 + m * 16 + fq * 4, v = wc * 64 + n * 16 + fr;
            uint2 o;
            o.x = f2bf(acc[m][n][0]) | ((unsigned)f2bf(acc[m][n][1]) << 16);
            o.y = f2bf(acc[m][n][2]) | ((unsigned)f2bf(acc[m][n][3]) << 16);
            stg<uint2>(ws, (unsigned)(OFF_UT + ((u * 128 + v) * 128 + d0) * 2), o);
        }
        __builtin_amdgcn_sched_barrier(0);
    }
}

__device__ void hgrn_sscan(CParams& p, int u) {
    const int tid = otid();
    const int bh = u >> 4, ec = (u & 15) * 256 + tid, v = ec >> 5, d4 = (ec & 31) * 4;
    const int b = bh >> 2, h = bh & 3;
    unsigned char* ws = p.ws;
    const unsigned ub = (unsigned)(OFF_UT + ((bh * 64 * 128 + v) * 128 + d4) * 2);
    const unsigned sb = (unsigned)(OFF_ST + ((bh * 64 * 128 + v) * 128 + d4) * 2);
    const unsigned db = (unsigned)(OFF_DEC + ((b * 64) * 512 + h * 128 + d4) * 4);
    f32x4 S = {0.f, 0.f, 0.f, 0.f};
    for (int c0 = 0; c0 < 64; c0 += 8) {
        uint2 uu[8]; f32x4 dd[8];
#pragma unroll
        for (int i = 0; i < 8; ++i) { uu[i] = ldg<uint2>(ws, ub + (unsigned)((c0 + i) * 128 * 128 * 2)); dd[i] = ldg<f32x4>(ws, db + (unsigned)((c0 + i) * 512 * 4)); }
#pragma unroll
        for (int i = 0; i < 8; ++i) {
            uint2 o;
            o.x = f2bf(S[0]) | ((unsigned)f2bf(S[1]) << 16); o.y = f2bf(S[2]) | ((unsigned)f2bf(S[3]) << 16);
            stg<uint2>(ws, sb + (unsigned)((c0 + i) * 128 * 128 * 2), o);
            S[0] = dd[i][0] * S[0] + bf2f((u16)(uu[i].x & 0xffff)); S[1] = dd[i][1] * S[1] + bf2f((u16)(uu[i].x >> 16));
            S[2] = dd[i][2] * S[2] + bf2f((u16)(uu[i].y & 0xffff)); S[3] = dd[i][3] * S[3] + bf2f((u16)(uu[i].y >> 16));
        }
    }
}

__device__ void s5_scan(CParams& p, int l, int u, char* lds) {
    const int tid = otid();
    const int b = u >> 5, g = u & 31, seg = tid >> 6, pp = tid & 63;
    const int lg = l * 32 + g;
    const float dt = expf(p.in[12][lg]);
    const float ar = p.in[5][lg * 64 + pp], ai = p.in[6][lg * 64 + pp];
    const float mag = expf(16.f * ar * dt), ang = 16.f * ai * dt;
    const float er = mag * cosf(ang), ei = mag * sinf(ang);
    const float mg2 = expf(1024.f * ar * dt), an2 = 1024.f * ai * dt;
    const float sr = mg2 * cosf(an2), si = mg2 * sinf(an2);
    unsigned char* ws = p.ws;
    const unsigned vb = (unsigned)(OFF_VC + (((b * 256 + seg * 64) * 32 + g) * 128 + pp) * 4);
    const unsigned hb = (unsigned)(OFF_HC + (((b * 256 + seg * 64) * 32 + g) * 128 + pp) * 2);
    float* ex = (float*)lds;
    __syncthreads();
    float hr = 0.f, hi = 0.f;
    for (int c0 = 0; c0 < 64; c0 += 16) {
        float vr[16], vi[16];
#pragma unroll
        for (int i = 0; i < 16; ++i) { vr[i] = ldg<float>(ws, vb + (unsigned)((c0 + i) * 4096 * 4)); vi[i] = ldg<float>(ws, vb + (unsigned)((c0 + i) * 4096 * 4 + 256)); }
#pragma unroll
        for (int i = 0; i < 16; ++i) { const float nr = er * hr - ei * hi + vr[i], ni = er * hi + ei * hr + vi[i]; hr = nr; hi = ni; }
    }
    ex[(seg * 64 + pp) * 2] = hr; ex[(seg * 64 + pp) * 2 + 1] = hi;
    __syncthreads();
    hr = 0.f; hi = 0.f;
    for (int sg = 0; sg < seg; ++sg) {
        const float lr = ex[(sg * 64 + pp) * 2], li = ex[(sg * 64 + pp) * 2 + 1];
        const float nr = sr * hr - si * hi + lr, ni = sr * hi + si * hr + li; hr = nr; hi = ni;
    }
    for (int c0 = 0; c0 < 64; c0 += 16) {
        float vr[16], vi[16];
#pragma unroll
        for (int i = 0; i < 16; ++i) { vr[i] = ldg<float>(ws, vb + (unsigned)((c0 + i) * 4096 * 4)); vi[i] = ldg<float>(ws, vb + (unsigned)((c0 + i) * 4096 * 4 + 256)); }
#pragma unroll
        for (int i = 0; i < 16; ++i) {
            stg<u16>(ws, hb + (unsigned)((c0 + i) * 4096 * 2), f2bf(hr));
            stg<u16>(ws, hb + (unsigned)((c0 + i) * 4096 * 2 + 128), f2bf(hi));
            const float nr = er * hr - ei * hi + vr[i], ni = er * hi + ei * hr + vi[i]; hr = nr; hi = ni;
        }
    }
}

__device__ void rg_gemm(CParams& p, int l, int u, char* lds) {
    LANE_IDS;
    const int wr = wid >> 1, wc = wid & 1;
    const int tm = u >> 3, h = (u >> 1) & 3, nt = u & 1, row0 = tm * 128;
    unsigned char* ws = p.ws;
    const unsigned aoff = (unsigned)(OFF_XC + h * 128 * 2), boff = (unsigned)(OFF_RGT + ((size_t)h * 256 * 128 + (size_t)nt * 128 * 128) * 2);
    f32x4 acc[4][4]; ZERO_ACC(acc, 4, 4);
    mma_glds<128, 128, 2, 2, true>(acc, 2, ws,
        [&](int r, int t) { return aoff + ((row0 + r) * 512 + t * 64) * 2; },
        [&](int c, int t) { return boff + (c * 128 + t * 64) * 2; }, NoHook(), lds);
    const float* ba = p.in[18] + (size_t)l * 512;
    const float* bx = p.in[20] + (size_t)l * 512;
    const float* lam = p.in[21] + (size_t)l * 512;
#pragma unroll
    for (int n = 0; n < 2; ++n) {
        const int ch = h * 128 + (nt * 2 + wc) * 32 + n * 16 + fq * 4;
        const f32x4 lm = *(const f32x4*)(lam + ch), bav = *(const f32x4*)(ba + ch), bxv = *(const f32x4*)(bx + ch);
        f32x4 c1;
#pragma unroll
        for (int i = 0; i < 4; ++i) c1[i] = -8.f * log1pf(expf(-lm[i]));
#pragma unroll
        for (int m = 0; m < 4; ++m) {
            const int row = row0 + wr * 64 + m * 16 + fr;
            const f32x4 x = unpack4(ldg<uint2>(ws, (unsigned)(OFF_XC + (row * 512 + ch) * 2)));
            f32x4 la, bb;
#pragma unroll
            for (int i = 0; i < 4; ++i) {
                const float r = sigm(acc[m][n][i] + bav[i]), ig = sigm(acc[m][n + 2][i] + bxv[i]);
                la[i] = c1[i] * r;
                bb[i] = sqrtf(fmaxf(1.f - __expf(2.f * la[i]), 0.f)) * ig * x[i];
            }
            stg<uint2>(ws, (unsigned)(OFF_LA + (row * 512 + ch) * 2), pack4(la));
            stg<uint2>(ws, (unsigned)(OFF_BB + (row * 512 + ch) * 2), pack4(bb));
        }
    }
}

__device__ void phase3(CParams& p, int l, char* lds) {
    for (int u = VB; u < 2176; u += VG) {
        if (u < 128) s5_scan(p, l, u, lds);
        else if (u < 1152) hgrn_u(p, u - 128, lds);
        else rg_gemm(p, l, u - 1152, lds);
    }
}

__device__ void hgrn_out(CParams& p, int l, int u, char* lds) {
    LANE_IDS;
    const int h = u & 3, c = (u >> 2) & 63, b = u >> 8;
    const int r0 = b * SEQ + c * 64;
    const size_t cu = (size_t)((b * 4 + h) * 64 + c);
    const u16* Pq = (const u16*)(p.ws + OFF_PQ) + (size_t)r0 * 512 + h * 128;
    const u16* Pk = (const u16*)(p.ws + OFF_PK) + (size_t)r0 * 512 + h * 128;
    const float* Bc = (const float*)(p.ws + OFF_PLF) + (size_t)r0 * 512 + h * 128;
    char* Ss = lds + (64 + 128) * 128;
    __syncthreads();
    {
        const int i = wid;
        const int t = 16 * i + fr;
        bf16x8 aq[4];
        float refv[4][8];
#pragma unroll
        for (int kk = 0; kk < 4; ++kk) {
            const int d0 = kk * 32 + fq * 8;
            bf16x8 q8 = *(const bf16x8*)(Pq + (size_t)t * 512 + d0);
#pragma unroll
            for (int e = 0; e < 8; ++e) {
                float rf = (i == 0) ? 0.f : Bc[(size_t)(16 * i - 1) * 512 + d0 + e];
                refv[kk][e] = rf;
                float bt = Bc[(size_t)t * 512 + d0 + e];
                aq[kk][e] = (short)f2bf(bf2f((u16)q8[e]) * __expf(bt - rf));
            }
        }
#pragma unroll
        for (int j = 0; j < 4; ++j) {
            f32x4 sc = {0.f, 0.f, 0.f, 0.f};
            if (j <= i) {
                const int s = 16 * j + fr;
#pragma unroll
                for (int kk = 0; kk < 4; ++kk) {
                    const int d0 = kk * 32 + fq * 8;
                    bf16x8 k8 = *(const bf16x8*)(Pk + (size_t)s * 512 + d0);
                    bf16x8 bk;
#pragma unroll
                    for (int e = 0; e < 8; ++e) {
                        float bsv = Bc[(size_t)s * 512 + d0 + e];
                        bk[e] = (short)f2bf(bf2f((u16)k8[e]) * __expf(fminf(refv[kk][e] - bsv, 60.f)));
                    }
                    sc = __builtin_amdgcn_mfma_f32_16x16x32_bf16(aq[kk], bk, sc, 0, 0, 0);
                }
            }
#pragma unroll
            for (int r = 0; r < 4; ++r) {
                const int tl = fq * 4 + r, sl = fr;
                float v = sc[r];
                if (j > i || (j == i && sl > tl)) v = 0.f;
                const int row = 16 * i + tl, col = 16 * j + sl;
                *(u16*)(Ss + swz(row, col >> 3) + (col & 7) * 2) = f2bf(v);
            }
        }
    }
    __syncthreads();
    const u16* STc = (const u16*)(p.ws + OFF_ST) + cu * 128 * 128;
    const u16* VTc = (const u16*)(p.ws + OFF_VT) + cu * 128 * 64;
    f32x4 acc[1][8]; ZERO_ACC(acc, 1, 8);
    mma_loop<64, 128, 4, 1, true>(acc, 3,
        [&](int r, int k) {
            bf16x8 o;
            if (k < 128) {
                bf16x8 q8 = *(const bf16x8*)(Pq + (size_t)r * 512 + k);
                const float4 b0 = *(const float4*)(Bc + (size_t)r * 512 + k), b1 = *(const float4*)(Bc + (size_t)r * 512 + k + 4);
                o[0] = (short)f2bf(bf2f((u16)q8[0]) * __expf(b0.x)); o[1] = (short)f2bf(bf2f((u16)q8[1]) * __expf(b0.y));
                o[2] = (short)f2bf(bf2f((u16)q8[2]) * __expf(b0.z)); o[3] = (short)f2bf(bf2f((u16)q8[3]) * __expf(b0.w));
                o[4] = (short)f2bf(bf2f((u16)q8[4]) * __expf(b1.x)); o[5] = (short)f2bf(bf2f((u16)q8[5]) * __expf(b1.y));
                o[6] = (short)f2bf(bf2f((u16)q8[6]) * __expf(b1.z)); o[7] = (short)f2bf(bf2f((u16)q8[7]) * __expf(b1.w));
            } else {
                o = *(const bf16x8*)(Ss + swz(r, (k - 128) >> 3));
            }
            return o;
        },
        [&](int cc, int k) {
            return (k < 128) ? *(const bf16x8*)(STc + (size_t)cc * 128 + k) : *(const bf16x8*)(VTc + (size_t)cc * 64 + (k - 128));
        }, NoHook(), lds);
    const float* nw = p.in[4] + (size_t)l * 512 + h * 128;
    {
        float ss = 0.f;
#pragma unroll
        for (int n = 0; n < 8; ++n)
#pragma unroll
            for (int j = 0; j < 4; ++j) ss += acc[0][n][j] * acc[0][n][j];
        ss += shfl_xor_l(ss, 16, lane); ss += shfl_xor_l(ss, 32, lane);
        const float rs = rsqrtf(ss * (1.f / 128.f) + 1e-6f);
        const int row = r0 + wid * 16 + fr;
#pragma unroll
        for (int n = 0; n < 8; ++n) {
            const int v = n * 16 + fq * 4;
            const f32x4 w4 = *(const f32x4*)(nw + v);
            const f32x4 g4 = unpack4(ldg<uint2>(p.ws, (unsigned)(OFF_PG + (row * 512 + h * 128 + v) * 2)));
            f32x4 o;
#pragma unroll
            for (int j = 0; j < 4; ++j) o[j] = acc[0][n][j] * rs * w4[j] * g4[j];
            stg<uint2>(p.ws, (unsigned)(OFF_YA + (row * 512 + h * 128 + v) * 2), pack4(o));
        }
    }
}

__device__ void s5_gemm_c(CParams& p, int l, int u, char* lds) {
    LANE_IDS;
    const int wr = wid >> 1, wc = wid & 1;
    const int g = u >> 4, tm = (u >> 1) & 7, tn = u & 1, row0 = tm * 128, col0 = tn * 128;
    unsigned char* ws = p.ws;
    const unsigned aoff = (unsigned)(OFF_PU + (size_t)g * NTOK * 16 * 2), boff = (unsigned)(OFF_BTC + (size_t)g * 256 * 384 * 2);
    f32x4 acc[4][4]; ZERO_ACC(acc, 4, 4);
    mma_glds<128, 128, 2, 2, true>(acc, 6, ws,
        [&](int r, int t) {
            return (t < 4) ? aoff + ((row0 + r) * 256 + t * 64) * 2 : (unsigned)(OFF_HC + (((row0 + r) * 32 + g) * 128 + (t - 4) * 64) * 2);
        },
        [&](int c, int t) { return boff + ((col0 + c) * 384 + t * 64) * 2; }, NoHook(), lds);
    const f32x4 dch = *(const f32x4*)(p.in[11] + (size_t)l * 512 + g * 16 + fq * 4);
    epiT<4, 4, 64, 64>(acc, wr, wc, fq, fr, [&](int r, int cc, const f32x4& v) {
        const int row = row0 + r, col = col0 + cc;
        const int jj = col >> 4, ch = col & 15;
        const int tok = (row >> 8) * SEQ + (row & 255) * 16 + jj;
        const f32x4 uu = unpack4(ldg<uint2>(ws, aoff + (tok * 16 + ch) * 2));
        f32x4 y;
#pragma unroll
        for (int i = 0; i < 4; ++i) y[i] = gelu_f(v[i] + dch[i] * uu[i]);
        stg<uint2>(ws, (unsigned)(OFF_YG + (tok * 512 + g * 16 + ch) * 2), pack4(y)); });
}

__device__ __forceinline__ void bf4(const uint2 q, float (&o)[4]) {
    o[0] = bf2f((u16)(q.x & 0xffff)); o[1] = bf2f((u16)(q.x >> 16)); o[2] = bf2f((u16)(q.y & 0xffff)); o[3] = bf2f((u16)(q.y >> 16));
}
__device__ void rg_local(CParams& p, int u) {
    const int tid = otid();
    const int b = u >> 5, seg = (u & 31) * 2 + (tid >> 7), c4 = (tid & 127) * 4;
    unsigned char* ws = p.ws;
    const unsigned base = (unsigned)(((b * SEQ + seg * 64) * 512 + c4) * 2);
    float hh[4] = {0.f, 0.f, 0.f, 0.f}, ap[4] = {1.f, 1.f, 1.f, 1.f};
    for (int s0 = 0; s0 < 64; s0 += 8) {
        uint2 a[8], bb[8];
#pragma unroll
        for (int i = 0; i < 8; ++i) { a[i] = ldg<uint2>(ws, (unsigned)OFF_LA + base + (unsigned)((s0 + i) * 1024)); bb[i] = ldg<uint2>(ws, (unsigned)OFF_BB + base + (unsigned)((s0 + i) * 1024)); }
#pragma unroll
        for (int i = 0; i < 8; ++i) {
            float av[4], bv[4]; bf4(a[i], av); bf4(bb[i], bv);
#pragma unroll
            for (int c = 0; c < 4; ++c) { const float e = __expf(av[c]); hh[c] = e * hh[c] + bv[c]; ap[c] *= e; }
        }
    }
    stg<f32x4>(ws, (unsigned)(OFF_SEGA + ((b * 64 + seg) * 512 + c4) * 4), f32x4{ap[0], ap[1], ap[2], ap[3]});
    stg<f32x4>(ws, (unsigned)(OFF_SEGH + ((b * 64 + seg) * 512 + c4) * 4), f32x4{hh[0], hh[1], hh[2], hh[3]});
}

__device__ void rg_final(CParams& p, int u) {
    const int tid = otid();
    const int b = u >> 5, seg = (u & 31) * 2 + (tid >> 7), c4 = (tid & 127) * 4;
    unsigned char* ws = p.ws;
    const unsigned base = (unsigned)(((b * SEQ + seg * 64) * 512 + c4) * 2);
    f32x4 hh = {0.f, 0.f, 0.f, 0.f};
    for (int sg0 = 0; sg0 < seg; sg0 += 8) {
        f32x4 sa[8], sh[8];
#pragma unroll
        for (int i = 0; i < 8; ++i) {
            const int sg = min(sg0 + i, 63);
            sa[i] = ldg<f32x4>(ws, (unsigned)(OFF_SEGA + ((b * 64 + sg) * 512 + c4) * 4));
            sh[i] = ldg<f32x4>(ws, (unsigned)(OFF_SEGH + ((b * 64 + sg) * 512 + c4) * 4));
        }
#pragma unroll
        for (int i = 0; i < 8; ++i) if (sg0 + i < seg) hh = sa[i] * hh + sh[i];
    }
    for (int s0 = 0; s0 < 64; s0 += 8) {
        uint2 a[8], bb[8], xg[8];
#pragma unroll
        for (int i = 0; i < 8; ++i) {
            a[i] = ldg<uint2>(ws, (unsigned)OFF_LA + base + (unsigned)((s0 + i) * 1024));
            bb[i] = ldg<uint2>(ws, (unsigned)OFF_BB + base + (unsigned)((s0 + i) * 1024));
            xg[i] = ldg<uint2>(ws, (unsigned)OFF_PXG + base + (unsigned)((s0 + i) * 1024));
        }
#pragma unroll
        for (int i = 0; i < 8; ++i) {
            float av[4], bv[4], xv[4]; bf4(a[i], av); bf4(bb[i], bv); bf4(xg[i], xv);
#pragma unroll
            for (int c = 0; c < 4; ++c) hh[c] = __expf(av[c]) * hh[c] + bv[c];
            uint2 o; o.x = f2bf(hh[0] * xv[0]) | ((unsigned)f2bf(hh[1] * xv[1]) << 16); o.y = f2bf(hh[2] * xv[2]) | ((unsigned)f2bf(hh[3] * xv[3]) << 16);
            stg<uint2>(ws, (unsigned)OFF_YC + base + (unsigned)((s0 + i) * 1024), o);
        }
    }
}

__device__ void phase4(CParams& p, int l, char* lds) {
    for (int u = VB; u < 896; u += VG) {
        if (u < 256) hgrn_sscan(p, u);
        else if (u < 384) rg_local(p, u - 256);
        else s5_gemm_c(p, l, u - 384, lds);
    }
}

__device__ void phase_glu(CParams& p, int l, char* lds) {
    LANE_IDS;
    const int wr = wid >> 1, wc = wid & 1;
    unsigned char* ws = p.ws;
    const float* gb = p.in[14] + (size_t)l * 512;
    for (int uu = VB; uu < 1664; uu += VG) {
        if (uu < 128) { rg_final(p, uu); continue; }
        if (uu < 1152) { hgrn_out(p, l, uu - 128, lds); continue; }
        const int u = uu - 1152;
        const int row0 = (u >> 2) * 128, col0 = (u & 3) * 128;
        f32x4 acc[4][4]; ZERO_ACC(acc, 4, 4);
        mma_glds<128, 128, 2, 2, true>(acc, 8, ws,
            [&](int r, int t) { return (unsigned)(OFF_YG + ((row0 + r) * 512 + t * 64) * 2); },
            [&](int c, int t) { return (unsigned)(OFF_GLUT + ((col0 + c) * 512 + t * 64) * 2); }, NoHook(), lds);
        epiT<4, 4, 64, 64>(acc, wr, wc, fq, fr, [&](int r, int cc, const f32x4& v) {
            const int row = row0 + r, col = col0 + cc;
            const f32x4 y = unpack4(ldg<uint2>(ws, (unsigned)(OFF_YG + (row * 512 + col) * 2)));
            const f32x4 bb = *(const f32x4*)(gb + col);
            f32x4 o;
#pragma unroll
            for (int i = 0; i < 4; ++i) o[i] = y[i] * sigm(v[i] + bb[i]);
            stg<uint2>(ws, (unsigned)(OFF_YB + (row * 512 + col) * 2), pack4(o)); });
    }
}

__device__ void phase_branch(CParams& p, int l, char* lds) {
    BrSched S; S.c = blockIdx.x;
    BrEpi E; E.ws = p.ws;
    g8::gemm_phase<BrEpi, BrSched, false>((LAS unsigned char*)lds, p.ws, 512, S, E);
}

__device__ void phase_out(CParams& p, int l, char* lds, char* hlds) {
    {
        OutSched S; S.A = (unsigned)OFF_MIXP; S.B = (unsigned)OFF_WOUTT; S.c = blockIdx.x; S.G = gridDim.x;
        OutEpi E; E.ws = p.ws; E.xres = (l == 0) ? p.in[0] : p.out;
        g8::gemm_phase<OutEpi, OutSched, false>((LAS unsigned char*)lds, p.ws, 1024, S, E);
    }
    for (int u = VB; u < 12288; u += VG) {
        const int e = u / 192, r = u % 192;
        if (r < 128)
            conv_tile(p.in[28] + (size_t)(l * 64 + e) * 1024 * 256, p.in[29] + (size_t)(l * 64 + e) * 1024 * 256, 256, 1024, 16,
                      (u16*)(p.ws + OFF_EW13) + (size_t)e * 512 * 1024, r, (float*)hlds);
        else
            conv_tile(p.in[30] + (size_t)(l * 64 + e) * 256 * 1024, nullptr, 1024, 256, 0,
                      (u16*)(p.ws + OFF_EW2) + (size_t)e * 1024 * 256, r - 128, (float*)hlds);
    }
}

__device__ __forceinline__ void ln_row(float (&v)[16], const float* g, const float* bta, int lane) {
    float s = 0.f;
#pragma unroll
    for (int i = 0; i < 16; ++i) s += v[i];
    const float mu = wave_sum(s, lane) * (1.f / 1024.f);
    float q = 0.f;
#pragma unroll
    for (int i = 0; i < 16; ++i) { float d = v[i] - mu; q += d * d; }
    const float rs = rsqrtf(wave_sum(q, lane) * (1.f / 1024.f) + 1e-5f);
#pragma unroll
    for (int i = 0; i < 4; ++i) {
        const float4 gg = *(const float4*)(g + i * 256 + lane * 4), bb = *(const float4*)(bta + i * 256 + lane * 4);
        v[i * 4 + 0] = (v[i * 4 + 0] - mu) * rs * gg.x + bb.x;
        v[i * 4 + 1] = (v[i * 4 + 1] - mu) * rs * gg.y + bb.y;
        v[i * 4 + 2] = (v[i * 4 + 2] - mu) * rs * gg.z + bb.z;
        v[i * 4 + 3] = (v[i * 4 + 3] - mu) * rs * gg.w + bb.w;
    }
}

__device__ void phase_route(CParams& p, int l, char* lds) {
    LANE_IDS;
    const float* Pre = (const float*)(p.ws + OFF_PRELN);
    u16* Xm = (u16*)(p.ws + OFF_XM);
    const float* g1 = p.in[24] + (size_t)l * 1024;
    const float* b1 = p.in[25] + (size_t)l * 1024;
    const float* rbias = p.in[27] + (size_t)l * 64;
    int* cursor = (int*)(p.ws + OFF_CUR);
    int* list = (int*)(p.ws + OFF_LIST);
    float* wlist = (float*)(p.ws + OFF_WLIST);
    float* Ls = (float*)(lds + 32768);
    int* hist = (int*)(lds + 32768 + 64 * 65 * 4);
    int* basep = hist + 64;
    for (int u = VB; u < 512; u += VG) {
        const int row0 = u * 32;
#pragma unroll 1
        for (int hb = 0; hb < 2; ++hb) {
            float v[4][16];
#pragma unroll
            for (int rr = 0; rr < 4; ++rr) {
                const int row = row0 + wid * 8 + hb * 4 + rr;
#pragma unroll
                for (int i = 0; i < 4; ++i) {
                    const float4 x = *(const float4*)(Pre + (size_t)row * 1024 + i * 256 + lane * 4);
                    v[rr][i * 4] = x.x; v[rr][i * 4 + 1] = x.y; v[rr][i * 4 + 2] = x.z; v[rr][i * 4 + 3] = x.w;
                }
            }
#pragma unroll
            for (int rr = 0; rr < 4; ++rr) {
                const int row = row0 + wid * 8 + hb * 4 + rr;
                ln_row(v[rr], g1, b1, lane);
#pragma unroll
                for (int i = 0; i < 4; ++i) {
                    uint2 o; o.x = f2bf(v[rr][i * 4]) | ((unsigned)f2bf(v[rr][i * 4 + 1]) << 16); o.y = f2bf(v[rr][i * 4 + 2]) | ((unsigned)f2bf(v[rr][i * 4 + 3]) << 16);
                    *(uint2*)(Xm + (size_t)row * 1024 + i * 256 + lane * 4) = o;
                }
            }
        }
        if (tid < 64) hist[tid] = 0;
        __syncthreads();
        f32x4 acc[1][2]; ZERO_ACC(acc, 1, 2);
        mma_glds<32, 64, 2, 2>(acc, 16, p.ws,
            [&](int r, int t) { return (unsigned)(OFF_XM + ((row0 + r) * 1024 + t * 64) * 2); },
            [&](int c, int t) { return (unsigned)(OFF_ROUTT + (c * 1024 + t * 64) * 2); }, NoHook(), lds);
#pragma unroll
        for (int n = 0; n < 2; ++n)
#pragma unroll
            for (int j = 0; j < 4; ++j) {
                const int r = (wid >> 1) * 16 + fq * 4 + j, e = (wid & 1) * 32 + n * 16 + fr;
                Ls[r * 65 + e] = sigm(acc[0][n][j]) + rbias[e];
            }
        __syncthreads();
        int myrank[8]; int myexp[8]; float wv[8];
        if (tid < 32) {
            float* sc = Ls + tid * 65;
            float gs[8];
#pragma unroll
            for (int g = 0; g < 8; ++g) {
                float m1 = -1e30f, m2 = -1e30f;
#pragma unroll
                for (int i = 0; i < 8; ++i) { float x = sc[g * 8 + i]; if (x > m1) { m2 = m1; m1 = x; } else if (x > m2) m2 = x; }
                gs[g] = m1 + m2;
            }
            unsigned gmask = 0;
#pragma unroll
            for (int it = 0; it < 4; ++it) {
                float best = -1e30f; int bi = 0;
#pragma unroll
                for (int g = 0; g < 8; ++g) { bool ok = !((gmask >> g) & 1u) && gs[g] > best; if (ok) { best = gs[g]; bi = g; } }
                gmask |= 1u << bi;
            }
            unsigned long long chosen = 0ull;
            float wsum = 0.f;
#pragma unroll
            for (int k = 0; k < 8; ++k) {
                float best = -1e30f; int bi = 0;
                for (int e = 0; e < 64; ++e) {
                    float x = sc[e];
                    bool ok = ((gmask >> (e >> 3)) & 1u) && !((chosen >> e) & 1ull) && x > best;
                    if (ok) { best = x; bi = e; }
                }
                chosen |= 1ull << bi;
                myexp[k] = bi;
                wv[k] = best - rbias[bi];
                wsum += wv[k];
            }
            const float sc_ = 2.5f / wsum;
#pragma unroll
            for (int k = 0; k < 8; ++k) {
                wv[k] *= sc_;
                myrank[k] = atomicAdd(&hist[myexp[k]], 1);
            }
        }
        __syncthreads();
        if (tid < 64) basep[tid] = atomicAdd(&cursor[tid], hist[tid]);
        __syncthreads();
        if (tid < 32) {
#pragma unroll
            for (int k = 0; k < 8; ++k) {
                const size_t pos = (size_t)myexp[k] * NTOK + basep[myexp[k]] + myrank[k];
                list[pos] = (row0 + tid) * 8 + k;
                wlist[pos] = wv[k];
            }
        }
        __syncthreads();
    }
}

__device__ void phase_combine(CParams& p, int l) {
    LANE_IDS;
    typedef float f32x2 __attribute__((ext_vector_type(2)));
    unsigned char* ws = p.ws;
    const float* g2 = p.in[34] + (size_t)l * 1024 + lane * 16;
    const float* b2 = p.in[35] + (size_t)l * 1024 + lane * 16;
    for (int row = VB * 4 + wid; row < NTOK; row += VG * 4) {
        f32x4 y[4]; uint4 xm[2]; u32x4 yb[8];
#pragma unroll
        for (int i = 0; i < 4; ++i) y[i] = ldg<f32x4>(p.out, (unsigned)((row * 1024 + lane * 16 + i * 4) * 4));
#pragma unroll
        for (int i = 0; i < 2; ++i) xm[i] = ldg<uint4>(ws, (unsigned)(OFF_XM + (row * 1024 + lane * 16 + i * 8) * 2));
#pragma unroll
        for (int k = 0; k < 8; ++k) yb[k] = ldg<u32x4>(ws, (unsigned)OFF_YBUF + (unsigned)((row * 8 + k) * 1024 + lane * 16));
        float v[16], s[16];
#pragma unroll
        for (int i = 0; i < 16; ++i) s[i] = 0.f;
#pragma unroll
        for (int k = 0; k < 8; ++k)
#pragma unroll
            for (int w = 0; w < 4; ++w) {
                const f32x2 lo = __builtin_amdgcn_cvt_pk_f32_fp8((int)yb[k][w], false), hi = __builtin_amdgcn_cvt_pk_f32_fp8((int)yb[k][w], true);
                s[w * 4 + 0] += lo.x; s[w * 4 + 1] += lo.y; s[w * 4 + 2] += hi.x; s[w * 4 + 3] += hi.y;
            }
#pragma unroll
        for (int i = 0; i < 2; ++i) {
            const uint4 x = xm[i];
            const float xf[8] = {bf2f((u16)(x.x & 0xffff)), bf2f((u16)(x.x >> 16)), bf2f((u16)(x.y & 0xffff)), bf2f((u16)(x.y >> 16)),
                                 bf2f((u16)(x.z & 0xffff)), bf2f((u16)(x.z >> 16)), bf2f((u16)(x.w & 0xffff)), bf2f((u16)(x.w >> 16))};
#pragma unroll
            for (int j = 0; j < 8; ++j) v[i * 8 + j] = y[i * 2 + (j >> 2)][j & 3] + DN_ALPHA * xf[j] + s[i * 8 + j] * (1.f / 32.f);
        }
        float sum = 0.f;
#pragma unroll
        for (int i = 0; i < 16; ++i) sum += v[i];
        const float mu = wave_sum(sum, lane) * (1.f / 1024.f);
        float q = 0.f;
#pragma unroll
        for (int i = 0; i < 16; ++i) { const float d = v[i] - mu; q += d * d; }
        const float rs = rsqrtf(wave_sum(q, lane) * (1.f / 1024.f) + 1e-5f);
#pragma unroll
        for (int i = 0; i < 4; ++i) {
            const f32x4 gg = *(const f32x4*)(g2 + i * 4), bb = *(const f32x4*)(b2 + i * 4);
#pragma unroll
            for (int j = 0; j < 4; ++j) v[i * 4 + j] = (v[i * 4 + j] - mu) * rs * gg[j] + bb[j];
            stg<f32x4>(p.out, (unsigned)((row * 1024 + lane * 16 + i * 4) * 4), f32x4{v[i * 4], v[i * 4 + 1], v[i * 4 + 2], v[i * 4 + 3]});
        }
#pragma unroll
        for (int i = 0; i < 2; ++i) {
            uint4 o;
            o.x = f2bf(v[i * 8 + 0]) | ((unsigned)f2bf(v[i * 8 + 1]) << 16); o.y = f2bf(v[i * 8 + 2]) | ((unsigned)f2bf(v[i * 8 + 3]) << 16);
            o.z = f2bf(v[i * 8 + 4]) | ((unsigned)f2bf(v[i * 8 + 5]) << 16); o.w = f2bf(v[i * 8 + 6]) | ((unsigned)f2bf(v[i * 8 + 7]) << 16);
            stg<uint4>(ws, (unsigned)(OFF_XB + (row * 1024 + lane * 16 + i * 8) * 2), o);
        }
    }
}


#define XB_TMO      128
#define XB_XCNT(j)  (256  + 64 * (j))
#define XB_XSUB(j)  (1280 + 64 * (j))
#define XB_XGEN(j)  (2304 + 64 * (j))
#define XB_TOP      3328
#define XB_TOPGEN   3392
#define XCD_BAR_WORDS 3456
#define XB_SPIN_CAP (1u << 22)
__device__ __forceinline__ unsigned xb_ld(unsigned* p)              { return __hip_atomic_load(p, __ATOMIC_RELAXED, __HIP_MEMORY_SCOPE_AGENT); }
__device__ __forceinline__ unsigned xb_add(unsigned* p, unsigned v) { return __hip_atomic_fetch_add(p, v, __ATOMIC_RELAXED, __HIP_MEMORY_SCOPE_AGENT); }
__device__ __forceinline__ unsigned xb_xcc_id() { return (unsigned)__builtin_amdgcn_s_getreg((3 << 11) | 20) & 0xFu; }
#define XB_SPIN(cond, bar) do { unsigned _sp = 0; while (cond) { __builtin_amdgcn_s_sleep(1); \
    if ((++_sp & 255u) == 0u) { if (xb_ld(&(bar)[XB_TMO])) break; if (_sp > XB_SPIN_CAP) { atomicAdd(&(bar)[XB_TMO], 1u); break; } } } } while (0)
struct XcdBarrier { unsigned* bar; unsigned x; volatile LAS unsigned* st; };
__device__ __forceinline__ XcdBarrier xcd_barrier_post(unsigned* bar, volatile LAS unsigned* st) {
    XcdBarrier b; b.bar = bar; b.x = xb_xcc_id(); b.st = st;
    if (threadIdx.x == 0) (void)xb_add(&bar[XB_XCNT(b.x)], 1u);
    return b;
}
__device__ __forceinline__ void xcd_barrier_complete(unsigned* bar, unsigned x, unsigned& nloc, unsigned& nx) {
    const unsigned G = gridDim.x * gridDim.y * gridDim.z;
    unsigned sum, cnt, mine, sp = 0u;
    for (;;) {
        sum = 0u; cnt = 0u; mine = 0u;
#pragma unroll
        for (unsigned j = 0; j < 16; ++j) { const unsigned c = xb_ld(&bar[XB_XCNT(j)]); sum += c; cnt += (c > 0u) ? 1u : 0u; mine = (j == x) ? c : mine; }
        if (sum == G) break;
        __builtin_amdgcn_s_sleep(1);
        if ((++sp & 255u) == 0u) { if (xb_ld(&bar[XB_TMO])) break; if (sp > XB_SPIN_CAP) { atomicAdd(&bar[XB_TMO], 1u); break; } }
    }
    nloc = mine > 0u ? mine : 1u; nx = cnt > 0u ? cnt : 1u;
}
__device__ __forceinline__ void xcd_barrier(const XcdBarrier& b) {
    asm volatile("s_waitcnt vmcnt(0)" ::: "memory");
    __syncthreads();
    if (threadIdx.x == 0) {
        unsigned* bar = b.bar;
        __builtin_amdgcn_s_waitcnt(0);
        unsigned nloc = b.st[0], nx = b.st[1];
        if (nloc == 0u) { xcd_barrier_complete(bar, b.x, nloc, nx); b.st[0] = nloc; b.st[1] = nx; }
        const unsigned old = xb_add(&bar[XB_XSUB(b.x)], 1u);
        const unsigned gen = old / nloc;
        if (old + 1u == (gen + 1u) * nloc) {
            __builtin_amdgcn_fence(__ATOMIC_RELEASE, "agent");
            asm volatile("s_waitcnt vmcnt(0)" ::: "memory");
            const unsigned og = xb_add(&bar[XB_TOP], 1u);
            const unsigned tg = og / nx;
            if (og + 1u == (tg + 1u) * nx) xb_add(&bar[XB_TOPGEN], 1u);
            else XB_SPIN(xb_ld(&bar[XB_TOPGEN]) == tg, bar);
            __builtin_amdgcn_fence(__ATOMIC_ACQUIRE, "agent");
            xb_add(&bar[XB_XGEN(b.x)], 1u);
            asm volatile("s_waitcnt vmcnt(0)" ::: "memory");
        } else {
            XB_SPIN(xb_ld(&bar[XB_XGEN(b.x)]) == gen, bar);
            __builtin_amdgcn_fence(__ATOMIC_ACQUIRE, "agent");
            asm volatile("s_waitcnt vmcnt(0)" ::: "memory");
        }
    }
    __syncthreads();
}

__global__ void __launch_bounds__(512, 2) fwd_kernel(Params p_unused) {
    extern __shared__ __attribute__((aligned(16))) char lds[];
    cg::grid_group grid = cg::this_grid();
    CParams* pp = (CParams*)__builtin_amdgcn_kernarg_segment_ptr();
    const int ph_lo = pp->ph_lo;
    volatile LAS unsigned* xst = (volatile LAS unsigned*)(lds + L_XST);
    if (threadIdx.x == 0) { xst[0] = 0u; xst[1] = 0u; *(LAS unsigned*)(lds + 147456 + 32) = 0u; }
    __syncthreads();
    const XcdBarrier xb = xcd_barrier_post((unsigned*)(pp->ws + OFF_BAR), xst);
    char* hlds = lds + __builtin_amdgcn_readfirstlane((int)(threadIdx.x >> 8)) * HLDS;
    unsigned long long tq_acc = 0;
    (void)ph_lo;
#pragma unroll
    for (int ph = 0; ph < 2 * NPH; ++ph) {
        asm volatile("" : "+s"(pp));
        CParams& p = *pp;
        const int l = ph / NPH, q = ph % NPH;
        unsigned long long tq0 = 0;
        if (PROBE_TQ >= 0 && q == PROBE_TQ) tq0 = __builtin_amdgcn_s_memrealtime();
#pragma unroll 1
        for (int rep = 0; rep < 1 + (int)((PROBE_MASK >> q) & 1u); ++rep) {
            if (rep) xcd_barrier(xb);
            switch (q) {
                case 0: phase_w(p, l, hlds); break;
                case 1: phase_proj(p, l, lds); break;
                case 2: phase2(p, l, hlds); break;
                case 3: phase3(p, l, hlds); break;
                case 4: phase4(p, l, hlds); break;
                case 5: phase_glu(p, l, hlds); break;
                case 6: phase_branch(p, l, lds); break;
                case 7: phase_out(p, l, lds, hlds); break;
                case 8: phase_route(p, l, hlds); break;
                case 9: phase_moe1(p, l, lds); break;
                case 10: phase_moe2(p, l, lds); break;
                default: phase_combine(p, l); break;
            }
        }
        if (ph + 1 < 2 * NPH) {
            if (p.coop == 1) xcd_barrier(xb);
            else if (p.coop == 2) grid.sync();
        }
        if (PROBE_TQ >= 0 && q == PROBE_TQ) tq_acc += __builtin_amdgcn_s_memrealtime() - tq0;
    }
    if (PROBE_TQ == 98) tq_acc = *(LAS unsigned*)(lds + 147456 + 32);
    if (PROBE_TQ >= 0 && blockIdx.x == 0) {
        const unsigned long long t0 = __builtin_amdgcn_s_memrealtime();
        while (__builtin_amdgcn_s_memrealtime() - t0 < 4ull * tq_acc) __builtin_amdgcn_s_sleep(8);
    }
}

extern "C" void kernel_launch(void* const* d_in, const int* in_sizes, int n_in, void* d_out, int out_size, void* d_ws, size_t ws_size,
                              hipStream_t stream) {
    static int grid_blocks = 0;
    if (!grid_blocks) {
        int dev = 0, cus = 0, per_cu = 0;
        (void)hipGetDevice(&dev);
        (void)hipDeviceGetAttribute(&cus, hipDeviceAttributeMultiprocessorCount, dev);
        (void)hipFuncSetAttribute((const void*)fwd_kernel, hipFuncAttributeMaxDynamicSharedMemorySize, LDS_BYTES);
        (void)hipOccupancyMaxActiveBlocksPerMultiprocessor(&per_cu, fwd_kernel, 512, LDS_BYTES);
        if (per_cu < 1) per_cu = 1;
        per_cu = 1;
        grid_blocks = cus * per_cu;
        if (ws_size < WS_NEED) fprintf(stderr, "kernel_launch: workspace too small: %zu < %zu\n", ws_size, (size_t)WS_NEED);
    }
    Params p{};
    for (int i = 0; i < 36; ++i) p.in[i] = (const float*)d_in[i];
    p.out = (float*)d_out;
    p.ws = (unsigned char*)d_ws;
    p.ph_lo = 0; p.ph_hi = 2 * NPH; p.coop = 1; p.pad = 0;
    (void)hipMemsetAsync((char*)d_ws + OFF_BAR, 0, XCD_BAR_WORDS * 4, stream);
    void* args[] = {&p};
    hipError_t e = hipLaunchCooperativeKernel((void*)fwd_kernel, dim3(grid_blocks), dim3(512), args, LDS_BYTES, stream);
    if (e != hipSuccess) fprintf(stderr, "cooperative launch failed: %s (grid %d)\n", hipGetErrorString(e), grid_blocks);
}
```

```cpp
#include <hip/hip_runtime.h>
#include <hip/hip_cooperative_groups.h>
#include <cstdio>
#include <cstdint>
namespace cg = cooperative_groups;

typedef unsigned short u16;
typedef __attribute__((ext_vector_type(8))) short bf16x8;
typedef __attribute__((ext_vector_type(4))) float f32x4;
typedef __attribute__((ext_vector_type(4))) unsigned u32x4;
#define LAS __attribute__((address_space(3)))

constexpr int NTOK = 16384, DM = 1024, SEQ = 4096, BW = 512, INC = 6656;
constexpr int NE = 64, EH = 256;
#ifndef PROBE_MASK
#define PROBE_MASK 0u
#endif
#define PROBE_TIMEK_ProjEpi false
#define PROBE_TIMEK_OutEpi false
#define PROBE_TIMEK_BrEpi false
#define PROBE_TIMEK_Moe1Epi false
#define PROBE_TIMEK_Moe2Epi false
#define PROBE_TIMEK_ShEpi false
#define PROBE_TQ -1
constexpr int NPH = 12;
constexpr float DN_ALPHA = 1.4142135623730951f;
constexpr size_t SLOT = 16777216ull;

constexpr size_t OFF_WINT  = 0;
constexpr size_t OFF_WBRT  = 13631488;
constexpr size_t OFF_WOUTT = 16777216;
constexpr size_t OFF_GLUT  = 18874368;
constexpr size_t OFF_RGT   = 19398656;
constexpr size_t OFF_SH13T = 19660800;
constexpr size_t OFF_SH2T  = 20709376;
constexpr size_t OFF_BTA   = 21233664;
constexpr size_t OFF_BTC   = 23330816;
constexpr size_t OFF_ROUTT = 29622272;
constexpr size_t OFF_MISC  = 29753344;
constexpr size_t OFF_LB    = OFF_MISC;
constexpr size_t OFF_CUR   = OFF_MISC + 2048;
constexpr size_t OFF_DEC   = OFF_MISC + 4096;
constexpr size_t OFF_SEGA  = OFF_DEC + 524288;
constexpr size_t OFF_SEGH  = OFF_SEGA + 524288;
constexpr size_t OFF_XB    = 2 * SLOT;
constexpr size_t OFF_VC    = 2 * SLOT;
constexpr size_t OFF_XC    = 3 * SLOT;
constexpr size_t OFF_MIXP  = 2 * SLOT;
constexpr size_t OFF_LIST  = 2 * SLOT;
constexpr size_t OFF_HSH   = 2 * SLOT + 4194304;
constexpr size_t OFF_WLIST = 2 * SLOT + 4194304 + 8388608;
constexpr size_t OFF_PQ    = 4 * SLOT;
constexpr size_t OFF_PLF   = 5 * SLOT;
constexpr size_t OFF_PK    = 7 * SLOT;
constexpr size_t OFF_PV    = 8 * SLOT;
constexpr size_t OFF_YC    = 8 * SLOT;
constexpr size_t OFF_PG    = 9 * SLOT;
constexpr size_t OFF_PU    = 10 * SLOT;
constexpr size_t OFF_PXG   = 11 * SLOT;
constexpr size_t OFF_PXR   = 12 * SLOT;
constexpr size_t OFF_YB    = 12 * SLOT;
constexpr size_t OFF_PGATE = 13 * SLOT;
constexpr size_t OFF_KTT   = 19 * SLOT;
constexpr size_t OFF_YA    = 19 * SLOT;
constexpr size_t OFF_VT    = 20 * SLOT;
constexpr size_t OFF_ST    = 21 * SLOT;
constexpr size_t OFF_LA    = 23 * SLOT;
constexpr size_t OFF_BB    = 24 * SLOT;
constexpr size_t OFF_YG    = 25 * SLOT;
constexpr size_t OFF_HC    = 26 * SLOT;
constexpr size_t OFF_UT    = 27 * SLOT;
constexpr size_t OFF_PRELN = 4 * SLOT;
constexpr size_t OFF_XM    = 8 * SLOT;
constexpr size_t OFF_EW13  = 10 * SLOT;
constexpr size_t OFF_EW2   = 14 * SLOT;
constexpr size_t OFF_HBUF  = 4 * SLOT;
constexpr size_t OFF_YBUF  = 16 * SLOT;
constexpr size_t OFF_BAR   = 32 * SLOT;
constexpr int HLDS = 73728;
constexpr int LDS_BYTES = 2 * HLDS + 64;
constexpr int L_XST = 2 * HLDS;
constexpr size_t WS_NEED   = 32 * SLOT + 16384;

struct Params {
    const float* in[36];
    float* out;
    unsigned char* ws;
    int ph_lo, ph_hi;
    int coop, pad;
};
typedef const __attribute__((address_space(4))) Params CParams;

__device__ __forceinline__ u16 f2bf(float f) {
    unsigned u = __builtin_bit_cast(unsigned, f);
    return (u16)((u + 0x7fffu + ((u >> 16) & 1u)) >> 16);
}
__device__ __forceinline__ float bf2f(u16 h) { return __builtin_bit_cast(float, (unsigned)h << 16); }
__device__ __forceinline__ float sigm(float x) { return __builtin_amdgcn_rcpf(1.f + __expf(-x)); }
__device__ __forceinline__ float silu_f(float x) { return x * sigm(x); }
__device__ __forceinline__ float gelu_f(float x) {
    float u = 0.7978845608028654f * (x + 0.044715f * x * x * x);
    float t = 1.f - 2.f * __builtin_amdgcn_rcpf(1.f + __expf(2.f * u));
    return 0.5f * x * (1.f + t);
}
__device__ __forceinline__ float shfl_xor_l(float v, int o, int lane) {
    return __builtin_bit_cast(float, __builtin_amdgcn_ds_bpermute((lane ^ o) << 2, __builtin_bit_cast(int, v)));
}
__device__ __forceinline__ float wave_sum(float v, int lane) {
#pragma unroll
    for (int o = 32; o >= 1; o >>= 1) v += shfl_xor_l(v, o, lane);
    return v;
}
__device__ __forceinline__ int swz(int row, int ch) { return row * 128 + ((ch ^ ((row >> 1) & 7)) << 4); }


template <class T> __device__ __forceinline__ T ldg(const void* base, unsigned off) { return *(const T*)((const char*)base + off); }
template <class T> __device__ __forceinline__ void stg(void* base, unsigned off, T v) { *(T*)((char*)base + off) = v; }
template <class T> __device__ __forceinline__ void stg_nt(void* base, unsigned off, T v) { __builtin_nontemporal_store(v, (T*)((char*)base + off)); }

template <int TM, int TN, int RW, int CW, class F>
__device__ __forceinline__ void epi(f32x4 (&acc)[TM][TN], int wr, int wc, int fq, int fr, F f) {
#pragma unroll
    for (int m = 0; m < TM; ++m) {
#pragma unroll
        for (int j = 0; j < 4; ++j) {
#pragma unroll
            for (int n = 0; n < TN; ++n) f(wr * RW + m * 16 + fq * 4 + j, wc * CW + n * 16 + fr, acc[m][n][j]);
        }
        __builtin_amdgcn_sched_barrier(0);
    }
}

template <int TM, int TN, int RW, int CW, class F>
__device__ __forceinline__ void epiT(f32x4 (&acc)[TM][TN], int wr, int wc, int fq, int fr, F f) {
#pragma unroll
    for (int m = 0; m < TM; ++m) {
#pragma unroll
        for (int n = 0; n < TN; ++n) f(wr * RW + m * 16 + fr, wc * CW + n * 16 + fq * 4, acc[m][n]);
    }
}
__device__ __forceinline__ uint2 pack4(const f32x4& a) {
    uint2 w; w.x = f2bf(a[0]) | ((unsigned)f2bf(a[1]) << 16); w.y = f2bf(a[2]) | ((unsigned)f2bf(a[3]) << 16); return w;
}
__device__ __forceinline__ f32x4 unpack4(const uint2 q) {
    return f32x4{bf2f((u16)(q.x & 0xffff)), bf2f((u16)(q.x >> 16)), bf2f((u16)(q.y & 0xffff)), bf2f((u16)(q.y >> 16))};
}

__device__ __forceinline__ int otid() { int t = threadIdx.x & 255; asm volatile("" : "+v"(t)); return t; }
#define VB ((int)blockIdx.x * 2 + __builtin_amdgcn_readfirstlane((int)(threadIdx.x >> 8)))
#define VG ((int)gridDim.x * 2)

struct NoHook { __device__ __forceinline__ void operator()(int) const {} };

template <int BM, int BN, int WM, int WN, bool TR = false, class AL, class BL, class HK>
__device__ __forceinline__ void mma_loop(f32x4 (&acc)[BM / WM / 16][BN / WN / 16], int nk, AL aload, BL bload, HK hook, char* lds) {
    constexpr int TM = BM / WM / 16, TN = BN / WN / 16;
    constexpr int ACH = BM / 32, BCH = BN / 32;
    const int tid = otid(), lane = tid & 63, wid = tid >> 6;
    const int wr = wid / WN, wc = wid % WN, fr = lane & 15, fq = lane >> 4;
    const int srow = tid >> 3, sk = (tid & 7) * 8;
    const int swr = srow * 128 + (((tid & 7) ^ ((tid >> 4) & 7)) << 4);
    const int xr = (fr >> 1) & 7;
    const int a_rd = (wr * (BM / WM) + fr) * 128;
    const int b_rd = BM * 128 + (wc * (BN / WN) + fr) * 128;
    bf16x8 ra[ACH], rb[BCH];
#pragma unroll
    for (int i = 0; i < ACH; ++i) ra[i] = aload(srow + i * 32, sk);
#pragma unroll
    for (int i = 0; i < BCH; ++i) rb[i] = bload(srow + i * 32, sk);
#pragma unroll 1
    for (int t = 0; t < nk; ++t) {
        __syncthreads();
#pragma unroll
        for (int i = 0; i < ACH; ++i) *(bf16x8*)(lds + swr + i * 4096) = ra[i];
#pragma unroll
        for (int i = 0; i < BCH; ++i) *(bf16x8*)(lds + BM * 128 + swr + i * 4096) = rb[i];
        __syncthreads();
        if (t + 1 < nk) {
#pragma unroll
            for (int i = 0; i < ACH; ++i) ra[i] = aload(srow + i * 32, (t + 1) * 64 + sk);
#pragma unroll
            for (int i = 0; i < BCH; ++i) rb[i] = bload(srow + i * 32, (t + 1) * 64 + sk);
        }
        hook(t);
#pragma unroll
        for (int ks = 0; ks < 2; ++ks) {
            const int co = ((ks * 4 + fq) ^ xr) << 4;
            bf16x8 af[TM], bfr[TN];
#pragma unroll
            for (int m = 0; m < TM; ++m) af[m] = *(const bf16x8*)(lds + a_rd + m * 2048 + co);
#pragma unroll
            for (int n = 0; n < TN; ++n) bfr[n] = *(const bf16x8*)(lds + b_rd + n * 2048 + co);
#pragma unroll
            for (int m = 0; m < TM; ++m)
#pragma unroll
                for (int n = 0; n < TN; ++n) acc[m][n] = TR ? __builtin_amdgcn_mfma_f32_16x16x32_bf16(bfr[n], af[m], acc[m][n], 0, 0, 0)
                                                            : __builtin_amdgcn_mfma_f32_16x16x32_bf16(af[m], bfr[n], acc[m][n], 0, 0, 0);
        }
    }
}

template <int BM, int BN, int WM, int WN, bool TR = false, class AO, class BO, class HK>
__device__ __forceinline__ void mma_glds(f32x4 (&acc)[BM / WM / 16][BN / WN / 16], int nk, const unsigned char* ws, AO aoff, BO boff, HK hook, char* lds) {
    constexpr int TM = BM / WM / 16, TN = BN / WN / 16;
    constexpr int ACH = BM / 32, BCH = BN / 32, BUF = (BM + BN) * 128;
    const int tid = otid(), lane = tid & 63, wid = tid >> 6;
    const int wr = wid / WN, wc = wid % WN, fr = lane & 15, fq = lane >> 4;
    const int srow = tid >> 3;
    const unsigned csrc = (unsigned)(((tid & 7) ^ ((tid >> 4) & 7)) << 4);
    const int xr = (fr >> 1) & 7;
    const int a_rd = (wr * (BM / WM) + fr) * 128;
    const int b_rd = BM * 128 + (wc * (BN / WN) + fr) * 128;
    auto stage = [&](int buf, int t) {
        char* d = lds + buf * BUF + tid * 16;
#pragma unroll
        for (int i = 0; i < ACH; ++i)
            __builtin_amdgcn_global_load_lds((const unsigned*)(ws + (aoff(srow + i * 32, t) + csrc)), (unsigned*)(d + i * 4096), 16, 0, 0);
#pragma unroll
        for (int i = 0; i < BCH; ++i)
            __builtin_amdgcn_global_load_lds((const unsigned*)(ws + (boff(srow + i * 32, t) + csrc)), (unsigned*)(d + BM * 128 + i * 4096), 16, 0, 0);
    };
    __syncthreads();
    stage(0, 0);
#pragma unroll 1
    for (int t = 0; t < nk; ++t) {
        asm volatile("s_waitcnt vmcnt(0)" ::: "memory");
        __syncthreads();
        if (t + 1 < nk) stage((t + 1) & 1, t + 1);
        hook(t);
        const char* bb = lds + (t & 1) * BUF;
#pragma unroll
        for (int ks = 0; ks < 2; ++ks) {
            const int co = ((ks * 4 + fq) ^ xr) << 4;
            bf16x8 af[TM], bfr[TN];
#pragma unroll
            for (int m = 0; m < TM; ++m) af[m] = *(const bf16x8*)(bb + a_rd + m * 2048 + co);
#pragma unroll
            for (int n = 0; n < TN; ++n) bfr[n] = *(const bf16x8*)(bb + b_rd + n * 2048 + co);
#pragma unroll
            for (int m = 0; m < TM; ++m)
#pragma unroll
                for (int n = 0; n < TN; ++n) acc[m][n] = TR ? __builtin_amdgcn_mfma_f32_16x16x32_bf16(bfr[n], af[m], acc[m][n], 0, 0, 0)
                                                            : __builtin_amdgcn_mfma_f32_16x16x32_bf16(af[m], bfr[n], acc[m][n], 0, 0, 0);
        }
    }
}

#define ZERO_ACC(acc, TM, TN) _Pragma("unroll") for (int m_ = 0; m_ < TM; ++m_) _Pragma("unroll") for (int n_ = 0; n_ < TN; ++n_) acc[m_][n_] = f32x4{0.f, 0.f, 0.f, 0.f}

#define LANE_IDS const int tid = otid(), lane = tid & 63, wid = tid >> 6, fr = lane & 15, fq = lane >> 4; (void)tid; (void)lane; (void)wid; (void)fr; (void)fq

namespace g8 {
constexpr int BM = 256, BK = 64, HALF = 128, HTB = HALF * BK * 2, STAGE_BYTES = 8 * HTB;
__device__ __forceinline__ int lds_byte(int r, int c) { const int st = (r >> 4) * 2 + (c >> 5), rr = r & 15, cc = c & 31, ob = rr * 64 + cc * 2; return st * 1024 + (ob ^ (((ob >> 9) & 1) << 5)); }
__device__ __forceinline__ void stage_rc(int b, int& R, int& C) { const int st = b / 1024, sb = b % 1024, swz = sb ^ (((sb >> 9) & 1) << 5); R = (st >> 1) * 16 + swz / 64; C = (st & 1) * 32 + (swz % 64) / 2; }
__device__ __forceinline__ int perm32(int rho) { const int n = rho >> 4, i = rho & 15; return 8 * (i >> 2) + 4 * n + (i & 3); }
struct Unit { unsigned A, B; int pm, pn, x0, x1; };
__device__ __forceinline__ unsigned cvt_pk_bf16(float lo, float hi) { unsigned r; asm volatile("v_cvt_pk_bf16_f32 %0, %1, %2" : "=v"(r) : "v"(lo), "v"(hi)); return r; }

template <class Epi, class Sched, bool GATHER>
__device__ __forceinline__ void gemm_phase(LAS unsigned char* lds, const unsigned char* wsb, const int K, const Sched& S, const Epi& E) {
    int tid_ = threadIdx.x; asm volatile("" : "+v"(tid_));
    const int tid = tid_, wid = __builtin_amdgcn_readfirstlane(tid >> 6), lane = tid & 63, wr = wid >> 2, wc = wid & 3, fr = lane & 15, fq = lane >> 4;
    const int nt = K / BK;
    unsigned voffA[2], voffB[2];
#pragma unroll
    for (int i = 0; i < 2; ++i) { int R, C; stage_rc(tid * 16 + i * 8192, R, C); const int Rb = Epi::PERM ? ((R & ~31) + perm32(R & 31)) : R;
        voffA[i] = (unsigned)(R * K + C) * 2u; voffB[i] = (unsigned)(Rb * K + C) * 2u; }
    const unsigned kstep = (unsigned)(BK * 2);
    const unsigned hstep = (unsigned)(HALF * K * 2);
    const unsigned ldsw = (unsigned)wid * 1024u;
    const int aoff = lds_byte(wr * 64 + fr, fq * 8), boff = lds_byte(wc * 32 + fr, fq * 8);
#define G8_SA(b, h) (((b) * 2 + (h)) * HTB)
#define G8_SB(b, h) ((4 + (b) * 2 + (h)) * HTB)
#define G8_STAGE(bufoff, gbase, voff) do { _Pragma("unroll") for (int _i = 0; _i < 2; ++_i) \
        __builtin_amdgcn_global_load_lds((const unsigned*)(wsb + (unsigned)((gbase) + (voff)[_i])), (LAS unsigned*)(lds + (bufoff) + ldsw + _i * 8192), 16, 0, 0); } while (0)
#define G8_STAGE_A(bufoff, kp, h, vg) do { if (GATHER) G8_STAGE(bufoff, kp, vg[h]); else G8_STAGE(bufoff, (kp) + (h) * hstep, voffA); } while (0)
#define G8_LDA(dst, b, h) do { _Pragma("unroll") for (int m = 0; m < 4; ++m) _Pragma("unroll") for (int k = 0; k < 2; ++k) dst[m][k] = *(const LAS bf16x8*)(lds + G8_SA(b, h) + aoff + m * 2048 + k * 1024); } while (0)
#define G8_LDB(dst, b, h) do { _Pragma("unroll") for (int n = 0; n < 2; ++n) _Pragma("unroll") for (int k = 0; k < 2; ++k) dst[n][k] = *(const LAS bf16x8*)(lds + G8_SB(b, h) + boff + n * 2048 + k * 1024); } while (0)
#define G8_MMA(ai, bj, At, Bt) do { __builtin_amdgcn_s_setprio(1); _Pragma("unroll") for (int m = 0; m < 4; ++m) _Pragma("unroll") for (int n = 0; n < 2; ++n) _Pragma("unroll") for (int k = 0; k < 2; ++k) \
        acc[ai][bj][m][n] = __builtin_amdgcn_mfma_f32_16x16x32_bf16(Bt[n][k], At[m][k], acc[ai][bj][m][n], 0, 0, 0); __builtin_amdgcn_s_setprio(0); } while (0)
#define G8_WAIT_V(n) asm volatile("s_waitcnt vmcnt(" #n ")" ::: "memory")
#define G8_WAIT_L(n) asm volatile("s_waitcnt lgkmcnt(" #n ")" ::: "memory")
#define G8_BAR __builtin_amdgcn_s_barrier()
#define G8_SCHED __builtin_amdgcn_sched_barrier(0)
#define G8_GOFF(dst, u) do { _Pragma("unroll") for (int _i = 0; _i < 2; ++_i) { int _R, _C; stage_rc(tid * 16 + _i * 8192, _R, _C); \
        _Pragma("unroll") for (int _h = 0; _h < 2; ++_h) dst[_h][_i] = (unsigned)(S.row(u, _h * HALF + _R) * K + _C) * 2u; } \
        asm volatile("" : "+v"(dst[0][0]), "+v"(dst[0][1]), "+v"(dst[1][0]), "+v"(dst[1][1])); } while (0)
    Unit cur, nxt; int ui = 0;
    if (!S.next(0, cur)) return;
    f32x4 acc[2][2][4][2];
#pragma unroll
    for (int a = 0; a < 2; ++a)
#pragma unroll
        for (int b = 0; b < 2; ++b)
#pragma unroll
            for (int m = 0; m < 4; ++m)
#pragma unroll
                for (int n = 0; n < 2; ++n) acc[a][b][m][n] = (f32x4){0.f, 0.f, 0.f, 0.f};
    bf16x8 At[4][2], B0[2][2], B1[2][2];
    unsigned vgc[2][2] = {{0u, 0u}, {0u, 0u}};
    LAS u32x4* gslot = (LAS u32x4*)(lds + STAGE_BYTES + 4096) + tid;
    unsigned cA = cur.A, cB = cur.B;
    if (GATHER) { G8_GOFF(vgc, cur); }
    G8_STAGE(G8_SB(0, 0), cB, voffB); G8_STAGE_A(G8_SA(0, 0), cA, 0, vgc); G8_STAGE(G8_SB(0, 1), cB + hstep, voffB); G8_STAGE_A(G8_SA(0, 1), cA, 1, vgc);
    if (wr == 1) G8_BAR;
    G8_WAIT_V(4); G8_BAR;
    G8_STAGE(G8_SB(1, 0), cB + kstep, voffB); G8_STAGE_A(G8_SA(1, 0), cA + kstep, 0, vgc); G8_STAGE(G8_SB(1, 1), cB + hstep + kstep, voffB);
    G8_WAIT_V(6); G8_BAR;
    for (;;) {
        const bool has_next = S.next(ui + 1, nxt);
        const unsigned nA = has_next ? nxt.A : cA, nB = has_next ? nxt.B : cB;
        if (GATHER && has_next) {
            unsigned vt[2][2]; G8_GOFF(vt, nxt);
            *gslot = u32x4{vt[0][0], vt[0][1], vt[1][0], vt[1][1]};
        }
        unsigned long long tk0 = 0;
        if (Epi::TIMEK) tk0 = __builtin_amdgcn_s_memrealtime();
#pragma unroll 1
        for (int t = 0; t < nt; t += 2) {
            const bool last = (t == nt - 2);
            const unsigned a1 = cA + (unsigned)(t + 1) * kstep;
            const unsigned a2 = last ? nA : cA + (unsigned)(t + 2) * kstep, b2 = last ? nB : cB + (unsigned)(t + 2) * kstep;
            const unsigned a3 = a2 + kstep, b3 = b2 + kstep;
            G8_LDB(B0, 0, 0); G8_SCHED; G8_LDA(At, 0, 0); G8_STAGE_A(G8_SA(1, 1), a1, 1, vgc);
            G8_WAIT_L(8); G8_BAR; G8_WAIT_L(0); G8_MMA(0, 0, At, B0); G8_BAR; G8_SCHED;
            G8_LDB(B1, 0, 1);
            if (GATHER && last && has_next) { const u32x4 x = *gslot; vgc[0][0] = x[0]; vgc[0][1] = x[1]; vgc[1][0] = x[2]; vgc[1][1] = x[3]; }
            G8_STAGE(G8_SB(0, 0), b2, voffB);
            G8_BAR; G8_WAIT_L(0); G8_MMA(0, 1, At, B1); G8_BAR;
            G8_LDA(At, 0, 1); G8_STAGE_A(G8_SA(0, 0), a2, 0, vgc);
            G8_BAR; G8_WAIT_L(0); G8_MMA(1, 0, At, B0); G8_BAR; G8_SCHED;
            G8_STAGE(G8_SB(0, 1), b2 + hstep, voffB);
            G8_WAIT_V(6); G8_BAR; G8_MMA(1, 1, At, B1); G8_BAR;
            G8_LDB(B0, 1, 0); G8_SCHED; G8_LDA(At, 1, 0); G8_STAGE_A(G8_SA(0, 1), a2, 1, vgc);
            G8_WAIT_L(8); G8_BAR; G8_WAIT_L(0); G8_MMA(0, 0, At, B0); G8_BAR; G8_SCHED;
            G8_LDB(B1, 1, 1); G8_STAGE(G8_SB(1, 0), b3, voffB);
            G8_BAR; G8_WAIT_L(0); G8_MMA(0, 1, At, B1); G8_BAR;
            G8_LDA(At, 1, 1); G8_STAGE_A(G8_SA(1, 0), a3, 0, vgc);
            G8_BAR; G8_WAIT_L(0); G8_MMA(1, 0, At, B0); G8_BAR; G8_SCHED;
            G8_STAGE(G8_SB(1, 1), b3 + hstep, voffB);
            G8_WAIT_V(6); G8_BAR; G8_MMA(1, 1, At, B1); G8_BAR;
        }
        if (Epi::TIMEK && tid == 0) { const unsigned dt = (unsigned)(__builtin_amdgcn_s_memrealtime() - tk0); *(LAS unsigned*)(lds + 147456 + 32) += dt; }
        const bool keep = E(acc, cur, wr, wc, fr, fq);
        if (!has_next) break;
        if (!keep) {
#pragma unroll
        for (int a = 0; a < 2; ++a)
#pragma unroll
            for (int b = 0; b < 2; ++b)
#pragma unroll
                for (int m = 0; m < 4; ++m)
#pragma unroll
                    for (int n = 0; n < 2; ++n) acc[a][b][m][n] = (f32x4){0.f, 0.f, 0.f, 0.f};
        }
        cur = nxt; cA = nA; cB = nB; ++ui;
    }
    G8_WAIT_V(0);
    if (wr == 0) G8_BAR;
    G8_BAR;
#undef G8_SA
#undef G8_SB
#undef G8_STAGE
#undef G8_STAGE_A
#undef G8_LDA
#undef G8_LDB
#undef G8_MMA
#undef G8_WAIT_V
#undef G8_WAIT_L
#undef G8_BAR
#undef G8_SCHED
#undef G8_GOFF
}
}

__device__ __forceinline__ u32x4 pack8v(const f32x4& a, const f32x4& b) {
    u32x4 w; w[0] = g8::cvt_pk_bf16(a[0], a[1]); w[1] = g8::cvt_pk_bf16(a[2], a[3]); w[2] = g8::cvt_pk_bf16(b[0], b[1]); w[3] = g8::cvt_pk_bf16(b[2], b[3]); return w;
}
__device__ __forceinline__ uint4 pack8(const f32x4& a, const f32x4& b) {
    uint4 w; w.x = g8::cvt_pk_bf16(a[0], a[1]); w.y = g8::cvt_pk_bf16(a[2], a[3]); w.z = g8::cvt_pk_bf16(b[0], b[1]); w.w = g8::cvt_pk_bf16(b[2], b[3]); return w;
}

struct ProjSched {
    unsigned A, B; int c, G;
    __device__ __forceinline__ bool next(int i, g8::Unit& u) const {
        const int L = i * G + c; if (L >= 64 * 26) return false;
        const int xcd = L & 7, jx = L >> 3;
        u.pm = xcd * 8 + (jx & 7); u.pn = jx >> 3;
        u.A = A + (unsigned)u.pm * 256 * DM * 2; u.B = B + (unsigned)u.pn * 256 * DM * 2; u.x0 = 0; u.x1 = 0; return true;
    }
    __device__ __forceinline__ int row(const g8::Unit&, int) const { return 0; }
};
struct ProjEpi {
    static constexpr bool TIMEK = PROBE_TIMEK_ProjEpi;
    static constexpr bool PERM = true;
    unsigned char* ws; const float* bg;
    __device__ __forceinline__ bool operator()(f32x4 (&acc)[2][2][4][2], const g8::Unit& u, int wr, int wc, int fr, int fq) const {
        const int seg = (u.pn * 256) >> 9;
        f32x4 cc[2][2];
#pragma unroll
        for (int bj = 0; bj < 2; ++bj) {
            const int col = u.pn * 256 + bj * 128 + wc * 32 + fq * 8;
            if (seg == 1) { cc[bj][0] = ldg<f32x4>(ws, (unsigned)(OFF_LB + (col & 511) * 4)); cc[bj][1] = ldg<f32x4>(ws, (unsigned)(OFF_LB + (col & 511) * 4 + 16)); }
            else if (seg >= 7) { cc[bj][0] = *(const f32x4*)(bg + col - 3584); cc[bj][1] = *(const f32x4*)(bg + col - 3584 + 4); }
            else { cc[bj][0] = f32x4{0.f, 0.f, 0.f, 0.f}; cc[bj][1] = cc[bj][0]; }
        }
#pragma unroll
        for (int ai = 0; ai < 2; ++ai)
#pragma unroll
            for (int m = 0; m < 4; ++m) {
                const int row = u.pm * 256 + ai * 128 + wr * 64 + m * 16 + fr;
#pragma unroll
                for (int bj = 0; bj < 2; ++bj) {
                    const int col = u.pn * 256 + bj * 128 + wc * 32 + fq * 8;
                    const int c = col & 511;
                    f32x4 v0 = acc[ai][bj][m][0], v1 = acc[ai][bj][m][1];
                    if (seg == 0 || seg == 3) {
#pragma unroll
                        for (int i = 0; i < 4; ++i) { v0[i] = silu_f(v0[i]); v1[i] = silu_f(v1[i]); }
                        stg<uint4>(ws, (unsigned)((seg == 0 ? OFF_PQ : OFF_PG) + (row * 512 + c) * 2), pack8(v0, v1));
                    } else if (seg == 1) {
                        const f32x4 l0 = cc[bj][0], l1 = cc[bj][1];
                        f32x4 g0, g1, k0, k1;
#pragma unroll
                        for (int i = 0; i < 4; ++i) {
                            const float s0 = sigm(v0[i]), s1 = sigm(v1[i]);
                            g0[i] = __logf(l0[i] + (1.f - l0[i]) * s0); g1[i] = __logf(l1[i] + (1.f - l1[i]) * s1);
                            k0[i] = (1.f - l0[i]) * (1.f - s0); k1[i] = (1.f - l1[i]) * (1.f - s1);
                        }
                        stg<f32x4>(ws, (unsigned)(OFF_PLF + (row * 512 + c) * 4), g0);
                        stg<f32x4>(ws, (unsigned)(OFF_PLF + (row * 512 + c) * 4 + 16), g1);
                        stg<uint4>(ws, (unsigned)(OFF_PK + (row * 512 + c) * 2), pack8(k0, k1));
                    } else if (seg == 2 || seg == 6) {
                        stg<uint4>(ws, (unsigned)((seg == 2 ? OFF_PV : OFF_PXR) + (row * 512 + c) * 2), pack8(v0, v1));
                    } else if (seg == 4) {
                        stg<uint4>(ws, (unsigned)(OFF_PU + (((c >> 4) * NTOK + row) * 16 + (c & 15)) * 2), pack8(v0, v1));
                    } else if (seg == 5) {
#pragma unroll
                        for (int i = 0; i < 4; ++i) { v0[i] = gelu_f(v0[i]); v1[i] = gelu_f(v1[i]); }
                        stg<uint4>(ws, (unsigned)(OFF_PXG + (row * 512 + c) * 2), pack8(v0, v1));
                    } else {
                        const int gc = col - 3584;
#pragma unroll
                        for (int i = 0; i < 4; ++i) { v0[i] = sigm(v0[i] + cc[bj][0][i]); v1[i] = sigm(v1[i] + cc[bj][1][i]); }
                        stg<uint4>(ws, (unsigned)(OFF_PGATE + (row * 3072 + gc) * 2), pack8(v0, v1));
                    }
                }
            }
        return false;
    }
};
__device__ void phase_proj(CParams& p, int l, char* lds) {
    ProjSched S; S.A = (unsigned)OFF_XB; S.B = (unsigned)OFF_WINT; S.c = blockIdx.x; S.G = gridDim.x;
    ProjEpi E; E.ws = p.ws; E.bg = p.in[2] + (size_t)l * 3072;
    g8::gemm_phase<ProjEpi, ProjSched, false>((LAS unsigned char*)lds, p.ws, 1024, S, E);
}

struct OutSched {
    unsigned A, B; int c, G;
    __device__ __forceinline__ bool next(int i, g8::Unit& u) const {
        const int L = i * G + c; if (L >= 64 * 4) return false;
        const int xcd = L & 7, jx = L >> 3;
        u.pm = xcd * 8 + (jx & 7); u.pn = jx >> 3;
        u.A = A + (unsigned)u.pm * 256 * 1024 * 2; u.B = B + (unsigned)u.pn * 256 * 1024 * 2; u.x0 = 0; u.x1 = 0; return true;
    }
    __device__ __forceinline__ int row(const g8::Unit&, int) const { return 0; }
};
struct OutEpi {
    static constexpr bool TIMEK = PROBE_TIMEK_OutEpi;
    static constexpr bool PERM = false;
    unsigned char* ws; const float* xres;
    __device__ __forceinline__ bool operator()(f32x4 (&acc)[2][2][4][2], const g8::Unit& u, int wr, int wc, int fr, int fq) const {
#pragma unroll
        for (int ai = 0; ai < 2; ++ai) {
            f32x4 x[4][2][2];
#pragma unroll
            for (int m = 0; m < 4; ++m)
#pragma unroll
                for (int bj = 0; bj < 2; ++bj)
#pragma unroll
                    for (int n = 0; n < 2; ++n) {
                        const int row = u.pm * 256 + ai * 128 + wr * 64 + m * 16 + fr, col = u.pn * 256 + bj * 128 + wc * 32 + n * 16 + fq * 4;
                        x[m][bj][n] = ldg<f32x4>(xres, (unsigned)((row * 1024 + col) * 4));
                    }
#pragma unroll
            for (int m = 0; m < 4; ++m)
#pragma unroll
                for (int bj = 0; bj < 2; ++bj)
#pragma unroll
                    for (int n = 0; n < 2; ++n) {
                        const int row = u.pm * 256 + ai * 128 + wr * 64 + m * 16 + fr, col = u.pn * 256 + bj * 128 + wc * 32 + n * 16 + fq * 4;
                        stg<f32x4>(ws, (unsigned)OFF_PRELN + (unsigned)((row * 1024 + col) * 4), x[m][bj][n] * DN_ALPHA + acc[ai][bj][m][n]);
                    }
        }
        return false;
    }
};

struct BrSched {
    int c;
    __device__ __forceinline__ bool next(int i, g8::Unit& u) const {
        if (i >= 3) return false;
        const int xcd = c & 7, jx = c >> 3;
        u.pm = xcd * 8 + (jx & 7); u.pn = jx >> 3; u.x0 = i; u.x1 = 0;
        u.A = (unsigned)(i == 0 ? OFF_YA : (i == 1 ? OFF_YB : OFF_YC)) + (unsigned)u.pm * 256 * 512 * 2;
        u.B = (unsigned)OFF_WBRT + (unsigned)i * 1024 * 512 * 2 + (unsigned)u.pn * 256 * 512 * 2;
        return true;
    }
    __device__ __forceinline__ int row(const g8::Unit&, int) const { return 0; }
};
struct BrEpi {
    static constexpr bool TIMEK = PROBE_TIMEK_BrEpi;
    static constexpr bool PERM = true;
    unsigned char* ws;
    __device__ __forceinline__ bool operator()(f32x4 (&acc)[2][2][4][2], const g8::Unit& u, int wr, int wc, int fr, int fq) const {
        const int k = u.x0;
#pragma unroll
        for (int ai = 0; ai < 2; ++ai) {
            uint4 gq[4][2], gn[4][2];
#pragma unroll
            for (int m = 0; m < 4; ++m)
#pragma unroll
                for (int bj = 0; bj < 2; ++bj) {
                    const int row = u.pm * 256 + ai * 128 + wr * 64 + m * 16 + fr, col = u.pn * 256 + bj * 128 + wc * 32 + fq * 8;
                    const unsigned go = (unsigned)(OFF_PGATE + (row * 3072 + k * 1024 + col) * 2);
                    gq[m][bj] = ldg<uint4>(ws, go);
                    gn[m][bj] = (k < 2) ? ldg<uint4>(ws, go + 2048) : uint4{0x3f803f80u, 0x3f803f80u, 0x3f803f80u, 0x3f803f80u};
                }
#pragma unroll
            for (int m = 0; m < 4; ++m)
#pragma unroll
                for (int bj = 0; bj < 2; ++bj) {
                    const int row = u.pm * 256 + ai * 128 + wr * 64 + m * 16 + fr, col = u.pn * 256 + bj * 128 + wc * 32 + fq * 8;
                    const uint4 q = gq[m][bj], nx = gn[m][bj];
                    float s[8] = {bf2f((u16)(q.x & 0xffff)), bf2f((u16)(q.x >> 16)), bf2f((u16)(q.y & 0xffff)), bf2f((u16)(q.y >> 16)),
                                  bf2f((u16)(q.z & 0xffff)), bf2f((u16)(q.z >> 16)), bf2f((u16)(q.w & 0xffff)), bf2f((u16)(q.w >> 16))};
                    s[0] *= __builtin_amdgcn_rcpf(bf2f((u16)(nx.x & 0xffff))); s[1] *= __builtin_amdgcn_rcpf(bf2f((u16)(nx.x >> 16)));
                    s[2] *= __builtin_amdgcn_rcpf(bf2f((u16)(nx.y & 0xffff))); s[3] *= __builtin_amdgcn_rcpf(bf2f((u16)(nx.y >> 16)));
                    s[4] *= __builtin_amdgcn_rcpf(bf2f((u16)(nx.z & 0xffff))); s[5] *= __builtin_amdgcn_rcpf(bf2f((u16)(nx.z >> 16)));
                    s[6] *= __builtin_amdgcn_rcpf(bf2f((u16)(nx.w & 0xffff))); s[7] *= __builtin_amdgcn_rcpf(bf2f((u16)(nx.w >> 16)));
#pragma unroll
                    for (int i = 0; i < 4; ++i) { acc[ai][bj][m][0][i] *= s[i]; acc[ai][bj][m][1][i] *= s[4 + i]; }
                    if (k == 2) stg<uint4>(ws, (unsigned)(OFF_MIXP + (row * 1024 + col) * 2), pack8(acc[ai][bj][m][0], acc[ai][bj][m][1]));
                }
        }
        return k < 2;
    }
};

struct MoeSched {
    const int* sm; const unsigned char* ws; unsigned A, Bexp, Bsh, Ash;
    int c, G, npn, K, bstride_e, gather, nsh;
    __device__ __forceinline__ bool next(int i, g8::Unit& u) const {
        int nbr = __builtin_amdgcn_readfirstlane(sm[64]); asm volatile("" : "+s"(nbr));
        const int L = i * G + c; if (L >= (nbr + nsh) * npn) return false;
        const int blk = L / npn; u.pn = L - blk * npn;
        if (blk >= nbr) {
            u.x0 = 64; u.pm = blk - nbr; u.x1 = NTOK;
            u.A = gather ? A : Ash + (unsigned)u.pm * 256 * K * 2;
            u.B = Bsh + (unsigned)u.pn * 256 * K * 2;
        } else {
            int e = __builtin_amdgcn_readfirstlane(sm[256 + blk]);
            int be = __builtin_amdgcn_readfirstlane(sm[e]), re = __builtin_amdgcn_readfirstlane(sm[65 + e]), ce = __builtin_amdgcn_readfirstlane(sm[130 + e]);
            asm volatile("" : "+s"(e), "+s"(be), "+s"(re), "+s"(ce));
            u.x0 = e; u.pm = blk - be; u.x1 = ce;
            u.A = gather ? A : A + (unsigned)(re + u.pm * 256) * K * 2;
            u.B = Bexp + (unsigned)e * bstride_e + (unsigned)u.pn * 256 * K * 2;
        }
        return true;
    }
    __device__ __forceinline__ int row(const g8::Unit& u, int r) const {
        const int rr = u.pm * 256 + r;
        if (u.x0 == 64) return rr;
        return (rr < u.x1) ? (ldg<int>(ws, (unsigned)(OFF_LIST + (u.x0 * NTOK + rr) * 4)) >> 3) : 0;
    }
};
__device__ __forceinline__ void moe_setup(CParams& p, int* sm) {
    __syncthreads();
    if (threadIdx.x == 0) {
        const int* cursor = (const int*)(p.ws + OFF_CUR);
        int nb = 0, nr = 0;
        for (int e = 0; e < 64; ++e) { sm[e] = nb; sm[65 + e] = nr; int c = cursor[e]; sm[130 + e] = c; nb += (c + 255) >> 8; nr += c; }
        sm[64] = nb; sm[129] = nr;
    }
    __syncthreads();
    if (threadIdx.x < 64) { const int e = threadIdx.x; for (int k = sm[e]; k < sm[e + 1]; ++k) sm[256 + k] = e; }
    __syncthreads();
}
struct Moe1Epi {
    static constexpr bool TIMEK = PROBE_TIMEK_Moe1Epi;
    static constexpr bool PERM = false;
    unsigned char* ws; const int* sm;
    __device__ __forceinline__ bool operator()(f32x4 (&acc)[2][2][4][2], const g8::Unit& u, int wr, int wc, int fr, int fq) const {
        const int rbase = (u.x0 == 64) ? 0 : __builtin_amdgcn_readfirstlane(sm[65 + (u.x0 & 63)]);
        const unsigned hoff = (unsigned)((u.x0 == 64) ? OFF_HSH + (size_t)u.pm * 256 * 256 * 2 : OFF_HBUF + (size_t)(rbase + u.pm * 256) * 256 * 2);
        const int valid = u.x1 - u.pm * 256;
        float rw[2][4];
        const unsigned wb = (unsigned)(OFF_WLIST + ((u.x0 & 63) * NTOK + u.pm * 256 + wr * 64 + fr) * 4);
#pragma unroll
        for (int ai = 0; ai < 2; ++ai)
#pragma unroll
            for (int m = 0; m < 4; ++m) {
                const int r = ai * 128 + wr * 64 + m * 16 + fr;
                rw[ai][m] = (u.x0 != 64 && r < valid) ? ldg<float>(ws, wb + (unsigned)((ai * 128 + m * 16) * 4)) : 1.f;
            }
#pragma unroll
        for (int ai = 0; ai < 2; ++ai)
#pragma unroll
            for (int m = 0; m < 4; ++m) {
                const int r = ai * 128 + wr * 64 + m * 16 + fr;
                const float w = rw[ai][m];
#pragma unroll
                for (int bj = 0; bj < 2; ++bj) {
                    const int hid = ((u.pn * 256 + bj * 128 + wc * 32) >> 1) + fq * 4;
                    const f32x4 a = acc[ai][bj][m][0], b = acc[ai][bj][m][1] * w;
                    uint2 pk;
                    pk.x = g8::cvt_pk_bf16(silu_f(a[0]) * b[0], silu_f(a[1]) * b[1]);
                    pk.y = g8::cvt_pk_bf16(silu_f(a[2]) * b[2], silu_f(a[3]) * b[3]);
                    if (r < valid) stg<uint2>(ws, hoff + (unsigned)(r * 256 + hid) * 2u, pk);
                }
                __builtin_amdgcn_sched_barrier(0);
            }
        return false;
    }
};
__device__ void phase_moe1(CParams& p, int l, char* lds) {
    int* sm = (int*)(lds + g8::STAGE_BYTES);
    moe_setup(p, sm);
    MoeSched S; S.sm = sm; S.ws = p.ws;
    S.A = (unsigned)OFF_XM; S.Ash = S.A; S.Bexp = (unsigned)OFF_EW13; S.Bsh = (unsigned)OFF_SH13T;
    S.c = (blockIdx.x & 7) * 32 + (blockIdx.x >> 3); S.G = gridDim.x; S.npn = 2; S.K = 1024; S.bstride_e = 512 * 1024 * 2; S.gather = 1; S.nsh = 64;
    Moe1Epi E; E.ws = p.ws; E.sm = sm;
    g8::gemm_phase<Moe1Epi, MoeSched, true>((LAS unsigned char*)lds, p.ws, 1024, S, E);
}
struct Moe2Epi {
    static constexpr bool TIMEK = PROBE_TIMEK_Moe2Epi;
    static constexpr bool PERM = true;
    unsigned char* ws;
    __device__ __forceinline__ bool operator()(f32x4 (&acc)[2][2][4][2], const g8::Unit& u, int wr, int wc, int fr, int fq) const {
        const int valid = u.x1 - u.pm * 256;
        const int colb = u.pn * 256 + wc * 32 + fq * 8;
        const unsigned lbase = (unsigned)(OFF_LIST + (u.x0 * NTOK + u.pm * 256 + wr * 64 + fr) * 4);
        int ent[2][4];
#pragma unroll
        for (int ai = 0; ai < 2; ++ai)
#pragma unroll
            for (int m = 0; m < 4; ++m) {
                const int r = ai * 128 + wr * 64 + m * 16 + fr;
                ent[ai][m] = (r < valid) ? ldg<int>(ws, lbase + (unsigned)((ai * 128 + m * 16) * 4)) : 0;
            }
#pragma unroll
        for (int ai = 0; ai < 2; ++ai)
#pragma unroll
            for (int m = 0; m < 4; ++m) {
                const int r = ai * 128 + wr * 64 + m * 16 + fr;
                if (r < valid) {
                    const unsigned o = (unsigned)OFF_YBUF + (unsigned)(ent[ai][m] * 1024 + colb);
#pragma unroll
                    for (int bj = 0; bj < 2; ++bj) {
                        const f32x4 a = acc[ai][bj][m][0] * 32.f, b = acc[ai][bj][m][1] * 32.f;
                        int w0 = __builtin_amdgcn_cvt_pk_fp8_f32(a[0], a[1], 0, false); w0 = __builtin_amdgcn_cvt_pk_fp8_f32(a[2], a[3], w0, true);
                        int w1 = __builtin_amdgcn_cvt_pk_fp8_f32(b[0], b[1], 0, false); w1 = __builtin_amdgcn_cvt_pk_fp8_f32(b[2], b[3], w1, true);
                        stg<uint2>(ws, o + bj * 128, uint2{(unsigned)w0, (unsigned)w1});
                    }
                }
                __builtin_amdgcn_sched_barrier(0);
            }
        return false;
    }
};
struct ShSched {
    int c, G;
    __device__ __forceinline__ bool next(int i, g8::Unit& u) const {
        const int L = i * G + c; if (L >= 64 * 4) return false;
        u.pm = L >> 2; u.pn = L & 3; u.A = (unsigned)OFF_HSH + (unsigned)u.pm * 256 * 256 * 2; u.B = (unsigned)OFF_SH2T + (unsigned)u.pn * 256 * 256 * 2; u.x0 = 64; u.x1 = NTOK; return true;
    }
    __device__ __forceinline__ int row(const g8::Unit&, int) const { return 0; }
};
struct ShEpi {
    static constexpr bool TIMEK = PROBE_TIMEK_ShEpi;
    static constexpr bool PERM = false;
    float* ysh;
    __device__ __forceinline__ bool operator()(f32x4 (&acc)[2][2][4][2], const g8::Unit& u, int wr, int wc, int fr, int fq) const {
#pragma unroll
        for (int ai = 0; ai < 2; ++ai)
#pragma unroll
            for (int m = 0; m < 4; ++m) {
                const int row = u.pm * 256 + ai * 128 + wr * 64 + m * 16 + fr;
#pragma unroll
                for (int bj = 0; bj < 2; ++bj)
#pragma unroll
                    for (int n = 0; n < 2; ++n)
                        stg<f32x4>(ysh, (unsigned)((row * 1024 + u.pn * 256 + bj * 128 + wc * 32 + n * 16 + fq * 4) * 4), acc[ai][bj][m][n]);
                __builtin_amdgcn_sched_barrier(0);
            }
        return false;
    }
};
__device__ void phase_moe2(CParams& p, int l, char* lds) {
    int* sm = (int*)(lds + g8::STAGE_BYTES);
    moe_setup(p, sm);
    MoeSched S; S.sm = sm; S.ws = p.ws;
    S.A = (unsigned)OFF_HBUF; S.Ash = (unsigned)OFF_HSH; S.Bexp = (unsigned)OFF_EW2; S.Bsh = (unsigned)OFF_SH2T;
    S.c = (blockIdx.x & 7) * 32 + (blockIdx.x >> 3); S.G = gridDim.x; S.npn = 4; S.K = 256; S.bstride_e = 1024 * 256 * 2; S.gather = 0; S.nsh = 0;
    Moe2Epi E; E.ws = p.ws;
    g8::gemm_phase<Moe2Epi, MoeSched, false>((LAS unsigned char*)lds, p.ws, 256, S, E);
    ShSched S2; S2.c = (blockIdx.x & 7) * 32 + (blockIdx.x >> 3); S2.G = gridDim.x;
    ShEpi E2; E2.ysh = p.out;
    g8::gemm_phase<ShEpi, ShSched, false>((LAS unsigned char*)lds, p.ws, 256, S2, E2);
}

__device__ void conv_tile(const float* s1, const float* s2, int ldsrc, int K, int perm, u16* dst, int tile, float* lds) {
    const int tid = otid();
    const int ktiles = K >> 6;
    const int kt = tile % ktiles, nt = tile / ktiles;
    __syncthreads();
#pragma unroll 4
    for (int i = 0; i < 16; ++i) {
        int idx = tid + i * 256, kr = idx >> 6, nc = idx & 63;
        const float* s; int col;
        if (perm == 32) { s = (nc < 32) ? s1 : s2; col = nt * 32 + (nc & 31); }
        else if (perm == 16) { s = ((nc & 31) < 16) ? s1 : s2; col = (nt * 2 + (nc >> 5)) * 16 + (nc & 15); }
        else { s = s1; col = nt * 64 + nc; }
        lds[kr * 65 + nc] = s[(size_t)(kt * 64 + kr) * ldsrc + col];
    }
    __syncthreads();
#pragma unroll 4
    for (int i = 0; i < 16; ++i) {
        int idx = tid + i * 256, nr = idx >> 6, kc = idx & 63;
        dst[(size_t)(nt * 64 + nr) * K + kt * 64 + kc] = f2bf(lds[kc * 65 + nr]);
    }
}

__device__ void s5_precompute(CParams& p, int l, int g, int part, float* lds) {
    const int tid = otid();
    float* Er = lds;
    float* Ei = Er + 64 * 17;
    float* Br = Ei + 64 * 17;
    float* Bi = Br + 1024;
    float* Cr = Bi + 1024;
    float* Ci = Cr + 1024;
    float* Kt = Ci + 1024;
    __syncthreads();
    const int lg = l * 32 + g;
    const float dt = expf(p.in[12][lg]);
    {
        const int pp = tid & 63, part = tid >> 6;
        const float ar = p.in[5][lg * 64 + pp], ai = p.in[6][lg * 64 + pp];
        for (int tau = part; tau <= 16; tau += 4) {
            float mag = expf((float)tau * ar * dt);
            float ang = (float)tau * ai * dt;
            Er[pp * 17 + tau] = mag * cosf(ang);
            Ei[pp * 17 + tau] = mag * sinf(ang);
        }
        float mag = expf(ar * dt), ang = ai * dt;
        float e1r = mag * cosf(ang) - 1.f, e1i = mag * sinf(ang);
        float den = ar * ar + ai * ai;
        float qr = (e1r * ar + e1i * ai) / den, qi = (e1i * ar - e1r * ai) / den;
        for (int c = part * 4; c < part * 4 + 4; ++c) {
            float br = p.in[7][((size_t)lg * 64 + pp) * 16 + c], bi = p.in[8][((size_t)lg * 64 + pp) * 16 + c];
            Br[pp * 16 + c] = qr * br - qi * bi;
            Bi[pp * 16 + c] = qr * bi + qi * br;
            Cr[c * 64 + pp] = p.in[9][((size_t)lg * 16 + c) * 64 + pp];
            Ci[c * 64 + pp] = p.in[10][((size_t)lg * 16 + c) * 64 + pp];
        }
    }
    __syncthreads();
    u16* bta = (u16*)(p.ws + OFF_BTA) + (size_t)g * 128 * 256;
    for (int i = part * 16; i < part * 16 + 16; ++i) {
        int idx = tid + i * 256, pr = idx >> 8, k = idx & 255, s = k >> 4, ch = k & 15, pp = pr & 63;
        float er = Er[pp * 17 + 15 - s], ei = Ei[pp * 17 + 15 - s], br = Br[pp * 16 + ch], bi = Bi[pp * 16 + ch];
        float v = (pr < 64) ? (er * br - ei * bi) : (er * bi + ei * br);
        bta[idx] = f2bf(v);
    }
    u16* btc = (u16*)(p.ws + OFF_BTC) + (size_t)g * 256 * 384;
    {
        const int ch = tid >> 4, c2 = tid & 15;
        for (int tt = 0; tt < 2; ++tt) {
            const int tau = part * 2 + tt;
            float s = 0.f;
            for (int pp = 0; pp < 64; ++pp) {
                float cr = Cr[ch * 64 + pp], ci = Ci[ch * 64 + pp], er = Er[pp * 17 + tau], ei = Ei[pp * 17 + tau];
                float gr = cr * er - ci * ei, gi = cr * ei + ci * er;
                s += gr * Br[pp * 16 + c2] - gi * Bi[pp * 16 + c2];
            }
            const u16 kv = f2bf(s);
            for (int j = tau; j < 16; ++j) btc[(size_t)(j * 16 + ch) * 384 + (j - tau) * 16 + c2] = kv;
            if (tau > 0) for (int j = 0; j + tau < 16; ++j) btc[(size_t)(j * 16 + ch) * 384 + (j + tau) * 16 + c2] = 0;
        }
        for (int i = 0; i < 16; ++i) {
            const int idx = tid + i * 256, n = part * 32 + (idx >> 7), pr = idx & 127, pp = pr & 63, j = n >> 4, chn = n & 15;
            float cr = Cr[chn * 64 + pp], ci = Ci[chn * 64 + pp], er = Er[pp * 17 + j + 1], ei = Ei[pp * 17 + j + 1];
            float gr = cr * er - ci * ei, gi = cr * ei + ci * er;
            btc[(size_t)n * 384 + 256 + pr] = f2bf((pr < 64) ? gr : -gi);
        }
    }
}

constexpr int W_CONV_TILES = 2608;
__device__ void phase_w(CParams& p, int l, char* lds) {
    const int tid = otid();
    const int nunits = W_CONV_TILES + 256 + 2 + (l == 0 ? 1024 : 0);
    for (int uu = VB; uu < nunits; uu += VG) {
        const int u = (uu < 256) ? uu + W_CONV_TILES : (uu < W_CONV_TILES + 256 ? uu - 256 : uu);
        if (u < W_CONV_TILES) {
            int t = u;
            const float *s1, *s2 = nullptr; int ld, K, perm = 0; u16* dst;
            if (t < 1664) { s1 = p.in[1] + (size_t)l * DM * INC; ld = INC; K = 1024; dst = (u16*)(p.ws + OFF_WINT); }
            else if ((t -= 1664) < 384) { int k = t >> 7; t &= 127; s1 = p.in[22] + (size_t)(l * 3 + k) * 512 * 1024; ld = 1024; K = 512; dst = (u16*)(p.ws + OFF_WBRT) + (size_t)k * 1024 * 512; }
            else if ((t -= 384) < 256) { s1 = p.in[23] + (size_t)l * 1024 * 1024; ld = 1024; K = 1024; dst = (u16*)(p.ws + OFF_WOUTT); }
            else if ((t -= 256) < 64) { s1 = p.in[13] + (size_t)l * 512 * 512; ld = 512; K = 512; dst = (u16*)(p.ws + OFF_GLUT); }
            else if ((t -= 64) < 32) { int h = t >> 3; t &= 7; s1 = p.in[17] + (size_t)(l * 4 + h) * 128 * 128; s2 = p.in[19] + (size_t)(l * 4 + h) * 128 * 128; ld = 128; K = 128; perm = 32; dst = (u16*)(p.ws + OFF_RGT) + (size_t)h * 256 * 128; }
            else if ((t -= 32) < 128) { s1 = p.in[31] + (size_t)l * 1024 * 256; s2 = p.in[32] + (size_t)l * 1024 * 256; ld = 256; K = 1024; perm = 16; dst = (u16*)(p.ws + OFF_SH13T); }
            else if ((t -= 128) < 64) { s1 = p.in[33] + (size_t)l * 256 * 1024; ld = 1024; K = 256; dst = (u16*)(p.ws + OFF_SH2T); }
            else { t -= 64; s1 = p.in[26] + (size_t)l * 1024 * 64; ld = 64; K = 1024; dst = (u16*)(p.ws + OFF_ROUTT); }
            conv_tile(s1, s2, ld, K, perm, dst, t, (float*)lds);
        } else if (u < W_CONV_TILES + 256) {
            s5_precompute(p, l, (u - W_CONV_TILES) >> 3, (u - W_CONV_TILES) & 7, (float*)lds);
        } else if (u == W_CONV_TILES + 256) {
            float* LB = (float*)(p.ws + OFF_LB);
            for (int c = tid; c < 512; c += 256) {
                float x0 = p.in[3][c], x1 = p.in[3][512 + c];
                LB[c] = (l == 0) ? 0.f : 1.f / (1.f + expf(x0 - x1));
            }
            if (tid < 64) ((int*)(p.ws + OFF_CUR))[tid] = 0;
        } else if (u == W_CONV_TILES + 257) {
        } else {
            int r0 = (u - (W_CONV_TILES + 258)) * 16;
            const float4* src = (const float4*)(p.in[0] + (size_t)r0 * DM);
            uint2* dst = (uint2*)((u16*)(p.ws + OFF_XB) + (size_t)r0 * DM);
            for (int i = tid; i < 16 * 256; i += 256) {
                float4 v = src[i];
                uint2 o; o.x = f2bf(v.x) | ((unsigned)f2bf(v.y) << 16); o.y = f2bf(v.z) | ((unsigned)f2bf(v.w) << 16);
                dst[i] = o;
            }
        }
    }
}

__device__ void hgrn_prep(CParams& p, int u, char* lds) {
    const int tid = otid();
    const int h = u & 3, c = (u >> 2) & 63, b = u >> 8;
    const int r0 = b * SEQ + c * 64;
    const unsigned cu = (unsigned)((b * 4 + h) * 64 + c);
    unsigned char* ws = p.ws;
    float* F = (float*)lds;
    u16* Kb = (u16*)(lds + 32768);
    u16* Vb = (u16*)(lds + 49152);
    __syncthreads();
#pragma unroll
    for (int i = 0; i < 8; ++i) {
        const int id = tid + i * 256, s = id >> 5, d4 = (id & 31) * 4;
        *(f32x4*)(F + s * 128 + d4) = ldg<f32x4>(ws, (unsigned)(OFF_PLF + ((r0 + s) * 512 + h * 128 + d4) * 4));
    }
#pragma unroll
    for (int i = 0; i < 4; ++i) {
        const int id = tid + i * 256, s = id >> 4, d8 = (id & 15) * 8;
        *(uint4*)(Kb + s * 128 + d8) = ldg<uint4>(ws, (unsigned)(OFF_PK + ((r0 + s) * 512 + h * 128 + d8) * 2));
        *(uint4*)(Vb + s * 128 + d8) = ldg<uint4>(ws, (unsigned)(OFF_PV + ((r0 + s) * 512 + h * 128 + d8) * 2));
    }
    __syncthreads();
    {
        const int d = tid & 127, hf = tid >> 7;
        float run = 0.f;
#pragma unroll 8
        for (int s = hf * 32; s < hf * 32 + 32; ++s) { run += F[s * 128 + d]; F[s * 128 + d] = run; }
        __syncthreads();
        if (hf) {
            const float add = F[31 * 128 + d];
#pragma unroll 8
            for (int s = 32; s < 64; ++s) F[s * 128 + d] += add;
        }
    }
    __syncthreads();
#pragma unroll
    for (int i = 0; i < 8; ++i) {
        const int id = tid + i * 256, s = id >> 5, d4 = (id & 31) * 4;
        stg<f32x4>(ws, (unsigned)(OFF_PLF + ((r0 + s) * 512 + h * 128 + d4) * 4), *(const f32x4*)(F + s * 128 + d4));
    }
    if (tid < 128) stg<float>(ws, (unsigned)(OFF_DEC + ((b * 64 + c) * 512 + h * 128 + tid) * 4), __expf(F[63 * 128 + tid]));
    {
        const int d = tid & 127;
        const float btot = F[63 * 128 + d];
#pragma unroll
        for (int i = 0; i < 4; ++i) {
            const int s8 = (tid >> 7) + 2 * i;
            bf16x8 ok, ov;
#pragma unroll
            for (int e = 0; e < 8; ++e) {
                const int s = s8 * 8 + e;
                ok[e] = (short)f2bf(bf2f(Kb[s * 128 + d]) * __expf(btot - F[s * 128 + d]));
                ov[e] = (short)Vb[s * 128 + d];
            }
            stg<bf16x8>(ws, (unsigned)(OFF_KTT + ((cu * 128 + d) * 64 + s8 * 8) * 2), ok);
            stg<bf16x8>(ws, (unsigned)(OFF_VT + ((cu * 128 + d) * 64 + s8 * 8) * 2), ov);
        }
    }
}

__device__ void s5_gemm_a(CParams& p, int u, char* lds) {
    LANE_IDS;
    const int wr = wid >> 1, wc = wid & 1;
    const int g = u >> 3, tm = u & 7, row0 = tm * 128;
    unsigned char* ws = p.ws;
    const unsigned aoff = (unsigned)(OFF_PU + (size_t)g * NTOK * 16 * 2), boff = (unsigned)(OFF_BTA + (size_t)g * 128 * 256 * 2);
    f32x4 acc[4][4]; ZERO_ACC(acc, 4, 4);
    mma_glds<128, 128, 2, 2, true>(acc, 4, ws,
        [&](int r, int t) { return aoff + ((row0 + r) * 256 + t * 64) * 2; },
        [&](int c, int t) { return boff + (c * 256 + t * 64) * 2; }, NoHook(), lds);
    epiT<4, 4, 64, 64>(acc, wr, wc, fq, fr, [&](int r, int cc, const f32x4& v) {
        stg<f32x4>(ws, (unsigned)(OFF_VC + (((row0 + r) * 32 + g) * 128 + cc) * 4), v); });
}

__device__ void rg_conv(CParams& p, int l, int u) {
    const int tid = otid();
    const u16* xr = (const u16*)(p.ws + OFF_PXR);
    u16* xc = (u16*)(p.ws + OFF_XC);
    const float* cw = p.in[15] + (size_t)l * 4 * 512;
    const float* cb = p.in[16] + (size_t)l * 512;
    for (int i = tid; i < 64 * 64; i += 256) {
        const int row = u * 64 + (i >> 6), c8 = (i & 63) * 8;
        const int t = row & (SEQ - 1);
        float a[8];
#pragma unroll
        for (int e = 0; e < 8; ++e) a[e] = cb[c8 + e];
#pragma unroll
        for (int j = 0; j < 4; ++j) {
            if (t - 3 + j >= 0) {
                bf16x8 x = *(const bf16x8*)(xr + (size_t)(row - 3 + j) * 512 + c8);
#pragma unroll
                for (int e = 0; e < 8; ++e) a[e] += cw[j * 512 + c8 + e] * bf2f((u16)x[e]);
            }
        }
        bf16x8 o;
#pragma unroll
        for (int e = 0; e < 8; ++e) o[e] = (short)f2bf(a[e]);
        *(bf16x8*)(xc + (size_t)row * 512 + c8) = o;
    }
}

__device__ void phase2(CParams& p, int l, char* lds) {
    for (int u = VB; u < 1536; u += VG) {
        if (u < 1024) hgrn_prep(p, u, lds);
        else if (u < 1280) s5_gemm_a(p, u - 1024, lds);
        else rg_conv(p, l, u - 1280);
    }
}

__device__ void hgrn_u(CParams& p, int u, char* lds) {
    LANE_IDS;
    const int wr = wid >> 1, wc = wid & 1;
    unsigned char* ws = p.ws;
    f32x4 acc[4][4]; ZERO_ACC(acc, 4, 4);
    mma_glds<128, 128, 2, 2>(acc, 1, ws,
        [&](int r, int t) { return (unsigned)(OFF_KTT + ((u * 128 + r) * 64) * 2); },
        [&](int c, int t) { return (unsigned)(OFF_VT + ((u * 128 + c) * 64) * 2); }, NoHook(), lds);
#pragma unroll
    for (int m = 0; m < 4; ++m) {
#pragma unroll
        for (int n = 0; n < 4; ++n) {
            const int d0 = wr * 64 + m * 16 + fq * 4, v = wc * 64 + n * 16 + fr;
            uint2 o;
            o.x = f2bf(acc[m][n][0]) | ((unsigned)f2bf(acc[m][n][1]) << 16);
            o.y = f2bf(acc[m][n][2]) | ((unsigned)f2bf(acc[m][n][3]) << 16);
            stg<uint2>(ws, (unsigned)(OFF_UT + ((u * 128 + v) * 128 + d0) * 2), o);
        }
        __builtin_amdgcn_sched_barrier(0);
    }
}

__device__ void hgrn_sscan(CParams& p, int u) {
    const int tid = otid();
    const int bh = u >> 4, ec = (u & 15) * 256 + tid, v = ec >> 5, d4 = (ec & 31) * 4;
    const int b = bh >> 2, h = bh & 3;
    unsigned char* ws = p.ws;
    const unsigned ub = (unsigned)(OFF_UT + ((bh * 64 * 128 + v) * 128 + d4) * 2);
    const unsigned sb = (unsigned)(OFF_ST + ((bh * 64 * 128 + v) * 128 + d4) * 2);
    const unsigned db = (unsigned)(OFF_DEC + ((b * 64) * 512 + h * 128 + d4) * 4);
    f32x4 S = {0.f, 0.f, 0.f, 0.f};
    for (int c0 = 0; c0 < 64; c0 += 8) {
        uint2 uu[8]; f32x4 dd[8];
#pragma unroll
        for (int i = 0; i < 8; ++i) { uu[i] = ldg<uint2>(ws, ub + (unsigned)((c0 + i) * 128 * 128 * 2)); dd[i] = ldg<f32x4>(ws, db + (unsigned)((c0 + i) * 512 * 4)); }
#pragma unroll
        for (int i = 0; i < 8; ++i) {
            uint2 o;
            o.x = f2bf(S[0]) | ((unsigned)f2bf(S[1]) << 16); o.y = f2bf(S[2]) | ((unsigned)f2bf(S[3]) << 16);
            stg<uint2>(ws, sb + (unsigned)((c0 + i) * 128 * 128 * 2), o);
            S[0] = dd[i][0] * S[0] + bf2f((u16)(uu[i].x & 0xffff)); S[1] = dd[i][1] * S[1] + bf2f((u16)(uu[i].x >> 16));
            S[2] = dd[i][2] * S[2] + bf2f((u16)(uu[i].y & 0xffff)); S[3] = dd[i][3] * S[3] + bf2f((u16)(uu[i].y >> 16));
        }
    }
}

__device__ void s5_scan(CParams& p, int l, int u, char* lds) {
    const int tid = otid();
    const int b = u >> 5, g = u & 31, seg = tid >> 6, pp = tid & 63;
    const int lg = l * 32 + g;
    const float dt = expf(p.in[12][lg]);
    const float ar = p.in[5][lg * 64 + pp], ai = p.in[6][lg * 64 + pp];
    const float mag = expf(16.f * ar * dt), ang = 16.f * ai * dt;
    const float er = mag * cosf(ang), ei = mag * sinf(ang);
    const float mg2 = expf(1024.f * ar * dt), an2 = 1024.f * ai * dt;
    const float sr = mg2 * cosf(an2), si = mg2 * sinf(an2);
    unsigned char* ws = p.ws;
    const unsigned vb = (unsigned)(OFF_VC + (((b * 256 + seg * 64) * 32 + g) * 128 + pp) * 4);
    const unsigned hb = (unsigned)(OFF_HC + (((b * 256 + seg * 64) * 32 + g) * 128 + pp) * 2);
    float* ex = (float*)lds;
    __syncthreads();
    float hr = 0.f, hi = 0.f;
    for (int c0 = 0; c0 < 64; c0 += 16) {
        float vr[16], vi[16];
#pragma unroll
        for (int i = 0; i < 16; ++i) { vr[i] = ldg<float>(ws, vb + (unsigned)((c0 + i) * 4096 * 4)); vi[i] = ldg<float>(ws, vb + (unsigned)((c0 + i) * 4096 * 4 + 256)); }
#pragma unroll
        for (int i = 0; i < 16; ++i) { const float nr = er * hr - ei * hi + vr[i], ni = er * hi + ei * hr + vi[i]; hr = nr; hi = ni; }
    }
    ex[(seg * 64 + pp) * 2] = hr; ex[(seg * 64 + pp) * 2 + 1] = hi;
    __syncthreads();
    hr = 0.f; hi = 0.f;
    for (int sg = 0; sg < seg; ++sg) {
        const float lr = ex[(sg * 64 + pp) * 2], li = ex[(sg * 64 + pp) * 2 + 1];
        const float nr = sr * hr - si * hi + lr, ni = sr * hi + si * hr + li; hr = nr; hi = ni;
    }
    for (int c0 = 0; c0 < 64; c0 += 16) {
        float vr[16], vi[16];
#pragma unroll
        for (int i = 0; i < 16; ++i) { vr[i] = ldg<float>(ws, vb + (unsigned)((c0 + i) * 4096 * 4)); vi[i] = ldg<float>(ws, vb + (unsigned)((c0 + i) * 4096 * 4 + 256)); }
#pragma unroll
        for (int i = 0; i < 16; ++i) {
            stg<u16>(ws, hb + (unsigned)((c0 + i) * 4096 * 2), f2bf(hr));
            stg<u16>(ws, hb + (unsigned)((c0 + i) * 4096 * 2 + 128), f2bf(hi));
            const float nr = er * hr - ei * hi + vr[i], ni = er * hi + ei * hr + vi[i]; hr = nr; hi = ni;
        }
    }
}

__device__ void rg_gemm(CParams& p, int l, int u, char* lds) {
    LANE_IDS;
    const int wr = wid >> 1, wc = wid & 1;
    const int tm = u >> 3, h = (u >> 1) & 3, nt = u & 1, row0 = tm * 128;
    unsigned char* ws = p.ws;
    const unsigned aoff = (unsigned)(OFF_XC + h * 128 * 2), boff = (unsigned)(OFF_RGT + ((size_t)h * 256 * 128 + (size_t)nt * 128 * 128) * 2);
    f32x4 acc[4][4]; ZERO_ACC(acc, 4, 4);
    mma_glds<128, 128, 2, 2, true>(acc, 2, ws,
        [&](int r, int t) { return aoff + ((row0 + r) * 512 + t * 64) * 2; },
        [&](int c, int t) { return boff + (c * 128 + t * 64) * 2; }, NoHook(), lds);
    const float* ba = p.in[18] + (size_t)l * 512;
    const float* bx = p.in[20] + (size_t)l * 512;
    const float* lam = p.in[21] + (size_t)l * 512;
#pragma unroll
    for (int n = 0; n < 2; ++n) {
        const int ch = h * 128 + (nt * 2 + wc) * 32 + n * 16 + fq * 4;
        const f32x4 lm = *(const f32x4*)(lam + ch), bav = *(const f32x4*)(ba + ch), bxv = *(const f32x4*)(bx + ch);
        f32x4 c1;
#pragma unroll
        for (int i = 0; i < 4; ++i) c1[i] = -8.f * log1pf(expf(-lm[i]));
#pragma unroll
        for (int m = 0; m < 4; ++m) {
            const int row = row0 + wr * 64 + m * 16 + fr;
            const f32x4 x = unpack4(ldg<uint2>(ws, (unsigned)(OFF_XC + (row * 512 + ch) * 2)));
            f32x4 la, bb;
#pragma unroll
            for (int i = 0; i < 4; ++i) {
                const float r = sigm(acc[m][n][i] + bav[i]), ig = sigm(acc[m][n + 2][i] + bxv[i]);
                la[i] = c1[i] * r;
                bb[i] = sqrtf(fmaxf(1.f - __expf(2.f * la[i]), 0.f)) * ig * x[i];
            }
            stg<uint2>(ws, (unsigned)(OFF_LA + (row * 512 + ch) * 2), pack4(la));
            stg<uint2>(ws, (unsigned)(OFF_BB + (row * 512 + ch) * 2), pack4(bb));
        }
    }
}

__device__ void phase3(CParams& p, int l, char* lds) {
    for (int u = VB; u < 2176; u += VG) {
        if (u < 128) s5_scan(p, l, u, lds);
        else if (u < 1152) hgrn_u(p, u - 128, lds);
        else rg_gemm(p, l, u - 1152, lds);
    }
}

__device__ void hgrn_out(CParams& p, int l, int u, char* lds) {
    LANE_IDS;
    const int h = u & 3, c = (u >> 2) & 63, b = u >> 8;
    const int r0 = b * SEQ + c * 64;
    const unsigned cu = (unsigned)((b * 4 + h) * 64 + c);
    unsigned char* ws = p.ws;
    char* F = lds;
    char* Qb = lds + 32768;
    char* Kb = lds + 49152;
    char* Ss = lds + 65536;
    __syncthreads();
#pragma unroll
    for (int i = 0; i < 8; ++i) {
        const int id = tid + i * 256, s = id >> 5, ch = id & 31;
        *(f32x4*)(F + s * 512 + ((ch ^ (s & 31)) << 4)) = ldg<f32x4>(ws, (unsigned)(OFF_PLF + ((r0 + s) * 512 + h * 128 + ch * 4) * 4));
    }
#pragma unroll
    for (int i = 0; i < 4; ++i) {
        const int id = tid + i * 256, s = id >> 4, ch = id & 15;
        *(uint4*)(Qb + s * 256 + ((ch ^ (s & 15)) << 4)) = ldg<uint4>(ws, (unsigned)(OFF_PQ + ((r0 + s) * 512 + h * 128 + ch * 8) * 2));
        *(uint4*)(Kb + s * 256 + ((ch ^ (s & 15)) << 4)) = ldg<uint4>(ws, (unsigned)(OFF_PK + ((r0 + s) * 512 + h * 128 + ch * 8) * 2));
    }
    __syncthreads();
    auto ldF8 = [&](int row, int d0, float (&o)[8]) {
        const int c0 = d0 >> 2;
        const f32x4 x = *(const f32x4*)(F + row * 512 + ((c0 ^ (row & 31)) << 4)), y = *(const f32x4*)(F + row * 512 + (((c0 + 1) ^ (row & 31)) << 4));
        o[0] = x[0]; o[1] = x[1]; o[2] = x[2]; o[3] = x[3]; o[4] = y[0]; o[5] = y[1]; o[6] = y[2]; o[7] = y[3];
    };
    auto ldH8 = [&](const char* base, int row, int d0) { return *(const bf16x8*)(base + row * 256 + (((d0 >> 3) ^ (row & 15)) << 4)); };
    {
        const int i = wid;
        const int t = 16 * i + fr;
        bf16x8 aq[4];
        float refv[4][8];
#pragma unroll
        for (int kk = 0; kk < 4; ++kk) {
            const int d0 = kk * 32 + fq * 8;
            float bt[8];
            ldF8(t, d0, bt);
            if (i == 0) {
#pragma unroll
                for (int e = 0; e < 8; ++e) refv[kk][e] = 0.f;
            } else ldF8(16 * i - 1, d0, refv[kk]);
            const bf16x8 q8 = ldH8(Qb, t, d0);
#pragma unroll
            for (int e = 0; e < 8; ++e) aq[kk][e] = (short)f2bf(bf2f((u16)q8[e]) * __expf(bt[e] - refv[kk][e]));
        }
#pragma unroll
        for (int j = 0; j < 4; ++j) {
            f32x4 sc = {0.f, 0.f, 0.f, 0.f};
            if (j <= i) {
                const int s = 16 * j + fr;
#pragma unroll
                for (int kk = 0; kk < 4; ++kk) {
                    const int d0 = kk * 32 + fq * 8;
                    float bs[8];
                    ldF8(s, d0, bs);
                    const bf16x8 k8 = ldH8(Kb, s, d0);
                    bf16x8 bk;
#pragma unroll
                    for (int e = 0; e < 8; ++e) bk[e] = (short)f2bf(bf2f((u16)k8[e]) * __expf(fminf(refv[kk][e] - bs[e], 60.f)));
                    sc = __builtin_amdgcn_mfma_f32_16x16x32_bf16(aq[kk], bk, sc, 0, 0, 0);
                }
            }
#pragma unroll
            for (int r = 0; r < 4; ++r) {
                const int tl = fq * 4 + r, sl = fr;
                float v = sc[r];
                if (j > i || (j == i && sl > tl)) v = 0.f;
                const int row = 16 * i + tl, col = 16 * j + sl;
                *(u16*)(Ss + row * 128 + (((col >> 3) ^ (row & 7)) << 4) + (col & 7) * 2) = f2bf(v);
            }
        }
    }
    __syncthreads();
    f32x4 acc[8];
#pragma unroll
    for (int n = 0; n < 8; ++n) acc[n] = f32x4{0.f, 0.f, 0.f, 0.f};
    auto bsrc = [&](int t, int id) -> unsigned {
        const int vrow = id >> 3, ch = id & 7;
        return (t < 2) ? (unsigned)(OFF_ST + ((cu * 128 + vrow) * 128 + t * 64 + ch * 8) * 2) : (unsigned)(OFF_VT + ((cu * 128 + vrow) * 64 + ch * 8) * 2);
    };
    uint4 rb[4];
#pragma unroll
    for (int i = 0; i < 4; ++i) rb[i] = ldg<uint4>(ws, bsrc(0, tid + i * 256));
    const int arow = wid * 16 + fr;
#pragma unroll 1
    for (int t = 0; t < 3; ++t) {
#pragma unroll
        for (int i = 0; i < 4; ++i) { const int id = tid + i * 256, vrow = id >> 3, ch = id & 7; *(uint4*)(Kb + vrow * 128 + ((ch ^ ((vrow >> 1) & 7)) << 4)) = rb[i]; }
        __syncthreads();
        if (t < 2) {
#pragma unroll
            for (int i = 0; i < 4; ++i) rb[i] = ldg<uint4>(ws, bsrc(t + 1, tid + i * 256));
        }
#pragma unroll
        for (int ks = 0; ks < 2; ++ks) {
            bf16x8 af;
            if (t < 2) {
                const int d0 = t * 64 + ks * 32 + fq * 8;
                float bq[8];
                ldF8(arow, d0, bq);
                const bf16x8 q8 = ldH8(Qb, arow, d0);
#pragma unroll
                for (int e = 0; e < 8; ++e) af[e] = (short)f2bf(bf2f((u16)q8[e]) * __expf(bq[e]));
            } else {
                af = *(const bf16x8*)(Ss + arow * 128 + (((ks * 4 + fq) ^ (arow & 7)) << 4));
            }
#pragma unroll
            for (int n = 0; n < 8; ++n) {
                const int brow = n * 16 + fr;
                const bf16x8 bfr = *(const bf16x8*)(Kb + brow * 128 + (((ks * 4 + fq) ^ ((brow >> 1) & 7)) << 4));
                acc[n] = __builtin_amdgcn_mfma_f32_16x16x32_bf16(bfr, af, acc[n], 0, 0, 0);
            }
        }
        __syncthreads();
    }
    const float* nw = p.in[4] + (size_t)l * 512 + h * 128;
    {
        float ss = 0.f;
#pragma unroll
        for (int n = 0; n < 8; ++n)
#pragma unroll
            for (int j = 0; j < 4; ++j) ss += acc[n][j] * acc[n][j];
        ss += shfl_xor_l(ss, 16, lane); ss += shfl_xor_l(ss, 32, lane);
        const float rs = rsqrtf(ss * (1.f / 128.f) + 1e-6f);
        const int row = r0 + wid * 16 + fr;
#pragma unroll
        for (int n = 0; n < 8; ++n) {
            const int v = n * 16 + fq * 4;
            const f32x4 w4 = *(const f32x4*)(nw + v);
            const f32x4 g4 = unpack4(ldg<uint2>(ws, (unsigned)(OFF_PG + (row * 512 + h * 128 + v) * 2)));
            f32x4 o;
#pragma unroll
            for (int j = 0; j < 4; ++j) o[j] = acc[n][j] * rs * w4[j] * g4[j];
            stg<uint2>(ws, (unsigned)(OFF_YA + (row * 512 + h * 128 + v) * 2), pack4(o));
        }
    }
}

__device__ void s5_gemm_c(CParams& p, int l, int u, char* lds) {
    LANE_IDS;
    const int wr = wid >> 1, wc = wid & 1;
    const int g = u >> 4, tm = (u >> 1) & 7, tn = u & 1, row0 = tm * 128, col0 = tn * 128;
    unsigned char* ws = p.ws;
    const unsigned aoff = (unsigned)(OFF_PU + (size_t)g * NTOK * 16 * 2), boff = (unsigned)(OFF_BTC + (size_t)g * 256 * 384 * 2);
    f32x4 acc[4][4]; ZERO_ACC(acc, 4, 4);
    mma_glds<128, 128, 2, 2, true>(acc, 6, ws,
        [&](int r, int t) {
            return (t < 4) ? aoff + ((row0 + r) * 256 + t * 64) * 2 : (unsigned)(OFF_HC + (((row0 + r) * 32 + g) * 128 + (t - 4) * 64) * 2);
        },
        [&](int c, int t) { return boff + ((col0 + c) * 384 + t * 64) * 2; }, NoHook(), lds);
    const f32x4 dch = *(const f32x4*)(p.in[11] + (size_t)l * 512 + g * 16 + fq * 4);
    epiT<4, 4, 64, 64>(acc, wr, wc, fq, fr, [&](int r, int cc, const f32x4& v) {
        const int row = row0 + r, col = col0 + cc;
        const int jj = col >> 4, ch = col & 15;
        const int tok = (row >> 8) * SEQ + (row & 255) * 16 + jj;
        const f32x4 uu = unpack4(ldg<uint2>(ws, aoff + (tok * 16 + ch) * 2));
        f32x4 y;
#pragma unroll
        for (int i = 0; i < 4; ++i) y[i] = gelu_f(v[i] + dch[i] * uu[i]);
        stg<uint2>(ws, (unsigned)(OFF_YG + (tok * 512 + g * 16 + ch) * 2), pack4(y)); });
}

__device__ __forceinline__ void bf4(const uint2 q, float (&o)[4]) {
    o[0] = bf2f((u16)(q.x & 0xffff)); o[1] = bf2f((u16)(q.x >> 16)); o[2] = bf2f((u16)(q.y & 0xffff)); o[3] = bf2f((u16)(q.y >> 16));
}
__device__ void rg_local(CParams& p, int u) {
    const int tid = otid();
    const int b = u >> 5, seg = (u & 31) * 2 + (tid >> 7), c4 = (tid & 127) * 4;
    unsigned char* ws = p.ws;
    const unsigned base = (unsigned)(((b * SEQ + seg * 64) * 512 + c4) * 2);
    float hh[4] = {0.f, 0.f, 0.f, 0.f}, ap[4] = {1.f, 1.f, 1.f, 1.f};
    for (int s0 = 0; s0 < 64; s0 += 8) {
        uint2 a[8], bb[8];
#pragma unroll
        for (int i = 0; i < 8; ++i) { a[i] = ldg<uint2>(ws, (unsigned)OFF_LA + base + (unsigned)((s0 + i) * 1024)); bb[i] = ldg<uint2>(ws, (unsigned)OFF_BB + base + (unsigned)((s0 + i) * 1024)); }
#pragma unroll
        for (int i = 0; i < 8; ++i) {
            float av[4], bv[4]; bf4(a[i], av); bf4(bb[i], bv);
#pragma unroll
            for (int c = 0; c < 4; ++c) { const float e = __expf(av[c]); hh[c] = e * hh[c] + bv[c]; ap[c] *= e; }
        }
    }
    stg<f32x4>(ws, (unsigned)(OFF_SEGA + ((b * 64 + seg) * 512 + c4) * 4), f32x4{ap[0], ap[1], ap[2], ap[3]});
    stg<f32x4>(ws, (unsigned)(OFF_SEGH + ((b * 64 + seg) * 512 + c4) * 4), f32x4{hh[0], hh[1], hh[2], hh[3]});
}

__device__ void rg_final(CParams& p, int u) {
    const int tid = otid();
    const int b = u >> 5, seg = (u & 31) * 2 + (tid >> 7), c4 = (tid & 127) * 4;
    unsigned char* ws = p.ws;
    const unsigned base = (unsigned)(((b * SEQ + seg * 64) * 512 + c4) * 2);
    f32x4 hh = {0.f, 0.f, 0.f, 0.f};
    for (int sg0 = 0; sg0 < seg; sg0 += 8) {
        f32x4 sa[8], sh[8];
#pragma unroll
        for (int i = 0; i < 8; ++i) {
            const int sg = min(sg0 + i, 63);
            sa[i] = ldg<f32x4>(ws, (unsigned)(OFF_SEGA + ((b * 64 + sg) * 512 + c4) * 4));
            sh[i] = ldg<f32x4>(ws, (unsigned)(OFF_SEGH + ((b * 64 + sg) * 512 + c4) * 4));
        }
#pragma unroll
        for (int i = 0; i < 8; ++i) if (sg0 + i < seg) hh = sa[i] * hh + sh[i];
    }
    for (int s0 = 0; s0 < 64; s0 += 8) {
        uint2 a[8], bb[8], xg[8];
#pragma unroll
        for (int i = 0; i < 8; ++i) {
            a[i] = ldg<uint2>(ws, (unsigned)OFF_LA + base + (unsigned)((s0 + i) * 1024));
            bb[i] = ldg<uint2>(ws, (unsigned)OFF_BB + base + (unsigned)((s0 + i) * 1024));
            xg[i] = ldg<uint2>(ws, (unsigned)OFF_PXG + base + (unsigned)((s0 + i) * 1024));
        }
#pragma unroll
        for (int i = 0; i < 8; ++i) {
            float av[4], bv[4], xv[4]; bf4(a[i], av); bf4(bb[i], bv); bf4(xg[i], xv);
#pragma unroll
            for (int c = 0; c < 4; ++c) hh[c] = __expf(av[c]) * hh[c] + bv[c];
            uint2 o; o.x = f2bf(hh[0] * xv[0]) | ((unsigned)f2bf(hh[1] * xv[1]) << 16); o.y = f2bf(hh[2] * xv[2]) | ((unsigned)f2bf(hh[3] * xv[3]) << 16);
            stg<uint2>(ws, (unsigned)OFF_YC + base + (unsigned)((s0 + i) * 1024), o);
        }
    }
}

__device__ void phase4(CParams& p, int l, char* lds) {
    for (int u = VB; u < 896; u += VG) {
        if (u < 256) hgrn_sscan(p, u);
        else if (u < 384) rg_local(p, u - 256);
        else s5_gemm_c(p, l, u - 384, lds);
    }
}

__device__ void phase_glu(CParams& p, int l, char* lds) {
    LANE_IDS;
    const int wr = wid >> 1, wc = wid & 1;
    unsigned char* ws = p.ws;
    const float* gb = p.in[14] + (size_t)l * 512;
    for (int uu = VB; uu < 1664; uu += VG) {
        if (uu < 128) { rg_final(p, uu); continue; }
        if (uu < 1152) { hgrn_out(p, l, uu - 128, lds); continue; }
        const int u = uu - 1152;
        const int row0 = (u >> 2) * 128, col0 = (u & 3) * 128;
        f32x4 acc[4][4]; ZERO_ACC(acc, 4, 4);
        mma_glds<128, 128, 2, 2, true>(acc, 8, ws,
            [&](int r, int t) { return (unsigned)(OFF_YG + ((row0 + r) * 512 + t * 64) * 2); },
            [&](int c, int t) { return (unsigned)(OFF_GLUT + ((col0 + c) * 512 + t * 64) * 2); }, NoHook(), lds);
        epiT<4, 4, 64, 64>(acc, wr, wc, fq, fr, [&](int r, int cc, const f32x4& v) {
            const int row = row0 + r, col = col0 + cc;
            const f32x4 y = unpack4(ldg<uint2>(ws, (unsigned)(OFF_YG + (row * 512 + col) * 2)));
            const f32x4 bb = *(const f32x4*)(gb + col);
            f32x4 o;
#pragma unroll
            for (int i = 0; i < 4; ++i) o[i] = y[i] * sigm(v[i] + bb[i]);
            stg<uint2>(ws, (unsigned)(OFF_YB + (row * 512 + col) * 2), pack4(o)); });
    }
}

__device__ void phase_branch(CParams& p, int l, char* lds) {
    BrSched S; S.c = blockIdx.x;
    BrEpi E; E.ws = p.ws;
    g8::gemm_phase<BrEpi, BrSched, false>((LAS unsigned char*)lds, p.ws, 512, S, E);
}

__device__ void phase_out(CParams& p, int l, char* lds, char* hlds) {
    {
        OutSched S; S.A = (unsigned)OFF_MIXP; S.B = (unsigned)OFF_WOUTT; S.c = blockIdx.x; S.G = gridDim.x;
        OutEpi E; E.ws = p.ws; E.xres = (l == 0) ? p.in[0] : p.out;
        g8::gemm_phase<OutEpi, OutSched, false>((LAS unsigned char*)lds, p.ws, 1024, S, E);
    }
    for (int u = VB; u < 12288; u += VG) {
        const int e = u / 192, r = u % 192;
        if (r < 128)
            conv_tile(p.in[28] + (size_t)(l * 64 + e) * 1024 * 256, p.in[29] + (size_t)(l * 64 + e) * 1024 * 256, 256, 1024, 16,
                      (u16*)(p.ws + OFF_EW13) + (size_t)e * 512 * 1024, r, (float*)hlds);
        else
            conv_tile(p.in[30] + (size_t)(l * 64 + e) * 256 * 1024, nullptr, 1024, 256, 0,
                      (u16*)(p.ws + OFF_EW2) + (size_t)e * 1024 * 256, r - 128, (float*)hlds);
    }
}

__device__ __forceinline__ void ln_row(float (&v)[16], const float* g, const float* bta, int lane) {
    float s = 0.f;
#pragma unroll
    for (int i = 0; i < 16; ++i) s += v[i];
    const float mu = wave_sum(s, lane) * (1.f / 1024.f);
    float q = 0.f;
#pragma unroll
    for (int i = 0; i < 16; ++i) { float d = v[i] - mu; q += d * d; }
    const float rs = rsqrtf(wave_sum(q, lane) * (1.f / 1024.f) + 1e-5f);
#pragma unroll
    for (int i = 0; i < 4; ++i) {
        const float4 gg = *(const float4*)(g + i * 256 + lane * 4), bb = *(const float4*)(bta + i * 256 + lane * 4);
        v[i * 4 + 0] = (v[i * 4 + 0] - mu) * rs * gg.x + bb.x;
        v[i * 4 + 1] = (v[i * 4 + 1] - mu) * rs * gg.y + bb.y;
        v[i * 4 + 2] = (v[i * 4 + 2] - mu) * rs * gg.z + bb.z;
        v[i * 4 + 3] = (v[i * 4 + 3] - mu) * rs * gg.w + bb.w;
    }
}

__device__ void phase_route(CParams& p, int l, char* lds) {
    LANE_IDS;
    const float* Pre = (const float*)(p.ws + OFF_PRELN);
    u16* Xm = (u16*)(p.ws + OFF_XM);
    const float* g1 = p.in[24] + (size_t)l * 1024;
    const float* b1 = p.in[25] + (size_t)l * 1024;
    const float* rbias = p.in[27] + (size_t)l * 64;
    int* cursor = (int*)(p.ws + OFF_CUR);
    int* list = (int*)(p.ws + OFF_LIST);
    float* wlist = (float*)(p.ws + OFF_WLIST);
    float* Ls = (float*)(lds + 32768);
    int* hist = (int*)(lds + 32768 + 64 * 65 * 4);
    int* basep = hist + 64;
    for (int u = VB; u < 512; u += VG) {
        const int row0 = u * 32;
#pragma unroll 1
        for (int hb = 0; hb < 2; ++hb) {
            float v[4][16];
#pragma unroll
            for (int rr = 0; rr < 4; ++rr) {
                const int row = row0 + wid * 8 + hb * 4 + rr;
#pragma unroll
                for (int i = 0; i < 4; ++i) {
                    const float4 x = *(const float4*)(Pre + (size_t)row * 1024 + i * 256 + lane * 4);
                    v[rr][i * 4] = x.x; v[rr][i * 4 + 1] = x.y; v[rr][i * 4 + 2] = x.z; v[rr][i * 4 + 3] = x.w;
                }
            }
#pragma unroll
            for (int rr = 0; rr < 4; ++rr) {
                const int row = row0 + wid * 8 + hb * 4 + rr;
                ln_row(v[rr], g1, b1, lane);
#pragma unroll
                for (int i = 0; i < 4; ++i) {
                    uint2 o; o.x = f2bf(v[rr][i * 4]) | ((unsigned)f2bf(v[rr][i * 4 + 1]) << 16); o.y = f2bf(v[rr][i * 4 + 2]) | ((unsigned)f2bf(v[rr][i * 4 + 3]) << 16);
                    *(uint2*)(Xm + (size_t)row * 1024 + i * 256 + lane * 4) = o;
                }
            }
        }
        if (tid < 64) hist[tid] = 0;
        __syncthreads();
        f32x4 acc[1][2]; ZERO_ACC(acc, 1, 2);
        mma_glds<32, 64, 2, 2>(acc, 16, p.ws,
            [&](int r, int t) { return (unsigned)(OFF_XM + ((row0 + r) * 1024 + t * 64) * 2); },
            [&](int c, int t) { return (unsigned)(OFF_ROUTT + (c * 1024 + t * 64) * 2); }, NoHook(), lds);
#pragma unroll
        for (int n = 0; n < 2; ++n)
#pragma unroll
            for (int j = 0; j < 4; ++j) {
                const int r = (wid >> 1) * 16 + fq * 4 + j, e = (wid & 1) * 32 + n * 16 + fr;
                Ls[r * 65 + e] = sigm(acc[0][n][j]) + rbias[e];
            }
        __syncthreads();
        int myrank[8]; int myexp[8]; float wv[8];
        if (tid < 32) {
            float* sc = Ls + tid * 65;
            float gs[8];
#pragma unroll
            for (int g = 0; g < 8; ++g) {
                float m1 = -1e30f, m2 = -1e30f;
#pragma unroll
                for (int i = 0; i < 8; ++i) { float x = sc[g * 8 + i]; if (x > m1) { m2 = m1; m1 = x; } else if (x > m2) m2 = x; }
                gs[g] = m1 + m2;
            }
            unsigned gmask = 0;
#pragma unroll
            for (int it = 0; it < 4; ++it) {
                float best = -1e30f; int bi = 0;
#pragma unroll
                for (int g = 0; g < 8; ++g) { bool ok = !((gmask >> g) & 1u) && gs[g] > best; if (ok) { best = gs[g]; bi = g; } }
                gmask |= 1u << bi;
            }
            unsigned long long chosen = 0ull;
            float wsum = 0.f;
#pragma unroll
            for (int k = 0; k < 8; ++k) {
                float best = -1e30f; int bi = 0;
                for (int e = 0; e < 64; ++e) {
                    float x = sc[e];
                    bool ok = ((gmask >> (e >> 3)) & 1u) && !((chosen >> e) & 1ull) && x > best;
                    if (ok) { best = x; bi = e; }
                }
                chosen |= 1ull << bi;
                myexp[k] = bi;
                wv[k] = best - rbias[bi];
                wsum += wv[k];
            }
            const float sc_ = 2.5f / wsum;
#pragma unroll
            for (int k = 0; k < 8; ++k) {
                wv[k] *= sc_;
                myrank[k] = atomicAdd(&hist[myexp[k]], 1);
            }
        }
        __syncthreads();
        if (tid < 64) basep[tid] = atomicAdd(&cursor[tid], hist[tid]);
        __syncthreads();
        if (tid < 32) {
#pragma unroll
            for (int k = 0; k < 8; ++k) {
                const size_t pos = (size_t)myexp[k] * NTOK + basep[myexp[k]] + myrank[k];
                list[pos] = (row0 + tid) * 8 + k;
                wlist[pos] = wv[k];
            }
        }
        __syncthreads();
    }
}

__device__ void phase_combine(CParams& p, int l) {
    LANE_IDS;
    typedef float f32x2 __attribute__((ext_vector_type(2)));
    unsigned char* ws = p.ws;
    const float* g2 = p.in[34] + (size_t)l * 1024 + lane * 16;
    const float* b2 = p.in[35] + (size_t)l * 1024 + lane * 16;
    for (int row = VB * 4 + wid; row < NTOK; row += VG * 4) {
        f32x4 y[4]; uint4 xm[2]; u32x4 yb[8];
#pragma unroll
        for (int i = 0; i < 4; ++i) y[i] = ldg<f32x4>(p.out, (unsigned)((row * 1024 + lane * 16 + i * 4) * 4));
#pragma unroll
        for (int i = 0; i < 2; ++i) xm[i] = ldg<uint4>(ws, (unsigned)(OFF_XM + (row * 1024 + lane * 16 + i * 8) * 2));
#pragma unroll
        for (int k = 0; k < 8; ++k) yb[k] = ldg<u32x4>(ws, (unsigned)OFF_YBUF + (unsigned)((row * 8 + k) * 1024 + lane * 16));
        float v[16], s[16];
#pragma unroll
        for (int i = 0; i < 16; ++i) s[i] = 0.f;
#pragma unroll
        for (int k = 0; k < 8; ++k)
#pragma unroll
            for (int w = 0; w < 4; ++w) {
                const f32x2 lo = __builtin_amdgcn_cvt_pk_f32_fp8((int)yb[k][w], false), hi = __builtin_amdgcn_cvt_pk_f32_fp8((int)yb[k][w], true);
                s[w * 4 + 0] += lo.x; s[w * 4 + 1] += lo.y; s[w * 4 + 2] += hi.x; s[w * 4 + 3] += hi.y;
            }
#pragma unroll
        for (int i = 0; i < 2; ++i) {
            const uint4 x = xm[i];
            const float xf[8] = {bf2f((u16)(x.x & 0xffff)), bf2f((u16)(x.x >> 16)), bf2f((u16)(x.y & 0xffff)), bf2f((u16)(x.y >> 16)),
                                 bf2f((u16)(x.z & 0xffff)), bf2f((u16)(x.z >> 16)), bf2f((u16)(x.w & 0xffff)), bf2f((u16)(x.w >> 16))};
#pragma unroll
            for (int j = 0; j < 8; ++j) v[i * 8 + j] = y[i * 2 + (j >> 2)][j & 3] + DN_ALPHA * xf[j] + s[i * 8 + j] * (1.f / 32.f);
        }
        float sum = 0.f;
#pragma unroll
        for (int i = 0; i < 16; ++i) sum += v[i];
        const float mu = wave_sum(sum, lane) * (1.f / 1024.f);
        float q = 0.f;
#pragma unroll
        for (int i = 0; i < 16; ++i) { const float d = v[i] - mu; q += d * d; }
        const float rs = rsqrtf(wave_sum(q, lane) * (1.f / 1024.f) + 1e-5f);
#pragma unroll
        for (int i = 0; i < 4; ++i) {
            const f32x4 gg = *(const f32x4*)(g2 + i * 4), bb = *(const f32x4*)(b2 + i * 4);
#pragma unroll
            for (int j = 0; j < 4; ++j) v[i * 4 + j] = (v[i * 4 + j] - mu) * rs * gg[j] + bb[j];
            stg<f32x4>(p.out, (unsigned)((row * 1024 + lane * 16 + i * 4) * 4), f32x4{v[i * 4], v[i * 4 + 1], v[i * 4 + 2], v[i * 4 + 3]});
        }
#pragma unroll
        for (int i = 0; i < 2; ++i) {
            uint4 o;
            o.x = f2bf(v[i * 8 + 0]) | ((unsigned)f2bf(v[i * 8 + 1]) << 16); o.y = f2bf(v[i * 8 + 2]) | ((unsigned)f2bf(v[i * 8 + 3]) << 16);
            o.z = f2bf(v[i * 8 + 4]) | ((unsigned)f2bf(v[i * 8 + 5]) << 16); o.w = f2bf(v[i * 8 + 6]) | ((unsigned)f2bf(v[i * 8 + 7]) << 16);
            stg<uint4>(ws, (unsigned)(OFF_XB + (row * 1024 + lane * 16 + i * 8) * 2), o);
        }
    }
}


#define XB_TMO      128
#define XB_XCNT(j)  (256  + 64 * (j))
#define XB_XSUB(j)  (1280 + 64 * (j))
#define XB_XGEN(j)  (2304 + 64 * (j))
#define XB_TOP      3328
#define XB_TOPGEN   3392
#define XCD_BAR_WORDS 3456
#define XB_SPIN_CAP (1u << 22)
__device__ __forceinline__ unsigned xb_ld(unsigned* p)              { return __hip_atomic_load(p, __ATOMIC_RELAXED, __HIP_MEMORY_SCOPE_AGENT); }
__device__ __forceinline__ unsigned xb_add(unsigned* p, unsigned v) { return __hip_atomic_fetch_add(p, v, __ATOMIC_RELAXED, __HIP_MEMORY_SCOPE_AGENT); }
__device__ __forceinline__ unsigned xb_xcc_id() { return (unsigned)__builtin_amdgcn_s_getreg((3 << 11) | 20) & 0xFu; }
#define XB_SPIN(cond, bar) do { unsigned _sp = 0; while (cond) { __builtin_amdgcn_s_sleep(1); \
    if ((++_sp & 255u) == 0u) { if (xb_ld(&(bar)[XB_TMO])) break; if (_sp > XB_SPIN_CAP) { atomicAdd(&(bar)[XB_TMO], 1u); break; } } } } while (0)
struct XcdBarrier { unsigned* bar; unsigned x; volatile LAS unsigned* st; };
__device__ __forceinline__ XcdBarrier xcd_barrier_post(unsigned* bar, volatile LAS unsigned* st) {
    XcdBarrier b; b.bar = bar; b.x = xb_xcc_id(); b.st = st;
    if (threadIdx.x == 0) (void)xb_add(&bar[XB_XCNT(b.x)], 1u);
    return b;
}
__device__ __forceinline__ void xcd_barrier_complete(unsigned* bar, unsigned x, unsigned& nloc, unsigned& nx) {
    const unsigned G = gridDim.x * gridDim.y * gridDim.z;
    unsigned sum, cnt, mine, sp = 0u;
    for (;;) {
        sum = 0u; cnt = 0u; mine = 0u;
#pragma unroll
        for (unsigned j = 0; j < 16; ++j) { const unsigned c = xb_ld(&bar[XB_XCNT(j)]); sum += c; cnt += (c > 0u) ? 1u : 0u; mine = (j == x) ? c : mine; }
        if (sum == G) break;
        __builtin_amdgcn_s_sleep(1);
        if ((++sp & 255u) == 0u) { if (xb_ld(&bar[XB_TMO])) break; if (sp > XB_SPIN_CAP) { atomicAdd(&bar[XB_TMO], 1u); break; } }
    }
    nloc = mine > 0u ? mine : 1u; nx = cnt > 0u ? cnt : 1u;
}
__device__ __forceinline__ void xcd_barrier(const XcdBarrier& b) {
    asm volatile("s_waitcnt vmcnt(0)" ::: "memory");
    __syncthreads();
    if (threadIdx.x == 0) {
        unsigned* bar = b.bar;
        __builtin_amdgcn_s_waitcnt(0);
        unsigned nloc = b.st[0], nx = b.st[1];
        if (nloc == 0u) { xcd_barrier_complete(bar, b.x, nloc, nx); b.st[0] = nloc; b.st[1] = nx; }
        const unsigned old = xb_add(&bar[XB_XSUB(b.x)], 1u);
        const unsigned gen = old / nloc;
        if (old + 1u == (gen + 1u) * nloc) {
            __builtin_amdgcn_fence(__ATOMIC_RELEASE, "agent");
            asm volatile("s_waitcnt vmcnt(0)" ::: "memory");
            const unsigned og = xb_add(&bar[XB_TOP], 1u);
            const unsigned tg = og / nx;
            if (og + 1u == (tg + 1u) * nx) xb_add(&bar[XB_TOPGEN], 1u);
            else XB_SPIN(xb_ld(&bar[XB_TOPGEN]) == tg, bar);
            __builtin_amdgcn_fence(__ATOMIC_ACQUIRE, "agent");
            xb_add(&bar[XB_XGEN(b.x)], 1u);
            asm volatile("s_waitcnt vmcnt(0)" ::: "memory");
        } else {
            XB_SPIN(xb_ld(&bar[XB_XGEN(b.x)]) == gen, bar);
            __builtin_amdgcn_fence(__ATOMIC_ACQUIRE, "agent");
            asm volatile("s_waitcnt vmcnt(0)" ::: "memory");
        }
    }
    __syncthreads();
}

__global__ void __launch_bounds__(512, 2) fwd_kernel(Params p_unused) {
    extern __shared__ __attribute__((aligned(16))) char lds[];
    cg::grid_group grid = cg::this_grid();
    CParams* pp = (CParams*)__builtin_amdgcn_kernarg_segment_ptr();
    const int ph_lo = pp->ph_lo;
    volatile LAS unsigned* xst = (volatile LAS unsigned*)(lds + L_XST);
    if (threadIdx.x == 0) { xst[0] = 0u; xst[1] = 0u; *(LAS unsigned*)(lds + 147456 + 32) = 0u; }
    __syncthreads();
    const XcdBarrier xb = xcd_barrier_post((unsigned*)(pp->ws + OFF_BAR), xst);
    char* hlds = lds + __builtin_amdgcn_readfirstlane((int)(threadIdx.x >> 8)) * HLDS;
    unsigned long long tq_acc = 0;
    (void)ph_lo;
#pragma unroll
    for (int ph = 0; ph < 2 * NPH; ++ph) {
        asm volatile("" : "+s"(pp));
        CParams& p = *pp;
        const int l = ph / NPH, q = ph % NPH;
        unsigned long long tq0 = 0;
        if (PROBE_TQ >= 0 && q == PROBE_TQ) tq0 = __builtin_amdgcn_s_memrealtime();
#pragma unroll 1
        for (int rep = 0; rep < 1 + (int)((PROBE_MASK >> q) & 1u); ++rep) {
            if (rep) xcd_barrier(xb);
            switch (q) {
                case 0: phase_w(p, l, hlds); break;
                case 1: phase_proj(p, l, lds); break;
                case 2: phase2(p, l, hlds); break;
                case 3: phase3(p, l, hlds); break;
                case 4: phase4(p, l, hlds); break;
                case 5: phase_glu(p, l, hlds); break;
                case 6: phase_branch(p, l, lds); break;
                case 7: phase_out(p, l, lds, hlds); break;
                case 8: phase_route(p, l, hlds); break;
                case 9: phase_moe1(p, l, lds); break;
                case 10: phase_moe2(p, l, lds); break;
                default: phase_combine(p, l); break;
            }
        }
        if (ph + 1 < 2 * NPH) {
            if (p.coop == 1) xcd_barrier(xb);
            else if (p.coop == 2) grid.sync();
        }
        if (PROBE_TQ >= 0 && q == PROBE_TQ) tq_acc += __builtin_amdgcn_s_memrealtime() - tq0;
    }
    if (PROBE_TQ == 98) tq_acc = *(LAS unsigned*)(lds + 147456 + 32);
    if (PROBE_TQ >= 0 && blockIdx.x == 0) {
        const unsigned long long t0 = __builtin_amdgcn_s_memrealtime();
        while (__builtin_amdgcn_s_memrealtime() - t0 < 4ull * tq_acc) __builtin_amdgcn_s_sleep(8);
    }
}

extern "C" void kernel_launch(void* const* d_in, const int* in_sizes, int n_in, void* d_out, int out_size, void* d_ws, size_t ws_size,
                              hipStream_t stream) {
    static int grid_blocks = 0;
    if (!grid_blocks) {
        int dev = 0, cus = 0, per_cu = 0;
        (void)hipGetDevice(&dev);
        (void)hipDeviceGetAttribute(&cus, hipDeviceAttributeMultiprocessorCount, dev);
        (void)hipFuncSetAttribute((const void*)fwd_kernel, hipFuncAttributeMaxDynamicSharedMemorySize, LDS_BYTES);
        (void)hipOccupancyMaxActiveBlocksPerMultiprocessor(&per_cu, fwd_kernel, 512, LDS_BYTES);
        if (per_cu < 1) per_cu = 1;
        per_cu = 1;
        grid_blocks = cus * per_cu;
        if (ws_size < WS_NEED) fprintf(stderr, "kernel_launch: workspace too small: %zu < %zu\n", ws_size, (size_t)WS_NEED);
    }
    Params p{};
    for (int i = 0; i < 36; ++i) p.in[i] = (const float*)d_in[i];
    p.out = (float*)d_out;
    p.ws = (unsigned char*)d_ws;
    p.ph_lo = 0; p.ph_hi = 2 * NPH; p.coop = 1; p.pad = 0;
    (void)hipMemsetAsync((char*)d_ws + OFF_BAR, 0, XCD_BAR_WORDS * 4, stream);
    void* args[] = {&p};
    hipError_t e = hipLaunchCooperativeKernel((void*)fwd_kernel, dim3(grid_blocks), dim3(512), args, LDS_BYTES, stream);
    if (e != hipSuccess) fprintf(stderr, "cooperative launch failed: %s (grid %d)\n", hipGetErrorString(e), grid_blocks);
}
```

```cpp
#include <hip/hip_runtime.h>
#include <hip/hip_cooperative_groups.h>
#include <cstdio>
#include <cstdint>
namespace cg = cooperative_groups;

typedef unsigned short u16;
typedef __attribute__((ext_vector_type(8))) short bf16x8;
typedef __attribute__((ext_vector_type(4))) float f32x4;
typedef __attribute__((ext_vector_type(4))) unsigned u32x4;
#define LAS __attribute__((address_space(3)))

constexpr int NTOK = 16384, DM = 1024, SEQ = 4096, BW = 512, INC = 6656;
constexpr int NE = 64, EH = 256;
#ifndef PROBE_MASK
#define PROBE_MASK 0u
#endif
#define PROBE_TIMEK_ProjEpi false
#define PROBE_TIMEK_OutEpi false
#define PROBE_TIMEK_BrEpi false
#define PROBE_TIMEK_Moe1Epi false
#define PROBE_TIMEK_Moe2Epi false
#define PROBE_TIMEK_ShEpi false
#define PROBE_TQ -1
constexpr int NPH = 12;
constexpr float DN_ALPHA = 1.4142135623730951f;
constexpr size_t SLOT = 16777216ull;

constexpr size_t OFF_WINT  = 0;
constexpr size_t OFF_WBRT  = 13631488;
constexpr size_t OFF_WOUTT = 16777216;
constexpr size_t OFF_GLUT  = 18874368;
constexpr size_t OFF_RGT   = 19398656;
constexpr size_t OFF_SH13T = 19660800;
constexpr size_t OFF_SH2T  = 20709376;
constexpr size_t OFF_BTA   = 21233664;
constexpr size_t OFF_BTC   = 23330816;
constexpr size_t OFF_ROUTT = 29622272;
constexpr size_t OFF_MISC  = 29753344;
constexpr size_t OFF_LB    = OFF_MISC;
constexpr size_t OFF_CUR   = OFF_MISC + 2048;
constexpr size_t OFF_DEC   = OFF_MISC + 4096;
constexpr size_t OFF_SEGA  = OFF_DEC + 524288;
constexpr size_t OFF_SEGH  = OFF_SEGA + 524288;
constexpr size_t OFF_XB    = 2 * SLOT;
constexpr size_t OFF_VC    = 29 * SLOT;
constexpr size_t OFF_XC    = 30 * SLOT;
constexpr size_t OFF_MIXP  = 30 * SLOT;
constexpr size_t OFF_LIST  = 2 * SLOT;
constexpr size_t OFF_HSH   = 2 * SLOT + 4194304;
constexpr size_t OFF_WLIST = 2 * SLOT + 4194304 + 8388608;
constexpr size_t OFF_PQ    = 4 * SLOT;
constexpr size_t OFF_PLF   = 5 * SLOT;
constexpr size_t OFF_PK    = 7 * SLOT;
constexpr size_t OFF_PV    = 8 * SLOT;
constexpr size_t OFF_YC    = 8 * SLOT;
constexpr size_t OFF_PG    = 9 * SLOT;
constexpr size_t OFF_PU    = 10 * SLOT;
constexpr size_t OFF_PXG   = 11 * SLOT;
constexpr size_t OFF_PXR   = 12 * SLOT;
constexpr size_t OFF_YB    = 12 * SLOT;
constexpr size_t OFF_PGATE = 13 * SLOT;
constexpr size_t OFF_KTT   = 19 * SLOT;
constexpr size_t OFF_YA    = 19 * SLOT;
constexpr size_t OFF_VT    = 20 * SLOT;
constexpr size_t OFF_ST    = 21 * SLOT;
constexpr size_t OFF_LA    = 23 * SLOT;
constexpr size_t OFF_BB    = 24 * SLOT;
constexpr size_t OFF_YG    = 25 * SLOT;
constexpr size_t OFF_HC    = 26 * SLOT;
constexpr size_t OFF_UT    = 27 * SLOT;
constexpr size_t OFF_PRELN = 4 * SLOT;
constexpr size_t OFF_XM    = 8 * SLOT;
constexpr size_t OFF_EW13  = 10 * SLOT;
constexpr size_t OFF_EW2   = 14 * SLOT;
constexpr size_t OFF_HBUF  = 4 * SLOT;
constexpr size_t OFF_YBUF  = 16 * SLOT;
constexpr size_t OFF_BAR   = 32 * SLOT;
constexpr int HLDS = 73728;
constexpr int LDS_BYTES = 2 * HLDS + 64;
constexpr int L_XST = 2 * HLDS;
constexpr size_t WS_NEED   = 32 * SLOT + 16384;

struct Params {
    const float* in[36];
    float* out;
    unsigned char* ws;
    int ph_lo, ph_hi;
    int coop, pad;
};
typedef const __attribute__((address_space(4))) Params CParams;

__device__ __forceinline__ u16 f2bf(float f) {
    unsigned u = __builtin_bit_cast(unsigned, f);
    return (u16)((u + 0x7fffu + ((u >> 16) & 1u)) >> 16);
}
__device__ __forceinline__ float bf2f(u16 h) { return __builtin_bit_cast(float, (unsigned)h << 16); }
__device__ __forceinline__ float sigm(float x) { return __builtin_amdgcn_rcpf(1.f + __expf(-x)); }
__device__ __forceinline__ float silu_f(float x) { return x * sigm(x); }
__device__ __forceinline__ float gelu_f(float x) {
    float u = 0.7978845608028654f * (x + 0.044715f * x * x * x);
    float t = 1.f - 2.f * __builtin_amdgcn_rcpf(1.f + __expf(2.f * u));
    return 0.5f * x * (1.f + t);
}
__device__ __forceinline__ float shfl_xor_l(float v, int o, int lane) {
    return __builtin_bit_cast(float, __builtin_amdgcn_ds_bpermute((lane ^ o) << 2, __builtin_bit_cast(int, v)));
}
__device__ __forceinline__ float wave_sum(float v, int lane) {
#pragma unroll
    for (int o = 32; o >= 1; o >>= 1) v += shfl_xor_l(v, o, lane);
    return v;
}
__device__ __forceinline__ int swz(int row, int ch) { return row * 128 + ((ch ^ ((row >> 1) & 7)) << 4); }


template <class T> __device__ __forceinline__ T ldg(const void* base, unsigned off) { return *(const T*)((const char*)base + off); }
template <class T> __device__ __forceinline__ void stg(void* base, unsigned off, T v) { *(T*)((char*)base + off) = v; }
template <class T> __device__ __forceinline__ void stg_nt(void* base, unsigned off, T v) { __builtin_nontemporal_store(v, (T*)((char*)base + off)); }

template <int TM, int TN, int RW, int CW, class F>
__device__ __forceinline__ void epi(f32x4 (&acc)[TM][TN], int wr, int wc, int fq, int fr, F f) {
#pragma unroll
    for (int m = 0; m < TM; ++m) {
#pragma unroll
        for (int j = 0; j < 4; ++j) {
#pragma unroll
            for (int n = 0; n < TN; ++n) f(wr * RW + m * 16 + fq * 4 + j, wc * CW + n * 16 + fr, acc[m][n][j]);
        }
        __builtin_amdgcn_sched_barrier(0);
    }
}

template <int TM, int TN, int RW, int CW, class F>
__device__ __forceinline__ void epiT(f32x4 (&acc)[TM][TN], int wr, int wc, int fq, int fr, F f) {
#pragma unroll
    for (int m = 0; m < TM; ++m) {
#pragma unroll
        for (int n = 0; n < TN; ++n) f(wr * RW + m * 16 + fr, wc * CW + n * 16 + fq * 4, acc[m][n]);
    }
}
__device__ __forceinline__ uint2 pack4(const f32x4& a) {
    uint2 w; w.x = f2bf(a[0]) | ((unsigned)f2bf(a[1]) << 16); w.y = f2bf(a[2]) | ((unsigned)f2bf(a[3]) << 16); return w;
}
__device__ __forceinline__ f32x4 unpack4(const uint2 q) {
    return f32x4{bf2f((u16)(q.x & 0xffff)), bf2f((u16)(q.x >> 16)), bf2f((u16)(q.y & 0xffff)), bf2f((u16)(q.y >> 16))};
}

__device__ __forceinline__ int otid() { int t = threadIdx.x & 255; asm volatile("" : "+v"(t)); return t; }
#define VB ((int)blockIdx.x * 2 + __builtin_amdgcn_readfirstlane((int)(threadIdx.x >> 8)))
#define VG ((int)gridDim.x * 2)

struct NoHook { __device__ __forceinline__ void operator()(int) const {} };

template <int BM, int BN, int WM, int WN, bool TR = false, class AL, class BL, class HK>
__device__ __forceinline__ void mma_loop(f32x4 (&acc)[BM / WM / 16][BN / WN / 16], int nk, AL aload, BL bload, HK hook, char* lds) {
    constexpr int TM = BM / WM / 16, TN = BN / WN / 16;
    constexpr int ACH = BM / 32, BCH = BN / 32;
    const int tid = otid(), lane = tid & 63, wid = tid >> 6;
    const int wr = wid / WN, wc = wid % WN, fr = lane & 15, fq = lane >> 4;
    const int srow = tid >> 3, sk = (tid & 7) * 8;
    const int swr = srow * 128 + (((tid & 7) ^ ((tid >> 4) & 7)) << 4);
    const int xr = (fr >> 1) & 7;
    const int a_rd = (wr * (BM / WM) + fr) * 128;
    const int b_rd = BM * 128 + (wc * (BN / WN) + fr) * 128;
    bf16x8 ra[ACH], rb[BCH];
#pragma unroll
    for (int i = 0; i < ACH; ++i) ra[i] = aload(srow + i * 32, sk);
#pragma unroll
    for (int i = 0; i < BCH; ++i) rb[i] = bload(srow + i * 32, sk);
#pragma unroll 1
    for (int t = 0; t < nk; ++t) {
        __syncthreads();
#pragma unroll
        for (int i = 0; i < ACH; ++i) *(bf16x8*)(lds + swr + i * 4096) = ra[i];
#pragma unroll
        for (int i = 0; i < BCH; ++i) *(bf16x8*)(lds + BM * 128 + swr + i * 4096) = rb[i];
        __syncthreads();
        if (t + 1 < nk) {
#pragma unroll
            for (int i = 0; i < ACH; ++i) ra[i] = aload(srow + i * 32, (t + 1) * 64 + sk);
#pragma unroll
            for (int i = 0; i < BCH; ++i) rb[i] = bload(srow + i * 32, (t + 1) * 64 + sk);
        }
        hook(t);
#pragma unroll
        for (int ks = 0; ks < 2; ++ks) {
            const int co = ((ks * 4 + fq) ^ xr) << 4;
            bf16x8 af[TM], bfr[TN];
#pragma unroll
            for (int m = 0; m < TM; ++m) af[m] = *(const bf16x8*)(lds + a_rd + m * 2048 + co);
#pragma unroll
            for (int n = 0; n < TN; ++n) bfr[n] = *(const bf16x8*)(lds + b_rd + n * 2048 + co);
#pragma unroll
            for (int m = 0; m < TM; ++m)
#pragma unroll
                for (int n = 0; n < TN; ++n) acc[m][n] = TR ? __builtin_amdgcn_mfma_f32_16x16x32_bf16(bfr[n], af[m], acc[m][n], 0, 0, 0)
                                                            : __builtin_amdgcn_mfma_f32_16x16x32_bf16(af[m], bfr[n], acc[m][n], 0, 0, 0);
        }
    }
}

template <int BM, int BN, int WM, int WN, bool TR = false, class AO, class BO, class HK>
__device__ __forceinline__ void mma_glds(f32x4 (&acc)[BM / WM / 16][BN / WN / 16], int nk, const unsigned char* ws, AO aoff, BO boff, HK hook, char* lds) {
    constexpr int TM = BM / WM / 16, TN = BN / WN / 16;
    constexpr int ACH = BM / 32, BCH = BN / 32, BUF = (BM + BN) * 128;
    const int tid = otid(), lane = tid & 63, wid = tid >> 6;
    const int wr = wid / WN, wc = wid % WN, fr = lane & 15, fq = lane >> 4;
    const int srow = tid >> 3;
    const unsigned csrc = (unsigned)(((tid & 7) ^ ((tid >> 4) & 7)) << 4);
    const int xr = (fr >> 1) & 7;
    const int a_rd = (wr * (BM / WM) + fr) * 128;
    const int b_rd = BM * 128 + (wc * (BN / WN) + fr) * 128;
    auto stage = [&](int buf, int t) {
        char* d = lds + buf * BUF + tid * 16;
#pragma unroll
        for (int i = 0; i < ACH; ++i)
            __builtin_amdgcn_global_load_lds((const unsigned*)(ws + (aoff(srow + i * 32, t) + csrc)), (unsigned*)(d + i * 4096), 16, 0, 0);
#pragma unroll
        for (int i = 0; i < BCH; ++i)
            __builtin_amdgcn_global_load_lds((const unsigned*)(ws + (boff(srow + i * 32, t) + csrc)), (unsigned*)(d + BM * 128 + i * 4096), 16, 0, 0);
    };
    __syncthreads();
    stage(0, 0);
#pragma unroll 1
    for (int t = 0; t < nk; ++t) {
        asm volatile("s_waitcnt vmcnt(0)" ::: "memory");
        __syncthreads();
        if (t + 1 < nk) stage((t + 1) & 1, t + 1);
        hook(t);
        const char* bb = lds + (t & 1) * BUF;
#pragma unroll
        for (int ks = 0; ks < 2; ++ks) {
            const int co = ((ks * 4 + fq) ^ xr) << 4;
            bf16x8 af[TM], bfr[TN];
#pragma unroll
            for (int m = 0; m < TM; ++m) af[m] = *(const bf16x8*)(bb + a_rd + m * 2048 + co);
#pragma unroll
            for (int n = 0; n < TN; ++n) bfr[n] = *(const bf16x8*)(bb + b_rd + n * 2048 + co);
#pragma unroll
            for (int m = 0; m < TM; ++m)
#pragma unroll
                for (int n = 0; n < TN; ++n) acc[m][n] = TR ? __builtin_amdgcn_mfma_f32_16x16x32_bf16(bfr[n], af[m], acc[m][n], 0, 0, 0)
                                                            : __builtin_amdgcn_mfma_f32_16x16x32_bf16(af[m], bfr[n], acc[m][n], 0, 0, 0);
        }
    }
}

#define ZERO_ACC(acc, TM, TN) _Pragma("unroll") for (int m_ = 0; m_ < TM; ++m_) _Pragma("unroll") for (int n_ = 0; n_ < TN; ++n_) acc[m_][n_] = f32x4{0.f, 0.f, 0.f, 0.f}

#define LANE_IDS const int tid = otid(), lane = tid & 63, wid = tid >> 6, fr = lane & 15, fq = lane >> 4; (void)tid; (void)lane; (void)wid; (void)fr; (void)fq

namespace g8 {
constexpr int BM = 256, BK = 64, HALF = 128, HTB = HALF * BK * 2, STAGE_BYTES = 8 * HTB;
__device__ __forceinline__ int lds_byte(int r, int c) { const int st = (r >> 4) * 2 + (c >> 5), rr = r & 15, cc = c & 31, ob = rr * 64 + cc * 2; return st * 1024 + (ob ^ (((ob >> 9) & 1) << 5)); }
__device__ __forceinline__ void stage_rc(int b, int& R, int& C) { const int st = b / 1024, sb = b % 1024, swz = sb ^ (((sb >> 9) & 1) << 5); R = (st >> 1) * 16 + swz / 64; C = (st & 1) * 32 + (swz % 64) / 2; }
__device__ __forceinline__ int perm32(int rho) { const int n = rho >> 4, i = rho & 15; return 8 * (i >> 2) + 4 * n + (i & 3); }
struct Unit { unsigned A, B; int pm, pn, x0, x1; };
__device__ __forceinline__ unsigned cvt_pk_bf16(float lo, float hi) { unsigned r; asm volatile("v_cvt_pk_bf16_f32 %0, %1, %2" : "=v"(r) : "v"(lo), "v"(hi)); return r; }

template <class Epi, class Sched, bool GATHER>
__device__ __forceinline__ void gemm_phase(LAS unsigned char* lds, const unsigned char* wsb, const int K, const Sched& S, const Epi& E) {
    int tid_ = threadIdx.x; asm volatile("" : "+v"(tid_));
    const int tid = tid_, wid = __builtin_amdgcn_readfirstlane(tid >> 6), lane = tid & 63, wr = wid >> 2, wc = wid & 3, fr = lane & 15, fq = lane >> 4;
    const int nt = K / BK;
    unsigned voffA[2], voffB[2];
#pragma unroll
    for (int i = 0; i < 2; ++i) { int R, C; stage_rc(tid * 16 + i * 8192, R, C); const int Rb = Epi::PERM ? ((R & ~31) + perm32(R & 31)) : R;
        voffA[i] = (unsigned)(R * K + C) * 2u; voffB[i] = (unsigned)(Rb * K + C) * 2u; }
    const unsigned kstep = (unsigned)(BK * 2);
    const unsigned hstep = (unsigned)(HALF * K * 2);
    const unsigned ldsw = (unsigned)wid * 1024u;
    const int aoff = lds_byte(wr * 64 + fr, fq * 8), boff = lds_byte(wc * 32 + fr, fq * 8);
#define G8_SA(b, h) (((b) * 2 + (h)) * HTB)
#define G8_SB(b, h) ((4 + (b) * 2 + (h)) * HTB)
#define G8_STAGE(bufoff, gbase, voff) do { _Pragma("unroll") for (int _i = 0; _i < 2; ++_i) \
        __builtin_amdgcn_global_load_lds((const unsigned*)(wsb + (unsigned)((gbase) + (voff)[_i])), (LAS unsigned*)(lds + (bufoff) + ldsw + _i * 8192), 16, 0, 0); } while (0)
#define G8_STAGE_A(bufoff, kp, h, vg) do { if (GATHER) G8_STAGE(bufoff, kp, vg[h]); else G8_STAGE(bufoff, (kp) + (h) * hstep, voffA); } while (0)
#define G8_LDA(dst, b, h) do { _Pragma("unroll") for (int m = 0; m < 4; ++m) _Pragma("unroll") for (int k = 0; k < 2; ++k) dst[m][k] = *(const LAS bf16x8*)(lds + G8_SA(b, h) + aoff + m * 2048 + k * 1024); } while (0)
#define G8_LDB(dst, b, h) do { _Pragma("unroll") for (int n = 0; n < 2; ++n) _Pragma("unroll") for (int k = 0; k < 2; ++k) dst[n][k] = *(const LAS bf16x8*)(lds + G8_SB(b, h) + boff + n * 2048 + k * 1024); } while (0)
#define G8_MMA(ai, bj, At, Bt) do { __builtin_amdgcn_s_setprio(1); _Pragma("unroll") for (int m = 0; m < 4; ++m) _Pragma("unroll") for (int n = 0; n < 2; ++n) _Pragma("unroll") for (int k = 0; k < 2; ++k) \
        acc[ai][bj][m][n] = __builtin_amdgcn_mfma_f32_16x16x32_bf16(Bt[n][k], At[m][k], acc[ai][bj][m][n], 0, 0, 0); __builtin_amdgcn_s_setprio(0); } while (0)
#define G8_WAIT_V(n) asm volatile("s_waitcnt vmcnt(" #n ")" ::: "memory")
#define G8_WAIT_L(n) asm volatile("s_waitcnt lgkmcnt(" #n ")" ::: "memory")
#define G8_BAR __builtin_amdgcn_s_barrier()
#define G8_SCHED __builtin_amdgcn_sched_barrier(0)
#define G8_GOFF(dst, u) do { _Pragma("unroll") for (int _i = 0; _i < 2; ++_i) { int _R, _C; stage_rc(tid * 16 + _i * 8192, _R, _C); \
        _Pragma("unroll") for (int _h = 0; _h < 2; ++_h) dst[_h][_i] = (unsigned)(S.row(u, _h * HALF + _R) * K + _C) * 2u; } \
        asm volatile("" : "+v"(dst[0][0]), "+v"(dst[0][1]), "+v"(dst[1][0]), "+v"(dst[1][1])); } while (0)
    Unit cur, nxt; int ui = 0;
    if (!S.next(0, cur)) return;
    f32x4 acc[2][2][4][2];
#pragma unroll
    for (int a = 0; a < 2; ++a)
#pragma unroll
        for (int b = 0; b < 2; ++b)
#pragma unroll
            for (int m = 0; m < 4; ++m)
#pragma unroll
                for (int n = 0; n < 2; ++n) acc[a][b][m][n] = (f32x4){0.f, 0.f, 0.f, 0.f};
    bf16x8 At[4][2], B0[2][2], B1[2][2];
    unsigned vgc[2][2] = {{0u, 0u}, {0u, 0u}};
    LAS u32x4* gslot = (LAS u32x4*)(lds + STAGE_BYTES + 4096) + tid;
    unsigned cA = cur.A, cB = cur.B;
    if (GATHER) { G8_GOFF(vgc, cur); }
    G8_STAGE(G8_SB(0, 0), cB, voffB); G8_STAGE_A(G8_SA(0, 0), cA, 0, vgc); G8_STAGE(G8_SB(0, 1), cB + hstep, voffB); G8_STAGE_A(G8_SA(0, 1), cA, 1, vgc);
    if (wr == 1) G8_BAR;
    G8_WAIT_V(4); G8_BAR;
    G8_STAGE(G8_SB(1, 0), cB + kstep, voffB); G8_STAGE_A(G8_SA(1, 0), cA + kstep, 0, vgc); G8_STAGE(G8_SB(1, 1), cB + hstep + kstep, voffB);
    G8_WAIT_V(6); G8_BAR;
    for (;;) {
        const bool has_next = S.next(ui + 1, nxt);
        const unsigned nA = has_next ? nxt.A : cA, nB = has_next ? nxt.B : cB;
        if (GATHER && has_next) {
            unsigned vt[2][2]; G8_GOFF(vt, nxt);
            *gslot = u32x4{vt[0][0], vt[0][1], vt[1][0], vt[1][1]};
        }
        unsigned long long tk0 = 0;
        if (Epi::TIMEK) tk0 = __builtin_amdgcn_s_memrealtime();
#pragma unroll 1
        for (int t = 0; t < nt; t += 2) {
            const bool last = (t == nt - 2);
            const unsigned a1 = cA + (unsigned)(t + 1) * kstep;
            const unsigned a2 = last ? nA : cA + (unsigned)(t + 2) * kstep, b2 = last ? nB : cB + (unsigned)(t + 2) * kstep;
            const unsigned a3 = a2 + kstep, b3 = b2 + kstep;
            G8_LDB(B0, 0, 0); G8_SCHED; G8_LDA(At, 0, 0); G8_STAGE_A(G8_SA(1, 1), a1, 1, vgc);
            G8_WAIT_L(8); G8_BAR; G8_WAIT_L(0); G8_MMA(0, 0, At, B0); G8_BAR; G8_SCHED;
            G8_LDB(B1, 0, 1);
            if (GATHER && last && has_next) { const u32x4 x = *gslot; vgc[0][0] = x[0]; vgc[0][1] = x[1]; vgc[1][0] = x[2]; vgc[1][1] = x[3]; }
            G8_STAGE(G8_SB(0, 0), b2, voffB);
            G8_BAR; G8_WAIT_L(0); G8_MMA(0, 1, At, B1); G8_BAR;
            G8_LDA(At, 0, 1); G8_STAGE_A(G8_SA(0, 0), a2, 0, vgc);
            G8_BAR; G8_WAIT_L(0); G8_MMA(1, 0, At, B0); G8_BAR; G8_SCHED;
            G8_STAGE(G8_SB(0, 1), b2 + hstep, voffB);
            G8_WAIT_V(6); G8_BAR; G8_MMA(1, 1, At, B1); G8_BAR;
            G8_LDB(B0, 1, 0); G8_SCHED; G8_LDA(At, 1, 0); G8_STAGE_A(G8_SA(0, 1), a2, 1, vgc);
            G8_WAIT_L(8); G8_BAR; G8_WAIT_L(0); G8_MMA(0, 0, At, B0); G8_BAR; G8_SCHED;
            G8_LDB(B1, 1, 1); G8_STAGE(G8_SB(1, 0), b3, voffB);
            G8_BAR; G8_WAIT_L(0); G8_MMA(0, 1, At, B1); G8_BAR;
            G8_LDA(At, 1, 1); G8_STAGE_A(G8_SA(1, 0), a3, 0, vgc);
            G8_BAR; G8_WAIT_L(0); G8_MMA(1, 0, At, B0); G8_BAR; G8_SCHED;
            G8_STAGE(G8_SB(1, 1), b3 + hstep, voffB);
            G8_WAIT_V(6); G8_BAR; G8_MMA(1, 1, At, B1); G8_BAR;
        }
        if (Epi::TIMEK && tid == 0) { const unsigned dt = (unsigned)(__builtin_amdgcn_s_memrealtime() - tk0); *(LAS unsigned*)(lds + 147456 + 32) += dt; }
        const bool keep = E(acc, cur, wr, wc, fr, fq);
        if (!has_next) break;
        if (!keep) {
#pragma unroll
        for (int a = 0; a < 2; ++a)
#pragma unroll
            for (int b = 0; b < 2; ++b)
#pragma unroll
                for (int m = 0; m < 4; ++m)
#pragma unroll
                    for (int n = 0; n < 2; ++n) acc[a][b][m][n] = (f32x4){0.f, 0.f, 0.f, 0.f};
        }
        cur = nxt; cA = nA; cB = nB; ++ui;
    }
    G8_WAIT_V(0);
    if (wr == 0) G8_BAR;
    G8_BAR;
#undef G8_SA
#undef G8_SB
#undef G8_STAGE
#undef G8_STAGE_A
#undef G8_LDA
#undef G8_LDB
#undef G8_MMA
#undef G8_WAIT_V
#undef G8_WAIT_L
#undef G8_BAR
#undef G8_SCHED
#undef G8_GOFF
}
}

__device__ __forceinline__ u32x4 pack8v(const f32x4& a, const f32x4& b) {
    u32x4 w; w[0] = g8::cvt_pk_bf16(a[0], a[1]); w[1] = g8::cvt_pk_bf16(a[2], a[3]); w[2] = g8::cvt_pk_bf16(b[0], b[1]); w[3] = g8::cvt_pk_bf16(b[2], b[3]); return w;
}
__device__ __forceinline__ uint4 pack8(const f32x4& a, const f32x4& b) {
    uint4 w; w.x = g8::cvt_pk_bf16(a[0], a[1]); w.y = g8::cvt_pk_bf16(a[2], a[3]); w.z = g8::cvt_pk_bf16(b[0], b[1]); w.w = g8::cvt_pk_bf16(b[2], b[3]); return w;
}

struct ProjSched {
    unsigned A, B; int c, G;
    __device__ __forceinline__ bool next(int i, g8::Unit& u) const {
        const int L = i * G + c; if (L >= 64 * 26) return false;
        const int xcd = L & 7, jx = L >> 3;
        u.pm = xcd * 8 + (jx & 7); u.pn = jx >> 3;
        u.A = A + (unsigned)u.pm * 256 * DM * 2; u.B = B + (unsigned)u.pn * 256 * DM * 2; u.x0 = 0; u.x1 = 0; return true;
    }
    __device__ __forceinline__ int row(const g8::Unit&, int) const { return 0; }
};
struct ProjEpi {
    static constexpr bool TIMEK = PROBE_TIMEK_ProjEpi;
    static constexpr bool PERM = true;
    unsigned char* ws; const float* bg;
    __device__ __forceinline__ bool operator()(f32x4 (&acc)[2][2][4][2], const g8::Unit& u, int wr, int wc, int fr, int fq) const {
        const int seg = (u.pn * 256) >> 9;
        f32x4 cc[2][2];
#pragma unroll
        for (int bj = 0; bj < 2; ++bj) {
            const int col = u.pn * 256 + bj * 128 + wc * 32 + fq * 8;
            if (seg == 1) { cc[bj][0] = ldg<f32x4>(ws, (unsigned)(OFF_LB + (col & 511) * 4)); cc[bj][1] = ldg<f32x4>(ws, (unsigned)(OFF_LB + (col & 511) * 4 + 16)); }
            else if (seg >= 7) { cc[bj][0] = *(const f32x4*)(bg + col - 3584); cc[bj][1] = *(const f32x4*)(bg + col - 3584 + 4); }
            else { cc[bj][0] = f32x4{0.f, 0.f, 0.f, 0.f}; cc[bj][1] = cc[bj][0]; }
        }
#pragma unroll
        for (int ai = 0; ai < 2; ++ai)
#pragma unroll
            for (int m = 0; m < 4; ++m) {
                const int row = u.pm * 256 + ai * 128 + wr * 64 + m * 16 + fr;
#pragma unroll
                for (int bj = 0; bj < 2; ++bj) {
                    const int col = u.pn * 256 + bj * 128 + wc * 32 + fq * 8;
                    const int c = col & 511;
                    f32x4 v0 = acc[ai][bj][m][0], v1 = acc[ai][bj][m][1];
                    if (seg == 0 || seg == 3) {
#pragma unroll
                        for (int i = 0; i < 4; ++i) { v0[i] = silu_f(v0[i]); v1[i] = silu_f(v1[i]); }
                        stg<uint4>(ws, (unsigned)((seg == 0 ? OFF_PQ : OFF_PG) + (row * 512 + c) * 2), pack8(v0, v1));
                    } else if (seg == 1) {
                        const f32x4 l0 = cc[bj][0], l1 = cc[bj][1];
                        f32x4 g0, g1, k0, k1;
#pragma unroll
                        for (int i = 0; i < 4; ++i) {
                            const float s0 = sigm(v0[i]), s1 = sigm(v1[i]);
                            g0[i] = __logf(l0[i] + (1.f - l0[i]) * s0); g1[i] = __logf(l1[i] + (1.f - l1[i]) * s1);
                            k0[i] = (1.f - l0[i]) * (1.f - s0); k1[i] = (1.f - l1[i]) * (1.f - s1);
                        }
                        stg<f32x4>(ws, (unsigned)(OFF_PLF + (row * 512 + c) * 4), g0);
                        stg<f32x4>(ws, (unsigned)(OFF_PLF + (row * 512 + c) * 4 + 16), g1);
                        stg<uint4>(ws, (unsigned)(OFF_PK + (row * 512 + c) * 2), pack8(k0, k1));
                    } else if (seg == 2 || seg == 6) {
                        stg<uint4>(ws, (unsigned)((seg == 2 ? OFF_PV : OFF_PXR) + (row * 512 + c) * 2), pack8(v0, v1));
                    } else if (seg == 4) {
                        stg<uint4>(ws, (unsigned)(OFF_PU + (((c >> 4) * NTOK + row) * 16 + (c & 15)) * 2), pack8(v0, v1));
                    } else if (seg == 5) {
#pragma unroll
                        for (int i = 0; i < 4; ++i) { v0[i] = gelu_f(v0[i]); v1[i] = gelu_f(v1[i]); }
                        stg<uint4>(ws, (unsigned)(OFF_PXG + (row * 512 + c) * 2), pack8(v0, v1));
                    } else {
                        const int gc = col - 3584;
#pragma unroll
                        for (int i = 0; i < 4; ++i) { v0[i] = sigm(v0[i] + cc[bj][0][i]); v1[i] = sigm(v1[i] + cc[bj][1][i]); }
                        stg<uint4>(ws, (unsigned)(OFF_PGATE + (row * 3072 + gc) * 2), pack8(v0, v1));
                    }
                }
            }
        return false;
    }
};
__device__ void phase_proj(CParams& p, int l, char* lds) {
    ProjSched S; S.A = (unsigned)OFF_XB; S.B = (unsigned)OFF_WINT; S.c = blockIdx.x; S.G = gridDim.x;
    ProjEpi E; E.ws = p.ws; E.bg = p.in[2] + (size_t)l * 3072;
    g8::gemm_phase<ProjEpi, ProjSched, false>((LAS unsigned char*)lds, p.ws, 1024, S, E);
}

struct OutSched {
    unsigned A, B; int c, G;
    __device__ __forceinline__ bool next(int i, g8::Unit& u) const {
        const int L = i * G + c; if (L >= 64 * 4) return false;
        const int xcd = L & 7, jx = L >> 3;
        u.pm = xcd * 8 + (jx & 7); u.pn = jx >> 3;
        u.A = A + (unsigned)u.pm * 256 * 1024 * 2; u.B = B + (unsigned)u.pn * 256 * 1024 * 2; u.x0 = 0; u.x1 = 0; return true;
    }
    __device__ __forceinline__ int row(const g8::Unit&, int) const { return 0; }
};
struct OutEpi {
    static constexpr bool TIMEK = PROBE_TIMEK_OutEpi;
    static constexpr bool PERM = false;
    unsigned char* ws;
    __device__ __forceinline__ bool operator()(f32x4 (&acc)[2][2][4][2], const g8::Unit& u, int wr, int wc, int fr, int fq) const {
#pragma unroll
        for (int ai = 0; ai < 2; ++ai) {
            f32x4 x[4][2][2];
#pragma unroll
            for (int m = 0; m < 4; ++m)
#pragma unroll
                for (int bj = 0; bj < 2; ++bj)
#pragma unroll
                    for (int n = 0; n < 2; ++n) {
                        const int row = u.pm * 256 + ai * 128 + wr * 64 + m * 16 + fr, col = u.pn * 256 + bj * 128 + wc * 32 + n * 16 + fq * 4;
                        x[m][bj][n] = unpack4(ldg<uint2>(ws, (unsigned)(OFF_XB + (row * 1024 + col) * 2)));
                    }
#pragma unroll
            for (int m = 0; m < 4; ++m)
#pragma unroll
                for (int bj = 0; bj < 2; ++bj)
#pragma unroll
                    for (int n = 0; n < 2; ++n) {
                        const int row = u.pm * 256 + ai * 128 + wr * 64 + m * 16 + fr, col = u.pn * 256 + bj * 128 + wc * 32 + n * 16 + fq * 4;
                        stg<f32x4>(ws, (unsigned)OFF_PRELN + (unsigned)((row * 1024 + col) * 4), x[m][bj][n] * DN_ALPHA + acc[ai][bj][m][n]);
                    }
        }
        return false;
    }
};

struct BrSched {
    int c;
    __device__ __forceinline__ bool next(int i, g8::Unit& u) const {
        if (i >= 3) return false;
        const int xcd = c & 7, jx = c >> 3;
        u.pm = xcd * 8 + (jx & 7); u.pn = jx >> 3; u.x0 = i; u.x1 = 0;
        u.A = (unsigned)(i == 0 ? OFF_YA : (i == 1 ? OFF_YB : OFF_YC)) + (unsigned)u.pm * 256 * 512 * 2;
        u.B = (unsigned)OFF_WBRT + (unsigned)i * 1024 * 512 * 2 + (unsigned)u.pn * 256 * 512 * 2;
        return true;
    }
    __device__ __forceinline__ int row(const g8::Unit&, int) const { return 0; }
};
struct BrEpi {
    static constexpr bool TIMEK = PROBE_TIMEK_BrEpi;
    static constexpr bool PERM = true;
    unsigned char* ws;
    __device__ __forceinline__ bool operator()(f32x4 (&acc)[2][2][4][2], const g8::Unit& u, int wr, int wc, int fr, int fq) const {
        const int k = u.x0;
#pragma unroll
        for (int ai = 0; ai < 2; ++ai) {
            uint4 gq[4][2], gn[4][2];
#pragma unroll
            for (int m = 0; m < 4; ++m)
#pragma unroll
                for (int bj = 0; bj < 2; ++bj) {
                    const int row = u.pm * 256 + ai * 128 + wr * 64 + m * 16 + fr, col = u.pn * 256 + bj * 128 + wc * 32 + fq * 8;
                    const unsigned go = (unsigned)(OFF_PGATE + (row * 3072 + k * 1024 + col) * 2);
                    gq[m][bj] = ldg<uint4>(ws, go);
                    gn[m][bj] = (k < 2) ? ldg<uint4>(ws, go + 2048) : uint4{0x3f803f80u, 0x3f803f80u, 0x3f803f80u, 0x3f803f80u};
                }
#pragma unroll
            for (int m = 0; m < 4; ++m)
#pragma unroll
                for (int bj = 0; bj < 2; ++bj) {
                    const int row = u.pm * 256 + ai * 128 + wr * 64 + m * 16 + fr, col = u.pn * 256 + bj * 128 + wc * 32 + fq * 8;
                    const uint4 q = gq[m][bj], nx = gn[m][bj];
                    float s[8] = {bf2f((u16)(q.x & 0xffff)), bf2f((u16)(q.x >> 16)), bf2f((u16)(q.y & 0xffff)), bf2f((u16)(q.y >> 16)),
                                  bf2f((u16)(q.z & 0xffff)), bf2f((u16)(q.z >> 16)), bf2f((u16)(q.w & 0xffff)), bf2f((u16)(q.w >> 16))};
                    s[0] *= __builtin_amdgcn_rcpf(bf2f((u16)(nx.x & 0xffff))); s[1] *= __builtin_amdgcn_rcpf(bf2f((u16)(nx.x >> 16)));
                    s[2] *= __builtin_amdgcn_rcpf(bf2f((u16)(nx.y & 0xffff))); s[3] *= __builtin_amdgcn_rcpf(bf2f((u16)(nx.y >> 16)));
                    s[4] *= __builtin_amdgcn_rcpf(bf2f((u16)(nx.z & 0xffff))); s[5] *= __builtin_amdgcn_rcpf(bf2f((u16)(nx.z >> 16)));
                    s[6] *= __builtin_amdgcn_rcpf(bf2f((u16)(nx.w & 0xffff))); s[7] *= __builtin_amdgcn_rcpf(bf2f((u16)(nx.w >> 16)));
#pragma unroll
                    for (int i = 0; i < 4; ++i) { acc[ai][bj][m][0][i] *= s[i]; acc[ai][bj][m][1][i] *= s[4 + i]; }
                    if (k == 2) stg<uint4>(ws, (unsigned)(OFF_MIXP + (row * 1024 + col) * 2), pack8(acc[ai][bj][m][0], acc[ai][bj][m][1]));
                }
        }
        return k < 2;
    }
};

struct MoeSched {
    const int* sm; const unsigned char* ws; unsigned A, Bexp, Bsh, Ash;
    int c, G, npn, K, bstride_e, gather, nsh;
    __device__ __forceinline__ bool next(int i, g8::Unit& u) const {
        int nbr = __builtin_amdgcn_readfirstlane(sm[64]); asm volatile("" : "+s"(nbr));
        const int L = i * G + c; if (L >= (nbr + nsh) * npn) return false;
        const int blk = L / npn; u.pn = L - blk * npn;
        if (blk >= nbr) {
            u.x0 = 64; u.pm = blk - nbr; u.x1 = NTOK;
            u.A = gather ? A : Ash + (unsigned)u.pm * 256 * K * 2;
            u.B = Bsh + (unsigned)u.pn * 256 * K * 2;
        } else {
            int e = __builtin_amdgcn_readfirstlane(sm[256 + blk]);
            int be = __builtin_amdgcn_readfirstlane(sm[e]), re = __builtin_amdgcn_readfirstlane(sm[65 + e]), ce = __builtin_amdgcn_readfirstlane(sm[130 + e]);
            asm volatile("" : "+s"(e), "+s"(be), "+s"(re), "+s"(ce));
            u.x0 = e; u.pm = blk - be; u.x1 = ce;
            u.A = gather ? A : A + (unsigned)(re + u.pm * 256) * K * 2;
            u.B = Bexp + (unsigned)e * bstride_e + (unsigned)u.pn * 256 * K * 2;
        }
        return true;
    }
    __device__ __forceinline__ int row(const g8::Unit& u, int r) const {
        const int rr = u.pm * 256 + r;
        if (u.x0 == 64) return rr;
        return (rr < u.x1) ? (ldg<int>(ws, (unsigned)(OFF_LIST + (u.x0 * NTOK + rr) * 4)) >> 3) : 0;
    }
};
__device__ __forceinline__ void moe_setup(CParams& p, int* sm) {
    __syncthreads();
    if (threadIdx.x == 0) {
        const int* cursor = (const int*)(p.ws + OFF_CUR);
        int nb = 0, nr = 0;
        for (int e = 0; e < 64; ++e) { sm[e] = nb; sm[65 + e] = nr; int c = cursor[e]; sm[130 + e] = c; nb += (c + 255) >> 8; nr += c; }
        sm[64] = nb; sm[129] = nr;
    }
    __syncthreads();
    if (threadIdx.x < 64) { const int e = threadIdx.x; for (int k = sm[e]; k < sm[e + 1]; ++k) sm[256 + k] = e; }
    __syncthreads();
}
struct Moe1Epi {
    static constexpr bool TIMEK = PROBE_TIMEK_Moe1Epi;
    static constexpr bool PERM = false;
    unsigned char* ws; const int* sm;
    __device__ __forceinline__ bool operator()(f32x4 (&acc)[2][2][4][2], const g8::Unit& u, int wr, int wc, int fr, int fq) const {
        const int rbase = (u.x0 == 64) ? 0 : __builtin_amdgcn_readfirstlane(sm[65 + (u.x0 & 63)]);
        const unsigned hoff = (unsigned)((u.x0 == 64) ? OFF_HSH + (size_t)u.pm * 256 * 256 * 2 : OFF_HBUF + (size_t)(rbase + u.pm * 256) * 256 * 2);
        const int valid = u.x1 - u.pm * 256;
        float rw[2][4];
        const unsigned wb = (unsigned)(OFF_WLIST + ((u.x0 & 63) * NTOK + u.pm * 256 + wr * 64 + fr) * 4);
#pragma unroll
        for (int ai = 0; ai < 2; ++ai)
#pragma unroll
            for (int m = 0; m < 4; ++m) {
                const int r = ai * 128 + wr * 64 + m * 16 + fr;
                rw[ai][m] = (u.x0 != 64 && r < valid) ? ldg<float>(ws, wb + (unsigned)((ai * 128 + m * 16) * 4)) : 1.f;
            }
#pragma unroll
        for (int ai = 0; ai < 2; ++ai)
#pragma unroll
            for (int m = 0; m < 4; ++m) {
                const int r = ai * 128 + wr * 64 + m * 16 + fr;
                const float w = rw[ai][m];
#pragma unroll
                for (int bj = 0; bj < 2; ++bj) {
                    const int hid = ((u.pn * 256 + bj * 128 + wc * 32) >> 1) + fq * 4;
                    const f32x4 a = acc[ai][bj][m][0], b = acc[ai][bj][m][1] * w;
                    uint2 pk;
                    pk.x = g8::cvt_pk_bf16(silu_f(a[0]) * b[0], silu_f(a[1]) * b[1]);
                    pk.y = g8::cvt_pk_bf16(silu_f(a[2]) * b[2], silu_f(a[3]) * b[3]);
                    if (r < valid) stg<uint2>(ws, hoff + (unsigned)(r * 256 + hid) * 2u, pk);
                }
                __builtin_amdgcn_sched_barrier(0);
            }
        return false;
    }
};
__device__ void phase_moe1(CParams& p, int l, char* lds) {
    int* sm = (int*)(lds + g8::STAGE_BYTES);
    moe_setup(p, sm);
    MoeSched S; S.sm = sm; S.ws = p.ws;
    S.A = (unsigned)OFF_XM; S.Ash = S.A; S.Bexp = (unsigned)OFF_EW13; S.Bsh = (unsigned)OFF_SH13T;
    S.c = (blockIdx.x & 7) * 32 + (blockIdx.x >> 3); S.G = gridDim.x; S.npn = 2; S.K = 1024; S.bstride_e = 512 * 1024 * 2; S.gather = 1; S.nsh = 64;
    Moe1Epi E; E.ws = p.ws; E.sm = sm;
    g8::gemm_phase<Moe1Epi, MoeSched, true>((LAS unsigned char*)lds, p.ws, 1024, S, E);
}
struct Moe2Epi {
    static constexpr bool TIMEK = PROBE_TIMEK_Moe2Epi;
    static constexpr bool PERM = true;
    unsigned char* ws;
    __device__ __forceinline__ bool operator()(f32x4 (&acc)[2][2][4][2], const g8::Unit& u, int wr, int wc, int fr, int fq) const {
        const int valid = u.x1 - u.pm * 256;
        const int colb = u.pn * 256 + wc * 32 + fq * 8;
        const unsigned lbase = (unsigned)(OFF_LIST + (u.x0 * NTOK + u.pm * 256 + wr * 64 + fr) * 4);
        int ent[2][4];
#pragma unroll
        for (int ai = 0; ai < 2; ++ai)
#pragma unroll
            for (int m = 0; m < 4; ++m) {
                const int r = ai * 128 + wr * 64 + m * 16 + fr;
                ent[ai][m] = (r < valid) ? ldg<int>(ws, lbase + (unsigned)((ai * 128 + m * 16) * 4)) : 0;
            }
#pragma unroll
        for (int ai = 0; ai < 2; ++ai)
#pragma unroll
            for (int m = 0; m < 4; ++m) {
                const int r = ai * 128 + wr * 64 + m * 16 + fr;
                if (r < valid) {
                    const unsigned o = (unsigned)OFF_YBUF + (unsigned)(ent[ai][m] * 1024 + colb);
#pragma unroll
                    for (int bj = 0; bj < 2; ++bj) {
                        const f32x4 a = acc[ai][bj][m][0] * 32.f, b = acc[ai][bj][m][1] * 32.f;
                        int w0 = __builtin_amdgcn_cvt_pk_fp8_f32(a[0], a[1], 0, false); w0 = __builtin_amdgcn_cvt_pk_fp8_f32(a[2], a[3], w0, true);
                        int w1 = __builtin_amdgcn_cvt_pk_fp8_f32(b[0], b[1], 0, false); w1 = __builtin_amdgcn_cvt_pk_fp8_f32(b[2], b[3], w1, true);
                        stg<uint2>(ws, o + bj * 128, uint2{(unsigned)w0, (unsigned)w1});
                    }
                }
                __builtin_amdgcn_sched_barrier(0);
            }
        return false;
    }
};
struct ShSched {
    int c, G;
    __device__ __forceinline__ bool next(int i, g8::Unit& u) const {
        const int L = i * G + c; if (L >= 64 * 4) return false;
        u.pm = L >> 2; u.pn = L & 3; u.A = (unsigned)OFF_HSH + (unsigned)u.pm * 256 * 256 * 2; u.B = (unsigned)OFF_SH2T + (unsigned)u.pn * 256 * 256 * 2; u.x0 = 64; u.x1 = NTOK; return true;
    }
    __device__ __forceinline__ int row(const g8::Unit&, int) const { return 0; }
};
struct ShEpi {
    static constexpr bool TIMEK = PROBE_TIMEK_ShEpi;
    static constexpr bool PERM = false;
    float* ysh;
    __device__ __forceinline__ bool operator()(f32x4 (&acc)[2][2][4][2], const g8::Unit& u, int wr, int wc, int fr, int fq) const {
#pragma unroll
        for (int ai = 0; ai < 2; ++ai)
#pragma unroll
            for (int m = 0; m < 4; ++m) {
                const int row = u.pm * 256 + ai * 128 + wr * 64 + m * 16 + fr;
#pragma unroll
                for (int bj = 0; bj < 2; ++bj)
#pragma unroll
                    for (int n = 0; n < 2; ++n)
                        stg<f32x4>(ysh, (unsigned)((row * 1024 + u.pn * 256 + bj * 128 + wc * 32 + n * 16 + fq * 4) * 4), acc[ai][bj][m][n]);
                __builtin_amdgcn_sched_barrier(0);
            }
        return false;
    }
};
__device__ void phase_moe2(CParams& p, int l, char* lds) {
    int* sm = (int*)(lds + g8::STAGE_BYTES);
    moe_setup(p, sm);
    MoeSched S; S.sm = sm; S.ws = p.ws;
    S.A = (unsigned)OFF_HBUF; S.Ash = (unsigned)OFF_HSH; S.Bexp = (unsigned)OFF_EW2; S.Bsh = (unsigned)OFF_SH2T;
    S.c = (blockIdx.x & 7) * 32 + (blockIdx.x >> 3); S.G = gridDim.x; S.npn = 4; S.K = 256; S.bstride_e = 1024 * 256 * 2; S.gather = 0; S.nsh = 0;
    Moe2Epi E; E.ws = p.ws;
    g8::gemm_phase<Moe2Epi, MoeSched, false>((LAS unsigned char*)lds, p.ws, 256, S, E);
    ShSched S2; S2.c = (blockIdx.x & 7) * 32 + (blockIdx.x >> 3); S2.G = gridDim.x;
    ShEpi E2; E2.ysh = p.out;
    g8::gemm_phase<ShEpi, ShSched, false>((LAS unsigned char*)lds, p.ws, 256, S2, E2);
}

__device__ void conv_tile(const float* s1, const float* s2, int ldsrc, int K, int perm, u16* dst, int tile, float* lds) {
    const int tid = otid();
    const int ktiles = K >> 6;
    const int kt = tile % ktiles, nt = tile / ktiles;
    __syncthreads();
#pragma unroll 4
    for (int i = 0; i < 16; ++i) {
        int idx = tid + i * 256, kr = idx >> 6, nc = idx & 63;
        const float* s; int col;
        if (perm == 32) { s = (nc < 32) ? s1 : s2; col = nt * 32 + (nc & 31); }
        else if (perm == 16) { s = ((nc & 31) < 16) ? s1 : s2; col = (nt * 2 + (nc >> 5)) * 16 + (nc & 15); }
        else { s = s1; col = nt * 64 + nc; }
        lds[kr * 65 + nc] = s[(size_t)(kt * 64 + kr) * ldsrc + col];
    }
    __syncthreads();
#pragma unroll 4
    for (int i = 0; i < 16; ++i) {
        int idx = tid + i * 256, nr = idx >> 6, kc = idx & 63;
        dst[(size_t)(nt * 64 + nr) * K + kt * 64 + kc] = f2bf(lds[kc * 65 + nr]);
    }
}

__device__ void s5_precompute(CParams& p, int l, int g, int part, float* lds) {
    const int tid = otid();
    float* Er = lds;
    float* Ei = Er + 64 * 17;
    float* Br = Ei + 64 * 17;
    float* Bi = Br + 1024;
    float* Cr = Bi + 1024;
    float* Ci = Cr + 1024;
    float* Kt = Ci + 1024;
    __syncthreads();
    const int lg = l * 32 + g;
    const float dt = expf(p.in[12][lg]);
    {
        const int pp = tid & 63, part = tid >> 6;
        const float ar = p.in[5][lg * 64 + pp], ai = p.in[6][lg * 64 + pp];
        for (int tau = part; tau <= 16; tau += 4) {
            float mag = expf((float)tau * ar * dt);
            float ang = (float)tau * ai * dt;
            Er[pp * 17 + tau] = mag * cosf(ang);
            Ei[pp * 17 + tau] = mag * sinf(ang);
        }
        float mag = expf(ar * dt), ang = ai * dt;
        float e1r = mag * cosf(ang) - 1.f, e1i = mag * sinf(ang);
        float den = ar * ar + ai * ai;
        float qr = (e1r * ar + e1i * ai) / den, qi = (e1i * ar - e1r * ai) / den;
        for (int c = part * 4; c < part * 4 + 4; ++c) {
            float br = p.in[7][((size_t)lg * 64 + pp) * 16 + c], bi = p.in[8][((size_t)lg * 64 + pp) * 16 + c];
            Br[pp * 16 + c] = qr * br - qi * bi;
            Bi[pp * 16 + c] = qr * bi + qi * br;
            Cr[c * 64 + pp] = p.in[9][((size_t)lg * 16 + c) * 64 + pp];
            Ci[c * 64 + pp] = p.in[10][((size_t)lg * 16 + c) * 64 + pp];
        }
    }
    __syncthreads();
    u16* bta = (u16*)(p.ws + OFF_BTA) + (size_t)g * 128 * 256;
    for (int i = part * 16; i < part * 16 + 16; ++i) {
        int idx = tid + i * 256, pr = idx >> 8, k = idx & 255, s = k >> 4, ch = k & 15, pp = pr & 63;
        float er = Er[pp * 17 + 15 - s], ei = Ei[pp * 17 + 15 - s], br = Br[pp * 16 + ch], bi = Bi[pp * 16 + ch];
        float v = (pr < 64) ? (er * br - ei * bi) : (er * bi + ei * br);
        bta[idx] = f2bf(v);
    }
    u16* btc = (u16*)(p.ws + OFF_BTC) + (size_t)g * 256 * 384;
    {
        const int ch = tid >> 4, c2 = tid & 15;
        for (int tt = 0; tt < 2; ++tt) {
            const int tau = part * 2 + tt;
            float s = 0.f;
            for (int pp = 0; pp < 64; ++pp) {
                float cr = Cr[ch * 64 + pp], ci = Ci[ch * 64 + pp], er = Er[pp * 17 + tau], ei = Ei[pp * 17 + tau];
                float gr = cr * er - ci * ei, gi = cr * ei + ci * er;
                s += gr * Br[pp * 16 + c2] - gi * Bi[pp * 16 + c2];
            }
            const u16 kv = f2bf(s);
            for (int j = tau; j < 16; ++j) btc[(size_t)(j * 16 + ch) * 384 + (j - tau) * 16 + c2] = kv;
            if (tau > 0) for (int j = 0; j + tau < 16; ++j) btc[(size_t)(j * 16 + ch) * 384 + (j + tau) * 16 + c2] = 0;
        }
        for (int i = 0; i < 16; ++i) {
            const int idx = tid + i * 256, n = part * 32 + (idx >> 7), pr = idx & 127, pp = pr & 63, j = n >> 4, chn = n & 15;
            float cr = Cr[chn * 64 + pp], ci = Ci[chn * 64 + pp], er = Er[pp * 17 + j + 1], ei = Ei[pp * 17 + j + 1];
            float gr = cr * er - ci * ei, gi = cr * ei + ci * er;
            btc[(size_t)n * 384 + 256 + pr] = f2bf((pr < 64) ? gr : -gi);
        }
    }
}

constexpr int W_CONV_TILES = 2608;
__device__ void phase_w(CParams& p, int l, char* lds) {
    const int tid = otid();
    const int nunits = W_CONV_TILES + 256 + 2 + (l == 0 ? 1024 : 0);
    for (int uu = VB; uu < nunits; uu += VG) {
        const int u = (uu < 256) ? uu + W_CONV_TILES : (uu < W_CONV_TILES + 256 ? uu - 256 : uu);
        if (u < W_CONV_TILES) {
            int t = u;
            const float *s1, *s2 = nullptr; int ld, K, perm = 0; u16* dst;
            if (t < 1664) { s1 = p.in[1] + (size_t)l * DM * INC; ld = INC; K = 1024; dst = (u16*)(p.ws + OFF_WINT); }
            else if ((t -= 1664) < 384) { int k = t >> 7; t &= 127; s1 = p.in[22] + (size_t)(l * 3 + k) * 512 * 1024; ld = 1024; K = 512; dst = (u16*)(p.ws + OFF_WBRT) + (size_t)k * 1024 * 512; }
            else if ((t -= 384) < 256) { s1 = p.in[23] + (size_t)l * 1024 * 1024; ld = 1024; K = 1024; dst = (u16*)(p.ws + OFF_WOUTT); }
            else if ((t -= 256) < 64) { s1 = p.in[13] + (size_t)l * 512 * 512; ld = 512; K = 512; dst = (u16*)(p.ws + OFF_GLUT); }
            else if ((t -= 64) < 32) { int h = t >> 3; t &= 7; s1 = p.in[17] + (size_t)(l * 4 + h) * 128 * 128; s2 = p.in[19] + (size_t)(l * 4 + h) * 128 * 128; ld = 128; K = 128; perm = 32; dst = (u16*)(p.ws + OFF_RGT) + (size_t)h * 256 * 128; }
            else if ((t -= 32) < 128) { s1 = p.in[31] + (size_t)l * 1024 * 256; s2 = p.in[32] + (size_t)l * 1024 * 256; ld = 256; K = 1024; perm = 16; dst = (u16*)(p.ws + OFF_SH13T); }
            else if ((t -= 128) < 64) { s1 = p.in[33] + (size_t)l * 256 * 1024; ld = 1024; K = 256; dst = (u16*)(p.ws + OFF_SH2T); }
            else { t -= 64; s1 = p.in[26] + (size_t)l * 1024 * 64; ld = 64; K = 1024; dst = (u16*)(p.ws + OFF_ROUTT); }
            conv_tile(s1, s2, ld, K, perm, dst, t, (float*)lds);
        } else if (u < W_CONV_TILES + 256) {
            s5_precompute(p, l, (u - W_CONV_TILES) >> 3, (u - W_CONV_TILES) & 7, (float*)lds);
        } else if (u == W_CONV_TILES + 256) {
            float* LB = (float*)(p.ws + OFF_LB);
            for (int c = tid; c < 512; c += 256) {
                float x0 = p.in[3][c], x1 = p.in[3][512 + c];
                LB[c] = (l == 0) ? 0.f : 1.f / (1.f + expf(x0 - x1));
            }
            if (tid < 64) ((int*)(p.ws + OFF_CUR))[tid] = 0;
        } else if (u == W_CONV_TILES + 257) {
        } else {
            int r0 = (u - (W_CONV_TILES + 258)) * 16;
            const float4* src = (const float4*)(p.in[0] + (size_t)r0 * DM);
            uint2* dst = (uint2*)((u16*)(p.ws + OFF_XB) + (size_t)r0 * DM);
            for (int i = tid; i < 16 * 256; i += 256) {
                float4 v = src[i];
                uint2 o; o.x = f2bf(v.x) | ((unsigned)f2bf(v.y) << 16); o.y = f2bf(v.z) | ((unsigned)f2bf(v.w) << 16);
                dst[i] = o;
            }
        }
    }
}

__device__ void hgrn_prep(CParams& p, int u, char* lds) {
    const int tid = otid();
    const int h = u & 3, c = (u >> 2) & 63, b = u >> 8;
    const int r0 = b * SEQ + c * 64;
    const unsigned cu = (unsigned)((b * 4 + h) * 64 + c);
    unsigned char* ws = p.ws;
    float* F = (float*)lds;
    u16* Kb = (u16*)(lds + 32768);
    u16* Vb = (u16*)(lds + 49152);
    __syncthreads();
#pragma unroll
    for (int i = 0; i < 8; ++i) {
        const int id = tid + i * 256, s = id >> 5, d4 = (id & 31) * 4;
        *(f32x4*)(F + s * 128 + d4) = ldg<f32x4>(ws, (unsigned)(OFF_PLF + ((r0 + s) * 512 + h * 128 + d4) * 4));
    }
#pragma unroll
    for (int i = 0; i < 4; ++i) {
        const int id = tid + i * 256, s = id >> 4, d8 = (id & 15) * 8;
        *(uint4*)(Kb + s * 128 + d8) = ldg<uint4>(ws, (unsigned)(OFF_PK + ((r0 + s) * 512 + h * 128 + d8) * 2));
        *(uint4*)(Vb + s * 128 + d8) = ldg<uint4>(ws, (unsigned)(OFF_PV + ((r0 + s) * 512 + h * 128 + d8) * 2));
    }
    __syncthreads();
    {
        const int d = tid & 127, hf = tid >> 7;
        float run = 0.f;
#pragma unroll 8
        for (int s = hf * 32; s < hf * 32 + 32; ++s) { run += F[s * 128 + d]; F[s * 128 + d] = run; }
        __syncthreads();
        if (hf) {
            const float add = F[31 * 128 + d];
#pragma unroll 8
            for (int s = 32; s < 64; ++s) F[s * 128 + d] += add;
        }
    }
    __syncthreads();
#pragma unroll
    for (int i = 0; i < 8; ++i) {
        const int id = tid + i * 256, s = id >> 5, d4 = (id & 31) * 4;
        stg<f32x4>(ws, (unsigned)(OFF_PLF + ((r0 + s) * 512 + h * 128 + d4) * 4), *(const f32x4*)(F + s * 128 + d4));
    }
    if (tid < 128) stg<float>(ws, (unsigned)(OFF_DEC + ((b * 64 + c) * 512 + h * 128 + tid) * 4), __expf(F[63 * 128 + tid]));
    {
        const int d = tid & 127;
        const float btot = F[63 * 128 + d];
#pragma unroll
        for (int i = 0; i < 4; ++i) {
            const int s8 = (tid >> 7) + 2 * i;
            bf16x8 ok, ov;
#pragma unroll
            for (int e = 0; e < 8; ++e) {
                const int s = s8 * 8 + e;
                ok[e] = (short)f2bf(bf2f(Kb[s * 128 + d]) * __expf(btot - F[s * 128 + d]));
                ov[e] = (short)Vb[s * 128 + d];
            }
            stg<bf16x8>(ws, (unsigned)(OFF_KTT + ((cu * 128 + d) * 64 + s8 * 8) * 2), ok);
            stg<bf16x8>(ws, (unsigned)(OFF_VT + ((cu * 128 + d) * 64 + s8 * 8) * 2), ov);
        }
    }
}

__device__ void s5_gemm_a(CParams& p, int u, char* lds) {
    LANE_IDS;
    const int wr = wid >> 1, wc = wid & 1;
    const int g = u >> 3, tm = u & 7, row0 = tm * 128;
    unsigned char* ws = p.ws;
    const unsigned aoff = (unsigned)(OFF_PU + (size_t)g * NTOK * 16 * 2), boff = (unsigned)(OFF_BTA + (size_t)g * 128 * 256 * 2);
    f32x4 acc[4][4]; ZERO_ACC(acc, 4, 4);
    mma_glds<128, 128, 2, 2, true>(acc, 4, ws,
        [&](int r, int t) { return aoff + ((row0 + r) * 256 + t * 64) * 2; },
        [&](int c, int t) { return boff + (c * 256 + t * 64) * 2; }, NoHook(), lds);
    epiT<4, 4, 64, 64>(acc, wr, wc, fq, fr, [&](int r, int cc, const f32x4& v) {
        stg<f32x4>(ws, (unsigned)(OFF_VC + (((row0 + r) * 32 + g) * 128 + cc) * 4), v); });
}

__device__ void rg_conv(CParams& p, int l, int u) {
    const int tid = otid();
    const u16* xr = (const u16*)(p.ws + OFF_PXR);
    u16* xc = (u16*)(p.ws + OFF_XC);
    const float* cw = p.in[15] + (size_t)l * 4 * 512;
    const float* cb = p.in[16] + (size_t)l * 512;
    for (int i = tid; i < 64 * 64; i += 256) {
        const int row = u * 64 + (i >> 6), c8 = (i & 63) * 8;
        const int t = row & (SEQ - 1);
        float a[8];
#pragma unroll
        for (int e = 0; e < 8; ++e) a[e] = cb[c8 + e];
#pragma unroll
        for (int j = 0; j < 4; ++j) {
            if (t - 3 + j >= 0) {
                bf16x8 x = *(const bf16x8*)(xr + (size_t)(row - 3 + j) * 512 + c8);
#pragma unroll
                for (int e = 0; e < 8; ++e) a[e] += cw[j * 512 + c8 + e] * bf2f((u16)x[e]);
            }
        }
        bf16x8 o;
#pragma unroll
        for (int e = 0; e < 8; ++e) o[e] = (short)f2bf(a[e]);
        *(bf16x8*)(xc + (size_t)row * 512 + c8) = o;
    }
}

__device__ void phase2(CParams& p, int l, char* lds) {
    for (int u = VB; u < 1536; u += VG) {
        if (u < 1024) hgrn_prep(p, u, lds);
        else if (u < 1280) s5_gemm_a(p, u - 1024, lds);
        else rg_conv(p, l, u - 1280);
    }
}

__device__ void hgrn_u(CParams& p, int u, char* lds) {
    LANE_IDS;
    const int wr = wid >> 1, wc = wid & 1;
    unsigned char* ws = p.ws;
    f32x4 acc[4][4]; ZERO_ACC(acc, 4, 4);
    mma_glds<128, 128, 2, 2>(acc, 1, ws,
        [&](int r, int t) { return (unsigned)(OFF_KTT + ((u * 128 + r) * 64) * 2); },
        [&](int c, int t) { return (unsigned)(OFF_VT + ((u * 128 + c) * 64) * 2); }, NoHook(), lds);
#pragma unroll
    for (int m = 0; m < 4; ++m) {
#pragma unroll
        for (int n = 0; n < 4; ++n) {
            const int d0 = wr * 64 + m * 16 + fq * 4, v = wc * 64 + n * 16 + fr;
            uint2 o;
            o.x = f2bf(acc[m][n][0]) | ((unsigned)f2bf(acc[m][n][1]) << 16);
            o.y = f2bf(acc[m][n][2]) | ((unsigned)f2bf(acc[m][n][3]) << 16);
            stg<uint2>(ws, (unsigned)(OFF_UT + ((u * 128 + v) * 128 + d0) * 2), o);
        }
        __builtin_amdgcn_sched_barrier(0);
    }
}

__device__ void hgrn_sscan(CParams& p, int item) {
    const int bh = item >> 12, ec = item & 4095, v = ec >> 5, d4 = (ec & 31) * 4;
    const int b = bh >> 2, h = bh & 3;
    unsigned char* ws = p.ws;
    const unsigned ub = (unsigned)(OFF_UT + ((bh * 64 * 128 + v) * 128 + d4) * 2);
    const unsigned sb = (unsigned)(OFF_ST + ((bh * 64 * 128 + v) * 128 + d4) * 2);
    const unsigned db = (unsigned)(OFF_DEC + ((b * 64) * 512 + h * 128 + d4) * 4);
    f32x4 S = {0.f, 0.f, 0.f, 0.f};
    for (int c0 = 0; c0 < 64; c0 += 8) {
        uint2 uu[8]; f32x4 dd[8];
#pragma unroll
        for (int i = 0; i < 8; ++i) { uu[i] = ldg<uint2>(ws, ub + (unsigned)((c0 + i) * 128 * 128 * 2)); dd[i] = ldg<f32x4>(ws, db + (unsigned)((c0 + i) * 512 * 4)); }
#pragma unroll
        for (int i = 0; i < 8; ++i) {
            uint2 o;
            o.x = f2bf(S[0]) | ((unsigned)f2bf(S[1]) << 16); o.y = f2bf(S[2]) | ((unsigned)f2bf(S[3]) << 16);
            stg<uint2>(ws, sb + (unsigned)((c0 + i) * 128 * 128 * 2), o);
            S[0] = dd[i][0] * S[0] + bf2f((u16)(uu[i].x & 0xffff)); S[1] = dd[i][1] * S[1] + bf2f((u16)(uu[i].x >> 16));
            S[2] = dd[i][2] * S[2] + bf2f((u16)(uu[i].y & 0xffff)); S[3] = dd[i][3] * S[3] + bf2f((u16)(uu[i].y >> 16));
        }
    }
}

__device__ void s5_scan(CParams& p, int l, int u, char* lds) {
    const int tid = otid();
    const int b = u >> 5, g = u & 31, seg = tid >> 6, pp = tid & 63;
    const int lg = l * 32 + g;
    const float dt = expf(p.in[12][lg]);
    const float ar = p.in[5][lg * 64 + pp], ai = p.in[6][lg * 64 + pp];
    const float mag = expf(16.f * ar * dt), ang = 16.f * ai * dt;
    const float er = mag * cosf(ang), ei = mag * sinf(ang);
    const float mg2 = expf(1024.f * ar * dt), an2 = 1024.f * ai * dt;
    const float sr = mg2 * cosf(an2), si = mg2 * sinf(an2);
    unsigned char* ws = p.ws;
    const unsigned vb = (unsigned)(OFF_VC + (((b * 256 + seg * 64) * 32 + g) * 128 + pp) * 4);
    const unsigned hb = (unsigned)(OFF_HC + (((b * 256 + seg * 64) * 32 + g) * 128 + pp) * 2);
    float* ex = (float*)lds;
    __syncthreads();
    float hr = 0.f, hi = 0.f;
    for (int c0 = 0; c0 < 64; c0 += 16) {
        float vr[16], vi[16];
#pragma unroll
        for (int i = 0; i < 16; ++i) { vr[i] = ldg<float>(ws, vb + (unsigned)((c0 + i) * 4096 * 4)); vi[i] = ldg<float>(ws, vb + (unsigned)((c0 + i) * 4096 * 4 + 256)); }
#pragma unroll
        for (int i = 0; i < 16; ++i) { const float nr = er * hr - ei * hi + vr[i], ni = er * hi + ei * hr + vi[i]; hr = nr; hi = ni; }
    }
    ex[(seg * 64 + pp) * 2] = hr; ex[(seg * 64 + pp) * 2 + 1] = hi;
    __syncthreads();
    hr = 0.f; hi = 0.f;
    for (int sg = 0; sg < seg; ++sg) {
        const float lr = ex[(sg * 64 + pp) * 2], li = ex[(sg * 64 + pp) * 2 + 1];
        const float nr = sr * hr - si * hi + lr, ni = sr * hi + si * hr + li; hr = nr; hi = ni;
    }
    for (int c0 = 0; c0 < 64; c0 += 16) {
        float vr[16], vi[16];
#pragma unroll
        for (int i = 0; i < 16; ++i) { vr[i] = ldg<float>(ws, vb + (unsigned)((c0 + i) * 4096 * 4)); vi[i] = ldg<float>(ws, vb + (unsigned)((c0 + i) * 4096 * 4 + 256)); }
#pragma unroll
        for (int i = 0; i < 16; ++i) {
            stg<u16>(ws, hb + (unsigned)((c0 + i) * 4096 * 2), f2bf(hr));
            stg<u16>(ws, hb + (unsigned)((c0 + i) * 4096 * 2 + 128), f2bf(hi));
            const float nr = er * hr - ei * hi + vr[i], ni = er * hi + ei * hr + vi[i]; hr = nr; hi = ni;
        }
    }
}

__device__ void rg_gemm(CParams& p, int l, int u, char* lds) {
    LANE_IDS;
    const int wr = wid >> 1, wc = wid & 1;
    const int tm = u >> 3, h = (u >> 1) & 3, nt = u & 1, row0 = tm * 128;
    unsigned char* ws = p.ws;
    const unsigned aoff = (unsigned)(OFF_XC + h * 128 * 2), boff = (unsigned)(OFF_RGT + ((size_t)h * 256 * 128 + (size_t)nt * 128 * 128) * 2);
    f32x4 acc[4][4]; ZERO_ACC(acc, 4, 4);
    mma_glds<128, 128, 2, 2, true>(acc, 2, ws,
        [&](int r, int t) { return aoff + ((row0 + r) * 512 + t * 64) * 2; },
        [&](int c, int t) { return boff + (c * 128 + t * 64) * 2; }, NoHook(), lds);
    const float* ba = p.in[18] + (size_t)l * 512;
    const float* bx = p.in[20] + (size_t)l * 512;
    const float* lam = p.in[21] + (size_t)l * 512;
#pragma unroll
    for (int n = 0; n < 2; ++n) {
        const int ch = h * 128 + (nt * 2 + wc) * 32 + n * 16 + fq * 4;
        const f32x4 lm = *(const f32x4*)(lam + ch), bav = *(const f32x4*)(ba + ch), bxv = *(const f32x4*)(bx + ch);
        f32x4 c1;
#pragma unroll
        for (int i = 0; i < 4; ++i) c1[i] = -8.f * log1pf(expf(-lm[i]));
#pragma unroll
        for (int m = 0; m < 4; ++m) {
            const int row = row0 + wr * 64 + m * 16 + fr;
            const f32x4 x = unpack4(ldg<uint2>(ws, (unsigned)(OFF_XC + (row * 512 + ch) * 2)));
            f32x4 la, bb;
#pragma unroll
            for (int i = 0; i < 4; ++i) {
                const float r = sigm(acc[m][n][i] + bav[i]), ig = sigm(acc[m][n + 2][i] + bxv[i]);
                la[i] = c1[i] * r;
                bb[i] = sqrtf(fmaxf(1.f - __expf(2.f * la[i]), 0.f)) * ig * x[i];
            }
            stg<uint2>(ws, (unsigned)(OFF_LA + (row * 512 + ch) * 2), pack4(la));
            stg<uint2>(ws, (unsigned)(OFF_BB + (row * 512 + ch) * 2), pack4(bb));
        }
    }
}

__device__ void phase3(CParams& p, int l, char* lds) {
    for (int u = VB; u < 2176; u += VG) {
        if (u < 128) s5_scan(p, l, u, lds);
        else if (u < 1152) hgrn_u(p, u - 128, lds);
        else rg_gemm(p, l, u - 1152, lds);
    }
}

__device__ void hgrn_out(CParams& p, int l, int u, char* lds) {
    LANE_IDS;
    const int h = u & 3, c = (u >> 2) & 63, b = u >> 8;
    const int r0 = b * SEQ + c * 64;
    const unsigned cu = (unsigned)((b * 4 + h) * 64 + c);
    unsigned char* ws = p.ws;
    char* F = lds;
    char* Qb = lds + 32768;
    char* Kb = lds + 49152;
    char* Ss = lds + 65536;
    __syncthreads();
#pragma unroll
    for (int i = 0; i < 8; ++i) {
        const int id = tid + i * 256, s = id >> 5, ch = id & 31;
        *(f32x4*)(F + s * 512 + ((ch ^ (s & 31)) << 4)) = ldg<f32x4>(ws, (unsigned)(OFF_PLF + ((r0 + s) * 512 + h * 128 + ch * 4) * 4));
    }
#pragma unroll
    for (int i = 0; i < 4; ++i) {
        const int id = tid + i * 256, s = id >> 4, ch = id & 15;
        *(uint4*)(Qb + s * 256 + ((ch ^ (s & 15)) << 4)) = ldg<uint4>(ws, (unsigned)(OFF_PQ + ((r0 + s) * 512 + h * 128 + ch * 8) * 2));
        *(uint4*)(Kb + s * 256 + ((ch ^ (s & 15)) << 4)) = ldg<uint4>(ws, (unsigned)(OFF_PK + ((r0 + s) * 512 + h * 128 + ch * 8) * 2));
    }
    __syncthreads();
    auto ldF8 = [&](int row, int d0, float (&o)[8]) {
        const int c0 = d0 >> 2;
        const f32x4 x = *(const f32x4*)(F + row * 512 + ((c0 ^ (row & 31)) << 4)), y = *(const f32x4*)(F + row * 512 + (((c0 + 1) ^ (row & 31)) << 4));
        o[0] = x[0]; o[1] = x[1]; o[2] = x[2]; o[3] = x[3]; o[4] = y[0]; o[5] = y[1]; o[6] = y[2]; o[7] = y[3];
    };
    auto ldH8 = [&](const char* base, int row, int d0) { return *(const bf16x8*)(base + row * 256 + (((d0 >> 3) ^ (row & 15)) << 4)); };
    {
        const int i = wid;
        const int t = 16 * i + fr;
        bf16x8 aq[4];
        float refv[4][8];
#pragma unroll
        for (int kk = 0; kk < 4; ++kk) {
            const int d0 = kk * 32 + fq * 8;
            float bt[8];
            ldF8(t, d0, bt);
            if (i == 0) {
#pragma unroll
                for (int e = 0; e < 8; ++e) refv[kk][e] = 0.f;
            } else ldF8(16 * i - 1, d0, refv[kk]);
            const bf16x8 q8 = ldH8(Qb, t, d0);
#pragma unroll
            for (int e = 0; e < 8; ++e) aq[kk][e] = (short)f2bf(bf2f((u16)q8[e]) * __expf(bt[e] - refv[kk][e]));
        }
#pragma unroll
        for (int j = 0; j < 4; ++j) {
            f32x4 sc = {0.f, 0.f, 0.f, 0.f};
            if (j <= i) {
                const int s = 16 * j + fr;
#pragma unroll
                for (int kk = 0; kk < 4; ++kk) {
                    const int d0 = kk * 32 + fq * 8;
                    float bs[8];
                    ldF8(s, d0, bs);
                    const bf16x8 k8 = ldH8(Kb, s, d0);
                    bf16x8 bk;
#pragma unroll
                    for (int e = 0; e < 8; ++e) bk[e] = (short)f2bf(bf2f((u16)k8[e]) * __expf(fminf(refv[kk][e] - bs[e], 60.f)));
                    sc = __builtin_amdgcn_mfma_f32_16x16x32_bf16(aq[kk], bk, sc, 0, 0, 0);
                }
            }
#pragma unroll
            for (int r = 0; r < 4; ++r) {
                const int tl = fq * 4 + r, sl = fr;
                float v = sc[r];
                if (j > i || (j == i && sl > tl)) v = 0.f;
                const int row = 16 * i + tl, col = 16 * j + sl;
                *(u16*)(Ss + row * 128 + (((col >> 3) ^ (row & 7)) << 4) + (col & 7) * 2) = f2bf(v);
            }
        }
    }
    __syncthreads();
    f32x4 acc[8];
#pragma unroll
    for (int n = 0; n < 8; ++n) acc[n] = f32x4{0.f, 0.f, 0.f, 0.f};
    auto bsrc = [&](int t, int id) -> unsigned {
        const int vrow = id >> 3, ch = id & 7;
        return (t < 2) ? (unsigned)(OFF_ST + ((cu * 128 + vrow) * 128 + t * 64 + ch * 8) * 2) : (unsigned)(OFF_VT + ((cu * 128 + vrow) * 64 + ch * 8) * 2);
    };
    uint4 rb[4];
#pragma unroll
    for (int i = 0; i < 4; ++i) rb[i] = ldg<uint4>(ws, bsrc(0, tid + i * 256));
    const int arow = wid * 16 + fr;
#pragma unroll 1
    for (int t = 0; t < 3; ++t) {
#pragma unroll
        for (int i = 0; i < 4; ++i) { const int id = tid + i * 256, vrow = id >> 3, ch = id & 7; *(uint4*)(Kb + vrow * 128 + ((ch ^ ((vrow >> 1) & 7)) << 4)) = rb[i]; }
        __syncthreads();
        if (t < 2) {
#pragma unroll
            for (int i = 0; i < 4; ++i) rb[i] = ldg<uint4>(ws, bsrc(t + 1, tid + i * 256));
        }
#pragma unroll
        for (int ks = 0; ks < 2; ++ks) {
            bf16x8 af;
            if (t < 2) {
                const int d0 = t * 64 + ks * 32 + fq * 8;
                float bq[8];
                ldF8(arow, d0, bq);
                const bf16x8 q8 = ldH8(Qb, arow, d0);
#pragma unroll
                for (int e = 0; e < 8; ++e) af[e] = (short)f2bf(bf2f((u16)q8[e]) * __expf(bq[e]));
            } else {
                af = *(const bf16x8*)(Ss + arow * 128 + (((ks * 4 + fq) ^ (arow & 7)) << 4));
            }
#pragma unroll
            for (int n = 0; n < 8; ++n) {
                const int brow = n * 16 + fr;
                const bf16x8 bfr = *(const bf16x8*)(Kb + brow * 128 + (((ks * 4 + fq) ^ ((brow >> 1) & 7)) << 4));
                acc[n] = __builtin_amdgcn_mfma_f32_16x16x32_bf16(bfr, af, acc[n], 0, 0, 0);
            }
        }
        __syncthreads();
    }
    const float* nw = p.in[4] + (size_t)l * 512 + h * 128;
    {
        float ss = 0.f;
#pragma unroll
        for (int n = 0; n < 8; ++n)
#pragma unroll
            for (int j = 0; j < 4; ++j) ss += acc[n][j] * acc[n][j];
        ss += shfl_xor_l(ss, 16, lane); ss += shfl_xor_l(ss, 32, lane);
        const float rs = rsqrtf(ss * (1.f / 128.f) + 1e-6f);
        const int row = r0 + wid * 16 + fr;
#pragma unroll
        for (int n = 0; n < 8; ++n) {
            const int v = n * 16 + fq * 4;
            const f32x4 w4 = *(const f32x4*)(nw + v);
            const f32x4 g4 = unpack4(ldg<uint2>(ws, (unsigned)(OFF_PG + (row * 512 + h * 128 + v) * 2)));
            f32x4 o;
#pragma unroll
            for (int j = 0; j < 4; ++j) o[j] = acc[n][j] * rs * w4[j] * g4[j];
            stg<uint2>(ws, (unsigned)(OFF_YA + (row * 512 + h * 128 + v) * 2), pack4(o));
        }
    }
}

__device__ void s5_gemm_c(CParams& p, int l, int u, char* lds) {
    LANE_IDS;
    const int wr = wid >> 1, wc = wid & 1;
    const int g = u >> 4, tm = (u >> 1) & 7, tn = u & 1, row0 = tm * 128, col0 = tn * 128;
    unsigned char* ws = p.ws;
    const unsigned aoff = (unsigned)(OFF_PU + (size_t)g * NTOK * 16 * 2), boff = (unsigned)(OFF_BTC + (size_t)g * 256 * 384 * 2);
    f32x4 acc[4][4]; ZERO_ACC(acc, 4, 4);
    mma_glds<128, 128, 2, 2, true>(acc, 6, ws,
        [&](int r, int t) {
            return (t < 4) ? aoff + ((row0 + r) * 256 + t * 64) * 2 : (unsigned)(OFF_HC + (((row0 + r) * 32 + g) * 128 + (t - 4) * 64) * 2);
        },
        [&](int c, int t) { return boff + ((col0 + c) * 384 + t * 64) * 2; }, NoHook(), lds);
    const f32x4 dch = *(const f32x4*)(p.in[11] + (size_t)l * 512 + g * 16 + fq * 4);
    epiT<4, 4, 64, 64>(acc, wr, wc, fq, fr, [&](int r, int cc, const f32x4& v) {
        const int row = row0 + r, col = col0 + cc;
        const int jj = col >> 4, ch = col & 15;
        const int tok = (row >> 8) * SEQ + (row & 255) * 16 + jj;
        const f32x4 uu = unpack4(ldg<uint2>(ws, aoff + (tok * 16 + ch) * 2));
        f32x4 y;
#pragma unroll
        for (int i = 0; i < 4; ++i) y[i] = gelu_f(v[i] + dch[i] * uu[i]);
        stg<uint2>(ws, (unsigned)(OFF_YG + (tok * 512 + g * 16 + ch) * 2), pack4(y)); });
}

__device__ __forceinline__ void bf4(const uint2 q, float (&o)[4]) {
    o[0] = bf2f((u16)(q.x & 0xffff)); o[1] = bf2f((u16)(q.x >> 16)); o[2] = bf2f((u16)(q.y & 0xffff)); o[3] = bf2f((u16)(q.y >> 16));
}
__device__ void rg_local(CParams& p, int item) {
    const int b = item >> 13, seg = (item >> 7) & 63, c4 = (item & 127) * 4;
    unsigned char* ws = p.ws;
    const unsigned base = (unsigned)(((b * SEQ + seg * 64) * 512 + c4) * 2);
    float hh[4] = {0.f, 0.f, 0.f, 0.f}, ap[4] = {1.f, 1.f, 1.f, 1.f};
    for (int s0 = 0; s0 < 64; s0 += 8) {
        uint2 a[8], bb[8];
#pragma unroll
        for (int i = 0; i < 8; ++i) { a[i] = ldg<uint2>(ws, (unsigned)OFF_LA + base + (unsigned)((s0 + i) * 1024)); bb[i] = ldg<uint2>(ws, (unsigned)OFF_BB + base + (unsigned)((s0 + i) * 1024)); }
#pragma unroll
        for (int i = 0; i < 8; ++i) {
            float av[4], bv[4]; bf4(a[i], av); bf4(bb[i], bv);
#pragma unroll
            for (int c = 0; c < 4; ++c) { const float e = __expf(av[c]); hh[c] = e * hh[c] + bv[c]; ap[c] *= e; }
        }
    }
    stg<f32x4>(ws, (unsigned)(OFF_SEGA + ((b * 64 + seg) * 512 + c4) * 4), f32x4{ap[0], ap[1], ap[2], ap[3]});
    stg<f32x4>(ws, (unsigned)(OFF_SEGH + ((b * 64 + seg) * 512 + c4) * 4), f32x4{hh[0], hh[1], hh[2], hh[3]});
}

__device__ void rg_final(CParams& p, int item) {
    const int b = item >> 13, seg = (item >> 7) & 63, c4 = (item & 127) * 4;
    unsigned char* ws = p.ws;
    const unsigned base = (unsigned)(((b * SEQ + seg * 64) * 512 + c4) * 2);
    f32x4 hh = {0.f, 0.f, 0.f, 0.f};
    for (int sg0 = 0; sg0 < seg; sg0 += 8) {
        f32x4 sa[8], sh[8];
#pragma unroll
        for (int i = 0; i < 8; ++i) {
            const int sg = min(sg0 + i, 63);
            sa[i] = ldg<f32x4>(ws, (unsigned)(OFF_SEGA + ((b * 64 + sg) * 512 + c4) * 4));
            sh[i] = ldg<f32x4>(ws, (unsigned)(OFF_SEGH + ((b * 64 + sg) * 512 + c4) * 4));
        }
#pragma unroll
        for (int i = 0; i < 8; ++i) if (sg0 + i < seg) hh = sa[i] * hh + sh[i];
    }
    for (int s0 = 0; s0 < 64; s0 += 8) {
        uint2 a[8], bb[8], xg[8];
#pragma unroll
        for (int i = 0; i < 8; ++i) {
            a[i] = ldg<uint2>(ws, (unsigned)OFF_LA + base + (unsigned)((s0 + i) * 1024));
            bb[i] = ldg<uint2>(ws, (unsigned)OFF_BB + base + (unsigned)((s0 + i) * 1024));
            xg[i] = ldg<uint2>(ws, (unsigned)OFF_PXG + base + (unsigned)((s0 + i) * 1024));
        }
#pragma unroll
        for (int i = 0; i < 8; ++i) {
            float av[4], bv[4], xv[4]; bf4(a[i], av); bf4(bb[i], bv); bf4(xg[i], xv);
#pragma unroll
            for (int c = 0; c < 4; ++c) hh[c] = __expf(av[c]) * hh[c] + bv[c];
            uint2 o; o.x = f2bf(hh[0] * xv[0]) | ((unsigned)f2bf(hh[1] * xv[1]) << 16); o.y = f2bf(hh[2] * xv[2]) | ((unsigned)f2bf(hh[3] * xv[3]) << 16);
            stg<uint2>(ws, (unsigned)OFF_YC + base + (unsigned)((s0 + i) * 1024), o);
        }
    }
}

__device__ void phase4(CParams& p, int l, char* lds) {
    {
        const int tid = otid();
        if (tid < 128) hgrn_sscan(p, VB * 128 + tid);
        else if (tid < 192) rg_local(p, VB * 64 + (tid - 128));
    }
    for (int u = VB; u < 512; u += VG) s5_gemm_c(p, l, u, lds);
}

__device__ void phase_glu(CParams& p, int l, char* lds) {
    LANE_IDS;
    const int wr = wid >> 1, wc = wid & 1;
    unsigned char* ws = p.ws;
    const float* gb = p.in[14] + (size_t)l * 512;
    if (tid < 64) rg_final(p, VB * 64 + tid);
    for (int uu = VB; uu < 1536; uu += VG) {
        if (uu < 1024) { hgrn_out(p, l, uu, lds); continue; }
        const int u = uu - 1024;
        const int row0 = (u >> 2) * 128, col0 = (u & 3) * 128;
        f32x4 acc[4][4]; ZERO_ACC(acc, 4, 4);
        mma_glds<128, 128, 2, 2, true>(acc, 8, ws,
            [&](int r, int t) { return (unsigned)(OFF_YG + ((row0 + r) * 512 + t * 64) * 2); },
            [&](int c, int t) { return (unsigned)(OFF_GLUT + ((col0 + c) * 512 + t * 64) * 2); }, NoHook(), lds);
        epiT<4, 4, 64, 64>(acc, wr, wc, fq, fr, [&](int r, int cc, const f32x4& v) {
            const int row = row0 + r, col = col0 + cc;
            const f32x4 y = unpack4(ldg<uint2>(ws, (unsigned)(OFF_YG + (row * 512 + col) * 2)));
            const f32x4 bb = *(const f32x4*)(gb + col);
            f32x4 o;
#pragma unroll
            for (int i = 0; i < 4; ++i) o[i] = y[i] * sigm(v[i] + bb[i]);
            stg<uint2>(ws, (unsigned)(OFF_YB + (row * 512 + col) * 2), pack4(o)); });
    }
}

__device__ void phase_branch(CParams& p, int l, char* lds) {
    BrSched S; S.c = blockIdx.x;
    BrEpi E; E.ws = p.ws;
    g8::gemm_phase<BrEpi, BrSched, false>((LAS unsigned char*)lds, p.ws, 512, S, E);
}

__device__ void phase_out(CParams& p, int l, char* lds, char* hlds) {
    {
        OutSched S; S.A = (unsigned)OFF_MIXP; S.B = (unsigned)OFF_WOUTT; S.c = blockIdx.x; S.G = gridDim.x;
        OutEpi E; E.ws = p.ws;
        g8::gemm_phase<OutEpi, OutSched, false>((LAS unsigned char*)lds, p.ws, 1024, S, E);
    }
    for (int u = VB; u < 12288; u += VG) {
        const int e = u / 192, r = u % 192;
        if (r < 128)
            conv_tile(p.in[28] + (size_t)(l * 64 + e) * 1024 * 256, p.in[29] + (size_t)(l * 64 + e) * 1024 * 256, 256, 1024, 16,
                      (u16*)(p.ws + OFF_EW13) + (size_t)e * 512 * 1024, r, (float*)hlds);
        else
            conv_tile(p.in[30] + (size_t)(l * 64 + e) * 256 * 1024, nullptr, 1024, 256, 0,
                      (u16*)(p.ws + OFF_EW2) + (size_t)e * 1024 * 256, r - 128, (float*)hlds);
    }
}

__device__ __forceinline__ void ln_row(float (&v)[16], const float* g, const float* bta, int lane) {
    float s = 0.f;
#pragma unroll
    for (int i = 0; i < 16; ++i) s += v[i];
    const float mu = wave_sum(s, lane) * (1.f / 1024.f);
    float q = 0.f;
#pragma unroll
    for (int i = 0; i < 16; ++i) { float d = v[i] - mu; q += d * d; }
    const float rs = rsqrtf(wave_sum(q, lane) * (1.f / 1024.f) + 1e-5f);
#pragma unroll
    for (int i = 0; i < 4; ++i) {
        const float4 gg = *(const float4*)(g + i * 256 + lane * 4), bb = *(const float4*)(bta + i * 256 + lane * 4);
        v[i * 4 + 0] = (v[i * 4 + 0] - mu) * rs * gg.x + bb.x;
        v[i * 4 + 1] = (v[i * 4 + 1] - mu) * rs * gg.y + bb.y;
        v[i * 4 + 2] = (v[i * 4 + 2] - mu) * rs * gg.z + bb.z;
        v[i * 4 + 3] = (v[i * 4 + 3] - mu) * rs * gg.w + bb.w;
    }
}

__device__ void phase_route(CParams& p, int l, char* lds) {
    LANE_IDS;
    const float* Pre = (const float*)(p.ws + OFF_PRELN);
    u16* Xm = (u16*)(p.ws + OFF_XM);
    const float* g1 = p.in[24] + (size_t)l * 1024;
    const float* b1 = p.in[25] + (size_t)l * 1024;
    const float* rbias = p.in[27] + (size_t)l * 64;
    int* cursor = (int*)(p.ws + OFF_CUR);
    int* list = (int*)(p.ws + OFF_LIST);
    float* wlist = (float*)(p.ws + OFF_WLIST);
    float* Ls = (float*)(lds + 32768);
    int* hist = (int*)(lds + 32768 + 64 * 65 * 4);
    int* basep = hist + 64;
    for (int u = VB; u < 512; u += VG) {
        const int row0 = u * 32;
#pragma unroll 1
        for (int hb = 0; hb < 2; ++hb) {
            float v[4][16];
#pragma unroll
            for (int rr = 0; rr < 4; ++rr) {
                const int row = row0 + wid * 8 + hb * 4 + rr;
#pragma unroll
                for (int i = 0; i < 4; ++i) {
                    const float4 x = *(const float4*)(Pre + (size_t)row * 1024 + i * 256 + lane * 4);
                    v[rr][i * 4] = x.x; v[rr][i * 4 + 1] = x.y; v[rr][i * 4 + 2] = x.z; v[rr][i * 4 + 3] = x.w;
                }
            }
#pragma unroll
            for (int rr = 0; rr < 4; ++rr) {
                const int row = row0 + wid * 8 + hb * 4 + rr;
                ln_row(v[rr], g1, b1, lane);
#pragma unroll
                for (int i = 0; i < 4; ++i) {
                    uint2 o; o.x = f2bf(v[rr][i * 4]) | ((unsigned)f2bf(v[rr][i * 4 + 1]) << 16); o.y = f2bf(v[rr][i * 4 + 2]) | ((unsigned)f2bf(v[rr][i * 4 + 3]) << 16);
                    *(uint2*)(Xm + (size_t)row * 1024 + i * 256 + lane * 4) = o;
                }
            }
        }
        if (tid < 64) hist[tid] = 0;
        __syncthreads();
        f32x4 acc[1][2]; ZERO_ACC(acc, 1, 2);
        mma_glds<32, 64, 2, 2>(acc, 16, p.ws,
            [&](int r, int t) { return (unsigned)(OFF_XM + ((row0 + r) * 1024 + t * 64) * 2); },
            [&](int c, int t) { return (unsigned)(OFF_ROUTT + (c * 1024 + t * 64) * 2); }, NoHook(), lds);
#pragma unroll
        for (int n = 0; n < 2; ++n)
#pragma unroll
            for (int j = 0; j < 4; ++j) {
                const int r = (wid >> 1) * 16 + fq * 4 + j, e = (wid & 1) * 32 + n * 16 + fr;
                Ls[r * 65 + e] = sigm(acc[0][n][j]) + rbias[e];
            }
        __syncthreads();
        int myrank[8]; int myexp[8]; float wv[8];
        if (tid < 32) {
            float* sc = Ls + tid * 65;
            float gs[8];
#pragma unroll
            for (int g = 0; g < 8; ++g) {
                float m1 = -1e30f, m2 = -1e30f;
#pragma unroll
                for (int i = 0; i < 8; ++i) { float x = sc[g * 8 + i]; if (x > m1) { m2 = m1; m1 = x; } else if (x > m2) m2 = x; }
                gs[g] = m1 + m2;
            }
            unsigned gmask = 0;
#pragma unroll
            for (int it = 0; it < 4; ++it) {
                float best = -1e30f; int bi = 0;
#pragma unroll
                for (int g = 0; g < 8; ++g) { bool ok = !((gmask >> g) & 1u) && gs[g] > best; if (ok) { best = gs[g]; bi = g; } }
                gmask |= 1u << bi;
            }
            unsigned long long chosen = 0ull;
            float wsum = 0.f;
#pragma unroll
            for (int k = 0; k < 8; ++k) {
                float best = -1e30f; int bi = 0;
                for (int e = 0; e < 64; ++e) {
                    float x = sc[e];
                    bool ok = ((gmask >> (e >> 3)) & 1u) && !((chosen >> e) & 1ull) && x > best;
                    if (ok) { best = x; bi = e; }
                }
                chosen |= 1ull << bi;
                myexp[k] = bi;
                wv[k] = best - rbias[bi];
                wsum += wv[k];
            }
            const float sc_ = 2.5f / wsum;
#pragma unroll
            for (int k = 0; k < 8; ++k) {
                wv[k] *= sc_;
                myrank[k] = atomicAdd(&hist[myexp[k]], 1);
            }
        }
        __syncthreads();
        if (tid < 64) basep[tid] = atomicAdd(&cursor[tid], hist[tid]);
        __syncthreads();
        if (tid < 32) {
#pragma unroll
            for (int k = 0; k < 8; ++k) {
                const size_t pos = (size_t)myexp[k] * NTOK + basep[myexp[k]] + myrank[k];
                list[pos] = (row0 + tid) * 8 + k;
                wlist[pos] = wv[k];
            }
        }
        __syncthreads();
    }
}

__device__ void phase_combine(CParams& p, int l) {
    LANE_IDS;
    typedef float f32x2 __attribute__((ext_vector_type(2)));
    unsigned char* ws = p.ws;
    const float* g2 = p.in[34] + (size_t)l * 1024 + lane * 16;
    const float* b2 = p.in[35] + (size_t)l * 1024 + lane * 16;
    for (int row = VB * 4 + wid; row < NTOK; row += VG * 4) {
        f32x4 y[4]; uint4 xm[2]; u32x4 yb[8];
#pragma unroll
        for (int i = 0; i < 4; ++i) y[i] = ldg<f32x4>(p.out, (unsigned)((row * 1024 + lane * 16 + i * 4) * 4));
#pragma unroll
        for (int i = 0; i < 2; ++i) xm[i] = ldg<uint4>(ws, (unsigned)(OFF_XM + (row * 1024 + lane * 16 + i * 8) * 2));
#pragma unroll
        for (int k = 0; k < 8; ++k) yb[k] = ldg<u32x4>(ws, (unsigned)OFF_YBUF + (unsigned)((row * 8 + k) * 1024 + lane * 16));
        float v[16], s[16];
#pragma unroll
        for (int i = 0; i < 16; ++i) s[i] = 0.f;
#pragma unroll
        for (int k = 0; k < 8; ++k)
#pragma unroll
            for (int w = 0; w < 4; ++w) {
                const f32x2 lo = __builtin_amdgcn_cvt_pk_f32_fp8((int)yb[k][w], false), hi = __builtin_amdgcn_cvt_pk_f32_fp8((int)yb[k][w], true);
                s[w * 4 + 0] += lo.x; s[w * 4 + 1] += lo.y; s[w * 4 + 2] += hi.x; s[w * 4 + 3] += hi.y;
            }
#pragma unroll
        for (int i = 0; i < 2; ++i) {
            const uint4 x = xm[i];
            const float xf[8] = {bf2f((u16)(x.x & 0xffff)), bf2f((u16)(x.x >> 16)), bf2f((u16)(x.y & 0xffff)), bf2f((u16)(x.y >> 16)),
                                 bf2f((u16)(x.z & 0xffff)), bf2f((u16)(x.z >> 16)), bf2f((u16)(x.w & 0xffff)), bf2f((u16)(x.w >> 16))};
#pragma unroll
            for (int j = 0; j < 8; ++j) v[i * 8 + j] = y[i * 2 + (j >> 2)][j & 3] + DN_ALPHA * xf[j] + s[i * 8 + j] * (1.f / 32.f);
        }
        float sum = 0.f;
#pragma unroll
        for (int i = 0; i < 16; ++i) sum += v[i];
        const float mu = wave_sum(sum, lane) * (1.f / 1024.f);
        float q = 0.f;
#pragma unroll
        for (int i = 0; i < 16; ++i) { const float d = v[i] - mu; q += d * d; }
        const float rs = rsqrtf(wave_sum(q, lane) * (1.f / 1024.f) + 1e-5f);
#pragma unroll
        for (int i = 0; i < 4; ++i) {
            const f32x4 gg = *(const f32x4*)(g2 + i * 4), bb = *(const f32x4*)(b2 + i * 4);
#pragma unroll
            for (int j = 0; j < 4; ++j) v[i * 4 + j] = (v[i * 4 + j] - mu) * rs * gg[j] + bb[j];
            if (l == 1) stg<f32x4>(p.out, (unsigned)((row * 1024 + lane * 16 + i * 4) * 4), f32x4{v[i * 4], v[i * 4 + 1], v[i * 4 + 2], v[i * 4 + 3]});
        }
#pragma unroll
        for (int i = 0; i < 2; ++i) {
            uint4 o;
            o.x = f2bf(v[i * 8 + 0]) | ((unsigned)f2bf(v[i * 8 + 1]) << 16); o.y = f2bf(v[i * 8 + 2]) | ((unsigned)f2bf(v[i * 8 + 3]) << 16);
            o.z = f2bf(v[i * 8 + 4]) | ((unsigned)f2bf(v[i * 8 + 5]) << 16); o.w = f2bf(v[i * 8 + 6]) | ((unsigned)f2bf(v[i * 8 + 7]) << 16);
            stg<uint4>(ws, (unsigned)(OFF_XB + (row * 1024 + lane * 16 + i * 8) * 2), o);
        }
    }
}


#define XB_TMO      128
#define XB_XCNT(j)  (256  + 64 * (j))
#define XB_XSUB(j)  (1280 + 64 * (j))
#define XB_XGEN(j)  (2304 + 64 * (j))
#define XB_TOP      3328
#define XB_TOPGEN   3392
#define XCD_BAR_WORDS 3456
#define XB_SPIN_CAP (1u << 22)
__device__ __forceinline__ unsigned xb_ld(unsigned* p)              { return __hip_atomic_load(p, __ATOMIC_RELAXED, __HIP_MEMORY_SCOPE_AGENT); }
__device__ __forceinline__ unsigned xb_add(unsigned* p, unsigned v) { return __hip_atomic_fetch_add(p, v, __ATOMIC_RELAXED, __HIP_MEMORY_SCOPE_AGENT); }
__device__ __forceinline__ unsigned xb_xcc_id() { return (unsigned)__builtin_amdgcn_s_getreg((3 << 11) | 20) & 0xFu; }
#define XB_SPIN(cond, bar) do { unsigned _sp = 0; while (cond) { __builtin_amdgcn_s_sleep(1); \
    if ((++_sp & 255u) == 0u) { if (xb_ld(&(bar)[XB_TMO])) break; if (_sp > XB_SPIN_CAP) { atomicAdd(&(bar)[XB_TMO], 1u); break; } } } } while (0)
struct XcdBarrier { unsigned* bar; unsigned x; volatile LAS unsigned* st; };
__device__ __forceinline__ XcdBarrier xcd_barrier_post(unsigned* bar, volatile LAS unsigned* st) {
    XcdBarrier b; b.bar = bar; b.x = xb_xcc_id(); b.st = st;
    if (threadIdx.x == 0) (void)xb_add(&bar[XB_XCNT(b.x)], 1u);
    return b;
}
__device__ __forceinline__ void xcd_barrier_complete(unsigned* bar, unsigned x, unsigned& nloc, unsigned& nx) {
    const unsigned G = gridDim.x * gridDim.y * gridDim.z;
    unsigned sum, cnt, mine, sp = 0u;
    for (;;) {
        sum = 0u; cnt = 0u; mine = 0u;
#pragma unroll
        for (unsigned j = 0; j < 16; ++j) { const unsigned c = xb_ld(&bar[XB_XCNT(j)]); sum += c; cnt += (c > 0u) ? 1u : 0u; mine = (j == x) ? c : mine; }
        if (sum == G) break;
        __builtin_amdgcn_s_sleep(1);
        if ((++sp & 255u) == 0u) { if (xb_ld(&bar[XB_TMO])) break; if (sp > XB_SPIN_CAP) { atomicAdd(&bar[XB_TMO], 1u); break; } }
    }
    nloc = mine > 0u ? mine : 1u; nx = cnt > 0u ? cnt : 1u;
}
__device__ __forceinline__ void xcd_barrier(const XcdBarrier& b) {
    asm volatile("s_waitcnt vmcnt(0)" ::: "memory");
    __syncthreads();
    if (threadIdx.x == 0) {
        unsigned* bar = b.bar;
        __builtin_amdgcn_s_waitcnt(0);
        unsigned nloc = b.st[0], nx = b.st[1];
        if (nloc == 0u) { xcd_barrier_complete(bar, b.x, nloc, nx); b.st[0] = nloc; b.st[1] = nx; }
        const unsigned old = xb_add(&bar[XB_XSUB(b.x)], 1u);
        const unsigned gen = old / nloc;
        if (old + 1u == (gen + 1u) * nloc) {
            __builtin_amdgcn_fence(__ATOMIC_RELEASE, "agent");
            asm volatile("s_waitcnt vmcnt(0)" ::: "memory");
            const unsigned og = xb_add(&bar[XB_TOP], 1u);
            const unsigned tg = og / nx;
            if (og + 1u == (tg + 1u) * nx) xb_add(&bar[XB_TOPGEN], 1u);
            else XB_SPIN(xb_ld(&bar[XB_TOPGEN]) == tg, bar);
            __builtin_amdgcn_fence(__ATOMIC_ACQUIRE, "agent");
            xb_add(&bar[XB_XGEN(b.x)], 1u);
            asm volatile("s_waitcnt vmcnt(0)" ::: "memory");
        } else {
            XB_SPIN(xb_ld(&bar[XB_XGEN(b.x)]) == gen, bar);
            __builtin_amdgcn_fence(__ATOMIC_ACQUIRE, "agent");
            asm volatile("s_waitcnt vmcnt(0)" ::: "memory");
        }
    }
    __syncthreads();
}

__global__ void __launch_bounds__(512, 2) fwd_kernel(Params p_unused) {
    extern __shared__ __attribute__((aligned(16))) char lds[];
    cg::grid_group grid = cg::this_grid();
    CParams* pp = (CParams*)__builtin_amdgcn_kernarg_segment_ptr();
    const int ph_lo = pp->ph_lo;
    volatile LAS unsigned* xst = (volatile LAS unsigned*)(lds + L_XST);
    if (threadIdx.x == 0) { xst[0] = 0u; xst[1] = 0u; *(LAS unsigned*)(lds + 147456 + 32) = 0u; }
    __syncthreads();
    const XcdBarrier xb = xcd_barrier_post((unsigned*)(pp->ws + OFF_BAR), xst);
    char* hlds = lds + __builtin_amdgcn_readfirstlane((int)(threadIdx.x >> 8)) * HLDS;
    unsigned long long tq_acc = 0;
    (void)ph_lo;
#pragma unroll
    for (int ph = 0; ph < 2 * NPH; ++ph) {
        asm volatile("" : "+s"(pp));
        CParams& p = *pp;
        const int l = ph / NPH, q = ph % NPH;
        unsigned long long tq0 = 0;
        if (PROBE_TQ >= 0 && q == PROBE_TQ) tq0 = __builtin_amdgcn_s_memrealtime();
#pragma unroll 1
        for (int rep = 0; rep < 1 + (int)((PROBE_MASK >> q) & 1u); ++rep) {
            if (rep) xcd_barrier(xb);
            switch (q) {
                case 0: phase_w(p, l, hlds); break;
                case 1: phase_proj(p, l, lds); break;
                case 2: phase2(p, l, hlds); break;
                case 3: phase3(p, l, hlds); break;
                case 4: phase4(p, l, hlds); break;
                case 5: phase_glu(p, l, hlds); break;
                case 6: phase_branch(p, l, lds); break;
                case 7: phase_out(p, l, lds, hlds); break;
                case 8: phase_route(p, l, hlds); break;
                case 9: phase_moe1(p, l, lds); break;
                case 10: phase_moe2(p, l, lds); break;
                default: phase_combine(p, l); break;
            }
        }
        if (ph + 1 < 2 * NPH) {
            if (p.coop == 1) xcd_barrier(xb);
            else if (p.coop == 2) grid.sync();
        }
        if (PROBE_TQ >= 0 && q == PROBE_TQ) tq_acc += __builtin_amdgcn_s_memrealtime() - tq0;
    }
    if (PROBE_TQ == 98) tq_acc = *(LAS unsigned*)(lds + 147456 + 32);
    if (PROBE_TQ >= 0 && blockIdx.x == 0) {
        const unsigned long long t0 = __builtin_amdgcn_s_memrealtime();
        while (__builtin_amdgcn_s_memrealtime() - t0 < 4ull * tq_acc) __builtin_amdgcn_s_sleep(8);
    }
}

extern "C" void kernel_launch(void* const* d_in, const int* in_sizes, int n_in, void* d_out, int out_size, void* d_ws, size_t ws_size,
                              hipStream_t stream) {
    static int grid_blocks = 0;
    if (!grid_blocks) {
        int dev = 0, cus = 0, per_cu = 0;
        (void)hipGetDevice(&dev);
        (void)hipDeviceGetAttribute(&cus, hipDeviceAttributeMultiprocessorCount, dev);
        (void)hipFuncSetAttribute((const void*)fwd_kernel, hipFuncAttributeMaxDynamicSharedMemorySize, LDS_BYTES);
        (void)hipOccupancyMaxActiveBlocksPerMultiprocessor(&per_cu, fwd_kernel, 512, LDS_BYTES);
        if (per_cu < 1) per_cu = 1;
        per_cu = 1;
        grid_blocks = cus * per_cu;
        if (ws_size < WS_NEED) fprintf(stderr, "kernel_launch: workspace too small: %zu < %zu\n", ws_size, (size_t)WS_NEED);
    }
    Params p{};
    for (int i = 0; i < 36; ++i) p.in[i] = (const float*)d_in[i];
    p.out = (float*)d_out;
    p.ws = (unsigned char*)d_ws;
    p.ph_lo = 0; p.ph_hi = 2 * NPH; p.coop = 1; p.pad = 0;
    (void)hipMemsetAsync((char*)d_ws + OFF_BAR, 0, XCD_BAR_WORDS * 4, stream);
    void* args[] = {&p};
    hipError_t e = hipLaunchCooperativeKernel((void*)fwd_kernel, dim3(grid_blocks), dim3(512), args, LDS_BYTES, stream);
    if (e != hipSuccess) fprintf(stderr, "cooperative launch failed: %s (grid %d)\n", hipGetErrorString(e), grid_blocks);
}
```

```cpp
#include <hip/hip_runtime.h>
#include <hip/hip_cooperative_groups.h>
#include <cstdio>
#include <cstdint>
namespace cg = cooperative_groups;

typedef unsigned short u16;
typedef __attribute__((ext_vector_type(8))) short bf16x8;
typedef __attribute__((ext_vector_type(4))) float f32x4;
typedef __attribute__((ext_vector_type(4))) unsigned u32x4;
#define LAS __attribute__((address_space(3)))

constexpr int NTOK = 16384, DM = 1024, SEQ = 4096, BW = 512, INC = 6656;
constexpr int NE = 64, EH = 256;
#ifndef PROBE_MASK
#define PROBE_MASK 0u
#endif
#define PROBE_TIMEK_ProjEpi false
#define PROBE_TIMEK_OutEpi false
#define PROBE_TIMEK_BrEpi false
#define PROBE_TIMEK_Moe1Epi false
#define PROBE_TIMEK_Moe2Epi false
#define PROBE_TIMEK_ShEpi false
#define PROBE_TQ -1
constexpr int NPH = 12;
constexpr float DN_ALPHA = 1.4142135623730951f;
constexpr size_t SLOT = 16777216ull;

constexpr size_t OFF_WINT  = 0;
constexpr size_t OFF_WBRT  = 13631488;
constexpr size_t OFF_WOUTT = 16777216;
constexpr size_t OFF_GLUT  = 18874368;
constexpr size_t OFF_RGT   = 19398656;
constexpr size_t OFF_SH13T = 19660800;
constexpr size_t OFF_SH2T  = 20709376;
constexpr size_t OFF_BTA   = 21233664;
constexpr size_t OFF_BTC   = 23330816;
constexpr size_t OFF_ROUTT = 29622272;
constexpr size_t OFF_MISC  = 29753344;
constexpr size_t OFF_LB    = OFF_MISC;
constexpr size_t OFF_CUR   = OFF_MISC + 2048;
constexpr size_t OFF_DEC   = OFF_MISC + 4096;
constexpr size_t OFF_SEGA  = OFF_DEC + 524288;
constexpr size_t OFF_SEGH  = OFF_SEGA + 524288;
constexpr size_t OFF_XB    = 2 * SLOT;
constexpr size_t OFF_VC    = 29 * SLOT;
constexpr size_t OFF_XC    = 30 * SLOT;
constexpr size_t OFF_MIXP  = 30 * SLOT;
constexpr size_t OFF_LIST  = 2 * SLOT;
constexpr size_t OFF_HSH   = 2 * SLOT + 4194304;
constexpr size_t OFF_WLIST = 2 * SLOT + 4194304 + 8388608;
constexpr size_t OFF_PQ    = 4 * SLOT;
constexpr size_t OFF_PLF   = 5 * SLOT;
constexpr size_t OFF_PK    = 7 * SLOT;
constexpr size_t OFF_PV    = 8 * SLOT;
constexpr size_t OFF_YC    = 8 * SLOT;
constexpr size_t OFF_PG    = 9 * SLOT;
constexpr size_t OFF_PU    = 10 * SLOT;
constexpr size_t OFF_PXG   = 11 * SLOT;
constexpr size_t OFF_PXR   = 12 * SLOT;
constexpr size_t OFF_YB    = 12 * SLOT;
constexpr size_t OFF_PGATE = 13 * SLOT;
constexpr size_t OFF_KTT   = 19 * SLOT;
constexpr size_t OFF_YA    = 19 * SLOT;
constexpr size_t OFF_VT    = 20 * SLOT;
constexpr size_t OFF_ST    = 21 * SLOT;
constexpr size_t OFF_LA    = 23 * SLOT;
constexpr size_t OFF_BB    = 24 * SLOT;
constexpr size_t OFF_YG    = 25 * SLOT;
constexpr size_t OFF_HC    = 26 * SLOT;
constexpr size_t OFF_UT    = 27 * SLOT;
constexpr size_t OFF_PRELN = 4 * SLOT;
constexpr size_t OFF_XM    = 8 * SLOT;
constexpr size_t OFF_EW13  = 10 * SLOT;
constexpr size_t OFF_EW2   = 14 * SLOT;
constexpr size_t OFF_HBUF  = 4 * SLOT;
constexpr size_t OFF_YBUF  = 16 * SLOT;
constexpr size_t OFF_YSH   = 24 * SLOT;
constexpr size_t OFF_BAR   = 32 * SLOT;
constexpr int HLDS = 73728;
constexpr int LDS_BYTES = 2 * HLDS + 64;
constexpr int L_XST = 2 * HLDS;
constexpr size_t WS_NEED   = 32 * SLOT + 16384;

struct Params {
    const float* in[36];
    float* out;
    unsigned char* ws;
    int ph_lo, ph_hi;
    int coop, pad;
};
typedef const __attribute__((address_space(4))) Params CParams;

__device__ __forceinline__ u16 f2bf(float f) {
    unsigned u = __builtin_bit_cast(unsigned, f);
    return (u16)((u + 0x7fffu + ((u >> 16) & 1u)) >> 16);
}
__device__ __forceinline__ float bf2f(u16 h) { return __builtin_bit_cast(float, (unsigned)h << 16); }
__device__ __forceinline__ float sigm(float x) { return __builtin_amdgcn_rcpf(1.f + __expf(-x)); }
__device__ __forceinline__ float silu_f(float x) { return x * sigm(x); }
__device__ __forceinline__ float gelu_f(float x) {
    float u = 0.7978845608028654f * (x + 0.044715f * x * x * x);
    float t = 1.f - 2.f * __builtin_amdgcn_rcpf(1.f + __expf(2.f * u));
    return 0.5f * x * (1.f + t);
}
__device__ __forceinline__ float shfl_xor_l(float v, int o, int lane) {
    return __builtin_bit_cast(float, __builtin_amdgcn_ds_bpermute((lane ^ o) << 2, __builtin_bit_cast(int, v)));
}
__device__ __forceinline__ float wave_sum(float v, int lane) {
#pragma unroll
    for (int o = 32; o >= 1; o >>= 1) v += shfl_xor_l(v, o, lane);
    return v;
}
__device__ __forceinline__ int swz(int row, int ch) { return row * 128 + ((ch ^ ((row >> 1) & 7)) << 4); }


template <class T> __device__ __forceinline__ T ldg(const void* base, unsigned off) { return *(const T*)((const char*)base + off); }
template <class T> __device__ __forceinline__ void stg(void* base, unsigned off, T v) { *(T*)((char*)base + off) = v; }
template <class T> __device__ __forceinline__ void stg_nt(void* base, unsigned off, T v) { __builtin_nontemporal_store(v, (T*)((char*)base + off)); }

template <int TM, int TN, int RW, int CW, class F>
__device__ __forceinline__ void epi(f32x4 (&acc)[TM][TN], int wr, int wc, int fq, int fr, F f) {
#pragma unroll
    for (int m = 0; m < TM; ++m) {
#pragma unroll
        for (int j = 0; j < 4; ++j) {
#pragma unroll
            for (int n = 0; n < TN; ++n) f(wr * RW + m * 16 + fq * 4 + j, wc * CW + n * 16 + fr, acc[m][n][j]);
        }
        __builtin_amdgcn_sched_barrier(0);
    }
}

template <int TM, int TN, int RW, int CW, class F>
__device__ __forceinline__ void epiT(f32x4 (&acc)[TM][TN], int wr, int wc, int fq, int fr, F f) {
#pragma unroll
    for (int m = 0; m < TM; ++m) {
#pragma unroll
        for (int n = 0; n < TN; ++n) f(wr * RW + m * 16 + fr, wc * CW + n * 16 + fq * 4, acc[m][n]);
    }
}
__device__ __forceinline__ uint2 pack4(const f32x4& a) {
    uint2 w; w.x = f2bf(a[0]) | ((unsigned)f2bf(a[1]) << 16); w.y = f2bf(a[2]) | ((unsigned)f2bf(a[3]) << 16); return w;
}
__device__ __forceinline__ f32x4 unpack4(const uint2 q) {
    return f32x4{bf2f((u16)(q.x & 0xffff)), bf2f((u16)(q.x >> 16)), bf2f((u16)(q.y & 0xffff)), bf2f((u16)(q.y >> 16))};
}

__device__ __forceinline__ int otid() { int t = threadIdx.x & 255; asm volatile("" : "+v"(t)); return t; }
#define VB ((int)blockIdx.x * 2 + __builtin_amdgcn_readfirstlane((int)(threadIdx.x >> 8)))
#define VG ((int)gridDim.x * 2)

struct NoHook { __device__ __forceinline__ void operator()(int) const {} };

template <int BM, int BN, int WM, int WN, bool TR = false, class AL, class BL, class HK>
__device__ __forceinline__ void mma_loop(f32x4 (&acc)[BM / WM / 16][BN / WN / 16], int nk, AL aload, BL bload, HK hook, char* lds) {
    constexpr int TM = BM / WM / 16, TN = BN / WN / 16;
    constexpr int ACH = BM / 32, BCH = BN / 32;
    const int tid = otid(), lane = tid & 63, wid = tid >> 6;
    const int wr = wid / WN, wc = wid % WN, fr = lane & 15, fq = lane >> 4;
    const int srow = tid >> 3, sk = (tid & 7) * 8;
    const int swr = srow * 128 + (((tid & 7) ^ ((tid >> 4) & 7)) << 4);
    const int xr = (fr >> 1) & 7;
    const int a_rd = (wr * (BM / WM) + fr) * 128;
    const int b_rd = BM * 128 + (wc * (BN / WN) + fr) * 128;
    bf16x8 ra[ACH], rb[BCH];
#pragma unroll
    for (int i = 0; i < ACH; ++i) ra[i] = aload(srow + i * 32, sk);
#pragma unroll
    for (int i = 0; i < BCH; ++i) rb[i] = bload(srow + i * 32, sk);
#pragma unroll 1
    for (int t = 0; t < nk; ++t) {
        __syncthreads();
#pragma unroll
        for (int i = 0; i < ACH; ++i) *(bf16x8*)(lds + swr + i * 4096) = ra[i];
#pragma unroll
        for (int i = 0; i < BCH; ++i) *(bf16x8*)(lds + BM * 128 + swr + i * 4096) = rb[i];
        __syncthreads();
        if (t + 1 < nk) {
#pragma unroll
            for (int i = 0; i < ACH; ++i) ra[i] = aload(srow + i * 32, (t + 1) * 64 + sk);
#pragma unroll
            for (int i = 0; i < BCH; ++i) rb[i] = bload(srow + i * 32, (t + 1) * 64 + sk);
        }
        hook(t);
#pragma unroll
        for (int ks = 0; ks < 2; ++ks) {
            const int co = ((ks * 4 + fq) ^ xr) << 4;
            bf16x8 af[TM], bfr[TN];
#pragma unroll
            for (int m = 0; m < TM; ++m) af[m] = *(const bf16x8*)(lds + a_rd + m * 2048 + co);
#pragma unroll
            for (int n = 0; n < TN; ++n) bfr[n] = *(const bf16x8*)(lds + b_rd + n * 2048 + co);
#pragma unroll
            for (int m = 0; m < TM; ++m)
#pragma unroll
                for (int n = 0; n < TN; ++n) acc[m][n] = TR ? __builtin_amdgcn_mfma_f32_16x16x32_bf16(bfr[n], af[m], acc[m][n], 0, 0, 0)
                                                            : __builtin_amdgcn_mfma_f32_16x16x32_bf16(af[m], bfr[n], acc[m][n], 0, 0, 0);
        }
    }
}

template <int BM, int BN, int WM, int WN, bool TR = false, class AO, class BO, class HK>
__device__ __forceinline__ void mma_glds(f32x4 (&acc)[BM / WM / 16][BN / WN / 16], int nk, const unsigned char* ws, AO aoff, BO boff, HK hook, char* lds) {
    constexpr int TM = BM / WM / 16, TN = BN / WN / 16;
    constexpr int ACH = BM / 32, BCH = BN / 32, BUF = (BM + BN) * 128;
    const int tid = otid(), lane = tid & 63, wid = tid >> 6;
    const int wr = wid / WN, wc = wid % WN, fr = lane & 15, fq = lane >> 4;
    const int srow = tid >> 3;
    const unsigned csrc = (unsigned)(((tid & 7) ^ ((tid >> 4) & 7)) << 4);
    const int xr = (fr >> 1) & 7;
    const int a_rd = (wr * (BM / WM) + fr) * 128;
    const int b_rd = BM * 128 + (wc * (BN / WN) + fr) * 128;
    auto stage = [&](int buf, int t) {
        char* d = lds + buf * BUF + tid * 16;
#pragma unroll
        for (int i = 0; i < ACH; ++i)
            __builtin_amdgcn_global_load_lds((const unsigned*)(ws + (aoff(srow + i * 32, t) + csrc)), (unsigned*)(d + i * 4096), 16, 0, 0);
#pragma unroll
        for (int i = 0; i < BCH; ++i)
            __builtin_amdgcn_global_load_lds((const unsigned*)(ws + (boff(srow + i * 32, t) + csrc)), (unsigned*)(d + BM * 128 + i * 4096), 16, 0, 0);
    };
    __syncthreads();
    stage(0, 0);
#pragma unroll 1
    for (int t = 0; t < nk; ++t) {
        asm volatile("s_waitcnt vmcnt(0)" ::: "memory");
        __syncthreads();
        if (t + 1 < nk) stage((t + 1) & 1, t + 1);
        hook(t);
        const char* bb = lds + (t & 1) * BUF;
#pragma unroll
        for (int ks = 0; ks < 2; ++ks) {
            const int co = ((ks * 4 + fq) ^ xr) << 4;
            bf16x8 af[TM], bfr[TN];
#pragma unroll
            for (int m = 0; m < TM; ++m) af[m] = *(const bf16x8*)(bb + a_rd + m * 2048 + co);
#pragma unroll
            for (int n = 0; n < TN; ++n) bfr[n] = *(const bf16x8*)(bb + b_rd + n * 2048 + co);
#pragma unroll
            for (int m = 0; m < TM; ++m)
#pragma unroll
                for (int n = 0; n < TN; ++n) acc[m][n] = TR ? __builtin_amdgcn_mfma_f32_16x16x32_bf16(bfr[n], af[m], acc[m][n], 0, 0, 0)
                                                            : __builtin_amdgcn_mfma_f32_16x16x32_bf16(af[m], bfr[n], acc[m][n], 0, 0, 0);
        }
    }
}

#define ZERO_ACC(acc, TM, TN) _Pragma("unroll") for (int m_ = 0; m_ < TM; ++m_) _Pragma("unroll") for (int n_ = 0; n_ < TN; ++n_) acc[m_][n_] = f32x4{0.f, 0.f, 0.f, 0.f}

#define LANE_IDS const int tid = otid(), lane = tid & 63, wid = tid >> 6, fr = lane & 15, fq = lane >> 4; (void)tid; (void)lane; (void)wid; (void)fr; (void)fq

namespace g8 {
constexpr int BM = 256, BK = 64, HALF = 128, HTB = HALF * BK * 2, STAGE_BYTES = 8 * HTB;
__device__ __forceinline__ int lds_byte(int r, int c) { const int st = (r >> 4) * 2 + (c >> 5), rr = r & 15, cc = c & 31, ob = rr * 64 + cc * 2; return st * 1024 + (ob ^ (((ob >> 9) & 1) << 5)); }
__device__ __forceinline__ void stage_rc(int b, int& R, int& C) { const int st = b / 1024, sb = b % 1024, swz = sb ^ (((sb >> 9) & 1) << 5); R = (st >> 1) * 16 + swz / 64; C = (st & 1) * 32 + (swz % 64) / 2; }
__device__ __forceinline__ int perm32(int rho) { const int n = rho >> 4, i = rho & 15; return 8 * (i >> 2) + 4 * n + (i & 3); }
struct Unit { unsigned A, B; int pm, pn, x0, x1; };
__device__ __forceinline__ unsigned cvt_pk_bf16(float lo, float hi) { unsigned r; asm volatile("v_cvt_pk_bf16_f32 %0, %1, %2" : "=v"(r) : "v"(lo), "v"(hi)); return r; }

template <class Epi, class Sched, bool GATHER>
__device__ __forceinline__ void gemm_phase(LAS unsigned char* lds, const unsigned char* wsb, const int K, const Sched& S, const Epi& E) {
    int tid_ = threadIdx.x; asm volatile("" : "+v"(tid_));
    const int tid = tid_, wid = __builtin_amdgcn_readfirstlane(tid >> 6), lane = tid & 63, wr = wid >> 2, wc = wid & 3, fr = lane & 15, fq = lane >> 4;
    const int nt = K / BK;
    unsigned voffA[2], voffB[2];
#pragma unroll
    for (int i = 0; i < 2; ++i) { int R, C; stage_rc(tid * 16 + i * 8192, R, C); const int Rb = Epi::PERM ? ((R & ~31) + perm32(R & 31)) : R;
        voffA[i] = (unsigned)(R * K + C) * 2u; voffB[i] = (unsigned)(Rb * K + C) * 2u; }
    const unsigned kstep = (unsigned)(BK * 2);
    const unsigned hstep = (unsigned)(HALF * K * 2);
    const unsigned ldsw = (unsigned)wid * 1024u;
    const int aoff = lds_byte(wr * 64 + fr, fq * 8), boff = lds_byte(wc * 32 + fr, fq * 8);
#define G8_SA(b, h) (((b) * 2 + (h)) * HTB)
#define G8_SB(b, h) ((4 + (b) * 2 + (h)) * HTB)
#define G8_STAGE(bufoff, gbase, voff) do { _Pragma("unroll") for (int _i = 0; _i < 2; ++_i) \
        __builtin_amdgcn_global_load_lds((const unsigned*)(wsb + (unsigned)((gbase) + (voff)[_i])), (LAS unsigned*)(lds + (bufoff) + ldsw + _i * 8192), 16, 0, 0); } while (0)
#define G8_STAGE_A(bufoff, kp, h, vg) do { if (GATHER) G8_STAGE(bufoff, kp, vg[h]); else G8_STAGE(bufoff, (kp) + (h) * hstep, voffA); } while (0)
#define G8_LDA(dst, b, h) do { _Pragma("unroll") for (int m = 0; m < 4; ++m) _Pragma("unroll") for (int k = 0; k < 2; ++k) dst[m][k] = *(const LAS bf16x8*)(lds + G8_SA(b, h) + aoff + m * 2048 + k * 1024); } while (0)
#define G8_LDB(dst, b, h) do { _Pragma("unroll") for (int n = 0; n < 2; ++n) _Pragma("unroll") for (int k = 0; k < 2; ++k) dst[n][k] = *(const LAS bf16x8*)(lds + G8_SB(b, h) + boff + n * 2048 + k * 1024); } while (0)
#define G8_MMA(ai, bj, At, Bt) do { __builtin_amdgcn_s_setprio(1); _Pragma("unroll") for (int m = 0; m < 4; ++m) _Pragma("unroll") for (int n = 0; n < 2; ++n) _Pragma("unroll") for (int k = 0; k < 2; ++k) \
        acc[ai][bj][m][n] = __builtin_amdgcn_mfma_f32_16x16x32_bf16(Bt[n][k], At[m][k], acc[ai][bj][m][n], 0, 0, 0); __builtin_amdgcn_s_setprio(0); } while (0)
#define G8_WAIT_V(n) asm volatile("s_waitcnt vmcnt(" #n ")" ::: "memory")
#define G8_WAIT_L(n) asm volatile("s_waitcnt lgkmcnt(" #n ")" ::: "memory")
#define G8_BAR __builtin_amdgcn_s_barrier()
#define G8_SCHED __builtin_amdgcn_sched_barrier(0)
#define G8_GOFF(dst, u) do { _Pragma("unroll") for (int _i = 0; _i < 2; ++_i) { int _R, _C; stage_rc(tid * 16 + _i * 8192, _R, _C); \
        _Pragma("unroll") for (int _h = 0; _h < 2; ++_h) dst[_h][_i] = (unsigned)(S.row(u, _h * HALF + _R) * K + _C) * 2u; } \
        asm volatile("" : "+v"(dst[0][0]), "+v"(dst[0][1]), "+v"(dst[1][0]), "+v"(dst[1][1])); } while (0)
    Unit cur, nxt; int ui = 0;
    if (!S.next(0, cur)) return;
    f32x4 acc[2][2][4][2];
#pragma unroll
    for (int a = 0; a < 2; ++a)
#pragma unroll
        for (int b = 0; b < 2; ++b)
#pragma unroll
            for (int m = 0; m < 4; ++m)
#pragma unroll
                for (int n = 0; n < 2; ++n) acc[a][b][m][n] = (f32x4){0.f, 0.f, 0.f, 0.f};
    bf16x8 At[4][2], B0[2][2], B1[2][2];
    unsigned vgc[2][2] = {{0u, 0u}, {0u, 0u}};
    LAS u32x4* gslot = (LAS u32x4*)(lds + STAGE_BYTES + 4096) + tid;
    unsigned cA = cur.A, cB = cur.B;
    if (GATHER) { G8_GOFF(vgc, cur); }
    G8_STAGE(G8_SB(0, 0), cB, voffB); G8_STAGE_A(G8_SA(0, 0), cA, 0, vgc); G8_STAGE(G8_SB(0, 1), cB + hstep, voffB); G8_STAGE_A(G8_SA(0, 1), cA, 1, vgc);
    if (wr == 1) G8_BAR;
    G8_WAIT_V(4); G8_BAR;
    G8_STAGE(G8_SB(1, 0), cB + kstep, voffB); G8_STAGE_A(G8_SA(1, 0), cA + kstep, 0, vgc); G8_STAGE(G8_SB(1, 1), cB + hstep + kstep, voffB);
    G8_WAIT_V(6); G8_BAR;
    for (;;) {
        const bool has_next = S.next(ui + 1, nxt);
        const unsigned nA = has_next ? nxt.A : cA, nB = has_next ? nxt.B : cB;
        if (GATHER && has_next) {
            unsigned vt[2][2]; G8_GOFF(vt, nxt);
            *gslot = u32x4{vt[0][0], vt[0][1], vt[1][0], vt[1][1]};
        }
        unsigned long long tk0 = 0;
        if (Epi::TIMEK) tk0 = __builtin_amdgcn_s_memrealtime();
#pragma unroll 1
        for (int t = 0; t < nt; t += 2) {
            const bool last = (t == nt - 2);
            const unsigned a1 = cA + (unsigned)(t + 1) * kstep;
            const unsigned a2 = last ? nA : cA + (unsigned)(t + 2) * kstep, b2 = last ? nB : cB + (unsigned)(t + 2) * kstep;
            const unsigned a3 = a2 + kstep, b3 = b2 + kstep;
            G8_LDB(B0, 0, 0); G8_SCHED; G8_LDA(At, 0, 0); G8_STAGE_A(G8_SA(1, 1), a1, 1, vgc);
            G8_WAIT_L(8); G8_BAR; G8_WAIT_L(0); G8_MMA(0, 0, At, B0); G8_BAR; G8_SCHED;
            G8_LDB(B1, 0, 1);
            if (GATHER && last && has_next) { const u32x4 x = *gslot; vgc[0][0] = x[0]; vgc[0][1] = x[1]; vgc[1][0] = x[2]; vgc[1][1] = x[3]; }
            G8_STAGE(G8_SB(0, 0), b2, voffB);
            G8_BAR; G8_WAIT_L(0); G8_MMA(0, 1, At, B1); G8_BAR;
            G8_LDA(At, 0, 1); G8_STAGE_A(G8_SA(0, 0), a2, 0, vgc);
            G8_BAR; G8_WAIT_L(0); G8_MMA(1, 0, At, B0); G8_BAR; G8_SCHED;
            G8_STAGE(G8_SB(0, 1), b2 + hstep, voffB);
            G8_WAIT_V(6); G8_BAR; G8_MMA(1, 1, At, B1); G8_BAR;
            G8_LDB(B0, 1, 0); G8_SCHED; G8_LDA(At, 1, 0); G8_STAGE_A(G8_SA(0, 1), a2, 1, vgc);
            G8_WAIT_L(8); G8_BAR; G8_WAIT_L(0); G8_MMA(0, 0, At, B0); G8_BAR; G8_SCHED;
            G8_LDB(B1, 1, 1); G8_STAGE(G8_SB(1, 0), b3, voffB);
            G8_BAR; G8_WAIT_L(0); G8_MMA(0, 1, At, B1); G8_BAR;
            G8_LDA(At, 1, 1); G8_STAGE_A(G8_SA(1, 0), a3, 0, vgc);
            G8_BAR; G8_WAIT_L(0); G8_MMA(1, 0, At, B0); G8_BAR; G8_SCHED;
            G8_STAGE(G8_SB(1, 1), b3 + hstep, voffB);
            G8_WAIT_V(6); G8_BAR; G8_MMA(1, 1, At, B1); G8_BAR;
        }
        if (Epi::TIMEK && tid == 0) { const unsigned dt = (unsigned)(__builtin_amdgcn_s_memrealtime() - tk0); *(LAS unsigned*)(lds + 147456 + 32) += dt; }
        const bool keep = E(acc, cur, wr, wc, fr, fq);
        if (!has_next) break;
        if (!keep) {
#pragma unroll
        for (int a = 0; a < 2; ++a)
#pragma unroll
            for (int b = 0; b < 2; ++b)
#pragma unroll
                for (int m = 0; m < 4; ++m)
#pragma unroll
                    for (int n = 0; n < 2; ++n) acc[a][b][m][n] = (f32x4){0.f, 0.f, 0.f, 0.f};
        }
        cur = nxt; cA = nA; cB = nB; ++ui;
    }
    G8_WAIT_V(0);
    if (wr == 0) G8_BAR;
    G8_BAR;
#undef G8_SA
#undef G8_SB
#undef G8_STAGE
#undef G8_STAGE_A
#undef G8_LDA
#undef G8_LDB
#undef G8_MMA
#undef G8_WAIT_V
#undef G8_WAIT_L
#undef G8_BAR
#undef G8_SCHED
#undef G8_GOFF
}
}

__device__ __forceinline__ u32x4 pack8v(const f32x4& a, const f32x4& b) {
    u32x4 w; w[0] = g8::cvt_pk_bf16(a[0], a[1]); w[1] = g8::cvt_pk_bf16(a[2], a[3]); w[2] = g8::cvt_pk_bf16(b[0], b[1]); w[3] = g8::cvt_pk_bf16(b[2], b[3]); return w;
}
__device__ __forceinline__ uint4 pack8(const f32x4& a, const f32x4& b) {
    uint4 w; w.x = g8::cvt_pk_bf16(a[0], a[1]); w.y = g8::cvt_pk_bf16(a[2], a[3]); w.z = g8::cvt_pk_bf16(b[0], b[1]); w.w = g8::cvt_pk_bf16(b[2], b[3]); return w;
}

struct ProjSched {
    unsigned A, B; int c, G;
    __device__ __forceinline__ bool next(int i, g8::Unit& u) const {
        const int L = i * G + c; if (L >= 64 * 26) return false;
        const int xcd = L & 7, jx = L >> 3;
        u.pm = xcd * 8 + (jx & 7); u.pn = jx >> 3;
        u.A = A + (unsigned)u.pm * 256 * DM * 2; u.B = B + (unsigned)u.pn * 256 * DM * 2; u.x0 = 0; u.x1 = 0; return true;
    }
    __device__ __forceinline__ int row(const g8::Unit&, int) const { return 0; }
};
struct ProjEpi {
    static constexpr bool TIMEK = PROBE_TIMEK_ProjEpi;
    static constexpr bool PERM = true;
    unsigned char* ws; const float* bg;
    __device__ __forceinline__ bool operator()(f32x4 (&acc)[2][2][4][2], const g8::Unit& u, int wr, int wc, int fr, int fq) const {
        const int seg = (u.pn * 256) >> 9;
        f32x4 cc[2][2];
#pragma unroll
        for (int bj = 0; bj < 2; ++bj) {
            const int col = u.pn * 256 + bj * 128 + wc * 32 + fq * 8;
            if (seg == 1) { cc[bj][0] = ldg<f32x4>(ws, (unsigned)(OFF_LB + (col & 511) * 4)); cc[bj][1] = ldg<f32x4>(ws, (unsigned)(OFF_LB + (col & 511) * 4 + 16)); }
            else if (seg >= 7) { cc[bj][0] = *(const f32x4*)(bg + col - 3584); cc[bj][1] = *(const f32x4*)(bg + col - 3584 + 4); }
            else { cc[bj][0] = f32x4{0.f, 0.f, 0.f, 0.f}; cc[bj][1] = cc[bj][0]; }
        }
#pragma unroll
        for (int ai = 0; ai < 2; ++ai)
#pragma unroll
            for (int m = 0; m < 4; ++m) {
                const int row = u.pm * 256 + ai * 128 + wr * 64 + m * 16 + fr;
#pragma unroll
                for (int bj = 0; bj < 2; ++bj) {
                    const int col = u.pn * 256 + bj * 128 + wc * 32 + fq * 8;
                    const int c = col & 511;
                    f32x4 v0 = acc[ai][bj][m][0], v1 = acc[ai][bj][m][1];
                    if (seg == 0 || seg == 3) {
#pragma unroll
                        for (int i = 0; i < 4; ++i) { v0[i] = silu_f(v0[i]); v1[i] = silu_f(v1[i]); }
                        stg<uint4>(ws, (unsigned)((seg == 0 ? OFF_PQ : OFF_PG) + (row * 512 + c) * 2), pack8(v0, v1));
                    } else if (seg == 1) {
                        const f32x4 l0 = cc[bj][0], l1 = cc[bj][1];
                        f32x4 g0, g1, k0, k1;
#pragma unroll
                        for (int i = 0; i < 4; ++i) {
                            const float s0 = sigm(v0[i]), s1 = sigm(v1[i]);
                            g0[i] = __logf(l0[i] + (1.f - l0[i]) * s0); g1[i] = __logf(l1[i] + (1.f - l1[i]) * s1);
                            k0[i] = (1.f - l0[i]) * (1.f - s0); k1[i] = (1.f - l1[i]) * (1.f - s1);
                        }
                        stg<f32x4>(ws, (unsigned)(OFF_PLF + (row * 512 + c) * 4), g0);
                        stg<f32x4>(ws, (unsigned)(OFF_PLF + (row * 512 + c) * 4 + 16), g1);
                        stg<uint4>(ws, (unsigned)(OFF_PK + (row * 512 + c) * 2), pack8(k0, k1));
                    } else if (seg == 2 || seg == 6) {
                        stg<uint4>(ws, (unsigned)((seg == 2 ? OFF_PV : OFF_PXR) + (row * 512 + c) * 2), pack8(v0, v1));
                    } else if (seg == 4) {
                        stg<uint4>(ws, (unsigned)(OFF_PU + (((c >> 4) * NTOK + row) * 16 + (c & 15)) * 2), pack8(v0, v1));
                    } else if (seg == 5) {
#pragma unroll
                        for (int i = 0; i < 4; ++i) { v0[i] = gelu_f(v0[i]); v1[i] = gelu_f(v1[i]); }
                        stg<uint4>(ws, (unsigned)(OFF_PXG + (row * 512 + c) * 2), pack8(v0, v1));
                    } else {
                        const int gc = col - 3584;
#pragma unroll
                        for (int i = 0; i < 4; ++i) { v0[i] = sigm(v0[i] + cc[bj][0][i]); v1[i] = sigm(v1[i] + cc[bj][1][i]); }
                        stg<uint4>(ws, (unsigned)(OFF_PGATE + (row * 3072 + gc) * 2), pack8(v0, v1));
                    }
                }
            }
        return false;
    }
};
__device__ void phase_proj(CParams& p, int l, char* lds) {
    ProjSched S; S.A = (unsigned)OFF_XB; S.B = (unsigned)OFF_WINT; S.c = blockIdx.x; S.G = gridDim.x;
    ProjEpi E; E.ws = p.ws; E.bg = p.in[2] + (size_t)l * 3072;
    g8::gemm_phase<ProjEpi, ProjSched, false>((LAS unsigned char*)lds, p.ws, 1024, S, E);
}

struct OutSched {
    unsigned A, B; int c, G;
    __device__ __forceinline__ bool next(int i, g8::Unit& u) const {
        const int L = i * G + c; if (L >= 64 * 4) return false;
        const int xcd = L & 7, jx = L >> 3;
        u.pm = xcd * 8 + (jx & 7); u.pn = jx >> 3;
        u.A = A + (unsigned)u.pm * 256 * 1024 * 2; u.B = B + (unsigned)u.pn * 256 * 1024 * 2; u.x0 = 0; u.x1 = 0; return true;
    }
    __device__ __forceinline__ int row(const g8::Unit&, int) const { return 0; }
};
struct OutEpi {
    static constexpr bool TIMEK = PROBE_TIMEK_OutEpi;
    static constexpr bool PERM = false;
    unsigned char* ws;
    __device__ __forceinline__ bool operator()(f32x4 (&acc)[2][2][4][2], const g8::Unit& u, int wr, int wc, int fr, int fq) const {
#pragma unroll
        for (int ai = 0; ai < 2; ++ai) {
            f32x4 x[4][2][2];
#pragma unroll
            for (int m = 0; m < 4; ++m)
#pragma unroll
                for (int bj = 0; bj < 2; ++bj)
#pragma unroll
                    for (int n = 0; n < 2; ++n) {
                        const int row = u.pm * 256 + ai * 128 + wr * 64 + m * 16 + fr, col = u.pn * 256 + bj * 128 + wc * 32 + n * 16 + fq * 4;
                        x[m][bj][n] = unpack4(ldg<uint2>(ws, (unsigned)(OFF_XB + (row * 1024 + col) * 2)));
                    }
#pragma unroll
            for (int m = 0; m < 4; ++m)
#pragma unroll
                for (int bj = 0; bj < 2; ++bj)
#pragma unroll
                    for (int n = 0; n < 2; ++n) {
                        const int row = u.pm * 256 + ai * 128 + wr * 64 + m * 16 + fr, col = u.pn * 256 + bj * 128 + wc * 32 + n * 16 + fq * 4;
                        stg<f32x4>(ws, (unsigned)OFF_PRELN + (unsigned)((row * 1024 + col) * 4), x[m][bj][n] * DN_ALPHA + acc[ai][bj][m][n]);
                    }
        }
        return false;
    }
};

struct BrSched {
    int c;
    __device__ __forceinline__ bool next(int i, g8::Unit& u) const {
        if (i >= 3) return false;
        const int xcd = c & 7, jx = c >> 3;
        u.pm = xcd * 8 + (jx & 7); u.pn = jx >> 3; u.x0 = i; u.x1 = 0;
        u.A = (unsigned)(i == 0 ? OFF_YA : (i == 1 ? OFF_YB : OFF_YC)) + (unsigned)u.pm * 256 * 512 * 2;
        u.B = (unsigned)OFF_WBRT + (unsigned)i * 1024 * 512 * 2 + (unsigned)u.pn * 256 * 512 * 2;
        return true;
    }
    __device__ __forceinline__ int row(const g8::Unit&, int) const { return 0; }
};
struct BrEpi {
    static constexpr bool TIMEK = PROBE_TIMEK_BrEpi;
    static constexpr bool PERM = true;
    unsigned char* ws;
    __device__ __forceinline__ bool operator()(f32x4 (&acc)[2][2][4][2], const g8::Unit& u, int wr, int wc, int fr, int fq) const {
        const int k = u.x0;
#pragma unroll
        for (int ai = 0; ai < 2; ++ai) {
            uint4 gq[4][2], gn[4][2];
#pragma unroll
            for (int m = 0; m < 4; ++m)
#pragma unroll
                for (int bj = 0; bj < 2; ++bj) {
                    const int row = u.pm * 256 + ai * 128 + wr * 64 + m * 16 + fr, col = u.pn * 256 + bj * 128 + wc * 32 + fq * 8;
                    const unsigned go = (unsigned)(OFF_PGATE + (row * 3072 + k * 1024 + col) * 2);
                    gq[m][bj] = ldg<uint4>(ws, go);
                    gn[m][bj] = (k < 2) ? ldg<uint4>(ws, go + 2048) : uint4{0x3f803f80u, 0x3f803f80u, 0x3f803f80u, 0x3f803f80u};
                }
#pragma unroll
            for (int m = 0; m < 4; ++m)
#pragma unroll
                for (int bj = 0; bj < 2; ++bj) {
                    const int row = u.pm * 256 + ai * 128 + wr * 64 + m * 16 + fr, col = u.pn * 256 + bj * 128 + wc * 32 + fq * 8;
                    const uint4 q = gq[m][bj], nx = gn[m][bj];
                    float s[8] = {bf2f((u16)(q.x & 0xffff)), bf2f((u16)(q.x >> 16)), bf2f((u16)(q.y & 0xffff)), bf2f((u16)(q.y >> 16)),
                                  bf2f((u16)(q.z & 0xffff)), bf2f((u16)(q.z >> 16)), bf2f((u16)(q.w & 0xffff)), bf2f((u16)(q.w >> 16))};
                    s[0] *= __builtin_amdgcn_rcpf(bf2f((u16)(nx.x & 0xffff))); s[1] *= __builtin_amdgcn_rcpf(bf2f((u16)(nx.x >> 16)));
                    s[2] *= __builtin_amdgcn_rcpf(bf2f((u16)(nx.y & 0xffff))); s[3] *= __builtin_amdgcn_rcpf(bf2f((u16)(nx.y >> 16)));
                    s[4] *= __builtin_amdgcn_rcpf(bf2f((u16)(nx.z & 0xffff))); s[5] *= __builtin_amdgcn_rcpf(bf2f((u16)(nx.z >> 16)));
                    s[6] *= __builtin_amdgcn_rcpf(bf2f((u16)(nx.w & 0xffff))); s[7] *= __builtin_amdgcn_rcpf(bf2f((u16)(nx.w >> 16)));
#pragma unroll
                    for (int i = 0; i < 4; ++i) { acc[ai][bj][m][0][i] *= s[i]; acc[ai][bj][m][1][i] *= s[4 + i]; }
                    if (k == 2) stg<uint4>(ws, (unsigned)(OFF_MIXP + (row * 1024 + col) * 2), pack8(acc[ai][bj][m][0], acc[ai][bj][m][1]));
                }
        }
        return k < 2;
    }
};

struct MoeSched {
    const int* sm; const unsigned char* ws; unsigned A, Bexp, Bsh, Ash;
    int c, G, npn, K, bstride_e, gather, nsh;
    __device__ __forceinline__ bool next(int i, g8::Unit& u) const {
        int nbr = __builtin_amdgcn_readfirstlane(sm[64]); asm volatile("" : "+s"(nbr));
        const int L = i * G + c; if (L >= (nbr + nsh) * npn) return false;
        const int blk = L / npn; u.pn = L - blk * npn;
        if (blk >= nbr) {
            u.x0 = 64; u.pm = blk - nbr; u.x1 = NTOK;
            u.A = gather ? A : Ash + (unsigned)u.pm * 256 * K * 2;
            u.B = Bsh + (unsigned)u.pn * 256 * K * 2;
        } else {
            int e = __builtin_amdgcn_readfirstlane(sm[256 + blk]);
            int be = __builtin_amdgcn_readfirstlane(sm[e]), re = __builtin_amdgcn_readfirstlane(sm[65 + e]), ce = __builtin_amdgcn_readfirstlane(sm[130 + e]);
            asm volatile("" : "+s"(e), "+s"(be), "+s"(re), "+s"(ce));
            u.x0 = e; u.pm = blk - be; u.x1 = ce;
            u.A = gather ? A : A + (unsigned)(re + u.pm * 256) * K * 2;
            u.B = Bexp + (unsigned)e * bstride_e + (unsigned)u.pn * 256 * K * 2;
        }
        return true;
    }
    __device__ __forceinline__ int row(const g8::Unit& u, int r) const {
        const int rr = u.pm * 256 + r;
        if (u.x0 == 64) return rr;
        return (rr < u.x1) ? (ldg<int>(ws, (unsigned)(OFF_LIST + (u.x0 * NTOK + rr) * 4)) >> 3) : 0;
    }
};
__device__ __forceinline__ void moe_setup(CParams& p, int* sm) {
    __syncthreads();
    if (threadIdx.x == 0) {
        const int* cursor = (const int*)(p.ws + OFF_CUR);
        int nb = 0, nr = 0;
        for (int e = 0; e < 64; ++e) { sm[e] = nb; sm[65 + e] = nr; int c = cursor[e]; sm[130 + e] = c; nb += (c + 255) >> 8; nr += c; }
        sm[64] = nb; sm[129] = nr;
    }
    __syncthreads();
    if (threadIdx.x < 64) { const int e = threadIdx.x; for (int k = sm[e]; k < sm[e + 1]; ++k) sm[256 + k] = e; }
    __syncthreads();
}
struct Moe1Epi {
    static constexpr bool TIMEK = PROBE_TIMEK_Moe1Epi;
    static constexpr bool PERM = false;
    unsigned char* ws; const int* sm;
    __device__ __forceinline__ bool operator()(f32x4 (&acc)[2][2][4][2], const g8::Unit& u, int wr, int wc, int fr, int fq) const {
        const int rbase = (u.x0 == 64) ? 0 : __builtin_amdgcn_readfirstlane(sm[65 + (u.x0 & 63)]);
        const unsigned hoff = (unsigned)((u.x0 == 64) ? OFF_HSH + (size_t)u.pm * 256 * 256 * 2 : OFF_HBUF + (size_t)(rbase + u.pm * 256) * 256 * 2);
        const int valid = u.x1 - u.pm * 256;
        float rw[2][4];
        const unsigned wb = (unsigned)(OFF_WLIST + ((u.x0 & 63) * NTOK + u.pm * 256 + wr * 64 + fr) * 4);
#pragma unroll
        for (int ai = 0; ai < 2; ++ai)
#pragma unroll
            for (int m = 0; m < 4; ++m) {
                const int r = ai * 128 + wr * 64 + m * 16 + fr;
                rw[ai][m] = (u.x0 != 64 && r < valid) ? ldg<float>(ws, wb + (unsigned)((ai * 128 + m * 16) * 4)) : 1.f;
            }
#pragma unroll
        for (int ai = 0; ai < 2; ++ai)
#pragma unroll
            for (int m = 0; m < 4; ++m) {
                const int r = ai * 128 + wr * 64 + m * 16 + fr;
                const float w = rw[ai][m];
#pragma unroll
                for (int bj = 0; bj < 2; ++bj) {
                    const int hid = ((u.pn * 256 + bj * 128 + wc * 32) >> 1) + fq * 4;
                    const f32x4 a = acc[ai][bj][m][0], b = acc[ai][bj][m][1] * w;
                    uint2 pk;
                    pk.x = g8::cvt_pk_bf16(silu_f(a[0]) * b[0], silu_f(a[1]) * b[1]);
                    pk.y = g8::cvt_pk_bf16(silu_f(a[2]) * b[2], silu_f(a[3]) * b[3]);
                    if (r < valid) stg<uint2>(ws, hoff + (unsigned)(r * 256 + hid) * 2u, pk);
                }
                __builtin_amdgcn_sched_barrier(0);
            }
        return false;
    }
};
__device__ void phase_moe1(CParams& p, int l, char* lds) {
    int* sm = (int*)(lds + g8::STAGE_BYTES);
    moe_setup(p, sm);
    MoeSched S; S.sm = sm; S.ws = p.ws;
    S.A = (unsigned)OFF_XM; S.Ash = S.A; S.Bexp = (unsigned)OFF_EW13; S.Bsh = (unsigned)OFF_SH13T;
    S.c = (blockIdx.x & 7) * 32 + (blockIdx.x >> 3); S.G = gridDim.x; S.npn = 2; S.K = 1024; S.bstride_e = 512 * 1024 * 2; S.gather = 1; S.nsh = 64;
    Moe1Epi E; E.ws = p.ws; E.sm = sm;
    g8::gemm_phase<Moe1Epi, MoeSched, true>((LAS unsigned char*)lds, p.ws, 1024, S, E);
}
struct Moe2Epi {
    static constexpr bool TIMEK = PROBE_TIMEK_Moe2Epi;
    static constexpr bool PERM = true;
    unsigned char* ws;
    __device__ __forceinline__ bool operator()(f32x4 (&acc)[2][2][4][2], const g8::Unit& u, int wr, int wc, int fr, int fq) const {
        const int valid = u.x1 - u.pm * 256;
        const int colb = u.pn * 256 + wc * 32 + fq * 8;
        const unsigned lbase = (unsigned)(OFF_LIST + (u.x0 * NTOK + u.pm * 256 + wr * 64 + fr) * 4);
        int ent[2][4];
#pragma unroll
        for (int ai = 0; ai < 2; ++ai)
#pragma unroll
            for (int m = 0; m < 4; ++m) {
                const int r = ai * 128 + wr * 64 + m * 16 + fr;
                ent[ai][m] = (r < valid) ? ldg<int>(ws, lbase + (unsigned)((ai * 128 + m * 16) * 4)) : 0;
            }
#pragma unroll
        for (int ai = 0; ai < 2; ++ai)
#pragma unroll
            for (int m = 0; m < 4; ++m) {
                const int r = ai * 128 + wr * 64 + m * 16 + fr;
                if (r < valid) {
                    const unsigned o = (unsigned)OFF_YBUF + (unsigned)(ent[ai][m] * 1024 + colb);
#pragma unroll
                    for (int bj = 0; bj < 2; ++bj) {
                        const f32x4 a = acc[ai][bj][m][0] * 32.f, b = acc[ai][bj][m][1] * 32.f;
                        int w0 = __builtin_amdgcn_cvt_pk_fp8_f32(a[0], a[1], 0, false); w0 = __builtin_amdgcn_cvt_pk_fp8_f32(a[2], a[3], w0, true);
                        int w1 = __builtin_amdgcn_cvt_pk_fp8_f32(b[0], b[1], 0, false); w1 = __builtin_amdgcn_cvt_pk_fp8_f32(b[2], b[3], w1, true);
                        stg<uint2>(ws, o + bj * 128, uint2{(unsigned)w0, (unsigned)w1});
                    }
                }
                __builtin_amdgcn_sched_barrier(0);
            }
        return false;
    }
};
struct ShSched {
    int c, G;
    __device__ __forceinline__ bool next(int i, g8::Unit& u) const {
        const int L = i * G + c; if (L >= 64 * 4) return false;
        u.pm = L >> 2; u.pn = L & 3; u.A = (unsigned)OFF_HSH + (unsigned)u.pm * 256 * 256 * 2; u.B = (unsigned)OFF_SH2T + (unsigned)u.pn * 256 * 256 * 2; u.x0 = 64; u.x1 = NTOK; return true;
    }
    __device__ __forceinline__ int row(const g8::Unit&, int) const { return 0; }
};
struct ShEpi {
    static constexpr bool TIMEK = PROBE_TIMEK_ShEpi;
    static constexpr bool PROBE = false;
    static constexpr bool PERM = true;
    unsigned char* ws;
    __device__ __forceinline__ bool operator()(f32x4 (&acc)[2][2][4][2], const g8::Unit& u, int wr, int wc, int fr, int fq) const {
#pragma unroll
        for (int ai = 0; ai < 2; ++ai)
#pragma unroll
            for (int m = 0; m < 4; ++m) {
                const int row = u.pm * 256 + ai * 128 + wr * 64 + m * 16 + fr;
#pragma unroll
                for (int bj = 0; bj < 2; ++bj)
                    stg<uint4>(ws, (unsigned)(OFF_YSH + (row * 1024 + u.pn * 256 + bj * 128 + wc * 32 + fq * 8) * 2), pack8(acc[ai][bj][m][0], acc[ai][bj][m][1]));
                __builtin_amdgcn_sched_barrier(0);
            }
        return false;
    }
};
__device__ void phase_moe2(CParams& p, int l, char* lds) {
    int* sm = (int*)(lds + g8::STAGE_BYTES);
    moe_setup(p, sm);
    MoeSched S; S.sm = sm; S.ws = p.ws;
    S.A = (unsigned)OFF_HBUF; S.Ash = (unsigned)OFF_HSH; S.Bexp = (unsigned)OFF_EW2; S.Bsh = (unsigned)OFF_SH2T;
    S.c = (blockIdx.x & 7) * 32 + (blockIdx.x >> 3); S.G = gridDim.x; S.npn = 4; S.K = 256; S.bstride_e = 1024 * 256 * 2; S.gather = 0; S.nsh = 0;
    Moe2Epi E; E.ws = p.ws;
    g8::gemm_phase<Moe2Epi, MoeSched, false>((LAS unsigned char*)lds, p.ws, 256, S, E);
    ShSched S2; S2.c = (blockIdx.x & 7) * 32 + (blockIdx.x >> 3); S2.G = gridDim.x;
    ShEpi E2; E2.ws = p.ws;
    g8::gemm_phase<ShEpi, ShSched, false>((LAS unsigned char*)lds, p.ws, 256, S2, E2);
}

__device__ void conv_tile(const float* s1, const float* s2, int ldsrc, int K, int perm, u16* dst, int tile, float* lds) {
    const int tid = otid();
    const int ktiles = K >> 6;
    const int kt = tile % ktiles, nt = tile / ktiles;
    __syncthreads();
#pragma unroll 4
    for (int i = 0; i < 16; ++i) {
        int idx = tid + i * 256, kr = idx >> 6, nc = idx & 63;
        const float* s; int col;
        if (perm == 32) { s = (nc < 32) ? s1 : s2; col = nt * 32 + (nc & 31); }
        else if (perm == 16) { s = ((nc & 31) < 16) ? s1 : s2; col = (nt * 2 + (nc >> 5)) * 16 + (nc & 15); }
        else { s = s1; col = nt * 64 + nc; }
        lds[kr * 65 + nc] = s[(size_t)(kt * 64 + kr) * ldsrc + col];
    }
    __syncthreads();
#pragma unroll 4
    for (int i = 0; i < 16; ++i) {
        int idx = tid + i * 256, nr = idx >> 6, kc = idx & 63;
        dst[(size_t)(nt * 64 + nr) * K + kt * 64 + kc] = f2bf(lds[kc * 65 + nr]);
    }
}

__device__ void s5_precompute(CParams& p, int l, int g, int part, float* lds) {
    const int tid = otid();
    float* Er = lds;
    float* Ei = Er + 64 * 17;
    float* Br = Ei + 64 * 17;
    float* Bi = Br + 1024;
    float* Cr = Bi + 1024;
    float* Ci = Cr + 1024;
    float* Kt = Ci + 1024;
    __syncthreads();
    const int lg = l * 32 + g;
    const float dt = expf(p.in[12][lg]);
    {
        const int pp = tid & 63, part = tid >> 6;
        const float ar = p.in[5][lg * 64 + pp], ai = p.in[6][lg * 64 + pp];
        for (int tau = part; tau <= 16; tau += 4) {
            float mag = expf((float)tau * ar * dt);
            float ang = (float)tau * ai * dt;
            Er[pp * 17 + tau] = mag * cosf(ang);
            Ei[pp * 17 + tau] = mag * sinf(ang);
        }
        float mag = expf(ar * dt), ang = ai * dt;
        float e1r = mag * cosf(ang) - 1.f, e1i = mag * sinf(ang);
        float den = ar * ar + ai * ai;
        float qr = (e1r * ar + e1i * ai) / den, qi = (e1i * ar - e1r * ai) / den;
        for (int c = part * 4; c < part * 4 + 4; ++c) {
            float br = p.in[7][((size_t)lg * 64 + pp) * 16 + c], bi = p.in[8][((size_t)lg * 64 + pp) * 16 + c];
            Br[pp * 16 + c] = qr * br - qi * bi;
            Bi[pp * 16 + c] = qr * bi + qi * br;
            Cr[c * 64 + pp] = p.in[9][((size_t)lg * 16 + c) * 64 + pp];
            Ci[c * 64 + pp] = p.in[10][((size_t)lg * 16 + c) * 64 + pp];
        }
    }
    __syncthreads();
    u16* bta = (u16*)(p.ws + OFF_BTA) + (size_t)g * 128 * 256;
    for (int i = part * 16; i < part * 16 + 16; ++i) {
        int idx = tid + i * 256, pr = idx >> 8, k = idx & 255, s = k >> 4, ch = k & 15, pp = pr & 63;
        float er = Er[pp * 17 + 15 - s], ei = Ei[pp * 17 + 15 - s], br = Br[pp * 16 + ch], bi = Bi[pp * 16 + ch];
        float v = (pr < 64) ? (er * br - ei * bi) : (er * bi + ei * br);
        bta[idx] = f2bf(v);
    }
    u16* btc = (u16*)(p.ws + OFF_BTC) + (size_t)g * 256 * 384;
    {
        const int ch = tid >> 4, c2 = tid & 15;
        for (int tt = 0; tt < 2; ++tt) {
            const int tau = part * 2 + tt;
            float s = 0.f;
            for (int pp = 0; pp < 64; ++pp) {
                float cr = Cr[ch * 64 + pp], ci = Ci[ch * 64 + pp], er = Er[pp * 17 + tau], ei = Ei[pp * 17 + tau];
                float gr = cr * er - ci * ei, gi = cr * ei + ci * er;
                s += gr * Br[pp * 16 + c2] - gi * Bi[pp * 16 + c2];
            }
            const u16 kv = f2bf(s);
            for (int j = tau; j < 16; ++j) btc[(size_t)(j * 16 + ch) * 384 + (j - tau) * 16 + c2] = kv;
            if (tau > 0) for (int j = 0; j + tau < 16; ++j) btc[(size_t)(j * 16 + ch) * 384 + (j + tau) * 16 + c2] = 0;
        }
        for (int i = 0; i < 16; ++i) {
            const int idx = tid + i * 256, n = part * 32 + (idx >> 7), pr = idx & 127, pp = pr & 63, j = n >> 4, chn = n & 15;
            float cr = Cr[chn * 64 + pp], ci = Ci[chn * 64 + pp], er = Er[pp * 17 + j + 1], ei = Ei[pp * 17 + j + 1];
            float gr = cr * er - ci * ei, gi = cr * ei + ci * er;
            btc[(size_t)n * 384 + 256 + pr] = f2bf((pr < 64) ? gr : -gi);
        }
    }
}

constexpr int W_CONV_TILES = 2608;
__device__ void phase_w(CParams& p, int l, char* lds) {
    const int tid = otid();
    const int nunits = W_CONV_TILES + 256 + 2 + (l == 0 ? 1024 : 0);
    for (int uu = VB; uu < nunits; uu += VG) {
        const int u = (uu < 256) ? uu + W_CONV_TILES : (uu < W_CONV_TILES + 256 ? uu - 256 : uu);
        if (u < W_CONV_TILES) {
            int t = u;
            const float *s1, *s2 = nullptr; int ld, K, perm = 0; u16* dst;
            if (t < 1664) { s1 = p.in[1] + (size_t)l * DM * INC; ld = INC; K = 1024; dst = (u16*)(p.ws + OFF_WINT); }
            else if ((t -= 1664) < 384) { int k = t >> 7; t &= 127; s1 = p.in[22] + (size_t)(l * 3 + k) * 512 * 1024; ld = 1024; K = 512; dst = (u16*)(p.ws + OFF_WBRT) + (size_t)k * 1024 * 512; }
            else if ((t -= 384) < 256) { s1 = p.in[23] + (size_t)l * 1024 * 1024; ld = 1024; K = 1024; dst = (u16*)(p.ws + OFF_WOUTT); }
            else if ((t -= 256) < 64) { s1 = p.in[13] + (size_t)l * 512 * 512; ld = 512; K = 512; dst = (u16*)(p.ws + OFF_GLUT); }
            else if ((t -= 64) < 32) { int h = t >> 3; t &= 7; s1 = p.in[17] + (size_t)(l * 4 + h) * 128 * 128; s2 = p.in[19] + (size_t)(l * 4 + h) * 128 * 128; ld = 128; K = 128; perm = 32; dst = (u16*)(p.ws + OFF_RGT) + (size_t)h * 256 * 128; }
            else if ((t -= 32) < 128) { s1 = p.in[31] + (size_t)l * 1024 * 256; s2 = p.in[32] + (size_t)l * 1024 * 256; ld = 256; K = 1024; perm = 16; dst = (u16*)(p.ws + OFF_SH13T); }
            else if ((t -= 128) < 64) { s1 = p.in[33] + (size_t)l * 256 * 1024; ld = 1024; K = 256; dst = (u16*)(p.ws + OFF_SH2T); }
            else { t -= 64; s1 = p.in[26] + (size_t)l * 1024 * 64; ld = 64; K = 1024; dst = (u16*)(p.ws + OFF_ROUTT); }
            conv_tile(s1, s2, ld, K, perm, dst, t, (float*)lds);
        } else if (u < W_CONV_TILES + 256) {
            s5_precompute(p, l, (u - W_CONV_TILES) >> 3, (u - W_CONV_TILES) & 7, (float*)lds);
        } else if (u == W_CONV_TILES + 256) {
            float* LB = (float*)(p.ws + OFF_LB);
            for (int c = tid; c < 512; c += 256) {
                float x0 = p.in[3][c], x1 = p.in[3][512 + c];
                LB[c] = (l == 0) ? 0.f : 1.f / (1.f + expf(x0 - x1));
            }
            if (tid < 64) ((int*)(p.ws + OFF_CUR))[tid] = 0;
        } else if (u == W_CONV_TILES + 257) {
        } else {
            int r0 = (u - (W_CONV_TILES + 258)) * 16;
            const float4* src = (const float4*)(p.in[0] + (size_t)r0 * DM);
            uint2* dst = (uint2*)((u16*)(p.ws + OFF_XB) + (size_t)r0 * DM);
            for (int i = tid; i < 16 * 256; i += 256) {
                float4 v = src[i];
                uint2 o; o.x = f2bf(v.x) | ((unsigned)f2bf(v.y) << 16); o.y = f2bf(v.z) | ((unsigned)f2bf(v.w) << 16);
                dst[i] = o;
            }
        }
    }
}

__device__ void hgrn_prep(CParams& p, int u, char* lds) {
    const int tid = otid();
    const int h = u & 3, c = (u >> 2) & 63, b = u >> 8;
    const int r0 = b * SEQ + c * 64;
    const unsigned cu = (unsigned)((b * 4 + h) * 64 + c);
    unsigned char* ws = p.ws;
    float* F = (float*)lds;
    u16* Kb = (u16*)(lds + 32768);
    u16* Vb = (u16*)(lds + 49152);
    __syncthreads();
#pragma unroll
    for (int i = 0; i < 8; ++i) {
        const int id = tid + i * 256, s = id >> 5, d4 = (id & 31) * 4;
        *(f32x4*)(F + s * 128 + d4) = ldg<f32x4>(ws, (unsigned)(OFF_PLF + ((r0 + s) * 512 + h * 128 + d4) * 4));
    }
#pragma unroll
    for (int i = 0; i < 4; ++i) {
        const int id = tid + i * 256, s = id >> 4, d8 = (id & 15) * 8;
        *(uint4*)(Kb + s * 128 + d8) = ldg<uint4>(ws, (unsigned)(OFF_PK + ((r0 + s) * 512 + h * 128 + d8) * 2));
        *(uint4*)(Vb + s * 128 + d8) = ldg<uint4>(ws, (unsigned)(OFF_PV + ((r0 + s) * 512 + h * 128 + d8) * 2));
    }
    __syncthreads();
    {
        const int d = tid & 127, hf = tid >> 7;
        float run = 0.f;
#pragma unroll 8
        for (int s = hf * 32; s < hf * 32 + 32; ++s) { run += F[s * 128 + d]; F[s * 128 + d] = run; }
        __syncthreads();
        if (hf) {
            const float add = F[31 * 128 + d];
#pragma unroll 8
            for (int s = 32; s < 64; ++s) F[s * 128 + d] += add;
        }
    }
    __syncthreads();
#pragma unroll
    for (int i = 0; i < 8; ++i) {
        const int id = tid + i * 256, s = id >> 5, d4 = (id & 31) * 4;
        stg<f32x4>(ws, (unsigned)(OFF_PLF + ((r0 + s) * 512 + h * 128 + d4) * 4), *(const f32x4*)(F + s * 128 + d4));
    }
    if (tid < 128) stg<float>(ws, (unsigned)(OFF_DEC + ((b * 64 + c) * 512 + h * 128 + tid) * 4), __expf(F[63 * 128 + tid]));
    {
        const int d = tid & 127;
        const float btot = F[63 * 128 + d];
#pragma unroll
        for (int i = 0; i < 4; ++i) {
            const int s8 = (tid >> 7) + 2 * i;
            bf16x8 ok, ov;
#pragma unroll
            for (int e = 0; e < 8; ++e) {
                const int s = s8 * 8 + e;
                ok[e] = (short)f2bf(bf2f(Kb[s * 128 + d]) * __expf(btot - F[s * 128 + d]));
                ov[e] = (short)Vb[s * 128 + d];
            }
            stg<bf16x8>(ws, (unsigned)(OFF_KTT + ((cu * 128 + d) * 64 + s8 * 8) * 2), ok);
            stg<bf16x8>(ws, (unsigned)(OFF_VT + ((cu * 128 + d) * 64 + s8 * 8) * 2), ov);
        }
    }
}

__device__ void s5_gemm_a(CParams& p, int u, char* lds) {
    LANE_IDS;
    const int wr = wid >> 1, wc = wid & 1;
    const int g = u >> 3, tm = u & 7, row0 = tm * 128;
    unsigned char* ws = p.ws;
    const unsigned aoff = (unsigned)(OFF_PU + (size_t)g * NTOK * 16 * 2), boff = (unsigned)(OFF_BTA + (size_t)g * 128 * 256 * 2);
    f32x4 acc[4][4]; ZERO_ACC(acc, 4, 4);
    mma_glds<128, 128, 2, 2, true>(acc, 4, ws,
        [&](int r, int t) { return aoff + ((row0 + r) * 256 + t * 64) * 2; },
        [&](int c, int t) { return boff + (c * 256 + t * 64) * 2; }, NoHook(), lds);
    epiT<4, 4, 64, 64>(acc, wr, wc, fq, fr, [&](int r, int cc, const f32x4& v) {
        stg<f32x4>(ws, (unsigned)(OFF_VC + (((row0 + r) * 32 + g) * 128 + cc) * 4), v); });
}

__device__ void rg_conv(CParams& p, int l, int u) {
    const int tid = otid();
    const u16* xr = (const u16*)(p.ws + OFF_PXR);
    u16* xc = (u16*)(p.ws + OFF_XC);
    const float* cw = p.in[15] + (size_t)l * 4 * 512;
    const float* cb = p.in[16] + (size_t)l * 512;
    for (int i = tid; i < 64 * 64; i += 256) {
        const int row = u * 64 + (i >> 6), c8 = (i & 63) * 8;
        const int t = row & (SEQ - 1);
        float a[8];
#pragma unroll
        for (int e = 0; e < 8; ++e) a[e] = cb[c8 + e];
#pragma unroll
        for (int j = 0; j < 4; ++j) {
            if (t - 3 + j >= 0) {
                bf16x8 x = *(const bf16x8*)(xr + (size_t)(row - 3 + j) * 512 + c8);
#pragma unroll
                for (int e = 0; e < 8; ++e) a[e] += cw[j * 512 + c8 + e] * bf2f((u16)x[e]);
            }
        }
        bf16x8 o;
#pragma unroll
        for (int e = 0; e < 8; ++e) o[e] = (short)f2bf(a[e]);
        *(bf16x8*)(xc + (size_t)row * 512 + c8) = o;
    }
}

__device__ void phase2(CParams& p, int l, char* lds) {
    for (int u = VB; u < 1536; u += VG) {
        if (u < 1024) hgrn_prep(p, u, lds);
        else if (u < 1280) s5_gemm_a(p, u - 1024, lds);
        else rg_conv(p, l, u - 1280);
    }
}

__device__ void hgrn_u(CParams& p, int u, char* lds) {
    LANE_IDS;
    const int wr = wid >> 1, wc = wid & 1;
    unsigned char* ws = p.ws;
    f32x4 acc[4][4]; ZERO_ACC(acc, 4, 4);
    mma_glds<128, 128, 2, 2>(acc, 1, ws,
        [&](int r, int t) { return (unsigned)(OFF_KTT + ((u * 128 + r) * 64) * 2); },
        [&](int c, int t) { return (unsigned)(OFF_VT + ((u * 128 + c) * 64) * 2); }, NoHook(), lds);
#pragma unroll
    for (int m = 0; m < 4; ++m) {
#pragma unroll
        for (int n = 0; n < 4; ++n) {
            const int d0 = wr * 64 + m * 16 + fq * 4, v = wc * 64 + n * 16 + fr;
            uint2 o;
            o.x = f2bf(acc[m][n][0]) | ((unsigned)f2bf(acc[m][n][1]) << 16);
            o.y = f2bf(acc[m][n][2]) | ((unsigned)f2bf(acc[m][n][3]) << 16);
            stg<uint2>(ws, (unsigned)(OFF_UT + ((u * 128 + v) * 128 + d0) * 2), o);
        }
        __builtin_amdgcn_sched_barrier(0);
    }
}

__device__ void hgrn_sscan(CParams& p, int item) {
    const int bh = item >> 12, ec = item & 4095, v = ec >> 5, d4 = (ec & 31) * 4;
    const int b = bh >> 2, h = bh & 3;
    unsigned char* ws = p.ws;
    const unsigned ub = (unsigned)(OFF_UT + ((bh * 64 * 128 + v) * 128 + d4) * 2);
    const unsigned sb = (unsigned)(OFF_ST + ((bh * 64 * 128 + v) * 128 + d4) * 2);
    const unsigned db = (unsigned)(OFF_DEC + ((b * 64) * 512 + h * 128 + d4) * 4);
    f32x4 S = {0.f, 0.f, 0.f, 0.f};
    for (int c0 = 0; c0 < 64; c0 += 8) {
        uint2 uu[8]; f32x4 dd[8];
#pragma unroll
        for (int i = 0; i < 8; ++i) { uu[i] = ldg<uint2>(ws, ub + (unsigned)((c0 + i) * 128 * 128 * 2)); dd[i] = ldg<f32x4>(ws, db + (unsigned)((c0 + i) * 512 * 4)); }
#pragma unroll
        for (int i = 0; i < 8; ++i) {
            uint2 o;
            o.x = f2bf(S[0]) | ((unsigned)f2bf(S[1]) << 16); o.y = f2bf(S[2]) | ((unsigned)f2bf(S[3]) << 16);
            stg<uint2>(ws, sb + (unsigned)((c0 + i) * 128 * 128 * 2), o);
            S[0] = dd[i][0] * S[0] + bf2f((u16)(uu[i].x & 0xffff)); S[1] = dd[i][1] * S[1] + bf2f((u16)(uu[i].x >> 16));
            S[2] = dd[i][2] * S[2] + bf2f((u16)(uu[i].y & 0xffff)); S[3] = dd[i][3] * S[3] + bf2f((u16)(uu[i].y >> 16));
        }
    }
}

__device__ void s5_scan(CParams& p, int l, int u, char* lds) {
    const int tid = otid();
    const int b = u >> 5, g = u & 31, seg = tid >> 6, pp = tid & 63;
    const int lg = l * 32 + g;
    const float dt = expf(p.in[12][lg]);
    const float ar = p.in[5][lg * 64 + pp], ai = p.in[6][lg * 64 + pp];
    const float mag = expf(16.f * ar * dt), ang = 16.f * ai * dt;
    const float er = mag * cosf(ang), ei = mag * sinf(ang);
    const float mg2 = expf(1024.f * ar * dt), an2 = 1024.f * ai * dt;
    const float sr = mg2 * cosf(an2), si = mg2 * sinf(an2);
    unsigned char* ws = p.ws;
    const unsigned vb = (unsigned)(OFF_VC + (((b * 256 + seg * 64) * 32 + g) * 128 + pp) * 4);
    const unsigned hb = (unsigned)(OFF_HC + (((b * 256 + seg * 64) * 32 + g) * 128 + pp) * 2);
    float* ex = (float*)lds;
    __syncthreads();
    float hr = 0.f, hi = 0.f;
    for (int c0 = 0; c0 < 64; c0 += 16) {
        float vr[16], vi[16];
#pragma unroll
        for (int i = 0; i < 16; ++i) { vr[i] = ldg<float>(ws, vb + (unsigned)((c0 + i) * 4096 * 4)); vi[i] = ldg<float>(ws, vb + (unsigned)((c0 + i) * 4096 * 4 + 256)); }
#pragma unroll
        for (int i = 0; i < 16; ++i) { const float nr = er * hr - ei * hi + vr[i], ni = er * hi + ei * hr + vi[i]; hr = nr; hi = ni; }
    }
    ex[(seg * 64 + pp) * 2] = hr; ex[(seg * 64 + pp) * 2 + 1] = hi;
    __syncthreads();
    hr = 0.f; hi = 0.f;
    for (int sg = 0; sg < seg; ++sg) {
        const float lr = ex[(sg * 64 + pp) * 2], li = ex[(sg * 64 + pp) * 2 + 1];
        const float nr = sr * hr - si * hi + lr, ni = sr * hi + si * hr + li; hr = nr; hi = ni;
    }
    for (int c0 = 0; c0 < 64; c0 += 16) {
        float vr[16], vi[16];
#pragma unroll
        for (int i = 0; i < 16; ++i) { vr[i] = ldg<float>(ws, vb + (unsigned)((c0 + i) * 4096 * 4)); vi[i] = ldg<float>(ws, vb + (unsigned)((c0 + i) * 4096 * 4 + 256)); }
#pragma unroll
        for (int i = 0; i < 16; ++i) {
            stg<u16>(ws, hb + (unsigned)((c0 + i) * 4096 * 2), f2bf(hr));
            stg<u16>(ws, hb + (unsigned)((c0 + i) * 4096 * 2 + 128), f2bf(hi));
            const float nr = er * hr - ei * hi + vr[i], ni = er * hi + ei * hr + vi[i]; hr = nr; hi = ni;
        }
    }
}

__device__ void rg_gemm(CParams& p, int l, int u, char* lds) {
    LANE_IDS;
    const int wr = wid >> 1, wc = wid & 1;
    const int tm = u >> 3, h = (u >> 1) & 3, nt = u & 1, row0 = tm * 128;
    unsigned char* ws = p.ws;
    const unsigned aoff = (unsigned)(OFF_XC + h * 128 * 2), boff = (unsigned)(OFF_RGT + ((size_t)h * 256 * 128 + (size_t)nt * 128 * 128) * 2);
    f32x4 acc[4][4]; ZERO_ACC(acc, 4, 4);
    mma_glds<128, 128, 2, 2, true>(acc, 2, ws,
        [&](int r, int t) { return aoff + ((row0 + r) * 512 + t * 64) * 2; },
        [&](int c, int t) { return boff + (c * 128 + t * 64) * 2; }, NoHook(), lds);
    const float* ba = p.in[18] + (size_t)l * 512;
    const float* bx = p.in[20] + (size_t)l * 512;
    const float* lam = p.in[21] + (size_t)l * 512;
#pragma unroll
    for (int n = 0; n < 2; ++n) {
        const int ch = h * 128 + (nt * 2 + wc) * 32 + n * 16 + fq * 4;
        const f32x4 lm = *(const f32x4*)(lam + ch), bav = *(const f32x4*)(ba + ch), bxv = *(const f32x4*)(bx + ch);
        f32x4 c1;
#pragma unroll
        for (int i = 0; i < 4; ++i) c1[i] = -8.f * log1pf(expf(-lm[i]));
#pragma unroll
        for (int m = 0; m < 4; ++m) {
            const int row = row0 + wr * 64 + m * 16 + fr;
            const f32x4 x = unpack4(ldg<uint2>(ws, (unsigned)(OFF_XC + (row * 512 + ch) * 2)));
            f32x4 la, bb;
#pragma unroll
            for (int i = 0; i < 4; ++i) {
                const float r = sigm(acc[m][n][i] + bav[i]), ig = sigm(acc[m][n + 2][i] + bxv[i]);
                la[i] = c1[i] * r;
                bb[i] = sqrtf(fmaxf(1.f - __expf(2.f * la[i]), 0.f)) * ig * x[i];
            }
            stg<uint2>(ws, (unsigned)(OFF_LA + (row * 512 + ch) * 2), pack4(la));
            stg<uint2>(ws, (unsigned)(OFF_BB + (row * 512 + ch) * 2), pack4(bb));
        }
    }
}

__device__ void phase3(CParams& p, int l, char* lds) {
    for (int u = VB; u < 2176; u += VG) {
        if (u < 128) s5_scan(p, l, u, lds);
        else if (u < 1152) hgrn_u(p, u - 128, lds);
        else rg_gemm(p, l, u - 1152, lds);
    }
}

__device__ void hgrn_out(CParams& p, int l, int u, char* lds) {
    LANE_IDS;
    const int h = u & 3, c = (u >> 2) & 63, b = u >> 8;
    const int r0 = b * SEQ + c * 64;
    const unsigned cu = (unsigned)((b * 4 + h) * 64 + c);
    unsigned char* ws = p.ws;
    char* F = lds;
    char* Qb = lds + 32768;
    char* Kb = lds + 49152;
    char* Ss = lds + 65536;
    __syncthreads();
#pragma unroll
    for (int i = 0; i < 8; ++i) {
        const int id = tid + i * 256, s = id >> 5, ch = id & 31;
        *(f32x4*)(F + s * 512 + ((ch ^ (s & 31)) << 4)) = ldg<f32x4>(ws, (unsigned)(OFF_PLF + ((r0 + s) * 512 + h * 128 + ch * 4) * 4));
    }
#pragma unroll
    for (int i = 0; i < 4; ++i) {
        const int id = tid + i * 256, s = id >> 4, ch = id & 15;
        *(uint4*)(Qb + s * 256 + ((ch ^ (s & 15)) << 4)) = ldg<uint4>(ws, (unsigned)(OFF_PQ + ((r0 + s) * 512 + h * 128 + ch * 8) * 2));
        *(uint4*)(Kb + s * 256 + ((ch ^ (s & 15)) << 4)) = ldg<uint4>(ws, (unsigned)(OFF_PK + ((r0 + s) * 512 + h * 128 + ch * 8) * 2));
    }
    __syncthreads();
    auto ldF8 = [&](int row, int d0, float (&o)[8]) {
        const int c0 = d0 >> 2;
        const f32x4 x = *(const f32x4*)(F + row * 512 + ((c0 ^ (row & 31)) << 4)), y = *(const f32x4*)(F + row * 512 + (((c0 + 1) ^ (row & 31)) << 4));
        o[0] = x[0]; o[1] = x[1]; o[2] = x[2]; o[3] = x[3]; o[4] = y[0]; o[5] = y[1]; o[6] = y[2]; o[7] = y[3];
    };
    auto ldH8 = [&](const char* base, int row, int d0) { return *(const bf16x8*)(base + row * 256 + (((d0 >> 3) ^ (row & 15)) << 4)); };
    {
        const int i = wid;
        const int t = 16 * i + fr;
        bf16x8 aq[4];
        float refv[4][8];
#pragma unroll
        for (int kk = 0; kk < 4; ++kk) {
            const int d0 = kk * 32 + fq * 8;
            float bt[8];
            ldF8(t, d0, bt);
            if (i == 0) {
#pragma unroll
                for (int e = 0; e < 8; ++e) refv[kk][e] = 0.f;
            } else ldF8(16 * i - 1, d0, refv[kk]);
            const bf16x8 q8 = ldH8(Qb, t, d0);
#pragma unroll
            for (int e = 0; e < 8; ++e) aq[kk][e] = (short)f2bf(bf2f((u16)q8[e]) * __expf(bt[e] - refv[kk][e]));
        }
#pragma unroll
        for (int j = 0; j < 4; ++j) {
            f32x4 sc = {0.f, 0.f, 0.f, 0.f};
            if (j <= i) {
                const int s = 16 * j + fr;
#pragma unroll
                for (int kk = 0; kk < 4; ++kk) {
                    const int d0 = kk * 32 + fq * 8;
                    float bs[8];
                    ldF8(s, d0, bs);
                    const bf16x8 k8 = ldH8(Kb, s, d0);
                    bf16x8 bk;
#pragma unroll
                    for (int e = 0; e < 8; ++e) bk[e] = (short)f2bf(bf2f((u16)k8[e]) * __expf(fminf(refv[kk][e] - bs[e], 60.f)));
                    sc = __builtin_amdgcn_mfma_f32_16x16x32_bf16(aq[kk], bk, sc, 0, 0, 0);
                }
            }
#pragma unroll
            for (int r = 0; r < 4; ++r) {
                const int tl = fq * 4 + r, sl = fr;
                float v = sc[r];
                if (j > i || (j == i && sl > tl)) v = 0.f;
                const int row = 16 * i + tl, col = 16 * j + sl;
                *(u16*)(Ss + row * 128 + (((col >> 3) ^ (row & 7)) << 4) + (col & 7) * 2) = f2bf(v);
            }
        }
    }
    __syncthreads();
    f32x4 acc[8];
#pragma unroll
    for (int n = 0; n < 8; ++n) acc[n] = f32x4{0.f, 0.f, 0.f, 0.f};
    auto bsrc = [&](int t, int id) -> unsigned {
        const int vrow = id >> 3, ch = id & 7;
        return (t < 2) ? (unsigned)(OFF_ST + ((cu * 128 + vrow) * 128 + t * 64 + ch * 8) * 2) : (unsigned)(OFF_VT + ((cu * 128 + vrow) * 64 + ch * 8) * 2);
    };
    uint4 rb[4];
#pragma unroll
    for (int i = 0; i < 4; ++i) rb[i] = ldg<uint4>(ws, bsrc(0, tid + i * 256));
    const int arow = wid * 16 + fr;
#pragma unroll 1
    for (int t = 0; t < 3; ++t) {
#pragma unroll
        for (int i = 0; i < 4; ++i) { const int id = tid + i * 256, vrow = id >> 3, ch = id & 7; *(uint4*)(Kb + vrow * 128 + ((ch ^ ((vrow >> 1) & 7)) << 4)) = rb[i]; }
        __syncthreads();
        if (t < 2) {
#pragma unroll
            for (int i = 0; i < 4; ++i) rb[i] = ldg<uint4>(ws, bsrc(t + 1, tid + i * 256));
        }
#pragma unroll
        for (int ks = 0; ks < 2; ++ks) {
            bf16x8 af;
            if (t < 2) {
                const int d0 = t * 64 + ks * 32 + fq * 8;
                float bq[8];
                ldF8(arow, d0, bq);
                const bf16x8 q8 = ldH8(Qb, arow, d0);
#pragma unroll
                for (int e = 0; e < 8; ++e) af[e] = (short)f2bf(bf2f((u16)q8[e]) * __expf(bq[e]));
            } else {
                af = *(const bf16x8*)(Ss + arow * 128 + (((ks * 4 + fq) ^ (arow & 7)) << 4));
            }
#pragma unroll
            for (int n = 0; n < 8; ++n) {
                const int brow = n * 16 + fr;
                const bf16x8 bfr = *(const bf16x8*)(Kb + brow * 128 + (((ks * 4 + fq) ^ ((brow >> 1) & 7)) << 4));
                acc[n] = __builtin_amdgcn_mfma_f32_16x16x32_bf16(bfr, af, acc[n], 0, 0, 0);
            }
        }
        __syncthreads();
    }
    const float* nw = p.in[4] + (size_t)l * 512 + h * 128;
    {
        float ss = 0.f;
#pragma unroll
        for (int n = 0; n < 8; ++n)
#pragma unroll
            for (int j = 0; j < 4; ++j) ss += acc[n][j] * acc[n][j];
        ss += shfl_xor_l(ss, 16, lane); ss += shfl_xor_l(ss, 32, lane);
        const float rs = rsqrtf(ss * (1.f / 128.f) + 1e-6f);
        const int row = r0 + wid * 16 + fr;
#pragma unroll
        for (int n = 0; n < 8; ++n) {
            const int v = n * 16 + fq * 4;
            const f32x4 w4 = *(const f32x4*)(nw + v);
            const f32x4 g4 = unpack4(ldg<uint2>(ws, (unsigned)(OFF_PG + (row * 512 + h * 128 + v) * 2)));
            f32x4 o;
#pragma unroll
            for (int j = 0; j < 4; ++j) o[j] = acc[n][j] * rs * w4[j] * g4[j];
            stg<uint2>(ws, (unsigned)(OFF_YA + (row * 512 + h * 128 + v) * 2), pack4(o));
        }
    }
}

__device__ void s5_gemm_c(CParams& p, int l, int u, char* lds) {
    LANE_IDS;
    const int wr = wid >> 1, wc = wid & 1;
    const int g = u >> 4, tm = (u >> 1) & 7, tn = u & 1, row0 = tm * 128, col0 = tn * 128;
    unsigned char* ws = p.ws;
    const unsigned aoff = (unsigned)(OFF_PU + (size_t)g * NTOK * 16 * 2), boff = (unsigned)(OFF_BTC + (size_t)g * 256 * 384 * 2);
    f32x4 acc[4][4]; ZERO_ACC(acc, 4, 4);
    mma_glds<128, 128, 2, 2, true>(acc, 6, ws,
        [&](int r, int t) {
            return (t < 4) ? aoff + ((row0 + r) * 256 + t * 64) * 2 : (unsigned)(OFF_HC + (((row0 + r) * 32 + g) * 128 + (t - 4) * 64) * 2);
        },
        [&](int c, int t) { return boff + ((col0 + c) * 384 + t * 64) * 2; }, NoHook(), lds);
    const f32x4 dch = *(const f32x4*)(p.in[11] + (size_t)l * 512 + g * 16 + fq * 4);
    epiT<4, 4, 64, 64>(acc, wr, wc, fq, fr, [&](int r, int cc, const f32x4& v) {
        const int row = row0 + r, col = col0 + cc;
        const int jj = col >> 4, ch = col & 15;
        const int tok = (row >> 8) * SEQ + (row & 255) * 16 + jj;
        const f32x4 uu = unpack4(ldg<uint2>(ws, aoff + (tok * 16 + ch) * 2));
        f32x4 y;
#pragma unroll
        for (int i = 0; i < 4; ++i) y[i] = gelu_f(v[i] + dch[i] * uu[i]);
        stg<uint2>(ws, (unsigned)(OFF_YG + (tok * 512 + g * 16 + ch) * 2), pack4(y)); });
}

__device__ __forceinline__ void bf4(const uint2 q, float (&o)[4]) {
    o[0] = bf2f((u16)(q.x & 0xffff)); o[1] = bf2f((u16)(q.x >> 16)); o[2] = bf2f((u16)(q.y & 0xffff)); o[3] = bf2f((u16)(q.y >> 16));
}
__device__ void rg_local(CParams& p, int item) {
    const int b = item >> 13, seg = (item >> 7) & 63, c4 = (item & 127) * 4;
    unsigned char* ws = p.ws;
    const unsigned base = (unsigned)(((b * SEQ + seg * 64) * 512 + c4) * 2);
    float hh[4] = {0.f, 0.f, 0.f, 0.f}, ap[4] = {1.f, 1.f, 1.f, 1.f};
    for (int s0 = 0; s0 < 64; s0 += 8) {
        uint2 a[8], bb[8];
#pragma unroll
        for (int i = 0; i < 8; ++i) { a[i] = ldg<uint2>(ws, (unsigned)OFF_LA + base + (unsigned)((s0 + i) * 1024)); bb[i] = ldg<uint2>(ws, (unsigned)OFF_BB + base + (unsigned)((s0 + i) * 1024)); }
#pragma unroll
        for (int i = 0; i < 8; ++i) {
            float av[4], bv[4]; bf4(a[i], av); bf4(bb[i], bv);
#pragma unroll
            for (int c = 0; c < 4; ++c) { const float e = __expf(av[c]); hh[c] = e * hh[c] + bv[c]; ap[c] *= e; }
        }
    }
    stg<f32x4>(ws, (unsigned)(OFF_SEGA + ((b * 64 + seg) * 512 + c4) * 4), f32x4{ap[0], ap[1], ap[2], ap[3]});
    stg<f32x4>(ws, (unsigned)(OFF_SEGH + ((b * 64 + seg) * 512 + c4) * 4), f32x4{hh[0], hh[1], hh[2], hh[3]});
}

__device__ void rg_final(CParams& p, int item) {
    const int b = item >> 13, seg = (item >> 7) & 63, c4 = (item & 127) * 4;
    unsigned char* ws = p.ws;
    const unsigned base = (unsigned)(((b * SEQ + seg * 64) * 512 + c4) * 2);
    f32x4 hh = {0.f, 0.f, 0.f, 0.f};
    for (int sg0 = 0; sg0 < seg; sg0 += 8) {
        f32x4 sa[8], sh[8];
#pragma unroll
        for (int i = 0; i < 8; ++i) {
            const int sg = min(sg0 + i, 63);
            sa[i] = ldg<f32x4>(ws, (unsigned)(OFF_SEGA + ((b * 64 + sg) * 512 + c4) * 4));
            sh[i] = ldg<f32x4>(ws, (unsigned)(OFF_SEGH + ((b * 64 + sg) * 512 + c4) * 4));
        }
#pragma unroll
        for (int i = 0; i < 8; ++i) if (sg0 + i < seg) hh = sa[i] * hh + sh[i];
    }
    for (int s0 = 0; s0 < 64; s0 += 8) {
        uint2 a[8], bb[8], xg[8];
#pragma unroll
        for (int i = 0; i < 8; ++i) {
            a[i] = ldg<uint2>(ws, (unsigned)OFF_LA + base + (unsigned)((s0 + i) * 1024));
            bb[i] = ldg<uint2>(ws, (unsigned)OFF_BB + base + (unsigned)((s0 + i) * 1024));
            xg[i] = ldg<uint2>(ws, (unsigned)OFF_PXG + base + (unsigned)((s0 + i) * 1024));
        }
#pragma unroll
        for (int i = 0; i < 8; ++i) {
            float av[4], bv[4], xv[4]; bf4(a[i], av); bf4(bb[i], bv); bf4(xg[i], xv);
#pragma unroll
            for (int c = 0; c < 4; ++c) hh[c] = __expf(av[c]) * hh[c] + bv[c];
            uint2 o; o.x = f2bf(hh[0] * xv[0]) | ((unsigned)f2bf(hh[1] * xv[1]) << 16); o.y = f2bf(hh[2] * xv[2]) | ((unsigned)f2bf(hh[3] * xv[3]) << 16);
            stg<uint2>(ws, (unsigned)OFF_YC + base + (unsigned)((s0 + i) * 1024), o);
        }
    }
}

__device__ void phase4(CParams& p, int l, char* lds) {
    {
        const int tid = otid();
        if (tid < 128) hgrn_sscan(p, VB * 128 + tid);
        else if (tid < 192) rg_local(p, VB * 64 + (tid - 128));
    }
    for (int u = VB; u < 512; u += VG) s5_gemm_c(p, l, u, lds);
}

__device__ void phase_glu(CParams& p, int l, char* lds) {
    LANE_IDS;
    const int wr = wid >> 1, wc = wid & 1;
    unsigned char* ws = p.ws;
    const float* gb = p.in[14] + (size_t)l * 512;
    if (tid < 64) rg_final(p, VB * 64 + tid);
    for (int uu = VB; uu < 1536; uu += VG) {
        if (uu < 1024) { hgrn_out(p, l, uu, lds); continue; }
        const int u = uu - 1024;
        const int row0 = (u >> 2) * 128, col0 = (u & 3) * 128;
        f32x4 acc[4][4]; ZERO_ACC(acc, 4, 4);
        mma_glds<128, 128, 2, 2, true>(acc, 8, ws,
            [&](int r, int t) { return (unsigned)(OFF_YG + ((row0 + r) * 512 + t * 64) * 2); },
            [&](int c, int t) { return (unsigned)(OFF_GLUT + ((col0 + c) * 512 + t * 64) * 2); }, NoHook(), lds);
        epiT<4, 4, 64, 64>(acc, wr, wc, fq, fr, [&](int r, int cc, const f32x4& v) {
            const int row = row0 + r, col = col0 + cc;
            const f32x4 y = unpack4(ldg<uint2>(ws, (unsigned)(OFF_YG + (row * 512 + col) * 2)));
            const f32x4 bb = *(const f32x4*)(gb + col);
            f32x4 o;
#pragma unroll
            for (int i = 0; i < 4; ++i) o[i] = y[i] * sigm(v[i] + bb[i]);
            stg<uint2>(ws, (unsigned)(OFF_YB + (row * 512 + col) * 2), pack4(o)); });
    }
}

__device__ void phase_branch(CParams& p, int l, char* lds) {
    BrSched S; S.c = blockIdx.x;
    BrEpi E; E.ws = p.ws;
    g8::gemm_phase<BrEpi, BrSched, false>((LAS unsigned char*)lds, p.ws, 512, S, E);
}

__device__ void phase_out(CParams& p, int l, char* lds, char* hlds) {
    {
        OutSched S; S.A = (unsigned)OFF_MIXP; S.B = (unsigned)OFF_WOUTT; S.c = blockIdx.x; S.G = gridDim.x;
        OutEpi E; E.ws = p.ws;
        g8::gemm_phase<OutEpi, OutSched, false>((LAS unsigned char*)lds, p.ws, 1024, S, E);
    }
    for (int u = VB; u < 12288; u += VG) {
        const int e = u / 192, r = u % 192;
        if (r < 128)
            conv_tile(p.in[28] + (size_t)(l * 64 + e) * 1024 * 256, p.in[29] + (size_t)(l * 64 + e) * 1024 * 256, 256, 1024, 16,
                      (u16*)(p.ws + OFF_EW13) + (size_t)e * 512 * 1024, r, (float*)hlds);
        else
            conv_tile(p.in[30] + (size_t)(l * 64 + e) * 256 * 1024, nullptr, 1024, 256, 0,
                      (u16*)(p.ws + OFF_EW2) + (size_t)e * 1024 * 256, r - 128, (float*)hlds);
    }
}

__device__ __forceinline__ void ln_row(float (&v)[16], const float* g, const float* bta, int lane) {
    float s = 0.f;
#pragma unroll
    for (int i = 0; i < 16; ++i) s += v[i];
    const float mu = wave_sum(s, lane) * (1.f / 1024.f);
    float q = 0.f;
#pragma unroll
    for (int i = 0; i < 16; ++i) { float d = v[i] - mu; q += d * d; }
    const float rs = rsqrtf(wave_sum(q, lane) * (1.f / 1024.f) + 1e-5f);
#pragma unroll
    for (int i = 0; i < 4; ++i) {
        const float4 gg = *(const float4*)(g + i * 256 + lane * 4), bb = *(const float4*)(bta + i * 256 + lane * 4);
        v[i * 4 + 0] = (v[i * 4 + 0] - mu) * rs * gg.x + bb.x;
        v[i * 4 + 1] = (v[i * 4 + 1] - mu) * rs * gg.y + bb.y;
        v[i * 4 + 2] = (v[i * 4 + 2] - mu) * rs * gg.z + bb.z;
        v[i * 4 + 3] = (v[i * 4 + 3] - mu) * rs * gg.w + bb.w;
    }
}

__device__ void phase_route(CParams& p, int l, char* lds) {
    LANE_IDS;
    const float* Pre = (const float*)(p.ws + OFF_PRELN);
    u16* Xm = (u16*)(p.ws + OFF_XM);
    const float* g1 = p.in[24] + (size_t)l * 1024;
    const float* b1 = p.in[25] + (size_t)l * 1024;
    const float* rbias = p.in[27] + (size_t)l * 64;
    int* cursor = (int*)(p.ws + OFF_CUR);
    int* list = (int*)(p.ws + OFF_LIST);
    float* wlist = (float*)(p.ws + OFF_WLIST);
    float* Ls = (float*)(lds + 32768);
    int* hist = (int*)(lds + 32768 + 64 * 65 * 4);
    int* basep = hist + 64;
    for (int u = VB; u < 512; u += VG) {
        const int row0 = u * 32;
#pragma unroll 1
        for (int hb = 0; hb < 2; ++hb) {
            float v[4][16];
#pragma unroll
            for (int rr = 0; rr < 4; ++rr) {
                const int row = row0 + wid * 8 + hb * 4 + rr;
#pragma unroll
                for (int i = 0; i < 4; ++i) {
                    const float4 x = *(const float4*)(Pre + (size_t)row * 1024 + i * 256 + lane * 4);
                    v[rr][i * 4] = x.x; v[rr][i * 4 + 1] = x.y; v[rr][i * 4 + 2] = x.z; v[rr][i * 4 + 3] = x.w;
                }
            }
#pragma unroll
            for (int rr = 0; rr < 4; ++rr) {
                const int row = row0 + wid * 8 + hb * 4 + rr;
                ln_row(v[rr], g1, b1, lane);
#pragma unroll
                for (int i = 0; i < 4; ++i) {
                    uint2 o; o.x = f2bf(v[rr][i * 4]) | ((unsigned)f2bf(v[rr][i * 4 + 1]) << 16); o.y = f2bf(v[rr][i * 4 + 2]) | ((unsigned)f2bf(v[rr][i * 4 + 3]) << 16);
                    *(uint2*)(Xm + (size_t)row * 1024 + i * 256 + lane * 4) = o;
                }
            }
        }
        if (tid < 64) hist[tid] = 0;
        __syncthreads();
        f32x4 acc[1][2]; ZERO_ACC(acc, 1, 2);
        mma_glds<32, 64, 2, 2>(acc, 16, p.ws,
            [&](int r, int t) { return (unsigned)(OFF_XM + ((row0 + r) * 1024 + t * 64) * 2); },
            [&](int c, int t) { return (unsigned)(OFF_ROUTT + (c * 1024 + t * 64) * 2); }, NoHook(), lds);
#pragma unroll
        for (int n = 0; n < 2; ++n)
#pragma unroll
            for (int j = 0; j < 4; ++j) {
                const int r = (wid >> 1) * 16 + fq * 4 + j, e = (wid & 1) * 32 + n * 16 + fr;
                Ls[r * 65 + e] = sigm(acc[0][n][j]) + rbias[e];
            }
        __syncthreads();
        int myrank[8]; int myexp[8]; float wv[8];
        if (tid < 32) {
            float* sc = Ls + tid * 65;
            float gs[8];
#pragma unroll
            for (int g = 0; g < 8; ++g) {
                float m1 = -1e30f, m2 = -1e30f;
#pragma unroll
                for (int i = 0; i < 8; ++i) { float x = sc[g * 8 + i]; if (x > m1) { m2 = m1; m1 = x; } else if (x > m2) m2 = x; }
                gs[g] = m1 + m2;
            }
            unsigned gmask = 0;
#pragma unroll
            for (int it = 0; it < 4; ++it) {
                float best = -1e30f; int bi = 0;
#pragma unroll
                for (int g = 0; g < 8; ++g) { bool ok = !((gmask >> g) & 1u) && gs[g] > best; if (ok) { best = gs[g]; bi = g; } }
                gmask |= 1u << bi;
            }
            unsigned long long chosen = 0ull;
            float wsum = 0.f;
#pragma unroll
            for (int k = 0; k < 8; ++k) {
                float best = -1e30f; int bi = 0;
                for (int e = 0; e < 64; ++e) {
                    float x = sc[e];
                    bool ok = ((gmask >> (e >> 3)) & 1u) && !((chosen >> e) & 1ull) && x > best;
                    if (ok) { best = x; bi = e; }
                }
                chosen |= 1ull << bi;
                myexp[k] = bi;
                wv[k] = best - rbias[bi];
                wsum += wv[k];
            }
            const float sc_ = 2.5f / wsum;
#pragma unroll
            for (int k = 0; k < 8; ++k) {
                wv[k] *= sc_;
                myrank[k] = atomicAdd(&hist[myexp[k]], 1);
            }
        }
        __syncthreads();
        if (tid < 64) basep[tid] = atomicAdd(&cursor[tid], hist[tid]);
        __syncthreads();
        if (tid < 32) {
#pragma unroll
            for (int k = 0; k < 8; ++k) {
                const size_t pos = (size_t)myexp[k] * NTOK + basep[myexp[k]] + myrank[k];
                list[pos] = (row0 + tid) * 8 + k;
                wlist[pos] = wv[k];
            }
        }
        __syncthreads();
    }
}

__device__ void phase_combine(CParams& p, int l) {
    LANE_IDS;
    typedef float f32x2 __attribute__((ext_vector_type(2)));
    unsigned char* ws = p.ws;
    const float* g2 = p.in[34] + (size_t)l * 1024 + lane * 16;
    const float* b2 = p.in[35] + (size_t)l * 1024 + lane * 16;
    for (int row = VB * 4 + wid; row < NTOK; row += VG * 4) {
        f32x4 y[4]; uint4 xm[2]; u32x4 yb[8];
#pragma unroll
        for (int i = 0; i < 2; ++i) { const uint4 q = ldg<uint4>(ws, (unsigned)(OFF_YSH + (row * 1024 + lane * 16 + i * 8) * 2)); y[i * 2] = unpack4(uint2{q.x, q.y}); y[i * 2 + 1] = unpack4(uint2{q.z, q.w}); }
#pragma unroll
        for (int i = 0; i < 2; ++i) xm[i] = ldg<uint4>(ws, (unsigned)(OFF_XM + (row * 1024 + lane * 16 + i * 8) * 2));
#pragma unroll
        for (int k = 0; k < 8; ++k) yb[k] = ldg<u32x4>(ws, (unsigned)OFF_YBUF + (unsigned)((row * 8 + k) * 1024 + lane * 16));
        float v[16], s[16];
#pragma unroll
        for (int i = 0; i < 16; ++i) s[i] = 0.f;
#pragma unroll
        for (int k = 0; k < 8; ++k)
#pragma unroll
            for (int w = 0; w < 4; ++w) {
                const f32x2 lo = __builtin_amdgcn_cvt_pk_f32_fp8((int)yb[k][w], false), hi = __builtin_amdgcn_cvt_pk_f32_fp8((int)yb[k][w], true);
                s[w * 4 + 0] += lo.x; s[w * 4 + 1] += lo.y; s[w * 4 + 2] += hi.x; s[w * 4 + 3] += hi.y;
            }
#pragma unroll
        for (int i = 0; i < 2; ++i) {
            const uint4 x = xm[i];
            const float xf[8] = {bf2f((u16)(x.x & 0xffff)), bf2f((u16)(x.x >> 16)), bf2f((u16)(x.y & 0xffff)), bf2f((u16)(x.y >> 16)),
                                 bf2f((u16)(x.z & 0xffff)), bf2f((u16)(x.z >> 16)), bf2f((u16)(x.w & 0xffff)), bf2f((u16)(x.w >> 16))};
#pragma unroll
            for (int j = 0; j < 8; ++j) v[i * 8 + j] = y[i * 2 + (j >> 2)][j & 3] + DN_ALPHA * xf[j] + s[i * 8 + j] * (1.f / 32.f);
        }
        float sum = 0.f;
#pragma unroll
        for (int i = 0; i < 16; ++i) sum += v[i];
        const float mu = wave_sum(sum, lane) * (1.f / 1024.f);
        float q = 0.f;
#pragma unroll
        for (int i = 0; i < 16; ++i) { const float d = v[i] - mu; q += d * d; }
        const float rs = rsqrtf(wave_sum(q, lane) * (1.f / 1024.f) + 1e-5f);
#pragma unroll
        for (int i = 0; i < 4; ++i) {
            const f32x4 gg = *(const f32x4*)(g2 + i * 4), bb = *(const f32x4*)(b2 + i * 4);
#pragma unroll
            for (int j = 0; j < 4; ++j) v[i * 4 + j] = (v[i * 4 + j] - mu) * rs * gg[j] + bb[j];
            if (l == 1) stg<f32x4>(p.out, (unsigned)((row * 1024 + lane * 16 + i * 4) * 4), f32x4{v[i * 4], v[i * 4 + 1], v[i * 4 + 2], v[i * 4 + 3]});
        }
#pragma unroll
        for (int i = 0; i < 2; ++i) {
            uint4 o;
            o.x = f2bf(v[i * 8 + 0]) | ((unsigned)f2bf(v[i * 8 + 1]) << 16); o.y = f2bf(v[i * 8 + 2]) | ((unsigned)f2bf(v[i * 8 + 3]) << 16);
            o.z = f2bf(v[i * 8 + 4]) | ((unsigned)f2bf(v[i * 8 + 5]) << 16); o.w = f2bf(v[i * 8 + 6]) | ((unsigned)f2bf(v[i * 8 + 7]) << 16);
            stg<uint4>(ws, (unsigned)(OFF_XB + (row * 1024 + lane * 16 + i * 8) * 2), o);
        }
    }
}


#define XB_TMO      128
#define XB_XCNT(j)  (256  + 64 * (j))
#define XB_XSUB(j)  (1280 + 64 * (j))
#define XB_XGEN(j)  (2304 + 64 * (j))
#define XB_TOP      3328
#define XB_TOPGEN   3392
#define XCD_BAR_WORDS 3456
#define XB_SPIN_CAP (1u << 22)
__device__ __forceinline__ unsigned xb_ld(unsigned* p)              { return __hip_atomic_load(p, __ATOMIC_RELAXED, __HIP_MEMORY_SCOPE_AGENT); }
__device__ __forceinline__ unsigned xb_add(unsigned* p, unsigned v) { return __hip_atomic_fetch_add(p, v, __ATOMIC_RELAXED, __HIP_MEMORY_SCOPE_AGENT); }
__device__ __forceinline__ unsigned xb_xcc_id() { return (unsigned)__builtin_amdgcn_s_getreg((3 << 11) | 20) & 0xFu; }
#define XB_SPIN(cond, bar) do { unsigned _sp = 0; while (cond) { __builtin_amdgcn_s_sleep(1); \
    if ((++_sp & 255u) == 0u) { if (xb_ld(&(bar)[XB_TMO])) break; if (_sp > XB_SPIN_CAP) { atomicAdd(&(bar)[XB_TMO], 1u); break; } } } } while (0)
struct XcdBarrier { unsigned* bar; unsigned x; volatile LAS unsigned* st; };
__device__ __forceinline__ XcdBarrier xcd_barrier_post(unsigned* bar, volatile LAS unsigned* st) {
    XcdBarrier b; b.bar = bar; b.x = xb_xcc_id(); b.st = st;
    if (threadIdx.x == 0) (void)xb_add(&bar[XB_XCNT(b.x)], 1u);
    return b;
}
__device__ __forceinline__ void xcd_barrier_complete(unsigned* bar, unsigned x, unsigned& nloc, unsigned& nx) {
    const unsigned G = gridDim.x * gridDim.y * gridDim.z;
    unsigned sum, cnt, mine, sp = 0u;
    for (;;) {
        sum = 0u; cnt = 0u; mine = 0u;
#pragma unroll
        for (unsigned j = 0; j < 16; ++j) { const unsigned c = xb_ld(&bar[XB_XCNT(j)]); sum += c; cnt += (c > 0u) ? 1u : 0u; mine = (j == x) ? c : mine; }
        if (sum == G) break;
        __builtin_amdgcn_s_sleep(1);
        if ((++sp & 255u) == 0u) { if (xb_ld(&bar[XB_TMO])) break; if (sp > XB_SPIN_CAP) { atomicAdd(&bar[XB_TMO], 1u); break; } }
    }
    nloc = mine > 0u ? mine : 1u; nx = cnt > 0u ? cnt : 1u;
}
__device__ __forceinline__ void xcd_barrier(const XcdBarrier& b) {
    asm volatile("s_waitcnt vmcnt(0)" ::: "memory");
    __syncthreads();
    if (threadIdx.x == 0) {
        unsigned* bar = b.bar;
        __builtin_amdgcn_s_waitcnt(0);
        unsigned nloc = b.st[0], nx = b.st[1];
        if (nloc == 0u) { xcd_barrier_complete(bar, b.x, nloc, nx); b.st[0] = nloc; b.st[1] = nx; }
        const unsigned old = xb_add(&bar[XB_XSUB(b.x)], 1u);
        const unsigned gen = old / nloc;
        if (old + 1u == (gen + 1u) * nloc) {
            __builtin_amdgcn_fence(__ATOMIC_RELEASE, "agent");
            asm volatile("s_waitcnt vmcnt(0)" ::: "memory");
            const unsigned og = xb_add(&bar[XB_TOP], 1u);
            const unsigned tg = og / nx;
            if (og + 1u == (tg + 1u) * nx) xb_add(&bar[XB_TOPGEN], 1u);
            else XB_SPIN(xb_ld(&bar[XB_TOPGEN]) == tg, bar);
            __builtin_amdgcn_fence(__ATOMIC_ACQUIRE, "agent");
            xb_add(&bar[XB_XGEN(b.x)], 1u);
            asm volatile("s_waitcnt vmcnt(0)" ::: "memory");
        } else {
            XB_SPIN(xb_ld(&bar[XB_XGEN(b.x)]) == gen, bar);
            __builtin_amdgcn_fence(__ATOMIC_ACQUIRE, "agent");
            asm volatile("s_waitcnt vmcnt(0)" ::: "memory");
        }
    }
    __syncthreads();
}

__global__ void __launch_bounds__(512, 2) fwd_kernel(Params p_unused) {
    extern __shared__ __attribute__((aligned(16))) char lds[];
    cg::grid_group grid = cg::this_grid();
    CParams* pp = (CParams*)__builtin_amdgcn_kernarg_segment_ptr();
    const int ph_lo = pp->ph_lo;
    volatile LAS unsigned* xst = (volatile LAS unsigned*)(lds + L_XST);
    if (threadIdx.x == 0) { xst[0] = 0u; xst[1] = 0u; *(LAS unsigned*)(lds + 147456 + 32) = 0u; }
    __syncthreads();
    const XcdBarrier xb = xcd_barrier_post((unsigned*)(pp->ws + OFF_BAR), xst);
    char* hlds = lds + __builtin_amdgcn_readfirstlane((int)(threadIdx.x >> 8)) * HLDS;
    unsigned long long tq_acc = 0;
    (void)ph_lo;
#pragma unroll
    for (int ph = 0; ph < 2 * NPH; ++ph) {
        asm volatile("" : "+s"(pp));
        CParams& p = *pp;
        const int l = ph / NPH, q = ph % NPH;
        unsigned long long tq0 = 0;
        if (PROBE_TQ >= 0 && q == PROBE_TQ) tq0 = __builtin_amdgcn_s_memrealtime();
#pragma unroll 1
        for (int rep = 0; rep < 1 + (int)((PROBE_MASK >> q) & 1u); ++rep) {
            if (rep) xcd_barrier(xb);
            switch (q) {
                case 0: phase_w(p, l, hlds); break;
                case 1: phase_proj(p, l, lds); break;
                case 2: phase2(p, l, hlds); break;
                case 3: phase3(p, l, hlds); break;
                case 4: phase4(p, l, hlds); break;
                case 5: phase_glu(p, l, hlds); break;
                case 6: phase_branch(p, l, lds); break;
                case 7: phase_out(p, l, lds, hlds); break;
                case 8: phase_route(p, l, hlds); break;
                case 9: phase_moe1(p, l, lds); break;
                case 10: phase_moe2(p, l, lds); break;
                default: phase_combine(p, l); break;
            }
        }
        if (ph + 1 < 2 * NPH) {
            if (p.coop == 1) xcd_barrier(xb);
            else if (p.coop == 2) grid.sync();
        }
        if (PROBE_TQ >= 0 && q == PROBE_TQ) tq_acc += __builtin_amdgcn_s_memrealtime() - tq0;
    }
    if (PROBE_TQ == 98) tq_acc = *(LAS unsigned*)(lds + 147456 + 32);
    if (PROBE_TQ >= 0 && blockIdx.x == 0) {
        const unsigned long long t0 = __builtin_amdgcn_s_memrealtime();
        while (__builtin_amdgcn_s_memrealtime() - t0 < 4ull * tq_acc) __builtin_amdgcn_s_sleep(8);
    }
}

extern "C" void kernel_launch(void* const* d_in, const int* in_sizes, int n_in, void* d_out, int out_size, void* d_ws, size_t ws_size,
                              hipStream_t stream) {
    static int grid_blocks = 0;
    if (!grid_blocks) {
        int dev = 0, cus = 0, per_cu = 0;
        (void)hipGetDevice(&dev);
        (void)hipDeviceGetAttribute(&cus, hipDeviceAttributeMultiprocessorCount, dev);
        (void)hipFuncSetAttribute((const void*)fwd_kernel, hipFuncAttributeMaxDynamicSharedMemorySize, LDS_BYTES);
        (void)hipOccupancyMaxActiveBlocksPerMultiprocessor(&per_cu, fwd_kernel, 512, LDS_BYTES);
        if (per_cu < 1) per_cu = 1;
        per_cu = 1;
        grid_blocks = cus * per_cu;
        if (ws_size < WS_NEED) fprintf(stderr, "kernel_launch: workspace too small: %zu < %zu\n", ws_size, (size_t)WS_NEED);
    }
    Params p{};
    for (int i = 0; i < 36; ++i) p.in[i] = (const float*)d_in[i];
    p.out = (float*)d_out;
    p.ws = (unsigned char*)d_ws;
    p.ph_lo = 0; p.ph_hi = 2 * NPH; p.coop = 1; p.pad = 0;
    (void)hipMemsetAsync((char*)d_ws + OFF_BAR, 0, XCD_BAR_WORDS * 4, stream);
    void* args[] = {&p};
    hipError_t e = hipLaunchCooperativeKernel((void*)fwd_kernel, dim3(grid_blocks), dim3(512), args, LDS_BYTES, stream);
    if (e != hipSuccess) fprintf(stderr, "cooperative launch failed: %s (grid %d)\n", hipGetErrorString(e), grid_blocks);
}
```

```cpp
#include <hip/hip_runtime.h>
#include <hip/hip_cooperative_groups.h>
#include <cstdio>
#include <cstdint>
namespace cg = cooperative_groups;

typedef unsigned short u16;
typedef __attribute__((ext_vector_type(8))) short bf16x8;
typedef __attribute__((ext_vector_type(4))) float f32x4;
typedef __attribute__((ext_vector_type(4))) unsigned u32x4;
#define LAS __attribute__((address_space(3)))

constexpr int NTOK = 16384, DM = 1024, SEQ = 4096, BW = 512, INC = 6656;
constexpr int NE = 64, EH = 256;
#ifndef PROBE_MASK
#define PROBE_MASK 0u
#endif
#define PROBE_TIMEK_ProjEpi false
#define PROBE_TIMEK_OutEpi false
#define PROBE_TIMEK_BrEpi false
#define PROBE_TIMEK_Moe1Epi false
#define PROBE_TIMEK_Moe2Epi false
#define PROBE_TIMEK_ShEpi false
#define PROBE_TQ -1
constexpr int NPH = 12;
constexpr float DN_ALPHA = 1.4142135623730951f;
constexpr size_t SLOT = 16777216ull;

constexpr size_t OFF_WINT  = 0;
constexpr size_t OFF_WBRT  = 13631488;
constexpr size_t OFF_WOUTT = 16777216;
constexpr size_t OFF_GLUT  = 18874368;
constexpr size_t OFF_RGT   = 19398656;
constexpr size_t OFF_SH13T = 19660800;
constexpr size_t OFF_SH2T  = 20709376;
constexpr size_t OFF_BTA   = 21233664;
constexpr size_t OFF_BTC   = 23330816;
constexpr size_t OFF_ROUTT = 29622272;
constexpr size_t OFF_MISC  = 29753344;
constexpr size_t OFF_LB    = OFF_MISC;
constexpr size_t OFF_CUR   = OFF_MISC + 2048;
constexpr size_t OFF_DEC   = OFF_MISC + 4096;
constexpr size_t OFF_SEGA  = OFF_DEC + 524288;
constexpr size_t OFF_SEGH  = OFF_SEGA + 524288;
constexpr size_t OFF_XB    = 2 * SLOT;
constexpr size_t OFF_VC    = 29 * SLOT;
constexpr size_t OFF_XC    = 30 * SLOT;
constexpr size_t OFF_MIXP  = 30 * SLOT;
constexpr size_t OFF_LIST  = 2 * SLOT;
constexpr size_t OFF_HSH   = 2 * SLOT + 4194304;
constexpr size_t OFF_WLIST = 2 * SLOT + 4194304 + 8388608;
constexpr size_t OFF_PQ    = 4 * SLOT;
constexpr size_t OFF_PLF   = 5 * SLOT;
constexpr size_t OFF_PK    = 7 * SLOT;
constexpr size_t OFF_PV    = 8 * SLOT;
constexpr size_t OFF_YC    = 8 * SLOT;
constexpr size_t OFF_PG    = 9 * SLOT;
constexpr size_t OFF_PU    = 10 * SLOT;
constexpr size_t OFF_PXG   = 11 * SLOT;
constexpr size_t OFF_PXR   = 12 * SLOT;
constexpr size_t OFF_YB    = 12 * SLOT;
constexpr size_t OFF_PGATE = 13 * SLOT;
constexpr size_t OFF_KTT   = 19 * SLOT;
constexpr size_t OFF_YA    = 19 * SLOT;
constexpr size_t OFF_VT    = 20 * SLOT;
constexpr size_t OFF_ST    = 21 * SLOT;
constexpr size_t OFF_LA    = 23 * SLOT;
constexpr size_t OFF_BB    = 24 * SLOT;
constexpr size_t OFF_YG    = 25 * SLOT;
constexpr size_t OFF_HC    = 26 * SLOT;
constexpr size_t OFF_UT    = 27 * SLOT;
constexpr size_t OFF_PRELN = 4 * SLOT;
constexpr size_t OFF_XM    = 8 * SLOT;
constexpr size_t OFF_EW13  = 10 * SLOT;
constexpr size_t OFF_EW2   = 14 * SLOT;
constexpr size_t OFF_HBUF  = 4 * SLOT;
constexpr size_t OFF_YBUF  = 16 * SLOT;
constexpr size_t OFF_YSH   = 24 * SLOT;
constexpr size_t OFF_BAR   = 32 * SLOT;
constexpr int HLDS = 73728;
constexpr int LDS_BYTES = 2 * HLDS + 64;
constexpr int L_XST = 2 * HLDS;
constexpr size_t WS_NEED   = 32 * SLOT + 16384;

struct Params {
    const float* in[36];
    float* out;
    unsigned char* ws;
    int ph_lo, ph_hi;
    int coop, pad;
};
typedef const __attribute__((address_space(4))) Params CParams;

__device__ __forceinline__ u16 f2bf(float f) {
    unsigned u = __builtin_bit_cast(unsigned, f);
    return (u16)((u + 0x7fffu + ((u >> 16) & 1u)) >> 16);
}
__device__ __forceinline__ float bf2f(u16 h) { return __builtin_bit_cast(float, (unsigned)h << 16); }
__device__ __forceinline__ float sigm(float x) { return __builtin_amdgcn_rcpf(1.f + __expf(-x)); }
__device__ __forceinline__ float silu_f(float x) { return x * sigm(x); }
__device__ __forceinline__ float gelu_f(float x) {
    float u = 0.7978845608028654f * (x + 0.044715f * x * x * x);
    float t = 1.f - 2.f * __builtin_amdgcn_rcpf(1.f + __expf(2.f * u));
    return 0.5f * x * (1.f + t);
}
__device__ __forceinline__ float shfl_xor_l(float v, int o, int lane) {
    return __builtin_bit_cast(float, __builtin_amdgcn_ds_bpermute((lane ^ o) << 2, __builtin_bit_cast(int, v)));
}
__device__ __forceinline__ float wave_sum(float v, int lane) {
#pragma unroll
    for (int o = 32; o >= 1; o >>= 1) v += shfl_xor_l(v, o, lane);
    return v;
}
__device__ __forceinline__ int swz(int row, int ch) { return row * 128 + ((ch ^ ((row >> 1) & 7)) << 4); }


template <class T> __device__ __forceinline__ T ldg(const void* base, unsigned off) { return *(const T*)((const char*)base + off); }
template <class T> __device__ __forceinline__ void stg(void* base, unsigned off, T v) { *(T*)((char*)base + off) = v; }
template <class T> __device__ __forceinline__ void stg_nt(void* base, unsigned off, T v) { __builtin_nontemporal_store(v, (T*)((char*)base + off)); }

template <int TM, int TN, int RW, int CW, class F>
__device__ __forceinline__ void epi(f32x4 (&acc)[TM][TN], int wr, int wc, int fq, int fr, F f) {
#pragma unroll
    for (int m = 0; m < TM; ++m) {
#pragma unroll
        for (int j = 0; j < 4; ++j) {
#pragma unroll
            for (int n = 0; n < TN; ++n) f(wr * RW + m * 16 + fq * 4 + j, wc * CW + n * 16 + fr, acc[m][n][j]);
        }
        __builtin_amdgcn_sched_barrier(0);
    }
}

template <int TM, int TN, int RW, int CW, class F>
__device__ __forceinline__ void epiT(f32x4 (&acc)[TM][TN], int wr, int wc, int fq, int fr, F f) {
#pragma unroll
    for (int m = 0; m < TM; ++m) {
#pragma unroll
        for (int n = 0; n < TN; ++n) f(wr * RW + m * 16 + fr, wc * CW + n * 16 + fq * 4, acc[m][n]);
    }
}
__device__ __forceinline__ uint2 pack4(const f32x4& a) {
    uint2 w; w.x = f2bf(a[0]) | ((unsigned)f2bf(a[1]) << 16); w.y = f2bf(a[2]) | ((unsigned)f2bf(a[3]) << 16); return w;
}
__device__ __forceinline__ f32x4 unpack4(const uint2 q) {
    return f32x4{bf2f((u16)(q.x & 0xffff)), bf2f((u16)(q.x >> 16)), bf2f((u16)(q.y & 0xffff)), bf2f((u16)(q.y >> 16))};
}

extern __shared__ __attribute__((aligned(16))) char g_lds[];
__device__ __forceinline__ void hsync() {
    asm volatile("s_waitcnt vmcnt(0) lgkmcnt(0)" ::: "memory");
    LAS unsigned* ctr = (LAS unsigned*)(g_lds + 2 * 73728 + 16) + __builtin_amdgcn_readfirstlane((int)(threadIdx.x >> 8));
    unsigned old = 0;
    if (__builtin_amdgcn_mbcnt_hi(~0u, __builtin_amdgcn_mbcnt_lo(~0u, 0u)) == 0) old = __hip_atomic_fetch_add(ctr, 1u, __ATOMIC_RELAXED, __HIP_MEMORY_SCOPE_WORKGROUP);
    old = __builtin_amdgcn_readfirstlane(old);
    const unsigned target = (old & ~3u) + 4u;
    while (__hip_atomic_load(ctr, __ATOMIC_RELAXED, __HIP_MEMORY_SCOPE_WORKGROUP) < target) __builtin_amdgcn_s_sleep(1);
    asm volatile("" ::: "memory");
}

__device__ __forceinline__ int otid() { int t = threadIdx.x & 255; asm volatile("" : "+v"(t)); return t; }
#define VB ((int)blockIdx.x * 2 + __builtin_amdgcn_readfirstlane((int)(threadIdx.x >> 8)))
#define VG ((int)gridDim.x * 2)

struct NoHook { __device__ __forceinline__ void operator()(int) const {} };

template <int BM, int BN, int WM, int WN, bool TR = false, class AL, class BL, class HK>
__device__ __forceinline__ void mma_loop(f32x4 (&acc)[BM / WM / 16][BN / WN / 16], int nk, AL aload, BL bload, HK hook, char* lds) {
    constexpr int TM = BM / WM / 16, TN = BN / WN / 16;
    constexpr int ACH = BM / 32, BCH = BN / 32;
    const int tid = otid(), lane = tid & 63, wid = tid >> 6;
    const int wr = wid / WN, wc = wid % WN, fr = lane & 15, fq = lane >> 4;
    const int srow = tid >> 3, sk = (tid & 7) * 8;
    const int swr = srow * 128 + (((tid & 7) ^ ((tid >> 4) & 7)) << 4);
    const int xr = (fr >> 1) & 7;
    const int a_rd = (wr * (BM / WM) + fr) * 128;
    const int b_rd = BM * 128 + (wc * (BN / WN) + fr) * 128;
    bf16x8 ra[ACH], rb[BCH];
#pragma unroll
    for (int i = 0; i < ACH; ++i) ra[i] = aload(srow + i * 32, sk);
#pragma unroll
    for (int i = 0; i < BCH; ++i) rb[i] = bload(srow + i * 32, sk);
#pragma unroll 1
    for (int t = 0; t < nk; ++t) {
        hsync();
#pragma unroll
        for (int i = 0; i < ACH; ++i) *(bf16x8*)(lds + swr + i * 4096) = ra[i];
#pragma unroll
        for (int i = 0; i < BCH; ++i) *(bf16x8*)(lds + BM * 128 + swr + i * 4096) = rb[i];
        hsync();
        if (t + 1 < nk) {
#pragma unroll
            for (int i = 0; i < ACH; ++i) ra[i] = aload(srow + i * 32, (t + 1) * 64 + sk);
#pragma unroll
            for (int i = 0; i < BCH; ++i) rb[i] = bload(srow + i * 32, (t + 1) * 64 + sk);
        }
        hook(t);
#pragma unroll
        for (int ks = 0; ks < 2; ++ks) {
            const int co = ((ks * 4 + fq) ^ xr) << 4;
            bf16x8 af[TM], bfr[TN];
#pragma unroll
            for (int m = 0; m < TM; ++m) af[m] = *(const bf16x8*)(lds + a_rd + m * 2048 + co);
#pragma unroll
            for (int n = 0; n < TN; ++n) bfr[n] = *(const bf16x8*)(lds + b_rd + n * 2048 + co);
#pragma unroll
            for (int m = 0; m < TM; ++m)
#pragma unroll
                for (int n = 0; n < TN; ++n) acc[m][n] = TR ? __builtin_amdgcn_mfma_f32_16x16x32_bf16(bfr[n], af[m], acc[m][n], 0, 0, 0)
                                                            : __builtin_amdgcn_mfma_f32_16x16x32_bf16(af[m], bfr[n], acc[m][n], 0, 0, 0);
        }
    }
}

template <int BM, int BN, int WM, int WN, bool TR = false, class AO, class BO, class HK>
__device__ __forceinline__ void mma_glds(f32x4 (&acc)[BM / WM / 16][BN / WN / 16], int nk, const unsigned char* ws, AO aoff, BO boff, HK hook, char* lds) {
    constexpr int TM = BM / WM / 16, TN = BN / WN / 16;
    constexpr int ACH = BM / 32, BCH = BN / 32, BUF = (BM + BN) * 128;
    const int tid = otid(), lane = tid & 63, wid = tid >> 6;
    const int wr = wid / WN, wc = wid % WN, fr = lane & 15, fq = lane >> 4;
    const int srow = tid >> 3;
    const unsigned csrc = (unsigned)(((tid & 7) ^ ((tid >> 4) & 7)) << 4);
    const int xr = (fr >> 1) & 7;
    const int a_rd = (wr * (BM / WM) + fr) * 128;
    const int b_rd = BM * 128 + (wc * (BN / WN) + fr) * 128;
    auto stage = [&](int buf, int t) {
        char* d = lds + buf * BUF + tid * 16;
#pragma unroll
        for (int i = 0; i < ACH; ++i)
            __builtin_amdgcn_global_load_lds((const unsigned*)(ws + (aoff(srow + i * 32, t) + csrc)), (unsigned*)(d + i * 4096), 16, 0, 0);
#pragma unroll
        for (int i = 0; i < BCH; ++i)
            __builtin_amdgcn_global_load_lds((const unsigned*)(ws + (boff(srow + i * 32, t) + csrc)), (unsigned*)(d + BM * 128 + i * 4096), 16, 0, 0);
    };
    hsync();
    stage(0, 0);
#pragma unroll 1
    for (int t = 0; t < nk; ++t) {
        asm volatile("s_waitcnt vmcnt(0)" ::: "memory");
        hsync();
        if (t + 1 < nk) stage((t + 1) & 1, t + 1);
        hook(t);
        const char* bb = lds + (t & 1) * BUF;
#pragma unroll
        for (int ks = 0; ks < 2; ++ks) {
            const int co = ((ks * 4 + fq) ^ xr) << 4;
            bf16x8 af[TM], bfr[TN];
#pragma unroll
            for (int m = 0; m < TM; ++m) af[m] = *(const bf16x8*)(bb + a_rd + m * 2048 + co);
#pragma unroll
            for (int n = 0; n < TN; ++n) bfr[n] = *(const bf16x8*)(bb + b_rd + n * 2048 + co);
#pragma unroll
            for (int m = 0; m < TM; ++m)
#pragma unroll
                for (int n = 0; n < TN; ++n) acc[m][n] = TR ? __builtin_amdgcn_mfma_f32_16x16x32_bf16(bfr[n], af[m], acc[m][n], 0, 0, 0)
                                                            : __builtin_amdgcn_mfma_f32_16x16x32_bf16(af[m], bfr[n], acc[m][n], 0, 0, 0);
        }
    }
}

#define ZERO_ACC(acc, TM, TN) _Pragma("unroll") for (int m_ = 0; m_ < TM; ++m_) _Pragma("unroll") for (int n_ = 0; n_ < TN; ++n_) acc[m_][n_] = f32x4{0.f, 0.f, 0.f, 0.f}

#define LANE_IDS const int tid = otid(), lane = tid & 63, wid = tid >> 6, fr = lane & 15, fq = lane >> 4; (void)tid; (void)lane; (void)wid; (void)fr; (void)fq

namespace g8 {
constexpr int BM = 256, BK = 64, HALF = 128, HTB = HALF * BK * 2, STAGE_BYTES = 8 * HTB;
__device__ __forceinline__ int lds_byte(int r, int c) { const int st = (r >> 4) * 2 + (c >> 5), rr = r & 15, cc = c & 31, ob = rr * 64 + cc * 2; return st * 1024 + (ob ^ (((ob >> 9) & 1) << 5)); }
__device__ __forceinline__ void stage_rc(int b, int& R, int& C) { const int st = b / 1024, sb = b % 1024, swz = sb ^ (((sb >> 9) & 1) << 5); R = (st >> 1) * 16 + swz / 64; C = (st & 1) * 32 + (swz % 64) / 2; }
__device__ __forceinline__ int perm32(int rho) { const int n = rho >> 4, i = rho & 15; return 8 * (i >> 2) + 4 * n + (i & 3); }
struct Unit { unsigned A, B; int pm, pn, x0, x1; };
__device__ __forceinline__ unsigned cvt_pk_bf16(float lo, float hi) { unsigned r; asm volatile("v_cvt_pk_bf16_f32 %0, %1, %2" : "=v"(r) : "v"(lo), "v"(hi)); return r; }

template <class Epi, class Sched, bool GATHER>
__device__ __forceinline__ void gemm_phase(LAS unsigned char* lds, const unsigned char* wsb, const int K, const Sched& S, const Epi& E) {
    int tid_ = threadIdx.x; asm volatile("" : "+v"(tid_));
    const int tid = tid_, wid = __builtin_amdgcn_readfirstlane(tid >> 6), lane = tid & 63, wr = wid >> 2, wc = wid & 3, fr = lane & 15, fq = lane >> 4;
    const int nt = K / BK;
    unsigned voffA[2], voffB[2];
#pragma unroll
    for (int i = 0; i < 2; ++i) { int R, C; stage_rc(tid * 16 + i * 8192, R, C); const int Rb = Epi::PERM ? ((R & ~31) + perm32(R & 31)) : R;
        voffA[i] = (unsigned)(R * K + C) * 2u; voffB[i] = (unsigned)(Rb * K + C) * 2u; }
    const unsigned kstep = (unsigned)(BK * 2);
    const unsigned hstep = (unsigned)(HALF * K * 2);
    const unsigned ldsw = (unsigned)wid * 1024u;
    const int aoff = lds_byte(wr * 64 + fr, fq * 8), boff = lds_byte(wc * 32 + fr, fq * 8);
#define G8_SA(b, h) (((b) * 2 + (h)) * HTB)
#define G8_SB(b, h) ((4 + (b) * 2 + (h)) * HTB)
#define G8_STAGE(bufoff, gbase, voff) do { _Pragma("unroll") for (int _i = 0; _i < 2; ++_i) \
        __builtin_amdgcn_global_load_lds((const unsigned*)(wsb + (unsigned)((gbase) + (voff)[_i])), (LAS unsigned*)(lds + (bufoff) + ldsw + _i * 8192), 16, 0, 0); } while (0)
#define G8_STAGE_A(bufoff, kp, h, vg) do { if (GATHER) G8_STAGE(bufoff, kp, vg[h]); else G8_STAGE(bufoff, (kp) + (h) * hstep, voffA); } while (0)
#define G8_LDA(dst, b, h) do { _Pragma("unroll") for (int m = 0; m < 4; ++m) _Pragma("unroll") for (int k = 0; k < 2; ++k) dst[m][k] = *(const LAS bf16x8*)(lds + G8_SA(b, h) + aoff + m * 2048 + k * 1024); } while (0)
#define G8_LDB(dst, b, h) do { _Pragma("unroll") for (int n = 0; n < 2; ++n) _Pragma("unroll") for (int k = 0; k < 2; ++k) dst[n][k] = *(const LAS bf16x8*)(lds + G8_SB(b, h) + boff + n * 2048 + k * 1024); } while (0)
#define G8_MMA(ai, bj, At, Bt) do { __builtin_amdgcn_s_setprio(1); _Pragma("unroll") for (int m = 0; m < 4; ++m) _Pragma("unroll") for (int n = 0; n < 2; ++n) _Pragma("unroll") for (int k = 0; k < 2; ++k) \
        acc[ai][bj][m][n] = __builtin_amdgcn_mfma_f32_16x16x32_bf16(Bt[n][k], At[m][k], acc[ai][bj][m][n], 0, 0, 0); __builtin_amdgcn_s_setprio(0); } while (0)
#define G8_WAIT_V(n) asm volatile("s_waitcnt vmcnt(" #n ")" ::: "memory")
#define G8_WAIT_L(n) asm volatile("s_waitcnt lgkmcnt(" #n ")" ::: "memory")
#define G8_BAR __builtin_amdgcn_s_barrier()
#define G8_SCHED __builtin_amdgcn_sched_barrier(0)
#define G8_GOFF(dst, u) do { _Pragma("unroll") for (int _i = 0; _i < 2; ++_i) { int _R, _C; stage_rc(tid * 16 + _i * 8192, _R, _C); \
        _Pragma("unroll") for (int _h = 0; _h < 2; ++_h) dst[_h][_i] = (unsigned)(S.row(u, _h * HALF + _R) * K + _C) * 2u; } \
        asm volatile("" : "+v"(dst[0][0]), "+v"(dst[0][1]), "+v"(dst[1][0]), "+v"(dst[1][1])); } while (0)
    Unit cur, nxt; int ui = 0;
    if (!S.next(0, cur)) return;
    f32x4 acc[2][2][4][2];
#pragma unroll
    for (int a = 0; a < 2; ++a)
#pragma unroll
        for (int b = 0; b < 2; ++b)
#pragma unroll
            for (int m = 0; m < 4; ++m)
#pragma unroll
                for (int n = 0; n < 2; ++n) acc[a][b][m][n] = (f32x4){0.f, 0.f, 0.f, 0.f};
    bf16x8 At[4][2], B0[2][2], B1[2][2];
    unsigned vgc[2][2] = {{0u, 0u}, {0u, 0u}};
    LAS u32x4* gslot = (LAS u32x4*)(lds + STAGE_BYTES + 4096) + tid;
    unsigned cA = cur.A, cB = cur.B;
    if (GATHER) { G8_GOFF(vgc, cur); }
    G8_STAGE(G8_SB(0, 0), cB, voffB); G8_STAGE_A(G8_SA(0, 0), cA, 0, vgc); G8_STAGE(G8_SB(0, 1), cB + hstep, voffB); G8_STAGE_A(G8_SA(0, 1), cA, 1, vgc);
    if (wr == 1) G8_BAR;
    G8_WAIT_V(4); G8_BAR;
    G8_STAGE(G8_SB(1, 0), cB + kstep, voffB); G8_STAGE_A(G8_SA(1, 0), cA + kstep, 0, vgc); G8_STAGE(G8_SB(1, 1), cB + hstep + kstep, voffB);
    G8_WAIT_V(6); G8_BAR;
    for (;;) {
        const bool has_next = S.next(ui + 1, nxt);
        const unsigned nA = has_next ? nxt.A : cA, nB = has_next ? nxt.B : cB;
        if (GATHER && has_next) {
            unsigned vt[2][2]; G8_GOFF(vt, nxt);
            *gslot = u32x4{vt[0][0], vt[0][1], vt[1][0], vt[1][1]};
        }
        unsigned long long tk0 = 0;
        if (Epi::TIMEK) tk0 = __builtin_amdgcn_s_memrealtime();
#pragma unroll 1
        for (int t = 0; t < nt; t += 2) {
            const bool last = (t == nt - 2);
            const unsigned a1 = cA + (unsigned)(t + 1) * kstep;
            const unsigned a2 = last ? nA : cA + (unsigned)(t + 2) * kstep, b2 = last ? nB : cB + (unsigned)(t + 2) * kstep;
            const unsigned a3 = a2 + kstep, b3 = b2 + kstep;
            G8_LDB(B0, 0, 0); G8_SCHED; G8_LDA(At, 0, 0); G8_STAGE_A(G8_SA(1, 1), a1, 1, vgc);
            G8_WAIT_L(8); G8_BAR; G8_WAIT_L(0); G8_MMA(0, 0, At, B0); G8_BAR; G8_SCHED;
            G8_LDB(B1, 0, 1);
            if (GATHER && last && has_next) { const u32x4 x = *gslot; vgc[0][0] = x[0]; vgc[0][1] = x[1]; vgc[1][0] = x[2]; vgc[1][1] = x[3]; }
            G8_STAGE(G8_SB(0, 0), b2, voffB);
            G8_BAR; G8_WAIT_L(0); G8_MMA(0, 1, At, B1); G8_BAR;
            G8_LDA(At, 0, 1); G8_STAGE_A(G8_SA(0, 0), a2, 0, vgc);
            G8_BAR; G8_WAIT_L(0); G8_MMA(1, 0, At, B0); G8_BAR; G8_SCHED;
            G8_STAGE(G8_SB(0, 1), b2 + hstep, voffB);
            G8_WAIT_V(6); G8_BAR; G8_MMA(1, 1, At, B1); G8_BAR;
            G8_LDB(B0, 1, 0); G8_SCHED; G8_LDA(At, 1, 0); G8_STAGE_A(G8_SA(0, 1), a2, 1, vgc);
            G8_WAIT_L(8); G8_BAR; G8_WAIT_L(0); G8_MMA(0, 0, At, B0); G8_BAR; G8_SCHED;
            G8_LDB(B1, 1, 1); G8_STAGE(G8_SB(1, 0), b3, voffB);
            G8_BAR; G8_WAIT_L(0); G8_MMA(0, 1, At, B1); G8_BAR;
            G8_LDA(At, 1, 1); G8_STAGE_A(G8_SA(1, 0), a3, 0, vgc);
            G8_BAR; G8_WAIT_L(0); G8_MMA(1, 0, At, B0); G8_BAR; G8_SCHED;
            G8_STAGE(G8_SB(1, 1), b3 + hstep, voffB);
            G8_WAIT_V(6); G8_BAR; G8_MMA(1, 1, At, B1); G8_BAR;
        }
        if (Epi::TIMEK && tid == 0) { const unsigned dt = (unsigned)(__builtin_amdgcn_s_memrealtime() - tk0); *(LAS unsigned*)(lds + 147456 + 32) += dt; }
        const bool keep = E(acc, cur, wr, wc, fr, fq);
        if (!has_next) break;
        if (!keep) {
#pragma unroll
        for (int a = 0; a < 2; ++a)
#pragma unroll
            for (int b = 0; b < 2; ++b)
#pragma unroll
                for (int m = 0; m < 4; ++m)
#pragma unroll
                    for (int n = 0; n < 2; ++n) acc[a][b][m][n] = (f32x4){0.f, 0.f, 0.f, 0.f};
        }
        cur = nxt; cA = nA; cB = nB; ++ui;
    }
    G8_WAIT_V(0);
    if (wr == 0) G8_BAR;
    G8_BAR;
#undef G8_SA
#undef G8_SB
#undef G8_STAGE
#undef G8_STAGE_A
#undef G8_LDA
#undef G8_LDB
#undef G8_MMA
#undef G8_WAIT_V
#undef G8_WAIT_L
#undef G8_BAR
#undef G8_SCHED
#undef G8_GOFF
}
}

__device__ __forceinline__ u32x4 pack8v(const f32x4& a, const f32x4& b) {
    u32x4 w; w[0] = g8::cvt_pk_bf16(a[0], a[1]); w[1] = g8::cvt_pk_bf16(a[2], a[3]); w[2] = g8::cvt_pk_bf16(b[0], b[1]); w[3] = g8::cvt_pk_bf16(b[2], b[3]); return w;
}
__device__ __forceinline__ uint4 pack8(const f32x4& a, const f32x4& b) {
    uint4 w; w.x = g8::cvt_pk_bf16(a[0], a[1]); w.y = g8::cvt_pk_bf16(a[2], a[3]); w.z = g8::cvt_pk_bf16(b[0], b[1]); w.w = g8::cvt_pk_bf16(b[2], b[3]); return w;
}

struct ProjSched {
    unsigned A, B; int c, G;
    __device__ __forceinline__ bool next(int i, g8::Unit& u) const {
        const int L = i * G + c; if (L >= 64 * 26) return false;
        const int xcd = L & 7, jx = L >> 3;
        u.pm = xcd * 8 + (jx & 7); u.pn = jx >> 3;
        u.A = A + (unsigned)u.pm * 256 * DM * 2; u.B = B + (unsigned)u.pn * 256 * DM * 2; u.x0 = 0; u.x1 = 0; return true;
    }
    __device__ __forceinline__ int row(const g8::Unit&, int) const { return 0; }
};
struct ProjEpi {
    static constexpr bool TIMEK = PROBE_TIMEK_ProjEpi;
    static constexpr bool PERM = true;
    unsigned char* ws; const float* bg;
    __device__ __forceinline__ bool operator()(f32x4 (&acc)[2][2][4][2], const g8::Unit& u, int wr, int wc, int fr, int fq) const {
        const int seg = (u.pn * 256) >> 9;
        f32x4 cc[2][2];
#pragma unroll
        for (int bj = 0; bj < 2; ++bj) {
            const int col = u.pn * 256 + bj * 128 + wc * 32 + fq * 8;
            if (seg == 1) { cc[bj][0] = ldg<f32x4>(ws, (unsigned)(OFF_LB + (col & 511) * 4)); cc[bj][1] = ldg<f32x4>(ws, (unsigned)(OFF_LB + (col & 511) * 4 + 16)); }
            else if (seg >= 7) { cc[bj][0] = *(const f32x4*)(bg + col - 3584); cc[bj][1] = *(const f32x4*)(bg + col - 3584 + 4); }
            else { cc[bj][0] = f32x4{0.f, 0.f, 0.f, 0.f}; cc[bj][1] = cc[bj][0]; }
        }
#pragma unroll
        for (int ai = 0; ai < 2; ++ai)
#pragma unroll
            for (int m = 0; m < 4; ++m) {
                const int row = u.pm * 256 + ai * 128 + wr * 64 + m * 16 + fr;
#pragma unroll
                for (int bj = 0; bj < 2; ++bj) {
                    const int col = u.pn * 256 + bj * 128 + wc * 32 + fq * 8;
                    const int c = col & 511;
                    f32x4 v0 = acc[ai][bj][m][0], v1 = acc[ai][bj][m][1];
                    if (seg == 0 || seg == 3) {
#pragma unroll
                        for (int i = 0; i < 4; ++i) { v0[i] = silu_f(v0[i]); v1[i] = silu_f(v1[i]); }
                        stg<uint4>(ws, (unsigned)((seg == 0 ? OFF_PQ : OFF_PG) + (row * 512 + c) * 2), pack8(v0, v1));
                    } else if (seg == 1) {
                        const f32x4 l0 = cc[bj][0], l1 = cc[bj][1];
                        f32x4 g0, g1, k0, k1;
#pragma unroll
                        for (int i = 0; i < 4; ++i) {
                            const float s0 = sigm(v0[i]), s1 = sigm(v1[i]);
                            g0[i] = __logf(l0[i] + (1.f - l0[i]) * s0); g1[i] = __logf(l1[i] + (1.f - l1[i]) * s1);
                            k0[i] = (1.f - l0[i]) * (1.f - s0); k1[i] = (1.f - l1[i]) * (1.f - s1);
                        }
                        stg<f32x4>(ws, (unsigned)(OFF_PLF + (row * 512 + c) * 4), g0);
                        stg<f32x4>(ws, (unsigned)(OFF_PLF + (row * 512 + c) * 4 + 16), g1);
                        stg<uint4>(ws, (unsigned)(OFF_PK + (row * 512 + c) * 2), pack8(k0, k1));
                    } else if (seg == 2 || seg == 6) {
                        stg<uint4>(ws, (unsigned)((seg == 2 ? OFF_PV : OFF_PXR) + (row * 512 + c) * 2), pack8(v0, v1));
                    } else if (seg == 4) {
                        stg<uint4>(ws, (unsigned)(OFF_PU + (((c >> 4) * NTOK + row) * 16 + (c & 15)) * 2), pack8(v0, v1));
                    } else if (seg == 5) {
#pragma unroll
                        for (int i = 0; i < 4; ++i) { v0[i] = gelu_f(v0[i]); v1[i] = gelu_f(v1[i]); }
                        stg<uint4>(ws, (unsigned)(OFF_PXG + (row * 512 + c) * 2), pack8(v0, v1));
                    } else {
                        const int gc = col - 3584;
#pragma unroll
                        for (int i = 0; i < 4; ++i) { v0[i] = sigm(v0[i] + cc[bj][0][i]); v1[i] = sigm(v1[i] + cc[bj][1][i]); }
                        stg<uint4>(ws, (unsigned)(OFF_PGATE + (row * 3072 + gc) * 2), pack8(v0, v1));
                    }
                }
            }
        return false;
    }
};
__device__ void phase_proj(CParams& p, int l, char* lds) {
    ProjSched S; S.A = (unsigned)OFF_XB; S.B = (unsigned)OFF_WINT; S.c = blockIdx.x; S.G = gridDim.x;
    ProjEpi E; E.ws = p.ws; E.bg = p.in[2] + (size_t)l * 3072;
    g8::gemm_phase<ProjEpi, ProjSched, false>((LAS unsigned char*)lds, p.ws, 1024, S, E);
}

struct OutSched {
    unsigned A, B; int c, G;
    __device__ __forceinline__ bool next(int i, g8::Unit& u) const {
        const int L = i * G + c; if (L >= 64 * 4) return false;
        const int xcd = L & 7, jx = L >> 3;
        u.pm = xcd * 8 + (jx & 7); u.pn = jx >> 3;
        u.A = A + (unsigned)u.pm * 256 * 1024 * 2; u.B = B + (unsigned)u.pn * 256 * 1024 * 2; u.x0 = 0; u.x1 = 0; return true;
    }
    __device__ __forceinline__ int row(const g8::Unit&, int) const { return 0; }
};
struct OutEpi {
    static constexpr bool TIMEK = PROBE_TIMEK_OutEpi;
    static constexpr bool PERM = false;
    unsigned char* ws;
    __device__ __forceinline__ bool operator()(f32x4 (&acc)[2][2][4][2], const g8::Unit& u, int wr, int wc, int fr, int fq) const {
#pragma unroll
        for (int ai = 0; ai < 2; ++ai) {
            f32x4 x[4][2][2];
#pragma unroll
            for (int m = 0; m < 4; ++m)
#pragma unroll
                for (int bj = 0; bj < 2; ++bj)
#pragma unroll
                    for (int n = 0; n < 2; ++n) {
                        const int row = u.pm * 256 + ai * 128 + wr * 64 + m * 16 + fr, col = u.pn * 256 + bj * 128 + wc * 32 + n * 16 + fq * 4;
                        x[m][bj][n] = unpack4(ldg<uint2>(ws, (unsigned)(OFF_XB + (row * 1024 + col) * 2)));
                    }
#pragma unroll
            for (int m = 0; m < 4; ++m)
#pragma unroll
                for (int bj = 0; bj < 2; ++bj)
#pragma unroll
                    for (int n = 0; n < 2; ++n) {
                        const int row = u.pm * 256 + ai * 128 + wr * 64 + m * 16 + fr, col = u.pn * 256 + bj * 128 + wc * 32 + n * 16 + fq * 4;
                        stg<f32x4>(ws, (unsigned)OFF_PRELN + (unsigned)((row * 1024 + col) * 4), x[m][bj][n] * DN_ALPHA + acc[ai][bj][m][n]);
                    }
        }
        return false;
    }
};

struct BrSched {
    int c;
    __device__ __forceinline__ bool next(int i, g8::Unit& u) const {
        if (i >= 3) return false;
        const int xcd = c & 7, jx = c >> 3;
        u.pm = xcd * 8 + (jx & 7); u.pn = jx >> 3; u.x0 = i; u.x1 = 0;
        u.A = (unsigned)(i == 0 ? OFF_YA : (i == 1 ? OFF_YB : OFF_YC)) + (unsigned)u.pm * 256 * 512 * 2;
        u.B = (unsigned)OFF_WBRT + (unsigned)i * 1024 * 512 * 2 + (unsigned)u.pn * 256 * 512 * 2;
        return true;
    }
    __device__ __forceinline__ int row(const g8::Unit&, int) const { return 0; }
};
struct BrEpi {
    static constexpr bool TIMEK = PROBE_TIMEK_BrEpi;
    static constexpr bool PERM = true;
    unsigned char* ws;
    __device__ __forceinline__ bool operator()(f32x4 (&acc)[2][2][4][2], const g8::Unit& u, int wr, int wc, int fr, int fq) const {
        const int k = u.x0;
#pragma unroll
        for (int ai = 0; ai < 2; ++ai) {
            uint4 gq[4][2], gn[4][2];
#pragma unroll
            for (int m = 0; m < 4; ++m)
#pragma unroll
                for (int bj = 0; bj < 2; ++bj) {
                    const int row = u.pm * 256 + ai * 128 + wr * 64 + m * 16 + fr, col = u.pn * 256 + bj * 128 + wc * 32 + fq * 8;
                    const unsigned go = (unsigned)(OFF_PGATE + (row * 3072 + k * 1024 + col) * 2);
                    gq[m][bj] = ldg<uint4>(ws, go);
                    gn[m][bj] = (k < 2) ? ldg<uint4>(ws, go + 2048) : uint4{0x3f803f80u, 0x3f803f80u, 0x3f803f80u, 0x3f803f80u};
                }
#pragma unroll
            for (int m = 0; m < 4; ++m)
#pragma unroll
                for (int bj = 0; bj < 2; ++bj) {
                    const int row = u.pm * 256 + ai * 128 + wr * 64 + m * 16 + fr, col = u.pn * 256 + bj * 128 + wc * 32 + fq * 8;
                    const uint4 q = gq[m][bj], nx = gn[m][bj];
                    float s[8] = {bf2f((u16)(q.x & 0xffff)), bf2f((u16)(q.x >> 16)), bf2f((u16)(q.y & 0xffff)), bf2f((u16)(q.y >> 16)),
                                  bf2f((u16)(q.z & 0xffff)), bf2f((u16)(q.z >> 16)), bf2f((u16)(q.w & 0xffff)), bf2f((u16)(q.w >> 16))};
                    s[0] *= __builtin_amdgcn_rcpf(bf2f((u16)(nx.x & 0xffff))); s[1] *= __builtin_amdgcn_rcpf(bf2f((u16)(nx.x >> 16)));
                    s[2] *= __builtin_amdgcn_rcpf(bf2f((u16)(nx.y & 0xffff))); s[3] *= __builtin_amdgcn_rcpf(bf2f((u16)(nx.y >> 16)));
                    s[4] *= __builtin_amdgcn_rcpf(bf2f((u16)(nx.z & 0xffff))); s[5] *= __builtin_amdgcn_rcpf(bf2f((u16)(nx.z >> 16)));
                    s[6] *= __builtin_amdgcn_rcpf(bf2f((u16)(nx.w & 0xffff))); s[7] *= __builtin_amdgcn_rcpf(bf2f((u16)(nx.w >> 16)));
#pragma unroll
                    for (int i = 0; i < 4; ++i) { acc[ai][bj][m][0][i] *= s[i]; acc[ai][bj][m][1][i] *= s[4 + i]; }
                    if (k == 2) stg<uint4>(ws, (unsigned)(OFF_MIXP + (row * 1024 + col) * 2), pack8(acc[ai][bj][m][0], acc[ai][bj][m][1]));
                }
        }
        return k < 2;
    }
};

struct MoeSched {
    const int* sm; const unsigned char* ws; unsigned A, Bexp, Bsh, Ash;
    int c, G, npn, K, bstride_e, gather, nsh;
    __device__ __forceinline__ bool next(int i, g8::Unit& u) const {
        int nbr = __builtin_amdgcn_readfirstlane(sm[64]); asm volatile("" : "+s"(nbr));
        const int L = i * G + c; if (L >= (nbr + nsh) * npn) return false;
        const int blk = L / npn; u.pn = L - blk * npn;
        if (blk >= nbr) {
            u.x0 = 64; u.pm = blk - nbr; u.x1 = NTOK;
            u.A = gather ? A : Ash + (unsigned)u.pm * 256 * K * 2;
            u.B = Bsh + (unsigned)u.pn * 256 * K * 2;
        } else {
            int e = __builtin_amdgcn_readfirstlane(sm[256 + blk]);
            int be = __builtin_amdgcn_readfirstlane(sm[e]), re = __builtin_amdgcn_readfirstlane(sm[65 + e]), ce = __builtin_amdgcn_readfirstlane(sm[130 + e]);
            asm volatile("" : "+s"(e), "+s"(be), "+s"(re), "+s"(ce));
            u.x0 = e; u.pm = blk - be; u.x1 = ce;
            u.A = gather ? A : A + (unsigned)(re + u.pm * 256) * K * 2;
            u.B = Bexp + (unsigned)e * bstride_e + (unsigned)u.pn * 256 * K * 2;
        }
        return true;
    }
    __device__ __forceinline__ int row(const g8::Unit& u, int r) const {
        const int rr = u.pm * 256 + r;
        if (u.x0 == 64) return rr;
        return (rr < u.x1) ? (ldg<int>(ws, (unsigned)(OFF_LIST + (u.x0 * NTOK + rr) * 4)) >> 3) : 0;
    }
};
__device__ __forceinline__ void moe_setup(CParams& p, int* sm) {
    __syncthreads();
    if (threadIdx.x == 0) {
        const int* cursor = (const int*)(p.ws + OFF_CUR);
        int nb = 0, nr = 0;
        for (int e = 0; e < 64; ++e) { sm[e] = nb; sm[65 + e] = nr; int c = cursor[e]; sm[130 + e] = c; nb += (c + 255) >> 8; nr += c; }
        sm[64] = nb; sm[129] = nr;
    }
    __syncthreads();
    if (threadIdx.x < 64) { const int e = threadIdx.x; for (int k = sm[e]; k < sm[e + 1]; ++k) sm[256 + k] = e; }
    __syncthreads();
}
struct Moe1Epi {
    static constexpr bool TIMEK = PROBE_TIMEK_Moe1Epi;
    static constexpr bool PERM = false;
    unsigned char* ws; const int* sm;
    __device__ __forceinline__ bool operator()(f32x4 (&acc)[2][2][4][2], const g8::Unit& u, int wr, int wc, int fr, int fq) const {
        const int rbase = (u.x0 == 64) ? 0 : __builtin_amdgcn_readfirstlane(sm[65 + (u.x0 & 63)]);
        const unsigned hoff = (unsigned)((u.x0 == 64) ? OFF_HSH + (size_t)u.pm * 256 * 256 * 2 : OFF_HBUF + (size_t)(rbase + u.pm * 256) * 256 * 2);
        const int valid = u.x1 - u.pm * 256;
        float rw[2][4];
        const unsigned wb = (unsigned)(OFF_WLIST + ((u.x0 & 63) * NTOK + u.pm * 256 + wr * 64 + fr) * 4);
#pragma unroll
        for (int ai = 0; ai < 2; ++ai)
#pragma unroll
            for (int m = 0; m < 4; ++m) {
                const int r = ai * 128 + wr * 64 + m * 16 + fr;
                rw[ai][m] = (u.x0 != 64 && r < valid) ? ldg<float>(ws, wb + (unsigned)((ai * 128 + m * 16) * 4)) : 1.f;
            }
#pragma unroll
        for (int ai = 0; ai < 2; ++ai)
#pragma unroll
            for (int m = 0; m < 4; ++m) {
                const int r = ai * 128 + wr * 64 + m * 16 + fr;
                const float w = rw[ai][m];
#pragma unroll
                for (int bj = 0; bj < 2; ++bj) {
                    const int hid = ((u.pn * 256 + bj * 128 + wc * 32) >> 1) + fq * 4;
                    const f32x4 a = acc[ai][bj][m][0], b = acc[ai][bj][m][1] * w;
                    uint2 pk;
                    pk.x = g8::cvt_pk_bf16(silu_f(a[0]) * b[0], silu_f(a[1]) * b[1]);
                    pk.y = g8::cvt_pk_bf16(silu_f(a[2]) * b[2], silu_f(a[3]) * b[3]);
                    if (r < valid) stg<uint2>(ws, hoff + (unsigned)(r * 256 + hid) * 2u, pk);
                }
                __builtin_amdgcn_sched_barrier(0);
            }
        return false;
    }
};
__device__ void phase_moe1(CParams& p, int l, char* lds) {
    int* sm = (int*)(lds + g8::STAGE_BYTES);
    moe_setup(p, sm);
    MoeSched S; S.sm = sm; S.ws = p.ws;
    S.A = (unsigned)OFF_XM; S.Ash = S.A; S.Bexp = (unsigned)OFF_EW13; S.Bsh = (unsigned)OFF_SH13T;
    S.c = (blockIdx.x & 7) * 32 + (blockIdx.x >> 3); S.G = gridDim.x; S.npn = 2; S.K = 1024; S.bstride_e = 512 * 1024 * 2; S.gather = 1; S.nsh = 64;
    Moe1Epi E; E.ws = p.ws; E.sm = sm;
    g8::gemm_phase<Moe1Epi, MoeSched, true>((LAS unsigned char*)lds, p.ws, 1024, S, E);
}
struct Moe2Epi {
    static constexpr bool TIMEK = PROBE_TIMEK_Moe2Epi;
    static constexpr bool PERM = true;
    unsigned char* ws;
    __device__ __forceinline__ bool operator()(f32x4 (&acc)[2][2][4][2], const g8::Unit& u, int wr, int wc, int fr, int fq) const {
        const int valid = u.x1 - u.pm * 256;
        const int colb = u.pn * 256 + wc * 32 + fq * 8;
        const unsigned lbase = (unsigned)(OFF_LIST + (u.x0 * NTOK + u.pm * 256 + wr * 64 + fr) * 4);
        int ent[2][4];
#pragma unroll
        for (int ai = 0; ai < 2; ++ai)
#pragma unroll
            for (int m = 0; m < 4; ++m) {
                const int r = ai * 128 + wr * 64 + m * 16 + fr;
                ent[ai][m] = (r < valid) ? ldg<int>(ws, lbase + (unsigned)((ai * 128 + m * 16) * 4)) : 0;
            }
#pragma unroll
        for (int ai = 0; ai < 2; ++ai)
#pragma unroll
            for (int m = 0; m < 4; ++m) {
                const int r = ai * 128 + wr * 64 + m * 16 + fr;
                if (r < valid) {
                    const unsigned o = (unsigned)OFF_YBUF + (unsigned)(ent[ai][m] * 1024 + colb);
#pragma unroll
                    for (int bj = 0; bj < 2; ++bj) {
                        const f32x4 a = acc[ai][bj][m][0] * 32.f, b = acc[ai][bj][m][1] * 32.f;
                        int w0 = __builtin_amdgcn_cvt_pk_fp8_f32(a[0], a[1], 0, false); w0 = __builtin_amdgcn_cvt_pk_fp8_f32(a[2], a[3], w0, true);
                        int w1 = __builtin_amdgcn_cvt_pk_fp8_f32(b[0], b[1], 0, false); w1 = __builtin_amdgcn_cvt_pk_fp8_f32(b[2], b[3], w1, true);
                        stg<uint2>(ws, o + bj * 128, uint2{(unsigned)w0, (unsigned)w1});
                    }
                }
                __builtin_amdgcn_sched_barrier(0);
            }
        return false;
    }
};
struct ShSched {
    int c, G;
    __device__ __forceinline__ bool next(int i, g8::Unit& u) const {
        const int L = i * G + c; if (L >= 64 * 4) return false;
        u.pm = L >> 2; u.pn = L & 3; u.A = (unsigned)OFF_HSH + (unsigned)u.pm * 256 * 256 * 2; u.B = (unsigned)OFF_SH2T + (unsigned)u.pn * 256 * 256 * 2; u.x0 = 64; u.x1 = NTOK; return true;
    }
    __device__ __forceinline__ int row(const g8::Unit&, int) const { return 0; }
};
struct ShEpi {
    static constexpr bool TIMEK = PROBE_TIMEK_ShEpi;
    static constexpr bool PROBE = false;
    static constexpr bool PERM = true;
    unsigned char* ws;
    __device__ __forceinline__ bool operator()(f32x4 (&acc)[2][2][4][2], const g8::Unit& u, int wr, int wc, int fr, int fq) const {
#pragma unroll
        for (int ai = 0; ai < 2; ++ai)
#pragma unroll
            for (int m = 0; m < 4; ++m) {
                const int row = u.pm * 256 + ai * 128 + wr * 64 + m * 16 + fr;
#pragma unroll
                for (int bj = 0; bj < 2; ++bj)
                    stg<uint4>(ws, (unsigned)(OFF_YSH + (row * 1024 + u.pn * 256 + bj * 128 + wc * 32 + fq * 8) * 2), pack8(acc[ai][bj][m][0], acc[ai][bj][m][1]));
                __builtin_amdgcn_sched_barrier(0);
            }
        return false;
    }
};
__device__ void phase_moe2(CParams& p, int l, char* lds) {
    int* sm = (int*)(lds + g8::STAGE_BYTES);
    moe_setup(p, sm);
    MoeSched S; S.sm = sm; S.ws = p.ws;
    S.A = (unsigned)OFF_HBUF; S.Ash = (unsigned)OFF_HSH; S.Bexp = (unsigned)OFF_EW2; S.Bsh = (unsigned)OFF_SH2T;
    S.c = (blockIdx.x & 7) * 32 + (blockIdx.x >> 3); S.G = gridDim.x; S.npn = 4; S.K = 256; S.bstride_e = 1024 * 256 * 2; S.gather = 0; S.nsh = 0;
    Moe2Epi E; E.ws = p.ws;
    g8::gemm_phase<Moe2Epi, MoeSched, false>((LAS unsigned char*)lds, p.ws, 256, S, E);
    ShSched S2; S2.c = (blockIdx.x & 7) * 32 + (blockIdx.x >> 3); S2.G = gridDim.x;
    ShEpi E2; E2.ws = p.ws;
    g8::gemm_phase<ShEpi, ShSched, false>((LAS unsigned char*)lds, p.ws, 256, S2, E2);
}

__device__ void conv_tile(const float* s1, const float* s2, int ldsrc, int K, int perm, u16* dst, int tile, float* lds) {
    const int tid = otid();
    const int ktiles = K >> 6;
    const int kt = tile % ktiles, nt = tile / ktiles;
    hsync();
#pragma unroll 4
    for (int i = 0; i < 16; ++i) {
        int idx = tid + i * 256, kr = idx >> 6, nc = idx & 63;
        const float* s; int col;
        if (perm == 32) { s = (nc < 32) ? s1 : s2; col = nt * 32 + (nc & 31); }
        else if (perm == 16) { s = ((nc & 31) < 16) ? s1 : s2; col = (nt * 2 + (nc >> 5)) * 16 + (nc & 15); }
        else { s = s1; col = nt * 64 + nc; }
        lds[kr * 65 + nc] = s[(size_t)(kt * 64 + kr) * ldsrc + col];
    }
    hsync();
#pragma unroll 4
    for (int i = 0; i < 16; ++i) {
        int idx = tid + i * 256, nr = idx >> 6, kc = idx & 63;
        dst[(size_t)(nt * 64 + nr) * K + kt * 64 + kc] = f2bf(lds[kc * 65 + nr]);
    }
}

__device__ void s5_precompute(CParams& p, int l, int g, int part, float* lds) {
    const int tid = otid();
    float* Er = lds;
    float* Ei = Er + 64 * 17;
    float* Br = Ei + 64 * 17;
    float* Bi = Br + 1024;
    float* Cr = Bi + 1024;
    float* Ci = Cr + 1024;
    float* Kt = Ci + 1024;
    hsync();
    const int lg = l * 32 + g;
    const float dt = expf(p.in[12][lg]);
    {
        const int pp = tid & 63, part = tid >> 6;
        const float ar = p.in[5][lg * 64 + pp], ai = p.in[6][lg * 64 + pp];
        for (int tau = part; tau <= 16; tau += 4) {
            float mag = expf((float)tau * ar * dt);
            float ang = (float)tau * ai * dt;
            Er[pp * 17 + tau] = mag * cosf(ang);
            Ei[pp * 17 + tau] = mag * sinf(ang);
        }
        float mag = expf(ar * dt), ang = ai * dt;
        float e1r = mag * cosf(ang) - 1.f, e1i = mag * sinf(ang);
        float den = ar * ar + ai * ai;
        float qr = (e1r * ar + e1i * ai) / den, qi = (e1i * ar - e1r * ai) / den;
        for (int c = part * 4; c < part * 4 + 4; ++c) {
            float br = p.in[7][((size_t)lg * 64 + pp) * 16 + c], bi = p.in[8][((size_t)lg * 64 + pp) * 16 + c];
            Br[pp * 16 + c] = qr * br - qi * bi;
            Bi[pp * 16 + c] = qr * bi + qi * br;
            Cr[c * 64 + pp] = p.in[9][((size_t)lg * 16 + c) * 64 + pp];
            Ci[c * 64 + pp] = p.in[10][((size_t)lg * 16 + c) * 64 + pp];
        }
    }
    hsync();
    u16* bta = (u16*)(p.ws + OFF_BTA) + (size_t)g * 128 * 256;
    for (int i = part * 16; i < part * 16 + 16; ++i) {
        int idx = tid + i * 256, pr = idx >> 8, k = idx & 255, s = k >> 4, ch = k & 15, pp = pr & 63;
        float er = Er[pp * 17 + 15 - s], ei = Ei[pp * 17 + 15 - s], br = Br[pp * 16 + ch], bi = Bi[pp * 16 + ch];
        float v = (pr < 64) ? (er * br - ei * bi) : (er * bi + ei * br);
        bta[idx] = f2bf(v);
    }
    u16* btc = (u16*)(p.ws + OFF_BTC) + (size_t)g * 256 * 384;
    {
        const int ch = tid >> 4, c2 = tid & 15;
        for (int tt = 0; tt < 2; ++tt) {
            const int tau = part * 2 + tt;
            float s = 0.f;
            for (int pp = 0; pp < 64; ++pp) {
                float cr = Cr[ch * 64 + pp], ci = Ci[ch * 64 + pp], er = Er[pp * 17 + tau], ei = Ei[pp * 17 + tau];
                float gr = cr * er - ci * ei, gi = cr * ei + ci * er;
                s += gr * Br[pp * 16 + c2] - gi * Bi[pp * 16 + c2];
            }
            const u16 kv = f2bf(s);
            for (int j = tau; j < 16; ++j) btc[(size_t)(j * 16 + ch) * 384 + (j - tau) * 16 + c2] = kv;
            if (tau > 0) for (int j = 0; j + tau < 16; ++j) btc[(size_t)(j * 16 + ch) * 384 + (j + tau) * 16 + c2] = 0;
        }
        for (int i = 0; i < 16; ++i) {
            const int idx = tid + i * 256, n = part * 32 + (idx >> 7), pr = idx & 127, pp = pr & 63, j = n >> 4, chn = n & 15;
            float cr = Cr[chn * 64 + pp], ci = Ci[chn * 64 + pp], er = Er[pp * 17 + j + 1], ei = Ei[pp * 17 + j + 1];
            float gr = cr * er - ci * ei, gi = cr * ei + ci * er;
            btc[(size_t)n * 384 + 256 + pr] = f2bf((pr < 64) ? gr : -gi);
        }
    }
}

constexpr int W_CONV_TILES = 2608;
__device__ void phase_w(CParams& p, int l, char* lds) {
    const int tid = otid();
    const int nunits = W_CONV_TILES + 256 + 2 + (l == 0 ? 1024 : 0);
    for (int uu = VB; uu < nunits; uu += VG) {
        const int u = (uu < 256) ? uu + W_CONV_TILES : (uu < W_CONV_TILES + 256 ? uu - 256 : uu);
        if (u < W_CONV_TILES) {
            int t = u;
            const float *s1, *s2 = nullptr; int ld, K, perm = 0; u16* dst;
            if (t < 1664) { s1 = p.in[1] + (size_t)l * DM * INC; ld = INC; K = 1024; dst = (u16*)(p.ws + OFF_WINT); }
            else if ((t -= 1664) < 384) { int k = t >> 7; t &= 127; s1 = p.in[22] + (size_t)(l * 3 + k) * 512 * 1024; ld = 1024; K = 512; dst = (u16*)(p.ws + OFF_WBRT) + (size_t)k * 1024 * 512; }
            else if ((t -= 384) < 256) { s1 = p.in[23] + (size_t)l * 1024 * 1024; ld = 1024; K = 1024; dst = (u16*)(p.ws + OFF_WOUTT); }
            else if ((t -= 256) < 64) { s1 = p.in[13] + (size_t)l * 512 * 512; ld = 512; K = 512; dst = (u16*)(p.ws + OFF_GLUT); }
            else if ((t -= 64) < 32) { int h = t >> 3; t &= 7; s1 = p.in[17] + (size_t)(l * 4 + h) * 128 * 128; s2 = p.in[19] + (size_t)(l * 4 + h) * 128 * 128; ld = 128; K = 128; perm = 32; dst = (u16*)(p.ws + OFF_RGT) + (size_t)h * 256 * 128; }
            else if ((t -= 32) < 128) { s1 = p.in[31] + (size_t)l * 1024 * 256; s2 = p.in[32] + (size_t)l * 1024 * 256; ld = 256; K = 1024; perm = 16; dst = (u16*)(p.ws + OFF_SH13T); }
            else if ((t -= 128) < 64) { s1 = p.in[33] + (size_t)l * 256 * 1024; ld = 1024; K = 256; dst = (u16*)(p.ws + OFF_SH2T); }
            else { t -= 64; s1 = p.in[26] + (size_t)l * 1024 * 64; ld = 64; K = 1024; dst = (u16*)(p.ws + OFF_ROUTT); }
            conv_tile(s1, s2, ld, K, perm, dst, t, (float*)lds);
        } else if (u < W_CONV_TILES + 256) {
            s5_precompute(p, l, (u - W_CONV_TILES) >> 3, (u - W_CONV_TILES) & 7, (float*)lds);
        } else if (u == W_CONV_TILES + 256) {
            float* LB = (float*)(p.ws + OFF_LB);
            for (int c = tid; c < 512; c += 256) {
                float x0 = p.in[3][c], x1 = p.in[3][512 + c];
                LB[c] = (l == 0) ? 0.f : 1.f / (1.f + expf(x0 - x1));
            }
            if (tid < 64) ((int*)(p.ws + OFF_CUR))[tid] = 0;
        } else if (u == W_CONV_TILES + 257) {
        } else {
            int r0 = (u - (W_CONV_TILES + 258)) * 16;
            const float4* src = (const float4*)(p.in[0] + (size_t)r0 * DM);
            uint2* dst = (uint2*)((u16*)(p.ws + OFF_XB) + (size_t)r0 * DM);
            for (int i = tid; i < 16 * 256; i += 256) {
                float4 v = src[i];
                uint2 o; o.x = f2bf(v.x) | ((unsigned)f2bf(v.y) << 16); o.y = f2bf(v.z) | ((unsigned)f2bf(v.w) << 16);
                dst[i] = o;
            }
        }
    }
}

__device__ void hgrn_prep(CParams& p, int u, char* lds) {
    const int tid = otid();
    const int h = u & 3, c = (u >> 2) & 63, b = u >> 8;
    const int r0 = b * SEQ + c * 64;
    const unsigned cu = (unsigned)((b * 4 + h) * 64 + c);
    unsigned char* ws = p.ws;
    float* F = (float*)lds;
    u16* Kb = (u16*)(lds + 32768);
    u16* Vb = (u16*)(lds + 49152);
    hsync();
#pragma unroll
    for (int i = 0; i < 8; ++i) {
        const int id = tid + i * 256, s = id >> 5, d4 = (id & 31) * 4;
        *(f32x4*)(F + s * 128 + d4) = ldg<f32x4>(ws, (unsigned)(OFF_PLF + ((r0 + s) * 512 + h * 128 + d4) * 4));
    }
#pragma unroll
    for (int i = 0; i < 4; ++i) {
        const int id = tid + i * 256, s = id >> 4, d8 = (id & 15) * 8;
        *(uint4*)(Kb + s * 128 + d8) = ldg<uint4>(ws, (unsigned)(OFF_PK + ((r0 + s) * 512 + h * 128 + d8) * 2));
        *(uint4*)(Vb + s * 128 + d8) = ldg<uint4>(ws, (unsigned)(OFF_PV + ((r0 + s) * 512 + h * 128 + d8) * 2));
    }
    hsync();
    {
        const int d = tid & 127, hf = tid >> 7;
        float run = 0.f;
#pragma unroll 8
        for (int s = hf * 32; s < hf * 32 + 32; ++s) { run += F[s * 128 + d]; F[s * 128 + d] = run; }
        hsync();
        if (hf) {
            const float add = F[31 * 128 + d];
#pragma unroll 8
            for (int s = 32; s < 64; ++s) F[s * 128 + d] += add;
        }
    }
    hsync();
#pragma unroll
    for (int i = 0; i < 8; ++i) {
        const int id = tid + i * 256, s = id >> 5, d4 = (id & 31) * 4;
        stg<f32x4>(ws, (unsigned)(OFF_PLF + ((r0 + s) * 512 + h * 128 + d4) * 4), *(const f32x4*)(F + s * 128 + d4));
    }
    if (tid < 128) stg<float>(ws, (unsigned)(OFF_DEC + ((b * 64 + c) * 512 + h * 128 + tid) * 4), __expf(F[63 * 128 + tid]));
    {
        const int d = tid & 127;
        const float btot = F[63 * 128 + d];
#pragma unroll
        for (int i = 0; i < 4; ++i) {
            const int s8 = (tid >> 7) + 2 * i;
            bf16x8 ok, ov;
#pragma unroll
            for (int e = 0; e < 8; ++e) {
                const int s = s8 * 8 + e;
                ok[e] = (short)f2bf(bf2f(Kb[s * 128 + d]) * __expf(btot - F[s * 128 + d]));
                ov[e] = (short)Vb[s * 128 + d];
            }
            stg<bf16x8>(ws, (unsigned)(OFF_KTT + ((cu * 128 + d) * 64 + s8 * 8) * 2), ok);
            stg<bf16x8>(ws, (unsigned)(OFF_VT + ((cu * 128 + d) * 64 + s8 * 8) * 2), ov);
        }
    }
}

__device__ void s5_gemm_a(CParams& p, int u, char* lds) {
    LANE_IDS;
    const int wr = wid >> 1, wc = wid & 1;
    const int g = u >> 3, tm = u & 7, row0 = tm * 128;
    unsigned char* ws = p.ws;
    const unsigned aoff = (unsigned)(OFF_PU + (size_t)g * NTOK * 16 * 2), boff = (unsigned)(OFF_BTA + (size_t)g * 128 * 256 * 2);
    f32x4 acc[4][4]; ZERO_ACC(acc, 4, 4);
    mma_glds<128, 128, 2, 2, true>(acc, 4, ws,
        [&](int r, int t) { return aoff + ((row0 + r) * 256 + t * 64) * 2; },
        [&](int c, int t) { return boff + (c * 256 + t * 64) * 2; }, NoHook(), lds);
    epiT<4, 4, 64, 64>(acc, wr, wc, fq, fr, [&](int r, int cc, const f32x4& v) {
        stg<f32x4>(ws, (unsigned)(OFF_VC + (((row0 + r) * 32 + g) * 128 + cc) * 4), v); });
}

__device__ void rg_conv(CParams& p, int l, int u) {
    const int tid = otid();
    const u16* xr = (const u16*)(p.ws + OFF_PXR);
    u16* xc = (u16*)(p.ws + OFF_XC);
    const float* cw = p.in[15] + (size_t)l * 4 * 512;
    const float* cb = p.in[16] + (size_t)l * 512;
    for (int i = tid; i < 64 * 64; i += 256) {
        const int row = u * 64 + (i >> 6), c8 = (i & 63) * 8;
        const int t = row & (SEQ - 1);
        float a[8];
#pragma unroll
        for (int e = 0; e < 8; ++e) a[e] = cb[c8 + e];
#pragma unroll
        for (int j = 0; j < 4; ++j) {
            if (t - 3 + j >= 0) {
                bf16x8 x = *(const bf16x8*)(xr + (size_t)(row - 3 + j) * 512 + c8);
#pragma unroll
                for (int e = 0; e < 8; ++e) a[e] += cw[j * 512 + c8 + e] * bf2f((u16)x[e]);
            }
        }
        bf16x8 o;
#pragma unroll
        for (int e = 0; e < 8; ++e) o[e] = (short)f2bf(a[e]);
        *(bf16x8*)(xc + (size_t)row * 512 + c8) = o;
    }
}

__device__ void phase2(CParams& p, int l, char* lds) {
    for (int u = VB; u < 1536; u += VG) {
        if (u < 1024) hgrn_prep(p, u, lds);
        else if (u < 1280) s5_gemm_a(p, u - 1024, lds);
        else rg_conv(p, l, u - 1280);
    }
}

__device__ void hgrn_u(CParams& p, int u, char* lds) {
    LANE_IDS;
    const int wr = wid >> 1, wc = wid & 1;
    unsigned char* ws = p.ws;
    f32x4 acc[4][4]; ZERO_ACC(acc, 4, 4);
    mma_glds<128, 128, 2, 2>(acc, 1, ws,
        [&](int r, int t) { return (unsigned)(OFF_KTT + ((u * 128 + r) * 64) * 2); },
        [&](int c, int t) { return (unsigned)(OFF_VT + ((u * 128 + c) * 64) * 2); }, NoHook(), lds);
#pragma unroll
    for (int m = 0; m < 4; ++m) {
#pragma unroll
        for (int n = 0; n < 4; ++n) {
            const int d0 = wr * 64 + m * 16 + fq * 4, v = wc * 64 + n * 16 + fr;
            uint2 o;
            o.x = f2bf(acc[m][n][0]) | ((unsigned)f2bf(acc[m][n][1]) << 16);
            o.y = f2bf(acc[m][n][2]) | ((unsigned)f2bf(acc[m][n][3]) << 16);
            stg<uint2>(ws, (unsigned)(OFF_UT + ((u * 128 + v) * 128 + d0) * 2), o);
        }
        __builtin_amdgcn_sched_barrier(0);
    }
}

__device__ void hgrn_sscan(CParams& p, int item) {
    const int bh = item >> 12, ec = item & 4095, v = ec >> 5, d4 = (ec & 31) * 4;
    const int b = bh >> 2, h = bh & 3;
    unsigned char* ws = p.ws;
    const unsigned ub = (unsigned)(OFF_UT + ((bh * 64 * 128 + v) * 128 + d4) * 2);
    const unsigned sb = (unsigned)(OFF_ST + ((bh * 64 * 128 + v) * 128 + d4) * 2);
    const unsigned db = (unsigned)(OFF_DEC + ((b * 64) * 512 + h * 128 + d4) * 4);
    f32x4 S = {0.f, 0.f, 0.f, 0.f};
    for (int c0 = 0; c0 < 64; c0 += 8) {
        uint2 uu[8]; f32x4 dd[8];
#pragma unroll
        for (int i = 0; i < 8; ++i) { uu[i] = ldg<uint2>(ws, ub + (unsigned)((c0 + i) * 128 * 128 * 2)); dd[i] = ldg<f32x4>(ws, db + (unsigned)((c0 + i) * 512 * 4)); }
#pragma unroll
        for (int i = 0; i < 8; ++i) {
            uint2 o;
            o.x = f2bf(S[0]) | ((unsigned)f2bf(S[1]) << 16); o.y = f2bf(S[2]) | ((unsigned)f2bf(S[3]) << 16);
            stg<uint2>(ws, sb + (unsigned)((c0 + i) * 128 * 128 * 2), o);
            S[0] = dd[i][0] * S[0] + bf2f((u16)(uu[i].x & 0xffff)); S[1] = dd[i][1] * S[1] + bf2f((u16)(uu[i].x >> 16));
            S[2] = dd[i][2] * S[2] + bf2f((u16)(uu[i].y & 0xffff)); S[3] = dd[i][3] * S[3] + bf2f((u16)(uu[i].y >> 16));
        }
    }
}

__device__ void s5_scan(CParams& p, int l, int u, char* lds) {
    const int tid = otid();
    const int b = u >> 5, g = u & 31, seg = tid >> 6, pp = tid & 63;
    const int lg = l * 32 + g;
    const float dt = expf(p.in[12][lg]);
    const float ar = p.in[5][lg * 64 + pp], ai = p.in[6][lg * 64 + pp];
    const float mag = expf(16.f * ar * dt), ang = 16.f * ai * dt;
    const float er = mag * cosf(ang), ei = mag * sinf(ang);
    const float mg2 = expf(1024.f * ar * dt), an2 = 1024.f * ai * dt;
    const float sr = mg2 * cosf(an2), si = mg2 * sinf(an2);
    unsigned char* ws = p.ws;
    const unsigned vb = (unsigned)(OFF_VC + (((b * 256 + seg * 64) * 32 + g) * 128 + pp) * 4);
    const unsigned hb = (unsigned)(OFF_HC + (((b * 256 + seg * 64) * 32 + g) * 128 + pp) * 2);
    float* ex = (float*)lds;
    hsync();
    float hr = 0.f, hi = 0.f;
    for (int c0 = 0; c0 < 64; c0 += 16) {
        float vr[16], vi[16];
#pragma unroll
        for (int i = 0; i < 16; ++i) { vr[i] = ldg<float>(ws, vb + (unsigned)((c0 + i) * 4096 * 4)); vi[i] = ldg<float>(ws, vb + (unsigned)((c0 + i) * 4096 * 4 + 256)); }
#pragma unroll
        for (int i = 0; i < 16; ++i) { const float nr = er * hr - ei * hi + vr[i], ni = er * hi + ei * hr + vi[i]; hr = nr; hi = ni; }
    }
    ex[(seg * 64 + pp) * 2] = hr; ex[(seg * 64 + pp) * 2 + 1] = hi;
    hsync();
    hr = 0.f; hi = 0.f;
    for (int sg = 0; sg < seg; ++sg) {
        const float lr = ex[(sg * 64 + pp) * 2], li = ex[(sg * 64 + pp) * 2 + 1];
        const float nr = sr * hr - si * hi + lr, ni = sr * hi + si * hr + li; hr = nr; hi = ni;
    }
    for (int c0 = 0; c0 < 64; c0 += 16) {
        float vr[16], vi[16];
#pragma unroll
        for (int i = 0; i < 16; ++i) { vr[i] = ldg<float>(ws, vb + (unsigned)((c0 + i) * 4096 * 4)); vi[i] = ldg<float>(ws, vb + (unsigned)((c0 + i) * 4096 * 4 + 256)); }
#pragma unroll
        for (int i = 0; i < 16; ++i) {
            stg<u16>(ws, hb + (unsigned)((c0 + i) * 4096 * 2), f2bf(hr));
            stg<u16>(ws, hb + (unsigned)((c0 + i) * 4096 * 2 + 128), f2bf(hi));
            const float nr = er * hr - ei * hi + vr[i], ni = er * hi + ei * hr + vi[i]; hr = nr; hi = ni;
        }
    }
}

__device__ void rg_gemm(CParams& p, int l, int u, char* lds) {
    LANE_IDS;
    const int wr = wid >> 1, wc = wid & 1;
    const int tm = u >> 3, h = (u >> 1) & 3, nt = u & 1, row0 = tm * 128;
    unsigned char* ws = p.ws;
    const unsigned aoff = (unsigned)(OFF_XC + h * 128 * 2), boff = (unsigned)(OFF_RGT + ((size_t)h * 256 * 128 + (size_t)nt * 128 * 128) * 2);
    f32x4 acc[4][4]; ZERO_ACC(acc, 4, 4);
    mma_glds<128, 128, 2, 2, true>(acc, 2, ws,
        [&](int r, int t) { return aoff + ((row0 + r) * 512 + t * 64) * 2; },
        [&](int c, int t) { return boff + (c * 128 + t * 64) * 2; }, NoHook(), lds);
    const float* ba = p.in[18] + (size_t)l * 512;
    const float* bx = p.in[20] + (size_t)l * 512;
    const float* lam = p.in[21] + (size_t)l * 512;
#pragma unroll
    for (int n = 0; n < 2; ++n) {
        const int ch = h * 128 + (nt * 2 + wc) * 32 + n * 16 + fq * 4;
        const f32x4 lm = *(const f32x4*)(lam + ch), bav = *(const f32x4*)(ba + ch), bxv = *(const f32x4*)(bx + ch);
        f32x4 c1;
#pragma unroll
        for (int i = 0; i < 4; ++i) c1[i] = -8.f * log1pf(expf(-lm[i]));
#pragma unroll
        for (int m = 0; m < 4; ++m) {
            const int row = row0 + wr * 64 + m * 16 + fr;
            const f32x4 x = unpack4(ldg<uint2>(ws, (unsigned)(OFF_XC + (row * 512 + ch) * 2)));
            f32x4 la, bb;
#pragma unroll
            for (int i = 0; i < 4; ++i) {
                const float r = sigm(acc[m][n][i] + bav[i]), ig = sigm(acc[m][n + 2][i] + bxv[i]);
                la[i] = c1[i] * r;
                bb[i] = sqrtf(fmaxf(1.f - __expf(2.f * la[i]), 0.f)) * ig * x[i];
            }
            stg<uint2>(ws, (unsigned)(OFF_LA + (row * 512 + ch) * 2), pack4(la));
            stg<uint2>(ws, (unsigned)(OFF_BB + (row * 512 + ch) * 2), pack4(bb));
        }
    }
}

__device__ void phase3(CParams& p, int l, char* lds) {
    for (int u = VB; u < 2176; u += VG) {
        if (u < 128) s5_scan(p, l, u, lds);
        else if (u < 1152) hgrn_u(p, u - 128, lds);
        else rg_gemm(p, l, u - 1152, lds);
    }
}

__device__ void hgrn_out(CParams& p, int l, int u, char* lds) {
    LANE_IDS;
    const int h = u & 3, c = (u >> 2) & 63, b = u >> 8;
    const int r0 = b * SEQ + c * 64;
    const unsigned cu = (unsigned)((b * 4 + h) * 64 + c);
    unsigned char* ws = p.ws;
    char* F = lds;
    char* Qb = lds + 32768;
    char* Kb = lds + 49152;
    char* Ss = lds + 65536;
    hsync();
#pragma unroll
    for (int i = 0; i < 8; ++i) {
        const int id = tid + i * 256, s = id >> 5, ch = id & 31;
        *(f32x4*)(F + s * 512 + ((ch ^ (s & 31)) << 4)) = ldg<f32x4>(ws, (unsigned)(OFF_PLF + ((r0 + s) * 512 + h * 128 + ch * 4) * 4));
    }
#pragma unroll
    for (int i = 0; i < 4; ++i) {
        const int id = tid + i * 256, s = id >> 4, ch = id & 15;
        *(uint4*)(Qb + s * 256 + ((ch ^ (s & 15)) << 4)) = ldg<uint4>(ws, (unsigned)(OFF_PQ + ((r0 + s) * 512 + h * 128 + ch * 8) * 2));
        *(uint4*)(Kb + s * 256 + ((ch ^ (s & 15)) << 4)) = ldg<uint4>(ws, (unsigned)(OFF_PK + ((r0 + s) * 512 + h * 128 + ch * 8) * 2));
    }
    hsync();
    auto ldF8 = [&](int row, int d0, float (&o)[8]) {
        const int c0 = d0 >> 2;
        const f32x4 x = *(const f32x4*)(F + row * 512 + ((c0 ^ (row & 31)) << 4)), y = *(const f32x4*)(F + row * 512 + (((c0 + 1) ^ (row & 31)) << 4));
        o[0] = x[0]; o[1] = x[1]; o[2] = x[2]; o[3] = x[3]; o[4] = y[0]; o[5] = y[1]; o[6] = y[2]; o[7] = y[3];
    };
    auto ldH8 = [&](const char* base, int row, int d0) { return *(const bf16x8*)(base + row * 256 + (((d0 >> 3) ^ (row & 15)) << 4)); };
    {
        const int i = wid;
        const int t = 16 * i + fr;
        bf16x8 aq[4];
        float refv[4][8];
#pragma unroll
        for (int kk = 0; kk < 4; ++kk) {
            const int d0 = kk * 32 + fq * 8;
            float bt[8];
            ldF8(t, d0, bt);
            if (i == 0) {
#pragma unroll
                for (int e = 0; e < 8; ++e) refv[kk][e] = 0.f;
            } else ldF8(16 * i - 1, d0, refv[kk]);
            const bf16x8 q8 = ldH8(Qb, t, d0);
#pragma unroll
            for (int e = 0; e < 8; ++e) aq[kk][e] = (short)f2bf(bf2f((u16)q8[e]) * __expf(bt[e] - refv[kk][e]));
        }
#pragma unroll
        for (int j = 0; j < 4; ++j) {
            f32x4 sc = {0.f, 0.f, 0.f, 0.f};
            if (j <= i) {
                const int s = 16 * j + fr;
#pragma unroll
                for (int kk = 0; kk < 4; ++kk) {
                    const int d0 = kk * 32 + fq * 8;
                    float bs[8];
                    ldF8(s, d0, bs);
                    const bf16x8 k8 = ldH8(Kb, s, d0);
                    bf16x8 bk;
#pragma unroll
                    for (int e = 0; e < 8; ++e) bk[e] = (short)f2bf(bf2f((u16)k8[e]) * __expf(fminf(refv[kk][e] - bs[e], 60.f)));
                    sc = __builtin_amdgcn_mfma_f32_16x16x32_bf16(aq[kk], bk, sc, 0, 0, 0);
                }
            }
#pragma unroll
            for (int r = 0; r < 4; ++r) {
                const int tl = fq * 4 + r, sl = fr;
                float v = sc[r];
                if (j > i || (j == i && sl > tl)) v = 0.f;
                const int row = 16 * i + tl, col = 16 * j + sl;
                *(u16*)(Ss + row * 128 + (((col >> 3) ^ (row & 7)) << 4) + (col & 7) * 2) = f2bf(v);
            }
        }
    }
    hsync();
    f32x4 acc[8];
#pragma unroll
    for (int n = 0; n < 8; ++n) acc[n] = f32x4{0.f, 0.f, 0.f, 0.f};
    auto bsrc = [&](int t, int id) -> unsigned {
        const int vrow = id >> 3, ch = id & 7;
        return (t < 2) ? (unsigned)(OFF_ST + ((cu * 128 + vrow) * 128 + t * 64 + ch * 8) * 2) : (unsigned)(OFF_VT + ((cu * 128 + vrow) * 64 + ch * 8) * 2);
    };
    uint4 rb[4];
#pragma unroll
    for (int i = 0; i < 4; ++i) rb[i] = ldg<uint4>(ws, bsrc(0, tid + i * 256));
    const int arow = wid * 16 + fr;
#pragma unroll 1
    for (int t = 0; t < 3; ++t) {
#pragma unroll
        for (int i = 0; i < 4; ++i) { const int id = tid + i * 256, vrow = id >> 3, ch = id & 7; *(uint4*)(Kb + vrow * 128 + ((ch ^ ((vrow >> 1) & 7)) << 4)) = rb[i]; }
        hsync();
        if (t < 2) {
#pragma unroll
            for (int i = 0; i < 4; ++i) rb[i] = ldg<uint4>(ws, bsrc(t + 1, tid + i * 256));
        }
#pragma unroll
        for (int ks = 0; ks < 2; ++ks) {
            bf16x8 af;
            if (t < 2) {
                const int d0 = t * 64 + ks * 32 + fq * 8;
                float bq[8];
                ldF8(arow, d0, bq);
                const bf16x8 q8 = ldH8(Qb, arow, d0);
#pragma unroll
                for (int e = 0; e < 8; ++e) af[e] = (short)f2bf(bf2f((u16)q8[e]) * __expf(bq[e]));
            } else {
                af = *(const bf16x8*)(Ss + arow * 128 + (((ks * 4 + fq) ^ (arow & 7)) << 4));
            }
#pragma unroll
            for (int n = 0; n < 8; ++n) {
                const int brow = n * 16 + fr;
                const bf16x8 bfr = *(const bf16x8*)(Kb + brow * 128 + (((ks * 4 + fq) ^ ((brow >> 1) & 7)) << 4));
                acc[n] = __builtin_amdgcn_mfma_f32_16x16x32_bf16(bfr, af, acc[n], 0, 0, 0);
            }
        }
        hsync();
    }
    const float* nw = p.in[4] + (size_t)l * 512 + h * 128;
    {
        float ss = 0.f;
#pragma unroll
        for (int n = 0; n < 8; ++n)
#pragma unroll
            for (int j = 0; j < 4; ++j) ss += acc[n][j] * acc[n][j];
        ss += shfl_xor_l(ss, 16, lane); ss += shfl_xor_l(ss, 32, lane);
        const float rs = rsqrtf(ss * (1.f / 128.f) + 1e-6f);
        const int row = r0 + wid * 16 + fr;
#pragma unroll
        for (int n = 0; n < 8; ++n) {
            const int v = n * 16 + fq * 4;
            const f32x4 w4 = *(const f32x4*)(nw + v);
            const f32x4 g4 = unpack4(ldg<uint2>(ws, (unsigned)(OFF_PG + (row * 512 + h * 128 + v) * 2)));
            f32x4 o;
#pragma unroll
            for (int j = 0; j < 4; ++j) o[j] = acc[n][j] * rs * w4[j] * g4[j];
            stg<uint2>(ws, (unsigned)(OFF_YA + (row * 512 + h * 128 + v) * 2), pack4(o));
        }
    }
}

__device__ void s5_gemm_c(CParams& p, int l, int u, char* lds) {
    LANE_IDS;
    const int wr = wid >> 1, wc = wid & 1;
    const int g = u >> 4, tm = (u >> 1) & 7, tn = u & 1, row0 = tm * 128, col0 = tn * 128;
    unsigned char* ws = p.ws;
    const unsigned aoff = (unsigned)(OFF_PU + (size_t)g * NTOK * 16 * 2), boff = (unsigned)(OFF_BTC + (size_t)g * 256 * 384 * 2);
    f32x4 acc[4][4]; ZERO_ACC(acc, 4, 4);
    mma_glds<128, 128, 2, 2, true>(acc, 6, ws,
        [&](int r, int t) {
            return (t < 4) ? aoff + ((row0 + r) * 256 + t * 64) * 2 : (unsigned)(OFF_HC + (((row0 + r) * 32 + g) * 128 + (t - 4) * 64) * 2);
        },
        [&](int c, int t) { return boff + ((col0 + c) * 384 + t * 64) * 2; }, NoHook(), lds);
    const f32x4 dch = *(const f32x4*)(p.in[11] + (size_t)l * 512 + g * 16 + fq * 4);
    epiT<4, 4, 64, 64>(acc, wr, wc, fq, fr, [&](int r, int cc, const f32x4& v) {
        const int row = row0 + r, col = col0 + cc;
        const int jj = col >> 4, ch = col & 15;
        const int tok = (row >> 8) * SEQ + (row & 255) * 16 + jj;
        const f32x4 uu = unpack4(ldg<uint2>(ws, aoff + (tok * 16 + ch) * 2));
        f32x4 y;
#pragma unroll
        for (int i = 0; i < 4; ++i) y[i] = gelu_f(v[i] + dch[i] * uu[i]);
        stg<uint2>(ws, (unsigned)(OFF_YG + (tok * 512 + g * 16 + ch) * 2), pack4(y)); });
}

__device__ __forceinline__ void bf4(const uint2 q, float (&o)[4]) {
    o[0] = bf2f((u16)(q.x & 0xffff)); o[1] = bf2f((u16)(q.x >> 16)); o[2] = bf2f((u16)(q.y & 0xffff)); o[3] = bf2f((u16)(q.y >> 16));
}
__device__ void rg_local(CParams& p, int item) {
    const int b = item >> 13, seg = (item >> 7) & 63, c4 = (item & 127) * 4;
    unsigned char* ws = p.ws;
    const unsigned base = (unsigned)(((b * SEQ + seg * 64) * 512 + c4) * 2);
    float hh[4] = {0.f, 0.f, 0.f, 0.f}, ap[4] = {1.f, 1.f, 1.f, 1.f};
    for (int s0 = 0; s0 < 64; s0 += 8) {
        uint2 a[8], bb[8];
#pragma unroll
        for (int i = 0; i < 8; ++i) { a[i] = ldg<uint2>(ws, (unsigned)OFF_LA + base + (unsigned)((s0 + i) * 1024)); bb[i] = ldg<uint2>(ws, (unsigned)OFF_BB + base + (unsigned)((s0 + i) * 1024)); }
#pragma unroll
        for (int i = 0; i < 8; ++i) {
            float av[4], bv[4]; bf4(a[i], av); bf4(bb[i], bv);
#pragma unroll
            for (int c = 0; c < 4; ++c) { const float e = __expf(av[c]); hh[c] = e * hh[c] + bv[c]; ap[c] *= e; }
        }
    }
    stg<f32x4>(ws, (unsigned)(OFF_SEGA + ((b * 64 + seg) * 512 + c4) * 4), f32x4{ap[0], ap[1], ap[2], ap[3]});
    stg<f32x4>(ws, (unsigned)(OFF_SEGH + ((b * 64 + seg) * 512 + c4) * 4), f32x4{hh[0], hh[1], hh[2], hh[3]});
}

__device__ void rg_final(CParams& p, int item) {
    const int b = item >> 13, seg = (item >> 7) & 63, c4 = (item & 127) * 4;
    unsigned char* ws = p.ws;
    const unsigned base = (unsigned)(((b * SEQ + seg * 64) * 512 + c4) * 2);
    f32x4 hh = {0.f, 0.f, 0.f, 0.f};
    for (int sg0 = 0; sg0 < seg; sg0 += 8) {
        f32x4 sa[8], sh[8];
#pragma unroll
        for (int i = 0; i < 8; ++i) {
            const int sg = min(sg0 + i, 63);
            sa[i] = ldg<f32x4>(ws, (unsigned)(OFF_SEGA + ((b * 64 + sg) * 512 + c4) * 4));
            sh[i] = ldg<f32x4>(ws, (unsigned)(OFF_SEGH + ((b * 64 + sg) * 512 + c4) * 4));
        }
#pragma unroll
        for (int i = 0; i < 8; ++i) if (sg0 + i < seg) hh = sa[i] * hh + sh[i];
    }
    for (int s0 = 0; s0 < 64; s0 += 8) {
        uint2 a[8], bb[8], xg[8];
#pragma unroll
        for (int i = 0; i < 8; ++i) {
            a[i] = ldg<uint2>(ws, (unsigned)OFF_LA + base + (unsigned)((s0 + i) * 1024));
            bb[i] = ldg<uint2>(ws, (unsigned)OFF_BB + base + (unsigned)((s0 + i) * 1024));
            xg[i] = ldg<uint2>(ws, (unsigned)OFF_PXG + base + (unsigned)((s0 + i) * 1024));
        }
#pragma unroll
        for (int i = 0; i < 8; ++i) {
            float av[4], bv[4], xv[4]; bf4(a[i], av); bf4(bb[i], bv); bf4(xg[i], xv);
#pragma unroll
            for (int c = 0; c < 4; ++c) hh[c] = __expf(av[c]) * hh[c] + bv[c];
            uint2 o; o.x = f2bf(hh[0] * xv[0]) | ((unsigned)f2bf(hh[1] * xv[1]) << 16); o.y = f2bf(hh[2] * xv[2]) | ((unsigned)f2bf(hh[3] * xv[3]) << 16);
            stg<uint2>(ws, (unsigned)OFF_YC + base + (unsigned)((s0 + i) * 1024), o);
        }
    }
}

__device__ void phase4(CParams& p, int l, char* lds) {
    {
        const int tid = otid();
        if (tid < 128) hgrn_sscan(p, VB * 128 + tid);
        else if (tid < 192) rg_local(p, VB * 64 + (tid - 128));
    }
    for (int u = VB; u < 512; u += VG) s5_gemm_c(p, l, u, lds);
}

__device__ void phase_glu(CParams& p, int l, char* lds) {
    LANE_IDS;
    const int wr = wid >> 1, wc = wid & 1;
    unsigned char* ws = p.ws;
    const float* gb = p.in[14] + (size_t)l * 512;
    if (tid < 64) rg_final(p, VB * 64 + tid);
    for (int uu = VB; uu < 1536; uu += VG) {
        if (uu < 1024) { hgrn_out(p, l, uu, lds); continue; }
        const int u = uu - 1024;
        const int row0 = (u >> 2) * 128, col0 = (u & 3) * 128;
        f32x4 acc[4][4]; ZERO_ACC(acc, 4, 4);
        mma_glds<128, 128, 2, 2, true>(acc, 8, ws,
            [&](int r, int t) { return (unsigned)(OFF_YG + ((row0 + r) * 512 + t * 64) * 2); },
            [&](int c, int t) { return (unsigned)(OFF_GLUT + ((col0 + c) * 512 + t * 64) * 2); }, NoHook(), lds);
        epiT<4, 4, 64, 64>(acc, wr, wc, fq, fr, [&](int r, int cc, const f32x4& v) {
            const int row = row0 + r, col = col0 + cc;
            const f32x4 y = unpack4(ldg<uint2>(ws, (unsigned)(OFF_YG + (row * 512 + col) * 2)));
            const f32x4 bb = *(const f32x4*)(gb + col);
            f32x4 o;
#pragma unroll
            for (int i = 0; i < 4; ++i) o[i] = y[i] * sigm(v[i] + bb[i]);
            stg<uint2>(ws, (unsigned)(OFF_YB + (row * 512 + col) * 2), pack4(o)); });
    }
}

__device__ void phase_branch(CParams& p, int l, char* lds) {
    BrSched S; S.c = blockIdx.x;
    BrEpi E; E.ws = p.ws;
    g8::gemm_phase<BrEpi, BrSched, false>((LAS unsigned char*)lds, p.ws, 512, S, E);
}

__device__ void phase_out(CParams& p, int l, char* lds, char* hlds) {
    {
        OutSched S; S.A = (unsigned)OFF_MIXP; S.B = (unsigned)OFF_WOUTT; S.c = blockIdx.x; S.G = gridDim.x;
        OutEpi E; E.ws = p.ws;
        g8::gemm_phase<OutEpi, OutSched, false>((LAS unsigned char*)lds, p.ws, 1024, S, E);
    }
    const int tid = otid();
    float* fl = (float*)hlds;
    for (int u = VB; u < 6144; u += VG) {
        const int e = u / 96, r = u % 96;
        const float *s1, *s2; int ld, K, kp, nt; u16* dst; bool perm;
        if (r < 64) { s1 = p.in[28] + (size_t)(l * 64 + e) * 1024 * 256; s2 = p.in[29] + (size_t)(l * 64 + e) * 1024 * 256; ld = 256; K = 1024; kp = r & 7; nt = r >> 3; perm = true;
                      dst = (u16*)(p.ws + OFF_EW13) + (size_t)e * 512 * 1024; }
        else { s1 = p.in[30] + (size_t)(l * 64 + e) * 256 * 1024; s2 = s1; ld = 1024; K = 256; kp = (r - 64) & 1; nt = (r - 64) >> 1; perm = false;
               dst = (u16*)(p.ws + OFF_EW2) + (size_t)e * 1024 * 256; }
        const int nc = (tid & 15) * 4;
        const float* s = perm ? (((nc & 31) < 16) ? s1 : s2) : s1;
        const int col = perm ? (nt * 2 + (nc >> 5)) * 16 + (nc & 15) : nt * 64 + nc;
        float4 v[8];
#pragma unroll
        for (int i = 0; i < 8; ++i) v[i] = *(const float4*)(s + (size_t)(kp * 128 + (tid >> 4) + 16 * i) * ld + col);
        hsync();
#pragma unroll
        for (int i = 0; i < 8; ++i) { float* d = fl + ((tid >> 4) + 16 * i) * 65 + nc; d[0] = v[i].x; d[1] = v[i].y; d[2] = v[i].z; d[3] = v[i].w; }
        hsync();
#pragma unroll
        for (int j = 0; j < 4; ++j) {
            const int n = tid >> 2, k8 = (tid & 3) * 8 + 32 * j;
            uint4 o;
            o.x = f2bf(fl[(k8 + 0) * 65 + n]) | ((unsigned)f2bf(fl[(k8 + 1) * 65 + n]) << 16);
            o.y = f2bf(fl[(k8 + 2) * 65 + n]) | ((unsigned)f2bf(fl[(k8 + 3) * 65 + n]) << 16);
            o.z = f2bf(fl[(k8 + 4) * 65 + n]) | ((unsigned)f2bf(fl[(k8 + 5) * 65 + n]) << 16);
            o.w = f2bf(fl[(k8 + 6) * 65 + n]) | ((unsigned)f2bf(fl[(k8 + 7) * 65 + n]) << 16);
            *(uint4*)(dst + (size_t)(nt * 64 + n) * K + kp * 128 + k8) = o;
        }
    }
}

__device__ __forceinline__ void ln_row(float (&v)[16], const float* g, const float* bta, int lane) {
    float s = 0.f;
#pragma unroll
    for (int i = 0; i < 16; ++i) s += v[i];
    const float mu = wave_sum(s, lane) * (1.f / 1024.f);
    float q = 0.f;
#pragma unroll
    for (int i = 0; i < 16; ++i) { float d = v[i] - mu; q += d * d; }
    const float rs = rsqrtf(wave_sum(q, lane) * (1.f / 1024.f) + 1e-5f);
#pragma unroll
    for (int i = 0; i < 4; ++i) {
        const float4 gg = *(const float4*)(g + i * 256 + lane * 4), bb = *(const float4*)(bta + i * 256 + lane * 4);
        v[i * 4 + 0] = (v[i * 4 + 0] - mu) * rs * gg.x + bb.x;
        v[i * 4 + 1] = (v[i * 4 + 1] - mu) * rs * gg.y + bb.y;
        v[i * 4 + 2] = (v[i * 4 + 2] - mu) * rs * gg.z + bb.z;
        v[i * 4 + 3] = (v[i * 4 + 3] - mu) * rs * gg.w + bb.w;
    }
}

__device__ void phase_route(CParams& p, int l, char* lds) {
    LANE_IDS;
    const float* Pre = (const float*)(p.ws + OFF_PRELN);
    u16* Xm = (u16*)(p.ws + OFF_XM);
    const float* g1 = p.in[24] + (size_t)l * 1024;
    const float* b1 = p.in[25] + (size_t)l * 1024;
    const float* rbias = p.in[27] + (size_t)l * 64;
    int* cursor = (int*)(p.ws + OFF_CUR);
    int* list = (int*)(p.ws + OFF_LIST);
    float* wlist = (float*)(p.ws + OFF_WLIST);
    float* Ls = (float*)(lds + 32768);
    int* hist = (int*)(lds + 32768 + 64 * 65 * 4);
    int* basep = hist + 64;
    for (int u = VB; u < 512; u += VG) {
        const int row0 = u * 32;
#pragma unroll 1
        for (int hb = 0; hb < 2; ++hb) {
            float v[4][16];
#pragma unroll
            for (int rr = 0; rr < 4; ++rr) {
                const int row = row0 + wid * 8 + hb * 4 + rr;
#pragma unroll
                for (int i = 0; i < 4; ++i) {
                    const float4 x = *(const float4*)(Pre + (size_t)row * 1024 + i * 256 + lane * 4);
                    v[rr][i * 4] = x.x; v[rr][i * 4 + 1] = x.y; v[rr][i * 4 + 2] = x.z; v[rr][i * 4 + 3] = x.w;
                }
            }
#pragma unroll
            for (int rr = 0; rr < 4; ++rr) {
                const int row = row0 + wid * 8 + hb * 4 + rr;
                ln_row(v[rr], g1, b1, lane);
#pragma unroll
                for (int i = 0; i < 4; ++i) {
                    uint2 o; o.x = f2bf(v[rr][i * 4]) | ((unsigned)f2bf(v[rr][i * 4 + 1]) << 16); o.y = f2bf(v[rr][i * 4 + 2]) | ((unsigned)f2bf(v[rr][i * 4 + 3]) << 16);
                    *(uint2*)(Xm + (size_t)row * 1024 + i * 256 + lane * 4) = o;
                }
            }
        }
        if (tid < 64) hist[tid] = 0;
        hsync();
        f32x4 acc[1][2]; ZERO_ACC(acc, 1, 2);
        mma_glds<32, 64, 2, 2>(acc, 16, p.ws,
            [&](int r, int t) { return (unsigned)(OFF_XM + ((row0 + r) * 1024 + t * 64) * 2); },
            [&](int c, int t) { return (unsigned)(OFF_ROUTT + (c * 1024 + t * 64) * 2); }, NoHook(), lds);
#pragma unroll
        for (int n = 0; n < 2; ++n)
#pragma unroll
            for (int j = 0; j < 4; ++j) {
                const int r = (wid >> 1) * 16 + fq * 4 + j, e = (wid & 1) * 32 + n * 16 + fr;
                Ls[r * 65 + e] = sigm(acc[0][n][j]) + rbias[e];
            }
        hsync();
        int myrank[8]; int myexp[8]; float wv[8];
        if (tid < 32) {
            float* sc = Ls + tid * 65;
            float gs[8];
#pragma unroll
            for (int g = 0; g < 8; ++g) {
                float m1 = -1e30f, m2 = -1e30f;
#pragma unroll
                for (int i = 0; i < 8; ++i) { float x = sc[g * 8 + i]; if (x > m1) { m2 = m1; m1 = x; } else if (x > m2) m2 = x; }
                gs[g] = m1 + m2;
            }
            unsigned gmask = 0;
#pragma unroll
            for (int it = 0; it < 4; ++it) {
                float best = -1e30f; int bi = 0;
#pragma unroll
                for (int g = 0; g < 8; ++g) { bool ok = !((gmask >> g) & 1u) && gs[g] > best; if (ok) { best = gs[g]; bi = g; } }
                gmask |= 1u << bi;
            }
            unsigned long long chosen = 0ull;
            float wsum = 0.f;
#pragma unroll
            for (int k = 0; k < 8; ++k) {
                float best = -1e30f; int bi = 0;
                for (int e = 0; e < 64; ++e) {
                    float x = sc[e];
                    bool ok = ((gmask >> (e >> 3)) & 1u) && !((chosen >> e) & 1ull) && x > best;
                    if (ok) { best = x; bi = e; }
                }
                chosen |= 1ull << bi;
                myexp[k] = bi;
                wv[k] = best - rbias[bi];
                wsum += wv[k];
            }
            const float sc_ = 2.5f / wsum;
#pragma unroll
            for (int k = 0; k < 8; ++k) {
                wv[k] *= sc_;
                myrank[k] = atomicAdd(&hist[myexp[k]], 1);
            }
        }
        hsync();
        if (tid < 64) basep[tid] = atomicAdd(&cursor[tid], hist[tid]);
        hsync();
        if (tid < 32) {
#pragma unroll
            for (int k = 0; k < 8; ++k) {
                const size_t pos = (size_t)myexp[k] * NTOK + basep[myexp[k]] + myrank[k];
                list[pos] = (row0 + tid) * 8 + k;
                wlist[pos] = wv[k];
            }
        }
        hsync();
    }
}

__device__ void phase_combine(CParams& p, int l) {
    LANE_IDS;
    typedef float f32x2 __attribute__((ext_vector_type(2)));
    unsigned char* ws = p.ws;
    const float* g2 = p.in[34] + (size_t)l * 1024 + lane * 16;
    const float* b2 = p.in[35] + (size_t)l * 1024 + lane * 16;
    for (int row = VB * 4 + wid; row < NTOK; row += VG * 4) {
        f32x4 y[4]; uint4 xm[2]; u32x4 yb[8];
#pragma unroll
        for (int i = 0; i < 2; ++i) { const uint4 q = ldg<uint4>(ws, (unsigned)(OFF_YSH + (row * 1024 + lane * 16 + i * 8) * 2)); y[i * 2] = unpack4(uint2{q.x, q.y}); y[i * 2 + 1] = unpack4(uint2{q.z, q.w}); }
#pragma unroll
        for (int i = 0; i < 2; ++i) xm[i] = ldg<uint4>(ws, (unsigned)(OFF_XM + (row * 1024 + lane * 16 + i * 8) * 2));
#pragma unroll
        for (int k = 0; k < 8; ++k) yb[k] = ldg<u32x4>(ws, (unsigned)OFF_YBUF + (unsigned)((row * 8 + k) * 1024 + lane * 16));
        float v[16], s[16];
#pragma unroll
        for (int i = 0; i < 16; ++i) s[i] = 0.f;
#pragma unroll
        for (int k = 0; k < 8; ++k)
#pragma unroll
            for (int w = 0; w < 4; ++w) {
                const f32x2 lo = __builtin_amdgcn_cvt_pk_f32_fp8((int)yb[k][w], false), hi = __builtin_amdgcn_cvt_pk_f32_fp8((int)yb[k][w], true);
                s[w * 4 + 0] += lo.x; s[w * 4 + 1] += lo.y; s[w * 4 + 2] += hi.x; s[w * 4 + 3] += hi.y;
            }
#pragma unroll
        for (int i = 0; i < 2; ++i) {
            const uint4 x = xm[i];
            const float xf[8] = {bf2f((u16)(x.x & 0xffff)), bf2f((u16)(x.x >> 16)), bf2f((u16)(x.y & 0xffff)), bf2f((u16)(x.y >> 16)),
                                 bf2f((u16)(x.z & 0xffff)), bf2f((u16)(x.z >> 16)), bf2f((u16)(x.w & 0xffff)), bf2f((u16)(x.w >> 16))};
#pragma unroll
            for (int j = 0; j < 8; ++j) v[i * 8 + j] = y[i * 2 + (j >> 2)][j & 3] + DN_ALPHA * xf[j] + s[i * 8 + j] * (1.f / 32.f);
        }
        float sum = 0.f;
#pragma unroll
        for (int i = 0; i < 16; ++i) sum += v[i];
        const float mu = wave_sum(sum, lane) * (1.f / 1024.f);
        float q = 0.f;
#pragma unroll
        for (int i = 0; i < 16; ++i) { const float d = v[i] - mu; q += d * d; }
        const float rs = rsqrtf(wave_sum(q, lane) * (1.f / 1024.f) + 1e-5f);
#pragma unroll
        for (int i = 0; i < 4; ++i) {
            const f32x4 gg = *(const f32x4*)(g2 + i * 4), bb = *(const f32x4*)(b2 + i * 4);
#pragma unroll
            for (int j = 0; j < 4; ++j) v[i * 4 + j] = (v[i * 4 + j] - mu) * rs * gg[j] + bb[j];
            if (l == 1) stg<f32x4>(p.out, (unsigned)((row * 1024 + lane * 16 + i * 4) * 4), f32x4{v[i * 4], v[i * 4 + 1], v[i * 4 + 2], v[i * 4 + 3]});
        }
#pragma unroll
        for (int i = 0; i < 2; ++i) {
            uint4 o;
            o.x = f2bf(v[i * 8 + 0]) | ((unsigned)f2bf(v[i * 8 + 1]) << 16); o.y = f2bf(v[i * 8 + 2]) | ((unsigned)f2bf(v[i * 8 + 3]) << 16);
            o.z = f2bf(v[i * 8 + 4]) | ((unsigned)f2bf(v[i * 8 + 5]) << 16); o.w = f2bf(v[i * 8 + 6]) | ((unsigned)f2bf(v[i * 8 + 7]) << 16);
            stg<uint4>(ws, (unsigned)(OFF_XB + (row * 1024 + lane * 16 + i * 8) * 2), o);
        }
    }
}


#define XB_TMO      128
#define XB_XCNT(j)  (256  + 64 * (j))
#define XB_XSUB(j)  (1280 + 64 * (j))
#define XB_XGEN(j)  (2304 + 64 * (j))
#define XB_TOP      3328
#define XB_TOPGEN   3392
#define XCD_BAR_WORDS 3456
#define XB_SPIN_CAP (1u << 22)
__device__ __forceinline__ unsigned xb_ld(unsigned* p)              { return __hip_atomic_load(p, __ATOMIC_RELAXED, __HIP_MEMORY_SCOPE_AGENT); }
__device__ __forceinline__ unsigned xb_add(unsigned* p, unsigned v) { return __hip_atomic_fetch_add(p, v, __ATOMIC_RELAXED, __HIP_MEMORY_SCOPE_AGENT); }
__device__ __forceinline__ unsigned xb_xcc_id() { return (unsigned)__builtin_amdgcn_s_getreg((3 << 11) | 20) & 0xFu; }
#define XB_SPIN(cond, bar) do { unsigned _sp = 0; while (cond) { __builtin_amdgcn_s_sleep(1); \
    if ((++_sp & 255u) == 0u) { if (xb_ld(&(bar)[XB_TMO])) break; if (_sp > XB_SPIN_CAP) { atomicAdd(&(bar)[XB_TMO], 1u); break; } } } } while (0)
struct XcdBarrier { unsigned* bar; unsigned x; volatile LAS unsigned* st; };
__device__ __forceinline__ XcdBarrier xcd_barrier_post(unsigned* bar, volatile LAS unsigned* st) {
    XcdBarrier b; b.bar = bar; b.x = xb_xcc_id(); b.st = st;
    if (threadIdx.x == 0) (void)xb_add(&bar[XB_XCNT(b.x)], 1u);
    return b;
}
__device__ __forceinline__ void xcd_barrier_complete(unsigned* bar, unsigned x, unsigned& nloc, unsigned& nx) {
    const unsigned G = gridDim.x * gridDim.y * gridDim.z;
    unsigned sum, cnt, mine, sp = 0u;
    for (;;) {
        sum = 0u; cnt = 0u; mine = 0u;
#pragma unroll
        for (unsigned j = 0; j < 16; ++j) { const unsigned c = xb_ld(&bar[XB_XCNT(j)]); sum += c; cnt += (c > 0u) ? 1u : 0u; mine = (j == x) ? c : mine; }
        if (sum == G) break;
        __builtin_amdgcn_s_sleep(1);
        if ((++sp & 255u) == 0u) { if (xb_ld(&bar[XB_TMO])) break; if (sp > XB_SPIN_CAP) { atomicAdd(&bar[XB_TMO], 1u); break; } }
    }
    nloc = mine > 0u ? mine : 1u; nx = cnt > 0u ? cnt : 1u;
}
__device__ __forceinline__ void xcd_barrier(const XcdBarrier& b) {
    asm volatile("s_waitcnt vmcnt(0)" ::: "memory");
    __syncthreads();
    if (threadIdx.x == 0) {
        unsigned* bar = b.bar;
        __builtin_amdgcn_s_waitcnt(0);
        unsigned nloc = b.st[0], nx = b.st[1];
        if (nloc == 0u) { xcd_barrier_complete(bar, b.x, nloc, nx); b.st[0] = nloc; b.st[1] = nx; }
        const unsigned old = xb_add(&bar[XB_XSUB(b.x)], 1u);
        const unsigned gen = old / nloc;
        if (old + 1u == (gen + 1u) * nloc) {
            __builtin_amdgcn_fence(__ATOMIC_RELEASE, "agent");
            asm volatile("s_waitcnt vmcnt(0)" ::: "memory");
            const unsigned og = xb_add(&bar[XB_TOP], 1u);
            const unsigned tg = og / nx;
            if (og + 1u == (tg + 1u) * nx) xb_add(&bar[XB_TOPGEN], 1u);
            else XB_SPIN(xb_ld(&bar[XB_TOPGEN]) == tg, bar);
            __builtin_amdgcn_fence(__ATOMIC_ACQUIRE, "agent");
            xb_add(&bar[XB_XGEN(b.x)], 1u);
            asm volatile("s_waitcnt vmcnt(0)" ::: "memory");
        } else {
            XB_SPIN(xb_ld(&bar[XB_XGEN(b.x)]) == gen, bar);
            __builtin_amdgcn_fence(__ATOMIC_ACQUIRE, "agent");
            asm volatile("s_waitcnt vmcnt(0)" ::: "memory");
        }
    }
    __syncthreads();
}

__global__ void __launch_bounds__(512, 2) fwd_kernel(Params p_unused) {
    char* lds = g_lds;
    cg::grid_group grid = cg::this_grid();
    CParams* pp = (CParams*)__builtin_amdgcn_kernarg_segment_ptr();
    const int ph_lo = pp->ph_lo;
    volatile LAS unsigned* xst = (volatile LAS unsigned*)(lds + L_XST);
    if (threadIdx.x == 0) { xst[0] = 0u; xst[1] = 0u; *(LAS unsigned*)(lds + 147456 + 16) = 0u; *(LAS unsigned*)(lds + 147456 + 20) = 0u; *(LAS unsigned*)(lds + 147456 + 32) = 0u; }
    __syncthreads();
    const XcdBarrier xb = xcd_barrier_post((unsigned*)(pp->ws + OFF_BAR), xst);
    char* hlds = lds + __builtin_amdgcn_readfirstlane((int)(threadIdx.x >> 8)) * HLDS;
    unsigned long long tq_acc = 0;
    (void)ph_lo;
#pragma unroll
    for (int ph = 0; ph < 2 * NPH; ++ph) {
        asm volatile("" : "+s"(pp));
        CParams& p = *pp;
        const int l = ph / NPH, q = ph % NPH;
        unsigned long long tq0 = 0;
        if (PROBE_TQ >= 0 && q == PROBE_TQ) tq0 = __builtin_amdgcn_s_memrealtime();
#pragma unroll 1
        for (int rep = 0; rep < 1 + (int)((PROBE_MASK >> q) & 1u); ++rep) {
            if (rep) xcd_barrier(xb);
            switch (q) {
                case 0: phase_w(p, l, hlds); break;
                case 1: phase_proj(p, l, lds); break;
                case 2: phase2(p, l, hlds); break;
                case 3: phase3(p, l, hlds); break;
                case 4: phase4(p, l, hlds); break;
                case 5: phase_glu(p, l, hlds); break;
                case 6: phase_branch(p, l, lds); break;
                case 7: phase_out(p, l, lds, hlds); break;
                case 8: phase_route(p, l, hlds); break;
                case 9: phase_moe1(p, l, lds); break;
                case 10: phase_moe2(p, l, lds); break;
                default: phase_combine(p, l); break;
            }
        }
        if (ph + 1 < 2 * NPH) {
            if (p.coop == 1) xcd_barrier(xb);
            else if (p.coop == 2) grid.sync();
        }
        if (PROBE_TQ >= 0 && q == PROBE_TQ) tq_acc += __builtin_amdgcn_s_memrealtime() - tq0;
    }
    if (PROBE_TQ == 98) tq_acc = *(LAS unsigned*)(lds + 147456 + 32);
    if (PROBE_TQ >= 0 && blockIdx.x == 0) {
        const unsigned long long t0 = __builtin_amdgcn_s_memrealtime();
        while (__builtin_amdgcn_s_memrealtime() - t0 < 4ull * tq_acc) __builtin_amdgcn_s_sleep(8);
    }
}

extern "C" void kernel_launch(void* const* d_in, const int* in_sizes, int n_in, void* d_out, int out_size, void* d_ws, size_t ws_size,
                              hipStream_t stream) {
    static int grid_blocks = 0;
    if (!grid_blocks) {
        int dev = 0, cus = 0, per_cu = 0;
        (void)hipGetDevice(&dev);
        (void)hipDeviceGetAttribute(&cus, hipDeviceAttributeMultiprocessorCount, dev);
        (void)hipFuncSetAttribute((const void*)fwd_kernel, hipFuncAttributeMaxDynamicSharedMemorySize, LDS_BYTES);
        (void)hipOccupancyMaxActiveBlocksPerMultiprocessor(&per_cu, fwd_kernel, 512, LDS_BYTES);
        if (per_cu < 1) per_cu = 1;
        per_cu = 1;
        grid_blocks = cus * per_cu;
        if (ws_size < WS_NEED) fprintf(stderr, "kernel_launch: workspace too small: %zu < %zu\n", ws_size, (size_t)WS_NEED);
    }
    Params p{};
    for (int i = 0; i < 36; ++i) p.in[i] = (const float*)d_in[i];
    p.out = (float*)d_out;
    p.ws = (unsigned char*)d_ws;
    p.ph_lo = 0; p.ph_hi = 2 * NPH; p.coop = 1; p.pad = 0;
    (void)hipMemsetAsync((char*)d_ws + OFF_BAR, 0, XCD_BAR_WORDS * 4, stream);
    void* args[] = {&p};
    hipError_t e = hipLaunchCooperativeKernel((void*)fwd_kernel, dim3(grid_blocks), dim3(512), args, LDS_BYTES, stream);
    if (e != hipSuccess) fprintf(stderr, "cooperative launch failed: %s (grid %d)\n", hipGetErrorString(e), grid_blocks);
}
```

```cpp
#include <hip/hip_runtime.h>
#include <hip/hip_cooperative_groups.h>
#include <cstdio>
#include <cstdint>
namespace cg = cooperative_groups;

typedef unsigned short u16;
typedef __attribute__((ext_vector_type(8))) short bf16x8;
typedef __attribute__((ext_vector_type(4))) float f32x4;
typedef __attribute__((ext_vector_type(4))) unsigned u32x4;
#define LAS __attribute__((address_space(3)))

constexpr int NTOK = 16384, DM = 1024, SEQ = 4096, BW = 512, INC = 6656;
constexpr int NE = 64, EH = 256;
#ifndef PROBE_MASK
#define PROBE_MASK 0u
#endif
#define PROBE_TIMEK_ProjEpi false
#define PROBE_TIMEK_OutEpi false
#define PROBE_TIMEK_BrEpi false
#define PROBE_TIMEK_Moe1Epi false
#define PROBE_TIMEK_Moe2Epi false
#define PROBE_TIMEK_ShEpi false
#define PROBE_TQ -1
constexpr int NPH = 12;
constexpr float DN_ALPHA = 1.4142135623730951f;
constexpr size_t SLOT = 16777216ull;

constexpr size_t OFF_WINT  = 0;
constexpr size_t OFF_WBRT  = 13631488;
constexpr size_t OFF_WOUTT = 16777216;
constexpr size_t OFF_GLUT  = 18874368;
constexpr size_t OFF_RGT   = 19398656;
constexpr size_t OFF_SH13T = 19660800;
constexpr size_t OFF_SH2T  = 20709376;
constexpr size_t OFF_BTA   = 21233664;
constexpr size_t OFF_BTC   = 23330816;
constexpr size_t OFF_ROUTT = 29622272;
constexpr size_t OFF_MISC  = 29753344;
constexpr size_t OFF_LB    = OFF_MISC;
constexpr size_t OFF_CUR   = OFF_MISC + 2048;
constexpr size_t OFF_DEC   = OFF_MISC + 4096;
constexpr size_t OFF_SEGA  = OFF_DEC + 524288;
constexpr size_t OFF_SEGH  = OFF_SEGA + 524288;
constexpr size_t OFF_XB    = 2 * SLOT;
constexpr size_t OFF_VC    = 29 * SLOT;
constexpr size_t OFF_XC    = 30 * SLOT;
constexpr size_t OFF_MIXP  = 30 * SLOT;
constexpr size_t OFF_LIST  = 2 * SLOT;
constexpr size_t OFF_HSH   = 2 * SLOT + 4194304;
constexpr size_t OFF_WLIST = 2 * SLOT + 4194304 + 8388608;
constexpr size_t OFF_PQ    = 4 * SLOT;
constexpr size_t OFF_PLF   = 5 * SLOT;
constexpr size_t OFF_PK    = 7 * SLOT;
constexpr size_t OFF_PV    = 8 * SLOT;
constexpr size_t OFF_YC    = 8 * SLOT;
constexpr size_t OFF_PG    = 9 * SLOT;
constexpr size_t OFF_PU    = 10 * SLOT;
constexpr size_t OFF_PXG   = 11 * SLOT;
constexpr size_t OFF_PXR   = 12 * SLOT;
constexpr size_t OFF_YB    = 12 * SLOT;
constexpr size_t OFF_PGATE = 13 * SLOT;
constexpr size_t OFF_KTT   = 19 * SLOT;
constexpr size_t OFF_YA    = 19 * SLOT;
constexpr size_t OFF_VT    = 20 * SLOT;
constexpr size_t OFF_ST    = 21 * SLOT;
constexpr size_t OFF_LA    = 23 * SLOT;
constexpr size_t OFF_BB    = 24 * SLOT;
constexpr size_t OFF_YG    = 25 * SLOT;
constexpr size_t OFF_HC    = 26 * SLOT;
constexpr size_t OFF_UT    = 27 * SLOT;
constexpr size_t OFF_PRELN = 4 * SLOT;
constexpr size_t OFF_XM    = 8 * SLOT;
constexpr size_t OFF_EW13  = 10 * SLOT;
constexpr size_t OFF_EW2   = 14 * SLOT;
constexpr size_t OFF_HBUF  = 4 * SLOT;
constexpr size_t OFF_YBUF  = 16 * SLOT;
constexpr size_t OFF_YSH   = 24 * SLOT;
constexpr size_t OFF_BAR   = 32 * SLOT;
constexpr int HLDS = 73728;
constexpr int LDS_BYTES = 2 * HLDS + 64;
constexpr int L_XST = 2 * HLDS;
constexpr size_t WS_NEED   = 32 * SLOT + 16384;

struct Params {
    const float* in[36];
    float* out;
    unsigned char* ws;
    int ph_lo, ph_hi;
    int coop, pad;
};
typedef const __attribute__((address_space(4))) Params CParams;

__device__ __forceinline__ u16 f2bf(float f) {
    unsigned u = __builtin_bit_cast(unsigned, f);
    return (u16)((u + 0x7fffu + ((u >> 16) & 1u)) >> 16);
}
__device__ __forceinline__ float bf2f(u16 h) { return __builtin_bit_cast(float, (unsigned)h << 16); }
__device__ __forceinline__ float sigm(float x) { return __builtin_amdgcn_rcpf(1.f + __expf(-x)); }
__device__ __forceinline__ float silu_f(float x) { return x * sigm(x); }
__device__ __forceinline__ float gelu_f(float x) {
    float u = 0.7978845608028654f * (x + 0.044715f * x * x * x);
    float t = 1.f - 2.f * __builtin_amdgcn_rcpf(1.f + __expf(2.f * u));
    return 0.5f * x * (1.f + t);
}
__device__ __forceinline__ float shfl_xor_l(float v, int o, int lane) {
    return __builtin_bit_cast(float, __builtin_amdgcn_ds_bpermute((lane ^ o) << 2, __builtin_bit_cast(int, v)));
}
__device__ __forceinline__ float wave_sum(float v, int lane) {
    (void)lane;
    v += __builtin_bit_cast(float, __builtin_amdgcn_update_dpp(0, __builtin_bit_cast(int, v), 0xB1, 0xF, 0xF, true));
    v += __builtin_bit_cast(float, __builtin_amdgcn_update_dpp(0, __builtin_bit_cast(int, v), 0x4E, 0xF, 0xF, true));
    v += __builtin_bit_cast(float, __builtin_amdgcn_update_dpp(0, __builtin_bit_cast(int, v), 0x124, 0xF, 0xF, true));
    v += __builtin_bit_cast(float, __builtin_amdgcn_update_dpp(0, __builtin_bit_cast(int, v), 0x128, 0xF, 0xF, true));
    const float s0 = __builtin_bit_cast(float, __builtin_amdgcn_readlane(__builtin_bit_cast(int, v), 0));
    const float s1 = __builtin_bit_cast(float, __builtin_amdgcn_readlane(__builtin_bit_cast(int, v), 16));
    const float s2 = __builtin_bit_cast(float, __builtin_amdgcn_readlane(__builtin_bit_cast(int, v), 32));
    const float s3 = __builtin_bit_cast(float, __builtin_amdgcn_readlane(__builtin_bit_cast(int, v), 48));
    return (s0 + s1) + (s2 + s3);
}
__device__ __forceinline__ int swz(int row, int ch) { return row * 128 + ((ch ^ ((row >> 1) & 7)) << 4); }


template <class T> __device__ __forceinline__ T ldg(const void* base, unsigned off) { return *(const T*)((const char*)base + off); }
template <class T> __device__ __forceinline__ void stg(void* base, unsigned off, T v) { *(T*)((char*)base + off) = v; }
template <class T> __device__ __forceinline__ void stg_nt(void* base, unsigned off, T v) { __builtin_nontemporal_store(v, (T*)((char*)base + off)); }

template <int TM, int TN, int RW, int CW, class F>
__device__ __forceinline__ void epi(f32x4 (&acc)[TM][TN], int wr, int wc, int fq, int fr, F f) {
#pragma unroll
    for (int m = 0; m < TM; ++m) {
#pragma unroll
        for (int j = 0; j < 4; ++j) {
#pragma unroll
            for (int n = 0; n < TN; ++n) f(wr * RW + m * 16 + fq * 4 + j, wc * CW + n * 16 + fr, acc[m][n][j]);
        }
        __builtin_amdgcn_sched_barrier(0);
    }
}

template <int TM, int TN, int RW, int CW, class F>
__device__ __forceinline__ void epiT(f32x4 (&acc)[TM][TN], int wr, int wc, int fq, int fr, F f) {
#pragma unroll
    for (int m = 0; m < TM; ++m) {
#pragma unroll
        for (int n = 0; n < TN; ++n) f(wr * RW + m * 16 + fr, wc * CW + n * 16 + fq * 4, acc[m][n]);
    }
}
__device__ __forceinline__ uint2 pack4(const f32x4& a) {
    uint2 w; w.x = f2bf(a[0]) | ((unsigned)f2bf(a[1]) << 16); w.y = f2bf(a[2]) | ((unsigned)f2bf(a[3]) << 16); return w;
}
__device__ __forceinline__ f32x4 unpack4(const uint2 q) {
    return f32x4{bf2f((u16)(q.x & 0xffff)), bf2f((u16)(q.x >> 16)), bf2f((u16)(q.y & 0xffff)), bf2f((u16)(q.y >> 16))};
}

extern __shared__ __attribute__((aligned(16))) char g_lds[];
__device__ __forceinline__ void hsync() {
    asm volatile("s_waitcnt vmcnt(0) lgkmcnt(0)" ::: "memory");
    LAS unsigned* ctr = (LAS unsigned*)(g_lds + 2 * 73728 + 16) + __builtin_amdgcn_readfirstlane((int)(threadIdx.x >> 8));
    unsigned old = 0;
    if (__builtin_amdgcn_mbcnt_hi(~0u, __builtin_amdgcn_mbcnt_lo(~0u, 0u)) == 0) old = __hip_atomic_fetch_add(ctr, 1u, __ATOMIC_RELAXED, __HIP_MEMORY_SCOPE_WORKGROUP);
    old = __builtin_amdgcn_readfirstlane(old);
    const unsigned target = (old & ~3u) + 4u;
    while (__hip_atomic_load(ctr, __ATOMIC_RELAXED, __HIP_MEMORY_SCOPE_WORKGROUP) < target) __builtin_amdgcn_s_sleep(1);
    asm volatile("" ::: "memory");
}

__device__ __forceinline__ int otid() { int t = threadIdx.x & 255; asm volatile("" : "+v"(t)); return t; }
#define VB ((int)blockIdx.x * 2 + __builtin_amdgcn_readfirstlane((int)(threadIdx.x >> 8)))
#define VG ((int)gridDim.x * 2)

struct NoHook { __device__ __forceinline__ void operator()(int) const {} };

template <int BM, int BN, int WM, int WN, bool TR = false, class AL, class BL, class HK>
__device__ __forceinline__ void mma_loop(f32x4 (&acc)[BM / WM / 16][BN / WN / 16], int nk, AL aload, BL bload, HK hook, char* lds) {
    constexpr int TM = BM / WM / 16, TN = BN / WN / 16;
    constexpr int ACH = BM / 32, BCH = BN / 32;
    const int tid = otid(), lane = tid & 63, wid = tid >> 6;
    const int wr = wid / WN, wc = wid % WN, fr = lane & 15, fq = lane >> 4;
    const int srow = tid >> 3, sk = (tid & 7) * 8;
    const int swr = srow * 128 + (((tid & 7) ^ ((tid >> 4) & 7)) << 4);
    const int xr = (fr >> 1) & 7;
    const int a_rd = (wr * (BM / WM) + fr) * 128;
    const int b_rd = BM * 128 + (wc * (BN / WN) + fr) * 128;
    bf16x8 ra[ACH], rb[BCH];
#pragma unroll
    for (int i = 0; i < ACH; ++i) ra[i] = aload(srow + i * 32, sk);
#pragma unroll
    for (int i = 0; i < BCH; ++i) rb[i] = bload(srow + i * 32, sk);
#pragma unroll 1
    for (int t = 0; t < nk; ++t) {
        hsync();
#pragma unroll
        for (int i = 0; i < ACH; ++i) *(bf16x8*)(lds + swr + i * 4096) = ra[i];
#pragma unroll
        for (int i = 0; i < BCH; ++i) *(bf16x8*)(lds + BM * 128 + swr + i * 4096) = rb[i];
        hsync();
        if (t + 1 < nk) {
#pragma unroll
            for (int i = 0; i < ACH; ++i) ra[i] = aload(srow + i * 32, (t + 1) * 64 + sk);
#pragma unroll
            for (int i = 0; i < BCH; ++i) rb[i] = bload(srow + i * 32, (t + 1) * 64 + sk);
        }
        hook(t);
#pragma unroll
        for (int ks = 0; ks < 2; ++ks) {
            const int co = ((ks * 4 + fq) ^ xr) << 4;
            bf16x8 af[TM], bfr[TN];
#pragma unroll
            for (int m = 0; m < TM; ++m) af[m] = *(const bf16x8*)(lds + a_rd + m * 2048 + co);
#pragma unroll
            for (int n = 0; n < TN; ++n) bfr[n] = *(const bf16x8*)(lds + b_rd + n * 2048 + co);
#pragma unroll
            for (int m = 0; m < TM; ++m)
#pragma unroll
                for (int n = 0; n < TN; ++n) acc[m][n] = TR ? __builtin_amdgcn_mfma_f32_16x16x32_bf16(bfr[n], af[m], acc[m][n], 0, 0, 0)
                                                            : __builtin_amdgcn_mfma_f32_16x16x32_bf16(af[m], bfr[n], acc[m][n], 0, 0, 0);
        }
    }
}

template <int BM, int BN, int WM, int WN, bool TR = false, class AO, class BO, class HK>
__device__ __forceinline__ void mma_glds(f32x4 (&acc)[BM / WM / 16][BN / WN / 16], int nk, const unsigned char* ws, AO aoff, BO boff, HK hook, char* lds) {
    constexpr int TM = BM / WM / 16, TN = BN / WN / 16;
    constexpr int ACH = BM / 32, BCH = BN / 32, BUF = (BM + BN) * 128;
    const int tid = otid(), lane = tid & 63, wid = tid >> 6;
    const int wr = wid / WN, wc = wid % WN, fr = lane & 15, fq = lane >> 4;
    const int srow = tid >> 3;
    const unsigned csrc = (unsigned)(((tid & 7) ^ ((tid >> 4) & 7)) << 4);
    const int xr = (fr >> 1) & 7;
    const int a_rd = (wr * (BM / WM) + fr) * 128;
    const int b_rd = BM * 128 + (wc * (BN / WN) + fr) * 128;
    auto stage = [&](int buf, int t) {
        char* d = lds + buf * BUF + tid * 16;
#pragma unroll
        for (int i = 0; i < ACH; ++i)
            __builtin_amdgcn_global_load_lds((const unsigned*)(ws + (aoff(srow + i * 32, t) + csrc)), (unsigned*)(d + i * 4096), 16, 0, 0);
#pragma unroll
        for (int i = 0; i < BCH; ++i)
            __builtin_amdgcn_global_load_lds((const unsigned*)(ws + (boff(srow + i * 32, t) + csrc)), (unsigned*)(d + BM * 128 + i * 4096), 16, 0, 0);
    };
    hsync();
    stage(0, 0);
#pragma unroll 1
    for (int t = 0; t < nk; ++t) {
        asm volatile("s_waitcnt vmcnt(0)" ::: "memory");
        hsync();
        if (t + 1 < nk) stage((t + 1) & 1, t + 1);
        hook(t);
        const char* bb = lds + (t & 1) * BUF;
#pragma unroll
        for (int ks = 0; ks < 2; ++ks) {
            const int co = ((ks * 4 + fq) ^ xr) << 4;
            bf16x8 af[TM], bfr[TN];
#pragma unroll
            for (int m = 0; m < TM; ++m) af[m] = *(const bf16x8*)(bb + a_rd + m * 2048 + co);
#pragma unroll
            for (int n = 0; n < TN; ++n) bfr[n] = *(const bf16x8*)(bb + b_rd + n * 2048 + co);
#pragma unroll
            for (int m = 0; m < TM; ++m)
#pragma unroll
                for (int n = 0; n < TN; ++n) acc[m][n] = TR ? __builtin_amdgcn_mfma_f32_16x16x32_bf16(bfr[n], af[m], acc[m][n], 0, 0, 0)
                                                            : __builtin_amdgcn_mfma_f32_16x16x32_bf16(af[m], bfr[n], acc[m][n], 0, 0, 0);
        }
    }
}

#define ZERO_ACC(acc, TM, TN) _Pragma("unroll") for (int m_ = 0; m_ < TM; ++m_) _Pragma("unroll") for (int n_ = 0; n_ < TN; ++n_) acc[m_][n_] = f32x4{0.f, 0.f, 0.f, 0.f}

#define LANE_IDS const int tid = otid(), lane = tid & 63, wid = tid >> 6, fr = lane & 15, fq = lane >> 4; (void)tid; (void)lane; (void)wid; (void)fr; (void)fq

namespace g8 {
constexpr int BM = 256, BK = 64, HALF = 128, HTB = HALF * BK * 2, STAGE_BYTES = 8 * HTB;
__device__ __forceinline__ int lds_byte(int r, int c) { const int st = (r >> 4) * 2 + (c >> 5), rr = r & 15, cc = c & 31, ob = rr * 64 + cc * 2; return st * 1024 + (ob ^ (((ob >> 9) & 1) << 5)); }
__device__ __forceinline__ void stage_rc(int b, int& R, int& C) { const int st = b / 1024, sb = b % 1024, swz = sb ^ (((sb >> 9) & 1) << 5); R = (st >> 1) * 16 + swz / 64; C = (st & 1) * 32 + (swz % 64) / 2; }
__device__ __forceinline__ int perm32(int rho) { const int n = rho >> 4, i = rho & 15; return 8 * (i >> 2) + 4 * n + (i & 3); }
struct Unit { unsigned A, B; int pm, pn, x0, x1; };
__device__ __forceinline__ unsigned cvt_pk_bf16(float lo, float hi) { unsigned r; asm volatile("v_cvt_pk_bf16_f32 %0, %1, %2" : "=v"(r) : "v"(lo), "v"(hi)); return r; }

template <class Epi, class Sched, bool GATHER>
__device__ __forceinline__ void gemm_phase(LAS unsigned char* lds, const unsigned char* wsb, const int K, const Sched& S, const Epi& E) {
    int tid_ = threadIdx.x; asm volatile("" : "+v"(tid_));
    const int tid = tid_, wid = __builtin_amdgcn_readfirstlane(tid >> 6), lane = tid & 63, wr = wid >> 2, wc = wid & 3, fr = lane & 15, fq = lane >> 4;
    const int nt = K / BK;
    unsigned voffA[2], voffB[2];
#pragma unroll
    for (int i = 0; i < 2; ++i) { int R, C; stage_rc(tid * 16 + i * 8192, R, C); const int Rb = Epi::PERM ? ((R & ~31) + perm32(R & 31)) : R;
        voffA[i] = (unsigned)(R * K + C) * 2u; voffB[i] = (unsigned)(Rb * K + C) * 2u; }
    const unsigned kstep = (unsigned)(BK * 2);
    const unsigned hstep = (unsigned)(HALF * K * 2);
    const unsigned ldsw = (unsigned)wid * 1024u;
    const int aoff = lds_byte(wr * 64 + fr, fq * 8), boff = lds_byte(wc * 32 + fr, fq * 8);
#define G8_SA(b, h) (((b) * 2 + (h)) * HTB)
#define G8_SB(b, h) ((4 + (b) * 2 + (h)) * HTB)
#define G8_STAGE(bufoff, gbase, voff) do { _Pragma("unroll") for (int _i = 0; _i < 2; ++_i) \
        __builtin_amdgcn_global_load_lds((const unsigned*)(wsb + (unsigned)((gbase) + (voff)[_i])), (LAS unsigned*)(lds + (bufoff) + ldsw + _i * 8192), 16, 0, 0); } while (0)
#define G8_STAGE_A(bufoff, kp, h, vg) do { if (GATHER) G8_STAGE(bufoff, kp, vg[h]); else G8_STAGE(bufoff, (kp) + (h) * hstep, voffA); } while (0)
#define G8_LDA(dst, b, h) do { _Pragma("unroll") for (int m = 0; m < 4; ++m) _Pragma("unroll") for (int k = 0; k < 2; ++k) dst[m][k] = *(const LAS bf16x8*)(lds + G8_SA(b, h) + aoff + m * 2048 + k * 1024); } while (0)
#define G8_LDB(dst, b, h) do { _Pragma("unroll") for (int n = 0; n < 2; ++n) _Pragma("unroll") for (int k = 0; k < 2; ++k) dst[n][k] = *(const LAS bf16x8*)(lds + G8_SB(b, h) + boff + n * 2048 + k * 1024); } while (0)
#define G8_MMA(ai, bj, At, Bt) do { __builtin_amdgcn_s_setprio(1); _Pragma("unroll") for (int m = 0; m < 4; ++m) _Pragma("unroll") for (int n = 0; n < 2; ++n) _Pragma("unroll") for (int k = 0; k < 2; ++k) \
        acc[ai][bj][m][n] = __builtin_amdgcn_mfma_f32_16x16x32_bf16(Bt[n][k], At[m][k], acc[ai][bj][m][n], 0, 0, 0); __builtin_amdgcn_s_setprio(0); } while (0)
#define G8_WAIT_V(n) asm volatile("s_waitcnt vmcnt(" #n ")" ::: "memory")
#define G8_WAIT_L(n) asm volatile("s_waitcnt lgkmcnt(" #n ")" ::: "memory")
#define G8_BAR __builtin_amdgcn_s_barrier()
#define G8_SCHED __builtin_amdgcn_sched_barrier(0)
#define G8_GOFF(dst, u) do { _Pragma("unroll") for (int _i = 0; _i < 2; ++_i) { int _R, _C; stage_rc(tid * 16 + _i * 8192, _R, _C); \
        _Pragma("unroll") for (int _h = 0; _h < 2; ++_h) dst[_h][_i] = (unsigned)(S.row(u, _h * HALF + _R) * K + _C) * 2u; } \
        asm volatile("" : "+v"(dst[0][0]), "+v"(dst[0][1]), "+v"(dst[1][0]), "+v"(dst[1][1])); } while (0)
    Unit cur, nxt; int ui = 0;
    if (!S.next(0, cur)) return;
    f32x4 acc[2][2][4][2];
#pragma unroll
    for (int a = 0; a < 2; ++a)
#pragma unroll
        for (int b = 0; b < 2; ++b)
#pragma unroll
            for (int m = 0; m < 4; ++m)
#pragma unroll
                for (int n = 0; n < 2; ++n) acc[a][b][m][n] = (f32x4){0.f, 0.f, 0.f, 0.f};
    bf16x8 At[4][2], B0[2][2], B1[2][2];
    unsigned vgc[2][2] = {{0u, 0u}, {0u, 0u}};
    LAS u32x4* gslot = (LAS u32x4*)(lds + STAGE_BYTES + 4096) + tid;
    unsigned cA = cur.A, cB = cur.B;
    if (GATHER) { G8_GOFF(vgc, cur); }
    G8_STAGE(G8_SB(0, 0), cB, voffB); G8_STAGE_A(G8_SA(0, 0), cA, 0, vgc); G8_STAGE(G8_SB(0, 1), cB + hstep, voffB); G8_STAGE_A(G8_SA(0, 1), cA, 1, vgc);
    if (wr == 1) G8_BAR;
    G8_WAIT_V(4); G8_BAR;
    G8_STAGE(G8_SB(1, 0), cB + kstep, voffB); G8_STAGE_A(G8_SA(1, 0), cA + kstep, 0, vgc); G8_STAGE(G8_SB(1, 1), cB + hstep + kstep, voffB);
    G8_WAIT_V(6); G8_BAR;
    for (;;) {
        const bool has_next = S.next(ui + 1, nxt);
        const unsigned nA = has_next ? nxt.A : cA, nB = has_next ? nxt.B : cB;
        if (GATHER && has_next) {
            unsigned vt[2][2]; G8_GOFF(vt, nxt);
            *gslot = u32x4{vt[0][0], vt[0][1], vt[1][0], vt[1][1]};
        }
        unsigned long long tk0 = 0;
        if (Epi::TIMEK) tk0 = __builtin_amdgcn_s_memrealtime();
#pragma unroll 1
        for (int t = 0; t < nt; t += 2) {
            const bool last = (t == nt - 2);
            const unsigned a1 = cA + (unsigned)(t + 1) * kstep;
            const unsigned a2 = last ? nA : cA + (unsigned)(t + 2) * kstep, b2 = last ? nB : cB + (unsigned)(t + 2) * kstep;
            const unsigned a3 = a2 + kstep, b3 = b2 + kstep;
            G8_LDB(B0, 0, 0); G8_SCHED; G8_LDA(At, 0, 0); G8_STAGE_A(G8_SA(1, 1), a1, 1, vgc);
            G8_WAIT_L(8); G8_BAR; G8_WAIT_L(0); G8_MMA(0, 0, At, B0); G8_BAR; G8_SCHED;
            G8_LDB(B1, 0, 1);
            if (GATHER && last && has_next) { const u32x4 x = *gslot; vgc[0][0] = x[0]; vgc[0][1] = x[1]; vgc[1][0] = x[2]; vgc[1][1] = x[3]; }
            G8_STAGE(G8_SB(0, 0), b2, voffB);
            G8_BAR; G8_WAIT_L(0); G8_MMA(0, 1, At, B1); G8_BAR;
            G8_LDA(At, 0, 1); G8_STAGE_A(G8_SA(0, 0), a2, 0, vgc);
            G8_BAR; G8_WAIT_L(0); G8_MMA(1, 0, At, B0); G8_BAR; G8_SCHED;
            G8_STAGE(G8_SB(0, 1), b2 + hstep, voffB);
            G8_WAIT_V(6); G8_BAR; G8_MMA(1, 1, At, B1); G8_BAR;
            G8_LDB(B0, 1, 0); G8_SCHED; G8_LDA(At, 1, 0); G8_STAGE_A(G8_SA(0, 1), a2, 1, vgc);
            G8_WAIT_L(8); G8_BAR; G8_WAIT_L(0); G8_MMA(0, 0, At, B0); G8_BAR; G8_SCHED;
            G8_LDB(B1, 1, 1); G8_STAGE(G8_SB(1, 0), b3, voffB);
            G8_BAR; G8_WAIT_L(0); G8_MMA(0, 1, At, B1); G8_BAR;
            G8_LDA(At, 1, 1); G8_STAGE_A(G8_SA(1, 0), a3, 0, vgc);
            G8_BAR; G8_WAIT_L(0); G8_MMA(1, 0, At, B0); G8_BAR; G8_SCHED;
            G8_STAGE(G8_SB(1, 1), b3 + hstep, voffB);
            G8_WAIT_V(6); G8_BAR; G8_MMA(1, 1, At, B1); G8_BAR;
        }
        if (Epi::TIMEK && tid == 0) { const unsigned dt = (unsigned)(__builtin_amdgcn_s_memrealtime() - tk0); *(LAS unsigned*)(lds + 147456 + 32) += dt; }
        const bool keep = E(acc, cur, wr, wc, fr, fq);
        if (!has_next) break;
        if (!keep) {
#pragma unroll
        for (int a = 0; a < 2; ++a)
#pragma unroll
            for (int b = 0; b < 2; ++b)
#pragma unroll
                for (int m = 0; m < 4; ++m)
#pragma unroll
                    for (int n = 0; n < 2; ++n) acc[a][b][m][n] = (f32x4){0.f, 0.f, 0.f, 0.f};
        }
        cur = nxt; cA = nA; cB = nB; ++ui;
    }
    G8_WAIT_V(0);
    if (wr == 0) G8_BAR;
    G8_BAR;
#undef G8_SA
#undef G8_SB
#undef G8_STAGE
#undef G8_STAGE_A
#undef G8_LDA
#undef G8_LDB
#undef G8_MMA
#undef G8_WAIT_V
#undef G8_WAIT_L
#undef G8_BAR
#undef G8_SCHED
#undef G8_GOFF
}
}

__device__ __forceinline__ u32x4 pack8v(const f32x4& a, const f32x4& b) {
    u32x4 w; w[0] = g8::cvt_pk_bf16(a[0], a[1]); w[1] = g8::cvt_pk_bf16(a[2], a[3]); w[2] = g8::cvt_pk_bf16(b[0], b[1]); w[3] = g8::cvt_pk_bf16(b[2], b[3]); return w;
}
__device__ __forceinline__ uint4 pack8(const f32x4& a, const f32x4& b) {
    uint4 w; w.x = g8::cvt_pk_bf16(a[0], a[1]); w.y = g8::cvt_pk_bf16(a[2], a[3]); w.z = g8::cvt_pk_bf16(b[0], b[1]); w.w = g8::cvt_pk_bf16(b[2], b[3]); return w;
}

struct ProjSched {
    unsigned A, B; int c, G;
    __device__ __forceinline__ bool next(int i, g8::Unit& u) const {
        const int L = i * G + c; if (L >= 64 * 26) return false;
        const int xcd = L & 7, jx = L >> 3;
        u.pm = xcd * 8 + (jx & 7); u.pn = jx >> 3;
        u.A = A + (unsigned)u.pm * 256 * DM * 2; u.B = B + (unsigned)u.pn * 256 * DM * 2; u.x0 = 0; u.x1 = 0; return true;
    }
    __device__ __forceinline__ int row(const g8::Unit&, int) const { return 0; }
};
struct ProjEpi {
    static constexpr bool TIMEK = PROBE_TIMEK_ProjEpi;
    static constexpr bool PERM = true;
    unsigned char* ws; const float* bg;
    __device__ __forceinline__ bool operator()(f32x4 (&acc)[2][2][4][2], const g8::Unit& u, int wr, int wc, int fr, int fq) const {
        const int seg = (u.pn * 256) >> 9;
        f32x4 cc[2][2];
#pragma unroll
        for (int bj = 0; bj < 2; ++bj) {
            const int col = u.pn * 256 + bj * 128 + wc * 32 + fq * 8;
            if (seg == 1) { cc[bj][0] = ldg<f32x4>(ws, (unsigned)(OFF_LB + (col & 511) * 4)); cc[bj][1] = ldg<f32x4>(ws, (unsigned)(OFF_LB + (col & 511) * 4 + 16)); }
            else if (seg >= 7) { cc[bj][0] = *(const f32x4*)(bg + col - 3584); cc[bj][1] = *(const f32x4*)(bg + col - 3584 + 4); }
            else { cc[bj][0] = f32x4{0.f, 0.f, 0.f, 0.f}; cc[bj][1] = cc[bj][0]; }
        }
#pragma unroll
        for (int ai = 0; ai < 2; ++ai)
#pragma unroll
            for (int m = 0; m < 4; ++m) {
                const int row = u.pm * 256 + ai * 128 + wr * 64 + m * 16 + fr;
#pragma unroll
                for (int bj = 0; bj < 2; ++bj) {
                    const int col = u.pn * 256 + bj * 128 + wc * 32 + fq * 8;
                    const int c = col & 511;
                    f32x4 v0 = acc[ai][bj][m][0], v1 = acc[ai][bj][m][1];
                    if (seg == 0 || seg == 3) {
#pragma unroll
                        for (int i = 0; i < 4; ++i) { v0[i] = silu_f(v0[i]); v1[i] = silu_f(v1[i]); }
                        stg<uint4>(ws, (unsigned)((seg == 0 ? OFF_PQ : OFF_PG) + (row * 512 + c) * 2), pack8(v0, v1));
                    } else if (seg == 1) {
                        const f32x4 l0 = cc[bj][0], l1 = cc[bj][1];
                        f32x4 g0, g1, k0, k1;
#pragma unroll
                        for (int i = 0; i < 4; ++i) {
                            const float s0 = sigm(v0[i]), s1 = sigm(v1[i]);
                            g0[i] = __logf(l0[i] + (1.f - l0[i]) * s0); g1[i] = __logf(l1[i] + (1.f - l1[i]) * s1);
                            k0[i] = (1.f - l0[i]) * (1.f - s0); k1[i] = (1.f - l1[i]) * (1.f - s1);
                        }
                        stg<f32x4>(ws, (unsigned)(OFF_PLF + (row * 512 + c) * 4), g0);
                        stg<f32x4>(ws, (unsigned)(OFF_PLF + (row * 512 + c) * 4 + 16), g1);
                        stg<uint4>(ws, (unsigned)(OFF_PK + (row * 512 + c) * 2), pack8(k0, k1));
                    } else if (seg == 2 || seg == 6) {
                        stg<uint4>(ws, (unsigned)((seg == 2 ? OFF_PV : OFF_PXR) + (row * 512 + c) * 2), pack8(v0, v1));
                    } else if (seg == 4) {
                        stg<uint4>(ws, (unsigned)(OFF_PU + (((c >> 4) * NTOK + row) * 16 + (c & 15)) * 2), pack8(v0, v1));
                    } else if (seg == 5) {
#pragma unroll
                        for (int i = 0; i < 4; ++i) { v0[i] = gelu_f(v0[i]); v1[i] = gelu_f(v1[i]); }
                        stg<uint4>(ws, (unsigned)(OFF_PXG + (row * 512 + c) * 2), pack8(v0, v1));
                    } else {
                        const int gc = col - 3584;
#pragma unroll
                        for (int i = 0; i < 4; ++i) { v0[i] = sigm(v0[i] + cc[bj][0][i]); v1[i] = sigm(v1[i] + cc[bj][1][i]); }
                        stg<uint4>(ws, (unsigned)(OFF_PGATE + (row * 3072 + gc) * 2), pack8(v0, v1));
                    }
                }
            }
        return false;
    }
};
__device__ void phase_proj(CParams& p, int l, char* lds) {
    ProjSched S; S.A = (unsigned)OFF_XB; S.B = (unsigned)OFF_WINT; S.c = blockIdx.x; S.G = gridDim.x;
    ProjEpi E; E.ws = p.ws; E.bg = p.in[2] + (size_t)l * 3072;
    g8::gemm_phase<ProjEpi, ProjSched, false>((LAS unsigned char*)lds, p.ws, 1024, S, E);
}

struct OutSched {
    unsigned A, B; int c, G;
    __device__ __forceinline__ bool next(int i, g8::Unit& u) const {
        const int L = i * G + c; if (L >= 64 * 4) return false;
        const int xcd = L & 7, jx = L >> 3;
        u.pm = xcd * 8 + (jx & 7); u.pn = jx >> 3;
        u.A = A + (unsigned)u.pm * 256 * 1024 * 2; u.B = B + (unsigned)u.pn * 256 * 1024 * 2; u.x0 = 0; u.x1 = 0; return true;
    }
    __device__ __forceinline__ int row(const g8::Unit&, int) const { return 0; }
};
struct OutEpi {
    static constexpr bool TIMEK = PROBE_TIMEK_OutEpi;
    static constexpr bool PERM = false;
    unsigned char* ws;
    __device__ __forceinline__ bool operator()(f32x4 (&acc)[2][2][4][2], const g8::Unit& u, int wr, int wc, int fr, int fq) const {
#pragma unroll
        for (int ai = 0; ai < 2; ++ai) {
            f32x4 x[4][2][2];
#pragma unroll
            for (int m = 0; m < 4; ++m)
#pragma unroll
                for (int bj = 0; bj < 2; ++bj)
#pragma unroll
                    for (int n = 0; n < 2; ++n) {
                        const int row = u.pm * 256 + ai * 128 + wr * 64 + m * 16 + fr, col = u.pn * 256 + bj * 128 + wc * 32 + n * 16 + fq * 4;
                        x[m][bj][n] = unpack4(ldg<uint2>(ws, (unsigned)(OFF_XB + (row * 1024 + col) * 2)));
                    }
#pragma unroll
            for (int m = 0; m < 4; ++m)
#pragma unroll
                for (int bj = 0; bj < 2; ++bj)
#pragma unroll
                    for (int n = 0; n < 2; ++n) {
                        const int row = u.pm * 256 + ai * 128 + wr * 64 + m * 16 + fr, col = u.pn * 256 + bj * 128 + wc * 32 + n * 16 + fq * 4;
                        stg<f32x4>(ws, (unsigned)OFF_PRELN + (unsigned)((row * 1024 + col) * 4), x[m][bj][n] * DN_ALPHA + acc[ai][bj][m][n]);
                    }
        }
        return false;
    }
};

struct BrSched {
    int c;
    __device__ __forceinline__ bool next(int i, g8::Unit& u) const {
        if (i >= 3) return false;
        const int xcd = c & 7, jx = c >> 3;
        u.pm = xcd * 8 + (jx & 7); u.pn = jx >> 3; u.x0 = i; u.x1 = 0;
        u.A = (unsigned)(i == 0 ? OFF_YA : (i == 1 ? OFF_YB : OFF_YC)) + (unsigned)u.pm * 256 * 512 * 2;
        u.B = (unsigned)OFF_WBRT + (unsigned)i * 1024 * 512 * 2 + (unsigned)u.pn * 256 * 512 * 2;
        return true;
    }
    __device__ __forceinline__ int row(const g8::Unit&, int) const { return 0; }
};
struct BrEpi {
    static constexpr bool TIMEK = PROBE_TIMEK_BrEpi;
    static constexpr bool PERM = true;
    unsigned char* ws;
    __device__ __forceinline__ bool operator()(f32x4 (&acc)[2][2][4][2], const g8::Unit& u, int wr, int wc, int fr, int fq) const {
        const int k = u.x0;
#pragma unroll
        for (int ai = 0; ai < 2; ++ai) {
            uint4 gq[4][2], gn[4][2];
#pragma unroll
            for (int m = 0; m < 4; ++m)
#pragma unroll
                for (int bj = 0; bj < 2; ++bj) {
                    const int row = u.pm * 256 + ai * 128 + wr * 64 + m * 16 + fr, col = u.pn * 256 + bj * 128 + wc * 32 + fq * 8;
                    const unsigned go = (unsigned)(OFF_PGATE + (row * 3072 + k * 1024 + col) * 2);
                    gq[m][bj] = ldg<uint4>(ws, go);
                    gn[m][bj] = (k < 2) ? ldg<uint4>(ws, go + 2048) : uint4{0x3f803f80u, 0x3f803f80u, 0x3f803f80u, 0x3f803f80u};
                }
#pragma unroll
            for (int m = 0; m < 4; ++m)
#pragma unroll
                for (int bj = 0; bj < 2; ++bj) {
                    const int row = u.pm * 256 + ai * 128 + wr * 64 + m * 16 + fr, col = u.pn * 256 + bj * 128 + wc * 32 + fq * 8;
                    const uint4 q = gq[m][bj], nx = gn[m][bj];
                    float s[8] = {bf2f((u16)(q.x & 0xffff)), bf2f((u16)(q.x >> 16)), bf2f((u16)(q.y & 0xffff)), bf2f((u16)(q.y >> 16)),
                                  bf2f((u16)(q.z & 0xffff)), bf2f((u16)(q.z >> 16)), bf2f((u16)(q.w & 0xffff)), bf2f((u16)(q.w >> 16))};
                    s[0] *= __builtin_amdgcn_rcpf(bf2f((u16)(nx.x & 0xffff))); s[1] *= __builtin_amdgcn_rcpf(bf2f((u16)(nx.x >> 16)));
                    s[2] *= __builtin_amdgcn_rcpf(bf2f((u16)(nx.y & 0xffff))); s[3] *= __builtin_amdgcn_rcpf(bf2f((u16)(nx.y >> 16)));
                    s[4] *= __builtin_amdgcn_rcpf(bf2f((u16)(nx.z & 0xffff))); s[5] *= __builtin_amdgcn_rcpf(bf2f((u16)(nx.z >> 16)));
                    s[6] *= __builtin_amdgcn_rcpf(bf2f((u16)(nx.w & 0xffff))); s[7] *= __builtin_amdgcn_rcpf(bf2f((u16)(nx.w >> 16)));
#pragma unroll
                    for (int i = 0; i < 4; ++i) { acc[ai][bj][m][0][i] *= s[i]; acc[ai][bj][m][1][i] *= s[4 + i]; }
                    if (k == 2) stg<uint4>(ws, (unsigned)(OFF_MIXP + (row * 1024 + col) * 2), pack8(acc[ai][bj][m][0], acc[ai][bj][m][1]));
                }
        }
        return k < 2;
    }
};

struct MoeSched {
    const int* sm; const unsigned char* ws; unsigned A, Bexp, Bsh, Ash;
    int c, G, npn, K, bstride_e, gather, nsh;
    __device__ __forceinline__ bool next(int i, g8::Unit& u) const {
        int nbr = __builtin_amdgcn_readfirstlane(sm[64]); asm volatile("" : "+s"(nbr));
        const int L = i * G + c; if (L >= (nbr + nsh) * npn) return false;
        const int blk = L / npn; u.pn = L - blk * npn;
        if (blk >= nbr) {
            u.x0 = 64; u.pm = blk - nbr; u.x1 = NTOK;
            u.A = gather ? A : Ash + (unsigned)u.pm * 256 * K * 2;
            u.B = Bsh + (unsigned)u.pn * 256 * K * 2;
        } else {
            int e = __builtin_amdgcn_readfirstlane(sm[256 + blk]);
            int be = __builtin_amdgcn_readfirstlane(sm[e]), re = __builtin_amdgcn_readfirstlane(sm[65 + e]), ce = __builtin_amdgcn_readfirstlane(sm[130 + e]);
            asm volatile("" : "+s"(e), "+s"(be), "+s"(re), "+s"(ce));
            u.x0 = e; u.pm = blk - be; u.x1 = ce;
            u.A = gather ? A : A + (unsigned)(re + u.pm * 256) * K * 2;
            u.B = Bexp + (unsigned)e * bstride_e + (unsigned)u.pn * 256 * K * 2;
        }
        return true;
    }
    __device__ __forceinline__ int row(const g8::Unit& u, int r) const {
        const int rr = u.pm * 256 + r;
        if (u.x0 == 64) return rr;
        return (rr < u.x1) ? (ldg<int>(ws, (unsigned)(OFF_LIST + (u.x0 * NTOK + rr) * 4)) >> 3) : 0;
    }
};
__device__ __forceinline__ void moe_setup(CParams& p, int* sm) {
    int t_ = threadIdx.x; asm volatile("" : "+v"(t_));
    __syncthreads();
    if (t_ < 64) sm[130 + t_] = ldg<int>(p.ws, (unsigned)(OFF_CUR + t_ * 4));
    __syncthreads();
    if (t_ == 0) {
        int nb = 0, nr = 0;
        for (int e = 0; e < 64; ++e) { sm[e] = nb; sm[65 + e] = nr; const int c = sm[130 + e]; nb += (c + 255) >> 8; nr += c; }
        sm[64] = nb; sm[129] = nr;
    }
    __syncthreads();
    if (t_ < 64) { const int e = t_; for (int k = sm[e]; k < sm[e + 1]; ++k) sm[256 + k] = e; }
    __syncthreads();
}
struct Moe1Epi {
    static constexpr bool TIMEK = PROBE_TIMEK_Moe1Epi;
    static constexpr bool PERM = false;
    unsigned char* ws; const int* sm;
    __device__ __forceinline__ bool operator()(f32x4 (&acc)[2][2][4][2], const g8::Unit& u, int wr, int wc, int fr, int fq) const {
        const int rbase = (u.x0 == 64) ? 0 : __builtin_amdgcn_readfirstlane(sm[65 + (u.x0 & 63)]);
        const unsigned hoff = (unsigned)((u.x0 == 64) ? OFF_HSH + (size_t)u.pm * 256 * 256 * 2 : OFF_HBUF + (size_t)(rbase + u.pm * 256) * 256 * 2);
        const int valid = u.x1 - u.pm * 256;
        float rw[2][4];
        const unsigned wb = (unsigned)(OFF_WLIST + ((u.x0 & 63) * NTOK + u.pm * 256 + wr * 64 + fr) * 4);
#pragma unroll
        for (int ai = 0; ai < 2; ++ai)
#pragma unroll
            for (int m = 0; m < 4; ++m) {
                const int r = ai * 128 + wr * 64 + m * 16 + fr;
                rw[ai][m] = (u.x0 != 64 && r < valid) ? ldg<float>(ws, wb + (unsigned)((ai * 128 + m * 16) * 4)) : 1.f;
            }
#pragma unroll
        for (int ai = 0; ai < 2; ++ai)
#pragma unroll
            for (int m = 0; m < 4; ++m) {
                const int r = ai * 128 + wr * 64 + m * 16 + fr;
                const float w = rw[ai][m];
#pragma unroll
                for (int bj = 0; bj < 2; ++bj) {
                    const int hid = ((u.pn * 256 + bj * 128 + wc * 32) >> 1) + fq * 4;
                    const f32x4 a = acc[ai][bj][m][0], b = acc[ai][bj][m][1] * w;
                    uint2 pk;
                    pk.x = g8::cvt_pk_bf16(silu_f(a[0]) * b[0], silu_f(a[1]) * b[1]);
                    pk.y = g8::cvt_pk_bf16(silu_f(a[2]) * b[2], silu_f(a[3]) * b[3]);
                    if (r < valid) stg<uint2>(ws, hoff + (unsigned)(r * 256 + hid) * 2u, pk);
                }
                __builtin_amdgcn_sched_barrier(0);
            }
        return false;
    }
};
__device__ void phase_moe1(CParams& p, int l, char* lds) {
    int* sm = (int*)(lds + g8::STAGE_BYTES);
    moe_setup(p, sm);
    MoeSched S; S.sm = sm; S.ws = p.ws;
    S.A = (unsigned)OFF_XM; S.Ash = S.A; S.Bexp = (unsigned)OFF_EW13; S.Bsh = (unsigned)OFF_SH13T;
    S.c = (blockIdx.x & 7) * 32 + (blockIdx.x >> 3); S.G = gridDim.x; S.npn = 2; S.K = 1024; S.bstride_e = 512 * 1024 * 2; S.gather = 1; S.nsh = 64;
    Moe1Epi E; E.ws = p.ws; E.sm = sm;
    g8::gemm_phase<Moe1Epi, MoeSched, true>((LAS unsigned char*)lds, p.ws, 1024, S, E);
}
struct Moe2Epi {
    static constexpr bool TIMEK = PROBE_TIMEK_Moe2Epi;
    static constexpr bool PERM = true;
    unsigned char* ws;
    __device__ __forceinline__ bool operator()(f32x4 (&acc)[2][2][4][2], const g8::Unit& u, int wr, int wc, int fr, int fq) const {
        const int valid = u.x1 - u.pm * 256;
        const int colb = u.pn * 256 + wc * 32 + fq * 8;
        const unsigned lbase = (unsigned)(OFF_LIST + (u.x0 * NTOK + u.pm * 256 + wr * 64 + fr) * 4);
        int ent[2][4];
#pragma unroll
        for (int ai = 0; ai < 2; ++ai)
#pragma unroll
            for (int m = 0; m < 4; ++m) {
                const int r = ai * 128 + wr * 64 + m * 16 + fr;
                ent[ai][m] = (r < valid) ? ldg<int>(ws, lbase + (unsigned)((ai * 128 + m * 16) * 4)) : 0;
            }
#pragma unroll
        for (int ai = 0; ai < 2; ++ai)
#pragma unroll
            for (int m = 0; m < 4; ++m) {
                const int r = ai * 128 + wr * 64 + m * 16 + fr;
                if (r < valid) {
                    const unsigned o = (unsigned)OFF_YBUF + (unsigned)(ent[ai][m] * 1024 + colb);
#pragma unroll
                    for (int bj = 0; bj < 2; ++bj) {
                        const f32x4 a = acc[ai][bj][m][0] * 32.f, b = acc[ai][bj][m][1] * 32.f;
                        int w0 = __builtin_amdgcn_cvt_pk_fp8_f32(a[0], a[1], 0, false); w0 = __builtin_amdgcn_cvt_pk_fp8_f32(a[2], a[3], w0, true);
                        int w1 = __builtin_amdgcn_cvt_pk_fp8_f32(b[0], b[1], 0, false); w1 = __builtin_amdgcn_cvt_pk_fp8_f32(b[2], b[3], w1, true);
                        stg<uint2>(ws, o + bj * 128, uint2{(unsigned)w0, (unsigned)w1});
                    }
                }
                __builtin_amdgcn_sched_barrier(0);
            }
        return false;
    }
};
struct ShSched {
    int c, G;
    __device__ __forceinline__ bool next(int i, g8::Unit& u) const {
        const int L = i * G + c; if (L >= 64 * 4) return false;
        u.pm = L >> 2; u.pn = L & 3; u.A = (unsigned)OFF_HSH + (unsigned)u.pm * 256 * 256 * 2; u.B = (unsigned)OFF_SH2T + (unsigned)u.pn * 256 * 256 * 2; u.x0 = 64; u.x1 = NTOK; return true;
    }
    __device__ __forceinline__ int row(const g8::Unit&, int) const { return 0; }
};
struct ShEpi {
    static constexpr bool TIMEK = PROBE_TIMEK_ShEpi;
    static constexpr bool PROBE = false;
    static constexpr bool PERM = true;
    unsigned char* ws;
    __device__ __forceinline__ bool operator()(f32x4 (&acc)[2][2][4][2], const g8::Unit& u, int wr, int wc, int fr, int fq) const {
#pragma unroll
        for (int ai = 0; ai < 2; ++ai)
#pragma unroll
            for (int m = 0; m < 4; ++m) {
                const int row = u.pm * 256 + ai * 128 + wr * 64 + m * 16 + fr;
#pragma unroll
                for (int bj = 0; bj < 2; ++bj)
                    stg<uint4>(ws, (unsigned)(OFF_YSH + (row * 1024 + u.pn * 256 + bj * 128 + wc * 32 + fq * 8) * 2), pack8(acc[ai][bj][m][0], acc[ai][bj][m][1]));
                __builtin_amdgcn_sched_barrier(0);
            }
        return false;
    }
};
__device__ void phase_moe2(CParams& p, int l, char* lds) {
    int* sm = (int*)(lds + g8::STAGE_BYTES);
    moe_setup(p, sm);
    MoeSched S; S.sm = sm; S.ws = p.ws;
    S.A = (unsigned)OFF_HBUF; S.Ash = (unsigned)OFF_HSH; S.Bexp = (unsigned)OFF_EW2; S.Bsh = (unsigned)OFF_SH2T;
    S.c = (blockIdx.x & 7) * 32 + (blockIdx.x >> 3); S.G = gridDim.x; S.npn = 4; S.K = 256; S.bstride_e = 1024 * 256 * 2; S.gather = 0; S.nsh = 0;
    Moe2Epi E; E.ws = p.ws;
    g8::gemm_phase<Moe2Epi, MoeSched, false>((LAS unsigned char*)lds, p.ws, 256, S, E);
    ShSched S2; S2.c = (blockIdx.x & 7) * 32 + (blockIdx.x >> 3); S2.G = gridDim.x;
    ShEpi E2; E2.ws = p.ws;
    g8::gemm_phase<ShEpi, ShSched, false>((LAS unsigned char*)lds, p.ws, 256, S2, E2);
}

__device__ void conv_tile(const float* s1, const float* s2, int ldsrc, int K, int perm, u16* dst, int tile, float* lds) {
    const int tid = otid();
    const int ktiles = K >> 6;
    const int kt = tile % ktiles, nt = tile / ktiles;
    hsync();
#pragma unroll 4
    for (int i = 0; i < 16; ++i) {
        int idx = tid + i * 256, kr = idx >> 6, nc = idx & 63;
        const float* s; int col;
        if (perm == 32) { s = (nc < 32) ? s1 : s2; col = nt * 32 + (nc & 31); }
        else if (perm == 16) { s = ((nc & 31) < 16) ? s1 : s2; col = (nt * 2 + (nc >> 5)) * 16 + (nc & 15); }
        else { s = s1; col = nt * 64 + nc; }
        lds[kr * 65 + nc] = s[(size_t)(kt * 64 + kr) * ldsrc + col];
    }
    hsync();
#pragma unroll 4
    for (int i = 0; i < 16; ++i) {
        int idx = tid + i * 256, nr = idx >> 6, kc = idx & 63;
        dst[(size_t)(nt * 64 + nr) * K + kt * 64 + kc] = f2bf(lds[kc * 65 + nr]);
    }
}

__device__ void s5_precompute(CParams& p, int l, int g, int part, float* lds) {
    const int tid = otid();
    float* Er = lds;
    float* Ei = Er + 64 * 17;
    float* Br = Ei + 64 * 17;
    float* Bi = Br + 1024;
    float* Cr = Bi + 1024;
    float* Ci = Cr + 1024;
    float* Kt = Ci + 1024;
    hsync();
    const int lg = l * 32 + g;
    const float dt = expf(p.in[12][lg]);
    {
        const int pp = tid & 63, part = tid >> 6;
        const float ar = p.in[5][lg * 64 + pp], ai = p.in[6][lg * 64 + pp];
        for (int tau = part; tau <= 16; tau += 4) {
            float mag = expf((float)tau * ar * dt);
            float ang = (float)tau * ai * dt;
            Er[pp * 17 + tau] = mag * cosf(ang);
            Ei[pp * 17 + tau] = mag * sinf(ang);
        }
        float mag = expf(ar * dt), ang = ai * dt;
        float e1r = mag * cosf(ang) - 1.f, e1i = mag * sinf(ang);
        float den = ar * ar + ai * ai;
        float qr = (e1r * ar + e1i * ai) / den, qi = (e1i * ar - e1r * ai) / den;
        for (int c = part * 4; c < part * 4 + 4; ++c) {
            float br = p.in[7][((size_t)lg * 64 + pp) * 16 + c], bi = p.in[8][((size_t)lg * 64 + pp) * 16 + c];
            Br[pp * 16 + c] = qr * br - qi * bi;
            Bi[pp * 16 + c] = qr * bi + qi * br;
            Cr[c * 64 + pp] = p.in[9][((size_t)lg * 16 + c) * 64 + pp];
            Ci[c * 64 + pp] = p.in[10][((size_t)lg * 16 + c) * 64 + pp];
        }
    }
    hsync();
    u16* bta = (u16*)(p.ws + OFF_BTA) + (size_t)g * 128 * 256;
    for (int i = part * 16; i < part * 16 + 16; ++i) {
        int idx = tid + i * 256, pr = idx >> 8, k = idx & 255, s = k >> 4, ch = k & 15, pp = pr & 63;
        float er = Er[pp * 17 + 15 - s], ei = Ei[pp * 17 + 15 - s], br = Br[pp * 16 + ch], bi = Bi[pp * 16 + ch];
        float v = (pr < 64) ? (er * br - ei * bi) : (er * bi + ei * br);
        bta[idx] = f2bf(v);
    }
    u16* btc = (u16*)(p.ws + OFF_BTC) + (size_t)g * 256 * 384;
    {
        const int ch = tid >> 4, c2 = tid & 15;
        for (int tt = 0; tt < 2; ++tt) {
            const int tau = part * 2 + tt;
            float s = 0.f;
            for (int pp = 0; pp < 64; ++pp) {
                float cr = Cr[ch * 64 + pp], ci = Ci[ch * 64 + pp], er = Er[pp * 17 + tau], ei = Ei[pp * 17 + tau];
                float gr = cr * er - ci * ei, gi = cr * ei + ci * er;
                s += gr * Br[pp * 16 + c2] - gi * Bi[pp * 16 + c2];
            }
            const u16 kv = f2bf(s);
            for (int j = tau; j < 16; ++j) btc[(size_t)(j * 16 + ch) * 384 + (j - tau) * 16 + c2] = kv;
            if (tau > 0) for (int j = 0; j + tau < 16; ++j) btc[(size_t)(j * 16 + ch) * 384 + (j + tau) * 16 + c2] = 0;
        }
        for (int i = 0; i < 16; ++i) {
            const int idx = tid + i * 256, n = part * 32 + (idx >> 7), pr = idx & 127, pp = pr & 63, j = n >> 4, chn = n & 15;
            float cr = Cr[chn * 64 + pp], ci = Ci[chn * 64 + pp], er = Er[pp * 17 + j + 1], ei = Ei[pp * 17 + j + 1];
            float gr = cr * er - ci * ei, gi = cr * ei + ci * er;
            btc[(size_t)n * 384 + 256 + pr] = f2bf((pr < 64) ? gr : -gi);
        }
    }
}

constexpr int W_CONV_TILES = 2608;
__device__ void phase_w(CParams& p, int l, char* lds) {
    const int tid = otid();
    const int nunits = W_CONV_TILES + 256 + 2 + (l == 0 ? 1024 : 0);
    for (int uu = VB; uu < nunits; uu += VG) {
        const int u = (uu < 256) ? uu + W_CONV_TILES : (uu < W_CONV_TILES + 256 ? uu - 256 : uu);
        if (u < W_CONV_TILES) {
            int t = u;
            const float *s1, *s2 = nullptr; int ld, K, perm = 0; u16* dst;
            if (t < 1664) { s1 = p.in[1] + (size_t)l * DM * INC; ld = INC; K = 1024; dst = (u16*)(p.ws + OFF_WINT); }
            else if ((t -= 1664) < 384) { int k = t >> 7; t &= 127; s1 = p.in[22] + (size_t)(l * 3 + k) * 512 * 1024; ld = 1024; K = 512; dst = (u16*)(p.ws + OFF_WBRT) + (size_t)k * 1024 * 512; }
            else if ((t -= 384) < 256) { s1 = p.in[23] + (size_t)l * 1024 * 1024; ld = 1024; K = 1024; dst = (u16*)(p.ws + OFF_WOUTT); }
            else if ((t -= 256) < 64) { s1 = p.in[13] + (size_t)l * 512 * 512; ld = 512; K = 512; dst = (u16*)(p.ws + OFF_GLUT); }
            else if ((t -= 64) < 32) { int h = t >> 3; t &= 7; s1 = p.in[17] + (size_t)(l * 4 + h) * 128 * 128; s2 = p.in[19] + (size_t)(l * 4 + h) * 128 * 128; ld = 128; K = 128; perm = 32; dst = (u16*)(p.ws + OFF_RGT) + (size_t)h * 256 * 128; }
            else if ((t -= 32) < 128) { s1 = p.in[31] + (size_t)l * 1024 * 256; s2 = p.in[32] + (size_t)l * 1024 * 256; ld = 256; K = 1024; perm = 16; dst = (u16*)(p.ws + OFF_SH13T); }
            else if ((t -= 128) < 64) { s1 = p.in[33] + (size_t)l * 256 * 1024; ld = 1024; K = 256; dst = (u16*)(p.ws + OFF_SH2T); }
            else { t -= 64; s1 = p.in[26] + (size_t)l * 1024 * 64; ld = 64; K = 1024; dst = (u16*)(p.ws + OFF_ROUTT); }
            conv_tile(s1, s2, ld, K, perm, dst, t, (float*)lds);
        } else if (u < W_CONV_TILES + 256) {
            s5_precompute(p, l, (u - W_CONV_TILES) >> 3, (u - W_CONV_TILES) & 7, (float*)lds);
        } else if (u == W_CONV_TILES + 256) {
            float* LB = (float*)(p.ws + OFF_LB);
            for (int c = tid; c < 512; c += 256) {
                float x0 = p.in[3][c], x1 = p.in[3][512 + c];
                LB[c] = (l == 0) ? 0.f : 1.f / (1.f + expf(x0 - x1));
            }
            if (tid < 64) ((int*)(p.ws + OFF_CUR))[tid] = 0;
        } else if (u == W_CONV_TILES + 257) {
        } else {
            int r0 = (u - (W_CONV_TILES + 258)) * 16;
            const float4* src = (const float4*)(p.in[0] + (size_t)r0 * DM);
            uint2* dst = (uint2*)((u16*)(p.ws + OFF_XB) + (size_t)r0 * DM);
#pragma unroll
            for (int i0 = 0; i0 < 16; i0 += 8) {
                float4 v[8];
#pragma unroll
                for (int i = 0; i < 8; ++i) v[i] = src[tid + (i0 + i) * 256];
#pragma unroll
                for (int i = 0; i < 8; ++i) {
                    uint2 o; o.x = f2bf(v[i].x) | ((unsigned)f2bf(v[i].y) << 16); o.y = f2bf(v[i].z) | ((unsigned)f2bf(v[i].w) << 16);
                    dst[tid + (i0 + i) * 256] = o;
                }
            }
        }
    }
}

__device__ void hgrn_prep(CParams& p, int u, char* lds) {
    const int tid = otid();
    const int h = u & 3, c = (u >> 2) & 63, b = u >> 8;
    const int r0 = b * SEQ + c * 64;
    const unsigned cu = (unsigned)((b * 4 + h) * 64 + c);
    unsigned char* ws = p.ws;
    float* F = (float*)lds;
    u16* Kb = (u16*)(lds + 32768);
    u16* Vb = (u16*)(lds + 49152);
    hsync();
#pragma unroll
    for (int i = 0; i < 8; ++i) {
        const int id = tid + i * 256, s = id >> 5, d4 = (id & 31) * 4;
        *(f32x4*)(F + s * 128 + d4) = ldg<f32x4>(ws, (unsigned)(OFF_PLF + ((r0 + s) * 512 + h * 128 + d4) * 4));
    }
#pragma unroll
    for (int i = 0; i < 4; ++i) {
        const int id = tid + i * 256, s = id >> 4, d8 = (id & 15) * 8;
        *(uint4*)(Kb + s * 128 + d8) = ldg<uint4>(ws, (unsigned)(OFF_PK + ((r0 + s) * 512 + h * 128 + d8) * 2));
        *(uint4*)(Vb + s * 128 + d8) = ldg<uint4>(ws, (unsigned)(OFF_PV + ((r0 + s) * 512 + h * 128 + d8) * 2));
    }
    hsync();
    {
        const int d = tid & 127, hf = tid >> 7;
        float run = 0.f;
#pragma unroll 8
        for (int s = hf * 32; s < hf * 32 + 32; ++s) { run += F[s * 128 + d]; F[s * 128 + d] = run; }
        hsync();
        if (hf) {
            const float add = F[31 * 128 + d];
#pragma unroll 8
            for (int s = 32; s < 64; ++s) F[s * 128 + d] += add;
        }
    }
    hsync();
#pragma unroll
    for (int i = 0; i < 8; ++i) {
        const int id = tid + i * 256, s = id >> 5, d4 = (id & 31) * 4;
        stg<f32x4>(ws, (unsigned)(OFF_PLF + ((r0 + s) * 512 + h * 128 + d4) * 4), *(const f32x4*)(F + s * 128 + d4));
    }
    if (tid < 128) stg<float>(ws, (unsigned)(OFF_DEC + ((b * 64 + c) * 512 + h * 128 + tid) * 4), __expf(F[63 * 128 + tid]));
    {
        const int d = tid & 127;
        const float btot = F[63 * 128 + d];
#pragma unroll
        for (int i = 0; i < 4; ++i) {
            const int s8 = (tid >> 7) + 2 * i;
            bf16x8 ok, ov;
#pragma unroll
            for (int e = 0; e < 8; ++e) {
                const int s = s8 * 8 + e;
                ok[e] = (short)f2bf(bf2f(Kb[s * 128 + d]) * __expf(btot - F[s * 128 + d]));
                ov[e] = (short)Vb[s * 128 + d];
            }
            stg<bf16x8>(ws, (unsigned)(OFF_KTT + ((cu * 128 + d) * 64 + s8 * 8) * 2), ok);
            stg<bf16x8>(ws, (unsigned)(OFF_VT + ((cu * 128 + d) * 64 + s8 * 8) * 2), ov);
        }
    }
}

__device__ void s5_gemm_a(CParams& p, int u, char* lds) {
    LANE_IDS;
    const int wr = wid >> 1, wc = wid & 1;
    const int g = u >> 3, tm = u & 7, row0 = tm * 128;
    unsigned char* ws = p.ws;
    const unsigned aoff = (unsigned)(OFF_PU + (size_t)g * NTOK * 16 * 2), boff = (unsigned)(OFF_BTA + (size_t)g * 128 * 256 * 2);
    f32x4 acc[4][4]; ZERO_ACC(acc, 4, 4);
    mma_glds<128, 128, 2, 2, true>(acc, 4, ws,
        [&](int r, int t) { return aoff + ((row0 + r) * 256 + t * 64) * 2; },
        [&](int c, int t) { return boff + (c * 256 + t * 64) * 2; }, NoHook(), lds);
    epiT<4, 4, 64, 64>(acc, wr, wc, fq, fr, [&](int r, int cc, const f32x4& v) {
        stg<f32x4>(ws, (unsigned)(OFF_VC + (((row0 + r) * 32 + g) * 128 + cc) * 4), v); });
}

__device__ void rg_conv(CParams& p, int l) {
    const int tid = otid();
    const int c8 = (tid & 63) * 8, row0 = VB * 32 + (tid >> 6) * 8;
    unsigned char* ws = p.ws;
    const float* cw = p.in[15] + (size_t)l * 4 * 512 + c8;
    const float* cb = p.in[16] + (size_t)l * 512 + c8;
    f32x4 w[4][2], bias[2];
#pragma unroll
    for (int j = 0; j < 4; ++j) { w[j][0] = *(const f32x4*)(cw + j * 512); w[j][1] = *(const f32x4*)(cw + j * 512 + 4); }
    bias[0] = *(const f32x4*)cb; bias[1] = *(const f32x4*)(cb + 4);
    const int seq0 = row0 & ~(SEQ - 1);
    uint4 x[11];
#pragma unroll
    for (int j = 0; j < 11; ++j) {
        const int row = row0 - 3 + j;
        x[j] = (row >= seq0) ? ldg<uint4>(ws, (unsigned)(OFF_PXR + (row * 512 + c8) * 2)) : uint4{0u, 0u, 0u, 0u};
    }
#pragma unroll
    for (int r = 0; r < 8; ++r) {
        f32x4 a0 = bias[0], a1 = bias[1];
#pragma unroll
        for (int j = 0; j < 4; ++j) {
            const uint4 q = x[r + j];
            a0 += w[j][0] * unpack4(uint2{q.x, q.y});
            a1 += w[j][1] * unpack4(uint2{q.z, q.w});
        }
        stg<uint4>(ws, (unsigned)(OFF_XC + ((row0 + r) * 512 + c8) * 2), pack8(a0, a1));
    }
}

__device__ void phase2(CParams& p, int l, char* lds) {
    rg_conv(p, l);
    for (int u = VB; u < 1280; u += VG) {
        if (u < 1024) hgrn_prep(p, u, lds);
        else s5_gemm_a(p, u - 1024, lds);
    }
}

__device__ void hgrn_u(CParams& p, int u, char* lds) {
    LANE_IDS;
    const int wr = wid >> 1, wc = wid & 1;
    unsigned char* ws = p.ws;
    f32x4 acc[4][4]; ZERO_ACC(acc, 4, 4);
    mma_glds<128, 128, 2, 2>(acc, 1, ws,
        [&](int r, int t) { return (unsigned)(OFF_KTT + ((u * 128 + r) * 64) * 2); },
        [&](int c, int t) { return (unsigned)(OFF_VT + ((u * 128 + c) * 64) * 2); }, NoHook(), lds);
#pragma unroll
    for (int m = 0; m < 4; ++m) {
#pragma unroll
        for (int n = 0; n < 4; ++n) {
            const int d0 = wr * 64 + m * 16 + fq * 4, v = wc * 64 + n * 16 + fr;
            uint2 o;
            o.x = f2bf(acc[m][n][0]) | ((unsigned)f2bf(acc[m][n][1]) << 16);
            o.y = f2bf(acc[m][n][2]) | ((unsigned)f2bf(acc[m][n][3]) << 16);
            stg<uint2>(ws, (unsigned)(OFF_UT + ((u * 128 + v) * 128 + d0) * 2), o);
        }
        __builtin_amdgcn_sched_barrier(0);
    }
}

__device__ void hgrn_sscan(CParams& p, int item) {
    const int bh = item >> 12, ec = item & 4095, v = ec >> 5, d4 = (ec & 31) * 4;
    const int b = bh >> 2, h = bh & 3;
    unsigned char* ws = p.ws;
    const unsigned ub = (unsigned)(OFF_UT + ((bh * 64 * 128 + v) * 128 + d4) * 2);
    const unsigned sb = (unsigned)(OFF_ST + ((bh * 64 * 128 + v) * 128 + d4) * 2);
    const unsigned db = (unsigned)(OFF_DEC + ((b * 64) * 512 + h * 128 + d4) * 4);
    f32x4 S = {0.f, 0.f, 0.f, 0.f};
    for (int c0 = 0; c0 < 64; c0 += 8) {
        uint2 uu[8]; f32x4 dd[8];
#pragma unroll
        for (int i = 0; i < 8; ++i) { uu[i] = ldg<uint2>(ws, ub + (unsigned)((c0 + i) * 128 * 128 * 2)); dd[i] = ldg<f32x4>(ws, db + (unsigned)((c0 + i) * 512 * 4)); }
#pragma unroll
        for (int i = 0; i < 8; ++i) {
            uint2 o;
            o.x = f2bf(S[0]) | ((unsigned)f2bf(S[1]) << 16); o.y = f2bf(S[2]) | ((unsigned)f2bf(S[3]) << 16);
            stg<uint2>(ws, sb + (unsigned)((c0 + i) * 128 * 128 * 2), o);
            S[0] = dd[i][0] * S[0] + bf2f((u16)(uu[i].x & 0xffff)); S[1] = dd[i][1] * S[1] + bf2f((u16)(uu[i].x >> 16));
            S[2] = dd[i][2] * S[2] + bf2f((u16)(uu[i].y & 0xffff)); S[3] = dd[i][3] * S[3] + bf2f((u16)(uu[i].y >> 16));
        }
    }
}

__device__ void s5_scan(CParams& p, int l, int u, char* lds) {
    const int tid = otid();
    const int b = u >> 5, g = u & 31, seg = tid >> 6, pp = tid & 63;
    const int lg = l * 32 + g;
    const float dt = expf(p.in[12][lg]);
    const float ar = p.in[5][lg * 64 + pp], ai = p.in[6][lg * 64 + pp];
    const float mag = expf(16.f * ar * dt), ang = 16.f * ai * dt;
    const float er = mag * cosf(ang), ei = mag * sinf(ang);
    const float mg2 = expf(1024.f * ar * dt), an2 = 1024.f * ai * dt;
    const float sr = mg2 * cosf(an2), si = mg2 * sinf(an2);
    unsigned char* ws = p.ws;
    const unsigned vb = (unsigned)(OFF_VC + (((b * 256 + seg * 64) * 32 + g) * 128 + pp) * 4);
    const unsigned hb = (unsigned)(OFF_HC + (((b * 256 + seg * 64) * 32 + g) * 128 + pp) * 2);
    float* ex = (float*)lds;
    hsync();
    float hr = 0.f, hi = 0.f;
    for (int c0 = 0; c0 < 64; c0 += 16) {
        float vr[16], vi[16];
#pragma unroll
        for (int i = 0; i < 16; ++i) { vr[i] = ldg<float>(ws, vb + (unsigned)((c0 + i) * 4096 * 4)); vi[i] = ldg<float>(ws, vb + (unsigned)((c0 + i) * 4096 * 4 + 256)); }
#pragma unroll
        for (int i = 0; i < 16; ++i) { const float nr = er * hr - ei * hi + vr[i], ni = er * hi + ei * hr + vi[i]; hr = nr; hi = ni; }
    }
    ex[(seg * 64 + pp) * 2] = hr; ex[(seg * 64 + pp) * 2 + 1] = hi;
    hsync();
    hr = 0.f; hi = 0.f;
    for (int sg = 0; sg < seg; ++sg) {
        const float lr = ex[(sg * 64 + pp) * 2], li = ex[(sg * 64 + pp) * 2 + 1];
        const float nr = sr * hr - si * hi + lr, ni = sr * hi + si * hr + li; hr = nr; hi = ni;
    }
    for (int c0 = 0; c0 < 64; c0 += 16) {
        float vr[16], vi[16];
#pragma unroll
        for (int i = 0; i < 16; ++i) { vr[i] = ldg<float>(ws, vb + (unsigned)((c0 + i) * 4096 * 4)); vi[i] = ldg<float>(ws, vb + (unsigned)((c0 + i) * 4096 * 4 + 256)); }
#pragma unroll
        for (int i = 0; i < 16; ++i) {
            stg<u16>(ws, hb + (unsigned)((c0 + i) * 4096 * 2), f2bf(hr));
            stg<u16>(ws, hb + (unsigned)((c0 + i) * 4096 * 2 + 128), f2bf(hi));
            const float nr = er * hr - ei * hi + vr[i], ni = er * hi + ei * hr + vi[i]; hr = nr; hi = ni;
        }
    }
}

__device__ void rg_gemm(CParams& p, int l, int u, char* lds) {
    LANE_IDS;
    const int wr = wid >> 1, wc = wid & 1;
    const int tm = u >> 3, h = (u >> 1) & 3, nt = u & 1, row0 = tm * 128;
    unsigned char* ws = p.ws;
    const unsigned aoff = (unsigned)(OFF_XC + h * 128 * 2), boff = (unsigned)(OFF_RGT + ((size_t)h * 256 * 128 + (size_t)nt * 128 * 128) * 2);
    f32x4 acc[4][4]; ZERO_ACC(acc, 4, 4);
    mma_glds<128, 128, 2, 2, true>(acc, 2, ws,
        [&](int r, int t) { return aoff + ((row0 + r) * 512 + t * 64) * 2; },
        [&](int c, int t) { return boff + (c * 128 + t * 64) * 2; }, NoHook(), lds);
    const float* ba = p.in[18] + (size_t)l * 512;
    const float* bx = p.in[20] + (size_t)l * 512;
    const float* lam = p.in[21] + (size_t)l * 512;
#pragma unroll
    for (int n = 0; n < 2; ++n) {
        const int ch = h * 128 + (nt * 2 + wc) * 32 + n * 16 + fq * 4;
        const f32x4 lm = *(const f32x4*)(lam + ch), bav = *(const f32x4*)(ba + ch), bxv = *(const f32x4*)(bx + ch);
        f32x4 c1;
#pragma unroll
        for (int i = 0; i < 4; ++i) c1[i] = -8.f * log1pf(expf(-lm[i]));
#pragma unroll
        for (int m = 0; m < 4; ++m) {
            const int row = row0 + wr * 64 + m * 16 + fr;
            const f32x4 x = unpack4(ldg<uint2>(ws, (unsigned)(OFF_XC + (row * 512 + ch) * 2)));
            f32x4 la, bb;
#pragma unroll
            for (int i = 0; i < 4; ++i) {
                const float r = sigm(acc[m][n][i] + bav[i]), ig = sigm(acc[m][n + 2][i] + bxv[i]);
                la[i] = c1[i] * r;
                bb[i] = sqrtf(fmaxf(1.f - __expf(2.f * la[i]), 0.f)) * ig * x[i];
            }
            stg<uint2>(ws, (unsigned)(OFF_LA + (row * 512 + ch) * 2), pack4(la));
            stg<uint2>(ws, (unsigned)(OFF_BB + (row * 512 + ch) * 2), pack4(bb));
        }
    }
}

__device__ void phase3(CParams& p, int l, char* lds) {
    for (int u = VB; u < 2176; u += VG) {
        if (u < 128) s5_scan(p, l, u, lds);
        else if (u < 1152) hgrn_u(p, u - 128, lds);
        else rg_gemm(p, l, u - 1152, lds);
    }
}

__device__ void hgrn_out(CParams& p, int l, int u, char* lds) {
    LANE_IDS;
    const int h = u & 3, c = (u >> 2) & 63, b = u >> 8;
    const int r0 = b * SEQ + c * 64;
    const unsigned cu = (unsigned)((b * 4 + h) * 64 + c);
    unsigned char* ws = p.ws;
    char* F = lds;
    char* Qb = lds + 32768;
    char* Kb = lds + 49152;
    char* Ss = lds + 65536;
    hsync();
#pragma unroll
    for (int i = 0; i < 8; ++i) {
        const int id = tid + i * 256, s = id >> 5, ch = id & 31;
        *(f32x4*)(F + s * 512 + ((ch ^ (s & 31)) << 4)) = ldg<f32x4>(ws, (unsigned)(OFF_PLF + ((r0 + s) * 512 + h * 128 + ch * 4) * 4));
    }
#pragma unroll
    for (int i = 0; i < 4; ++i) {
        const int id = tid + i * 256, s = id >> 4, ch = id & 15;
        *(uint4*)(Qb + s * 256 + ((ch ^ (s & 15)) << 4)) = ldg<uint4>(ws, (unsigned)(OFF_PQ + ((r0 + s) * 512 + h * 128 + ch * 8) * 2));
        *(uint4*)(Kb + s * 256 + ((ch ^ (s & 15)) << 4)) = ldg<uint4>(ws, (unsigned)(OFF_PK + ((r0 + s) * 512 + h * 128 + ch * 8) * 2));
    }
    hsync();
    auto ldF8 = [&](int row, int d0, float (&o)[8]) {
        const int c0 = d0 >> 2;
        const f32x4 x = *(const f32x4*)(F + row * 512 + ((c0 ^ (row & 31)) << 4)), y = *(const f32x4*)(F + row * 512 + (((c0 + 1) ^ (row & 31)) << 4));
        o[0] = x[0]; o[1] = x[1]; o[2] = x[2]; o[3] = x[3]; o[4] = y[0]; o[5] = y[1]; o[6] = y[2]; o[7] = y[3];
    };
    auto ldH8 = [&](const char* base, int row, int d0) { return *(const bf16x8*)(base + row * 256 + (((d0 >> 3) ^ (row & 15)) << 4)); };
    {
        const int i = wid;
        const int t = 16 * i + fr;
        bf16x8 aq[4];
        float refv[4][8];
#pragma unroll
        for (int kk = 0; kk < 4; ++kk) {
            const int d0 = kk * 32 + fq * 8;
            float bt[8];
            ldF8(t, d0, bt);
            if (i == 0) {
#pragma unroll
                for (int e = 0; e < 8; ++e) refv[kk][e] = 0.f;
            } else ldF8(16 * i - 1, d0, refv[kk]);
            const bf16x8 q8 = ldH8(Qb, t, d0);
#pragma unroll
            for (int e = 0; e < 8; ++e) aq[kk][e] = (short)f2bf(bf2f((u16)q8[e]) * __expf(bt[e] - refv[kk][e]));
        }
#pragma unroll
        for (int j = 0; j < 4; ++j) {
            f32x4 sc = {0.f, 0.f, 0.f, 0.f};
            if (j <= i) {
                const int s = 16 * j + fr;
#pragma unroll
                for (int kk = 0; kk < 4; ++kk) {
                    const int d0 = kk * 32 + fq * 8;
                    float bs[8];
                    ldF8(s, d0, bs);
                    const bf16x8 k8 = ldH8(Kb, s, d0);
                    bf16x8 bk;
#pragma unroll
                    for (int e = 0; e < 8; ++e) bk[e] = (short)f2bf(bf2f((u16)k8[e]) * __expf(fminf(refv[kk][e] - bs[e], 60.f)));
                    sc = __builtin_amdgcn_mfma_f32_16x16x32_bf16(aq[kk], bk, sc, 0, 0, 0);
                }
            }
#pragma unroll
            for (int r = 0; r < 4; ++r) {
                const int tl = fq * 4 + r, sl = fr;
                float v = sc[r];
                if (j > i || (j == i && sl > tl)) v = 0.f;
                const int row = 16 * i + tl, col = 16 * j + sl;
                *(u16*)(Ss + row * 128 + (((col >> 3) ^ (row & 7)) << 4) + (col & 7) * 2) = f2bf(v);
            }
        }
    }
    hsync();
    f32x4 acc[8];
#pragma unroll
    for (int n = 0; n < 8; ++n) acc[n] = f32x4{0.f, 0.f, 0.f, 0.f};
    auto bsrc = [&](int t, int id) -> unsigned {
        const int vrow = id >> 3, ch = id & 7;
        return (t < 2) ? (unsigned)(OFF_ST + ((cu * 128 + vrow) * 128 + t * 64 + ch * 8) * 2) : (unsigned)(OFF_VT + ((cu * 128 + vrow) * 64 + ch * 8) * 2);
    };
    uint4 rb[4];
#pragma unroll
    for (int i = 0; i < 4; ++i) rb[i] = ldg<uint4>(ws, bsrc(0, tid + i * 256));
    const int arow = wid * 16 + fr;
#pragma unroll 1
    for (int t = 0; t < 3; ++t) {
#pragma unroll
        for (int i = 0; i < 4; ++i) { const int id = tid + i * 256, vrow = id >> 3, ch = id & 7; *(uint4*)(Kb + vrow * 128 + ((ch ^ ((vrow >> 1) & 7)) << 4)) = rb[i]; }
        hsync();
        if (t < 2) {
#pragma unroll
            for (int i = 0; i < 4; ++i) rb[i] = ldg<uint4>(ws, bsrc(t + 1, tid + i * 256));
        }
#pragma unroll
        for (int ks = 0; ks < 2; ++ks) {
            bf16x8 af;
            if (t < 2) {
                const int d0 = t * 64 + ks * 32 + fq * 8;
                float bq[8];
                ldF8(arow, d0, bq);
                const bf16x8 q8 = ldH8(Qb, arow, d0);
#pragma unroll
                for (int e = 0; e < 8; ++e) af[e] = (short)f2bf(bf2f((u16)q8[e]) * __expf(bq[e]));
            } else {
                af = *(const bf16x8*)(Ss + arow * 128 + (((ks * 4 + fq) ^ (arow & 7)) << 4));
            }
#pragma unroll
            for (int n = 0; n < 8; ++n) {
                const int brow = n * 16 + fr;
                const bf16x8 bfr = *(const bf16x8*)(Kb + brow * 128 + (((ks * 4 + fq) ^ ((brow >> 1) & 7)) << 4));
                acc[n] = __builtin_amdgcn_mfma_f32_16x16x32_bf16(bfr, af, acc[n], 0, 0, 0);
            }
        }
        hsync();
    }
    const float* nw = p.in[4] + (size_t)l * 512 + h * 128;
    {
        float ss = 0.f;
#pragma unroll
        for (int n = 0; n < 8; ++n)
#pragma unroll
            for (int j = 0; j < 4; ++j) ss += acc[n][j] * acc[n][j];
        ss += shfl_xor_l(ss, 16, lane); ss += shfl_xor_l(ss, 32, lane);
        const float rs = rsqrtf(ss * (1.f / 128.f) + 1e-6f);
        const int row = r0 + wid * 16 + fr;
#pragma unroll
        for (int n = 0; n < 8; ++n) {
            const int v = n * 16 + fq * 4;
            const f32x4 w4 = *(const f32x4*)(nw + v);
            const f32x4 g4 = unpack4(ldg<uint2>(ws, (unsigned)(OFF_PG + (row * 512 + h * 128 + v) * 2)));
            f32x4 o;
#pragma unroll
            for (int j = 0; j < 4; ++j) o[j] = acc[n][j] * rs * w4[j] * g4[j];
            stg<uint2>(ws, (unsigned)(OFF_YA + (row * 512 + h * 128 + v) * 2), pack4(o));
        }
    }
}

__device__ void s5_gemm_c(CParams& p, int l, int u, char* lds) {
    LANE_IDS;
    const int wr = wid >> 1, wc = wid & 1;
    const int g = u >> 4, tm = (u >> 1) & 7, tn = u & 1, row0 = tm * 128, col0 = tn * 128;
    unsigned char* ws = p.ws;
    const unsigned aoff = (unsigned)(OFF_PU + (size_t)g * NTOK * 16 * 2), boff = (unsigned)(OFF_BTC + (size_t)g * 256 * 384 * 2);
    f32x4 acc[4][4]; ZERO_ACC(acc, 4, 4);
    mma_glds<128, 128, 2, 2, true>(acc, 6, ws,
        [&](int r, int t) {
            return (t < 4) ? aoff + ((row0 + r) * 256 + t * 64) * 2 : (unsigned)(OFF_HC + (((row0 + r) * 32 + g) * 128 + (t - 4) * 64) * 2);
        },
        [&](int c, int t) { return boff + ((col0 + c) * 384 + t * 64) * 2; }, NoHook(), lds);
    const f32x4 dch = *(const f32x4*)(p.in[11] + (size_t)l * 512 + g * 16 + fq * 4);
    epiT<4, 4, 64, 64>(acc, wr, wc, fq, fr, [&](int r, int cc, const f32x4& v) {
        const int row = row0 + r, col = col0 + cc;
        const int jj = col >> 4, ch = col & 15;
        const int tok = (row >> 8) * SEQ + (row & 255) * 16 + jj;
        const f32x4 uu = unpack4(ldg<uint2>(ws, aoff + (tok * 16 + ch) * 2));
        f32x4 y;
#pragma unroll
        for (int i = 0; i < 4; ++i) y[i] = gelu_f(v[i] + dch[i] * uu[i]);
        stg<uint2>(ws, (unsigned)(OFF_YG + (tok * 512 + g * 16 + ch) * 2), pack4(y)); });
}

__device__ __forceinline__ void bf4(const uint2 q, float (&o)[4]) {
    o[0] = bf2f((u16)(q.x & 0xffff)); o[1] = bf2f((u16)(q.x >> 16)); o[2] = bf2f((u16)(q.y & 0xffff)); o[3] = bf2f((u16)(q.y >> 16));
}
__device__ void rg_local(CParams& p, int item) {
    const int b = item >> 13, seg = (item >> 7) & 63, c4 = (item & 127) * 4;
    unsigned char* ws = p.ws;
    const unsigned base = (unsigned)(((b * SEQ + seg * 64) * 512 + c4) * 2);
    float hh[4] = {0.f, 0.f, 0.f, 0.f}, ap[4] = {1.f, 1.f, 1.f, 1.f};
    for (int s0 = 0; s0 < 64; s0 += 8) {
        uint2 a[8], bb[8];
#pragma unroll
        for (int i = 0; i < 8; ++i) { a[i] = ldg<uint2>(ws, (unsigned)OFF_LA + base + (unsigned)((s0 + i) * 1024)); bb[i] = ldg<uint2>(ws, (unsigned)OFF_BB + base + (unsigned)((s0 + i) * 1024)); }
#pragma unroll
        for (int i = 0; i < 8; ++i) {
            float av[4], bv[4]; bf4(a[i], av); bf4(bb[i], bv);
#pragma unroll
            for (int c = 0; c < 4; ++c) { const float e = __expf(av[c]); hh[c] = e * hh[c] + bv[c]; ap[c] *= e; }
        }
    }
    stg<f32x4>(ws, (unsigned)(OFF_SEGA + ((b * 64 + seg) * 512 + c4) * 4), f32x4{ap[0], ap[1], ap[2], ap[3]});
    stg<f32x4>(ws, (unsigned)(OFF_SEGH + ((b * 64 + seg) * 512 + c4) * 4), f32x4{hh[0], hh[1], hh[2], hh[3]});
}

__device__ void rg_final(CParams& p, int item) {
    const int b = item >> 13, seg = (item >> 7) & 63, c4 = (item & 127) * 4;
    unsigned char* ws = p.ws;
    const unsigned base = (unsigned)(((b * SEQ + seg * 64) * 512 + c4) * 2);
    f32x4 hh = {0.f, 0.f, 0.f, 0.f};
    for (int sg0 = 0; sg0 < seg; sg0 += 8) {
        f32x4 sa[8], sh[8];
#pragma unroll
        for (int i = 0; i < 8; ++i) {
            const int sg = min(sg0 + i, 63);
            sa[i] = ldg<f32x4>(ws, (unsigned)(OFF_SEGA + ((b * 64 + sg) * 512 + c4) * 4));
            sh[i] = ldg<f32x4>(ws, (unsigned)(OFF_SEGH + ((b * 64 + sg) * 512 + c4) * 4));
        }
#pragma unroll
        for (int i = 0; i < 8; ++i) if (sg0 + i < seg) hh = sa[i] * hh + sh[i];
    }
    for (int s0 = 0; s0 < 64; s0 += 8) {
        uint2 a[8], bb[8], xg[8];
#pragma unroll
        for (int i = 0; i < 8; ++i) {
            a[i] = ldg<uint2>(ws, (unsigned)OFF_LA + base + (unsigned)((s0 + i) * 1024));
            bb[i] = ldg<uint2>(ws, (unsigned)OFF_BB + base + (unsigned)((s0 + i) * 1024));
            xg[i] = ldg<uint2>(ws, (unsigned)OFF_PXG + base + (unsigned)((s0 + i) * 1024));
        }
#pragma unroll
        for (int i = 0; i < 8; ++i) {
            float av[4], bv[4], xv[4]; bf4(a[i], av); bf4(bb[i], bv); bf4(xg[i], xv);
#pragma unroll
            for (int c = 0; c < 4; ++c) hh[c] = __expf(av[c]) * hh[c] + bv[c];
            uint2 o; o.x = f2bf(hh[0] * xv[0]) | ((unsigned)f2bf(hh[1] * xv[1]) << 16); o.y = f2bf(hh[2] * xv[2]) | ((unsigned)f2bf(hh[3] * xv[3]) << 16);
            stg<uint2>(ws, (unsigned)OFF_YC + base + (unsigned)((s0 + i) * 1024), o);
        }
    }
}

__device__ void phase4(CParams& p, int l, char* lds) {
    {
        const int tid = otid();
        if (tid < 128) hgrn_sscan(p, VB * 128 + tid);
        else if (tid < 192) rg_local(p, VB * 64 + (tid - 128));
    }
    for (int u = VB; u < 512; u += VG) s5_gemm_c(p, l, u, lds);
}

__device__ void phase_glu(CParams& p, int l, char* lds) {
    LANE_IDS;
    const int wr = wid >> 1, wc = wid & 1;
    unsigned char* ws = p.ws;
    const float* gb = p.in[14] + (size_t)l * 512;
    if (tid < 64) rg_final(p, VB * 64 + tid);
    for (int uu = VB; uu < 1536; uu += VG) {
        if (uu < 1024) { hgrn_out(p, l, uu, lds); continue; }
        const int u = uu - 1024;
        const int row0 = (u >> 2) * 128, col0 = (u & 3) * 128;
        f32x4 acc[4][4]; ZERO_ACC(acc, 4, 4);
        mma_glds<128, 128, 2, 2, true>(acc, 8, ws,
            [&](int r, int t) { return (unsigned)(OFF_YG + ((row0 + r) * 512 + t * 64) * 2); },
            [&](int c, int t) { return (unsigned)(OFF_GLUT + ((col0 + c) * 512 + t * 64) * 2); }, NoHook(), lds);
        epiT<4, 4, 64, 64>(acc, wr, wc, fq, fr, [&](int r, int cc, const f32x4& v) {
            const int row = row0 + r, col = col0 + cc;
            const f32x4 y = unpack4(ldg<uint2>(ws, (unsigned)(OFF_YG + (row * 512 + col) * 2)));
            const f32x4 bb = *(const f32x4*)(gb + col);
            f32x4 o;
#pragma unroll
            for (int i = 0; i < 4; ++i) o[i] = y[i] * sigm(v[i] + bb[i]);
            stg<uint2>(ws, (unsigned)(OFF_YB + (row * 512 + col) * 2), pack4(o)); });
    }
}

__device__ void phase_branch(CParams& p, int l, char* lds) {
    BrSched S; S.c = blockIdx.x;
    BrEpi E; E.ws = p.ws;
    g8::gemm_phase<BrEpi, BrSched, false>((LAS unsigned char*)lds, p.ws, 512, S, E);
}

__device__ void phase_out(CParams& p, int l, char* lds, char* hlds) {
    {
        OutSched S; S.A = (unsigned)OFF_MIXP; S.B = (unsigned)OFF_WOUTT; S.c = blockIdx.x; S.G = gridDim.x;
        OutEpi E; E.ws = p.ws;
        g8::gemm_phase<OutEpi, OutSched, false>((LAS unsigned char*)lds, p.ws, 1024, S, E);
    }
    const int tid = otid();
    float* fl = (float*)hlds;
    for (int u = VB; u < 6144; u += VG) {
        const int e = u / 96, r = u % 96;
        const float *s1, *s2; int ld, K, kp, nt; u16* dst; bool perm;
        if (r < 64) { s1 = p.in[28] + (size_t)(l * 64 + e) * 1024 * 256; s2 = p.in[29] + (size_t)(l * 64 + e) * 1024 * 256; ld = 256; K = 1024; kp = r & 7; nt = r >> 3; perm = true;
                      dst = (u16*)(p.ws + OFF_EW13) + (size_t)e * 512 * 1024; }
        else { s1 = p.in[30] + (size_t)(l * 64 + e) * 256 * 1024; s2 = s1; ld = 1024; K = 256; kp = (r - 64) & 1; nt = (r - 64) >> 1; perm = false;
               dst = (u16*)(p.ws + OFF_EW2) + (size_t)e * 1024 * 256; }
        const int nc = (tid & 15) * 4;
        const float* s = perm ? (((nc & 31) < 16) ? s1 : s2) : s1;
        const int col = perm ? (nt * 2 + (nc >> 5)) * 16 + (nc & 15) : nt * 64 + nc;
        float4 v[8];
#pragma unroll
        for (int i = 0; i < 8; ++i) v[i] = *(const float4*)(s + (size_t)(kp * 128 + (tid >> 4) + 16 * i) * ld + col);
        hsync();
#pragma unroll
        for (int i = 0; i < 8; ++i) { float* d = fl + ((tid >> 4) + 16 * i) * 65 + nc; d[0] = v[i].x; d[1] = v[i].y; d[2] = v[i].z; d[3] = v[i].w; }
        hsync();
#pragma unroll
        for (int j = 0; j < 4; ++j) {
            const int n = tid >> 2, k8 = (tid & 3) * 8 + 32 * j;
            uint4 o;
            o.x = f2bf(fl[(k8 + 0) * 65 + n]) | ((unsigned)f2bf(fl[(k8 + 1) * 65 + n]) << 16);
            o.y = f2bf(fl[(k8 + 2) * 65 + n]) | ((unsigned)f2bf(fl[(k8 + 3) * 65 + n]) << 16);
            o.z = f2bf(fl[(k8 + 4) * 65 + n]) | ((unsigned)f2bf(fl[(k8 + 5) * 65 + n]) << 16);
            o.w = f2bf(fl[(k8 + 6) * 65 + n]) | ((unsigned)f2bf(fl[(k8 + 7) * 65 + n]) << 16);
            *(uint4*)(dst + (size_t)(nt * 64 + n) * K + kp * 128 + k8) = o;
        }
    }
}

__device__ __forceinline__ void ln_row(float (&v)[16], const float* g, const float* bta, int lane) {
    float s = 0.f;
#pragma unroll
    for (int i = 0; i < 16; ++i) s += v[i];
    const float mu = wave_sum(s, lane) * (1.f / 1024.f);
    float q = 0.f;
#pragma unroll
    for (int i = 0; i < 16; ++i) { float d = v[i] - mu; q += d * d; }
    const float rs = rsqrtf(wave_sum(q, lane) * (1.f / 1024.f) + 1e-5f);
#pragma unroll
    for (int i = 0; i < 4; ++i) {
        const float4 gg = *(const float4*)(g + i * 256 + lane * 4), bb = *(const float4*)(bta + i * 256 + lane * 4);
        v[i * 4 + 0] = (v[i * 4 + 0] - mu) * rs * gg.x + bb.x;
        v[i * 4 + 1] = (v[i * 4 + 1] - mu) * rs * gg.y + bb.y;
        v[i * 4 + 2] = (v[i * 4 + 2] - mu) * rs * gg.z + bb.z;
        v[i * 4 + 3] = (v[i * 4 + 3] - mu) * rs * gg.w + bb.w;
    }
}

__device__ void phase_route(CParams& p, int l, char* lds) {
    LANE_IDS;
    const float* Pre = (const float*)(p.ws + OFF_PRELN);
    u16* Xm = (u16*)(p.ws + OFF_XM);
    const float* g1 = p.in[24] + (size_t)l * 1024;
    const float* b1 = p.in[25] + (size_t)l * 1024;
    const float* rbias = p.in[27] + (size_t)l * 64;
    int* cursor = (int*)(p.ws + OFF_CUR);
    int* list = (int*)(p.ws + OFF_LIST);
    float* wlist = (float*)(p.ws + OFF_WLIST);
    float* Ls = (float*)(lds + 32768);
    int* hist = (int*)(lds + 32768 + 64 * 65 * 4);
    int* basep = hist + 64;
    for (int u = VB; u < 512; u += VG) {
        const int row0 = u * 32;
#pragma unroll 1
        for (int hb = 0; hb < 2; ++hb) {
            float v[4][16];
#pragma unroll
            for (int rr = 0; rr < 4; ++rr) {
                const int row = row0 + wid * 8 + hb * 4 + rr;
#pragma unroll
                for (int i = 0; i < 4; ++i) {
                    const float4 x = *(const float4*)(Pre + (size_t)row * 1024 + i * 256 + lane * 4);
                    v[rr][i * 4] = x.x; v[rr][i * 4 + 1] = x.y; v[rr][i * 4 + 2] = x.z; v[rr][i * 4 + 3] = x.w;
                }
            }
#pragma unroll
            for (int rr = 0; rr < 4; ++rr) {
                const int row = row0 + wid * 8 + hb * 4 + rr;
                ln_row(v[rr], g1, b1, lane);
#pragma unroll
                for (int i = 0; i < 4; ++i) {
                    uint2 o; o.x = f2bf(v[rr][i * 4]) | ((unsigned)f2bf(v[rr][i * 4 + 1]) << 16); o.y = f2bf(v[rr][i * 4 + 2]) | ((unsigned)f2bf(v[rr][i * 4 + 3]) << 16);
                    *(uint2*)(Xm + (size_t)row * 1024 + i * 256 + lane * 4) = o;
                }
            }
        }
        if (tid < 64) hist[tid] = 0;
        hsync();
        f32x4 acc[1][2]; ZERO_ACC(acc, 1, 2);
        mma_glds<32, 64, 2, 2>(acc, 16, p.ws,
            [&](int r, int t) { return (unsigned)(OFF_XM + ((row0 + r) * 1024 + t * 64) * 2); },
            [&](int c, int t) { return (unsigned)(OFF_ROUTT + (c * 1024 + t * 64) * 2); }, NoHook(), lds);
#pragma unroll
        for (int n = 0; n < 2; ++n)
#pragma unroll
            for (int j = 0; j < 4; ++j) {
                const int r = (wid >> 1) * 16 + fq * 4 + j, e = (wid & 1) * 32 + n * 16 + fr;
                Ls[r * 65 + e] = sigm(acc[0][n][j]) + rbias[e];
            }
        hsync();
        int myrank[8]; int myexp[8]; float wv[8];
        if (tid < 32) {
            float* sc = Ls + tid * 65;
            float gs[8];
#pragma unroll
            for (int g = 0; g < 8; ++g) {
                float m1 = -1e30f, m2 = -1e30f;
#pragma unroll
                for (int i = 0; i < 8; ++i) { float x = sc[g * 8 + i]; if (x > m1) { m2 = m1; m1 = x; } else if (x > m2) m2 = x; }
                gs[g] = m1 + m2;
            }
            unsigned gmask = 0;
#pragma unroll
            for (int it = 0; it < 4; ++it) {
                float best = -1e30f; int bi = 0;
#pragma unroll
                for (int g = 0; g < 8; ++g) { bool ok = !((gmask >> g) & 1u) && gs[g] > best; if (ok) { best = gs[g]; bi = g; } }
                gmask |= 1u << bi;
            }
            unsigned long long chosen = 0ull;
            float wsum = 0.f;
#pragma unroll
            for (int k = 0; k < 8; ++k) {
                float best = -1e30f; int bi = 0;
                for (int e = 0; e < 64; ++e) {
                    float x = sc[e];
                    bool ok = ((gmask >> (e >> 3)) & 1u) && !((chosen >> e) & 1ull) && x > best;
                    if (ok) { best = x; bi = e; }
                }
                chosen |= 1ull << bi;
                myexp[k] = bi;
                wv[k] = best - rbias[bi];
                wsum += wv[k];
            }
            const float sc_ = 2.5f / wsum;
#pragma unroll
            for (int k = 0; k < 8; ++k) {
                wv[k] *= sc_;
                myrank[k] = atomicAdd(&hist[myexp[k]], 1);
            }
        }
        hsync();
        if (tid < 64) basep[tid] = atomicAdd(&cursor[tid], hist[tid]);
        hsync();
        if (tid < 32) {
#pragma unroll
            for (int k = 0; k < 8; ++k) {
                const size_t pos = (size_t)myexp[k] * NTOK + basep[myexp[k]] + myrank[k];
                list[pos] = (row0 + tid) * 8 + k;
                wlist[pos] = wv[k];
            }
        }
        hsync();
    }
}

__device__ void phase_combine(CParams& p, int l) {
    LANE_IDS;
    typedef float f32x2 __attribute__((ext_vector_type(2)));
    unsigned char* ws = p.ws;
    const float* g2 = p.in[34] + (size_t)l * 1024 + lane * 16;
    const float* b2 = p.in[35] + (size_t)l * 1024 + lane * 16;
    for (int row = VB * 4 + wid; row < NTOK; row += VG * 4) {
        f32x4 y[4]; uint4 xm[2]; u32x4 yb[8];
#pragma unroll
        for (int i = 0; i < 2; ++i) { const uint4 q = ldg<uint4>(ws, (unsigned)(OFF_YSH + (row * 1024 + lane * 16 + i * 8) * 2)); y[i * 2] = unpack4(uint2{q.x, q.y}); y[i * 2 + 1] = unpack4(uint2{q.z, q.w}); }
#pragma unroll
        for (int i = 0; i < 2; ++i) xm[i] = ldg<uint4>(ws, (unsigned)(OFF_XM + (row * 1024 + lane * 16 + i * 8) * 2));
#pragma unroll
        for (int k = 0; k < 8; ++k) yb[k] = ldg<u32x4>(ws, (unsigned)OFF_YBUF + (unsigned)((row * 8 + k) * 1024 + lane * 16));
        float v[16], s[16];
#pragma unroll
        for (int i = 0; i < 16; ++i) s[i] = 0.f;
#pragma unroll
        for (int k = 0; k < 8; ++k)
#pragma unroll
            for (int w = 0; w < 4; ++w) {
                const f32x2 lo = __builtin_amdgcn_cvt_pk_f32_fp8((int)yb[k][w], false), hi = __builtin_amdgcn_cvt_pk_f32_fp8((int)yb[k][w], true);
                s[w * 4 + 0] += lo.x; s[w * 4 + 1] += lo.y; s[w * 4 + 2] += hi.x; s[w * 4 + 3] += hi.y;
            }
#pragma unroll
        for (int i = 0; i < 2; ++i) {
            const uint4 x = xm[i];
            const float xf[8] = {bf2f((u16)(x.x & 0xffff)), bf2f((u16)(x.x >> 16)), bf2f((u16)(x.y & 0xffff)), bf2f((u16)(x.y >> 16)),
                                 bf2f((u16)(x.z & 0xffff)), bf2f((u16)(x.z >> 16)), bf2f((u16)(x.w & 0xffff)), bf2f((u16)(x.w >> 16))};
#pragma unroll
            for (int j = 0; j < 8; ++j) v[i * 8 + j] = y[i * 2 + (j >> 2)][j & 3] + DN_ALPHA * xf[j] + s[i * 8 + j] * (1.f / 32.f);
        }
        float sum = 0.f;
#pragma unroll
        for (int i = 0; i < 16; ++i) sum += v[i];
        const float mu = wave_sum(sum, lane) * (1.f / 1024.f);
        float q = 0.f;
#pragma unroll
        for (int i = 0; i < 16; ++i) { const float d = v[i] - mu; q += d * d; }
        const float rs = rsqrtf(wave_sum(q, lane) * (1.f / 1024.f) + 1e-5f);
#pragma unroll
        for (int i = 0; i < 4; ++i) {
            const f32x4 gg = *(const f32x4*)(g2 + i * 4), bb = *(const f32x4*)(b2 + i * 4);
#pragma unroll
            for (int j = 0; j < 4; ++j) v[i * 4 + j] = (v[i * 4 + j] - mu) * rs * gg[j] + bb[j];
            if (l == 1) stg<f32x4>(p.out, (unsigned)((row * 1024 + lane * 16 + i * 4) * 4), f32x4{v[i * 4], v[i * 4 + 1], v[i * 4 + 2], v[i * 4 + 3]});
        }
#pragma unroll
        for (int i = 0; i < 2; ++i) {
            uint4 o;
            o.x = f2bf(v[i * 8 + 0]) | ((unsigned)f2bf(v[i * 8 + 1]) << 16); o.y = f2bf(v[i * 8 + 2]) | ((unsigned)f2bf(v[i * 8 + 3]) << 16);
            o.z = f2bf(v[i * 8 + 4]) | ((unsigned)f2bf(v[i * 8 + 5]) << 16); o.w = f2bf(v[i * 8 + 6]) | ((unsigned)f2bf(v[i * 8 + 7]) << 16);
            stg<uint4>(ws, (unsigned)(OFF_XB + (row * 1024 + lane * 16 + i * 8) * 2), o);
        }
    }
}


#define XB_TMO      128
#define XB_XCNT(j)  (256  + 64 * (j))
#define XB_XSUB(j)  (1280 + 64 * (j))
#define XB_XGEN(j)  (2304 + 64 * (j))
#define XB_TOP      3328
#define XB_TOPGEN   3392
#define XCD_BAR_WORDS 3456
#define XB_SPIN_CAP (1u << 22)
__device__ __forceinline__ unsigned xb_ld(unsigned* p)              { return __hip_atomic_load(p, __ATOMIC_RELAXED, __HIP_MEMORY_SCOPE_AGENT); }
__device__ __forceinline__ unsigned xb_add(unsigned* p, unsigned v) { return __hip_atomic_fetch_add(p, v, __ATOMIC_RELAXED, __HIP_MEMORY_SCOPE_AGENT); }
__device__ __forceinline__ unsigned xb_xcc_id() { return (unsigned)__builtin_amdgcn_s_getreg((3 << 11) | 20) & 0xFu; }
#define XB_SPIN(cond, bar) do { unsigned _sp = 0; while (cond) { __builtin_amdgcn_s_sleep(1); \
    if ((++_sp & 255u) == 0u) { if (xb_ld(&(bar)[XB_TMO])) break; if (_sp > XB_SPIN_CAP) { atomicAdd(&(bar)[XB_TMO], 1u); break; } } } } while (0)
struct XcdBarrier { unsigned* bar; unsigned x; volatile LAS unsigned* st; };
__device__ __forceinline__ XcdBarrier xcd_barrier_post(unsigned* bar, volatile LAS unsigned* st) {
    XcdBarrier b; b.bar = bar; b.x = xb_xcc_id(); b.st = st;
    if (threadIdx.x == 0) (void)xb_add(&bar[XB_XCNT(b.x)], 1u);
    return b;
}
__device__ __forceinline__ void xcd_barrier_complete(unsigned* bar, unsigned x, unsigned& nloc, unsigned& nx) {
    const unsigned G = gridDim.x * gridDim.y * gridDim.z;
    unsigned sum, cnt, mine, sp = 0u;
    for (;;) {
        sum = 0u; cnt = 0u; mine = 0u;
#pragma unroll
        for (unsigned j = 0; j < 16; ++j) { const unsigned c = xb_ld(&bar[XB_XCNT(j)]); sum += c; cnt += (c > 0u) ? 1u : 0u; mine = (j == x) ? c : mine; }
        if (sum == G) break;
        __builtin_amdgcn_s_sleep(1);
        if ((++sp & 255u) == 0u) { if (xb_ld(&bar[XB_TMO])) break; if (sp > XB_SPIN_CAP) { atomicAdd(&bar[XB_TMO], 1u); break; } }
    }
    nloc = mine > 0u ? mine : 1u; nx = cnt > 0u ? cnt : 1u;
}
__device__ __forceinline__ void xcd_barrier(const XcdBarrier& b) {
    asm volatile("s_waitcnt vmcnt(0)" ::: "memory");
    __syncthreads();
    if (threadIdx.x == 0) {
        unsigned* bar = b.bar;
        __builtin_amdgcn_s_waitcnt(0);
        unsigned nloc = b.st[0], nx = b.st[1];
        if (nloc == 0u) { xcd_barrier_complete(bar, b.x, nloc, nx); b.st[0] = nloc; b.st[1] = nx; }
        const unsigned old = xb_add(&bar[XB_XSUB(b.x)], 1u);
        const unsigned gen = old / nloc;
        if (old + 1u == (gen + 1u) * nloc) {
            __builtin_amdgcn_fence(__ATOMIC_RELEASE, "agent");
            asm volatile("s_waitcnt vmcnt(0)" ::: "memory");
            const unsigned og = xb_add(&bar[XB_TOP], 1u);
            const unsigned tg = og / nx;
            if (og + 1u == (tg + 1u) * nx) xb_add(&bar[XB_TOPGEN], 1u);
            else XB_SPIN(xb_ld(&bar[XB_TOPGEN]) == tg, bar);
            __builtin_amdgcn_fence(__ATOMIC_ACQUIRE, "agent");
            xb_add(&bar[XB_XGEN(b.x)], 1u);
            asm volatile("s_waitcnt vmcnt(0)" ::: "memory");
        } else {
            XB_SPIN(xb_ld(&bar[XB_XGEN(b.x)]) == gen, bar);
            __builtin_amdgcn_fence(__ATOMIC_ACQUIRE, "agent");
            asm volatile("s_waitcnt vmcnt(0)" ::: "memory");
        }
    }
    __syncthreads();
}

__global__ void __launch_bounds__(512, 2) fwd_kernel(Params p_unused) {
    char* lds = g_lds;
    cg::grid_group grid = cg::this_grid();
    CParams* pp = (CParams*)__builtin_amdgcn_kernarg_segment_ptr();
    const int ph_lo = pp->ph_lo;
    volatile LAS unsigned* xst = (volatile LAS unsigned*)(lds + L_XST);
    if (threadIdx.x == 0) { xst[0] = 0u; xst[1] = 0u; *(LAS unsigned*)(lds + 147456 + 16) = 0u; *(LAS unsigned*)(lds + 147456 + 20) = 0u; *(LAS unsigned*)(lds + 147456 + 32) = 0u; }
    __syncthreads();
    const XcdBarrier xb = xcd_barrier_post((unsigned*)(pp->ws + OFF_BAR), xst);
    char* hlds = lds + __builtin_amdgcn_readfirstlane((int)(threadIdx.x >> 8)) * HLDS;
    unsigned long long tq_acc = 0;
    (void)ph_lo;
#pragma unroll
    for (int ph = 0; ph < 2 * NPH; ++ph) {
        asm volatile("" : "+s"(pp));
        CParams& p = *pp;
        const int l = ph / NPH, q = ph % NPH;
        unsigned long long tq0 = 0;
        if (PROBE_TQ >= 0 && q == PROBE_TQ) tq0 = __builtin_amdgcn_s_memrealtime();
#pragma unroll 1
        for (int rep = 0; rep < 1 + (int)((PROBE_MASK >> q) & 1u); ++rep) {
            if (rep) xcd_barrier(xb);
            switch (q) {
                case 0: phase_w(p, l, hlds); break;
                case 1: phase_proj(p, l, lds); break;
                case 2: phase2(p, l, hlds); break;
                case 3: phase3(p, l, hlds); break;
                case 4: phase4(p, l, hlds); break;
                case 5: phase_glu(p, l, hlds); break;
                case 6: phase_branch(p, l, lds); break;
                case 7: phase_out(p, l, lds, hlds); break;
                case 8: phase_route(p, l, hlds); break;
                case 9: phase_moe1(p, l, lds); break;
                case 10: phase_moe2(p, l, lds); break;
                default: phase_combine(p, l); break;
            }
        }
        if (ph + 1 < 2 * NPH) {
            if (p.coop == 1) xcd_barrier(xb);
            else if (p.coop == 2) grid.sync();
        }
        if (PROBE_TQ >= 0 && q == PROBE_TQ) tq_acc += __builtin_amdgcn_s_memrealtime() - tq0;
    }
    if (PROBE_TQ == 98) tq_acc = *(LAS unsigned*)(lds + 147456 + 32);
    if (PROBE_TQ >= 0 && blockIdx.x == 0) {
        const unsigned long long t0 = __builtin_amdgcn_s_memrealtime();
        while (__builtin_amdgcn_s_memrealtime() - t0 < 4ull * tq_acc) __builtin_amdgcn_s_sleep(8);
    }
}

extern "C" void kernel_launch(void* const* d_in, const int* in_sizes, int n_in, void* d_out, int out_size, void* d_ws, size_t ws_size,
                              hipStream_t stream) {
    static int grid_blocks = 0;
    if (!grid_blocks) {
        int dev = 0, cus = 0, per_cu = 0;
        (void)hipGetDevice(&dev);
        (void)hipDeviceGetAttribute(&cus, hipDeviceAttributeMultiprocessorCount, dev);
        (void)hipFuncSetAttribute((const void*)fwd_kernel, hipFuncAttributeMaxDynamicSharedMemorySize, LDS_BYTES);
        (void)hipOccupancyMaxActiveBlocksPerMultiprocessor(&per_cu, fwd_kernel, 512, LDS_BYTES);
        if (per_cu < 1) per_cu = 1;
        per_cu = 1;
        grid_blocks = cus * per_cu;
        if (ws_size < WS_NEED) fprintf(stderr, "kernel_launch: workspace too small: %zu < %zu\n", ws_size, (size_t)WS_NEED);
    }
    Params p{};
    for (int i = 0; i < 36; ++i) p.in[i] = (const float*)d_in[i];
    p.out = (float*)d_out;
    p.ws = (unsigned char*)d_ws;
    p.ph_lo = 0; p.ph_hi = 2 * NPH; p.coop = 1; p.pad = 0;
    (void)hipMemsetAsync((char*)d_ws + OFF_BAR, 0, XCD_BAR_WORDS * 4, stream);
    void* args[] = {&p};
    hipError_t e = hipLaunchCooperativeKernel((void*)fwd_kernel, dim3(grid_blocks), dim3(512), args, LDS_BYTES, stream);
    if (e != hipSuccess) fprintf(stderr, "cooperative launch failed: %s (grid %d)\n", hipGetErrorString(e), grid_blocks);
}
```

```cpp
#include <hip/hip_runtime.h>
#include <hip/hip_cooperative_groups.h>
#include <cstdio>
#include <cstdint>
namespace cg = cooperative_groups;

typedef unsigned short u16;
typedef __attribute__((ext_vector_type(8))) short bf16x8;
typedef __attribute__((ext_vector_type(4))) float f32x4;
typedef __attribute__((ext_vector_type(4))) unsigned u32x4;
#define LAS __attribute__((address_space(3)))

constexpr int NTOK = 16384, DM = 1024, SEQ = 4096, BW = 512, INC = 6656;
constexpr int NE = 64, EH = 256;
#ifndef PROBE_MASK
#define PROBE_MASK 0u
#endif
#define PROBE_TIMEK_ProjEpi false
#define PROBE_TIMEK_OutEpi false
#define PROBE_TIMEK_BrEpi false
#define PROBE_TIMEK_Moe1Epi false
#define PROBE_TIMEK_Moe2Epi false
#define PROBE_TIMEK_ShEpi false
#define PROBE_TQ -1
constexpr int NPH = 12;
constexpr float DN_ALPHA = 1.4142135623730951f;
constexpr size_t SLOT = 16777216ull;

constexpr size_t OFF_WINT  = 0;
constexpr size_t OFF_WBRT  = 13631488;
constexpr size_t OFF_WOUTT = 16777216;
constexpr size_t OFF_GLUT  = 18874368;
constexpr size_t OFF_RGT   = 19398656;
constexpr size_t OFF_SH13T = 19660800;
constexpr size_t OFF_SH2T  = 20709376;
constexpr size_t OFF_BTA   = 21233664;
constexpr size_t OFF_BTC   = 23330816;
constexpr size_t OFF_ROUTT = 29622272;
constexpr size_t OFF_MISC  = 29753344;
constexpr size_t OFF_LB    = OFF_MISC;
constexpr size_t OFF_CUR   = OFF_MISC + 2048;
constexpr size_t OFF_DEC   = OFF_MISC + 4096;
constexpr size_t OFF_SEGA  = OFF_DEC + 524288;
constexpr size_t OFF_SEGH  = OFF_SEGA + 524288;
constexpr size_t OFF_BGC   = OFF_SEGH + 524288;
constexpr size_t OFF_XB    = 2 * SLOT;
constexpr size_t OFF_VC    = 29 * SLOT;
constexpr size_t OFF_XC    = 30 * SLOT;
constexpr size_t OFF_MIXP  = 30 * SLOT;
constexpr size_t OFF_LIST  = 2 * SLOT;
constexpr size_t OFF_HSH   = 2 * SLOT + 4194304;
constexpr size_t OFF_WLIST = 2 * SLOT + 4194304 + 8388608;
constexpr size_t OFF_PQ    = 4 * SLOT;
constexpr size_t OFF_PLF   = 5 * SLOT;
constexpr size_t OFF_PK    = 7 * SLOT;
constexpr size_t OFF_PV    = 8 * SLOT;
constexpr size_t OFF_YC    = 8 * SLOT;
constexpr size_t OFF_PG    = 9 * SLOT;
constexpr size_t OFF_PU    = 10 * SLOT;
constexpr size_t OFF_PXG   = 11 * SLOT;
constexpr size_t OFF_PXR   = 12 * SLOT;
constexpr size_t OFF_YB    = 12 * SLOT;
constexpr size_t OFF_PGATE = 13 * SLOT;
constexpr size_t OFF_KTT   = 19 * SLOT;
constexpr size_t OFF_YA    = 19 * SLOT;
constexpr size_t OFF_VT    = 20 * SLOT;
constexpr size_t OFF_ST    = 21 * SLOT;
constexpr size_t OFF_LA    = 23 * SLOT;
constexpr size_t OFF_BB    = 24 * SLOT;
constexpr size_t OFF_YG    = 25 * SLOT;
constexpr size_t OFF_HC    = 26 * SLOT;
constexpr size_t OFF_UT    = 27 * SLOT;
constexpr size_t OFF_PRELN = 4 * SLOT;
constexpr size_t OFF_XM    = 8 * SLOT;
constexpr size_t OFF_EW13  = 10 * SLOT;
constexpr size_t OFF_EW2   = 14 * SLOT;
constexpr size_t OFF_HBUF  = 4 * SLOT;
constexpr size_t OFF_YBUF  = 16 * SLOT;
constexpr size_t OFF_YSH   = 24 * SLOT;
constexpr size_t OFF_BAR   = 32 * SLOT;
constexpr int HLDS = 73728;
constexpr int LDS_BYTES = 2 * HLDS + 64;
constexpr int L_XST = 2 * HLDS;
constexpr size_t WS_NEED   = 32 * SLOT + 16384;

struct Params {
    const float* in[36];
    float* out;
    unsigned char* ws;
    int ph_lo, ph_hi;
    int coop, pad;
};
typedef const __attribute__((address_space(4))) Params CParams;

__device__ __forceinline__ u16 f2bf(float f) {
    unsigned u = __builtin_bit_cast(unsigned, f);
    return (u16)((u + 0x7fffu + ((u >> 16) & 1u)) >> 16);
}
__device__ __forceinline__ float bf2f(u16 h) { return __builtin_bit_cast(float, (unsigned)h << 16); }
__device__ __forceinline__ float sigm(float x) { return __builtin_amdgcn_rcpf(1.f + __expf(-x)); }
__device__ __forceinline__ float silu_f(float x) { return x * sigm(x); }
__device__ __forceinline__ float gelu_f(float x) {
    float u = 0.7978845608028654f * (x + 0.044715f * x * x * x);
    float t = 1.f - 2.f * __builtin_amdgcn_rcpf(1.f + __expf(2.f * u));
    return 0.5f * x * (1.f + t);
}
__device__ __forceinline__ float shfl_xor_l(float v, int o, int lane) {
    return __builtin_bit_cast(float, __builtin_amdgcn_ds_bpermute((lane ^ o) << 2, __builtin_bit_cast(int, v)));
}
__device__ __forceinline__ float wave_sum(float v, int lane) {
    (void)lane;
    v += __builtin_bit_cast(float, __builtin_amdgcn_update_dpp(0, __builtin_bit_cast(int, v), 0xB1, 0xF, 0xF, true));
    v += __builtin_bit_cast(float, __builtin_amdgcn_update_dpp(0, __builtin_bit_cast(int, v), 0x4E, 0xF, 0xF, true));
    v += __builtin_bit_cast(float, __builtin_amdgcn_update_dpp(0, __builtin_bit_cast(int, v), 0x124, 0xF, 0xF, true));
    v += __builtin_bit_cast(float, __builtin_amdgcn_update_dpp(0, __builtin_bit_cast(int, v), 0x128, 0xF, 0xF, true));
    const float s0 = __builtin_bit_cast(float, __builtin_amdgcn_readlane(__builtin_bit_cast(int, v), 0));
    const float s1 = __builtin_bit_cast(float, __builtin_amdgcn_readlane(__builtin_bit_cast(int, v), 16));
    const float s2 = __builtin_bit_cast(float, __builtin_amdgcn_readlane(__builtin_bit_cast(int, v), 32));
    const float s3 = __builtin_bit_cast(float, __builtin_amdgcn_readlane(__builtin_bit_cast(int, v), 48));
    return (s0 + s1) + (s2 + s3);
}
__device__ __forceinline__ int swz(int row, int ch) { return row * 128 + ((ch ^ ((row >> 1) & 7)) << 4); }


template <class T> __device__ __forceinline__ T ldg(const void* base, unsigned off) { return *(const T*)((const char*)base + off); }
template <class T> __device__ __forceinline__ void stg(void* base, unsigned off, T v) { *(T*)((char*)base + off) = v; }
template <class T> __device__ __forceinline__ void stg_nt(void* base, unsigned off, T v) { __builtin_nontemporal_store(v, (T*)((char*)base + off)); }

template <int TM, int TN, int RW, int CW, class F>
__device__ __forceinline__ void epi(f32x4 (&acc)[TM][TN], int wr, int wc, int fq, int fr, F f) {
#pragma unroll
    for (int m = 0; m < TM; ++m) {
#pragma unroll
        for (int j = 0; j < 4; ++j) {
#pragma unroll
            for (int n = 0; n < TN; ++n) f(wr * RW + m * 16 + fq * 4 + j, wc * CW + n * 16 + fr, acc[m][n][j]);
        }
        __builtin_amdgcn_sched_barrier(0);
    }
}

template <int TM, int TN, int RW, int CW, class F>
__device__ __forceinline__ void epiT(f32x4 (&acc)[TM][TN], int wr, int wc, int fq, int fr, F f) {
#pragma unroll
    for (int m = 0; m < TM; ++m) {
#pragma unroll
        for (int n = 0; n < TN; ++n) f(wr * RW + m * 16 + fr, wc * CW + n * 16 + fq * 4, acc[m][n]);
    }
}
__device__ __forceinline__ uint2 pack4(const f32x4& a) {
    uint2 w; w.x = f2bf(a[0]) | ((unsigned)f2bf(a[1]) << 16); w.y = f2bf(a[2]) | ((unsigned)f2bf(a[3]) << 16); return w;
}
__device__ __forceinline__ f32x4 unpack4(const uint2 q) {
    return f32x4{bf2f((u16)(q.x & 0xffff)), bf2f((u16)(q.x >> 16)), bf2f((u16)(q.y & 0xffff)), bf2f((u16)(q.y >> 16))};
}

extern __shared__ __attribute__((aligned(16))) char g_lds[];
__device__ __forceinline__ void hsync() {
    asm volatile("s_waitcnt vmcnt(0) lgkmcnt(0)" ::: "memory");
    LAS unsigned* ctr = (LAS unsigned*)(g_lds + 2 * 73728 + 16) + __builtin_amdgcn_readfirstlane((int)(threadIdx.x >> 8));
    unsigned old = 0;
    if (__builtin_amdgcn_mbcnt_hi(~0u, __builtin_amdgcn_mbcnt_lo(~0u, 0u)) == 0) old = __hip_atomic_fetch_add(ctr, 1u, __ATOMIC_RELAXED, __HIP_MEMORY_SCOPE_WORKGROUP);
    old = __builtin_amdgcn_readfirstlane(old);
    const unsigned target = (old & ~3u) + 4u;
    while (__hip_atomic_load(ctr, __ATOMIC_RELAXED, __HIP_MEMORY_SCOPE_WORKGROUP) < target) __builtin_amdgcn_s_sleep(1);
    asm volatile("" ::: "memory");
}

__device__ __forceinline__ int otid() { int t = threadIdx.x & 255; asm volatile("" : "+v"(t)); return t; }
#define VB ((int)blockIdx.x * 2 + __builtin_amdgcn_readfirstlane((int)(threadIdx.x >> 8)))
#define VG ((int)gridDim.x * 2)

struct NoHook { __device__ __forceinline__ void operator()(int) const {} };

template <int BM, int BN, int WM, int WN, bool TR = false, class AL, class BL, class HK>
__device__ __forceinline__ void mma_loop(f32x4 (&acc)[BM / WM / 16][BN / WN / 16], int nk, AL aload, BL bload, HK hook, char* lds) {
    constexpr int TM = BM / WM / 16, TN = BN / WN / 16;
    constexpr int ACH = BM / 32, BCH = BN / 32;
    const int tid = otid(), lane = tid & 63, wid = tid >> 6;
    const int wr = wid / WN, wc = wid % WN, fr = lane & 15, fq = lane >> 4;
    const int srow = tid >> 3, sk = (tid & 7) * 8;
    const int swr = srow * 128 + (((tid & 7) ^ ((tid >> 4) & 7)) << 4);
    const int xr = (fr >> 1) & 7;
    const int a_rd = (wr * (BM / WM) + fr) * 128;
    const int b_rd = BM * 128 + (wc * (BN / WN) + fr) * 128;
    bf16x8 ra[ACH], rb[BCH];
#pragma unroll
    for (int i = 0; i < ACH; ++i) ra[i] = aload(srow + i * 32, sk);
#pragma unroll
    for (int i = 0; i < BCH; ++i) rb[i] = bload(srow + i * 32, sk);
#pragma unroll 1
    for (int t = 0; t < nk; ++t) {
        hsync();
#pragma unroll
        for (int i = 0; i < ACH; ++i) *(bf16x8*)(lds + swr + i * 4096) = ra[i];
#pragma unroll
        for (int i = 0; i < BCH; ++i) *(bf16x8*)(lds + BM * 128 + swr + i * 4096) = rb[i];
        hsync();
        if (t + 1 < nk) {
#pragma unroll
            for (int i = 0; i < ACH; ++i) ra[i] = aload(srow + i * 32, (t + 1) * 64 + sk);
#pragma unroll
            for (int i = 0; i < BCH; ++i) rb[i] = bload(srow + i * 32, (t + 1) * 64 + sk);
        }
        hook(t);
#pragma unroll
        for (int ks = 0; ks < 2; ++ks) {
            const int co = ((ks * 4 + fq) ^ xr) << 4;
            bf16x8 af[TM], bfr[TN];
#pragma unroll
            for (int m = 0; m < TM; ++m) af[m] = *(const bf16x8*)(lds + a_rd + m * 2048 + co);
#pragma unroll
            for (int n = 0; n < TN; ++n) bfr[n] = *(const bf16x8*)(lds + b_rd + n * 2048 + co);
#pragma unroll
            for (int m = 0; m < TM; ++m)
#pragma unroll
                for (int n = 0; n < TN; ++n) acc[m][n] = TR ? __builtin_amdgcn_mfma_f32_16x16x32_bf16(bfr[n], af[m], acc[m][n], 0, 0, 0)
                                                            : __builtin_amdgcn_mfma_f32_16x16x32_bf16(af[m], bfr[n], acc[m][n], 0, 0, 0);
        }
    }
}

template <int BM, int BN, int WM, int WN, bool TR = false, class AO, class BO, class HK>
__device__ __forceinline__ void mma_glds(f32x4 (&acc)[BM / WM / 16][BN / WN / 16], int nk, const unsigned char* ws, AO aoff, BO boff, HK hook, char* lds) {
    constexpr int TM = BM / WM / 16, TN = BN / WN / 16;
    constexpr int ACH = BM / 32, BCH = BN / 32, BUF = (BM + BN) * 128;
    const int tid = otid(), lane = tid & 63, wid = tid >> 6;
    const int wr = wid / WN, wc = wid % WN, fr = lane & 15, fq = lane >> 4;
    const int srow = tid >> 3;
    const unsigned csrc = (unsigned)(((tid & 7) ^ ((tid >> 4) & 7)) << 4);
    const int xr = (fr >> 1) & 7;
    const int a_rd = (wr * (BM / WM) + fr) * 128;
    const int b_rd = BM * 128 + (wc * (BN / WN) + fr) * 128;
    auto stage = [&](int buf, int t) {
        char* d = lds + buf * BUF + tid * 16;
#pragma unroll
        for (int i = 0; i < ACH; ++i)
            __builtin_amdgcn_global_load_lds((const unsigned*)(ws + (aoff(srow + i * 32, t) + csrc)), (unsigned*)(d + i * 4096), 16, 0, 0);
#pragma unroll
        for (int i = 0; i < BCH; ++i)
            __builtin_amdgcn_global_load_lds((const unsigned*)(ws + (boff(srow + i * 32, t) + csrc)), (unsigned*)(d + BM * 128 + i * 4096), 16, 0, 0);
    };
    hsync();
    stage(0, 0);
#pragma unroll 1
    for (int t = 0; t < nk; ++t) {
        asm volatile("s_waitcnt vmcnt(0)" ::: "memory");
        hsync();
        if (t + 1 < nk) stage((t + 1) & 1, t + 1);
        hook(t);
        const char* bb = lds + (t & 1) * BUF;
#pragma unroll
        for (int ks = 0; ks < 2; ++ks) {
            const int co = ((ks * 4 + fq) ^ xr) << 4;
            bf16x8 af[TM], bfr[TN];
#pragma unroll
            for (int m = 0; m < TM; ++m) af[m] = *(const bf16x8*)(bb + a_rd + m * 2048 + co);
#pragma unroll
            for (int n = 0; n < TN; ++n) bfr[n] = *(const bf16x8*)(bb + b_rd + n * 2048 + co);
#pragma unroll
            for (int m = 0; m < TM; ++m)
#pragma unroll
                for (int n = 0; n < TN; ++n) acc[m][n] = TR ? __builtin_amdgcn_mfma_f32_16x16x32_bf16(bfr[n], af[m], acc[m][n], 0, 0, 0)
                                                            : __builtin_amdgcn_mfma_f32_16x16x32_bf16(af[m], bfr[n], acc[m][n], 0, 0, 0);
        }
    }
}

#define ZERO_ACC(acc, TM, TN) _Pragma("unroll") for (int m_ = 0; m_ < TM; ++m_) _Pragma("unroll") for (int n_ = 0; n_ < TN; ++n_) acc[m_][n_] = f32x4{0.f, 0.f, 0.f, 0.f}

#define LANE_IDS const int tid = otid(), lane = tid & 63, wid = tid >> 6, fr = lane & 15, fq = lane >> 4; (void)tid; (void)lane; (void)wid; (void)fr; (void)fq

namespace g8 {
constexpr int BM = 256, BK = 64, HALF = 128, HTB = HALF * BK * 2, STAGE_BYTES = 8 * HTB;
__device__ __forceinline__ int lds_byte(int r, int c) { const int st = (r >> 4) * 2 + (c >> 5), rr = r & 15, cc = c & 31, ob = rr * 64 + cc * 2; return st * 1024 + (ob ^ (((ob >> 9) & 1) << 5)); }
__device__ __forceinline__ void stage_rc(int b, int& R, int& C) { const int st = b / 1024, sb = b % 1024, swz = sb ^ (((sb >> 9) & 1) << 5); R = (st >> 1) * 16 + swz / 64; C = (st & 1) * 32 + (swz % 64) / 2; }
__device__ __forceinline__ int perm32(int rho) { const int n = rho >> 4, i = rho & 15; return 8 * (i >> 2) + 4 * n + (i & 3); }
struct Unit { unsigned A, B; int pm, pn, x0, x1; };
__device__ __forceinline__ unsigned cvt_pk_bf16(float lo, float hi) { unsigned r; asm volatile("v_cvt_pk_bf16_f32 %0, %1, %2" : "=v"(r) : "v"(lo), "v"(hi)); return r; }

template <class Epi, class Sched, bool GATHER>
__device__ __forceinline__ void gemm_phase(LAS unsigned char* lds, const unsigned char* wsb, const int K, const Sched& S, const Epi& E) {
    int tid_ = threadIdx.x; asm volatile("" : "+v"(tid_));
    const int tid = tid_, wid = __builtin_amdgcn_readfirstlane(tid >> 6), lane = tid & 63, wr = wid >> 2, wc = wid & 3, fr = lane & 15, fq = lane >> 4;
    const int nt = K / BK;
    unsigned voffA[2], voffB[2];
#pragma unroll
    for (int i = 0; i < 2; ++i) { int R, C; stage_rc(tid * 16 + i * 8192, R, C); const int Rb = Epi::PERM ? ((R & ~31) + perm32(R & 31)) : R;
        voffA[i] = (unsigned)(R * K + C) * 2u; voffB[i] = (unsigned)(Rb * K + C) * 2u; }
    const unsigned kstep = (unsigned)(BK * 2);
    const unsigned hstep = (unsigned)(HALF * K * 2);
    const unsigned ldsw = (unsigned)wid * 1024u;
    const int aoff = lds_byte(wr * 64 + fr, fq * 8), boff = lds_byte(wc * 32 + fr, fq * 8);
#define G8_SA(b, h) (((b) * 2 + (h)) * HTB)
#define G8_SB(b, h) ((4 + (b) * 2 + (h)) * HTB)
#define G8_STAGE(bufoff, gbase, voff) do { _Pragma("unroll") for (int _i = 0; _i < 2; ++_i) \
        __builtin_amdgcn_global_load_lds((const unsigned*)(wsb + (unsigned)((gbase) + (voff)[_i])), (LAS unsigned*)(lds + (bufoff) + ldsw + _i * 8192), 16, 0, 0); } while (0)
#define G8_STAGE_A(bufoff, kp, h, vg) do { if (GATHER) G8_STAGE(bufoff, kp, vg[h]); else G8_STAGE(bufoff, (kp) + (h) * hstep, voffA); } while (0)
#define G8_LDA(dst, b, h) do { _Pragma("unroll") for (int m = 0; m < 4; ++m) _Pragma("unroll") for (int k = 0; k < 2; ++k) dst[m][k] = *(const LAS bf16x8*)(lds + G8_SA(b, h) + aoff + m * 2048 + k * 1024); } while (0)
#define G8_LDB(dst, b, h) do { _Pragma("unroll") for (int n = 0; n < 2; ++n) _Pragma("unroll") for (int k = 0; k < 2; ++k) dst[n][k] = *(const LAS bf16x8*)(lds + G8_SB(b, h) + boff + n * 2048 + k * 1024); } while (0)
#define G8_MMA(ai, bj, At, Bt) do { __builtin_amdgcn_s_setprio(1); _Pragma("unroll") for (int m = 0; m < 4; ++m) _Pragma("unroll") for (int n = 0; n < 2; ++n) _Pragma("unroll") for (int k = 0; k < 2; ++k) \
        acc[ai][bj][m][n] = __builtin_amdgcn_mfma_f32_16x16x32_bf16(Bt[n][k], At[m][k], acc[ai][bj][m][n], 0, 0, 0); __builtin_amdgcn_s_setprio(0); } while (0)
#define G8_WAIT_V(n) asm volatile("s_waitcnt vmcnt(" #n ")" ::: "memory")
#define G8_WAIT_L(n) asm volatile("s_waitcnt lgkmcnt(" #n ")" ::: "memory")
#define G8_BAR __builtin_amdgcn_s_barrier()
#define G8_SCHED __builtin_amdgcn_sched_barrier(0)
#define G8_GOFF(dst, u) do { _Pragma("unroll") for (int _i = 0; _i < 2; ++_i) { int _R, _C; stage_rc(tid * 16 + _i * 8192, _R, _C); \
        _Pragma("unroll") for (int _h = 0; _h < 2; ++_h) dst[_h][_i] = (unsigned)(S.row(u, _h * HALF + _R) * K + _C) * 2u; } \
        asm volatile("" : "+v"(dst[0][0]), "+v"(dst[0][1]), "+v"(dst[1][0]), "+v"(dst[1][1])); } while (0)
    Unit cur, nxt; int ui = 0;
    if (!S.next(0, cur)) return;
    f32x4 acc[2][2][4][2];
#pragma unroll
    for (int a = 0; a < 2; ++a)
#pragma unroll
        for (int b = 0; b < 2; ++b)
#pragma unroll
            for (int m = 0; m < 4; ++m)
#pragma unroll
                for (int n = 0; n < 2; ++n) acc[a][b][m][n] = (f32x4){0.f, 0.f, 0.f, 0.f};
    bf16x8 At[4][2], B0[2][2], B1[2][2];
    unsigned vgc[2][2] = {{0u, 0u}, {0u, 0u}};
    unsigned cA = cur.A, cB = cur.B;
    if (GATHER) { G8_GOFF(vgc, cur); }
    G8_STAGE(G8_SB(0, 0), cB, voffB); G8_STAGE_A(G8_SA(0, 0), cA, 0, vgc); G8_STAGE(G8_SB(0, 1), cB + hstep, voffB); G8_STAGE_A(G8_SA(0, 1), cA, 1, vgc);
    if (wr == 1) G8_BAR;
    G8_WAIT_V(4); G8_BAR;
    G8_STAGE(G8_SB(1, 0), cB + kstep, voffB); G8_STAGE_A(G8_SA(1, 0), cA + kstep, 0, vgc); G8_STAGE(G8_SB(1, 1), cB + hstep + kstep, voffB);
    G8_WAIT_V(6); G8_BAR;
    for (;;) {
        if (Epi::ROWTAB && tid < 256)
            __builtin_amdgcn_global_load_lds((const unsigned*)(wsb + (E.tab_off(cur) + (unsigned)tid * 4u)), (LAS unsigned*)(lds + STAGE_BYTES + 12288 + (ui & 1) * 1024 + wid * 256), 4, 0, 0);
        const bool has_next = S.next(ui + 1, nxt);
        const unsigned nA = has_next ? nxt.A : cA, nB = has_next ? nxt.B : cB;
        if (GATHER && has_next && S.has_list(nxt) && tid < 256)
            __builtin_amdgcn_global_load_lds((const unsigned*)(wsb + (S.list_off(nxt) + (unsigned)tid * 4u)), (LAS unsigned*)(lds + STAGE_BYTES + 14336 + ((ui + 1) & 1) * 1024 + wid * 256), 4, 0, 0);
        unsigned long long tk0 = 0;
        if (Epi::TIMEK) tk0 = __builtin_amdgcn_s_memrealtime();
#pragma unroll 1
        for (int t = 0; t < nt; t += 2) {
            const bool last = (t == nt - 2);
            const unsigned a1 = cA + (unsigned)(t + 1) * kstep;
            const unsigned a2 = last ? nA : cA + (unsigned)(t + 2) * kstep, b2 = last ? nB : cB + (unsigned)(t + 2) * kstep;
            const unsigned a3 = a2 + kstep, b3 = b2 + kstep;
            G8_LDB(B0, 0, 0); G8_SCHED; G8_LDA(At, 0, 0); G8_STAGE_A(G8_SA(1, 1), a1, 1, vgc);
            G8_WAIT_L(8); G8_BAR; G8_WAIT_L(0); G8_MMA(0, 0, At, B0); G8_BAR; G8_SCHED;
            G8_LDB(B1, 0, 1);
            if (GATHER && last && has_next) {
                const LAS int* t2 = (const LAS int*)(lds + STAGE_BYTES + 14336 + ((ui + 1) & 1) * 1024);
#pragma unroll
                for (int i = 0; i < 2; ++i) { int R, C; stage_rc(tid * 16 + i * 8192, R, C);
#pragma unroll
                    for (int h = 0; h < 2; ++h) vgc[h][i] = (unsigned)(S.row_tab(nxt, h * HALF + R, t2) * K + C) * 2u; }
            }
            G8_STAGE(G8_SB(0, 0), b2, voffB);
            G8_BAR; G8_WAIT_L(0); G8_MMA(0, 1, At, B1); G8_BAR;
            G8_LDA(At, 0, 1); G8_STAGE_A(G8_SA(0, 0), a2, 0, vgc);
            G8_BAR; G8_WAIT_L(0); G8_MMA(1, 0, At, B0); G8_BAR; G8_SCHED;
            G8_STAGE(G8_SB(0, 1), b2 + hstep, voffB);
            G8_WAIT_V(6); G8_BAR; G8_MMA(1, 1, At, B1); G8_BAR;
            G8_LDB(B0, 1, 0); G8_SCHED; G8_LDA(At, 1, 0); G8_STAGE_A(G8_SA(0, 1), a2, 1, vgc);
            G8_WAIT_L(8); G8_BAR; G8_WAIT_L(0); G8_MMA(0, 0, At, B0); G8_BAR; G8_SCHED;
            G8_LDB(B1, 1, 1); G8_STAGE(G8_SB(1, 0), b3, voffB);
            G8_BAR; G8_WAIT_L(0); G8_MMA(0, 1, At, B1); G8_BAR;
            G8_LDA(At, 1, 1); G8_STAGE_A(G8_SA(1, 0), a3, 0, vgc);
            G8_BAR; G8_WAIT_L(0); G8_MMA(1, 0, At, B0); G8_BAR; G8_SCHED;
            G8_STAGE(G8_SB(1, 1), b3 + hstep, voffB);
            G8_WAIT_V(6); G8_BAR; G8_MMA(1, 1, At, B1); G8_BAR;
        }
        if (Epi::TIMEK && tid == 0) { const unsigned dt = (unsigned)(__builtin_amdgcn_s_memrealtime() - tk0); *(LAS unsigned*)(lds + 147456 + 32) += dt; }
        const bool keep = E(acc, cur, wr, wc, fr, fq, (const LAS unsigned*)(lds + STAGE_BYTES + 12288 + (ui & 1) * 1024));
        if (!has_next) break;
        if (!keep) {
#pragma unroll
        for (int a = 0; a < 2; ++a)
#pragma unroll
            for (int b = 0; b < 2; ++b)
#pragma unroll
                for (int m = 0; m < 4; ++m)
#pragma unroll
                    for (int n = 0; n < 2; ++n) acc[a][b][m][n] = (f32x4){0.f, 0.f, 0.f, 0.f};
        }
        cur = nxt; cA = nA; cB = nB; ++ui;
    }
    G8_WAIT_V(0);
    if (wr == 0) G8_BAR;
    G8_BAR;
#undef G8_SA
#undef G8_SB
#undef G8_STAGE
#undef G8_STAGE_A
#undef G8_LDA
#undef G8_LDB
#undef G8_MMA
#undef G8_WAIT_V
#undef G8_WAIT_L
#undef G8_BAR
#undef G8_SCHED
#undef G8_GOFF
}
}

__device__ __forceinline__ u32x4 pack8v(const f32x4& a, const f32x4& b) {
    u32x4 w; w[0] = g8::cvt_pk_bf16(a[0], a[1]); w[1] = g8::cvt_pk_bf16(a[2], a[3]); w[2] = g8::cvt_pk_bf16(b[0], b[1]); w[3] = g8::cvt_pk_bf16(b[2], b[3]); return w;
}
__device__ __forceinline__ uint4 pack8(const f32x4& a, const f32x4& b) {
    uint4 w; w.x = g8::cvt_pk_bf16(a[0], a[1]); w.y = g8::cvt_pk_bf16(a[2], a[3]); w.z = g8::cvt_pk_bf16(b[0], b[1]); w.w = g8::cvt_pk_bf16(b[2], b[3]); return w;
}

struct ProjSched {
    __device__ __forceinline__ bool has_list(const g8::Unit&) const { return false; }
    __device__ __forceinline__ unsigned list_off(const g8::Unit&) const { return 0u; }
    __device__ __forceinline__ int row_tab(const g8::Unit&, int, const LAS int*) const { return 0; }
    unsigned A, B; int c, G;
    __device__ __forceinline__ bool next(int i, g8::Unit& u) const {
        const int L = i * G + c; if (L >= 64 * 26) return false;
        const int xcd = L & 7, jx = L >> 3;
        u.pm = xcd * 8 + (jx & 7); u.pn = jx >> 3;
        u.A = A + (unsigned)u.pm * 256 * DM * 2; u.B = B + (unsigned)u.pn * 256 * DM * 2; u.x0 = 0; u.x1 = 0; return true;
    }
    __device__ __forceinline__ int row(const g8::Unit&, int) const { return 0; }
};
struct ProjEpi {
    static constexpr bool ROWTAB = true;
    __device__ __forceinline__ unsigned tab_off(const g8::Unit& u) const {
        const int seg = (u.pn * 256) >> 9;
        return (seg >= 7) ? (unsigned)(OFF_BGC + (u.pn * 256 - 3584) * 4) : (unsigned)(OFF_LB + ((u.pn * 256) & 511) * 4);
    }
    static constexpr bool TIMEK = PROBE_TIMEK_ProjEpi;
    static constexpr bool PERM = true;
    unsigned char* ws; const float* bg;
    __device__ __forceinline__ bool operator()(f32x4 (&acc)[2][2][4][2], const g8::Unit& u, int wr, int wc, int fr, int fq, const LAS unsigned* rt) const {
        const int seg = (u.pn * 256) >> 9;
        f32x4 cc[2][2];
#pragma unroll
        for (int bj = 0; bj < 2; ++bj) {
            const int tc = bj * 128 + wc * 32 + fq * 8;
            const LAS f32x4* tp = (const LAS f32x4*)(rt + tc);
            cc[bj][0] = tp[0]; cc[bj][1] = tp[1];
        }
#pragma unroll
        for (int ai = 0; ai < 2; ++ai)
#pragma unroll
            for (int m = 0; m < 4; ++m) {
                const int row = u.pm * 256 + ai * 128 + wr * 64 + m * 16 + fr;
#pragma unroll
                for (int bj = 0; bj < 2; ++bj) {
                    const int col = u.pn * 256 + bj * 128 + wc * 32 + fq * 8;
                    const int c = col & 511;
                    f32x4 v0 = acc[ai][bj][m][0], v1 = acc[ai][bj][m][1];
                    if (seg == 0 || seg == 3) {
#pragma unroll
                        for (int i = 0; i < 4; ++i) { v0[i] = silu_f(v0[i]); v1[i] = silu_f(v1[i]); }
                        stg<uint4>(ws, (unsigned)((seg == 0 ? OFF_PQ : OFF_PG) + (row * 512 + c) * 2), pack8(v0, v1));
                    } else if (seg == 1) {
                        const f32x4 l0 = cc[bj][0], l1 = cc[bj][1];
                        f32x4 g0, g1, k0, k1;
#pragma unroll
                        for (int i = 0; i < 4; ++i) {
                            const float s0 = sigm(v0[i]), s1 = sigm(v1[i]);
                            g0[i] = __logf(l0[i] + (1.f - l0[i]) * s0); g1[i] = __logf(l1[i] + (1.f - l1[i]) * s1);
                            k0[i] = (1.f - l0[i]) * (1.f - s0); k1[i] = (1.f - l1[i]) * (1.f - s1);
                        }
                        stg<f32x4>(ws, (unsigned)(OFF_PLF + (row * 512 + c) * 4), g0);
                        stg<f32x4>(ws, (unsigned)(OFF_PLF + (row * 512 + c) * 4 + 16), g1);
                        stg<uint4>(ws, (unsigned)(OFF_PK + (row * 512 + c) * 2), pack8(k0, k1));
                    } else if (seg == 2 || seg == 6) {
                        stg<uint4>(ws, (unsigned)((seg == 2 ? OFF_PV : OFF_PXR) + (row * 512 + c) * 2), pack8(v0, v1));
                    } else if (seg == 4) {
                        stg<uint4>(ws, (unsigned)(OFF_PU + (((c >> 4) * NTOK + row) * 16 + (c & 15)) * 2), pack8(v0, v1));
                    } else if (seg == 5) {
#pragma unroll
                        for (int i = 0; i < 4; ++i) { v0[i] = gelu_f(v0[i]); v1[i] = gelu_f(v1[i]); }
                        stg<uint4>(ws, (unsigned)(OFF_PXG + (row * 512 + c) * 2), pack8(v0, v1));
                    } else {
                        const int gc = col - 3584;
#pragma unroll
                        for (int i = 0; i < 4; ++i) { v0[i] = sigm(v0[i] + cc[bj][0][i]); v1[i] = sigm(v1[i] + cc[bj][1][i]); }
                        stg<uint4>(ws, (unsigned)(OFF_PGATE + (row * 3072 + gc) * 2), pack8(v0, v1));
                    }
                }
            }
        return false;
    }
};
__device__ void phase_proj(CParams& p, int l, char* lds) {
    ProjSched S; S.A = (unsigned)OFF_XB; S.B = (unsigned)OFF_WINT; S.c = blockIdx.x; S.G = gridDim.x;
    ProjEpi E; E.ws = p.ws; E.bg = p.in[2] + (size_t)l * 3072;
    g8::gemm_phase<ProjEpi, ProjSched, false>((LAS unsigned char*)lds, p.ws, 1024, S, E);
}

struct OutSched {
    __device__ __forceinline__ bool has_list(const g8::Unit&) const { return false; }
    __device__ __forceinline__ unsigned list_off(const g8::Unit&) const { return 0u; }
    __device__ __forceinline__ int row_tab(const g8::Unit&, int, const LAS int*) const { return 0; }
    unsigned A, B; int c, G;
    __device__ __forceinline__ bool next(int i, g8::Unit& u) const {
        const int L = i * G + c; if (L >= 64 * 4) return false;
        const int xcd = L & 7, jx = L >> 3;
        u.pm = xcd * 8 + (jx & 7); u.pn = jx >> 3;
        u.A = A + (unsigned)u.pm * 256 * 1024 * 2; u.B = B + (unsigned)u.pn * 256 * 1024 * 2; u.x0 = 0; u.x1 = 0; return true;
    }
    __device__ __forceinline__ int row(const g8::Unit&, int) const { return 0; }
};
struct OutEpi {
    static constexpr bool ROWTAB = false;
    __device__ __forceinline__ unsigned tab_off(const g8::Unit&) const { return 0u; }
    static constexpr bool TIMEK = PROBE_TIMEK_OutEpi;
    static constexpr bool PERM = false;
    unsigned char* ws;
    __device__ __forceinline__ bool operator()(f32x4 (&acc)[2][2][4][2], const g8::Unit& u, int wr, int wc, int fr, int fq, const LAS unsigned* rt) const {
#pragma unroll
        for (int ai = 0; ai < 2; ++ai) {
            f32x4 x[4][2][2];
#pragma unroll
            for (int m = 0; m < 4; ++m)
#pragma unroll
                for (int bj = 0; bj < 2; ++bj)
#pragma unroll
                    for (int n = 0; n < 2; ++n) {
                        const int row = u.pm * 256 + ai * 128 + wr * 64 + m * 16 + fr, col = u.pn * 256 + bj * 128 + wc * 32 + n * 16 + fq * 4;
                        x[m][bj][n] = unpack4(ldg<uint2>(ws, (unsigned)(OFF_XB + (row * 1024 + col) * 2)));
                    }
#pragma unroll
            for (int m = 0; m < 4; ++m)
#pragma unroll
                for (int bj = 0; bj < 2; ++bj)
#pragma unroll
                    for (int n = 0; n < 2; ++n) {
                        const int row = u.pm * 256 + ai * 128 + wr * 64 + m * 16 + fr, col = u.pn * 256 + bj * 128 + wc * 32 + n * 16 + fq * 4;
                        stg<f32x4>(ws, (unsigned)OFF_PRELN + (unsigned)((row * 1024 + col) * 4), x[m][bj][n] * DN_ALPHA + acc[ai][bj][m][n]);
                    }
        }
        return false;
    }
};

struct BrSched {
    __device__ __forceinline__ bool has_list(const g8::Unit&) const { return false; }
    __device__ __forceinline__ unsigned list_off(const g8::Unit&) const { return 0u; }
    __device__ __forceinline__ int row_tab(const g8::Unit&, int, const LAS int*) const { return 0; }
    int c;
    __device__ __forceinline__ bool next(int i, g8::Unit& u) const {
        if (i >= 3) return false;
        const int xcd = c & 7, jx = c >> 3;
        u.pm = xcd * 8 + (jx & 7); u.pn = jx >> 3; u.x0 = i; u.x1 = 0;
        u.A = (unsigned)(i == 0 ? OFF_YA : (i == 1 ? OFF_YB : OFF_YC)) + (unsigned)u.pm * 256 * 512 * 2;
        u.B = (unsigned)OFF_WBRT + (unsigned)i * 1024 * 512 * 2 + (unsigned)u.pn * 256 * 512 * 2;
        return true;
    }
    __device__ __forceinline__ int row(const g8::Unit&, int) const { return 0; }
};
struct BrEpi {
    static constexpr bool ROWTAB = false;
    __device__ __forceinline__ unsigned tab_off(const g8::Unit&) const { return 0u; }
    static constexpr bool TIMEK = PROBE_TIMEK_BrEpi;
    static constexpr bool PERM = true;
    unsigned char* ws;
    __device__ __forceinline__ bool operator()(f32x4 (&acc)[2][2][4][2], const g8::Unit& u, int wr, int wc, int fr, int fq, const LAS unsigned* rt) const {
        const int k = u.x0;
#pragma unroll
        for (int ai = 0; ai < 2; ++ai) {
            uint4 gq[4][2], gn[4][2];
#pragma unroll
            for (int m = 0; m < 4; ++m)
#pragma unroll
                for (int bj = 0; bj < 2; ++bj) {
                    const int row = u.pm * 256 + ai * 128 + wr * 64 + m * 16 + fr, col = u.pn * 256 + bj * 128 + wc * 32 + fq * 8;
                    const unsigned go = (unsigned)(OFF_PGATE + (row * 3072 + k * 1024 + col) * 2);
                    gq[m][bj] = ldg<uint4>(ws, go);
                    gn[m][bj] = (k < 2) ? ldg<uint4>(ws, go + 2048) : uint4{0x3f803f80u, 0x3f803f80u, 0x3f803f80u, 0x3f803f80u};
                }
#pragma unroll
            for (int m = 0; m < 4; ++m)
#pragma unroll
                for (int bj = 0; bj < 2; ++bj) {
                    const int row = u.pm * 256 + ai * 128 + wr * 64 + m * 16 + fr, col = u.pn * 256 + bj * 128 + wc * 32 + fq * 8;
                    const uint4 q = gq[m][bj], nx = gn[m][bj];
                    float s[8] = {bf2f((u16)(q.x & 0xffff)), bf2f((u16)(q.x >> 16)), bf2f((u16)(q.y & 0xffff)), bf2f((u16)(q.y >> 16)),
                                  bf2f((u16)(q.z & 0xffff)), bf2f((u16)(q.z >> 16)), bf2f((u16)(q.w & 0xffff)), bf2f((u16)(q.w >> 16))};
                    s[0] *= __builtin_amdgcn_rcpf(bf2f((u16)(nx.x & 0xffff))); s[1] *= __builtin_amdgcn_rcpf(bf2f((u16)(nx.x >> 16)));
                    s[2] *= __builtin_amdgcn_rcpf(bf2f((u16)(nx.y & 0xffff))); s[3] *= __builtin_amdgcn_rcpf(bf2f((u16)(nx.y >> 16)));
                    s[4] *= __builtin_amdgcn_rcpf(bf2f((u16)(nx.z & 0xffff))); s[5] *= __builtin_amdgcn_rcpf(bf2f((u16)(nx.z >> 16)));
                    s[6] *= __builtin_amdgcn_rcpf(bf2f((u16)(nx.w & 0xffff))); s[7] *= __builtin_amdgcn_rcpf(bf2f((u16)(nx.w >> 16)));
#pragma unroll
                    for (int i = 0; i < 4; ++i) { acc[ai][bj][m][0][i] *= s[i]; acc[ai][bj][m][1][i] *= s[4 + i]; }
                    if (k == 2) stg<uint4>(ws, (unsigned)(OFF_MIXP + (row * 1024 + col) * 2), pack8(acc[ai][bj][m][0], acc[ai][bj][m][1]));
                }
        }
        return k < 2;
    }
};

struct MoeSched {
    const int* sm; const unsigned char* ws; unsigned A, Bexp, Bsh, Ash;
    int c, G, npn, K, bstride_e, gather, nsh;
    __device__ __forceinline__ bool next(int i, g8::Unit& u) const {
        int nbr = __builtin_amdgcn_readfirstlane(sm[64]); asm volatile("" : "+s"(nbr));
        const int L = i * G + c; if (L >= (nbr + nsh) * npn) return false;
        const int blk = L / npn; u.pn = L - blk * npn;
        if (blk >= nbr) {
            u.x0 = 64; u.pm = blk - nbr; u.x1 = NTOK;
            u.A = gather ? A : Ash + (unsigned)u.pm * 256 * K * 2;
            u.B = Bsh + (unsigned)u.pn * 256 * K * 2;
        } else {
            int e = __builtin_amdgcn_readfirstlane(sm[256 + blk]);
            int be = __builtin_amdgcn_readfirstlane(sm[e]), re = __builtin_amdgcn_readfirstlane(sm[65 + e]), ce = __builtin_amdgcn_readfirstlane(sm[130 + e]);
            asm volatile("" : "+s"(e), "+s"(be), "+s"(re), "+s"(ce));
            u.x0 = e; u.pm = blk - be; u.x1 = ce;
            u.A = gather ? A : A + (unsigned)(re + u.pm * 256) * K * 2;
            u.B = Bexp + (unsigned)e * bstride_e + (unsigned)u.pn * 256 * K * 2;
        }
        return true;
    }
    __device__ __forceinline__ bool has_list(const g8::Unit& u) const { return u.x0 != 64; }
    __device__ __forceinline__ unsigned list_off(const g8::Unit& u) const { return (unsigned)(OFF_LIST + (u.x0 * NTOK + u.pm * 256) * 4); }
    __device__ __forceinline__ int row_tab(const g8::Unit& u, int r, const LAS int* tab) const {
        const int rr = u.pm * 256 + r;
        if (u.x0 == 64) return rr;
        return (rr < u.x1) ? (tab[r] >> 3) : 0;
    }
    __device__ __forceinline__ int row(const g8::Unit& u, int r) const {
        const int rr = u.pm * 256 + r;
        if (u.x0 == 64) return rr;
        return (rr < u.x1) ? (ldg<int>(ws, (unsigned)(OFF_LIST + (u.x0 * NTOK + rr) * 4)) >> 3) : 0;
    }
};
__device__ __forceinline__ void moe_setup(CParams& p, int* sm) {
    int t_ = threadIdx.x; asm volatile("" : "+v"(t_));
    __syncthreads();
    if (t_ < 64) sm[130 + t_] = ldg<int>(p.ws, (unsigned)(OFF_CUR + t_ * 4));
    __syncthreads();
    if (t_ == 0) {
        int nb = 0, nr = 0;
        for (int e = 0; e < 64; ++e) { sm[e] = nb; sm[65 + e] = nr; const int c = sm[130 + e]; nb += (c + 255) >> 8; nr += c; }
        sm[64] = nb; sm[129] = nr;
    }
    __syncthreads();
    if (t_ < 64) { const int e = t_; for (int k = sm[e]; k < sm[e + 1]; ++k) sm[256 + k] = e; }
    __syncthreads();
}
struct Moe1Epi {
    static constexpr bool ROWTAB = true;
    __device__ __forceinline__ unsigned tab_off(const g8::Unit& u) const { return (unsigned)(OFF_WLIST + ((u.x0 & 63) * NTOK + u.pm * 256) * 4); }
    static constexpr bool TIMEK = PROBE_TIMEK_Moe1Epi;
    static constexpr bool PERM = false;
    unsigned char* ws; const int* sm;
    __device__ __forceinline__ bool operator()(f32x4 (&acc)[2][2][4][2], const g8::Unit& u, int wr, int wc, int fr, int fq, const LAS unsigned* rt) const {
        const int rbase = (u.x0 == 64) ? 0 : __builtin_amdgcn_readfirstlane(sm[65 + (u.x0 & 63)]);
        const unsigned hoff = (unsigned)((u.x0 == 64) ? OFF_HSH + (size_t)u.pm * 256 * 256 * 2 : OFF_HBUF + (size_t)(rbase + u.pm * 256) * 256 * 2);
        const int valid = u.x1 - u.pm * 256;
        float rw[2][4];
#pragma unroll
        for (int ai = 0; ai < 2; ++ai)
#pragma unroll
            for (int m = 0; m < 4; ++m) {
                const int r = ai * 128 + wr * 64 + m * 16 + fr;
                rw[ai][m] = (u.x0 != 64 && r < valid) ? __builtin_bit_cast(float, rt[r]) : 1.f;
            }
#pragma unroll
        for (int ai = 0; ai < 2; ++ai)
#pragma unroll
            for (int m = 0; m < 4; ++m) {
                const int r = ai * 128 + wr * 64 + m * 16 + fr;
                const float w = rw[ai][m];
#pragma unroll
                for (int bj = 0; bj < 2; ++bj) {
                    const int hid = ((u.pn * 256 + bj * 128 + wc * 32) >> 1) + fq * 4;
                    const f32x4 a = acc[ai][bj][m][0], b = acc[ai][bj][m][1] * w;
                    uint2 pk;
                    pk.x = g8::cvt_pk_bf16(silu_f(a[0]) * b[0], silu_f(a[1]) * b[1]);
                    pk.y = g8::cvt_pk_bf16(silu_f(a[2]) * b[2], silu_f(a[3]) * b[3]);
                    if (r < valid) stg<uint2>(ws, hoff + (unsigned)(r * 256 + hid) * 2u, pk);
                }
                __builtin_amdgcn_sched_barrier(0);
            }
        return false;
    }
};
__device__ void phase_moe1(CParams& p, int l, char* lds) {
    int* sm = (int*)(lds + g8::STAGE_BYTES);
    moe_setup(p, sm);
    MoeSched S; S.sm = sm; S.ws = p.ws;
    S.A = (unsigned)OFF_XM; S.Ash = S.A; S.Bexp = (unsigned)OFF_EW13; S.Bsh = (unsigned)OFF_SH13T;
    S.c = (blockIdx.x & 7) * 32 + (blockIdx.x >> 3); S.G = gridDim.x; S.npn = 2; S.K = 1024; S.bstride_e = 512 * 1024 * 2; S.gather = 1; S.nsh = 64;
    Moe1Epi E; E.ws = p.ws; E.sm = sm;
    g8::gemm_phase<Moe1Epi, MoeSched, true>((LAS unsigned char*)lds, p.ws, 1024, S, E);
}
struct Moe2Epi {
    static constexpr bool ROWTAB = true;
    __device__ __forceinline__ unsigned tab_off(const g8::Unit& u) const { return (unsigned)(OFF_LIST + (u.x0 * NTOK + u.pm * 256) * 4); }
    static constexpr bool TIMEK = PROBE_TIMEK_Moe2Epi;
    static constexpr bool PERM = true;
    unsigned char* ws;
    __device__ __forceinline__ bool operator()(f32x4 (&acc)[2][2][4][2], const g8::Unit& u, int wr, int wc, int fr, int fq, const LAS unsigned* rt) const {
        const int valid = u.x1 - u.pm * 256;
        const int colb = u.pn * 256 + wc * 32 + fq * 8;
        int ent[2][4];
#pragma unroll
        for (int ai = 0; ai < 2; ++ai)
#pragma unroll
            for (int m = 0; m < 4; ++m) {
                const int r = ai * 128 + wr * 64 + m * 16 + fr;
                ent[ai][m] = (r < valid) ? (int)rt[r] : 0;
            }
#pragma unroll
        for (int ai = 0; ai < 2; ++ai)
#pragma unroll
            for (int m = 0; m < 4; ++m) {
                const int r = ai * 128 + wr * 64 + m * 16 + fr;
                if (r < valid) {
                    const unsigned o = (unsigned)OFF_YBUF + (unsigned)(ent[ai][m] * 1024 + colb);
#pragma unroll
                    for (int bj = 0; bj < 2; ++bj) {
                        const f32x4 a = acc[ai][bj][m][0] * 32.f, b = acc[ai][bj][m][1] * 32.f;
                        int w0 = __builtin_amdgcn_cvt_pk_fp8_f32(a[0], a[1], 0, false); w0 = __builtin_amdgcn_cvt_pk_fp8_f32(a[2], a[3], w0, true);
                        int w1 = __builtin_amdgcn_cvt_pk_fp8_f32(b[0], b[1], 0, false); w1 = __builtin_amdgcn_cvt_pk_fp8_f32(b[2], b[3], w1, true);
                        stg<uint2>(ws, o + bj * 128, uint2{(unsigned)w0, (unsigned)w1});
                    }
                }
                __builtin_amdgcn_sched_barrier(0);
            }
        return false;
    }
};
struct ShSched {
    __device__ __forceinline__ bool has_list(const g8::Unit&) const { return false; }
    __device__ __forceinline__ unsigned list_off(const g8::Unit&) const { return 0u; }
    __device__ __forceinline__ int row_tab(const g8::Unit&, int, const LAS int*) const { return 0; }
    int c, G;
    __device__ __forceinline__ bool next(int i, g8::Unit& u) const {
        const int L = i * G + c; if (L >= 64 * 4) return false;
        u.pm = L >> 2; u.pn = L & 3; u.A = (unsigned)OFF_HSH + (unsigned)u.pm * 256 * 256 * 2; u.B = (unsigned)OFF_SH2T + (unsigned)u.pn * 256 * 256 * 2; u.x0 = 64; u.x1 = NTOK; return true;
    }
    __device__ __forceinline__ int row(const g8::Unit&, int) const { return 0; }
};
struct ShEpi {
    static constexpr bool ROWTAB = false;
    __device__ __forceinline__ unsigned tab_off(const g8::Unit&) const { return 0u; }
    static constexpr bool TIMEK = PROBE_TIMEK_ShEpi;
    static constexpr bool PROBE = false;
    static constexpr bool PERM = true;
    unsigned char* ws;
    __device__ __forceinline__ bool operator()(f32x4 (&acc)[2][2][4][2], const g8::Unit& u, int wr, int wc, int fr, int fq, const LAS unsigned* rt) const {
#pragma unroll
        for (int ai = 0; ai < 2; ++ai)
#pragma unroll
            for (int m = 0; m < 4; ++m) {
                const int row = u.pm * 256 + ai * 128 + wr * 64 + m * 16 + fr;
#pragma unroll
                for (int bj = 0; bj < 2; ++bj)
                    stg<uint4>(ws, (unsigned)(OFF_YSH + (row * 1024 + u.pn * 256 + bj * 128 + wc * 32 + fq * 8) * 2), pack8(acc[ai][bj][m][0], acc[ai][bj][m][1]));
                __builtin_amdgcn_sched_barrier(0);
            }
        return false;
    }
};
__device__ void phase_moe2(CParams& p, int l, char* lds) {
    int* sm = (int*)(lds + g8::STAGE_BYTES);
    moe_setup(p, sm);
    MoeSched S; S.sm = sm; S.ws = p.ws;
    S.A = (unsigned)OFF_HBUF; S.Ash = (unsigned)OFF_HSH; S.Bexp = (unsigned)OFF_EW2; S.Bsh = (unsigned)OFF_SH2T;
    S.c = (blockIdx.x & 7) * 32 + (blockIdx.x >> 3); S.G = gridDim.x; S.npn = 4; S.K = 256; S.bstride_e = 1024 * 256 * 2; S.gather = 0; S.nsh = 0;
    Moe2Epi E; E.ws = p.ws;
    g8::gemm_phase<Moe2Epi, MoeSched, false>((LAS unsigned char*)lds, p.ws, 256, S, E);
    ShSched S2; S2.c = (blockIdx.x & 7) * 32 + (blockIdx.x >> 3); S2.G = gridDim.x;
    ShEpi E2; E2.ws = p.ws;
    g8::gemm_phase<ShEpi, ShSched, false>((LAS unsigned char*)lds, p.ws, 256, S2, E2);
}

__device__ void conv_tile(const float* s1, const float* s2, int ldsrc, int K, int perm, u16* dst, int tile, float* lds) {
    const int tid = otid();
    const int ktiles = K >> 6;
    const int kt = tile % ktiles, nt = tile / ktiles;
    hsync();
#pragma unroll 4
    for (int i = 0; i < 16; ++i) {
        int idx = tid + i * 256, kr = idx >> 6, nc = idx & 63;
        const float* s; int col;
        if (perm == 32) { s = (nc < 32) ? s1 : s2; col = nt * 32 + (nc & 31); }
        else if (perm == 16) { s = ((nc & 31) < 16) ? s1 : s2; col = (nt * 2 + (nc >> 5)) * 16 + (nc & 15); }
        else { s = s1; col = nt * 64 + nc; }
        lds[kr * 65 + nc] = s[(size_t)(kt * 64 + kr) * ldsrc + col];
    }
    hsync();
#pragma unroll 4
    for (int i = 0; i < 16; ++i) {
        int idx = tid + i * 256, nr = idx >> 6, kc = idx & 63;
        dst[(size_t)(nt * 64 + nr) * K + kt * 64 + kc] = f2bf(lds[kc * 65 + nr]);
    }
}

__device__ void s5_precompute(CParams& p, int l, int g, int part, float* lds) {
    const int tid = otid();
    float* Er = lds;
    float* Ei = Er + 64 * 17;
    float* Br = Ei + 64 * 17;
    float* Bi = Br + 1024;
    float* Cr = Bi + 1024;
    float* Ci = Cr + 1024;
    float* Kt = Ci + 1024;
    hsync();
    const int lg = l * 32 + g;
    const float dt = expf(p.in[12][lg]);
    {
        const int pp = tid & 63, part = tid >> 6;
        const float ar = p.in[5][lg * 64 + pp], ai = p.in[6][lg * 64 + pp];
        for (int tau = part; tau <= 16; tau += 4) {
            float mag = expf((float)tau * ar * dt);
            float ang = (float)tau * ai * dt;
            Er[pp * 17 + tau] = mag * cosf(ang);
            Ei[pp * 17 + tau] = mag * sinf(ang);
        }
        float mag = expf(ar * dt), ang = ai * dt;
        float e1r = mag * cosf(ang) - 1.f, e1i = mag * sinf(ang);
        float den = ar * ar + ai * ai;
        float qr = (e1r * ar + e1i * ai) / den, qi = (e1i * ar - e1r * ai) / den;
        for (int c = part * 4; c < part * 4 + 4; ++c) {
            float br = p.in[7][((size_t)lg * 64 + pp) * 16 + c], bi = p.in[8][((size_t)lg * 64 + pp) * 16 + c];
            Br[pp * 16 + c] = qr * br - qi * bi;
            Bi[pp * 16 + c] = qr * bi + qi * br;
            Cr[c * 64 + pp] = p.in[9][((size_t)lg * 16 + c) * 64 + pp];
            Ci[c * 64 + pp] = p.in[10][((size_t)lg * 16 + c) * 64 + pp];
        }
    }
    hsync();
    u16* bta = (u16*)(p.ws + OFF_BTA) + (size_t)g * 128 * 256;
    for (int i = part * 16; i < part * 16 + 16; ++i) {
        int idx = tid + i * 256, pr = idx >> 8, k = idx & 255, s = k >> 4, ch = k & 15, pp = pr & 63;
        float er = Er[pp * 17 + 15 - s], ei = Ei[pp * 17 + 15 - s], br = Br[pp * 16 + ch], bi = Bi[pp * 16 + ch];
        float v = (pr < 64) ? (er * br - ei * bi) : (er * bi + ei * br);
        bta[idx] = f2bf(v);
    }
    u16* btc = (u16*)(p.ws + OFF_BTC) + (size_t)g * 256 * 384;
    {
        const int ch = tid >> 4, c2 = tid & 15;
        for (int tt = 0; tt < 2; ++tt) {
            const int tau = part * 2 + tt;
            float s = 0.f;
            for (int pp = 0; pp < 64; ++pp) {
                float cr = Cr[ch * 64 + pp], ci = Ci[ch * 64 + pp], er = Er[pp * 17 + tau], ei = Ei[pp * 17 + tau];
                float gr = cr * er - ci * ei, gi = cr * ei + ci * er;
                s += gr * Br[pp * 16 + c2] - gi * Bi[pp * 16 + c2];
            }
            const u16 kv = f2bf(s);
            for (int j = tau; j < 16; ++j) btc[(size_t)(j * 16 + ch) * 384 + (j - tau) * 16 + c2] = kv;
            if (tau > 0) for (int j = 0; j + tau < 16; ++j) btc[(size_t)(j * 16 + ch) * 384 + (j + tau) * 16 + c2] = 0;
        }
        for (int i = 0; i < 16; ++i) {
            const int idx = tid + i * 256, n = part * 32 + (idx >> 7), pr = idx & 127, pp = pr & 63, j = n >> 4, chn = n & 15;
            float cr = Cr[chn * 64 + pp], ci = Ci[chn * 64 + pp], er = Er[pp * 17 + j + 1], ei = Ei[pp * 17 + j + 1];
            float gr = cr * er - ci * ei, gi = cr * ei + ci * er;
            btc[(size_t)n * 384 + 256 + pr] = f2bf((pr < 64) ? gr : -gi);
        }
    }
}

constexpr int W_CONV_TILES = 2608;
__device__ void phase_w(CParams& p, int l, char* lds) {
    const int tid = otid();
    const int nunits = W_CONV_TILES + 256 + 2 + (l == 0 ? 1024 : 0);
    for (int uu = VB; uu < nunits; uu += VG) {
        const int u = (uu < 256) ? uu + W_CONV_TILES : (uu < W_CONV_TILES + 256 ? uu - 256 : uu);
        if (u < W_CONV_TILES) {
            int t = u;
            const float *s1, *s2 = nullptr; int ld, K, perm = 0; u16* dst;
            if (t < 1664) { s1 = p.in[1] + (size_t)l * DM * INC; ld = INC; K = 1024; dst = (u16*)(p.ws + OFF_WINT); }
            else if ((t -= 1664) < 384) { int k = t >> 7; t &= 127; s1 = p.in[22] + (size_t)(l * 3 + k) * 512 * 1024; ld = 1024; K = 512; dst = (u16*)(p.ws + OFF_WBRT) + (size_t)k * 1024 * 512; }
            else if ((t -= 384) < 256) { s1 = p.in[23] + (size_t)l * 1024 * 1024; ld = 1024; K = 1024; dst = (u16*)(p.ws + OFF_WOUTT); }
            else if ((t -= 256) < 64) { s1 = p.in[13] + (size_t)l * 512 * 512; ld = 512; K = 512; dst = (u16*)(p.ws + OFF_GLUT); }
            else if ((t -= 64) < 32) { int h = t >> 3; t &= 7; s1 = p.in[17] + (size_t)(l * 4 + h) * 128 * 128; s2 = p.in[19] + (size_t)(l * 4 + h) * 128 * 128; ld = 128; K = 128; perm = 32; dst = (u16*)(p.ws + OFF_RGT) + (size_t)h * 256 * 128; }
            else if ((t -= 32) < 128) { s1 = p.in[31] + (size_t)l * 1024 * 256; s2 = p.in[32] + (size_t)l * 1024 * 256; ld = 256; K = 1024; perm = 16; dst = (u16*)(p.ws + OFF_SH13T); }
            else if ((t -= 128) < 64) { s1 = p.in[33] + (size_t)l * 256 * 1024; ld = 1024; K = 256; dst = (u16*)(p.ws + OFF_SH2T); }
            else { t -= 64; s1 = p.in[26] + (size_t)l * 1024 * 64; ld = 64; K = 1024; dst = (u16*)(p.ws + OFF_ROUTT); }
            conv_tile(s1, s2, ld, K, perm, dst, t, (float*)lds);
        } else if (u < W_CONV_TILES + 256) {
            s5_precompute(p, l, (u - W_CONV_TILES) >> 3, (u - W_CONV_TILES) & 7, (float*)lds);
        } else if (u == W_CONV_TILES + 256) {
            float* LB = (float*)(p.ws + OFF_LB);
            for (int c = tid; c < 512; c += 256) {
                float x0 = p.in[3][c], x1 = p.in[3][512 + c];
                LB[c] = (l == 0) ? 0.f : 1.f / (1.f + expf(x0 - x1));
            }
            if (tid < 64) ((int*)(p.ws + OFF_CUR))[tid] = 0;
            for (int c = tid; c < 3072; c += 256) ((float*)(p.ws + OFF_BGC))[c] = p.in[2][(size_t)l * 3072 + c];
        } else if (u == W_CONV_TILES + 257) {
        } else {
            int r0 = (u - (W_CONV_TILES + 258)) * 16;
            const float4* src = (const float4*)(p.in[0] + (size_t)r0 * DM);
            uint2* dst = (uint2*)((u16*)(p.ws + OFF_XB) + (size_t)r0 * DM);
#pragma unroll
            for (int i0 = 0; i0 < 16; i0 += 8) {
                float4 v[8];
#pragma unroll
                for (int i = 0; i < 8; ++i) v[i] = src[tid + (i0 + i) * 256];
#pragma unroll
                for (int i = 0; i < 8; ++i) {
                    uint2 o; o.x = f2bf(v[i].x) | ((unsigned)f2bf(v[i].y) << 16); o.y = f2bf(v[i].z) | ((unsigned)f2bf(v[i].w) << 16);
                    dst[tid + (i0 + i) * 256] = o;
                }
            }
        }
    }
}

__device__ void hgrn_prep(CParams& p, int u, char* lds) {
    const int tid = otid();
    const int h = u & 3, c = (u >> 2) & 63, b = u >> 8;
    const int r0 = b * SEQ + c * 64;
    const unsigned cu = (unsigned)((b * 4 + h) * 64 + c);
    unsigned char* ws = p.ws;
    float* F = (float*)lds;
    u16* Kb = (u16*)(lds + 32768);
    u16* Vb = (u16*)(lds + 49152);
    hsync();
#pragma unroll
    for (int i = 0; i < 8; ++i) {
        const int id = tid + i * 256, s = id >> 5, d4 = (id & 31) * 4;
        *(f32x4*)(F + s * 128 + d4) = ldg<f32x4>(ws, (unsigned)(OFF_PLF + ((r0 + s) * 512 + h * 128 + d4) * 4));
    }
#pragma unroll
    for (int i = 0; i < 4; ++i) {
        const int id = tid + i * 256, s = id >> 4, d8 = (id & 15) * 8;
        *(uint4*)(Kb + s * 128 + d8) = ldg<uint4>(ws, (unsigned)(OFF_PK + ((r0 + s) * 512 + h * 128 + d8) * 2));
        *(uint4*)(Vb + s * 128 + d8) = ldg<uint4>(ws, (unsigned)(OFF_PV + ((r0 + s) * 512 + h * 128 + d8) * 2));
    }
    hsync();
    {
        const int d = tid & 127, hf = tid >> 7;
        float run = 0.f;
#pragma unroll 8
        for (int s = hf * 32; s < hf * 32 + 32; ++s) { run += F[s * 128 + d]; F[s * 128 + d] = run; }
        hsync();
        if (hf) {
            const float add = F[31 * 128 + d];
#pragma unroll 8
            for (int s = 32; s < 64; ++s) F[s * 128 + d] += add;
        }
    }
    hsync();
#pragma unroll
    for (int i = 0; i < 8; ++i) {
        const int id = tid + i * 256, s = id >> 5, d4 = (id & 31) * 4;
        stg<f32x4>(ws, (unsigned)(OFF_PLF + ((r0 + s) * 512 + h * 128 + d4) * 4), *(const f32x4*)(F + s * 128 + d4));
    }
    if (tid < 128) stg<float>(ws, (unsigned)(OFF_DEC + ((b * 64 + c) * 512 + h * 128 + tid) * 4), __expf(F[63 * 128 + tid]));
    {
        const int d = tid & 127;
        const float btot = F[63 * 128 + d];
#pragma unroll
        for (int i = 0; i < 4; ++i) {
            const int s8 = (tid >> 7) + 2 * i;
            bf16x8 ok, ov;
#pragma unroll
            for (int e = 0; e < 8; ++e) {
                const int s = s8 * 8 + e;
                ok[e] = (short)f2bf(bf2f(Kb[s * 128 + d]) * __expf(btot - F[s * 128 + d]));
                ov[e] = (short)Vb[s * 128 + d];
            }
            stg<bf16x8>(ws, (unsigned)(OFF_KTT + ((cu * 128 + d) * 64 + s8 * 8) * 2), ok);
            stg<bf16x8>(ws, (unsigned)(OFF_VT + ((cu * 128 + d) * 64 + s8 * 8) * 2), ov);
        }
    }
}

__device__ void s5_gemm_a(CParams& p, int u, char* lds) {
    LANE_IDS;
    const int wr = wid >> 1, wc = wid & 1;
    const int g = u >> 3, tm = u & 7, row0 = tm * 128;
    unsigned char* ws = p.ws;
    const unsigned aoff = (unsigned)(OFF_PU + (size_t)g * NTOK * 16 * 2), boff = (unsigned)(OFF_BTA + (size_t)g * 128 * 256 * 2);
    f32x4 acc[4][4]; ZERO_ACC(acc, 4, 4);
    mma_glds<128, 128, 2, 2, true>(acc, 4, ws,
        [&](int r, int t) { return aoff + ((row0 + r) * 256 + t * 64) * 2; },
        [&](int c, int t) { return boff + (c * 256 + t * 64) * 2; }, NoHook(), lds);
    epiT<4, 4, 64, 64>(acc, wr, wc, fq, fr, [&](int r, int cc, const f32x4& v) {
        stg<f32x4>(ws, (unsigned)(OFF_VC + (((row0 + r) * 32 + g) * 128 + cc) * 4), v); });
}

__device__ void rg_conv(CParams& p, int l) {
    const int tid = otid();
    const int c8 = (tid & 63) * 8, row0 = VB * 32 + (tid >> 6) * 8;
    unsigned char* ws = p.ws;
    const float* cw = p.in[15] + (size_t)l * 4 * 512 + c8;
    const float* cb = p.in[16] + (size_t)l * 512 + c8;
    f32x4 w[4][2], bias[2];
#pragma unroll
    for (int j = 0; j < 4; ++j) { w[j][0] = *(const f32x4*)(cw + j * 512); w[j][1] = *(const f32x4*)(cw + j * 512 + 4); }
    bias[0] = *(const f32x4*)cb; bias[1] = *(const f32x4*)(cb + 4);
    const int seq0 = row0 & ~(SEQ - 1);
    uint4 x[11];
#pragma unroll
    for (int j = 0; j < 11; ++j) {
        const int row = row0 - 3 + j;
        x[j] = (row >= seq0) ? ldg<uint4>(ws, (unsigned)(OFF_PXR + (row * 512 + c8) * 2)) : uint4{0u, 0u, 0u, 0u};
    }
#pragma unroll
    for (int r = 0; r < 8; ++r) {
        f32x4 a0 = bias[0], a1 = bias[1];
#pragma unroll
        for (int j = 0; j < 4; ++j) {
            const uint4 q = x[r + j];
            a0 += w[j][0] * unpack4(uint2{q.x, q.y});
            a1 += w[j][1] * unpack4(uint2{q.z, q.w});
        }
        stg<uint4>(ws, (unsigned)(OFF_XC + ((row0 + r) * 512 + c8) * 2), pack8(a0, a1));
    }
}

__device__ void phase2(CParams& p, int l, char* lds) {
    rg_conv(p, l);
    for (int u = VB; u < 1280; u += VG) {
        if (u < 1024) hgrn_prep(p, u, lds);
        else s5_gemm_a(p, u - 1024, lds);
    }
}

__device__ void hgrn_u(CParams& p, int u, char* lds) {
    LANE_IDS;
    const int wr = wid >> 1, wc = wid & 1;
    unsigned char* ws = p.ws;
    f32x4 acc[4][4]; ZERO_ACC(acc, 4, 4);
    mma_glds<128, 128, 2, 2>(acc, 1, ws,
        [&](int r, int t) { return (unsigned)(OFF_KTT + ((u * 128 + r) * 64) * 2); },
        [&](int c, int t) { return (unsigned)(OFF_VT + ((u * 128 + c) * 64) * 2); }, NoHook(), lds);
#pragma unroll
    for (int m = 0; m < 4; ++m) {
#pragma unroll
        for (int n = 0; n < 4; ++n) {
            const int d0 = wr * 64 + m * 16 + fq * 4, v = wc * 64 + n * 16 + fr;
            uint2 o;
            o.x = f2bf(acc[m][n][0]) | ((unsigned)f2bf(acc[m][n][1]) << 16);
            o.y = f2bf(acc[m][n][2]) | ((unsigned)f2bf(acc[m][n][3]) << 16);
            stg<uint2>(ws, (unsigned)(OFF_UT + ((u * 128 + v) * 128 + d0) * 2), o);
        }
        __builtin_amdgcn_sched_barrier(0);
    }
}

__device__ void hgrn_sscan(CParams& p, int item) {
    const int bh = item >> 12, ec = item & 4095, v = ec >> 5, d4 = (ec & 31) * 4;
    const int b = bh >> 2, h = bh & 3;
    unsigned char* ws = p.ws;
    const unsigned ub = (unsigned)(OFF_UT + ((bh * 64 * 128 + v) * 128 + d4) * 2);
    const unsigned sb = (unsigned)(OFF_ST + ((bh * 64 * 128 + v) * 128 + d4) * 2);
    const unsigned db = (unsigned)(OFF_DEC + ((b * 64) * 512 + h * 128 + d4) * 4);
    f32x4 S = {0.f, 0.f, 0.f, 0.f};
    for (int c0 = 0; c0 < 64; c0 += 8) {
        uint2 uu[8]; f32x4 dd[8];
#pragma unroll
        for (int i = 0; i < 8; ++i) { uu[i] = ldg<uint2>(ws, ub + (unsigned)((c0 + i) * 128 * 128 * 2)); dd[i] = ldg<f32x4>(ws, db + (unsigned)((c0 + i) * 512 * 4)); }
#pragma unroll
        for (int i = 0; i < 8; ++i) {
            uint2 o;
            o.x = f2bf(S[0]) | ((unsigned)f2bf(S[1]) << 16); o.y = f2bf(S[2]) | ((unsigned)f2bf(S[3]) << 16);
            stg<uint2>(ws, sb + (unsigned)((c0 + i) * 128 * 128 * 2), o);
            S[0] = dd[i][0] * S[0] + bf2f((u16)(uu[i].x & 0xffff)); S[1] = dd[i][1] * S[1] + bf2f((u16)(uu[i].x >> 16));
            S[2] = dd[i][2] * S[2] + bf2f((u16)(uu[i].y & 0xffff)); S[3] = dd[i][3] * S[3] + bf2f((u16)(uu[i].y >> 16));
        }
    }
}

__device__ void s5_scan(CParams& p, int l, int u, char* lds) {
    const int tid = otid();
    const int b = u >> 5, g = u & 31, seg = tid >> 6, pp = tid & 63;
    const int lg = l * 32 + g;
    const float dt = expf(p.in[12][lg]);
    const float ar = p.in[5][lg * 64 + pp], ai = p.in[6][lg * 64 + pp];
    const float mag = expf(16.f * ar * dt), ang = 16.f * ai * dt;
    const float er = mag * cosf(ang), ei = mag * sinf(ang);
    const float mg2 = expf(1024.f * ar * dt), an2 = 1024.f * ai * dt;
    const float sr = mg2 * cosf(an2), si = mg2 * sinf(an2);
    unsigned char* ws = p.ws;
    const unsigned vb = (unsigned)(OFF_VC + (((b * 256 + seg * 64) * 32 + g) * 128 + pp) * 4);
    const unsigned hb = (unsigned)(OFF_HC + (((b * 256 + seg * 64) * 32 + g) * 128 + pp) * 2);
    float* ex = (float*)lds;
    hsync();
    float hr = 0.f, hi = 0.f;
    for (int c0 = 0; c0 < 64; c0 += 16) {
        float vr[16], vi[16];
#pragma unroll
        for (int i = 0; i < 16; ++i) { vr[i] = ldg<float>(ws, vb + (unsigned)((c0 + i) * 4096 * 4)); vi[i] = ldg<float>(ws, vb + (unsigned)((c0 + i) * 4096 * 4 + 256)); }
#pragma unroll
        for (int i = 0; i < 16; ++i) { const float nr = er * hr - ei * hi + vr[i], ni = er * hi + ei * hr + vi[i]; hr = nr; hi = ni; }
    }
    ex[(seg * 64 + pp) * 2] = hr; ex[(seg * 64 + pp) * 2 + 1] = hi;
    hsync();
    hr = 0.f; hi = 0.f;
    for (int sg = 0; sg < seg; ++sg) {
        const float lr = ex[(sg * 64 + pp) * 2], li = ex[(sg * 64 + pp) * 2 + 1];
        const float nr = sr * hr - si * hi + lr, ni = sr * hi + si * hr + li; hr = nr; hi = ni;
    }
    for (int c0 = 0; c0 < 64; c0 += 16) {
        float vr[16], vi[16];
#pragma unroll
        for (int i = 0; i < 16; ++i) { vr[i] = ldg<float>(ws, vb + (unsigned)((c0 + i) * 4096 * 4)); vi[i] = ldg<float>(ws, vb + (unsigned)((c0 + i) * 4096 * 4 + 256)); }
#pragma unroll
        for (int i = 0; i < 16; ++i) {
            stg<u16>(ws, hb + (unsigned)((c0 + i) * 4096 * 2), f2bf(hr));
            stg<u16>(ws, hb + (unsigned)((c0 + i) * 4096 * 2 + 128), f2bf(hi));
            const float nr = er * hr - ei * hi + vr[i], ni = er * hi + ei * hr + vi[i]; hr = nr; hi = ni;
        }
    }
}

__device__ void rg_gemm(CParams& p, int l, int u, char* lds) {
    LANE_IDS;
    const int wr = wid >> 1, wc = wid & 1;
    const int tm = u >> 3, h = (u >> 1) & 3, nt = u & 1, row0 = tm * 128;
    unsigned char* ws = p.ws;
    const unsigned aoff = (unsigned)(OFF_XC + h * 128 * 2), boff = (unsigned)(OFF_RGT + ((size_t)h * 256 * 128 + (size_t)nt * 128 * 128) * 2);
    f32x4 acc[4][4]; ZERO_ACC(acc, 4, 4);
    mma_glds<128, 128, 2, 2, true>(acc, 2, ws,
        [&](int r, int t) { return aoff + ((row0 + r) * 512 + t * 64) * 2; },
        [&](int c, int t) { return boff + (c * 128 + t * 64) * 2; }, NoHook(), lds);
    const float* ba = p.in[18] + (size_t)l * 512;
    const float* bx = p.in[20] + (size_t)l * 512;
    const float* lam = p.in[21] + (size_t)l * 512;
#pragma unroll
    for (int n = 0; n < 2; ++n) {
        const int ch = h * 128 + (nt * 2 + wc) * 32 + n * 16 + fq * 4;
        const f32x4 lm = *(const f32x4*)(lam + ch), bav = *(const f32x4*)(ba + ch), bxv = *(const f32x4*)(bx + ch);
        f32x4 c1;
#pragma unroll
        for (int i = 0; i < 4; ++i) c1[i] = -8.f * log1pf(expf(-lm[i]));
#pragma unroll
        for (int m = 0; m < 4; ++m) {
            const int row = row0 + wr * 64 + m * 16 + fr;
            const f32x4 x = unpack4(ldg<uint2>(ws, (unsigned)(OFF_XC + (row * 512 + ch) * 2)));
            f32x4 la, bb;
#pragma unroll
            for (int i = 0; i < 4; ++i) {
                const float r = sigm(acc[m][n][i] + bav[i]), ig = sigm(acc[m][n + 2][i] + bxv[i]);
                la[i] = c1[i] * r;
                bb[i] = sqrtf(fmaxf(1.f - __expf(2.f * la[i]), 0.f)) * ig * x[i];
            }
            stg<uint2>(ws, (unsigned)(OFF_LA + (row * 512 + ch) * 2), pack4(la));
            stg<uint2>(ws, (unsigned)(OFF_BB + (row * 512 + ch) * 2), pack4(bb));
        }
    }
}

__device__ void phase3(CParams& p, int l, char* lds) {
    for (int u = VB; u < 2176; u += VG) {
        if (u < 128) s5_scan(p, l, u, lds);
        else if (u < 1152) hgrn_u(p, u - 128, lds);
        else rg_gemm(p, l, u - 1152, lds);
    }
}

__device__ void hgrn_out(CParams& p, int l, int u, char* lds) {
    LANE_IDS;
    const int h = u & 3, c = (u >> 2) & 63, b = u >> 8;
    const int r0 = b * SEQ + c * 64;
    const unsigned cu = (unsigned)((b * 4 + h) * 64 + c);
    unsigned char* ws = p.ws;
    char* F = lds;
    char* Qb = lds + 32768;
    char* Kb = lds + 49152;
    char* Ss = lds + 65536;
    hsync();
#pragma unroll
    for (int i = 0; i < 8; ++i) {
        const int id = tid + i * 256, s = id >> 5, ch = id & 31;
        *(f32x4*)(F + s * 512 + ((ch ^ (s & 31)) << 4)) = ldg<f32x4>(ws, (unsigned)(OFF_PLF + ((r0 + s) * 512 + h * 128 + ch * 4) * 4));
    }
#pragma unroll
    for (int i = 0; i < 4; ++i) {
        const int id = tid + i * 256, s = id >> 4, ch = id & 15;
        *(uint4*)(Qb + s * 256 + ((ch ^ (s & 15)) << 4)) = ldg<uint4>(ws, (unsigned)(OFF_PQ + ((r0 + s) * 512 + h * 128 + ch * 8) * 2));
        *(uint4*)(Kb + s * 256 + ((ch ^ (s & 15)) << 4)) = ldg<uint4>(ws, (unsigned)(OFF_PK + ((r0 + s) * 512 + h * 128 + ch * 8) * 2));
    }
    hsync();
    auto ldF8 = [&](int row, int d0, float (&o)[8]) {
        const int c0 = d0 >> 2;
        const f32x4 x = *(const f32x4*)(F + row * 512 + ((c0 ^ (row & 31)) << 4)), y = *(const f32x4*)(F + row * 512 + (((c0 + 1) ^ (row & 31)) << 4));
        o[0] = x[0]; o[1] = x[1]; o[2] = x[2]; o[3] = x[3]; o[4] = y[0]; o[5] = y[1]; o[6] = y[2]; o[7] = y[3];
    };
    auto ldH8 = [&](const char* base, int row, int d0) { return *(const bf16x8*)(base + row * 256 + (((d0 >> 3) ^ (row & 15)) << 4)); };
    {
        const int i = wid;
        const int t = 16 * i + fr;
        bf16x8 aq[4];
        float refv[4][8];
#pragma unroll
        for (int kk = 0; kk < 4; ++kk) {
            const int d0 = kk * 32 + fq * 8;
            float bt[8];
            ldF8(t, d0, bt);
            if (i == 0) {
#pragma unroll
                for (int e = 0; e < 8; ++e) refv[kk][e] = 0.f;
            } else ldF8(16 * i - 1, d0, refv[kk]);
            const bf16x8 q8 = ldH8(Qb, t, d0);
#pragma unroll
            for (int e = 0; e < 8; ++e) aq[kk][e] = (short)f2bf(bf2f((u16)q8[e]) * __expf(bt[e] - refv[kk][e]));
        }
#pragma unroll
        for (int j = 0; j < 4; ++j) {
            f32x4 sc = {0.f, 0.f, 0.f, 0.f};
            if (j <= i) {
                const int s = 16 * j + fr;
#pragma unroll
                for (int kk = 0; kk < 4; ++kk) {
                    const int d0 = kk * 32 + fq * 8;
                    float bs[8];
                    ldF8(s, d0, bs);
                    const bf16x8 k8 = ldH8(Kb, s, d0);
                    bf16x8 bk;
#pragma unroll
                    for (int e = 0; e < 8; ++e) bk[e] = (short)f2bf(bf2f((u16)k8[e]) * __expf(fminf(refv[kk][e] - bs[e], 60.f)));
                    sc = __builtin_amdgcn_mfma_f32_16x16x32_bf16(aq[kk], bk, sc, 0, 0, 0);
                }
            }
#pragma unroll
            for (int r = 0; r < 4; ++r) {
                const int tl = fq * 4 + r, sl = fr;
                float v = sc[r];
                if (j > i || (j == i && sl > tl)) v = 0.f;
                const int row = 16 * i + tl, col = 16 * j + sl;
                *(u16*)(Ss + row * 128 + (((col >> 3) ^ (row & 7)) << 4) + (col & 7) * 2) = f2bf(v);
            }
        }
    }
    hsync();
    f32x4 acc[8];
#pragma unroll
    for (int n = 0; n < 8; ++n) acc[n] = f32x4{0.f, 0.f, 0.f, 0.f};
    auto bsrc = [&](int t, int id) -> unsigned {
        const int vrow = id >> 3, ch = id & 7;
        return (t < 2) ? (unsigned)(OFF_ST + ((cu * 128 + vrow) * 128 + t * 64 + ch * 8) * 2) : (unsigned)(OFF_VT + ((cu * 128 + vrow) * 64 + ch * 8) * 2);
    };
    uint4 rb[4];
#pragma unroll
    for (int i = 0; i < 4; ++i) rb[i] = ldg<uint4>(ws, bsrc(0, tid + i * 256));
    const int arow = wid * 16 + fr;
#pragma unroll 1
    for (int t = 0; t < 3; ++t) {
#pragma unroll
        for (int i = 0; i < 4; ++i) { const int id = tid + i * 256, vrow = id >> 3, ch = id & 7; *(uint4*)(Kb + vrow * 128 + ((ch ^ ((vrow >> 1) & 7)) << 4)) = rb[i]; }
        hsync();
        if (t < 2) {
#pragma unroll
            for (int i = 0; i < 4; ++i) rb[i] = ldg<uint4>(ws, bsrc(t + 1, tid + i * 256));
        }
#pragma unroll
        for (int ks = 0; ks < 2; ++ks) {
            bf16x8 af;
            if (t < 2) {
                const int d0 = t * 64 + ks * 32 + fq * 8;
                float bq[8];
                ldF8(arow, d0, bq);
                const bf16x8 q8 = ldH8(Qb, arow, d0);
#pragma unroll
                for (int e = 0; e < 8; ++e) af[e] = (short)f2bf(bf2f((u16)q8[e]) * __expf(bq[e]));
            } else {
                af = *(const bf16x8*)(Ss + arow * 128 + (((ks * 4 + fq) ^ (arow & 7)) << 4));
            }
#pragma unroll
            for (int n = 0; n < 8; ++n) {
                const int brow = n * 16 + fr;
                const bf16x8 bfr = *(const bf16x8*)(Kb + brow * 128 + (((ks * 4 + fq) ^ ((brow >> 1) & 7)) << 4));
                acc[n] = __builtin_amdgcn_mfma_f32_16x16x32_bf16(bfr, af, acc[n], 0, 0, 0);
            }
        }
        hsync();
    }
    const float* nw = p.in[4] + (size_t)l * 512 + h * 128;
    {
        float ss = 0.f;
#pragma unroll
        for (int n = 0; n < 8; ++n)
#pragma unroll
            for (int j = 0; j < 4; ++j) ss += acc[n][j] * acc[n][j];
        ss += shfl_xor_l(ss, 16, lane); ss += shfl_xor_l(ss, 32, lane);
        const float rs = rsqrtf(ss * (1.f / 128.f) + 1e-6f);
        const int row = r0 + wid * 16 + fr;
#pragma unroll
        for (int n = 0; n < 8; ++n) {
            const int v = n * 16 + fq * 4;
            const f32x4 w4 = *(const f32x4*)(nw + v);
            const f32x4 g4 = unpack4(ldg<uint2>(ws, (unsigned)(OFF_PG + (row * 512 + h * 128 + v) * 2)));
            f32x4 o;
#pragma unroll
            for (int j = 0; j < 4; ++j) o[j] = acc[n][j] * rs * w4[j] * g4[j];
            stg<uint2>(ws, (unsigned)(OFF_YA + (row * 512 + h * 128 + v) * 2), pack4(o));
        }
    }
}

__device__ void s5_gemm_c(CParams& p, int l, int u, char* lds) {
    LANE_IDS;
    const int wr = wid >> 1, wc = wid & 1;
    const int g = u >> 4, tm = (u >> 1) & 7, tn = u & 1, row0 = tm * 128, col0 = tn * 128;
    unsigned char* ws = p.ws;
    const unsigned aoff = (unsigned)(OFF_PU + (size_t)g * NTOK * 16 * 2), boff = (unsigned)(OFF_BTC + (size_t)g * 256 * 384 * 2);
    f32x4 acc[4][4]; ZERO_ACC(acc, 4, 4);
    mma_glds<128, 128, 2, 2, true>(acc, 6, ws,
        [&](int r, int t) {
            return (t < 4) ? aoff + ((row0 + r) * 256 + t * 64) * 2 : (unsigned)(OFF_HC + (((row0 + r) * 32 + g) * 128 + (t - 4) * 64) * 2);
        },
        [&](int c, int t) { return boff + ((col0 + c) * 384 + t * 64) * 2; }, NoHook(), lds);
    const f32x4 dch = *(const f32x4*)(p.in[11] + (size_t)l * 512 + g * 16 + fq * 4);
    epiT<4, 4, 64, 64>(acc, wr, wc, fq, fr, [&](int r, int cc, const f32x4& v) {
        const int row = row0 + r, col = col0 + cc;
        const int jj = col >> 4, ch = col & 15;
        const int tok = (row >> 8) * SEQ + (row & 255) * 16 + jj;
        const f32x4 uu = unpack4(ldg<uint2>(ws, aoff + (tok * 16 + ch) * 2));
        f32x4 y;
#pragma unroll
        for (int i = 0; i < 4; ++i) y[i] = gelu_f(v[i] + dch[i] * uu[i]);
        stg<uint2>(ws, (unsigned)(OFF_YG + (tok * 512 + g * 16 + ch) * 2), pack4(y)); });
}

__device__ __forceinline__ void bf4(const uint2 q, float (&o)[4]) {
    o[0] = bf2f((u16)(q.x & 0xffff)); o[1] = bf2f((u16)(q.x >> 16)); o[2] = bf2f((u16)(q.y & 0xffff)); o[3] = bf2f((u16)(q.y >> 16));
}
__device__ void rg_local(CParams& p, int item) {
    const int b = item >> 13, seg = (item >> 7) & 63, c4 = (item & 127) * 4;
    unsigned char* ws = p.ws;
    const unsigned base = (unsigned)(((b * SEQ + seg * 64) * 512 + c4) * 2);
    float hh[4] = {0.f, 0.f, 0.f, 0.f}, ap[4] = {1.f, 1.f, 1.f, 1.f};
    for (int s0 = 0; s0 < 64; s0 += 8) {
        uint2 a[8], bb[8];
#pragma unroll
        for (int i = 0; i < 8; ++i) { a[i] = ldg<uint2>(ws, (unsigned)OFF_LA + base + (unsigned)((s0 + i) * 1024)); bb[i] = ldg<uint2>(ws, (unsigned)OFF_BB + base + (unsigned)((s0 + i) * 1024)); }
#pragma unroll
        for (int i = 0; i < 8; ++i) {
            float av[4], bv[4]; bf4(a[i], av); bf4(bb[i], bv);
#pragma unroll
            for (int c = 0; c < 4; ++c) { const float e = __expf(av[c]); hh[c] = e * hh[c] + bv[c]; ap[c] *= e; }
        }
    }
    stg<f32x4>(ws, (unsigned)(OFF_SEGA + ((b * 64 + seg) * 512 + c4) * 4), f32x4{ap[0], ap[1], ap[2], ap[3]});
    stg<f32x4>(ws, (unsigned)(OFF_SEGH + ((b * 64 + seg) * 512 + c4) * 4), f32x4{hh[0], hh[1], hh[2], hh[3]});
}

__device__ void rg_final(CParams& p, int item) {
    const int b = item >> 13, seg = (item >> 7) & 63, c4 = (item & 127) * 4;
    unsigned char* ws = p.ws;
    const unsigned base = (unsigned)(((b * SEQ + seg * 64) * 512 + c4) * 2);
    f32x4 hh = {0.f, 0.f, 0.f, 0.f};
    for (int sg0 = 0; sg0 < seg; sg0 += 8) {
        f32x4 sa[8], sh[8];
#pragma unroll
        for (int i = 0; i < 8; ++i) {
            const int sg = min(sg0 + i, 63);
            sa[i] = ldg<f32x4>(ws, (unsigned)(OFF_SEGA + ((b * 64 + sg) * 512 + c4) * 4));
            sh[i] = ldg<f32x4>(ws, (unsigned)(OFF_SEGH + ((b * 64 + sg) * 512 + c4) * 4));
        }
#pragma unroll
        for (int i = 0; i < 8; ++i) if (sg0 + i < seg) hh = sa[i] * hh + sh[i];
    }
    for (int s0 = 0; s0 < 64; s0 += 8) {
        uint2 a[8], bb[8], xg[8];
#pragma unroll
        for (int i = 0; i < 8; ++i) {
            a[i] = ldg<uint2>(ws, (unsigned)OFF_LA + base + (unsigned)((s0 + i) * 1024));
            bb[i] = ldg<uint2>(ws, (unsigned)OFF_BB + base + (unsigned)((s0 + i) * 1024));
            xg[i] = ldg<uint2>(ws, (unsigned)OFF_PXG + base + (unsigned)((s0 + i) * 1024));
        }
#pragma unroll
        for (int i = 0; i < 8; ++i) {
            float av[4], bv[4], xv[4]; bf4(a[i], av); bf4(bb[i], bv); bf4(xg[i], xv);
#pragma unroll
            for (int c = 0; c < 4; ++c) hh[c] = __expf(av[c]) * hh[c] + bv[c];
            uint2 o; o.x = f2bf(hh[0] * xv[0]) | ((unsigned)f2bf(hh[1] * xv[1]) << 16); o.y = f2bf(hh[2] * xv[2]) | ((unsigned)f2bf(hh[3] * xv[3]) << 16);
            stg<uint2>(ws, (unsigned)OFF_YC + base + (unsigned)((s0 + i) * 1024), o);
        }
    }
}

__device__ void phase4(CParams& p, int l, char* lds) {
    {
        const int tid = otid();
        if (tid < 128) hgrn_sscan(p, VB * 128 + tid);
        else if (tid < 192) rg_local(p, VB * 64 + (tid - 128));
    }
    for (int u = VB; u < 512; u += VG) s5_gemm_c(p, l, u, lds);
}

__device__ void phase_glu(CParams& p, int l, char* lds) {
    LANE_IDS;
    const int wr = wid >> 1, wc = wid & 1;
    unsigned char* ws = p.ws;
    const float* gb = p.in[14] + (size_t)l * 512;
    if (tid < 64) rg_final(p, VB * 64 + tid);
    for (int uu = VB; uu < 1536; uu += VG) {
        if (uu < 1024) { hgrn_out(p, l, uu, lds); continue; }
        const int u = uu - 1024;
        const int row0 = (u >> 2) * 128, col0 = (u & 3) * 128;
        f32x4 acc[4][4]; ZERO_ACC(acc, 4, 4);
        mma_glds<128, 128, 2, 2, true>(acc, 8, ws,
            [&](int r, int t) { return (unsigned)(OFF_YG + ((row0 + r) * 512 + t * 64) * 2); },
            [&](int c, int t) { return (unsigned)(OFF_GLUT + ((col0 + c) * 512 + t * 64) * 2); }, NoHook(), lds);
        epiT<4, 4, 64, 64>(acc, wr, wc, fq, fr, [&](int r, int cc, const f32x4& v) {
            const int row = row0 + r, col = col0 + cc;
            const f32x4 y = unpack4(ldg<uint2>(ws, (unsigned)(OFF_YG + (row * 512 + col) * 2)));
            const f32x4 bb = *(const f32x4*)(gb + col);
            f32x4 o;
#pragma unroll
            for (int i = 0; i < 4; ++i) o[i] = y[i] * sigm(v[i] + bb[i]);
            stg<uint2>(ws, (unsigned)(OFF_YB + (row * 512 + col) * 2), pack4(o)); });
    }
}

__device__ void phase_branch(CParams& p, int l, char* lds) {
    BrSched S; S.c = blockIdx.x;
    BrEpi E; E.ws = p.ws;
    g8::gemm_phase<BrEpi, BrSched, false>((LAS unsigned char*)lds, p.ws, 512, S, E);
}

__device__ void phase_out(CParams& p, int l, char* lds, char* hlds) {
    {
        OutSched S; S.A = (unsigned)OFF_MIXP; S.B = (unsigned)OFF_WOUTT; S.c = blockIdx.x; S.G = gridDim.x;
        OutEpi E; E.ws = p.ws;
        g8::gemm_phase<OutEpi, OutSched, false>((LAS unsigned char*)lds, p.ws, 1024, S, E);
    }
    const int tid = otid();
    float* fl = (float*)hlds;
    for (int u = VB; u < 6144; u += VG) {
        const int e = u / 96, r = u % 96;
        const float *s1, *s2; int ld, K, kp, nt; u16* dst; bool perm;
        if (r < 64) { s1 = p.in[28] + (size_t)(l * 64 + e) * 1024 * 256; s2 = p.in[29] + (size_t)(l * 64 + e) * 1024 * 256; ld = 256; K = 1024; kp = r & 7; nt = r >> 3; perm = true;
                      dst = (u16*)(p.ws + OFF_EW13) + (size_t)e * 512 * 1024; }
        else { s1 = p.in[30] + (size_t)(l * 64 + e) * 256 * 1024; s2 = s1; ld = 1024; K = 256; kp = (r - 64) & 1; nt = (r - 64) >> 1; perm = false;
               dst = (u16*)(p.ws + OFF_EW2) + (size_t)e * 1024 * 256; }
        const int nc = (tid & 15) * 4;
        const float* s = perm ? (((nc & 31) < 16) ? s1 : s2) : s1;
        const int col = perm ? (nt * 2 + (nc >> 5)) * 16 + (nc & 15) : nt * 64 + nc;
        float4 v[8];
#pragma unroll
        for (int i = 0; i < 8; ++i) v[i] = *(const float4*)(s + (size_t)(kp * 128 + (tid >> 4) + 16 * i) * ld + col);
        hsync();
#pragma unroll
        for (int i = 0; i < 8; ++i) { float* d = fl + ((tid >> 4) + 16 * i) * 65 + nc; d[0] = v[i].x; d[1] = v[i].y; d[2] = v[i].z; d[3] = v[i].w; }
        hsync();
#pragma unroll
        for (int j = 0; j < 4; ++j) {
            const int n = tid >> 2, k8 = (tid & 3) * 8 + 32 * j;
            uint4 o;
            o.x = f2bf(fl[(k8 + 0) * 65 + n]) | ((unsigned)f2bf(fl[(k8 + 1) * 65 + n]) << 16);
            o.y = f2bf(fl[(k8 + 2) * 65 + n]) | ((unsigned)f2bf(fl[(k8 + 3) * 65 + n]) << 16);
            o.z = f2bf(fl[(k8 + 4) * 65 + n]) | ((unsigned)f2bf(fl[(k8 + 5) * 65 + n]) << 16);
            o.w = f2bf(fl[(k8 + 6) * 65 + n]) | ((unsigned)f2bf(fl[(k8 + 7) * 65 + n]) << 16);
            *(uint4*)(dst + (size_t)(nt * 64 + n) * K + kp * 128 + k8) = o;
        }
    }
}

__device__ __forceinline__ void ln_row(float (&v)[16], const float* g, const float* bta, int lane) {
    float s = 0.f;
#pragma unroll
    for (int i = 0; i < 16; ++i) s += v[i];
    const float mu = wave_sum(s, lane) * (1.f / 1024.f);
    float q = 0.f;
#pragma unroll
    for (int i = 0; i < 16; ++i) { float d = v[i] - mu; q += d * d; }
    const float rs = rsqrtf(wave_sum(q, lane) * (1.f / 1024.f) + 1e-5f);
#pragma unroll
    for (int i = 0; i < 4; ++i) {
        const float4 gg = *(const float4*)(g + i * 256 + lane * 4), bb = *(const float4*)(bta + i * 256 + lane * 4);
        v[i * 4 + 0] = (v[i * 4 + 0] - mu) * rs * gg.x + bb.x;
        v[i * 4 + 1] = (v[i * 4 + 1] - mu) * rs * gg.y + bb.y;
        v[i * 4 + 2] = (v[i * 4 + 2] - mu) * rs * gg.z + bb.z;
        v[i * 4 + 3] = (v[i * 4 + 3] - mu) * rs * gg.w + bb.w;
    }
}

__device__ void phase_route(CParams& p, int l, char* lds) {
    LANE_IDS;
    const float* Pre = (const float*)(p.ws + OFF_PRELN);
    u16* Xm = (u16*)(p.ws + OFF_XM);
    const float* g1 = p.in[24] + (size_t)l * 1024;
    const float* b1 = p.in[25] + (size_t)l * 1024;
    const float* rbias = p.in[27] + (size_t)l * 64;
    int* cursor = (int*)(p.ws + OFF_CUR);
    int* list = (int*)(p.ws + OFF_LIST);
    float* wlist = (float*)(p.ws + OFF_WLIST);
    float* Ls = (float*)(lds + 32768);
    int* hist = (int*)(lds + 32768 + 64 * 65 * 4);
    int* basep = hist + 64;
    for (int u = VB; u < 512; u += VG) {
        const int row0 = u * 32;
#pragma unroll 1
        for (int hb = 0; hb < 2; ++hb) {
            float v[4][16];
#pragma unroll
            for (int rr = 0; rr < 4; ++rr) {
                const int row = row0 + wid * 8 + hb * 4 + rr;
#pragma unroll
                for (int i = 0; i < 4; ++i) {
                    const float4 x = *(const float4*)(Pre + (size_t)row * 1024 + i * 256 + lane * 4);
                    v[rr][i * 4] = x.x; v[rr][i * 4 + 1] = x.y; v[rr][i * 4 + 2] = x.z; v[rr][i * 4 + 3] = x.w;
                }
            }
#pragma unroll
            for (int rr = 0; rr < 4; ++rr) {
                const int row = row0 + wid * 8 + hb * 4 + rr;
                ln_row(v[rr], g1, b1, lane);
#pragma unroll
                for (int i = 0; i < 4; ++i) {
                    uint2 o; o.x = f2bf(v[rr][i * 4]) | ((unsigned)f2bf(v[rr][i * 4 + 1]) << 16); o.y = f2bf(v[rr][i * 4 + 2]) | ((unsigned)f2bf(v[rr][i * 4 + 3]) << 16);
                    *(uint2*)(Xm + (size_t)row * 1024 + i * 256 + lane * 4) = o;
                }
            }
        }
        if (tid < 64) hist[tid] = 0;
        hsync();
        f32x4 acc[1][2]; ZERO_ACC(acc, 1, 2);
        mma_glds<32, 64, 2, 2>(acc, 16, p.ws,
            [&](int r, int t) { return (unsigned)(OFF_XM + ((row0 + r) * 1024 + t * 64) * 2); },
            [&](int c, int t) { return (unsigned)(OFF_ROUTT + (c * 1024 + t * 64) * 2); }, NoHook(), lds);
#pragma unroll
        for (int n = 0; n < 2; ++n)
#pragma unroll
            for (int j = 0; j < 4; ++j) {
                const int r = (wid >> 1) * 16 + fq * 4 + j, e = (wid & 1) * 32 + n * 16 + fr;
                Ls[r * 65 + e] = sigm(acc[0][n][j]) + rbias[e];
            }
        hsync();
        int myrank[8]; int myexp[8]; float wv[8];
        if (tid < 32) {
            float* sc = Ls + tid * 65;
            float gs[8];
#pragma unroll
            for (int g = 0; g < 8; ++g) {
                float m1 = -1e30f, m2 = -1e30f;
#pragma unroll
                for (int i = 0; i < 8; ++i) { float x = sc[g * 8 + i]; if (x > m1) { m2 = m1; m1 = x; } else if (x > m2) m2 = x; }
                gs[g] = m1 + m2;
            }
            unsigned gmask = 0;
#pragma unroll
            for (int it = 0; it < 4; ++it) {
                float best = -1e30f; int bi = 0;
#pragma unroll
                for (int g = 0; g < 8; ++g) { bool ok = !((gmask >> g) & 1u) && gs[g] > best; if (ok) { best = gs[g]; bi = g; } }
                gmask |= 1u << bi;
            }
            unsigned long long chosen = 0ull;
            float wsum = 0.f;
#pragma unroll
            for (int k = 0; k < 8; ++k) {
                float best = -1e30f; int bi = 0;
                for (int e = 0; e < 64; ++e) {
                    float x = sc[e];
                    bool ok = ((gmask >> (e >> 3)) & 1u) && !((chosen >> e) & 1ull) && x > best;
                    if (ok) { best = x; bi = e; }
                }
                chosen |= 1ull << bi;
                myexp[k] = bi;
                wv[k] = best - rbias[bi];
                wsum += wv[k];
            }
            const float sc_ = 2.5f / wsum;
#pragma unroll
            for (int k = 0; k < 8; ++k) {
                wv[k] *= sc_;
                myrank[k] = atomicAdd(&hist[myexp[k]], 1);
            }
        }
        hsync();
        if (tid < 64) basep[tid] = atomicAdd(&cursor[tid], hist[tid]);
        hsync();
        if (tid < 32) {
#pragma unroll
            for (int k = 0; k < 8; ++k) {
                const size_t pos = (size_t)myexp[k] * NTOK + basep[myexp[k]] + myrank[k];
                list[pos] = (row0 + tid) * 8 + k;
                wlist[pos] = wv[k];
            }
        }
        hsync();
    }
}

__device__ void phase_combine(CParams& p, int l) {
    LANE_IDS;
    typedef float f32x2 __attribute__((ext_vector_type(2)));
    unsigned char* ws = p.ws;
    const float* g2 = p.in[34] + (size_t)l * 1024 + lane * 16;
    const float* b2 = p.in[35] + (size_t)l * 1024 + lane * 16;
    for (int row = VB * 4 + wid; row < NTOK; row += VG * 4) {
        f32x4 y[4]; uint4 xm[2]; u32x4 yb[8];
#pragma unroll
        for (int i = 0; i < 2; ++i) { const uint4 q = ldg<uint4>(ws, (unsigned)(OFF_YSH + (row * 1024 + lane * 16 + i * 8) * 2)); y[i * 2] = unpack4(uint2{q.x, q.y}); y[i * 2 + 1] = unpack4(uint2{q.z, q.w}); }
#pragma unroll
        for (int i = 0; i < 2; ++i) xm[i] = ldg<uint4>(ws, (unsigned)(OFF_XM + (row * 1024 + lane * 16 + i * 8) * 2));
#pragma unroll
        for (int k = 0; k < 8; ++k) yb[k] = ldg<u32x4>(ws, (unsigned)OFF_YBUF + (unsigned)((row * 8 + k) * 1024 + lane * 16));
        float v[16], s[16];
#pragma unroll
        for (int i = 0; i < 16; ++i) s[i] = 0.f;
#pragma unroll
        for (int k = 0; k < 8; ++k)
#pragma unroll
            for (int w = 0; w < 4; ++w) {
                const f32x2 lo = __builtin_amdgcn_cvt_pk_f32_fp8((int)yb[k][w], false), hi = __builtin_amdgcn_cvt_pk_f32_fp8((int)yb[k][w], true);
                s[w * 4 + 0] += lo.x; s[w * 4 + 1] += lo.y; s[w * 4 + 2] += hi.x; s[w * 4 + 3] += hi.y;
            }
#pragma unroll
        for (int i = 0; i < 2; ++i) {
            const uint4 x = xm[i];
            const float xf[8] = {bf2f((u16)(x.x & 0xffff)), bf2f((u16)(x.x >> 16)), bf2f((u16)(x.y & 0xffff)), bf2f((u16)(x.y >> 16)),
                                 bf2f((u16)(x.z & 0xffff)), bf2f((u16)(x.z >> 16)), bf2f((u16)(x.w & 0xffff)), bf2f((u16)(x.w >> 16))};
#pragma unroll
            for (int j = 0; j < 8; ++j) v[i * 8 + j] = y[i * 2 + (j >> 2)][j & 3] + DN_ALPHA * xf[j] + s[i * 8 + j] * (1.f / 32.f);
        }
        float sum = 0.f;
#pragma unroll
        for (int i = 0; i < 16; ++i) sum += v[i];
        const float mu = wave_sum(sum, lane) * (1.f / 1024.f);
        float q = 0.f;
#pragma unroll
        for (int i = 0; i < 16; ++i) { const float d = v[i] - mu; q += d * d; }
        const float rs = rsqrtf(wave_sum(q, lane) * (1.f / 1024.f) + 1e-5f);
#pragma unroll
        for (int i = 0; i < 4; ++i) {
            const f32x4 gg = *(const f32x4*)(g2 + i * 4), bb = *(const f32x4*)(b2 + i * 4);
#pragma unroll
            for (int j = 0; j < 4; ++j) v[i * 4 + j] = (v[i * 4 + j] - mu) * rs * gg[j] + bb[j];
            if (l == 1) stg<f32x4>(p.out, (unsigned)((row * 1024 + lane * 16 + i * 4) * 4), f32x4{v[i * 4], v[i * 4 + 1], v[i * 4 + 2], v[i * 4 + 3]});
        }
#pragma unroll
        for (int i = 0; i < 2; ++i) {
            uint4 o;
            o.x = f2bf(v[i * 8 + 0]) | ((unsigned)f2bf(v[i * 8 + 1]) << 16); o.y = f2bf(v[i * 8 + 2]) | ((unsigned)f2bf(v[i * 8 + 3]) << 16);
            o.z = f2bf(v[i * 8 + 4]) | ((unsigned)f2bf(v[i * 8 + 5]) << 16); o.w = f2bf(v[i * 8 + 6]) | ((unsigned)f2bf(v[i * 8 + 7]) << 16);
            stg<uint4>(ws, (unsigned)(OFF_XB + (row * 1024 + lane * 16 + i * 8) * 2), o);
        }
    }
}


#define XB_TMO      128
#define XB_XCNT(j)  (256  + 64 * (j))
#define XB_XSUB(j)  (1280 + 64 * (j))
#define XB_XGEN(j)  (2304 + 64 * (j))
#define XB_TOP      3328
#define XB_TOPGEN   3392
#define XCD_BAR_WORDS 3456
#define XB_SPIN_CAP (1u << 22)
__device__ __forceinline__ unsigned xb_ld(unsigned* p)              { return __hip_atomic_load(p, __ATOMIC_RELAXED, __HIP_MEMORY_SCOPE_AGENT); }
__device__ __forceinline__ unsigned xb_add(unsigned* p, unsigned v) { return __hip_atomic_fetch_add(p, v, __ATOMIC_RELAXED, __HIP_MEMORY_SCOPE_AGENT); }
__device__ __forceinline__ unsigned xb_xcc_id() { return (unsigned)__builtin_amdgcn_s_getreg((3 << 11) | 20) & 0xFu; }
#define XB_SPIN(cond, bar) do { unsigned _sp = 0; while (cond) { __builtin_amdgcn_s_sleep(1); \
    if ((++_sp & 255u) == 0u) { if (xb_ld(&(bar)[XB_TMO])) break; if (_sp > XB_SPIN_CAP) { atomicAdd(&(bar)[XB_TMO], 1u); break; } } } } while (0)
struct XcdBarrier { unsigned* bar; unsigned x; volatile LAS unsigned* st; };
__device__ __forceinline__ XcdBarrier xcd_barrier_post(unsigned* bar, volatile LAS unsigned* st) {
    XcdBarrier b; b.bar = bar; b.x = xb_xcc_id(); b.st = st;
    if (threadIdx.x == 0) (void)xb_add(&bar[XB_XCNT(b.x)], 1u);
    return b;
}
__device__ __forceinline__ void xcd_barrier_complete(unsigned* bar, unsigned x, unsigned& nloc, unsigned& nx) {
    const unsigned G = gridDim.x * gridDim.y * gridDim.z;
    unsigned sum, cnt, mine, sp = 0u;
    for (;;) {
        sum = 0u; cnt = 0u; mine = 0u;
#pragma unroll
        for (unsigned j = 0; j < 16; ++j) { const unsigned c = xb_ld(&bar[XB_XCNT(j)]); sum += c; cnt += (c > 0u) ? 1u : 0u; mine = (j == x) ? c : mine; }
        if (sum == G) break;
        __builtin_amdgcn_s_sleep(1);
        if ((++sp & 255u) == 0u) { if (xb_ld(&bar[XB_TMO])) break; if (sp > XB_SPIN_CAP) { atomicAdd(&bar[XB_TMO], 1u); break; } }
    }
    nloc = mine > 0u ? mine : 1u; nx = cnt > 0u ? cnt : 1u;
}
__device__ __forceinline__ void xcd_barrier(const XcdBarrier& b) {
    asm volatile("s_waitcnt vmcnt(0)" ::: "memory");
    __syncthreads();
    if (threadIdx.x == 0) {
        unsigned* bar = b.bar;
        __builtin_amdgcn_s_waitcnt(0);
        unsigned nloc = b.st[0], nx = b.st[1];
        if (nloc == 0u) { xcd_barrier_complete(bar, b.x, nloc, nx); b.st[0] = nloc; b.st[1] = nx; }
        const unsigned old = xb_add(&bar[XB_XSUB(b.x)], 1u);
        const unsigned gen = old / nloc;
        if (old + 1u == (gen + 1u) * nloc) {
            __builtin_amdgcn_fence(__ATOMIC_RELEASE, "agent");
            asm volatile("s_waitcnt vmcnt(0)" ::: "memory");
            const unsigned og = xb_add(&bar[XB_TOP], 1u);
            const unsigned tg = og / nx;
            if (og + 1u == (tg + 1u) * nx) xb_add(&bar[XB_TOPGEN], 1u);
            else XB_SPIN(xb_ld(&bar[XB_TOPGEN]) == tg, bar);
            __builtin_amdgcn_fence(__ATOMIC_ACQUIRE, "agent");
            xb_add(&bar[XB_XGEN(b.x)], 1u);
            asm volatile("s_waitcnt vmcnt(0)" ::: "memory");
        } else {
            XB_SPIN(xb_ld(&bar[XB_XGEN(b.x)]) == gen, bar);
            __builtin_amdgcn_fence(__ATOMIC_ACQUIRE, "agent");
            asm volatile("s_waitcnt vmcnt(0)" ::: "memory");
        }
    }
    __syncthreads();
}

__global__ void __launch_bounds__(512, 2) fwd_kernel(Params p_unused) {
    char* lds = g_lds;
    cg::grid_group grid = cg::this_grid();
    CParams* pp = (CParams*)__builtin_amdgcn_kernarg_segment_ptr();
    const int ph_lo = pp->ph_lo;
    volatile LAS unsigned* xst = (volatile LAS unsigned*)(lds + L_XST);
    if (threadIdx.x == 0) { xst[0] = 0u; xst[1] = 0u; *(LAS unsigned*)(lds + 147456 + 16) = 0u; *(LAS unsigned*)(lds + 147456 + 20) = 0u; *(LAS unsigned*)(lds + 147456 + 32) = 0u; }
    __syncthreads();
    const XcdBarrier xb = xcd_barrier_post((unsigned*)(pp->ws + OFF_BAR), xst);
    char* hlds = lds + __builtin_amdgcn_readfirstlane((int)(threadIdx.x >> 8)) * HLDS;
    unsigned long long tq_acc = 0;
    (void)ph_lo;
#pragma unroll
    for (int ph = 0; ph < 2 * NPH; ++ph) {
        asm volatile("" : "+s"(pp));
        CParams& p = *pp;
        const int l = ph / NPH, q = ph % NPH;
        unsigned long long tq0 = 0;
        if (PROBE_TQ >= 0 && q == PROBE_TQ) tq0 = __builtin_amdgcn_s_memrealtime();
#pragma unroll 1
        for (int rep = 0; rep < 1 + (int)((PROBE_MASK >> q) & 1u); ++rep) {
            if (rep) xcd_barrier(xb);
            switch (q) {
                case 0: phase_w(p, l, hlds); break;
                case 1: phase_proj(p, l, lds); break;
                case 2: phase2(p, l, hlds); break;
                case 3: phase3(p, l, hlds); break;
                case 4: phase4(p, l, hlds); break;
                case 5: phase_glu(p, l, hlds); break;
                case 6: phase_branch(p, l, lds); break;
                case 7: phase_out(p, l, lds, hlds); break;
                case 8: phase_route(p, l, hlds); break;
                case 9: phase_moe1(p, l, lds); break;
                case 10: phase_moe2(p, l, lds); break;
                default: phase_combine(p, l); break;
            }
        }
        if (ph + 1 < 2 * NPH) {
            if (p.coop == 1) xcd_barrier(xb);
            else if (p.coop == 2) grid.sync();
        }
        if (PROBE_TQ >= 0 && q == PROBE_TQ) tq_acc += __builtin_amdgcn_s_memrealtime() - tq0;
    }
    if (PROBE_TQ == 98) tq_acc = *(LAS unsigned*)(lds + 147456 + 32);
    if (PROBE_TQ >= 0 && blockIdx.x == 0) {
        const unsigned long long t0 = __builtin_amdgcn_s_memrealtime();
        while (__builtin_amdgcn_s_memrealtime() - t0 < 4ull * tq_acc) __builtin_amdgcn_s_sleep(8);
    }
}

extern "C" void kernel_launch(void* const* d_in, const int* in_sizes, int n_in, void* d_out, int out_size, void* d_ws, size_t ws_size,
                              hipStream_t stream) {
    static int grid_blocks = 0;
    if (!grid_blocks) {
        int dev = 0, cus = 0, per_cu = 0;
        (void)hipGetDevice(&dev);
        (void)hipDeviceGetAttribute(&cus, hipDeviceAttributeMultiprocessorCount, dev);
        (void)hipFuncSetAttribute((const void*)fwd_kernel, hipFuncAttributeMaxDynamicSharedMemorySize, LDS_BYTES);
        (void)hipOccupancyMaxActiveBlocksPerMultiprocessor(&per_cu, fwd_kernel, 512, LDS_BYTES);
        if (per_cu < 1) per_cu = 1;
        per_cu = 1;
        grid_blocks = cus * per_cu;
        if (ws_size < WS_NEED) fprintf(stderr, "kernel_launch: workspace too small: %zu < %zu\n", ws_size, (size_t)WS_NEED);
    }
    Params p{};
    for (int i = 0; i < 36; ++i) p.in[i] = (const float*)d_in[i];
    p.out = (float*)d_out;
    p.ws = (unsigned char*)d_ws;
    p.ph_lo = 0; p.ph_hi = 2 * NPH; p.coop = 1; p.pad = 0;
    (void)hipMemsetAsync((char*)d_ws + OFF_BAR, 0, XCD_BAR_WORDS * 4, stream);
    void* args[] = {&p};
    hipError_t e = hipLaunchCooperativeKernel((void*)fwd_kernel, dim3(grid_blocks), dim3(512), args, LDS_BYTES, stream);
    if (e != hipSuccess) fprintf(stderr, "cooperative launch failed: %s (grid %d)\n", hipGetErrorString(e), grid_blocks);
}
```
